# Optimizing an MI355X kernel written in HIP

```python
import math
import jax, jax.numpy as jnp
from jax import lax
import numpy as np

D_MODEL = 1024
BATCH = 8
SEQ = 4096
DEPTH = 1

N_ATT_HEADS = 4
ATT_HEAD_DIM = 64
ATT_V_DIM = 2 * ATT_HEAD_DIM
QK_WIDTH = N_ATT_HEADS * 2 * ATT_HEAD_DIM
ATT_WIDTH = N_ATT_HEADS * ATT_V_DIM
Q_BLOCK = 128
ROPE_THETA = 10000.0
SSM_WIDTH = D_MODEL - ATT_WIDTH
SSM_GROUP = 16
SSM_GROUPS = SSM_WIDTH // SSM_GROUP
SSM_STATE = 64
DT_MIN = 1e-3
DT_MAX = 1e-1
MIX_WIDTH = ATT_WIDTH + SSM_WIDTH
IN_WIDTH = 2 * QK_WIDTH + ATT_WIDTH + SSM_WIDTH
N_EXPERTS = 256
TOP_K = 8
N_GROUPS = 8
TOPK_GROUPS = 4
EXPERT_DIM = 256
SHARED_DIM = 256
ROUTED_SCALE = 2.5
MOE_BLOCK = 128
EPS = 1e-6

kernel_name = 'hymba_diffattn_s5_moe_adaln'


def rms_norm(t, g):
    tf = t.astype(jnp.float32)
    y = tf * lax.rsqrt(jnp.mean(tf * tf, axis=-1, keepdims=True) + EPS)
    return (y * g.astype(jnp.float32)).astype(t.dtype)


def modulate(h, shift, scale):
    return h * (1.0 + scale[:, None, :]) + shift[:, None, :]


def rope_tables(seq_len):
    inv_freq = 1.0 / (ROPE_THETA ** (jnp.arange(0, ATT_HEAD_DIM, 2, dtype=jnp.float32) / ATT_HEAD_DIM))
    ang = jnp.arange(seq_len, dtype=jnp.float32)[:, None] * inv_freq[None, :]
    return jnp.cos(ang)[None, :, None, None, :], jnp.sin(ang)[None, :, None, None, :]


def apply_rope(t, cos, sin):
    t = t.astype(jnp.float32)
    t1, t2 = jnp.split(t, 2, axis=-1)
    return jnp.concatenate([t1 * cos - t2 * sin, t1 * sin + t2 * cos], axis=-1)


def lambda_init(layer):
    return 0.8 - 0.6 * math.exp(-0.3 * layer)


def diff_attention(q, k, v, q_g, k_g, lq1, lk1, lq2, lk2, sub_g, cos, sin, lam_init):
    bsz, seq_len, _ = q.shape
    out_dtype = q.dtype
    q = apply_rope(rms_norm(q.reshape(bsz, seq_len, N_ATT_HEADS, 2, ATT_HEAD_DIM), q_g), cos, sin)
    k = apply_rope(rms_norm(k.reshape(bsz, seq_len, N_ATT_HEADS, 2, ATT_HEAD_DIM), k_g), cos, sin)
    v = v.reshape(bsz, seq_len, N_ATT_HEADS, ATT_V_DIM).astype(jnp.float32)
    f32 = jnp.float32
    lam = (jnp.exp(jnp.sum(lq1.astype(f32) * lk1.astype(f32)))
           - jnp.exp(jnp.sum(lq2.astype(f32) * lk2.astype(f32))) + lam_init)
    scale = ATT_HEAD_DIM ** -0.5
    k_pos = jnp.arange(seq_len)

    def one_block(i):
        q_blk = lax.dynamic_slice_in_dim(q, i * Q_BLOCK, Q_BLOCK, axis=1)
        s = jnp.einsum('bqhcd,bkhcd->bhcqk', q_blk, k) * scale
        q_pos = i * Q_BLOCK + jnp.arange(Q_BLOCK)
        causal = k_pos[None, :] <= q_pos[:, None]
        p = jax.nn.softmax(jnp.where(causal, s, -jnp.inf), axis=-1)
        w = p[:, :, 0] - lam * p[:, :, 1]
        return jnp.einsum('bhqk,bkhe->bqhe', w, v)

    o = lax.map(one_block, jnp.arange(seq_len // Q_BLOCK))
    o = jnp.moveaxis(o, 0, 1).reshape(bsz, seq_len, N_ATT_HEADS, ATT_V_DIM)
    o = rms_norm(o, sub_g) * (1.0 - lam_init)
    return o.reshape(bsz, seq_len, ATT_WIDTH).astype(out_dtype)


def complex_scan_combine(earlier, later):
    a1r, a1i, b1r, b1i = earlier
    a2r, a2i, b2r, b2i = later
    return (a2r * a1r - a2i * a1i,
            a2r * a1i + a2i * a1r,
            a2r * b1r - a2i * b1i + b2r,
            a2r * b1i + a2i * b1r + b2i)


def s5_branch(u, a_re, a_im, log_dt, b_re, b_im, c_re, c_im, d_skip, w_glu, norm_g):
    bsz, seq_len, _ = u.shape
    f32 = jnp.float32
    uf = u.astype(f32).reshape(bsz, seq_len, SSM_GROUPS, SSM_GROUP)
    a_re = a_re.astype(f32)
    a_im = a_im.astype(f32)
    dt = jnp.exp(log_dt.astype(f32))[:, None]
    mag = jnp.exp(a_re * dt)
    abar_re = mag * jnp.cos(a_im * dt)
    abar_im = mag * jnp.sin(a_im * dt)
    den = a_re * a_re + a_im * a_im
    nr = abar_re - 1.0
    f_re = ((nr * a_re + abar_im * a_im) / den)[..., None]
    f_im = ((abar_im * a_re - nr * a_im) / den)[..., None]
    b_re = b_re.astype(f32)
    b_im = b_im.astype(f32)
    bb_re = f_re * b_re - f_im * b_im
    bb_im = f_re * b_im + f_im * b_re
    bu_re = jnp.einsum('blgc,gpc->blgp', uf, bb_re)
    bu_im = jnp.einsum('blgc,gpc->blgp', uf, bb_im)
    a_seq_re = jnp.broadcast_to(abar_re, (1, seq_len, SSM_GROUPS, SSM_STATE))
    a_seq_im = jnp.broadcast_to(abar_im, (1, seq_len, SSM_GROUPS, SSM_STATE))
    _, _, s_re, s_im = lax.associative_scan(complex_scan_combine, (a_seq_re, a_seq_im, bu_re, bu_im), axis=1)
    y = (jnp.einsum('blgp,gcp->blgc', s_re, c_re.astype(f32))
         - jnp.einsum('blgp,gcp->blgc', s_im, c_im.astype(f32))
         + d_skip.astype(f32) * uf)
    y = jax.nn.gelu(y.reshape(bsz, seq_len, SSM_WIDTH))
    y = y * jax.nn.sigmoid(y @ w_glu.astype(f32))
    return rms_norm(y, norm_g).astype(u.dtype)


def swiglu(t, w_g, w_u, w_d):
    return (jax.nn.silu(t @ w_g) * (t @ w_u)) @ w_d


def route(hf, w_router, r_bias):
    n_tok = hf.shape[0]
    per_group = N_EXPERTS // N_GROUPS
    s = jax.nn.sigmoid((hf @ w_router).astype(jnp.float32))
    sb = s + r_bias.astype(jnp.float32)
    grp_score = lax.top_k(sb.reshape(n_tok, N_GROUPS, per_group), 2)[0].sum(axis=-1)
    _, g_idx = lax.top_k(grp_score, TOPK_GROUPS)
    g_mask = jax.nn.one_hot(g_idx, N_GROUPS, dtype=jnp.float32).sum(axis=-2) > 0
    e_mask = jnp.repeat(g_mask, per_group, axis=-1)
    _, e_idx = lax.top_k(jnp.where(e_mask, sb, -jnp.inf), TOP_K)
    w = jnp.take_along_axis(s, e_idx, axis=-1)
    w = w / jnp.sum(w, axis=-1, keepdims=True) * ROUTED_SCALE
    return e_idx, w


def routed_experts(hf, e_idx, gate_w, w_g, w_u, w_d):
    n_tok = hf.shape[0]
    n_assign = n_tok * TOP_K
    n_blocks = (n_assign + N_EXPERTS * (MOE_BLOCK - 1) + MOE_BLOCK - 1) // MOE_BLOCK
    e_flat = e_idx.reshape(n_assign)
    t_flat = jnp.repeat(jnp.arange(n_tok, dtype=jnp.int32), TOP_K)
    g_flat = gate_w.reshape(n_assign).astype(hf.dtype)
    order = jnp.argsort(e_flat)
    e_sorted = e_flat[order]
    counts = jnp.bincount(e_flat, length=N_EXPERTS)
    starts = jnp.cumsum(counts) - counts
    padded = (counts + MOE_BLOCK - 1) // MOE_BLOCK * MOE_BLOCK
    pad_ends = jnp.cumsum(padded)
    pad_starts = pad_ends - padded
    dest = pad_starts[e_sorted] + jnp.arange(n_assign, dtype=jnp.int32) - starts[e_sorted]
    slot_tok = jnp.zeros((n_blocks * MOE_BLOCK,), jnp.int32).at[dest].set(t_flat[order])
    slot_gate = jnp.zeros((n_blocks * MOE_BLOCK,), hf.dtype).at[dest].set(g_flat[order])
    block_start = jnp.arange(n_blocks, dtype=jnp.int32) * MOE_BLOCK
    block_expert = jnp.minimum(jnp.searchsorted(pad_ends, block_start, side='right'), N_EXPERTS - 1)

    def one_block(acc, blk):
        tok, gate, e = blk
        yb = swiglu(hf[tok], w_g[e], w_u[e], w_d[e]) * gate[:, None]
        return acc.at[tok].add(yb), None

    out, _ = lax.scan(one_block, jnp.zeros_like(hf),
                      (slot_tok.reshape(n_blocks, MOE_BLOCK), slot_gate.reshape(n_blocks, MOE_BLOCK), block_expert))
    return out


def setup_inputs(seed: int = 0) -> dict:
    key = jax.random.key(seed)
    ks = jax.random.split(key, 33)
    nrm = jax.random.normal
    L, D = DEPTH, D_MODEL
    G, P, C = SSM_GROUPS, SSM_STATE, SSM_GROUP
    E, DE, DS = N_EXPERTS, EXPERT_DIM, SHARED_DIM
    x = nrm(ks[0], (BATCH, SEQ, D), jnp.float32)
    c = nrm(ks[1], (BATCH, D), jnp.float32)
    norm1_g = 1.0 + 0.02 * nrm(ks[2], (L, D))
    norm2_g = 1.0 + 0.02 * nrm(ks[3], (L, D))
    w_ada = 0.5 * D ** -0.5 * nrm(ks[4], (L, D, 6 * D))
    b_ada = 0.02 * nrm(ks[5], (L, 6 * D))
    w_in = D ** -0.5 * nrm(ks[6], (L, D, IN_WIDTH))
    q_norm_g = 1.0 + 0.02 * nrm(ks[7], (L, ATT_HEAD_DIM))
    k_norm_g = 1.0 + 0.02 * nrm(ks[8], (L, ATT_HEAD_DIM))
    lambda_q1 = 0.1 * nrm(ks[9], (L, ATT_HEAD_DIM))
    lambda_k1 = 0.1 * nrm(ks[10], (L, ATT_HEAD_DIM))
    lambda_q2 = 0.1 * nrm(ks[11], (L, ATT_HEAD_DIM))
    lambda_k2 = 0.1 * nrm(ks[12], (L, ATT_HEAD_DIM))
    subln_g = 1.0 + 0.02 * nrm(ks[13], (L, ATT_V_DIM))
    ssm_a_re = -0.5 * (1.0 + 0.05 * jax.random.uniform(ks[14], (L, G, P), minval=-1.0, maxval=1.0))
    ssm_a_im = math.pi * jnp.arange(P, dtype=jnp.float32) + 0.01 * nrm(ks[15], (L, G, P))
    ssm_log_dt = jax.random.uniform(ks[16], (L, G), minval=math.log(DT_MIN), maxval=math.log(DT_MAX))
    ssm_b_re = (2 * C) ** -0.5 * nrm(ks[17], (L, G, P, C))
    ssm_b_im = (2 * C) ** -0.5 * nrm(ks[18], (L, G, P, C))
    ssm_c_re = (2 * P) ** -0.5 * nrm(ks[19], (L, G, C, P))
    ssm_c_im = (2 * P) ** -0.5 * nrm(ks[20], (L, G, C, P))
    ssm_d = nrm(ks[21], (L, G, C))
    w_glu = SSM_WIDTH ** -0.5 * nrm(ks[22], (L, SSM_WIDTH, SSM_WIDTH))
    ssm_norm_g = 1.0 + 0.02 * nrm(ks[23], (L, SSM_WIDTH))
    w_out = MIX_WIDTH ** -0.5 * nrm(ks[24], (L, MIX_WIDTH, D))
    w_router = D ** -0.5 * nrm(ks[25], (L, D, E))
    router_bias = 0.01 * nrm(ks[26], (L, E))
    w_gate_e = D ** -0.5 * nrm(ks[27], (L, E, D, DE))
    w_up_e = D ** -0.5 * nrm(ks[28], (L, E, D, DE))
    w_down_e = DE ** -0.5 * nrm(ks[29], (L, E, DE, D))
    w_gate_s = D ** -0.5 * nrm(ks[30], (L, D, DS))
    w_up_s = D ** -0.5 * nrm(ks[31], (L, D, DS))
    w_down_s = DS ** -0.5 * nrm(ks[32], (L, DS, D))
    return {'x': x, 'c': c, 'norm1_g': norm1_g, 'norm2_g': norm2_g, 'w_ada': w_ada, 'b_ada': b_ada,
            'w_in': w_in, 'q_norm_g': q_norm_g, 'k_norm_g': k_norm_g,
            'lambda_q1': lambda_q1, 'lambda_k1': lambda_k1, 'lambda_q2': lambda_q2, 'lambda_k2': lambda_k2,
            'subln_g': subln_g, 'ssm_a_re': ssm_a_re, 'ssm_a_im': ssm_a_im, 'ssm_log_dt': ssm_log_dt,
            'ssm_b_re': ssm_b_re, 'ssm_b_im': ssm_b_im, 'ssm_c_re': ssm_c_re, 'ssm_c_im': ssm_c_im,
            'ssm_d': ssm_d, 'w_glu': w_glu, 'ssm_norm_g': ssm_norm_g, 'w_out': w_out,
            'w_router': w_router, 'router_bias': router_bias,
            'w_gate_e': w_gate_e, 'w_up_e': w_up_e, 'w_down_e': w_down_e,
            'w_gate_s': w_gate_s, 'w_up_s': w_up_s, 'w_down_s': w_down_s}


def reference(x, c, norm1_g, norm2_g, w_ada, b_ada, w_in, q_norm_g, k_norm_g,
              lambda_q1, lambda_k1, lambda_q2, lambda_k2, subln_g,
              ssm_a_re, ssm_a_im, ssm_log_dt, ssm_b_re, ssm_b_im, ssm_c_re, ssm_c_im,
              ssm_d, w_glu, ssm_norm_g, w_out, w_router, router_bias,
              w_gate_e, w_up_e, w_down_e, w_gate_s, w_up_s, w_down_s):
    bsz, seq_len, _ = x.shape
    cos, sin = rope_tables(seq_len)
    split_at = [QK_WIDTH, 2 * QK_WIDTH, 2 * QK_WIDTH + ATT_WIDTH]
    for layer in range(DEPTH):
        mod = jax.nn.silu(c) @ w_ada[layer] + b_ada[layer]
        sh1, sc1, g1, sh2, sc2, g2 = jnp.split(mod, 6, axis=-1)
        h = modulate(rms_norm(x, norm1_g[layer]), sh1, sc1)
        q, k, v, u = jnp.split(h @ w_in[layer], split_at, axis=-1)
        att = diff_attention(q, k, v, q_norm_g[layer], k_norm_g[layer],
                             lambda_q1[layer], lambda_k1[layer], lambda_q2[layer], lambda_k2[layer],
                             subln_g[layer], cos, sin, lambda_init(layer))
        ssm = s5_branch(u, ssm_a_re[layer], ssm_a_im[layer], ssm_log_dt[layer],
                        ssm_b_re[layer], ssm_b_im[layer], ssm_c_re[layer], ssm_c_im[layer],
                        ssm_d[layer], w_glu[layer], ssm_norm_g[layer])
        mix = jnp.concatenate([att, ssm], axis=-1) @ w_out[layer]
        x = x + g1[:, None, :] * mix
        h = modulate(rms_norm(x, norm2_g[layer]), sh2, sc2).reshape(bsz * seq_len, D_MODEL)
        e_idx, gate_w = route(h, w_router[layer], router_bias[layer])
        ffn = (routed_experts(h, e_idx, gate_w, w_gate_e[layer], w_up_e[layer], w_down_e[layer])
               + swiglu(h, w_gate_s[layer], w_up_s[layer], w_down_s[layer]))
        x = x + g2[:, None, :] * ffn.reshape(bsz, seq_len, D_MODEL)
    return x
```

```cpp
#include <hip/hip_runtime.h>
#include <cstdio>
#include <cstdint>

typedef unsigned short bf16_t;
typedef float f32x4 __attribute__((ext_vector_type(4)));
typedef unsigned u32x4 __attribute__((ext_vector_type(4)));
typedef unsigned u32x2 __attribute__((ext_vector_type(2)));

constexpr int DM = 1024, NB = 8, SEQ = 4096, T = NB * SEQ;
constexpr int NH = 4, HD = 64, VD = 128, QKW = 512, ATTW = 512, SSMW = 512;
constexpr int SG = 32, SC = 16, SP = 64;
constexpr int LC = 16;
constexpr int NCHUNK = SEQ / LC;
constexpr int APK = 384;
constexpr int NE = 256, TOPK = 8, NGRP = 8, TOPG = 4, ED = 256;
constexpr int NS_MAX = 327680;
constexpr float EPS = 1e-6f;
constexpr float LAM_INIT = 0.2f;
constexpr float ROUTED_SCALE = 2.5f;

constexpr size_t MiB = 1u << 20;
constexpr size_t WS_CTL = 0, CTL_BYTES = 1 * MiB;
constexpr int CW_COUNTS = 1024;
constexpr int CW_CURSOR = 1024 + 256;
constexpr int CW_NTILES = 2048;
constexpr size_t CTL_SS1 = 256 * 1024;
constexpr size_t CTL_SS2 = 384 * 1024;
constexpr size_t WS_MOD = 1 * MiB;
constexpr size_t WS_LAM = 1 * MiB + 256 * 1024;
constexpr size_t WS_ROPE = 1 * MiB + 512 * 1024;
constexpr size_t WS_SSMP = 2 * MiB + 512 * 1024;
constexpr size_t WS_EIDX = 4 * MiB;
constexpr size_t WS_GATEW = 5 * MiB;
constexpr size_t WS_SLOT_TOK = 6 * MiB;
constexpr size_t WS_SLOT_ASG = 7 * MiB + 512 * 1024;
constexpr size_t WS_SLOT_GATE = 9 * MiB;
constexpr size_t WS_TILE_E = 10 * MiB + 512 * 1024;
constexpr size_t WS_PADST = 10 * MiB + 768 * 1024;
constexpr size_t WS_YA = 32 * MiB;
constexpr size_t WS_H = 288 * MiB;
constexpr size_t WS_QK = 352 * MiB;
constexpr size_t WS_Y = 352 * MiB;
constexpr size_t WS_V = 416 * MiB;
constexpr size_t WS_AP = 448 * MiB;
constexpr size_t WS_ACTE = 544 * MiB;
constexpr size_t WS_MIXIN = 544 * MiB;
constexpr size_t WS_LOGITS = 608 * MiB;
constexpr size_t WS_ACTS = 640 * MiB;
constexpr size_t WS_ATTO = 832 * MiB;
constexpr size_t WS_NEED = 1024 * MiB;

__device__ __forceinline__ float bf2f(bf16_t v) { return __uint_as_float((unsigned)v << 16); }
__device__ __forceinline__ bf16_t f2bf(float f) { unsigned u = __float_as_uint(f); return (bf16_t)((u + 0x7fffu + ((u >> 16) & 1u)) >> 16); }
__device__ __forceinline__ unsigned pk2(float lo, float hi) { return (unsigned)f2bf(lo) | ((unsigned)f2bf(hi) << 16); }
__device__ __forceinline__ float wave_sum(float v) {
#pragma unroll
    for (int o = 1; o < 64; o <<= 1) v += __shfl_xor(v, o);
    return v;
}
__device__ __forceinline__ float siluf(float v) { return v / (1.f + __expf(-v)); }
__device__ __forceinline__ float sigmoidf(float v) { return 1.f / (1.f + __expf(-v)); }
__device__ __forceinline__ float gelu_tanh(float v) { const float u = 0.7978845608028654f * (v + 0.044715f * v * v * v); return 0.5f * v * (1.f + tanhf(u)); }

struct Params {
    const float* in[33];
    float* out;
    unsigned char* ws;
    int ph_lo, ph_hi;
};

struct Ctx {
    int tid, lane, wave, bid, nb;
    int gtid, gthreads, gwave, gwaves;
    unsigned char* ws;
    float* lds;
};

enum { I_X = 0, I_C, I_N1G, I_N2G, I_WADA, I_BADA, I_WIN, I_QNG, I_KNG, I_LQ1, I_LK1, I_LQ2, I_LK2, I_SUBG,
       I_ARE, I_AIM, I_LOGDT, I_BRE, I_BIM, I_CRE, I_CIM, I_SD, I_WGLU, I_SNG, I_WOUT, I_WR, I_RB,
       I_WGE, I_WUE, I_WDE, I_WGS, I_WUS, I_WDS };

struct SG_Args {
    const bf16_t* A; int lda; const int* rowidx;
    const float* W; const float* W2; int ldb;
    size_t wstride;
    const int* tile_e;
    int M, N, K;
};
template <bool DUAL, class Epi>
__device__ __forceinline__ void sgemm_phase(const Ctx& c, const SG_Args g, const Epi& E) {
    float* As = c.lds;
    float* Bs = c.lds + 16 * 132;
    float* Bs2 = Bs + 16 * 128;
    const int tid = c.tid, ty = tid >> 5, tx = tid & 31;
    const int nMt = g.M / 128, nNt = g.N / 128, ntile = nMt * nNt;
    for (int tile = c.bid; tile < ntile; tile += c.nb) {
        const int mt = tile / nNt, nt = tile % nNt;
        const float* W = g.W; const float* W2 = g.W2;
        if (g.tile_e) { const int e = g.tile_e[mt >> 1]; if (e < 0) continue; W += (size_t)e * g.wstride; if (DUAL) W2 += (size_t)e * g.wstride; }
        f32x4 acc[8], acc2[8];
#pragma unroll
        for (int i = 0; i < 8; ++i) { acc[i] = (f32x4){0.f, 0.f, 0.f, 0.f}; acc2[i] = (f32x4){0.f, 0.f, 0.f, 0.f}; }
        const int arow = mt * 128 + (tid >> 2), akq = (tid & 3) * 4;
        const int asrc = g.rowidx ? g.rowidx[arow] : arow;
        const bf16_t* ap = g.A + (size_t)asrc * g.lda + akq;
        const int bk = tid >> 5, bn = (tid & 31) * 4;
        const float* bp = W + (size_t)bk * g.ldb + nt * 128 + bn;
        const float* bp2 = DUAL ? (W2 + (size_t)bk * g.ldb + nt * 128 + bn) : nullptr;
#pragma unroll 1
        for (int k0 = 0; k0 < g.K; k0 += 16) {
            const u32x2 av = *(const u32x2*)(ap + k0);
            const f32x4 bv = *(const f32x4*)(bp + (size_t)k0 * g.ldb);
            f32x4 bv2 = {0.f, 0.f, 0.f, 0.f};
            if (DUAL) bv2 = *(const f32x4*)(bp2 + (size_t)k0 * g.ldb);
            __syncthreads();
            As[(akq + 0) * 132 + (tid >> 2)] = __uint_as_float(av.x << 16);
            As[(akq + 1) * 132 + (tid >> 2)] = __uint_as_float(av.x & 0xffff0000u);
            As[(akq + 2) * 132 + (tid >> 2)] = __uint_as_float(av.y << 16);
            As[(akq + 3) * 132 + (tid >> 2)] = __uint_as_float(av.y & 0xffff0000u);
            *(f32x4*)(Bs + bk * 128 + bn) = bv;
            if (DUAL) *(f32x4*)(Bs2 + bk * 128 + bn) = bv2;
            __syncthreads();
#pragma unroll
            for (int kk = 0; kk < 16; ++kk) {
                const f32x4 a0 = *(const f32x4*)(As + kk * 132 + ty * 8), a1 = *(const f32x4*)(As + kk * 132 + ty * 8 + 4);
                const f32x4 b = *(const f32x4*)(Bs + kk * 128 + tx * 4);
                const float a[8] = {a0.x, a0.y, a0.z, a0.w, a1.x, a1.y, a1.z, a1.w};
#pragma unroll
                for (int i = 0; i < 8; ++i) acc[i] += a[i] * b;
                if (DUAL) {
                    const f32x4 b2 = *(const f32x4*)(Bs2 + kk * 128 + tx * 4);
#pragma unroll
                    for (int i = 0; i < 8; ++i) acc2[i] += a[i] * b2;
                }
            }
        }
#pragma unroll
        for (int i = 0; i < 8; ++i) E(mt * 128 + ty * 8 + i, nt * 128 + tx * 4, acc[i], acc2[i], tx);
    }
}

__device__ __forceinline__ void ph_prologue(const Ctx& c, const Params& p) {
    float* mod = (float*)(c.ws + WS_MOD);
    for (int idx = c.gtid; idx < NB * 6 * DM; idx += c.gthreads) {
        const int b = idx / (6 * DM), j = idx % (6 * DM);
        const float* cc = p.in[I_C] + b * DM; const float* w = p.in[I_WADA] + j;
        float acc = p.in[I_BADA][j];
#pragma unroll 8
        for (int k = 0; k < DM; ++k) acc += siluf(cc[k]) * w[(size_t)k * (6 * DM)];
        mod[idx] = acc;
    }
    float* ropec = (float*)(c.ws + WS_ROPE); float* ropes = ropec + SEQ * 32;
    for (int idx = c.gtid; idx < SEQ * 32; idx += c.gthreads) {
        const int l = idx >> 5, i = idx & 31;
        const double invf = exp(-log(10000.0) * (double)(2 * i) / 64.0);
        const double ang = (double)l * invf;
        ropec[idx] = (float)cos(ang); ropes[idx] = (float)sin(ang);
    }
    float* sp = (float*)(c.ws + WS_SSMP);
    float* abr = sp, * abi = sp + SG * SP, * bbr = sp + 2 * SG * SP, * bbi = bbr + SG * SP * SC;
    for (int idx = c.gtid; idx < SG * SP; idx += c.gthreads) {
        const int g = idx / SP;
        const double are = p.in[I_ARE][idx], aim = p.in[I_AIM][idx], dt = exp((double)p.in[I_LOGDT][g]);
        const double mag = exp(are * dt), ar = mag * cos(aim * dt), ai = mag * sin(aim * dt);
        abr[idx] = (float)ar; abi[idx] = (float)ai;
        const double den = are * are + aim * aim, nr = ar - 1.0;
        const double fre = (nr * are + ai * aim) / den, fim = (ai * are - nr * aim) / den;
        for (int ch = 0; ch < SC; ++ch) {
            const double br = p.in[I_BRE][idx * SC + ch], bi = p.in[I_BIM][idx * SC + ch];
            bbr[idx * SC + ch] = (float)(fre * br - fim * bi); bbi[idx * SC + ch] = (float)(fre * bi + fim * br);
        }
    }
    if (c.gtid == 0) {
        float s1 = 0.f, s2 = 0.f, gq = 0.f, gk = 0.f;
        for (int i = 0; i < HD; ++i) { s1 += p.in[I_LQ1][i] * p.in[I_LK1][i]; s2 += p.in[I_LQ2][i] * p.in[I_LK2][i];
            gq = fmaxf(gq, fabsf(p.in[I_QNG][i])); gk = fmaxf(gk, fabsf(p.in[I_KNG][i])); }
        float* lam = (float*)(c.ws + WS_LAM);
        lam[0] = __expf(s1) - __expf(s2) + LAM_INIT;
        lam[1] = 0.125f * 64.f * gq * gk;
    }
    int* stok = (int*)(c.ws + WS_SLOT_TOK); int* sasg = (int*)(c.ws + WS_SLOT_ASG); float* sgate = (float*)(c.ws + WS_SLOT_GATE);
    for (int idx = c.gtid; idx < NS_MAX; idx += c.gthreads) { stok[idx] = 0; sasg[idx] = -1; sgate[idx] = 0.f; }
    int* te = (int*)(c.ws + WS_TILE_E);
    for (int idx = c.gtid; idx < NS_MAX / 256; idx += c.gthreads) te[idx] = -1;
}

__device__ __forceinline__ void ph_h1(const Ctx& c, const Params& p) {
    const float* mod = (const float*)(c.ws + WS_MOD); bf16_t* H = (bf16_t*)(c.ws + WS_H);
    for (int t = c.gwave; t < T; t += c.gwaves) {
        const int b = t / SEQ; const f32x4* xr = (const f32x4*)(p.in[I_X] + (size_t)t * DM) + c.lane;
        f32x4 v[4]; float s = 0.f;
#pragma unroll
        for (int j = 0; j < 4; ++j) { v[j] = xr[64 * j]; s += v[j].x * v[j].x + v[j].y * v[j].y + v[j].z * v[j].z + v[j].w * v[j].w; }
        const float rstd = rsqrtf(wave_sum(s) * (1.f / DM) + EPS);
        const float* sh = mod + b * 6 * DM, * sc = sh + DM;
#pragma unroll
        for (int j = 0; j < 4; ++j) { const int col = 4 * c.lane + 256 * j;
            const f32x4 g = *(const f32x4*)(p.in[I_N1G] + col), s1 = *(const f32x4*)(sc + col), h1 = *(const f32x4*)(sh + col);
            const f32x4 o = (v[j] * rstd * g) * (1.f + s1) + h1;
            u32x2 w; w.x = pk2(o.x, o.y); w.y = pk2(o.z, o.w); *(u32x2*)(H + (size_t)t * DM + col) = w; }
    }
}

struct EpiWin {
    bf16_t* QK; bf16_t* V; bf16_t* AP;
    __device__ __forceinline__ void operator()(int row, int col, const f32x4& a, const f32x4&, int) const {
        u32x2 w; w.x = pk2(a[0], a[1]); w.y = pk2(a[2], a[3]);
        if (col < 1024) *(u32x2*)(QK + (size_t)row * 1024 + col) = w;
        else if (col < 1536) *(u32x2*)(V + (size_t)row * 512 + (col - 1024)) = w;
        else { const int cc = col - 1536, g = cc >> 4, ch = cc & 15, b = row / SEQ, l = row % SEQ;
            *(u32x2*)(AP + ((size_t)(g * (NB * NCHUNK) + b * NCHUNK + (l >> 4)) * APK + (l & 15) * 16 + ch)) = w; }
    }
};

__device__ __forceinline__ void ph_qkn(const Ctx& c, const Params& p) {
    bf16_t* QK = (bf16_t*)(c.ws + WS_QK);
    const float* ropec = (const float*)(c.ws + WS_ROPE); const float* ropes = ropec + SEQ * 32;
    const int l = c.lane;
    const float gq = p.in[I_QNG][l], gk = p.in[I_KNG][l];
    for (int t = c.gwave; t < T; t += c.gwaves) {
        const int pos = t % SEQ; const float cs = ropec[pos * 32 + (l & 31)], sn = ropes[pos * 32 + (l & 31)];
        bf16_t* r = QK + (size_t)t * 1024;
#pragma unroll 4
        for (int gi = 0; gi < 16; ++gi) {
            const float v = bf2f(r[gi * 64 + l]);
            const float rstd = rsqrtf(wave_sum(v * v) * (1.f / 64.f) + EPS);
            const float y = v * rstd * (gi < 8 ? gq : gk);
            const float o = __shfl_xor(y, 32);
            const float res = (l < 32) ? (y * cs - o * sn) : (o * sn + y * cs);
            r[gi * 64 + l] = f2bf(res);
        }
    }
}

__device__ __forceinline__ void ph_att_base(const Ctx& c, const Params& p) {
    const bf16_t* QK = (const bf16_t*)(c.ws + WS_QK); const bf16_t* V = (const bf16_t*)(c.ws + WS_V); float* AO = (float*)(c.ws + WS_ATTO);
    const float smax = ((const float*)(c.ws + WS_LAM))[1];
    const int nitem = NB * NH * 4 * (SEQ / 64);
    for (int it = c.gwave; it < nitem; it += c.gwaves) {
        const int qb = (SEQ / 64 - 1) - (it / (NB * NH * 4)), bhc = it % (NB * NH * 4), b = bhc / (NH * 4), h = (bhc >> 2) % NH, cc = (bhc >> 1) & 1, vh = bhc & 1;
        const int q = qb * 64 + c.lane; const size_t trow = (size_t)b * SEQ + q;
        float qv[64];
        { const bf16_t* qp = QK + trow * 1024 + h * 128 + cc * 64;
#pragma unroll
          for (int d = 0; d < 64; ++d) qv[d] = bf2f(qp[d]) * 0.125f; }
        float o[64];
#pragma unroll
        for (int d = 0; d < 64; ++d) o[d] = 0.f;
        float lsum = 0.f;
        const int jmax = qb * 64 + 63;
        for (int j = 0; j <= jmax; ++j) {
            const size_t krow = (size_t)b * SEQ + j;
            const u32x4* kp = (const u32x4*)(QK + krow * 1024 + 512 + h * 128 + cc * 64);
            float s = 0.f;
#pragma unroll
            for (int i = 0; i < 8; ++i) { const u32x4 kk = kp[i];
                s += qv[8 * i + 0] * __uint_as_float(kk.x << 16) + qv[8 * i + 1] * __uint_as_float(kk.x & 0xffff0000u)
                   + qv[8 * i + 2] * __uint_as_float(kk.y << 16) + qv[8 * i + 3] * __uint_as_float(kk.y & 0xffff0000u)
                   + qv[8 * i + 4] * __uint_as_float(kk.z << 16) + qv[8 * i + 5] * __uint_as_float(kk.z & 0xffff0000u)
                   + qv[8 * i + 6] * __uint_as_float(kk.w << 16) + qv[8 * i + 7] * __uint_as_float(kk.w & 0xffff0000u); }
            float pe = (j <= q) ? __expf(s - smax) : 0.f;
            lsum += pe;
            const u32x4* vp = (const u32x4*)(V + krow * 512 + h * 128 + vh * 64);
#pragma unroll
            for (int i = 0; i < 8; ++i) { const u32x4 vv = vp[i];
                o[8 * i + 0] += pe * __uint_as_float(vv.x << 16); o[8 * i + 1] += pe * __uint_as_float(vv.x & 0xffff0000u);
                o[8 * i + 2] += pe * __uint_as_float(vv.y << 16); o[8 * i + 3] += pe * __uint_as_float(vv.y & 0xffff0000u);
                o[8 * i + 4] += pe * __uint_as_float(vv.z << 16); o[8 * i + 5] += pe * __uint_as_float(vv.z & 0xffff0000u);
                o[8 * i + 6] += pe * __uint_as_float(vv.w << 16); o[8 * i + 7] += pe * __uint_as_float(vv.w & 0xffff0000u); }
        }
        const float rl = 1.f / lsum;
        float* op = AO + (trow * 8 + h * 2 + cc) * 128 + vh * 64;
#pragma unroll
        for (int d = 0; d < 64; d += 4) *(f32x4*)(op + d) = (f32x4){o[d] * rl, o[d + 1] * rl, o[d + 2] * rl, o[d + 3] * rl};
    }
}
__device__ __forceinline__ void ph_att_comb(const Ctx& c, const Params& p) {
    const float* AO = (const float*)(c.ws + WS_ATTO); bf16_t* MX = (bf16_t*)(c.ws + WS_MIXIN);
    const float lam = ((const float*)(c.ws + WS_LAM))[0];
    for (int it = c.gwave; it < T * NH; it += c.gwaves) {
        const int t = it >> 2, h = it & 3;
        const float* o1 = AO + ((size_t)t * 8 + h * 2) * 128, * o2 = o1 + 128;
        const float a = o1[c.lane] - lam * o2[c.lane], b = o1[64 + c.lane] - lam * o2[64 + c.lane];
        const float rstd = rsqrtf(wave_sum(a * a + b * b) * (1.f / 128.f) + EPS) * (1.f - LAM_INIT);
        MX[(size_t)t * 1024 + h * 128 + c.lane] = f2bf(a * rstd * p.in[I_SUBG][c.lane]);
        MX[(size_t)t * 1024 + h * 128 + 64 + c.lane] = f2bf(b * rstd * p.in[I_SUBG][64 + c.lane]);
    }
}

__device__ __forceinline__ void ph_ssm_base(const Ctx& c, const Params& p) {
    const bf16_t* AP = (const bf16_t*)(c.ws + WS_AP); bf16_t* Y = (bf16_t*)(c.ws + WS_Y);
    const float* sp = (const float*)(c.ws + WS_SSMP);
    const float* abr = sp, * abi = sp + SG * SP, * bbr = sp + 2 * SG * SP, * bbi = bbr + SG * SP * SC;
    for (int it = c.gwave; it < NB * SG; it += c.gwaves) {
        const int b = it / SG, g = it % SG, pp = c.lane;
        const float ar = abr[g * SP + pp], ai = abi[g * SP + pp];
        float br[16], bi[16], cr[16], ci[16];
#pragma unroll
        for (int ch = 0; ch < 16; ++ch) { br[ch] = bbr[(g * SP + pp) * SC + ch]; bi[ch] = bbi[(g * SP + pp) * SC + ch];
            cr[ch] = p.in[I_CRE][(g * SC + ch) * SP + pp]; ci[ch] = p.in[I_CIM][(g * SC + ch) * SP + pp]; }
        const float dsk = (pp < 16) ? p.in[I_SD][g * SC + pp] : 0.f;
        float sr = 0.f, si = 0.f;
        for (int l = 0; l < SEQ; ++l) {
            const bf16_t* up = AP + ((size_t)(g * (NB * NCHUNK) + b * NCHUNK + (l >> 4)) * APK + (l & 15) * 16);
            const u32x4 u0 = *(const u32x4*)up, u1 = *(const u32x4*)(up + 8);
            float u[16] = { __uint_as_float(u0.x << 16), __uint_as_float(u0.x & 0xffff0000u), __uint_as_float(u0.y << 16), __uint_as_float(u0.y & 0xffff0000u),
                            __uint_as_float(u0.z << 16), __uint_as_float(u0.z & 0xffff0000u), __uint_as_float(u0.w << 16), __uint_as_float(u0.w & 0xffff0000u),
                            __uint_as_float(u1.x << 16), __uint_as_float(u1.x & 0xffff0000u), __uint_as_float(u1.y << 16), __uint_as_float(u1.y & 0xffff0000u),
                            __uint_as_float(u1.z << 16), __uint_as_float(u1.z & 0xffff0000u), __uint_as_float(u1.w << 16), __uint_as_float(u1.w & 0xffff0000u) };
            float bur = 0.f, bui = 0.f;
#pragma unroll
            for (int ch = 0; ch < 16; ++ch) { bur += u[ch] * br[ch]; bui += u[ch] * bi[ch]; }
            const float nr = ar * sr - ai * si + bur, ni = ar * si + ai * sr + bui; sr = nr; si = ni;
            float mine = 0.f;
#pragma unroll
            for (int ch = 0; ch < 16; ++ch) { const float v = wave_sum(sr * cr[ch] - si * ci[ch]); if (pp == ch) mine = v + dsk * u[ch]; }
            if (pp < 16) Y[((size_t)b * SEQ + l) * 512 + g * 16 + pp] = f2bf(gelu_tanh(mine));
        }
    }
}

struct EpiGlu {
    const bf16_t* Y; bf16_t* MX; float* ss;
    __device__ __forceinline__ void operator()(int row, int col, const f32x4& a, const f32x4&, int) const {
        const u32x2 yv = *(const u32x2*)(Y + (size_t)row * 512 + col);
        const float y0 = __uint_as_float(yv.x << 16), y1 = __uint_as_float(yv.x & 0xffff0000u), y2 = __uint_as_float(yv.y << 16), y3 = __uint_as_float(yv.y & 0xffff0000u);
        const float v0 = y0 * sigmoidf(a[0]), v1 = y1 * sigmoidf(a[1]), v2 = y2 * sigmoidf(a[2]), v3 = y3 * sigmoidf(a[3]);
        u32x2 w; w.x = pk2(v0, v1); w.y = pk2(v2, v3); *(u32x2*)(MX + (size_t)row * 1024 + 512 + col) = w;
        float s = v0 * v0 + v1 * v1 + v2 * v2 + v3 * v3;
#pragma unroll
        for (int o = 1; o < 32; o <<= 1) s += __shfl_xor(s, o);
        if ((threadIdx.x & 31) == 0) atomicAdd(ss + row, s);
    }
};
__device__ __forceinline__ void ph_ssm_norm(const Ctx& c, const Params& p) {
    bf16_t* MX = (bf16_t*)(c.ws + WS_MIXIN); const float* ss = (const float*)(c.ws + WS_CTL + CTL_SS1);
    for (int t = c.gwave; t < T; t += c.gwaves) {
        const float rstd = rsqrtf(ss[t] * (1.f / 512.f) + EPS);
        bf16_t* r = MX + (size_t)t * 1024 + 512 + c.lane * 8; const float* g = p.in[I_SNG] + c.lane * 8;
        u32x4 w = *(u32x4*)r; unsigned* wp = (unsigned*)&w;
#pragma unroll
        for (int i = 0; i < 4; ++i) { const float a = __uint_as_float(wp[i] << 16) * rstd * g[2 * i], b = __uint_as_float(wp[i] & 0xffff0000u) * rstd * g[2 * i + 1]; wp[i] = pk2(a, b); }
        *(u32x4*)r = w;
    }
}
struct EpiWout {
    const float* x; const float* mod; float* out; float* ss;
    __device__ __forceinline__ void operator()(int row, int col, const f32x4& a, const f32x4&, int) const {
        const int b = row / SEQ; const f32x4 xv = *(const f32x4*)(x + (size_t)row * DM + col), g1 = *(const f32x4*)(mod + b * 6 * DM + 2 * DM + col);
        const f32x4 o = {xv.x + g1.x * a[0], xv.y + g1.y * a[1], xv.z + g1.z * a[2], xv.w + g1.w * a[3]};
        *(f32x4*)(out + (size_t)row * DM + col) = o;
        float s = o.x * o.x + o.y * o.y + o.z * o.z + o.w * o.w;
#pragma unroll
        for (int of = 1; of < 32; of <<= 1) s += __shfl_xor(s, of);
        if ((threadIdx.x & 31) == 0) atomicAdd(ss + row, s);
    }
};
__device__ __forceinline__ void ph_h2(const Ctx& c, const Params& p) {
    const float* mod = (const float*)(c.ws + WS_MOD); bf16_t* H = (bf16_t*)(c.ws + WS_H);
    const float* ss = (const float*)(c.ws + WS_CTL + CTL_SS2);
    for (int t = c.gwave; t < T; t += c.gwaves) {
        const int b = t / SEQ; const f32x4* xr = (const f32x4*)(p.out + (size_t)t * DM) + c.lane;
        const float rstd = rsqrtf(ss[t] * (1.f / DM) + EPS);
        const float* sh = mod + b * 6 * DM + 3 * DM, * sc = sh + DM;
#pragma unroll
        for (int j = 0; j < 4; ++j) { const int col = 4 * c.lane + 256 * j; const f32x4 v = xr[64 * j];
            const f32x4 g = *(const f32x4*)(p.in[I_N2G] + col), s1 = *(const f32x4*)(sc + col), h1 = *(const f32x4*)(sh + col);
            const f32x4 o = (v * rstd * g) * (1.f + s1) + h1;
            u32x2 w; w.x = pk2(o.x, o.y); w.y = pk2(o.z, o.w); *(u32x2*)(H + (size_t)t * DM + col) = w; }
    }
}
struct EpiLogits { float* L; __device__ __forceinline__ void operator()(int row, int col, const f32x4& a, const f32x4&, int) const { *(f32x4*)(L + (size_t)row * 256 + col) = (f32x4){a[0], a[1], a[2], a[3]}; } };
struct EpiSwiglu { bf16_t* O; int ldo;
    __device__ __forceinline__ void operator()(int row, int col, const f32x4& a, const f32x4& b, int) const {
        u32x2 w; w.x = pk2(siluf(a[0]) * b[0], siluf(a[1]) * b[1]); w.y = pk2(siluf(a[2]) * b[2], siluf(a[3]) * b[3]); *(u32x2*)(O + (size_t)row * ldo + col) = w; } };

__device__ __forceinline__ void ph_route(const Ctx& c, const Params& p) {
    const float* L = (const float*)(c.ws + WS_LOGITS);
    int* eidx = (int*)(c.ws + WS_EIDX); float* gw = (float*)(c.ws + WS_GATEW); unsigned* counts = (unsigned*)(c.ws + WS_CTL) + CW_COUNTS;
    const int l = c.lane; const float NEG = -__builtin_inff();
    float rb[4];
#pragma unroll
    for (int r = 0; r < 4; ++r) rb[r] = p.in[I_RB][l + 64 * r];
    for (int t = c.gwave; t < T; t += c.gwaves) {
        float s[4], sb[4];
#pragma unroll
        for (int r = 0; r < 4; ++r) { s[r] = sigmoidf(L[(size_t)t * 256 + l + 64 * r]); sb[r] = s[r] + rb[r]; }
        float gs[4];
#pragma unroll
        for (int r = 0; r < 4; ++r) {
            float m1 = sb[r]; int i1 = l;
#pragma unroll
            for (int o = 1; o < 32; o <<= 1) { const float om = __shfl_xor(m1, o); const int oi = __shfl_xor(i1, o); if (om > m1 || (om == m1 && oi < i1)) { m1 = om; i1 = oi; } }
            float m2 = (l == i1) ? NEG : sb[r];
#pragma unroll
            for (int o = 1; o < 32; o <<= 1) m2 = fmaxf(m2, __shfl_xor(m2, o));
            gs[r] = m1 + m2;
        }
        float gsc[8];
#pragma unroll
        for (int r = 0; r < 4; ++r) { gsc[2 * r] = __shfl(gs[r], 0); gsc[2 * r + 1] = __shfl(gs[r], 32); }
        unsigned gmask = 0;
#pragma unroll
        for (int a = 0; a < 8; ++a) { int rank = 0;
#pragma unroll
            for (int b2 = 0; b2 < 8; ++b2) rank += (gsc[b2] > gsc[a] || (gsc[b2] == gsc[a] && b2 < a)) ? 1 : 0;
            if (rank < TOPG) gmask |= 1u << a; }
        float mv[4];
#pragma unroll
        for (int r = 0; r < 4; ++r) mv[r] = ((gmask >> (2 * r + (l >> 5))) & 1u) ? sb[r] : NEG;
        float wsel = 0.f; int esel = -1; float wsum = 0.f;
#pragma unroll
        for (int k = 0; k < TOPK; ++k) {
            float bm = mv[0]; int bi = l;
#pragma unroll
            for (int r = 1; r < 4; ++r) if (mv[r] > bm) { bm = mv[r]; bi = l + 64 * r; }
#pragma unroll
            for (int o = 1; o < 64; o <<= 1) { const float om = __shfl_xor(bm, o); const int oi = __shfl_xor(bi, o); if (om > bm || (om == bm && oi < bi)) { bm = om; bi = oi; } }
            float sv = 0.f;
#pragma unroll
            for (int r = 0; r < 4; ++r) if (bi == l + 64 * r) { sv = s[r]; mv[r] = NEG; }
            sv = __shfl(sv, bi & 63);
            wsum += sv;
            if (l == k) { wsel = sv; esel = bi; }
        }
        if (l < TOPK) { eidx[t * 8 + l] = esel; gw[t * 8 + l] = wsel / wsum * ROUTED_SCALE; atomicAdd(counts + esel, 1u); }
    }
}
__device__ __forceinline__ void ph_slot(const Ctx& c, const Params& p) {
    const unsigned* counts = (const unsigned*)(c.ws + WS_CTL) + CW_COUNTS; unsigned* cursor = (unsigned*)(c.ws + WS_CTL) + CW_CURSOR;
    int* ps = (int*)c.lds;
    if (c.tid == 0) { int acc = 0; for (int e = 0; e < NE; ++e) { ps[e] = acc; acc += ((int)counts[e] + 255) / 256 * 256; } ps[NE] = acc; }
    __syncthreads();
    const int* eidx = (const int*)(c.ws + WS_EIDX); const float* gw = (const float*)(c.ws + WS_GATEW);
    int* stok = (int*)(c.ws + WS_SLOT_TOK); int* sasg = (int*)(c.ws + WS_SLOT_ASG); float* sgate = (float*)(c.ws + WS_SLOT_GATE);
    for (int a = c.gtid; a < T * TOPK; a += c.gthreads) {
        const int e = eidx[a]; const unsigned pos = atomicAdd(cursor + e, 1u); const int slot = ps[e] + (int)pos;
        stok[slot] = a >> 3; sasg[slot] = a; sgate[slot] = gw[a];
    }
    if (c.bid == 0) {
        int* te = (int*)(c.ws + WS_TILE_E); int* padst = (int*)(c.ws + WS_PADST);
        for (int e = c.tid; e <= NE; e += 512) padst[e] = ps[e];
        for (int e = c.tid; e < NE; e += 512) for (int tl = ps[e] / 256; tl < ps[e + 1] / 256; ++tl) te[tl] = e;
        if (c.tid == 0) ((unsigned*)(c.ws + WS_CTL))[CW_NTILES] = (unsigned)(ps[NE] / 256);
    }
}
struct EpiE2 { const int* sasg; const float* sgate; bf16_t* YA;
    __device__ __forceinline__ void operator()(int row, int col, const f32x4& a, const f32x4&, int) const {
        const int asg = sasg[row]; if (asg < 0) return; const float g = sgate[row];
        u32x2 w; w.x = pk2(g * a[0], g * a[1]); w.y = pk2(g * a[2], g * a[3]); *(u32x2*)(YA + (size_t)asg * DM + col) = w; } };
struct EpiSD { const float* mod; float* out;
    __device__ __forceinline__ void operator()(int row, int col, const f32x4& a, const f32x4&, int) const {
        const int b = row / SEQ; const f32x4 g2 = *(const f32x4*)(mod + b * 6 * DM + 5 * DM + col); f32x4* o = (f32x4*)(out + (size_t)row * DM + col);
        f32x4 v = *o; v.x += g2.x * a[0]; v.y += g2.y * a[1]; v.z += g2.z * a[2]; v.w += g2.w * a[3]; *o = v; } };
__device__ __forceinline__ void ph_combine(const Ctx& c, const Params& p) {
    const float* mod = (const float*)(c.ws + WS_MOD); const bf16_t* YA = (const bf16_t*)(c.ws + WS_YA); float* out = p.out;
    for (int idx = c.gtid; idx < T * (DM / 8); idx += c.gthreads) {
        const int t = idx >> 7, col = (idx & 127) * 8, b = t / SEQ;
        float s[8] = {0.f, 0.f, 0.f, 0.f, 0.f, 0.f, 0.f, 0.f};
#pragma unroll
        for (int k = 0; k < 8; ++k) { const u32x4 w = *(const u32x4*)(YA + ((size_t)t * 8 + k) * DM + col); const unsigned* wp = (const unsigned*)&w;
#pragma unroll
            for (int i = 0; i < 4; ++i) { s[2 * i] += __uint_as_float(wp[i] << 16); s[2 * i + 1] += __uint_as_float(wp[i] & 0xffff0000u); } }
        const float* g2 = mod + b * 6 * DM + 5 * DM + col; float* o = out + (size_t)t * DM + col;
        f32x4 o0 = *(f32x4*)o, o1 = *(f32x4*)(o + 4);
        o0.x += g2[0] * s[0]; o0.y += g2[1] * s[1]; o0.z += g2[2] * s[2]; o0.w += g2[3] * s[3];
        o1.x += g2[4] * s[4]; o1.y += g2[5] * s[5]; o1.z += g2[6] * s[6]; o1.w += g2[7] * s[7];
        *(f32x4*)o = o0; *(f32x4*)(o + 4) = o1;
    }
}

#ifndef PHASE_MASK
#define PHASE_MASK 0xFFFFFFFFu
#endif
enum { PH_PRO = 0, PH_H1, PH_WIN, PH_QKN, PH_ATT, PH_ATTC, PH_SSM, PH_GLU, PH_NORM, PH_WOUT, PH_H2, PH_RS, PH_RS2, PH_SD, PH_ROUTE, PH_SLOT, PH_E1, PH_E2, PH_COMB, PH_COUNT };
constexpr int NTHREADS = 512;
constexpr int LDS_BYTES = 147456;

template <unsigned PHASE_MASK_T>
__global__ void __launch_bounds__(NTHREADS, 2) mega(Params p) {
    extern __shared__ __attribute__((aligned(16))) unsigned char lds_raw[];
    Ctx c; c.tid = threadIdx.x; c.lane = c.tid & 63; c.wave = c.tid >> 6; c.bid = blockIdx.x; c.nb = gridDim.x;
    c.gtid = c.bid * NTHREADS + c.tid; c.gthreads = c.nb * NTHREADS; c.gwave = c.bid * (NTHREADS / 64) + c.wave; c.gwaves = c.nb * (NTHREADS / 64);
    c.ws = p.ws; c.lds = (float*)lds_raw;
    unsigned char* ws = p.ws;
#define IN(k) (p.ph_lo <= (k) && (k) < p.ph_hi)
    {
        {
        if constexpr (((PHASE_MASK_T) >> PH_PRO) & 1) if (IN(PH_PRO)) ph_prologue(c, p);
        if constexpr (((PHASE_MASK_T) >> PH_H1) & 1) if (IN(PH_H1)) ph_h1(c, p);
        if constexpr (((PHASE_MASK_T) >> PH_WIN) & 1) if (IN(PH_WIN)) { SG_Args g{(const bf16_t*)(ws + WS_H), DM, nullptr, p.in[I_WIN], nullptr, 2048, 0, nullptr, T, 2048, DM};
            EpiWin E{(bf16_t*)(ws + WS_QK), (bf16_t*)(ws + WS_V), (bf16_t*)(ws + WS_AP)}; sgemm_phase<false>(c, g, E); }
        if constexpr (((PHASE_MASK_T) >> PH_QKN) & 1) if (IN(PH_QKN)) ph_qkn(c, p);
        if constexpr (((PHASE_MASK_T) >> PH_ATT) & 1) if (IN(PH_ATT)) ph_att_base(c, p);
        if constexpr (((PHASE_MASK_T) >> PH_ATTC) & 1) if (IN(PH_ATTC)) ph_att_comb(c, p);
        if constexpr (((PHASE_MASK_T) >> PH_SSM) & 1) if (IN(PH_SSM)) ph_ssm_base(c, p);
        if constexpr (((PHASE_MASK_T) >> PH_GLU) & 1) if (IN(PH_GLU)) { SG_Args g{(const bf16_t*)(ws + WS_Y), 512, nullptr, p.in[I_WGLU], nullptr, 512, 0, nullptr, T, 512, 512};
            EpiGlu E{(const bf16_t*)(ws + WS_Y), (bf16_t*)(ws + WS_MIXIN), (float*)(ws + WS_CTL + CTL_SS1)}; sgemm_phase<false>(c, g, E); }
        if constexpr (((PHASE_MASK_T) >> PH_NORM) & 1) if (IN(PH_NORM)) ph_ssm_norm(c, p);
        if constexpr (((PHASE_MASK_T) >> PH_WOUT) & 1) if (IN(PH_WOUT)) { SG_Args g{(const bf16_t*)(ws + WS_MIXIN), DM, nullptr, p.in[I_WOUT], nullptr, DM, 0, nullptr, T, DM, DM};
            EpiWout E{p.in[I_X], (const float*)(ws + WS_MOD), p.out, (float*)(ws + WS_CTL + CTL_SS2)}; sgemm_phase<false>(c, g, E); }
        if constexpr (((PHASE_MASK_T) >> PH_H2) & 1) if (IN(PH_H2)) ph_h2(c, p);
        if constexpr (((PHASE_MASK_T) >> PH_RS) & 1) if (IN(PH_RS)) { SG_Args g{(const bf16_t*)(ws + WS_H), DM, nullptr, p.in[I_WR], nullptr, 256, 0, nullptr, T, 256, DM};
            EpiLogits E{(float*)(ws + WS_LOGITS)}; sgemm_phase<false>(c, g, E); }
        if constexpr (((PHASE_MASK_T) >> PH_RS2) & 1) if (IN(PH_RS2)) { SG_Args g2{(const bf16_t*)(ws + WS_H), DM, nullptr, p.in[I_WGS], p.in[I_WUS], 256, 0, nullptr, T, 256, DM};
            EpiSwiglu E2{(bf16_t*)(ws + WS_ACTS), 256}; sgemm_phase<true>(c, g2, E2); }
        if constexpr (((PHASE_MASK_T) >> PH_SD) & 1) if (IN(PH_SD)) { SG_Args g{(const bf16_t*)(ws + WS_ACTS), 256, nullptr, p.in[I_WDS], nullptr, DM, 0, nullptr, T, DM, ED};
            EpiSD E{(const float*)(ws + WS_MOD), p.out}; sgemm_phase<false>(c, g, E); }
        if constexpr (((PHASE_MASK_T) >> PH_ROUTE) & 1) if (IN(PH_ROUTE)) ph_route(c, p);
        if constexpr (((PHASE_MASK_T) >> PH_SLOT) & 1) if (IN(PH_SLOT)) ph_slot(c, p);
        if constexpr (((PHASE_MASK_T) >> PH_E1) & 1) if (IN(PH_E1)) { SG_Args g{(const bf16_t*)(ws + WS_H), DM, (const int*)(ws + WS_SLOT_TOK), p.in[I_WGE], p.in[I_WUE], 256, (size_t)DM * ED, (const int*)(ws + WS_TILE_E), NS_MAX, ED, DM};
            EpiSwiglu E{(bf16_t*)(ws + WS_ACTE), 256}; sgemm_phase<true>(c, g, E); }
        if constexpr (((PHASE_MASK_T) >> PH_E2) & 1) if (IN(PH_E2)) { SG_Args g{(const bf16_t*)(ws + WS_ACTE), 256, nullptr, p.in[I_WDE], nullptr, DM, (size_t)ED * DM, (const int*)(ws + WS_TILE_E), NS_MAX, DM, ED};
            EpiE2 E{(const int*)(ws + WS_SLOT_ASG), (const float*)(ws + WS_SLOT_GATE), (bf16_t*)(ws + WS_YA)}; sgemm_phase<false>(c, g, E); }
        if constexpr (((PHASE_MASK_T) >> PH_COMB) & 1) if (IN(PH_COMB)) ph_combine(c, p);
        }
    }
}

template <int PH> static void launch_all(int grid, Params a, hipStream_t stream) {
    if constexpr (PH < PH_COUNT) {
        a.ph_lo = PH; a.ph_hi = PH + 1;
        hipLaunchKernelGGL((mega<(1u << PH)>), dim3(grid), dim3(NTHREADS), LDS_BYTES, stream, a);
        launch_all<PH + 1>(grid, a, stream);
    }
}
template <int PH> static bool set_attr_all() {
    if constexpr (PH < PH_COUNT) {
        if (hipFuncSetAttribute((const void*)mega<(1u << PH)>, hipFuncAttributeMaxDynamicSharedMemorySize, LDS_BYTES) != hipSuccess) return false;
        return set_attr_all<PH + 1>();
    } else return true;
}
extern "C" void kernel_launch(void* const* d_in, const int* in_sizes, int n_in, void* d_out, int out_size, void* d_ws, size_t ws_size, hipStream_t stream) {
    static int grid = 0;
    if (grid == 0) {
        if (n_in != 33 || out_size != T * DM || ws_size < WS_NEED) { fprintf(stderr, "kernel_launch: unexpected shapes (n_in %d out %d ws %zu)\n", n_in, out_size, ws_size); grid = -1; return; }
        int dev = 0, cus = 0;
        if (hipGetDevice(&dev) != hipSuccess || hipDeviceGetAttribute(&cus, hipDeviceAttributeMultiprocessorCount, dev) != hipSuccess) { grid = -1; return; }
        if (!set_attr_all<0>()) { grid = -1; return; }
        grid = cus;
    }
    if (grid < 0) return;
    (void)hipMemsetAsync((char*)d_ws + WS_CTL, 0, CTL_BYTES, stream);
    Params a{};
    for (int i = 0; i < 33; ++i) a.in[i] = (const float*)d_in[i];
    a.out = (float*)d_out; a.ws = (unsigned char*)d_ws;
    launch_all<0>(grid, a, stream);
}
```

```cpp
#include <hip/hip_runtime.h>
#include <cstdio>
#include <cstdint>

typedef unsigned short bf16_t;
typedef float f32x4 __attribute__((ext_vector_type(4)));
typedef unsigned u32x4 __attribute__((ext_vector_type(4)));
typedef unsigned u32x2 __attribute__((ext_vector_type(2)));

constexpr int DM = 1024, NB = 8, SEQ = 4096, T = NB * SEQ;
constexpr int NH = 4, HD = 64, VD = 128, QKW = 512, ATTW = 512, SSMW = 512;
constexpr int SG = 32, SC = 16, SP = 64;
constexpr int LC = 16;
constexpr int NCHUNK = SEQ / LC;
constexpr int APK = 384;
constexpr int NE = 256, TOPK = 8, NGRP = 8, TOPG = 4, ED = 256;
constexpr int NS_MAX = 327680;
constexpr float EPS = 1e-6f;
constexpr float LAM_INIT = 0.2f;
constexpr float ROUTED_SCALE = 2.5f;

constexpr size_t MiB = 1u << 20;
constexpr size_t WS_CTL = 0, CTL_BYTES = 1 * MiB;
constexpr int CW_COUNTS = 1024;
constexpr int CW_CURSOR = 1024 + 256;
constexpr int CW_NTILES = 2048;
constexpr int CW_BAR = 4096;
constexpr size_t CTL_SS1 = 256 * 1024;
constexpr size_t CTL_SS2 = 384 * 1024;
constexpr size_t WS_MOD = 1 * MiB;
constexpr size_t WS_LAM = 1 * MiB + 256 * 1024;
constexpr size_t WS_ROPE = 1 * MiB + 512 * 1024;
constexpr size_t WS_SSMP = 2 * MiB + 512 * 1024;
constexpr size_t WS_EIDX = 4 * MiB;
constexpr size_t WS_GATEW = 5 * MiB;
constexpr size_t WS_SLOT_TOK = 6 * MiB;
constexpr size_t WS_SLOT_ASG = 7 * MiB + 512 * 1024;
constexpr size_t WS_SLOT_GATE = 9 * MiB;
constexpr size_t WS_TILE_E = 10 * MiB + 512 * 1024;
constexpr size_t WS_PADST = 10 * MiB + 768 * 1024;
constexpr size_t WS_WIN_T = 12 * MiB;
constexpr size_t WS_WOUT_T = 16 * MiB;
constexpr size_t WS_WGLU_T = 18 * MiB;
constexpr size_t WS_WRS_T = 19 * MiB;
constexpr size_t WS_WDS_T = 21 * MiB;
constexpr size_t WS_WGU = 32 * MiB;
constexpr size_t WS_WD = 704 * MiB;
constexpr size_t WS_YA = 32 * MiB;
constexpr size_t WS_H = 288 * MiB;
constexpr size_t WS_QK = 352 * MiB;
constexpr size_t WS_Y = 352 * MiB;
constexpr size_t WS_V = 416 * MiB;
constexpr size_t WS_AP = 448 * MiB;
constexpr size_t WS_ACTE = 544 * MiB;
constexpr size_t WS_MIXIN = 544 * MiB;
constexpr size_t WS_LOGITS = 608 * MiB;
constexpr size_t WS_ACTS = 640 * MiB;
constexpr size_t WS_ATTO = 832 * MiB;
constexpr size_t WS_NEED = 1024 * MiB;

__device__ __forceinline__ float bf2f(bf16_t v) { return __uint_as_float((unsigned)v << 16); }
__device__ __forceinline__ bf16_t f2bf(float f) { unsigned u = __float_as_uint(f); return (bf16_t)((u + 0x7fffu + ((u >> 16) & 1u)) >> 16); }
__device__ __forceinline__ unsigned pk2(float lo, float hi) { return (unsigned)f2bf(lo) | ((unsigned)f2bf(hi) << 16); }
__device__ __forceinline__ float wave_sum(float v) {
#pragma unroll
    for (int o = 1; o < 64; o <<= 1) v += __shfl_xor(v, o);
    return v;
}
__device__ __forceinline__ float siluf(float v) { return v / (1.f + __expf(-v)); }
__device__ __forceinline__ float sigmoidf(float v) { return 1.f / (1.f + __expf(-v)); }
__device__ __forceinline__ float gelu_tanh(float v) { const float u = 0.7978845608028654f * (v + 0.044715f * v * v * v); return 0.5f * v * (1.f + tanhf(u)); }

struct Params {
    const float* in[33];
    float* out;
    unsigned char* ws;
    int pad0, pad1;
};

struct Ctx {
    int tid, lane, wave, bid, nb;
    int gtid, gthreads, gwave, gwaves;
    unsigned char* ws;
    float* lds;
};

enum { I_X = 0, I_C, I_N1G, I_N2G, I_WADA, I_BADA, I_WIN, I_QNG, I_KNG, I_LQ1, I_LK1, I_LQ2, I_LK2, I_SUBG,
       I_ARE, I_AIM, I_LOGDT, I_BRE, I_BIM, I_CRE, I_CIM, I_SD, I_WGLU, I_SNG, I_WOUT, I_WR, I_RB,
       I_WGE, I_WUE, I_WDE, I_WGS, I_WUS, I_WDS };

struct SG_Args {
    const bf16_t* A; int lda; const int* rowidx;
    const float* W; const float* W2; int ldb;
    size_t wstride;
    const int* tile_e;
    int M, N, K;
};
template <bool DUAL, class Epi>
__device__ __forceinline__ void sgemm_phase(const Ctx& c, const SG_Args g, const Epi& E) {
    float* As = c.lds;
    float* Bs = c.lds + 16 * 132;
    float* Bs2 = Bs + 16 * 128;
    const int tid = c.tid, ty = tid >> 5, tx = tid & 31;
    const int nMt = g.M / 128, nNt = g.N / 128, ntile = nMt * nNt;
    for (int tile = c.bid; tile < ntile; tile += c.nb) {
        const int mt = tile / nNt, nt = tile % nNt;
        const float* W = g.W; const float* W2 = g.W2;
        if (g.tile_e) { const int e = g.tile_e[mt >> 1]; if (e < 0) continue; W += (size_t)e * g.wstride; if (DUAL) W2 += (size_t)e * g.wstride; }
        f32x4 acc[8], acc2[8];
#pragma unroll
        for (int i = 0; i < 8; ++i) { acc[i] = (f32x4){0.f, 0.f, 0.f, 0.f}; acc2[i] = (f32x4){0.f, 0.f, 0.f, 0.f}; }
        const int arow = mt * 128 + (tid >> 2), akq = (tid & 3) * 4;
        const int asrc = g.rowidx ? g.rowidx[arow] : arow;
        const bf16_t* ap = g.A + (size_t)asrc * g.lda + akq;
        const int bk = tid >> 5, bn = (tid & 31) * 4;
        const float* bp = W + (size_t)bk * g.ldb + nt * 128 + bn;
        const float* bp2 = DUAL ? (W2 + (size_t)bk * g.ldb + nt * 128 + bn) : nullptr;
#pragma unroll 1
        for (int k0 = 0; k0 < g.K; k0 += 16) {
            const u32x2 av = *(const u32x2*)(ap + k0);
            const f32x4 bv = *(const f32x4*)(bp + (size_t)k0 * g.ldb);
            f32x4 bv2 = {0.f, 0.f, 0.f, 0.f};
            if (DUAL) bv2 = *(const f32x4*)(bp2 + (size_t)k0 * g.ldb);
            __syncthreads();
            As[(akq + 0) * 132 + (tid >> 2)] = __uint_as_float(av.x << 16);
            As[(akq + 1) * 132 + (tid >> 2)] = __uint_as_float(av.x & 0xffff0000u);
            As[(akq + 2) * 132 + (tid >> 2)] = __uint_as_float(av.y << 16);
            As[(akq + 3) * 132 + (tid >> 2)] = __uint_as_float(av.y & 0xffff0000u);
            *(f32x4*)(Bs + bk * 128 + bn) = bv;
            if (DUAL) *(f32x4*)(Bs2 + bk * 128 + bn) = bv2;
            __syncthreads();
#pragma unroll
            for (int kk = 0; kk < 16; ++kk) {
                const f32x4 a0 = *(const f32x4*)(As + kk * 132 + ty * 8), a1 = *(const f32x4*)(As + kk * 132 + ty * 8 + 4);
                const f32x4 b = *(const f32x4*)(Bs + kk * 128 + tx * 4);
                const float a[8] = {a0.x, a0.y, a0.z, a0.w, a1.x, a1.y, a1.z, a1.w};
#pragma unroll
                for (int i = 0; i < 8; ++i) acc[i] += a[i] * b;
                if (DUAL) {
                    const f32x4 b2 = *(const f32x4*)(Bs2 + kk * 128 + tx * 4);
#pragma unroll
                    for (int i = 0; i < 8; ++i) acc2[i] += a[i] * b2;
                }
            }
        }
#pragma unroll
        for (int i = 0; i < 8; ++i) E(mt * 128 + ty * 8 + i, nt * 128 + tx * 4, acc[i], acc2[i], tx);
    }
}

__device__ __forceinline__ void ph_prologue(const Ctx& c, const Params& p) {
    float* mod = (float*)(c.ws + WS_MOD);
    for (int idx = c.gtid; idx < NB * 6 * DM; idx += c.gthreads) {
        const int b = idx / (6 * DM), j = idx % (6 * DM);
        const float* cc = p.in[I_C] + b * DM; const float* w = p.in[I_WADA] + j;
        float acc = p.in[I_BADA][j];
#pragma unroll 8
        for (int k = 0; k < DM; ++k) acc += siluf(cc[k]) * w[(size_t)k * (6 * DM)];
        mod[idx] = acc;
    }
    float* ropec = (float*)(c.ws + WS_ROPE); float* ropes = ropec + SEQ * 32;
    for (int idx = c.gtid; idx < SEQ * 32; idx += c.gthreads) {
        const int l = idx >> 5, i = idx & 31;
        const double invf = exp(-log(10000.0) * (double)(2 * i) / 64.0);
        const double ang = (double)l * invf;
        ropec[idx] = (float)cos(ang); ropes[idx] = (float)sin(ang);
    }
    float* sp = (float*)(c.ws + WS_SSMP);
    float* abr = sp, * abi = sp + SG * SP, * bbr = sp + 2 * SG * SP, * bbi = bbr + SG * SP * SC;
    for (int idx = c.gtid; idx < SG * SP; idx += c.gthreads) {
        const int g = idx / SP;
        const double are = p.in[I_ARE][idx], aim = p.in[I_AIM][idx], dt = exp((double)p.in[I_LOGDT][g]);
        const double mag = exp(are * dt), ar = mag * cos(aim * dt), ai = mag * sin(aim * dt);
        abr[idx] = (float)ar; abi[idx] = (float)ai;
        const double den = are * are + aim * aim, nr = ar - 1.0;
        const double fre = (nr * are + ai * aim) / den, fim = (ai * are - nr * aim) / den;
        for (int ch = 0; ch < SC; ++ch) {
            const double br = p.in[I_BRE][idx * SC + ch], bi = p.in[I_BIM][idx * SC + ch];
            bbr[idx * SC + ch] = (float)(fre * br - fim * bi); bbi[idx * SC + ch] = (float)(fre * bi + fim * br);
        }
    }
    if (c.gtid == 0) {
        float s1 = 0.f, s2 = 0.f, gq = 0.f, gk = 0.f;
        for (int i = 0; i < HD; ++i) { s1 += p.in[I_LQ1][i] * p.in[I_LK1][i]; s2 += p.in[I_LQ2][i] * p.in[I_LK2][i];
            gq = fmaxf(gq, fabsf(p.in[I_QNG][i])); gk = fmaxf(gk, fabsf(p.in[I_KNG][i])); }
        float* lam = (float*)(c.ws + WS_LAM);
        lam[0] = __expf(s1) - __expf(s2) + LAM_INIT;
        lam[1] = 0.125f * 64.f * gq * gk;
    }
    int* stok = (int*)(c.ws + WS_SLOT_TOK); int* sasg = (int*)(c.ws + WS_SLOT_ASG); float* sgate = (float*)(c.ws + WS_SLOT_GATE);
    for (int idx = c.gtid; idx < NS_MAX; idx += c.gthreads) { stok[idx] = 0; sasg[idx] = -1; sgate[idx] = 0.f; }
    int* te = (int*)(c.ws + WS_TILE_E);
    for (int idx = c.gtid; idx < NS_MAX / 256; idx += c.gthreads) te[idx] = -1;
}

__device__ __forceinline__ void ph_h1(const Ctx& c, const Params& p) {
    const float* mod = (const float*)(c.ws + WS_MOD); bf16_t* H = (bf16_t*)(c.ws + WS_H);
    for (int t = c.gwave; t < T; t += c.gwaves) {
        const int b = t / SEQ; const f32x4* xr = (const f32x4*)(p.in[I_X] + (size_t)t * DM) + c.lane;
        f32x4 v[4]; float s = 0.f;
#pragma unroll
        for (int j = 0; j < 4; ++j) { v[j] = xr[64 * j]; s += v[j].x * v[j].x + v[j].y * v[j].y + v[j].z * v[j].z + v[j].w * v[j].w; }
        const float rstd = rsqrtf(wave_sum(s) * (1.f / DM) + EPS);
        const float* sh = mod + b * 6 * DM, * sc = sh + DM;
#pragma unroll
        for (int j = 0; j < 4; ++j) { const int col = 4 * c.lane + 256 * j;
            const f32x4 g = *(const f32x4*)(p.in[I_N1G] + col), s1 = *(const f32x4*)(sc + col), h1 = *(const f32x4*)(sh + col);
            const f32x4 o = (v[j] * rstd * g) * (1.f + s1) + h1;
            u32x2 w; w.x = pk2(o.x, o.y); w.y = pk2(o.z, o.w); *(u32x2*)(H + (size_t)t * DM + col) = w; }
    }
}

struct EpiWin {
    bf16_t* QK; bf16_t* V; bf16_t* AP;
    __device__ __forceinline__ void operator()(int row, int col, const f32x4& a, const f32x4&, int) const {
        u32x2 w; w.x = pk2(a[0], a[1]); w.y = pk2(a[2], a[3]);
        if (col < 1024) *(u32x2*)(QK + (size_t)row * 1024 + col) = w;
        else if (col < 1536) *(u32x2*)(V + (size_t)row * 512 + (col - 1024)) = w;
        else { const int cc = col - 1536, g = cc >> 4, ch = cc & 15, b = row / SEQ, l = row % SEQ;
            *(u32x2*)(AP + ((size_t)(g * (NB * NCHUNK) + b * NCHUNK + (l >> 4)) * APK + (l & 15) * 16 + ch)) = w; }
    }
};

__device__ __forceinline__ void ph_qkn(const Ctx& c, const Params& p) {
    bf16_t* QK = (bf16_t*)(c.ws + WS_QK);
    const float* ropec = (const float*)(c.ws + WS_ROPE); const float* ropes = ropec + SEQ * 32;
    const int l = c.lane;
    const float gq = p.in[I_QNG][l], gk = p.in[I_KNG][l];
    for (int t = c.gwave; t < T; t += c.gwaves) {
        const int pos = t % SEQ; const float cs = ropec[pos * 32 + (l & 31)], sn = ropes[pos * 32 + (l & 31)];
        bf16_t* r = QK + (size_t)t * 1024;
#pragma unroll 4
        for (int gi = 0; gi < 16; ++gi) {
            const float v = bf2f(r[gi * 64 + l]);
            const float rstd = rsqrtf(wave_sum(v * v) * (1.f / 64.f) + EPS);
            const float y = v * rstd * (gi < 8 ? gq : gk);
            const float o = __shfl_xor(y, 32);
            const float res = (l < 32) ? (y * cs - o * sn) : (o * sn + y * cs);
            r[gi * 64 + l] = f2bf(res);
        }
    }
}

__device__ __forceinline__ void ph_att_base(const Ctx& c, const Params& p) {
    const bf16_t* QK = (const bf16_t*)(c.ws + WS_QK); const bf16_t* V = (const bf16_t*)(c.ws + WS_V); float* AO = (float*)(c.ws + WS_ATTO);
    const float smax = ((const float*)(c.ws + WS_LAM))[1];
    const int nitem = NB * NH * 4 * (SEQ / 64);
    for (int it = c.gwave; it < nitem; it += c.gwaves) {
        const int qb = (SEQ / 64 - 1) - (it / (NB * NH * 4)), bhc = it % (NB * NH * 4), b = bhc / (NH * 4), h = (bhc >> 2) % NH, cc = (bhc >> 1) & 1, vh = bhc & 1;
        const int q = qb * 64 + c.lane; const size_t trow = (size_t)b * SEQ + q;
        float qv[64];
        { const bf16_t* qp = QK + trow * 1024 + h * 128 + cc * 64;
#pragma unroll
          for (int d = 0; d < 64; ++d) qv[d] = bf2f(qp[d]) * 0.125f; }
        float o[64];
#pragma unroll
        for (int d = 0; d < 64; ++d) o[d] = 0.f;
        float lsum = 0.f;
        const int jmax = qb * 64 + 63;
        for (int j = 0; j <= jmax; ++j) {
            const size_t krow = (size_t)b * SEQ + j;
            const u32x4* kp = (const u32x4*)(QK + krow * 1024 + 512 + h * 128 + cc * 64);
            float s = 0.f;
#pragma unroll
            for (int i = 0; i < 8; ++i) { const u32x4 kk = kp[i];
                s += qv[8 * i + 0] * __uint_as_float(kk.x << 16) + qv[8 * i + 1] * __uint_as_float(kk.x & 0xffff0000u)
                   + qv[8 * i + 2] * __uint_as_float(kk.y << 16) + qv[8 * i + 3] * __uint_as_float(kk.y & 0xffff0000u)
                   + qv[8 * i + 4] * __uint_as_float(kk.z << 16) + qv[8 * i + 5] * __uint_as_float(kk.z & 0xffff0000u)
                   + qv[8 * i + 6] * __uint_as_float(kk.w << 16) + qv[8 * i + 7] * __uint_as_float(kk.w & 0xffff0000u); }
            float pe = (j <= q) ? __expf(s - smax) : 0.f;
            lsum += pe;
            const u32x4* vp = (const u32x4*)(V + krow * 512 + h * 128 + vh * 64);
#pragma unroll
            for (int i = 0; i < 8; ++i) { const u32x4 vv = vp[i];
                o[8 * i + 0] += pe * __uint_as_float(vv.x << 16); o[8 * i + 1] += pe * __uint_as_float(vv.x & 0xffff0000u);
                o[8 * i + 2] += pe * __uint_as_float(vv.y << 16); o[8 * i + 3] += pe * __uint_as_float(vv.y & 0xffff0000u);
                o[8 * i + 4] += pe * __uint_as_float(vv.z << 16); o[8 * i + 5] += pe * __uint_as_float(vv.z & 0xffff0000u);
                o[8 * i + 6] += pe * __uint_as_float(vv.w << 16); o[8 * i + 7] += pe * __uint_as_float(vv.w & 0xffff0000u); }
        }
        const float rl = 1.f / lsum;
        float* op = AO + (trow * 8 + h * 2 + cc) * 128 + vh * 64;
#pragma unroll
        for (int d = 0; d < 64; d += 4) *(f32x4*)(op + d) = (f32x4){o[d] * rl, o[d + 1] * rl, o[d + 2] * rl, o[d + 3] * rl};
    }
}
__device__ __forceinline__ void ph_att_comb(const Ctx& c, const Params& p) {
    const float* AO = (const float*)(c.ws + WS_ATTO); bf16_t* MX = (bf16_t*)(c.ws + WS_MIXIN);
    const float lam = ((const float*)(c.ws + WS_LAM))[0];
    for (int it = c.gwave; it < T * NH; it += c.gwaves) {
        const int t = it >> 2, h = it & 3;
        const float* o1 = AO + ((size_t)t * 8 + h * 2) * 128, * o2 = o1 + 128;
        const float a = o1[c.lane] - lam * o2[c.lane], b = o1[64 + c.lane] - lam * o2[64 + c.lane];
        const float rstd = rsqrtf(wave_sum(a * a + b * b) * (1.f / 128.f) + EPS) * (1.f - LAM_INIT);
        MX[(size_t)t * 1024 + h * 128 + c.lane] = f2bf(a * rstd * p.in[I_SUBG][c.lane]);
        MX[(size_t)t * 1024 + h * 128 + 64 + c.lane] = f2bf(b * rstd * p.in[I_SUBG][64 + c.lane]);
    }
}

__device__ __forceinline__ void ph_ssm_base(const Ctx& c, const Params& p) {
    const bf16_t* AP = (const bf16_t*)(c.ws + WS_AP); bf16_t* Y = (bf16_t*)(c.ws + WS_Y);
    const float* sp = (const float*)(c.ws + WS_SSMP);
    const float* abr = sp, * abi = sp + SG * SP, * bbr = sp + 2 * SG * SP, * bbi = bbr + SG * SP * SC;
    for (int it = c.gwave; it < NB * SG; it += c.gwaves) {
        const int b = it / SG, g = it % SG, pp = c.lane;
        const float ar = abr[g * SP + pp], ai = abi[g * SP + pp];
        float br[16], bi[16], cr[16], ci[16];
#pragma unroll
        for (int ch = 0; ch < 16; ++ch) { br[ch] = bbr[(g * SP + pp) * SC + ch]; bi[ch] = bbi[(g * SP + pp) * SC + ch];
            cr[ch] = p.in[I_CRE][(g * SC + ch) * SP + pp]; ci[ch] = p.in[I_CIM][(g * SC + ch) * SP + pp]; }
        const float dsk = (pp < 16) ? p.in[I_SD][g * SC + pp] : 0.f;
        float sr = 0.f, si = 0.f;
        for (int l = 0; l < SEQ; ++l) {
            const bf16_t* up = AP + ((size_t)(g * (NB * NCHUNK) + b * NCHUNK + (l >> 4)) * APK + (l & 15) * 16);
            const u32x4 u0 = *(const u32x4*)up, u1 = *(const u32x4*)(up + 8);
            float u[16] = { __uint_as_float(u0.x << 16), __uint_as_float(u0.x & 0xffff0000u), __uint_as_float(u0.y << 16), __uint_as_float(u0.y & 0xffff0000u),
                            __uint_as_float(u0.z << 16), __uint_as_float(u0.z & 0xffff0000u), __uint_as_float(u0.w << 16), __uint_as_float(u0.w & 0xffff0000u),
                            __uint_as_float(u1.x << 16), __uint_as_float(u1.x & 0xffff0000u), __uint_as_float(u1.y << 16), __uint_as_float(u1.y & 0xffff0000u),
                            __uint_as_float(u1.z << 16), __uint_as_float(u1.z & 0xffff0000u), __uint_as_float(u1.w << 16), __uint_as_float(u1.w & 0xffff0000u) };
            float bur = 0.f, bui = 0.f;
#pragma unroll
            for (int ch = 0; ch < 16; ++ch) { bur += u[ch] * br[ch]; bui += u[ch] * bi[ch]; }
            const float nr = ar * sr - ai * si + bur, ni = ar * si + ai * sr + bui; sr = nr; si = ni;
            float mine = 0.f;
#pragma unroll
            for (int ch = 0; ch < 16; ++ch) { const float v = wave_sum(sr * cr[ch] - si * ci[ch]); if (pp == ch) mine = v + dsk * u[ch]; }
            if (pp < 16) Y[((size_t)b * SEQ + l) * 512 + g * 16 + pp] = f2bf(gelu_tanh(mine));
        }
    }
}

struct EpiGlu {
    const bf16_t* Y; bf16_t* MX; float* ss;
    __device__ __forceinline__ void operator()(int row, int col, const f32x4& a, const f32x4&, int) const {
        const u32x2 yv = *(const u32x2*)(Y + (size_t)row * 512 + col);
        const float y0 = __uint_as_float(yv.x << 16), y1 = __uint_as_float(yv.x & 0xffff0000u), y2 = __uint_as_float(yv.y << 16), y3 = __uint_as_float(yv.y & 0xffff0000u);
        const float v0 = y0 * sigmoidf(a[0]), v1 = y1 * sigmoidf(a[1]), v2 = y2 * sigmoidf(a[2]), v3 = y3 * sigmoidf(a[3]);
        u32x2 w; w.x = pk2(v0, v1); w.y = pk2(v2, v3); *(u32x2*)(MX + (size_t)row * 1024 + 512 + col) = w;
        float s = v0 * v0 + v1 * v1 + v2 * v2 + v3 * v3;
#pragma unroll
        for (int o = 1; o < 32; o <<= 1) s += __shfl_xor(s, o);
        if ((threadIdx.x & 31) == 0) atomicAdd(ss + row, s);
    }
};
__device__ __forceinline__ void ph_ssm_norm(const Ctx& c, const Params& p) {
    bf16_t* MX = (bf16_t*)(c.ws + WS_MIXIN); const float* ss = (const float*)(c.ws + WS_CTL + CTL_SS1);
    for (int t = c.gwave; t < T; t += c.gwaves) {
        const float rstd = rsqrtf(ss[t] * (1.f / 512.f) + EPS);
        bf16_t* r = MX + (size_t)t * 1024 + 512 + c.lane * 8; const float* g = p.in[I_SNG] + c.lane * 8;
        u32x4 w = *(u32x4*)r; unsigned* wp = (unsigned*)&w;
#pragma unroll
        for (int i = 0; i < 4; ++i) { const float a = __uint_as_float(wp[i] << 16) * rstd * g[2 * i], b = __uint_as_float(wp[i] & 0xffff0000u) * rstd * g[2 * i + 1]; wp[i] = pk2(a, b); }
        *(u32x4*)r = w;
    }
}
struct EpiWout {
    const float* x; const float* mod; float* out; float* ss;
    __device__ __forceinline__ void operator()(int row, int col, const f32x4& a, const f32x4&, int) const {
        const int b = row / SEQ; const f32x4 xv = *(const f32x4*)(x + (size_t)row * DM + col), g1 = *(const f32x4*)(mod + b * 6 * DM + 2 * DM + col);
        const f32x4 o = {xv.x + g1.x * a[0], xv.y + g1.y * a[1], xv.z + g1.z * a[2], xv.w + g1.w * a[3]};
        *(f32x4*)(out + (size_t)row * DM + col) = o;
        float s = o.x * o.x + o.y * o.y + o.z * o.z + o.w * o.w;
#pragma unroll
        for (int of = 1; of < 32; of <<= 1) s += __shfl_xor(s, of);
        if ((threadIdx.x & 31) == 0) atomicAdd(ss + row, s);
    }
};
__device__ __forceinline__ void ph_h2(const Ctx& c, const Params& p) {
    const float* mod = (const float*)(c.ws + WS_MOD); bf16_t* H = (bf16_t*)(c.ws + WS_H);
    const float* ss = (const float*)(c.ws + WS_CTL + CTL_SS2);
    for (int t = c.gwave; t < T; t += c.gwaves) {
        const int b = t / SEQ; const f32x4* xr = (const f32x4*)(p.out + (size_t)t * DM) + c.lane;
        const float rstd = rsqrtf(ss[t] * (1.f / DM) + EPS);
        const float* sh = mod + b * 6 * DM + 3 * DM, * sc = sh + DM;
#pragma unroll
        for (int j = 0; j < 4; ++j) { const int col = 4 * c.lane + 256 * j; const f32x4 v = xr[64 * j];
            const f32x4 g = *(const f32x4*)(p.in[I_N2G] + col), s1 = *(const f32x4*)(sc + col), h1 = *(const f32x4*)(sh + col);
            const f32x4 o = (v * rstd * g) * (1.f + s1) + h1;
            u32x2 w; w.x = pk2(o.x, o.y); w.y = pk2(o.z, o.w); *(u32x2*)(H + (size_t)t * DM + col) = w; }
    }
}
struct EpiLogits { float* L; __device__ __forceinline__ void operator()(int row, int col, const f32x4& a, const f32x4&, int) const { *(f32x4*)(L + (size_t)row * 256 + col) = (f32x4){a[0], a[1], a[2], a[3]}; } };
struct EpiSwiglu { bf16_t* O; int ldo;
    __device__ __forceinline__ void operator()(int row, int col, const f32x4& a, const f32x4& b, int) const {
        u32x2 w; w.x = pk2(siluf(a[0]) * b[0], siluf(a[1]) * b[1]); w.y = pk2(siluf(a[2]) * b[2], siluf(a[3]) * b[3]); *(u32x2*)(O + (size_t)row * ldo + col) = w; } };

__device__ __forceinline__ void ph_route(const Ctx& c, const Params& p) {
    const float* L = (const float*)(c.ws + WS_LOGITS);
    int* eidx = (int*)(c.ws + WS_EIDX); float* gw = (float*)(c.ws + WS_GATEW); unsigned* counts = (unsigned*)(c.ws + WS_CTL) + CW_COUNTS;
    const int l = c.lane; const float NEG = -__builtin_inff();
    float rb[4];
#pragma unroll
    for (int r = 0; r < 4; ++r) rb[r] = p.in[I_RB][l + 64 * r];
    for (int t = c.gwave; t < T; t += c.gwaves) {
        float s[4], sb[4];
#pragma unroll
        for (int r = 0; r < 4; ++r) { s[r] = sigmoidf(L[(size_t)t * 256 + l + 64 * r]); sb[r] = s[r] + rb[r]; }
        float gs[4];
#pragma unroll
        for (int r = 0; r < 4; ++r) {
            float m1 = sb[r]; int i1 = l;
#pragma unroll
            for (int o = 1; o < 32; o <<= 1) { const float om = __shfl_xor(m1, o); const int oi = __shfl_xor(i1, o); if (om > m1 || (om == m1 && oi < i1)) { m1 = om; i1 = oi; } }
            float m2 = (l == i1) ? NEG : sb[r];
#pragma unroll
            for (int o = 1; o < 32; o <<= 1) m2 = fmaxf(m2, __shfl_xor(m2, o));
            gs[r] = m1 + m2;
        }
        float gsc[8];
#pragma unroll
        for (int r = 0; r < 4; ++r) { gsc[2 * r] = __shfl(gs[r], 0); gsc[2 * r + 1] = __shfl(gs[r], 32); }
        unsigned gmask = 0;
#pragma unroll
        for (int a = 0; a < 8; ++a) { int rank = 0;
#pragma unroll
            for (int b2 = 0; b2 < 8; ++b2) rank += (gsc[b2] > gsc[a] || (gsc[b2] == gsc[a] && b2 < a)) ? 1 : 0;
            if (rank < TOPG) gmask |= 1u << a; }
        float mv[4];
#pragma unroll
        for (int r = 0; r < 4; ++r) mv[r] = ((gmask >> (2 * r + (l >> 5))) & 1u) ? sb[r] : NEG;
        float wsel = 0.f; int esel = -1; float wsum = 0.f;
#pragma unroll
        for (int k = 0; k < TOPK; ++k) {
            float bm = mv[0]; int bi = l;
#pragma unroll
            for (int r = 1; r < 4; ++r) if (mv[r] > bm) { bm = mv[r]; bi = l + 64 * r; }
#pragma unroll
            for (int o = 1; o < 64; o <<= 1) { const float om = __shfl_xor(bm, o); const int oi = __shfl_xor(bi, o); if (om > bm || (om == bm && oi < bi)) { bm = om; bi = oi; } }
            float sv = 0.f;
#pragma unroll
            for (int r = 0; r < 4; ++r) if (bi == l + 64 * r) { sv = s[r]; mv[r] = NEG; }
            sv = __shfl(sv, bi & 63);
            wsum += sv;
            if (l == k) { wsel = sv; esel = bi; }
        }
        if (l < TOPK) { eidx[t * 8 + l] = esel; gw[t * 8 + l] = wsel / wsum * ROUTED_SCALE; atomicAdd(counts + esel, 1u); }
    }
}
__device__ __forceinline__ void ph_slot(const Ctx& c, const Params& p) {
    const unsigned* counts = (const unsigned*)(c.ws + WS_CTL) + CW_COUNTS; unsigned* cursor = (unsigned*)(c.ws + WS_CTL) + CW_CURSOR;
    int* ps = (int*)c.lds;
    if (c.tid == 0) { int acc = 0; for (int e = 0; e < NE; ++e) { ps[e] = acc; acc += ((int)counts[e] + 255) / 256 * 256; } ps[NE] = acc; }
    __syncthreads();
    const int* eidx = (const int*)(c.ws + WS_EIDX); const float* gw = (const float*)(c.ws + WS_GATEW);
    int* stok = (int*)(c.ws + WS_SLOT_TOK); int* sasg = (int*)(c.ws + WS_SLOT_ASG); float* sgate = (float*)(c.ws + WS_SLOT_GATE);
    for (int a = c.gtid; a < T * TOPK; a += c.gthreads) {
        const int e = eidx[a]; const unsigned pos = atomicAdd(cursor + e, 1u); const int slot = ps[e] + (int)pos;
        stok[slot] = a >> 3; sasg[slot] = a; sgate[slot] = gw[a];
    }
    if (c.bid == 0) {
        int* te = (int*)(c.ws + WS_TILE_E); int* padst = (int*)(c.ws + WS_PADST);
        for (int e = c.tid; e <= NE; e += 512) padst[e] = ps[e];
        for (int e = c.tid; e < NE; e += 512) for (int tl = ps[e] / 256; tl < ps[e + 1] / 256; ++tl) te[tl] = e;
        if (c.tid == 0) ((unsigned*)(c.ws + WS_CTL))[CW_NTILES] = (unsigned)(ps[NE] / 256);
    }
}
struct EpiE2 { const int* sasg; const float* sgate; bf16_t* YA;
    __device__ __forceinline__ void operator()(int row, int col, const f32x4& a, const f32x4&, int) const {
        const int asg = sasg[row]; if (asg < 0) return; const float g = sgate[row];
        u32x2 w; w.x = pk2(g * a[0], g * a[1]); w.y = pk2(g * a[2], g * a[3]); *(u32x2*)(YA + (size_t)asg * DM + col) = w; } };
struct EpiSD { const float* mod; float* out;
    __device__ __forceinline__ void operator()(int row, int col, const f32x4& a, const f32x4&, int) const {
        const int b = row / SEQ; const f32x4 g2 = *(const f32x4*)(mod + b * 6 * DM + 5 * DM + col); f32x4* o = (f32x4*)(out + (size_t)row * DM + col);
        f32x4 v = *o; v.x += g2.x * a[0]; v.y += g2.y * a[1]; v.z += g2.z * a[2]; v.w += g2.w * a[3]; *o = v; } };
__device__ __forceinline__ void ph_combine(const Ctx& c, const Params& p) {
    const float* mod = (const float*)(c.ws + WS_MOD); const bf16_t* YA = (const bf16_t*)(c.ws + WS_YA); float* out = p.out;
    for (int idx = c.gtid; idx < T * (DM / 8); idx += c.gthreads) {
        const int t = idx >> 7, col = (idx & 127) * 8, b = t / SEQ;
        float s[8] = {0.f, 0.f, 0.f, 0.f, 0.f, 0.f, 0.f, 0.f};
#pragma unroll
        for (int k = 0; k < 8; ++k) { const u32x4 w = *(const u32x4*)(YA + ((size_t)t * 8 + k) * DM + col); const unsigned* wp = (const unsigned*)&w;
#pragma unroll
            for (int i = 0; i < 4; ++i) { s[2 * i] += __uint_as_float(wp[i] << 16); s[2 * i + 1] += __uint_as_float(wp[i] & 0xffff0000u); } }
        const float* g2 = mod + b * 6 * DM + 5 * DM + col; float* o = out + (size_t)t * DM + col;
        f32x4 o0 = *(f32x4*)o, o1 = *(f32x4*)(o + 4);
        o0.x += g2[0] * s[0]; o0.y += g2[1] * s[1]; o0.z += g2[2] * s[2]; o0.w += g2[3] * s[3];
        o1.x += g2[4] * s[4]; o1.y += g2[5] * s[5]; o1.z += g2[6] * s[6]; o1.w += g2[7] * s[7];
        *(f32x4*)o = o0; *(f32x4*)(o + 4) = o1;
    }
}


#define GAS __attribute__((address_space(1)))
#define LAS __attribute__((address_space(3)))
#define XB_TMO      128
#define XB_XCNT(j)  (256  + 64 * (j))
#define XB_XSUB(j)  (1280 + 64 * (j))
#define XB_XGEN(j)  (2304 + 64 * (j))
#define XB_TOP      3328
#define XB_TOPGEN   3392
#define XCD_BAR_WORDS 3456
#define XB_SPIN_CAP (1u << 18)

__device__ __forceinline__ unsigned xb_ld(unsigned* p)              { return __hip_atomic_load(p, __ATOMIC_RELAXED, __HIP_MEMORY_SCOPE_AGENT); }
__device__ __forceinline__ unsigned xb_add(unsigned* p, unsigned v) { return __hip_atomic_fetch_add(p, v, __ATOMIC_RELAXED, __HIP_MEMORY_SCOPE_AGENT); }
__device__ __forceinline__ unsigned xb_xcc_id() { return (unsigned)__builtin_amdgcn_s_getreg((3 << 11) | 20) & 0xFu; }
#define XB_SPIN(cond, bar) do { unsigned _sp = 0; while (cond) { __builtin_amdgcn_s_sleep(1); \
    if ((++_sp & 255u) == 0u) { if (xb_ld(&(bar)[XB_TMO])) break; if (_sp > XB_SPIN_CAP) { atomicAdd(&(bar)[XB_TMO], 1u); break; } } } } while (0)

struct XcdBarrier {
    unsigned* bar; unsigned x;
    volatile LAS unsigned* st;
};

__device__ __forceinline__ XcdBarrier xcd_barrier_post(unsigned* bar, volatile LAS unsigned* st) {
    XcdBarrier b; b.bar = bar; b.x = xb_xcc_id(); b.st = st;
    if (threadIdx.x == 0) (void)xb_add(&bar[XB_XCNT(b.x)], 1u);
    return b;
}
__device__ __forceinline__ void xcd_barrier_complete(unsigned* bar, unsigned x, unsigned& nloc, unsigned& nx) {
    const unsigned G = gridDim.x * gridDim.y * gridDim.z;
    unsigned sum, cnt, mine, sp = 0u;
    for (;;) {
        sum = 0u; cnt = 0u; mine = 0u;
#pragma unroll
        for (unsigned j = 0; j < 16; ++j) { const unsigned c = xb_ld(&bar[XB_XCNT(j)]); sum += c; cnt += (c > 0u) ? 1u : 0u; mine = (j == x) ? c : mine; }
        if (sum == G) break;
        __builtin_amdgcn_s_sleep(1);
        if ((++sp & 255u) == 0u) { if (xb_ld(&bar[XB_TMO])) break; if (sp > XB_SPIN_CAP) { atomicAdd(&bar[XB_TMO], 1u); break; } }
    }
    nloc = mine > 0u ? mine : 1u; nx = cnt > 0u ? cnt : 1u;
}

__device__ __forceinline__ void xcd_barrier(const XcdBarrier& b) {
    asm volatile("s_waitcnt vmcnt(0)" ::: "memory");
    __syncthreads();
    if (threadIdx.x == 0) {
        unsigned* bar = b.bar;
        __builtin_amdgcn_s_waitcnt(0);
        unsigned nloc = b.st[0], nx = b.st[1];
        if (nloc == 0u) { xcd_barrier_complete(bar, b.x, nloc, nx); b.st[0] = nloc; b.st[1] = nx; }
        const unsigned old = xb_add(&bar[XB_XSUB(b.x)], 1u);
        const unsigned gen = old / nloc;
        if (old + 1u == (gen + 1u) * nloc) {
            __builtin_amdgcn_fence(__ATOMIC_RELEASE, "agent");
            asm volatile("s_waitcnt vmcnt(0)" ::: "memory");
            const unsigned og = xb_add(&bar[XB_TOP], 1u);
            const unsigned tg = og / nx;
            if (og + 1u == (tg + 1u) * nx) xb_add(&bar[XB_TOPGEN], 1u);
            else XB_SPIN(xb_ld(&bar[XB_TOPGEN]) == tg, bar);
            __builtin_amdgcn_fence(__ATOMIC_ACQUIRE, "agent");
            xb_add(&bar[XB_XGEN(b.x)], 1u);
            asm volatile("s_waitcnt vmcnt(0)" ::: "memory");
        } else {
            XB_SPIN(xb_ld(&bar[XB_XGEN(b.x)]) == gen, bar);
            __builtin_amdgcn_fence(__ATOMIC_ACQUIRE, "agent");
            asm volatile("s_waitcnt vmcnt(0)" ::: "memory");
        }
    }
    __syncthreads();
}

namespace pg8 {
#define PG8_LAS __attribute__((address_space(3)))
typedef short bf16x8 __attribute__((ext_vector_type(8)));
constexpr int BM = 256, BK = 64, HALF = 128, HTB = HALF * BK * 2  , STAGE_BYTES = 8 * HTB;

__host__ __device__ __forceinline__ int lds_byte(int r, int c) { const int st = (r >> 4) * 2 + (c >> 5), rr = r & 15, cc = c & 31, ob = rr * 64 + cc * 2; return st * 1024 + (ob ^ (((ob >> 9) & 1) << 5)); }
__host__ __device__ __forceinline__ void stage_rc(int b, int& R, int& C) { const int st = b / 1024, sb = b % 1024, swz = sb ^ (((sb >> 9) & 1) << 5); R = (st >> 1) * 16 + swz / 64; C = (st & 1) * 32 + (swz % 64) / 2; }
__host__ __device__ __forceinline__ int perm32(int rho) { const int n = rho >> 4, i = rho & 15; return 8 * (i >> 2) + 4 * n + (i & 3); }

struct Unit { int pm, pn, pb; };
struct Gemm { const bf16_t* A; const bf16_t* Bt; int K, lda; const int* rowidx; };

__device__ __forceinline__ unsigned cvt_pk_bf16(float lo, float hi) { unsigned r; asm volatile("v_cvt_pk_bf16_f32 %0, %1, %2" : "=v"(r) : "v"(lo), "v"(hi)); return r; }

template <class Epi, class Sched, bool GATHER, bool ALIGN_EPI>
__device__ __forceinline__ void gemm_phase(PG8_LAS unsigned char* lds, const Gemm g, const Sched& S, const Epi& E) {
    int tid_ = threadIdx.x; asm volatile("" : "+v"(tid_));
    const int tid = tid_, wid = __builtin_amdgcn_readfirstlane(tid >> 6), lane = tid & 63, wr = wid >> 2, wc = wid & 3, fr = lane & 15, fq = lane >> 4;
    const int K = g.K, nt = K / BK, lda = g.lda;
    unsigned voffB[2], oc[2][2], on[2][2];
#pragma unroll
    for (int i = 0; i < 2; ++i) { int R, C; stage_rc(tid * 16 + i * 8192, R, C); const int Rb = Epi::PERM ? ((R & ~31) + perm32(R & 31)) : R;
        voffB[i] = (unsigned)(Rb * K + C) * 2u;
        oc[0][i] = (unsigned)(R * lda + C) * 2u; oc[1][i] = (unsigned)((R + HALF) * lda + C) * 2u; on[0][i] = oc[0][i]; on[1][i] = oc[1][i]; }
    const size_t kstep = (size_t)(BK * 2);
    const size_t hstep = (size_t)HALF * K * 2;
    const size_t tstepB = 2 * hstep, tstepA = (size_t)BM * lda * 2;
    const unsigned ldsw = (unsigned)wid * 1024u;
    const int aoff = lds_byte(wr * 64 + fr, fq * 8), boff = lds_byte(wc * 32 + fr, fq * 8);
#define PG8_SA(b, h) (((b) * 2 + (h)) * HTB)
#define PG8_SB(b, h) ((4 + (b) * 2 + (h)) * HTB)
#define PG8_STAGE(bufoff, gbase, voff) do { _Pragma("unroll") for (int _i = 0; _i < 2; ++_i) \
        __builtin_amdgcn_global_load_lds((const unsigned*)((const char*)(gbase) + (voff)[_i]), (PG8_LAS unsigned*)(lds + (bufoff) + ldsw + _i * 8192), 16, 0, 0); } while (0)
#define PG8_LDA(dst, b, h) do { _Pragma("unroll") for (int m = 0; m < 4; ++m) _Pragma("unroll") for (int k = 0; k < 2; ++k) dst[m][k] = *(const PG8_LAS bf16x8*)(lds + PG8_SA(b, h) + aoff + m * 2048 + k * 1024); } while (0)
#define PG8_LDB(dst, b, h) do { _Pragma("unroll") for (int n = 0; n < 2; ++n) _Pragma("unroll") for (int k = 0; k < 2; ++k) dst[n][k] = *(const PG8_LAS bf16x8*)(lds + PG8_SB(b, h) + boff + n * 2048 + k * 1024); } while (0)
#define PG8_MMA(ai, bj, At, Bt) do { __builtin_amdgcn_s_setprio(1); _Pragma("unroll") for (int m = 0; m < 4; ++m) _Pragma("unroll") for (int n = 0; n < 2; ++n) _Pragma("unroll") for (int k = 0; k < 2; ++k) \
        acc[ai][bj][m][n] = __builtin_amdgcn_mfma_f32_16x16x32_bf16(Bt[n][k], At[m][k], acc[ai][bj][m][n], 0, 0, 0); __builtin_amdgcn_s_setprio(0); } while (0)
#define PG8_WAIT_V(n) asm volatile("s_waitcnt vmcnt(" #n ")" ::: "memory")
#define PG8_WAIT_L(n) asm volatile("s_waitcnt lgkmcnt(" #n ")" ::: "memory")
#define PG8_BAR __builtin_amdgcn_s_barrier()
#define PG8_SCHED __builtin_amdgcn_sched_barrier(0)
#define PG8_GIDX(dst, unit) do { _Pragma("unroll") for (int _i = 0; _i < 2; ++_i) { int R_, C_; stage_rc(tid * 16 + _i * 8192, R_, C_); \
        const int r0_ = g.rowidx[(unit).pm * BM + R_], r1_ = g.rowidx[(unit).pm * BM + HALF + R_]; \
        dst[0][_i] = (unsigned)(r0_ * lda + C_) * 2u; dst[1][_i] = (unsigned)(r1_ * lda + C_) * 2u; } } while (0)
    Unit cur, nxt; int ui = 0;
    if (!S.next(0, cur)) return;
    f32x4 acc[2][2][4][2];
#pragma unroll
    for (int a = 0; a < 2; ++a)
#pragma unroll
        for (int b = 0; b < 2; ++b)
#pragma unroll
            for (int m = 0; m < 4; ++m)
#pragma unroll
                for (int n = 0; n < 2; ++n) acc[a][b][m][n] = (f32x4){0.f, 0.f, 0.f, 0.f};
    bf16x8 At[4][2], B0[2][2], B1[2][2];
    if constexpr (GATHER) { PG8_GIDX(oc, cur); }
    const char* cA = GATHER ? (const char*)g.A : (const char*)g.A + (size_t)cur.pm * tstepA; const char* cB = (const char*)g.Bt + (size_t)cur.pb * tstepB;
    PG8_STAGE(PG8_SB(0, 0), cB, voffB); PG8_STAGE(PG8_SB(0, 1), cB + hstep, voffB); PG8_STAGE(PG8_SA(0, 0), cA, oc[0]); PG8_STAGE(PG8_SA(0, 1), cA, oc[1]);
    if (wr == 1) PG8_BAR;
    PG8_WAIT_V(2); PG8_BAR;
    PG8_STAGE(PG8_SB(1, 0), cB + kstep, voffB); PG8_STAGE(PG8_SA(1, 0), cA + kstep, oc[0]); PG8_STAGE(PG8_SB(1, 1), cB + hstep + kstep, voffB);
    PG8_WAIT_V(6); PG8_BAR;
    for (;;) {
        const bool has_next = S.next(ui + 1, nxt);
        if constexpr (GATHER) { if (has_next) { PG8_GIDX(on, nxt); } }
        const char* nA = has_next ? (GATHER ? (const char*)g.A : (const char*)g.A + (size_t)nxt.pm * tstepA) : cA; const char* nB = has_next ? (const char*)g.Bt + (size_t)nxt.pb * tstepB : cB;
#pragma unroll 1
        for (int t = 0; t < nt; t += 2) {
            const bool last = (t == nt - 2);
            const char* a1 = cA + (size_t)(t + 1) * kstep;
            const char* a2 = last ? nA : cA + (size_t)(t + 2) * kstep; const char* b2 = last ? nB : cB + (size_t)(t + 2) * kstep;
            const char* a3 = a2 + kstep; const char* b3 = b2 + kstep;
            PG8_LDB(B0, 0, 0); PG8_LDB(B1, 0, 1); PG8_SCHED; PG8_LDA(At, 0, 0); PG8_STAGE(PG8_SA(1, 1), a1, oc[1]);
            if constexpr (GATHER) { if (last && has_next) { oc[0][0] = on[0][0]; oc[0][1] = on[0][1]; oc[1][0] = on[1][0]; oc[1][1] = on[1][1]; } }
            PG8_WAIT_V(8); PG8_WAIT_L(0); PG8_BAR; PG8_MMA(0, 0, At, B0); PG8_MMA(0, 1, At, B1); PG8_BAR; PG8_SCHED;
            PG8_LDA(At, 0, 1); PG8_STAGE(PG8_SB(0, 0), b2, voffB); PG8_STAGE(PG8_SB(0, 1), b2 + hstep, voffB); PG8_STAGE(PG8_SA(0, 0), a2, oc[0]);
            PG8_WAIT_V(8); PG8_WAIT_L(0); PG8_BAR; PG8_MMA(1, 0, At, B0); PG8_MMA(1, 1, At, B1); PG8_BAR; PG8_SCHED;
            PG8_LDB(B0, 1, 0); PG8_LDB(B1, 1, 1); PG8_SCHED; PG8_LDA(At, 1, 0); PG8_STAGE(PG8_SA(0, 1), a2, oc[1]);
            PG8_WAIT_V(8); PG8_WAIT_L(0); PG8_BAR; PG8_MMA(0, 0, At, B0); PG8_MMA(0, 1, At, B1); PG8_BAR; PG8_SCHED;
            PG8_LDA(At, 1, 1); PG8_STAGE(PG8_SB(1, 0), b3, voffB); PG8_STAGE(PG8_SB(1, 1), b3 + hstep, voffB); PG8_STAGE(PG8_SA(1, 0), a3, oc[0]);
            PG8_WAIT_V(8); PG8_WAIT_L(0); PG8_BAR; PG8_MMA(1, 0, At, B0); PG8_MMA(1, 1, At, B1); PG8_BAR; PG8_SCHED;
        }
        if constexpr (ALIGN_EPI) { if (wr == 0) PG8_BAR; }
        E(acc, cur, wr, wc, fr, fq);
        if (!has_next) break;
#pragma unroll
        for (int a = 0; a < 2; ++a)
#pragma unroll
            for (int b = 0; b < 2; ++b)
#pragma unroll
                for (int m = 0; m < 4; ++m)
#pragma unroll
                    for (int n = 0; n < 2; ++n) acc[a][b][m][n] = (f32x4){0.f, 0.f, 0.f, 0.f};
        cur = nxt; cA = nA; cB = nB; ++ui;
        if constexpr (ALIGN_EPI) { if (wr == 1) PG8_BAR; }
    }
    PG8_WAIT_V(0);
    if constexpr (!ALIGN_EPI) { if (wr == 0) PG8_BAR; }
    PG8_BAR;
#undef PG8_SA
#undef PG8_SB
#undef PG8_STAGE
#undef PG8_LDA
#undef PG8_LDB
#undef PG8_MMA
#undef PG8_WAIT_V
#undef PG8_WAIT_L
#undef PG8_BAR
#undef PG8_SCHED
#undef PG8_GIDX
}

struct DenseOrder {
    int nM, nN, nwg, G, c;
    __device__ __forceinline__ void init(int M, int N, int G_, int c_) { nM = M / BM; nN = N / BM; nwg = nM * nN; G = G_; c = c_; }
    __device__ __forceinline__ bool next(int i, Unit& u) const {
        const long L = (long)i * G + c; if (L >= nwg) return false;
        int wgid = (int)L; { const int q = nwg / 8, r = nwg % 8, xcd = wgid % 8, off = wgid / 8; wgid = (xcd < r ? xcd * (q + 1) : r * (q + 1) + (xcd - r) * q) + off; }
        const int nig = 8 * nN, gid = wgid / nig, fm = gid * 8, gsz = (nM - fm) < 8 ? (nM - fm) : 8;
        u.pm = fm + ((wgid % nig) % gsz); u.pn = (wgid % nig) / gsz; u.pb = u.pn; return true;
    }
};
struct GroupedOrder {
    const int* tile_e; int ntiles, NT, G, vcu;
    __device__ __forceinline__ bool next(int i, Unit& u) const {
        const int L = i * G + vcu; if (L >= ntiles * NT) return false;
        const int mt = L / NT, nn = L - mt * NT; u.pm = mt; u.pn = nn; u.pb = tile_e[mt] * NT + nn; return true;
    }
};

#define EPI_ROWS_BEGIN const int row0 = u.pm * BM + wr * 64 + fr; _Pragma("unroll") for (int ai = 0; ai < 2; ++ai) _Pragma("unroll") for (int m = 0; m < 4; ++m) { const int row = row0 + ai * HALF + m * 16;
#define EPI_ROWS_END }
struct EpiWinF {
    static constexpr bool PERM = true;
    bf16_t* QK; bf16_t* V; bf16_t* AP;
    __device__ __forceinline__ void operator()(const f32x4 (&acc)[2][2][4][2], const Unit& u, int wr, int wc, int fr, int fq) const {
        const int colt = u.pn * BM + wc * 32 + 8 * fq;
        EPI_ROWS_BEGIN
#pragma unroll
            for (int bj = 0; bj < 2; ++bj) { const f32x4 v0 = acc[ai][bj][m][0], v1 = acc[ai][bj][m][1]; const int col = colt + bj * HALF;
                u32x4 w; w.x = cvt_pk_bf16(v0[0], v0[1]); w.y = cvt_pk_bf16(v0[2], v0[3]); w.z = cvt_pk_bf16(v1[0], v1[1]); w.w = cvt_pk_bf16(v1[2], v1[3]);
                bf16_t* dst;
                if (u.pn < 4) dst = QK + (size_t)row * 1024 + col;
                else if (u.pn < 6) dst = V + (size_t)row * 512 + (col - 1024);
                else { const int cc = col - 1536, gg = cc >> 4, ch = cc & 15, b = row / SEQ, l = row % SEQ;
                    dst = AP + ((size_t)(gg * (NB * NCHUNK) + b * NCHUNK + (l >> 4)) * APK + (l & 15) * 16 + ch); }
                *(u32x4*)dst = w; }
        EPI_ROWS_END
    }
};
struct EpiGluF {
    static constexpr bool PERM = true;
    const bf16_t* Y; bf16_t* MX; float* ss;
    __device__ __forceinline__ void operator()(const f32x4 (&acc)[2][2][4][2], const Unit& u, int wr, int wc, int fr, int fq) const {
        const int colt = u.pn * BM + wc * 32 + 8 * fq;
        EPI_ROWS_BEGIN
            float s = 0.f;
#pragma unroll
            for (int bj = 0; bj < 2; ++bj) { const int col = colt + bj * HALF; const u32x4 yv = *(const u32x4*)(Y + (size_t)row * 512 + col);
                const f32x4 a0 = acc[ai][bj][m][0], a1 = acc[ai][bj][m][1];
                float v[8];
                v[0] = __uint_as_float(yv.x << 16) * sigmoidf(a0[0]); v[1] = __uint_as_float(yv.x & 0xffff0000u) * sigmoidf(a0[1]);
                v[2] = __uint_as_float(yv.y << 16) * sigmoidf(a0[2]); v[3] = __uint_as_float(yv.y & 0xffff0000u) * sigmoidf(a0[3]);
                v[4] = __uint_as_float(yv.z << 16) * sigmoidf(a1[0]); v[5] = __uint_as_float(yv.z & 0xffff0000u) * sigmoidf(a1[1]);
                v[6] = __uint_as_float(yv.w << 16) * sigmoidf(a1[2]); v[7] = __uint_as_float(yv.w & 0xffff0000u) * sigmoidf(a1[3]);
#pragma unroll
                for (int i = 0; i < 8; ++i) s += v[i] * v[i];
                u32x4 w; w.x = cvt_pk_bf16(v[0], v[1]); w.y = cvt_pk_bf16(v[2], v[3]); w.z = cvt_pk_bf16(v[4], v[5]); w.w = cvt_pk_bf16(v[6], v[7]);
                *(u32x4*)(MX + (size_t)row * 1024 + 512 + col) = w; }
            s += __shfl_xor(s, 16); s += __shfl_xor(s, 32);
            if (fq == 0) atomicAdd(ss + row, s);
        EPI_ROWS_END
    }
};
struct EpiWoutF {
    static constexpr bool PERM = false;
    const float* x; const float* mod; float* out; float* ss;
    __device__ __forceinline__ void operator()(const f32x4 (&acc)[2][2][4][2], const Unit& u, int wr, int wc, int fr, int fq) const {
        const int colt = u.pn * BM + wc * 32 + 4 * fq;
        EPI_ROWS_BEGIN
            const int b = row / SEQ; float s = 0.f;
#pragma unroll
            for (int bj = 0; bj < 2; ++bj)
#pragma unroll
                for (int n = 0; n < 2; ++n) { const int col = colt + bj * HALF + n * 16;
                    const f32x4 xv = *(const f32x4*)(x + (size_t)row * DM + col), g1 = *(const f32x4*)(mod + b * 6 * DM + 2 * DM + col);
                    const f32x4 o = xv + g1 * acc[ai][bj][m][n];
                    *(f32x4*)(out + (size_t)row * DM + col) = o; s += o[0] * o[0] + o[1] * o[1] + o[2] * o[2] + o[3] * o[3]; }
            s += __shfl_xor(s, 16); s += __shfl_xor(s, 32);
            if (fq == 0) atomicAdd(ss + row, s);
        EPI_ROWS_END
    }
};
struct EpiRSF {
    static constexpr bool PERM = true;
    float* L; bf16_t* AS;
    __device__ __forceinline__ void operator()(const f32x4 (&acc)[2][2][4][2], const Unit& u, int wr, int wc, int fr, int fq) const {
        const int c8 = wc * 32 + 8 * fq;
        EPI_ROWS_BEGIN
            if (u.pn == 0) {
#pragma unroll
                for (int bj = 0; bj < 2; ++bj) { float* d = L + (size_t)row * 256 + bj * HALF + c8; *(f32x4*)d = acc[ai][bj][m][0]; *(f32x4*)(d + 4) = acc[ai][bj][m][1]; }
            } else {
                const f32x4 g0 = acc[ai][0][m][0], g1 = acc[ai][0][m][1], u0 = acc[ai][1][m][0], u1 = acc[ai][1][m][1];
                u32x4 w; w.x = cvt_pk_bf16(siluf(g0[0]) * u0[0], siluf(g0[1]) * u0[1]); w.y = cvt_pk_bf16(siluf(g0[2]) * u0[2], siluf(g0[3]) * u0[3]);
                w.z = cvt_pk_bf16(siluf(g1[0]) * u1[0], siluf(g1[1]) * u1[1]); w.w = cvt_pk_bf16(siluf(g1[2]) * u1[2], siluf(g1[3]) * u1[3]);
                *(u32x4*)(AS + (size_t)row * 256 + (u.pn - 1) * 128 + c8) = w;
            }
        EPI_ROWS_END
    }
};
struct EpiSDF {
    static constexpr bool PERM = false;
    const float* mod; float* out;
    __device__ __forceinline__ void operator()(const f32x4 (&acc)[2][2][4][2], const Unit& u, int wr, int wc, int fr, int fq) const {
        const int colt = u.pn * BM + wc * 32 + 4 * fq;
        EPI_ROWS_BEGIN
            const int b = row / SEQ;
#pragma unroll
            for (int bj = 0; bj < 2; ++bj)
#pragma unroll
                for (int n = 0; n < 2; ++n) { const int col = colt + bj * HALF + n * 16; const f32x4 g2 = *(const f32x4*)(mod + b * 6 * DM + 5 * DM + col);
                    f32x4* o = (f32x4*)(out + (size_t)row * DM + col); *o = *o + g2 * acc[ai][bj][m][n]; }
        EPI_ROWS_END
    }
};
struct EpiE1F {
    static constexpr bool PERM = true;
    bf16_t* AE;
    __device__ __forceinline__ void operator()(const f32x4 (&acc)[2][2][4][2], const Unit& u, int wr, int wc, int fr, int fq) const {
        const int c8 = u.pn * 128 + wc * 32 + 8 * fq;
        EPI_ROWS_BEGIN
            const f32x4 g0 = acc[ai][0][m][0], g1 = acc[ai][0][m][1], u0 = acc[ai][1][m][0], u1 = acc[ai][1][m][1];
            u32x4 w; w.x = cvt_pk_bf16(siluf(g0[0]) * u0[0], siluf(g0[1]) * u0[1]); w.y = cvt_pk_bf16(siluf(g0[2]) * u0[2], siluf(g0[3]) * u0[3]);
            w.z = cvt_pk_bf16(siluf(g1[0]) * u1[0], siluf(g1[1]) * u1[1]); w.w = cvt_pk_bf16(siluf(g1[2]) * u1[2], siluf(g1[3]) * u1[3]);
            *(u32x4*)(AE + (size_t)row * 256 + c8) = w;
        EPI_ROWS_END
    }
};
struct EpiE2F {
    static constexpr bool PERM = true;
    const int* sasg; const float* sgate; bf16_t* YA;
    __device__ __forceinline__ void operator()(const f32x4 (&acc)[2][2][4][2], const Unit& u, int wr, int wc, int fr, int fq) const {
        const int colt = u.pn * BM + wc * 32 + 8 * fq;
        EPI_ROWS_BEGIN
            const int asg = sasg[row]; const float gt = sgate[row];
            if (asg >= 0) {
#pragma unroll
                for (int bj = 0; bj < 2; ++bj) { const f32x4 v0 = acc[ai][bj][m][0] * gt, v1 = acc[ai][bj][m][1] * gt;
                    u32x4 w; w.x = cvt_pk_bf16(v0[0], v0[1]); w.y = cvt_pk_bf16(v0[2], v0[3]); w.z = cvt_pk_bf16(v1[0], v1[1]); w.w = cvt_pk_bf16(v1[2], v1[3]);
                    *(u32x4*)(YA + (size_t)asg * DM + colt + bj * HALF) = w; }
            }
        EPI_ROWS_END
    }
};
}

__device__ __forceinline__ void transpose_item(const float* W, int K, int N, bf16_t* WT, int kb, int nb, int rowbase, float* scr, int lane) {
    const int k0 = 64 * kb, n0 = 32 * nb;
#pragma unroll 8
    for (int i = 0; i < 32; ++i) { const int kk = 2 * i + (lane >> 5); scr[kk * 33 + (lane & 31)] = W[(size_t)(k0 + kk) * N + n0 + (lane & 31)]; }
    asm volatile("s_waitcnt lgkmcnt(0)" ::: "memory");
    const int cch = lane & 7;
#pragma unroll
    for (int j = 0; j < 4; ++j) { const int n = (lane >> 3) + 8 * j; const float* s = scr + (8 * cch) * 33 + n;
        u32x4 o; o.x = pk2(s[0 * 33], s[1 * 33]); o.y = pk2(s[2 * 33], s[3 * 33]); o.z = pk2(s[4 * 33], s[5 * 33]); o.w = pk2(s[6 * 33], s[7 * 33]);
        *(u32x4*)(WT + (size_t)(rowbase + n) * K + k0 + 8 * cch) = o; }
    asm volatile("s_waitcnt lgkmcnt(0)" ::: "memory");
}
__device__ __forceinline__ int gu_row(int n0, int up) { return (n0 >> 7) * 256 + up * 128 + (n0 & 127); }
__device__ __forceinline__ void ph_convert(const Ctx& c, const Params& p) {
    float* scr = c.lds + c.wave * (64 * 33);
    unsigned char* ws = c.ws;
    constexpr int I0 = 16 * 64, I1 = 16 * 32, I2 = 8 * 16, I3 = 16 * 8, I6 = 4 * 32, IE = 128;
    constexpr int DENSE = I0 + I1 + I2 + 3 * I3 + I6, NITEMS = DENSE + 3 * IE * NE;
    for (int it = c.gwave; it < NITEMS; it += c.gwaves) {
        int r = it;
        if (r < I0) { transpose_item(p.in[I_WIN], DM, 2048, (bf16_t*)(ws + WS_WIN_T), r / 64, r % 64, (r % 64) * 32, scr, c.lane); continue; } r -= I0;
        if (r < I1) { transpose_item(p.in[I_WOUT], DM, DM, (bf16_t*)(ws + WS_WOUT_T), r / 32, r % 32, (r % 32) * 32, scr, c.lane); continue; } r -= I1;
        if (r < I2) { transpose_item(p.in[I_WGLU], 512, 512, (bf16_t*)(ws + WS_WGLU_T), r / 16, r % 16, (r % 16) * 32, scr, c.lane); continue; } r -= I2;
        if (r < I3) { transpose_item(p.in[I_WR], DM, 256, (bf16_t*)(ws + WS_WRS_T), r / 8, r % 8, (r % 8) * 32, scr, c.lane); continue; } r -= I3;
        if (r < I3) { transpose_item(p.in[I_WGS], DM, 256, (bf16_t*)(ws + WS_WRS_T), r / 8, r % 8, 256 + gu_row((r % 8) * 32, 0), scr, c.lane); continue; } r -= I3;
        if (r < I3) { transpose_item(p.in[I_WUS], DM, 256, (bf16_t*)(ws + WS_WRS_T), r / 8, r % 8, 256 + gu_row((r % 8) * 32, 1), scr, c.lane); continue; } r -= I3;
        if (r < I6) { transpose_item(p.in[I_WDS], 256, DM, (bf16_t*)(ws + WS_WDS_T), r / 32, r % 32, (r % 32) * 32, scr, c.lane); continue; } r -= I6;
        const int e = r / (3 * IE), q = r % (3 * IE), which = q / IE, ii = q % IE;
        if (which == 0) transpose_item(p.in[I_WGE] + (size_t)e * DM * ED, DM, ED, (bf16_t*)(ws + WS_WGU) + (size_t)e * 512 * DM, ii / 8, ii % 8, gu_row((ii % 8) * 32, 0), scr, c.lane);
        else if (which == 1) transpose_item(p.in[I_WUE] + (size_t)e * DM * ED, DM, ED, (bf16_t*)(ws + WS_WGU) + (size_t)e * 512 * DM, ii / 8, ii % 8, gu_row((ii % 8) * 32, 1), scr, c.lane);
        else transpose_item(p.in[I_WDE] + (size_t)e * ED * DM, ED, DM, (bf16_t*)(ws + WS_WD) + (size_t)e * DM * ED, ii / 32, ii % 32, (ii % 32) * 32, scr, c.lane);
    }
}

enum { PH_PRO = 0, PH_CONV, PH_H1, PH_WIN, PH_WIN_F, PH_QKN, PH_ATT, PH_ATTC, PH_SSM, PH_GLU, PH_GLU_F, PH_NORM, PH_WOUT, PH_WOUT_F, PH_H2,
       PH_RS, PH_RS2, PH_RS_F, PH_SD, PH_SD_F, PH_ROUTE, PH_SLOT, PH_E1, PH_E1_F, PH_E2, PH_E2_F, PH_COMB, PH_COUNT };
constexpr int NTHREADS = 512;
constexpr int LDS_BYTES = 147456;
constexpr int LDS_MISC_OFF = 131072 + 320;
typedef unsigned long long mask_t;
#define PHBIT(k) (1ull << (k))

template <mask_t MASK>
__global__ void __launch_bounds__(NTHREADS, 2) mega(Params p) {
    extern __shared__ __attribute__((aligned(16))) unsigned char lds_raw[];
#define MAKE_CTX() Ctx c; { int t_ = threadIdx.x; asm volatile("" : "+v"(t_)); c.tid = t_; c.lane = c.tid & 63; c.wave = __builtin_amdgcn_readfirstlane(c.tid >> 6); c.bid = blockIdx.x; c.nb = gridDim.x; \
    c.gtid = c.bid * NTHREADS + c.tid; c.gthreads = c.nb * NTHREADS; c.gwave = c.bid * (NTHREADS / 64) + c.wave; c.gwaves = c.nb * (NTHREADS / 64); c.ws = p.ws; c.lds = (float*)lds_raw; }
    unsigned char* ws = p.ws;
    PG8_LAS unsigned char* lds3 = (PG8_LAS unsigned char*)lds_raw;
    const int G = gridDim.x, bid = blockIdx.x, vcu = (G % 8 == 0) ? (bid % 8) * (G / 8) + bid / 8 : bid;
    constexpr bool MULTI = (MASK & (MASK - 1)) != 0;
    XcdBarrier bar; bar.bar = (unsigned*)(ws + WS_CTL) + CW_BAR; bar.x = 0; bar.st = nullptr;
    if constexpr (MULTI) {
        volatile LAS unsigned* misc = (volatile LAS unsigned*)(lds3 + LDS_MISC_OFF);
        if (threadIdx.x < 32) misc[threadIdx.x] = 0u;
        __syncthreads();
        bar = xcd_barrier_post((unsigned*)(ws + WS_CTL) + CW_BAR, misc + 8);
    }
    bool first = true;
#define PHASE(k) if constexpr ((MASK >> (k)) & 1ull) if ((MULTI ? (first ? (first = false, true) : (xcd_barrier(bar), true)) : true))
    PHASE(PH_PRO) { MAKE_CTX(); ph_prologue(c, p); }
    PHASE(PH_CONV) { MAKE_CTX(); ph_convert(c, p); }
    PHASE(PH_H1) { MAKE_CTX(); ph_h1(c, p); }
    PHASE(PH_WIN) { MAKE_CTX(); SG_Args g{(const bf16_t*)(ws + WS_H), DM, nullptr, p.in[I_WIN], nullptr, 2048, 0, nullptr, T, 2048, DM};
        EpiWin E{(bf16_t*)(ws + WS_QK), (bf16_t*)(ws + WS_V), (bf16_t*)(ws + WS_AP)}; sgemm_phase<false>(c, g, E); }
    PHASE(PH_WIN_F) { MAKE_CTX(); pg8::Gemm g{(const bf16_t*)(ws + WS_H), (const bf16_t*)(ws + WS_WIN_T), DM, DM, nullptr}; pg8::DenseOrder S; S.init(T, 2048, G, bid);
        pg8::EpiWinF E{(bf16_t*)(ws + WS_QK), (bf16_t*)(ws + WS_V), (bf16_t*)(ws + WS_AP)}; pg8::gemm_phase<pg8::EpiWinF, pg8::DenseOrder, false, true>(lds3, g, S, E); }
    PHASE(PH_QKN) { MAKE_CTX(); ph_qkn(c, p); }
    PHASE(PH_ATT) { MAKE_CTX(); ph_att_base(c, p); }
    PHASE(PH_ATTC) { MAKE_CTX(); ph_att_comb(c, p); }
    PHASE(PH_SSM) { MAKE_CTX(); ph_ssm_base(c, p); }
    PHASE(PH_GLU) { MAKE_CTX(); SG_Args g{(const bf16_t*)(ws + WS_Y), 512, nullptr, p.in[I_WGLU], nullptr, 512, 0, nullptr, T, 512, 512};
        EpiGlu E{(const bf16_t*)(ws + WS_Y), (bf16_t*)(ws + WS_MIXIN), (float*)(ws + WS_CTL + CTL_SS1)}; sgemm_phase<false>(c, g, E); }
    PHASE(PH_GLU_F) { MAKE_CTX(); pg8::Gemm g{(const bf16_t*)(ws + WS_Y), (const bf16_t*)(ws + WS_WGLU_T), 512, 512, nullptr}; pg8::DenseOrder S; S.init(T, 512, G, bid);
        pg8::EpiGluF E{(const bf16_t*)(ws + WS_Y), (bf16_t*)(ws + WS_MIXIN), (float*)(ws + WS_CTL + CTL_SS1)}; pg8::gemm_phase<pg8::EpiGluF, pg8::DenseOrder, false, true>(lds3, g, S, E); }
    PHASE(PH_NORM) { MAKE_CTX(); ph_ssm_norm(c, p); }
    PHASE(PH_WOUT) { MAKE_CTX(); SG_Args g{(const bf16_t*)(ws + WS_MIXIN), DM, nullptr, p.in[I_WOUT], nullptr, DM, 0, nullptr, T, DM, DM};
        EpiWout E{p.in[I_X], (const float*)(ws + WS_MOD), p.out, (float*)(ws + WS_CTL + CTL_SS2)}; sgemm_phase<false>(c, g, E); }
    PHASE(PH_WOUT_F) { MAKE_CTX(); pg8::Gemm g{(const bf16_t*)(ws + WS_MIXIN), (const bf16_t*)(ws + WS_WOUT_T), DM, DM, nullptr}; pg8::DenseOrder S; S.init(T, DM, G, bid);
        pg8::EpiWoutF E{p.in[I_X], (const float*)(ws + WS_MOD), p.out, (float*)(ws + WS_CTL + CTL_SS2)}; pg8::gemm_phase<pg8::EpiWoutF, pg8::DenseOrder, false, true>(lds3, g, S, E); }
    PHASE(PH_H2) { MAKE_CTX(); ph_h2(c, p); }
    PHASE(PH_RS) { MAKE_CTX(); SG_Args g{(const bf16_t*)(ws + WS_H), DM, nullptr, p.in[I_WR], nullptr, 256, 0, nullptr, T, 256, DM};
        EpiLogits E{(float*)(ws + WS_LOGITS)}; sgemm_phase<false>(c, g, E); }
    PHASE(PH_RS2) { MAKE_CTX(); SG_Args g2{(const bf16_t*)(ws + WS_H), DM, nullptr, p.in[I_WGS], p.in[I_WUS], 256, 0, nullptr, T, 256, DM};
        EpiSwiglu E2{(bf16_t*)(ws + WS_ACTS), 256}; sgemm_phase<true>(c, g2, E2); }
    PHASE(PH_RS_F) { MAKE_CTX(); pg8::Gemm g{(const bf16_t*)(ws + WS_H), (const bf16_t*)(ws + WS_WRS_T), DM, DM, nullptr}; pg8::DenseOrder S; S.init(T, 768, G, bid);
        pg8::EpiRSF E{(float*)(ws + WS_LOGITS), (bf16_t*)(ws + WS_ACTS)}; pg8::gemm_phase<pg8::EpiRSF, pg8::DenseOrder, false, true>(lds3, g, S, E); }
    PHASE(PH_SD) { MAKE_CTX(); SG_Args g{(const bf16_t*)(ws + WS_ACTS), 256, nullptr, p.in[I_WDS], nullptr, DM, 0, nullptr, T, DM, ED};
        EpiSD E{(const float*)(ws + WS_MOD), p.out}; sgemm_phase<false>(c, g, E); }
    PHASE(PH_SD_F) { MAKE_CTX(); pg8::Gemm g{(const bf16_t*)(ws + WS_ACTS), (const bf16_t*)(ws + WS_WDS_T), ED, ED, nullptr}; pg8::DenseOrder S; S.init(T, DM, G, bid);
        pg8::EpiSDF E{(const float*)(ws + WS_MOD), p.out}; pg8::gemm_phase<pg8::EpiSDF, pg8::DenseOrder, false, true>(lds3, g, S, E); }
    PHASE(PH_ROUTE) { MAKE_CTX(); ph_route(c, p); }
    PHASE(PH_SLOT) { MAKE_CTX(); ph_slot(c, p); }
    PHASE(PH_E1) { MAKE_CTX(); SG_Args g{(const bf16_t*)(ws + WS_H), DM, (const int*)(ws + WS_SLOT_TOK), p.in[I_WGE], p.in[I_WUE], 256, (size_t)DM * ED, (const int*)(ws + WS_TILE_E), NS_MAX, ED, DM};
        EpiSwiglu E{(bf16_t*)(ws + WS_ACTE), 256}; sgemm_phase<true>(c, g, E); }
    PHASE(PH_E1_F) { MAKE_CTX(); pg8::Gemm g{(const bf16_t*)(ws + WS_H), (const bf16_t*)(ws + WS_WGU), DM, DM, (const int*)(ws + WS_SLOT_TOK)};
        pg8::GroupedOrder S{(const int*)(ws + WS_TILE_E), (int)((const unsigned*)(ws + WS_CTL))[CW_NTILES], 2, G, vcu};
        pg8::EpiE1F E{(bf16_t*)(ws + WS_ACTE)}; pg8::gemm_phase<pg8::EpiE1F, pg8::GroupedOrder, true, true>(lds3, g, S, E); }
    PHASE(PH_E2) { MAKE_CTX(); SG_Args g{(const bf16_t*)(ws + WS_ACTE), 256, nullptr, p.in[I_WDE], nullptr, DM, (size_t)ED * DM, (const int*)(ws + WS_TILE_E), NS_MAX, DM, ED};
        EpiE2 E{(const int*)(ws + WS_SLOT_ASG), (const float*)(ws + WS_SLOT_GATE), (bf16_t*)(ws + WS_YA)}; sgemm_phase<false>(c, g, E); }
    PHASE(PH_E2_F) { MAKE_CTX(); pg8::Gemm g{(const bf16_t*)(ws + WS_ACTE), (const bf16_t*)(ws + WS_WD), ED, ED, nullptr};
        pg8::GroupedOrder S{(const int*)(ws + WS_TILE_E), (int)((const unsigned*)(ws + WS_CTL))[CW_NTILES], 4, G, vcu};
        pg8::EpiE2F E{(const int*)(ws + WS_SLOT_ASG), (const float*)(ws + WS_SLOT_GATE), (bf16_t*)(ws + WS_YA)}; pg8::gemm_phase<pg8::EpiE2F, pg8::GroupedOrder, false, true>(lds3, g, S, E); }
    PHASE(PH_COMB) { MAKE_CTX(); ph_combine(c, p); }
#undef PHASE
}

#ifndef PLAN
#define PLAN 2
#endif
#if PLAN == 0
#define LAUNCH_LIST X(PHBIT(PH_PRO)) X(PHBIT(PH_H1)) X(PHBIT(PH_WIN)) X(PHBIT(PH_QKN)) X(PHBIT(PH_ATT)) X(PHBIT(PH_ATTC)) X(PHBIT(PH_SSM)) X(PHBIT(PH_GLU)) X(PHBIT(PH_NORM)) \
    X(PHBIT(PH_WOUT)) X(PHBIT(PH_H2)) X(PHBIT(PH_RS)) X(PHBIT(PH_RS2)) X(PHBIT(PH_SD)) X(PHBIT(PH_ROUTE)) X(PHBIT(PH_SLOT)) X(PHBIT(PH_E1)) X(PHBIT(PH_E2)) X(PHBIT(PH_COMB))
#elif PLAN == 1
#define LAUNCH_LIST X(PHBIT(PH_PRO)) X(PHBIT(PH_CONV)) X(PHBIT(PH_H1)) X(PHBIT(PH_WIN_F)) X(PHBIT(PH_QKN)) X(PHBIT(PH_ATT)) X(PHBIT(PH_ATTC)) X(PHBIT(PH_SSM)) X(PHBIT(PH_GLU_F)) X(PHBIT(PH_NORM)) \
    X(PHBIT(PH_WOUT_F)) X(PHBIT(PH_H2)) X(PHBIT(PH_RS_F)) X(PHBIT(PH_SD_F)) X(PHBIT(PH_ROUTE)) X(PHBIT(PH_SLOT)) X(PHBIT(PH_E1_F)) X(PHBIT(PH_E2_F)) X(PHBIT(PH_COMB))
#elif PLAN == 2
#define LAUNCH_LIST X(PHBIT(PH_PRO) | PHBIT(PH_CONV) | PHBIT(PH_H1) | PHBIT(PH_WIN_F) | PHBIT(PH_QKN) | PHBIT(PH_ATT) | PHBIT(PH_ATTC) | PHBIT(PH_SSM) | PHBIT(PH_GLU_F) | PHBIT(PH_NORM) | \
    PHBIT(PH_WOUT_F) | PHBIT(PH_H2) | PHBIT(PH_RS_F) | PHBIT(PH_SD_F) | PHBIT(PH_ROUTE) | PHBIT(PH_SLOT) | PHBIT(PH_E1_F) | PHBIT(PH_E2_F) | PHBIT(PH_COMB))
#endif

extern "C" void kernel_launch(void* const* d_in, const int* in_sizes, int n_in, void* d_out, int out_size, void* d_ws, size_t ws_size, hipStream_t stream) {
    static int grid = 0;
    if (grid == 0) {
        if (n_in != 33 || out_size != T * DM || ws_size < WS_NEED) { fprintf(stderr, "kernel_launch: unexpected shapes (n_in %d out %d ws %zu)\n", n_in, out_size, ws_size); grid = -1; return; }
        int dev = 0, cus = 0;
        if (hipGetDevice(&dev) != hipSuccess || hipDeviceGetAttribute(&cus, hipDeviceAttributeMultiprocessorCount, dev) != hipSuccess) { grid = -1; return; }
        bool ok = true;
#define X(m) ok = ok && (hipFuncSetAttribute((const void*)mega<(m)>, hipFuncAttributeMaxDynamicSharedMemorySize, LDS_BYTES) == hipSuccess);
        LAUNCH_LIST
#undef X
        if (!ok) { grid = -1; return; }
        grid = cus;
    }
    if (grid < 0) return;
    (void)hipMemsetAsync((char*)d_ws + WS_CTL, 0, CTL_BYTES, stream);
    Params a{};
    for (int i = 0; i < 33; ++i) a.in[i] = (const float*)d_in[i];
    a.out = (float*)d_out; a.ws = (unsigned char*)d_ws;
#define X(m) hipLaunchKernelGGL((mega<(m)>), dim3(grid), dim3(NTHREADS), LDS_BYTES, stream, a);
    LAUNCH_LIST
#undef X
}
```

```cpp
#include <hip/hip_runtime.h>
#include <cstdio>
#include <cstdint>

typedef unsigned short bf16_t;
typedef float f32x4 __attribute__((ext_vector_type(4)));
typedef unsigned u32x4 __attribute__((ext_vector_type(4)));
typedef unsigned u32x2 __attribute__((ext_vector_type(2)));

constexpr int DM = 1024, NB = 8, SEQ = 4096, T = NB * SEQ;
constexpr int NH = 4, HD = 64, VD = 128, QKW = 512, ATTW = 512, SSMW = 512;
constexpr int SG = 32, SC = 16, SP = 64;
constexpr int LC = 16;
constexpr int NCHUNK = SEQ / LC;
constexpr int APK = 384;
constexpr int NE = 256, TOPK = 8, NGRP = 8, TOPG = 4, ED = 256;
constexpr int NS_MAX = 327680;
constexpr float EPS = 1e-6f;
constexpr float LAM_INIT = 0.2f;
constexpr float ROUTED_SCALE = 2.5f;

constexpr size_t MiB = 1u << 20;
constexpr size_t WS_CTL = 0, CTL_BYTES = 1 * MiB;
constexpr int CW_COUNTS = 1024;
constexpr int CW_CURSOR = 1024 + 256;
constexpr int CW_NTILES = 2048;
constexpr int CW_BAR = 4096;
constexpr size_t CTL_SS1 = 256 * 1024;
constexpr size_t CTL_SS2 = 384 * 1024;
constexpr size_t WS_MOD = 1 * MiB;
constexpr size_t WS_LAM = 1 * MiB + 256 * 1024;
constexpr size_t WS_ROPE = 1 * MiB + 512 * 1024;
constexpr size_t WS_SSMP = 2 * MiB + 512 * 1024;
constexpr size_t WS_EIDX = 4 * MiB;
constexpr size_t WS_GATEW = 5 * MiB;
constexpr size_t WS_SLOT_TOK = 6 * MiB;
constexpr size_t WS_SLOT_ASG = 7 * MiB + 512 * 1024;
constexpr size_t WS_SLOT_GATE = 9 * MiB;
constexpr size_t WS_TILE_E = 10 * MiB + 512 * 1024;
constexpr size_t WS_PADST = 10 * MiB + 768 * 1024;
constexpr size_t WS_WIN_T = 12 * MiB;
constexpr size_t WS_WOUT_T = 16 * MiB;
constexpr size_t WS_WGLU_T = 18 * MiB;
constexpr size_t WS_WRS_T = 19 * MiB;
constexpr size_t WS_WDS_T = 21 * MiB;
constexpr size_t WS_SSM_BA = 22 * MiB;
constexpr size_t WS_SSM_BC = 26 * MiB;
constexpr size_t WS_DS = 496 * MiB;
constexpr size_t WS_WGU = 32 * MiB;
constexpr size_t WS_WD = 704 * MiB;
constexpr size_t WS_YA = 32 * MiB;
constexpr size_t WS_H = 288 * MiB;
constexpr size_t WS_QK = 352 * MiB;
constexpr size_t WS_Y = 352 * MiB;
constexpr size_t WS_V = 416 * MiB;
constexpr size_t WS_AP = 448 * MiB;
constexpr size_t WS_ACTE = 544 * MiB;
constexpr size_t WS_MIXIN = 544 * MiB;
constexpr size_t WS_LOGITS = 608 * MiB;
constexpr size_t WS_ACTS = 640 * MiB;
constexpr size_t WS_ATTO = 832 * MiB;
constexpr size_t WS_NEED = 1024 * MiB;

__device__ __forceinline__ float bf2f(bf16_t v) { return __uint_as_float((unsigned)v << 16); }
__device__ __forceinline__ bf16_t f2bf(float f) { unsigned u = __float_as_uint(f); return (bf16_t)((u + 0x7fffu + ((u >> 16) & 1u)) >> 16); }
__device__ __forceinline__ unsigned pk2(float lo, float hi) { return (unsigned)f2bf(lo) | ((unsigned)f2bf(hi) << 16); }
__device__ __forceinline__ float wave_sum(float v) {
#pragma unroll
    for (int o = 1; o < 64; o <<= 1) v += __shfl_xor(v, o);
    return v;
}
__device__ __forceinline__ float siluf(float v) { return v / (1.f + __expf(-v)); }
__device__ __forceinline__ float sigmoidf(float v) { return 1.f / (1.f + __expf(-v)); }
__device__ __forceinline__ float gelu_tanh(float v) { const float u = 0.7978845608028654f * (v + 0.044715f * v * v * v); return 0.5f * v * (1.f + tanhf(u)); }

struct Params {
    const float* in[33];
    float* out;
    unsigned char* ws;
    int pad0, pad1;
};

struct Ctx {
    int tid, lane, wave, bid, nb;
    int gtid, gthreads, gwave, gwaves;
    unsigned char* ws;
    float* lds;
};

enum { I_X = 0, I_C, I_N1G, I_N2G, I_WADA, I_BADA, I_WIN, I_QNG, I_KNG, I_LQ1, I_LK1, I_LQ2, I_LK2, I_SUBG,
       I_ARE, I_AIM, I_LOGDT, I_BRE, I_BIM, I_CRE, I_CIM, I_SD, I_WGLU, I_SNG, I_WOUT, I_WR, I_RB,
       I_WGE, I_WUE, I_WDE, I_WGS, I_WUS, I_WDS };

struct SG_Args {
    const bf16_t* A; int lda; const int* rowidx;
    const float* W; const float* W2; int ldb;
    size_t wstride;
    const int* tile_e;
    int M, N, K;
};
template <bool DUAL, class Epi>
__device__ __forceinline__ void sgemm_phase(const Ctx& c, const SG_Args g, const Epi& E) {
    float* As = c.lds;
    float* Bs = c.lds + 16 * 132;
    float* Bs2 = Bs + 16 * 128;
    const int tid = c.tid, ty = tid >> 5, tx = tid & 31;
    const int nMt = g.M / 128, nNt = g.N / 128, ntile = nMt * nNt;
    for (int tile = c.bid; tile < ntile; tile += c.nb) {
        const int mt = tile / nNt, nt = tile % nNt;
        const float* W = g.W; const float* W2 = g.W2;
        if (g.tile_e) { const int e = g.tile_e[mt >> 1]; if (e < 0) continue; W += (size_t)e * g.wstride; if (DUAL) W2 += (size_t)e * g.wstride; }
        f32x4 acc[8], acc2[8];
#pragma unroll
        for (int i = 0; i < 8; ++i) { acc[i] = (f32x4){0.f, 0.f, 0.f, 0.f}; acc2[i] = (f32x4){0.f, 0.f, 0.f, 0.f}; }
        const int arow = mt * 128 + (tid >> 2), akq = (tid & 3) * 4;
        const int asrc = g.rowidx ? g.rowidx[arow] : arow;
        const bf16_t* ap = g.A + (size_t)asrc * g.lda + akq;
        const int bk = tid >> 5, bn = (tid & 31) * 4;
        const float* bp = W + (size_t)bk * g.ldb + nt * 128 + bn;
        const float* bp2 = DUAL ? (W2 + (size_t)bk * g.ldb + nt * 128 + bn) : nullptr;
#pragma unroll 1
        for (int k0 = 0; k0 < g.K; k0 += 16) {
            const u32x2 av = *(const u32x2*)(ap + k0);
            const f32x4 bv = *(const f32x4*)(bp + (size_t)k0 * g.ldb);
            f32x4 bv2 = {0.f, 0.f, 0.f, 0.f};
            if (DUAL) bv2 = *(const f32x4*)(bp2 + (size_t)k0 * g.ldb);
            __syncthreads();
            As[(akq + 0) * 132 + (tid >> 2)] = __uint_as_float(av.x << 16);
            As[(akq + 1) * 132 + (tid >> 2)] = __uint_as_float(av.x & 0xffff0000u);
            As[(akq + 2) * 132 + (tid >> 2)] = __uint_as_float(av.y << 16);
            As[(akq + 3) * 132 + (tid >> 2)] = __uint_as_float(av.y & 0xffff0000u);
            *(f32x4*)(Bs + bk * 128 + bn) = bv;
            if (DUAL) *(f32x4*)(Bs2 + bk * 128 + bn) = bv2;
            __syncthreads();
#pragma unroll
            for (int kk = 0; kk < 16; ++kk) {
                const f32x4 a0 = *(const f32x4*)(As + kk * 132 + ty * 8), a1 = *(const f32x4*)(As + kk * 132 + ty * 8 + 4);
                const f32x4 b = *(const f32x4*)(Bs + kk * 128 + tx * 4);
                const float a[8] = {a0.x, a0.y, a0.z, a0.w, a1.x, a1.y, a1.z, a1.w};
#pragma unroll
                for (int i = 0; i < 8; ++i) acc[i] += a[i] * b;
                if (DUAL) {
                    const f32x4 b2 = *(const f32x4*)(Bs2 + kk * 128 + tx * 4);
#pragma unroll
                    for (int i = 0; i < 8; ++i) acc2[i] += a[i] * b2;
                }
            }
        }
#pragma unroll
        for (int i = 0; i < 8; ++i) E(mt * 128 + ty * 8 + i, nt * 128 + tx * 4, acc[i], acc2[i], tx);
    }
}

__device__ __forceinline__ void ph_prologue(const Ctx& c, const Params& p) {
    float* mod = (float*)(c.ws + WS_MOD);
    for (int idx = c.gtid; idx < NB * 6 * DM; idx += c.gthreads) {
        const int b = idx / (6 * DM), j = idx % (6 * DM);
        const float* cc = p.in[I_C] + b * DM; const float* w = p.in[I_WADA] + j;
        float acc = p.in[I_BADA][j];
#pragma unroll 8
        for (int k = 0; k < DM; ++k) acc += siluf(cc[k]) * w[(size_t)k * (6 * DM)];
        mod[idx] = acc;
    }
    float* ropec = (float*)(c.ws + WS_ROPE); float* ropes = ropec + SEQ * 32;
    for (int idx = c.gtid; idx < SEQ * 32; idx += c.gthreads) {
        const int l = idx >> 5, i = idx & 31;
        const double invf = exp(-log(10000.0) * (double)(2 * i) / 64.0);
        const double ang = (double)l * invf;
        ropec[idx] = (float)cos(ang); ropes[idx] = (float)sin(ang);
    }
    float* sp = (float*)(c.ws + WS_SSMP);
    float* abr = sp, * abi = sp + SG * SP, * bbr = sp + 2 * SG * SP, * bbi = bbr + SG * SP * SC;
    for (int idx = c.gtid; idx < SG * SP; idx += c.gthreads) {
        const int g = idx / SP;
        const double are = p.in[I_ARE][idx], aim = p.in[I_AIM][idx], dt = exp((double)p.in[I_LOGDT][g]);
        const double mag = exp(are * dt), ar = mag * cos(aim * dt), ai = mag * sin(aim * dt);
        abr[idx] = (float)ar; abi[idx] = (float)ai;
        const double den = are * are + aim * aim, nr = ar - 1.0;
        const double fre = (nr * are + ai * aim) / den, fim = (ai * are - nr * aim) / den;
        for (int ch = 0; ch < SC; ++ch) {
            const double br = p.in[I_BRE][idx * SC + ch], bi = p.in[I_BIM][idx * SC + ch];
            bbr[idx * SC + ch] = (float)(fre * br - fim * bi); bbi[idx * SC + ch] = (float)(fre * bi + fim * br);
        }
    }
    if (c.gtid == 0) {
        float s1 = 0.f, s2 = 0.f, gq = 0.f, gk = 0.f;
        for (int i = 0; i < HD; ++i) { s1 += p.in[I_LQ1][i] * p.in[I_LK1][i]; s2 += p.in[I_LQ2][i] * p.in[I_LK2][i];
            gq = fmaxf(gq, fabsf(p.in[I_QNG][i])); gk = fmaxf(gk, fabsf(p.in[I_KNG][i])); }
        float* lam = (float*)(c.ws + WS_LAM);
        lam[0] = __expf(s1) - __expf(s2) + LAM_INIT;
        lam[1] = 0.125f * 64.f * gq * gk;
    }
    int* stok = (int*)(c.ws + WS_SLOT_TOK); int* sasg = (int*)(c.ws + WS_SLOT_ASG); float* sgate = (float*)(c.ws + WS_SLOT_GATE);
    for (int idx = c.gtid; idx < NS_MAX; idx += c.gthreads) { stok[idx] = 0; sasg[idx] = -1; sgate[idx] = 0.f; }
    int* te = (int*)(c.ws + WS_TILE_E);
    for (int idx = c.gtid; idx < NS_MAX / 256; idx += c.gthreads) te[idx] = -1;
}

__device__ __forceinline__ void ph_h1(const Ctx& c, const Params& p) {
    const float* mod = (const float*)(c.ws + WS_MOD); bf16_t* H = (bf16_t*)(c.ws + WS_H);
    for (int t = c.gwave; t < T; t += c.gwaves) {
        const int b = t / SEQ; const f32x4* xr = (const f32x4*)(p.in[I_X] + (size_t)t * DM) + c.lane;
        f32x4 v[4]; float s = 0.f;
#pragma unroll
        for (int j = 0; j < 4; ++j) { v[j] = xr[64 * j]; s += v[j].x * v[j].x + v[j].y * v[j].y + v[j].z * v[j].z + v[j].w * v[j].w; }
        const float rstd = rsqrtf(wave_sum(s) * (1.f / DM) + EPS);
        const float* sh = mod + b * 6 * DM, * sc = sh + DM;
#pragma unroll
        for (int j = 0; j < 4; ++j) { const int col = 4 * c.lane + 256 * j;
            const f32x4 g = *(const f32x4*)(p.in[I_N1G] + col), s1 = *(const f32x4*)(sc + col), h1 = *(const f32x4*)(sh + col);
            const f32x4 o = (v[j] * rstd * g) * (1.f + s1) + h1;
            u32x2 w; w.x = pk2(o.x, o.y); w.y = pk2(o.z, o.w); *(u32x2*)(H + (size_t)t * DM + col) = w; }
    }
}

struct EpiWin {
    bf16_t* QK; bf16_t* V; bf16_t* AP;
    __device__ __forceinline__ void operator()(int row, int col, const f32x4& a, const f32x4&, int) const {
        u32x2 w; w.x = pk2(a[0], a[1]); w.y = pk2(a[2], a[3]);
        if (col < 1024) *(u32x2*)(QK + (size_t)row * 1024 + col) = w;
        else if (col < 1536) *(u32x2*)(V + (size_t)row * 512 + (col - 1024)) = w;
        else { const int cc = col - 1536, g = cc >> 4, ch = cc & 15, b = row / SEQ, l = row % SEQ;
            *(u32x2*)(AP + ((size_t)(g * (NB * NCHUNK) + b * NCHUNK + (l >> 4)) * APK + (l & 15) * 16 + ch)) = w; }
    }
};

__device__ __forceinline__ void ph_qkn(const Ctx& c, const Params& p) {
    bf16_t* QK = (bf16_t*)(c.ws + WS_QK);
    const float* ropec = (const float*)(c.ws + WS_ROPE); const float* ropes = ropec + SEQ * 32;
    const int l = c.lane;
    const float gq = p.in[I_QNG][l], gk = p.in[I_KNG][l];
    for (int t = c.gwave; t < T; t += c.gwaves) {
        const int pos = t % SEQ; const float cs = ropec[pos * 32 + (l & 31)], sn = ropes[pos * 32 + (l & 31)];
        bf16_t* r = QK + (size_t)t * 1024;
#pragma unroll 4
        for (int gi = 0; gi < 16; ++gi) {
            const float v = bf2f(r[gi * 64 + l]);
            const float rstd = rsqrtf(wave_sum(v * v) * (1.f / 64.f) + EPS);
            const float y = v * rstd * (gi < 8 ? gq : gk);
            const float o = __shfl_xor(y, 32);
            const float res = (l < 32) ? (y * cs - o * sn) : (o * sn + y * cs);
            r[gi * 64 + l] = f2bf(res);
        }
    }
}

__device__ __forceinline__ void ph_att_base(const Ctx& c, const Params& p) {
    const bf16_t* QK = (const bf16_t*)(c.ws + WS_QK); const bf16_t* V = (const bf16_t*)(c.ws + WS_V); float* AO = (float*)(c.ws + WS_ATTO);
    const float smax = ((const float*)(c.ws + WS_LAM))[1];
    const int nitem = NB * NH * 4 * (SEQ / 64);
    for (int it = c.gwave; it < nitem; it += c.gwaves) {
        const int qb = (SEQ / 64 - 1) - (it / (NB * NH * 4)), bhc = it % (NB * NH * 4), b = bhc / (NH * 4), h = (bhc >> 2) % NH, cc = (bhc >> 1) & 1, vh = bhc & 1;
        const int q = qb * 64 + c.lane; const size_t trow = (size_t)b * SEQ + q;
        float qv[64];
        { const bf16_t* qp = QK + trow * 1024 + h * 128 + cc * 64;
#pragma unroll
          for (int d = 0; d < 64; ++d) qv[d] = bf2f(qp[d]) * 0.125f; }
        float o[64];
#pragma unroll
        for (int d = 0; d < 64; ++d) o[d] = 0.f;
        float lsum = 0.f;
        const int jmax = qb * 64 + 63;
        for (int j = 0; j <= jmax; ++j) {
            const size_t krow = (size_t)b * SEQ + j;
            const u32x4* kp = (const u32x4*)(QK + krow * 1024 + 512 + h * 128 + cc * 64);
            float s = 0.f;
#pragma unroll
            for (int i = 0; i < 8; ++i) { const u32x4 kk = kp[i];
                s += qv[8 * i + 0] * __uint_as_float(kk.x << 16) + qv[8 * i + 1] * __uint_as_float(kk.x & 0xffff0000u)
                   + qv[8 * i + 2] * __uint_as_float(kk.y << 16) + qv[8 * i + 3] * __uint_as_float(kk.y & 0xffff0000u)
                   + qv[8 * i + 4] * __uint_as_float(kk.z << 16) + qv[8 * i + 5] * __uint_as_float(kk.z & 0xffff0000u)
                   + qv[8 * i + 6] * __uint_as_float(kk.w << 16) + qv[8 * i + 7] * __uint_as_float(kk.w & 0xffff0000u); }
            float pe = (j <= q) ? __expf(s - smax) : 0.f;
            lsum += pe;
            const u32x4* vp = (const u32x4*)(V + krow * 512 + h * 128 + vh * 64);
#pragma unroll
            for (int i = 0; i < 8; ++i) { const u32x4 vv = vp[i];
                o[8 * i + 0] += pe * __uint_as_float(vv.x << 16); o[8 * i + 1] += pe * __uint_as_float(vv.x & 0xffff0000u);
                o[8 * i + 2] += pe * __uint_as_float(vv.y << 16); o[8 * i + 3] += pe * __uint_as_float(vv.y & 0xffff0000u);
                o[8 * i + 4] += pe * __uint_as_float(vv.z << 16); o[8 * i + 5] += pe * __uint_as_float(vv.z & 0xffff0000u);
                o[8 * i + 6] += pe * __uint_as_float(vv.w << 16); o[8 * i + 7] += pe * __uint_as_float(vv.w & 0xffff0000u); }
        }
        const float rl = 1.f / lsum;
        float* op = AO + (trow * 8 + h * 2 + cc) * 128 + vh * 64;
#pragma unroll
        for (int d = 0; d < 64; d += 4) *(f32x4*)(op + d) = (f32x4){o[d] * rl, o[d + 1] * rl, o[d + 2] * rl, o[d + 3] * rl};
    }
}
__device__ __forceinline__ void ph_att_comb(const Ctx& c, const Params& p) {
    const float* AO = (const float*)(c.ws + WS_ATTO); bf16_t* MX = (bf16_t*)(c.ws + WS_MIXIN);
    const float lam = ((const float*)(c.ws + WS_LAM))[0];
    for (int it = c.gwave; it < T * NH; it += c.gwaves) {
        const int t = it >> 2, h = it & 3;
        const float* o1 = AO + ((size_t)t * 8 + h * 2) * 128, * o2 = o1 + 128;
        const float a = o1[c.lane] - lam * o2[c.lane], b = o1[64 + c.lane] - lam * o2[64 + c.lane];
        const float rstd = rsqrtf(wave_sum(a * a + b * b) * (1.f / 128.f) + EPS) * (1.f - LAM_INIT);
        MX[(size_t)t * 1024 + h * 128 + c.lane] = f2bf(a * rstd * p.in[I_SUBG][c.lane]);
        MX[(size_t)t * 1024 + h * 128 + 64 + c.lane] = f2bf(b * rstd * p.in[I_SUBG][64 + c.lane]);
    }
}

__device__ __forceinline__ void ph_ssm_base(const Ctx& c, const Params& p) {
    const bf16_t* AP = (const bf16_t*)(c.ws + WS_AP); bf16_t* Y = (bf16_t*)(c.ws + WS_Y);
    const float* sp = (const float*)(c.ws + WS_SSMP);
    const float* abr = sp, * abi = sp + SG * SP, * bbr = sp + 2 * SG * SP, * bbi = bbr + SG * SP * SC;
    for (int it = c.gwave; it < NB * SG; it += c.gwaves) {
        const int b = it / SG, g = it % SG, pp = c.lane;
        const float ar = abr[g * SP + pp], ai = abi[g * SP + pp];
        float br[16], bi[16], cr[16], ci[16];
#pragma unroll
        for (int ch = 0; ch < 16; ++ch) { br[ch] = bbr[(g * SP + pp) * SC + ch]; bi[ch] = bbi[(g * SP + pp) * SC + ch];
            cr[ch] = p.in[I_CRE][(g * SC + ch) * SP + pp]; ci[ch] = p.in[I_CIM][(g * SC + ch) * SP + pp]; }
        const float dsk = (pp < 16) ? p.in[I_SD][g * SC + pp] : 0.f;
        float sr = 0.f, si = 0.f;
        for (int l = 0; l < SEQ; ++l) {
            const bf16_t* up = AP + ((size_t)(g * (NB * NCHUNK) + b * NCHUNK + (l >> 4)) * APK + (l & 15) * 16);
            const u32x4 u0 = *(const u32x4*)up, u1 = *(const u32x4*)(up + 8);
            float u[16] = { __uint_as_float(u0.x << 16), __uint_as_float(u0.x & 0xffff0000u), __uint_as_float(u0.y << 16), __uint_as_float(u0.y & 0xffff0000u),
                            __uint_as_float(u0.z << 16), __uint_as_float(u0.z & 0xffff0000u), __uint_as_float(u0.w << 16), __uint_as_float(u0.w & 0xffff0000u),
                            __uint_as_float(u1.x << 16), __uint_as_float(u1.x & 0xffff0000u), __uint_as_float(u1.y << 16), __uint_as_float(u1.y & 0xffff0000u),
                            __uint_as_float(u1.z << 16), __uint_as_float(u1.z & 0xffff0000u), __uint_as_float(u1.w << 16), __uint_as_float(u1.w & 0xffff0000u) };
            float bur = 0.f, bui = 0.f;
#pragma unroll
            for (int ch = 0; ch < 16; ++ch) { bur += u[ch] * br[ch]; bui += u[ch] * bi[ch]; }
            const float nr = ar * sr - ai * si + bur, ni = ar * si + ai * sr + bui; sr = nr; si = ni;
            float mine = 0.f;
#pragma unroll
            for (int ch = 0; ch < 16; ++ch) { const float v = wave_sum(sr * cr[ch] - si * ci[ch]); if (pp == ch) mine = v + dsk * u[ch]; }
            if (pp < 16) Y[((size_t)b * SEQ + l) * 512 + g * 16 + pp] = f2bf(gelu_tanh(mine));
        }
    }
}

struct EpiGlu {
    const bf16_t* Y; bf16_t* MX; float* ss;
    __device__ __forceinline__ void operator()(int row, int col, const f32x4& a, const f32x4&, int) const {
        const u32x2 yv = *(const u32x2*)(Y + (size_t)row * 512 + col);
        const float y0 = __uint_as_float(yv.x << 16), y1 = __uint_as_float(yv.x & 0xffff0000u), y2 = __uint_as_float(yv.y << 16), y3 = __uint_as_float(yv.y & 0xffff0000u);
        const float v0 = y0 * sigmoidf(a[0]), v1 = y1 * sigmoidf(a[1]), v2 = y2 * sigmoidf(a[2]), v3 = y3 * sigmoidf(a[3]);
        u32x2 w; w.x = pk2(v0, v1); w.y = pk2(v2, v3); *(u32x2*)(MX + (size_t)row * 1024 + 512 + col) = w;
        float s = v0 * v0 + v1 * v1 + v2 * v2 + v3 * v3;
#pragma unroll
        for (int o = 1; o < 32; o <<= 1) s += __shfl_xor(s, o);
        if ((threadIdx.x & 31) == 0) atomicAdd(ss + row, s);
    }
};
__device__ __forceinline__ void ph_ssm_norm(const Ctx& c, const Params& p) {
    bf16_t* MX = (bf16_t*)(c.ws + WS_MIXIN); const float* ss = (const float*)(c.ws + WS_CTL + CTL_SS1);
    for (int t = c.gwave; t < T; t += c.gwaves) {
        const float rstd = rsqrtf(ss[t] * (1.f / 512.f) + EPS);
        bf16_t* r = MX + (size_t)t * 1024 + 512 + c.lane * 8; const float* g = p.in[I_SNG] + c.lane * 8;
        u32x4 w = *(u32x4*)r; unsigned* wp = (unsigned*)&w;
#pragma unroll
        for (int i = 0; i < 4; ++i) { const float a = __uint_as_float(wp[i] << 16) * rstd * g[2 * i], b = __uint_as_float(wp[i] & 0xffff0000u) * rstd * g[2 * i + 1]; wp[i] = pk2(a, b); }
        *(u32x4*)r = w;
    }
}
struct EpiWout {
    const float* x; const float* mod; float* out; float* ss;
    __device__ __forceinline__ void operator()(int row, int col, const f32x4& a, const f32x4&, int) const {
        const int b = row / SEQ; const f32x4 xv = *(const f32x4*)(x + (size_t)row * DM + col), g1 = *(const f32x4*)(mod + b * 6 * DM + 2 * DM + col);
        const f32x4 o = {xv.x + g1.x * a[0], xv.y + g1.y * a[1], xv.z + g1.z * a[2], xv.w + g1.w * a[3]};
        *(f32x4*)(out + (size_t)row * DM + col) = o;
        float s = o.x * o.x + o.y * o.y + o.z * o.z + o.w * o.w;
#pragma unroll
        for (int of = 1; of < 32; of <<= 1) s += __shfl_xor(s, of);
        if ((threadIdx.x & 31) == 0) atomicAdd(ss + row, s);
    }
};
__device__ __forceinline__ void ph_h2(const Ctx& c, const Params& p) {
    const float* mod = (const float*)(c.ws + WS_MOD); bf16_t* H = (bf16_t*)(c.ws + WS_H);
    const float* ss = (const float*)(c.ws + WS_CTL + CTL_SS2);
    for (int t = c.gwave; t < T; t += c.gwaves) {
        const int b = t / SEQ; const f32x4* xr = (const f32x4*)(p.out + (size_t)t * DM) + c.lane;
        const float rstd = rsqrtf(ss[t] * (1.f / DM) + EPS);
        const float* sh = mod + b * 6 * DM + 3 * DM, * sc = sh + DM;
#pragma unroll
        for (int j = 0; j < 4; ++j) { const int col = 4 * c.lane + 256 * j; const f32x4 v = xr[64 * j];
            const f32x4 g = *(const f32x4*)(p.in[I_N2G] + col), s1 = *(const f32x4*)(sc + col), h1 = *(const f32x4*)(sh + col);
            const f32x4 o = (v * rstd * g) * (1.f + s1) + h1;
            u32x2 w; w.x = pk2(o.x, o.y); w.y = pk2(o.z, o.w); *(u32x2*)(H + (size_t)t * DM + col) = w; }
    }
}
struct EpiLogits { float* L; __device__ __forceinline__ void operator()(int row, int col, const f32x4& a, const f32x4&, int) const { *(f32x4*)(L + (size_t)row * 256 + col) = (f32x4){a[0], a[1], a[2], a[3]}; } };
struct EpiSwiglu { bf16_t* O; int ldo;
    __device__ __forceinline__ void operator()(int row, int col, const f32x4& a, const f32x4& b, int) const {
        u32x2 w; w.x = pk2(siluf(a[0]) * b[0], siluf(a[1]) * b[1]); w.y = pk2(siluf(a[2]) * b[2], siluf(a[3]) * b[3]); *(u32x2*)(O + (size_t)row * ldo + col) = w; } };

__device__ __forceinline__ void ph_route(const Ctx& c, const Params& p) {
    const float* L = (const float*)(c.ws + WS_LOGITS);
    int* eidx = (int*)(c.ws + WS_EIDX); float* gw = (float*)(c.ws + WS_GATEW); unsigned* counts = (unsigned*)(c.ws + WS_CTL) + CW_COUNTS;
    const int l = c.lane; const float NEG = -__builtin_inff();
    float rb[4];
#pragma unroll
    for (int r = 0; r < 4; ++r) rb[r] = p.in[I_RB][l + 64 * r];
    for (int t = c.gwave; t < T; t += c.gwaves) {
        float s[4], sb[4];
#pragma unroll
        for (int r = 0; r < 4; ++r) { s[r] = sigmoidf(L[(size_t)t * 256 + l + 64 * r]); sb[r] = s[r] + rb[r]; }
        float gs[4];
#pragma unroll
        for (int r = 0; r < 4; ++r) {
            float m1 = sb[r]; int i1 = l;
#pragma unroll
            for (int o = 1; o < 32; o <<= 1) { const float om = __shfl_xor(m1, o); const int oi = __shfl_xor(i1, o); if (om > m1 || (om == m1 && oi < i1)) { m1 = om; i1 = oi; } }
            float m2 = (l == i1) ? NEG : sb[r];
#pragma unroll
            for (int o = 1; o < 32; o <<= 1) m2 = fmaxf(m2, __shfl_xor(m2, o));
            gs[r] = m1 + m2;
        }
        float gsc[8];
#pragma unroll
        for (int r = 0; r < 4; ++r) { gsc[2 * r] = __shfl(gs[r], 0); gsc[2 * r + 1] = __shfl(gs[r], 32); }
        unsigned gmask = 0;
#pragma unroll
        for (int a = 0; a < 8; ++a) { int rank = 0;
#pragma unroll
            for (int b2 = 0; b2 < 8; ++b2) rank += (gsc[b2] > gsc[a] || (gsc[b2] == gsc[a] && b2 < a)) ? 1 : 0;
            if (rank < TOPG) gmask |= 1u << a; }
        float mv[4];
#pragma unroll
        for (int r = 0; r < 4; ++r) mv[r] = ((gmask >> (2 * r + (l >> 5))) & 1u) ? sb[r] : NEG;
        float wsel = 0.f; int esel = -1; float wsum = 0.f;
#pragma unroll
        for (int k = 0; k < TOPK; ++k) {
            float bm = mv[0]; int bi = l;
#pragma unroll
            for (int r = 1; r < 4; ++r) if (mv[r] > bm) { bm = mv[r]; bi = l + 64 * r; }
#pragma unroll
            for (int o = 1; o < 64; o <<= 1) { const float om = __shfl_xor(bm, o); const int oi = __shfl_xor(bi, o); if (om > bm || (om == bm && oi < bi)) { bm = om; bi = oi; } }
            float sv = 0.f;
#pragma unroll
            for (int r = 0; r < 4; ++r) if (bi == l + 64 * r) { sv = s[r]; mv[r] = NEG; }
            sv = __shfl(sv, bi & 63);
            wsum += sv;
            if (l == k) { wsel = sv; esel = bi; }
        }
        if (l < TOPK) { eidx[t * 8 + l] = esel; gw[t * 8 + l] = wsel / wsum * ROUTED_SCALE; atomicAdd(counts + esel, 1u); }
    }
}
__device__ __forceinline__ void ph_slot(const Ctx& c, const Params& p) {
    const unsigned* counts = (const unsigned*)(c.ws + WS_CTL) + CW_COUNTS; unsigned* cursor = (unsigned*)(c.ws + WS_CTL) + CW_CURSOR;
    int* ps = (int*)c.lds;
    if (c.tid == 0) { int acc = 0; for (int e = 0; e < NE; ++e) { ps[e] = acc; acc += ((int)counts[e] + 255) / 256 * 256; } ps[NE] = acc; }
    __syncthreads();
    const int* eidx = (const int*)(c.ws + WS_EIDX); const float* gw = (const float*)(c.ws + WS_GATEW);
    int* stok = (int*)(c.ws + WS_SLOT_TOK); int* sasg = (int*)(c.ws + WS_SLOT_ASG); float* sgate = (float*)(c.ws + WS_SLOT_GATE);
    for (int a = c.gtid; a < T * TOPK; a += c.gthreads) {
        const int e = eidx[a]; const unsigned pos = atomicAdd(cursor + e, 1u); const int slot = ps[e] + (int)pos;
        stok[slot] = a >> 3; sasg[slot] = a; sgate[slot] = gw[a];
    }
    if (c.bid == 0) {
        int* te = (int*)(c.ws + WS_TILE_E); int* padst = (int*)(c.ws + WS_PADST);
        for (int e = c.tid; e <= NE; e += 512) padst[e] = ps[e];
        for (int e = c.tid; e < NE; e += 512) for (int tl = ps[e] / 256; tl < ps[e + 1] / 256; ++tl) te[tl] = e;
        if (c.tid == 0) ((unsigned*)(c.ws + WS_CTL))[CW_NTILES] = (unsigned)(ps[NE] / 256);
    }
}
struct EpiE2 { const int* sasg; const float* sgate; bf16_t* YA;
    __device__ __forceinline__ void operator()(int row, int col, const f32x4& a, const f32x4&, int) const {
        const int asg = sasg[row]; if (asg < 0) return; const float g = sgate[row];
        u32x2 w; w.x = pk2(g * a[0], g * a[1]); w.y = pk2(g * a[2], g * a[3]); *(u32x2*)(YA + (size_t)asg * DM + col) = w; } };
struct EpiSD { const float* mod; float* out;
    __device__ __forceinline__ void operator()(int row, int col, const f32x4& a, const f32x4&, int) const {
        const int b = row / SEQ; const f32x4 g2 = *(const f32x4*)(mod + b * 6 * DM + 5 * DM + col); f32x4* o = (f32x4*)(out + (size_t)row * DM + col);
        f32x4 v = *o; v.x += g2.x * a[0]; v.y += g2.y * a[1]; v.z += g2.z * a[2]; v.w += g2.w * a[3]; *o = v; } };
__device__ __forceinline__ void ph_combine(const Ctx& c, const Params& p) {
    const float* mod = (const float*)(c.ws + WS_MOD); const bf16_t* YA = (const bf16_t*)(c.ws + WS_YA); float* out = p.out;
    for (int idx = c.gtid; idx < T * (DM / 8); idx += c.gthreads) {
        const int t = idx >> 7, col = (idx & 127) * 8, b = t / SEQ;
        float s[8] = {0.f, 0.f, 0.f, 0.f, 0.f, 0.f, 0.f, 0.f};
#pragma unroll
        for (int k = 0; k < 8; ++k) { const u32x4 w = *(const u32x4*)(YA + ((size_t)t * 8 + k) * DM + col); const unsigned* wp = (const unsigned*)&w;
#pragma unroll
            for (int i = 0; i < 4; ++i) { s[2 * i] += __uint_as_float(wp[i] << 16); s[2 * i + 1] += __uint_as_float(wp[i] & 0xffff0000u); } }
        const float* g2 = mod + b * 6 * DM + 5 * DM + col; float* o = out + (size_t)t * DM + col;
        f32x4 o0 = *(f32x4*)o, o1 = *(f32x4*)(o + 4);
        o0.x += g2[0] * s[0]; o0.y += g2[1] * s[1]; o0.z += g2[2] * s[2]; o0.w += g2[3] * s[3];
        o1.x += g2[4] * s[4]; o1.y += g2[5] * s[5]; o1.z += g2[6] * s[6]; o1.w += g2[7] * s[7];
        *(f32x4*)o = o0; *(f32x4*)(o + 4) = o1;
    }
}


#define GAS __attribute__((address_space(1)))
#define LAS __attribute__((address_space(3)))
#define XB_TMO      128
#define XB_XCNT(j)  (256  + 64 * (j))
#define XB_XSUB(j)  (1280 + 64 * (j))
#define XB_XGEN(j)  (2304 + 64 * (j))
#define XB_TOP      3328
#define XB_TOPGEN   3392
#define XCD_BAR_WORDS 3456
#define XB_SPIN_CAP (1u << 18)

__device__ __forceinline__ unsigned xb_ld(unsigned* p)              { return __hip_atomic_load(p, __ATOMIC_RELAXED, __HIP_MEMORY_SCOPE_AGENT); }
__device__ __forceinline__ unsigned xb_add(unsigned* p, unsigned v) { return __hip_atomic_fetch_add(p, v, __ATOMIC_RELAXED, __HIP_MEMORY_SCOPE_AGENT); }
__device__ __forceinline__ unsigned xb_xcc_id() { return (unsigned)__builtin_amdgcn_s_getreg((3 << 11) | 20) & 0xFu; }
#define XB_SPIN(cond, bar) do { unsigned _sp = 0; while (cond) { __builtin_amdgcn_s_sleep(1); \
    if ((++_sp & 255u) == 0u) { if (xb_ld(&(bar)[XB_TMO])) break; if (_sp > XB_SPIN_CAP) { atomicAdd(&(bar)[XB_TMO], 1u); break; } } } } while (0)

struct XcdBarrier {
    unsigned* bar; unsigned x;
    volatile LAS unsigned* st;
};

__device__ __forceinline__ XcdBarrier xcd_barrier_post(unsigned* bar, volatile LAS unsigned* st) {
    XcdBarrier b; b.bar = bar; b.x = xb_xcc_id(); b.st = st;
    if (threadIdx.x == 0) (void)xb_add(&bar[XB_XCNT(b.x)], 1u);
    return b;
}
__device__ __forceinline__ void xcd_barrier_complete(unsigned* bar, unsigned x, unsigned& nloc, unsigned& nx) {
    const unsigned G = gridDim.x * gridDim.y * gridDim.z;
    unsigned sum, cnt, mine, sp = 0u;
    for (;;) {
        sum = 0u; cnt = 0u; mine = 0u;
#pragma unroll
        for (unsigned j = 0; j < 16; ++j) { const unsigned c = xb_ld(&bar[XB_XCNT(j)]); sum += c; cnt += (c > 0u) ? 1u : 0u; mine = (j == x) ? c : mine; }
        if (sum == G) break;
        __builtin_amdgcn_s_sleep(1);
        if ((++sp & 255u) == 0u) { if (xb_ld(&bar[XB_TMO])) break; if (sp > XB_SPIN_CAP) { atomicAdd(&bar[XB_TMO], 1u); break; } }
    }
    nloc = mine > 0u ? mine : 1u; nx = cnt > 0u ? cnt : 1u;
}

__device__ __forceinline__ void xcd_barrier(const XcdBarrier& b) {
    asm volatile("s_waitcnt vmcnt(0)" ::: "memory");
    __syncthreads();
    if (threadIdx.x == 0) {
        unsigned* bar = b.bar;
        __builtin_amdgcn_s_waitcnt(0);
        unsigned nloc = b.st[0], nx = b.st[1];
        if (nloc == 0u) { xcd_barrier_complete(bar, b.x, nloc, nx); b.st[0] = nloc; b.st[1] = nx; }
        const unsigned old = xb_add(&bar[XB_XSUB(b.x)], 1u);
        const unsigned gen = old / nloc;
        if (old + 1u == (gen + 1u) * nloc) {
            __builtin_amdgcn_fence(__ATOMIC_RELEASE, "agent");
            asm volatile("s_waitcnt vmcnt(0)" ::: "memory");
            const unsigned og = xb_add(&bar[XB_TOP], 1u);
            const unsigned tg = og / nx;
            if (og + 1u == (tg + 1u) * nx) xb_add(&bar[XB_TOPGEN], 1u);
            else XB_SPIN(xb_ld(&bar[XB_TOPGEN]) == tg, bar);
            __builtin_amdgcn_fence(__ATOMIC_ACQUIRE, "agent");
            xb_add(&bar[XB_XGEN(b.x)], 1u);
            asm volatile("s_waitcnt vmcnt(0)" ::: "memory");
        } else {
            XB_SPIN(xb_ld(&bar[XB_XGEN(b.x)]) == gen, bar);
            __builtin_amdgcn_fence(__ATOMIC_ACQUIRE, "agent");
            asm volatile("s_waitcnt vmcnt(0)" ::: "memory");
        }
    }
    __syncthreads();
}

namespace pg8 {
#define PG8_LAS __attribute__((address_space(3)))
typedef short bf16x8 __attribute__((ext_vector_type(8)));
constexpr int BM = 256, BK = 64, HALF = 128, HTB = HALF * BK * 2  , STAGE_BYTES = 8 * HTB;

__host__ __device__ __forceinline__ int lds_byte(int r, int c) { const int st = (r >> 4) * 2 + (c >> 5), rr = r & 15, cc = c & 31, ob = rr * 64 + cc * 2; return st * 1024 + (ob ^ (((ob >> 9) & 1) << 5)); }
__host__ __device__ __forceinline__ void stage_rc(int b, int& R, int& C) { const int st = b / 1024, sb = b % 1024, swz = sb ^ (((sb >> 9) & 1) << 5); R = (st >> 1) * 16 + swz / 64; C = (st & 1) * 32 + (swz % 64) / 2; }
__host__ __device__ __forceinline__ int perm32(int rho) { const int n = rho >> 4, i = rho & 15; return 8 * (i >> 2) + 4 * n + (i & 3); }

struct Unit { int pm, pn, pb; };
struct Gemm { const bf16_t* A; const bf16_t* Bt; int K, lda; const int* rowidx; };

__device__ __forceinline__ unsigned cvt_pk_bf16(float lo, float hi) { unsigned r; asm volatile("v_cvt_pk_bf16_f32 %0, %1, %2" : "=v"(r) : "v"(lo), "v"(hi)); return r; }

template <class Epi, class Sched, bool GATHER, bool ALIGN_EPI>
__device__ __forceinline__ void gemm_phase(PG8_LAS unsigned char* lds, const Gemm g, const Sched& S, const Epi& E) {
    int tid_ = threadIdx.x; asm volatile("" : "+v"(tid_));
    const int tid = tid_, wid = __builtin_amdgcn_readfirstlane(tid >> 6), lane = tid & 63, wr = wid >> 2, wc = wid & 3, fr = lane & 15, fq = lane >> 4;
    const int K = g.K, nt = K / BK, lda = g.lda;
    unsigned voffB[2], oc[2][2], on[2][2];
#pragma unroll
    for (int i = 0; i < 2; ++i) { int R, C; stage_rc(tid * 16 + i * 8192, R, C); const int Rb = Epi::PERM ? ((R & ~31) + perm32(R & 31)) : R;
        voffB[i] = (unsigned)(Rb * K + C) * 2u;
        oc[0][i] = (unsigned)(R * lda + C) * 2u; oc[1][i] = (unsigned)((R + HALF) * lda + C) * 2u; on[0][i] = oc[0][i]; on[1][i] = oc[1][i]; }
    const size_t kstep = (size_t)(BK * 2);
    const size_t hstep = (size_t)HALF * K * 2;
    const size_t tstepB = 2 * hstep, tstepA = (size_t)BM * lda * 2;
    const unsigned ldsw = (unsigned)wid * 1024u;
    const int aoff = lds_byte(wr * 64 + fr, fq * 8), boff = lds_byte(wc * 32 + fr, fq * 8);
#define PG8_SA(b, h) (((b) * 2 + (h)) * HTB)
#define PG8_SB(b, h) ((4 + (b) * 2 + (h)) * HTB)
#define PG8_STAGE(bufoff, gbase, voff) do { _Pragma("unroll") for (int _i = 0; _i < 2; ++_i) \
        __builtin_amdgcn_global_load_lds((const unsigned*)((const char*)(gbase) + (voff)[_i]), (PG8_LAS unsigned*)(lds + (bufoff) + ldsw + _i * 8192), 16, 0, 0); } while (0)
#define PG8_LDA(dst, b, h) do { _Pragma("unroll") for (int m = 0; m < 4; ++m) _Pragma("unroll") for (int k = 0; k < 2; ++k) dst[m][k] = *(const PG8_LAS bf16x8*)(lds + PG8_SA(b, h) + aoff + m * 2048 + k * 1024); } while (0)
#define PG8_LDB(dst, b, h) do { _Pragma("unroll") for (int n = 0; n < 2; ++n) _Pragma("unroll") for (int k = 0; k < 2; ++k) dst[n][k] = *(const PG8_LAS bf16x8*)(lds + PG8_SB(b, h) + boff + n * 2048 + k * 1024); } while (0)
#define PG8_MMA(ai, bj, At, Bt) do { __builtin_amdgcn_s_setprio(1); _Pragma("unroll") for (int m = 0; m < 4; ++m) _Pragma("unroll") for (int n = 0; n < 2; ++n) _Pragma("unroll") for (int k = 0; k < 2; ++k) \
        acc[ai][bj][m][n] = __builtin_amdgcn_mfma_f32_16x16x32_bf16(Bt[n][k], At[m][k], acc[ai][bj][m][n], 0, 0, 0); __builtin_amdgcn_s_setprio(0); } while (0)
#define PG8_WAIT_V(n) asm volatile("s_waitcnt vmcnt(" #n ")" ::: "memory")
#define PG8_WAIT_L(n) asm volatile("s_waitcnt lgkmcnt(" #n ")" ::: "memory")
#define PG8_BAR __builtin_amdgcn_s_barrier()
#define PG8_SCHED __builtin_amdgcn_sched_barrier(0)
#define PG8_GIDX(dst, unit) do { _Pragma("unroll") for (int _i = 0; _i < 2; ++_i) { int R_, C_; stage_rc(tid * 16 + _i * 8192, R_, C_); \
        const int r0_ = g.rowidx[(unit).pm * BM + R_], r1_ = g.rowidx[(unit).pm * BM + HALF + R_]; \
        dst[0][_i] = (unsigned)(r0_ * lda + C_) * 2u; dst[1][_i] = (unsigned)(r1_ * lda + C_) * 2u; } } while (0)
    Unit cur, nxt; int ui = 0;
    if (!S.next(0, cur)) return;
    f32x4 acc[2][2][4][2];
#pragma unroll
    for (int a = 0; a < 2; ++a)
#pragma unroll
        for (int b = 0; b < 2; ++b)
#pragma unroll
            for (int m = 0; m < 4; ++m)
#pragma unroll
                for (int n = 0; n < 2; ++n) acc[a][b][m][n] = (f32x4){0.f, 0.f, 0.f, 0.f};
    bf16x8 At[4][2], B0[2][2], B1[2][2];
    if constexpr (GATHER) { PG8_GIDX(oc, cur); }
    const char* cA = GATHER ? (const char*)g.A : (const char*)g.A + (size_t)cur.pm * tstepA; const char* cB = (const char*)g.Bt + (size_t)cur.pb * tstepB;
    PG8_STAGE(PG8_SB(0, 0), cB, voffB); PG8_STAGE(PG8_SB(0, 1), cB + hstep, voffB); PG8_STAGE(PG8_SA(0, 0), cA, oc[0]); PG8_STAGE(PG8_SA(0, 1), cA, oc[1]);
    if (wr == 1) PG8_BAR;
    PG8_WAIT_V(2); PG8_BAR;
    PG8_STAGE(PG8_SB(1, 0), cB + kstep, voffB); PG8_STAGE(PG8_SA(1, 0), cA + kstep, oc[0]); PG8_STAGE(PG8_SB(1, 1), cB + hstep + kstep, voffB);
    PG8_WAIT_V(6); PG8_BAR;
    for (;;) {
        const bool has_next = S.next(ui + 1, nxt);
        if constexpr (GATHER) { if (has_next) { PG8_GIDX(on, nxt); } }
        const char* nA = has_next ? (GATHER ? (const char*)g.A : (const char*)g.A + (size_t)nxt.pm * tstepA) : cA; const char* nB = has_next ? (const char*)g.Bt + (size_t)nxt.pb * tstepB : cB;
#pragma unroll 1
        for (int t = 0; t < nt; t += 2) {
            const bool last = (t == nt - 2);
            const char* a1 = cA + (size_t)(t + 1) * kstep;
            const char* a2 = last ? nA : cA + (size_t)(t + 2) * kstep; const char* b2 = last ? nB : cB + (size_t)(t + 2) * kstep;
            const char* a3 = a2 + kstep; const char* b3 = b2 + kstep;
            PG8_LDB(B0, 0, 0); PG8_LDB(B1, 0, 1); PG8_SCHED; PG8_LDA(At, 0, 0); PG8_STAGE(PG8_SA(1, 1), a1, oc[1]);
            if constexpr (GATHER) { if (last && has_next) { oc[0][0] = on[0][0]; oc[0][1] = on[0][1]; oc[1][0] = on[1][0]; oc[1][1] = on[1][1]; } }
            PG8_WAIT_V(8); PG8_WAIT_L(0); PG8_BAR; PG8_MMA(0, 0, At, B0); PG8_MMA(0, 1, At, B1); PG8_BAR; PG8_SCHED;
            PG8_LDA(At, 0, 1); PG8_STAGE(PG8_SB(0, 0), b2, voffB); PG8_STAGE(PG8_SB(0, 1), b2 + hstep, voffB); PG8_STAGE(PG8_SA(0, 0), a2, oc[0]);
            PG8_WAIT_V(8); PG8_WAIT_L(0); PG8_BAR; PG8_MMA(1, 0, At, B0); PG8_MMA(1, 1, At, B1); PG8_BAR; PG8_SCHED;
            PG8_LDB(B0, 1, 0); PG8_LDB(B1, 1, 1); PG8_SCHED; PG8_LDA(At, 1, 0); PG8_STAGE(PG8_SA(0, 1), a2, oc[1]);
            PG8_WAIT_V(8); PG8_WAIT_L(0); PG8_BAR; PG8_MMA(0, 0, At, B0); PG8_MMA(0, 1, At, B1); PG8_BAR; PG8_SCHED;
            PG8_LDA(At, 1, 1); PG8_STAGE(PG8_SB(1, 0), b3, voffB); PG8_STAGE(PG8_SB(1, 1), b3 + hstep, voffB); PG8_STAGE(PG8_SA(1, 0), a3, oc[0]);
            PG8_WAIT_V(8); PG8_WAIT_L(0); PG8_BAR; PG8_MMA(1, 0, At, B0); PG8_MMA(1, 1, At, B1); PG8_BAR; PG8_SCHED;
        }
        if constexpr (ALIGN_EPI) { if (wr == 0) PG8_BAR; }
        E(acc, cur, wr, wc, fr, fq);
        if (!has_next) break;
#pragma unroll
        for (int a = 0; a < 2; ++a)
#pragma unroll
            for (int b = 0; b < 2; ++b)
#pragma unroll
                for (int m = 0; m < 4; ++m)
#pragma unroll
                    for (int n = 0; n < 2; ++n) acc[a][b][m][n] = (f32x4){0.f, 0.f, 0.f, 0.f};
        cur = nxt; cA = nA; cB = nB; ++ui;
        if constexpr (ALIGN_EPI) { if (wr == 1) PG8_BAR; }
    }
    PG8_WAIT_V(0);
    if constexpr (!ALIGN_EPI) { if (wr == 0) PG8_BAR; }
    PG8_BAR;
#undef PG8_SA
#undef PG8_SB
#undef PG8_STAGE
#undef PG8_LDA
#undef PG8_LDB
#undef PG8_MMA
#undef PG8_WAIT_V
#undef PG8_WAIT_L
#undef PG8_BAR
#undef PG8_SCHED
#undef PG8_GIDX
}

struct DenseOrder {
    int nM, nN, nwg, G, c;
    __device__ __forceinline__ void init(int M, int N, int G_, int c_) { nM = M / BM; nN = N / BM; nwg = nM * nN; G = G_; c = c_; }
    __device__ __forceinline__ bool next(int i, Unit& u) const {
        const long L = (long)i * G + c; if (L >= nwg) return false;
        int wgid = (int)L; { const int q = nwg / 8, r = nwg % 8, xcd = wgid % 8, off = wgid / 8; wgid = (xcd < r ? xcd * (q + 1) : r * (q + 1) + (xcd - r) * q) + off; }
        const int nig = 8 * nN, gid = wgid / nig, fm = gid * 8, gsz = (nM - fm) < 8 ? (nM - fm) : 8;
        u.pm = fm + ((wgid % nig) % gsz); u.pn = (wgid % nig) / gsz; u.pb = u.pn; return true;
    }
};
struct GroupedOrder {
    const int* tile_e; int ntiles, NT, G, vcu;
    __device__ __forceinline__ bool next(int i, Unit& u) const {
        const int L = i * G + vcu; if (L >= ntiles * NT) return false;
        const int mt = L / NT, nn = L - mt * NT; u.pm = mt; u.pn = nn; u.pb = tile_e[mt] * NT + nn; return true;
    }
};

#define EPI_ROWS_BEGIN const int row0 = u.pm * BM + wr * 64 + fr; _Pragma("unroll") for (int ai = 0; ai < 2; ++ai) _Pragma("unroll") for (int m = 0; m < 4; ++m) { const int row = row0 + ai * HALF + m * 16;
#define EPI_ROWS_END }
struct EpiWinF {
    static constexpr bool PERM = true;
    bf16_t* QK; bf16_t* V; bf16_t* AP;
    __device__ __forceinline__ void operator()(const f32x4 (&acc)[2][2][4][2], const Unit& u, int wr, int wc, int fr, int fq) const {
        const int colt = u.pn * BM + wc * 32 + 8 * fq;
        EPI_ROWS_BEGIN
#pragma unroll
            for (int bj = 0; bj < 2; ++bj) { const f32x4 v0 = acc[ai][bj][m][0], v1 = acc[ai][bj][m][1]; const int col = colt + bj * HALF;
                u32x4 w; w.x = cvt_pk_bf16(v0[0], v0[1]); w.y = cvt_pk_bf16(v0[2], v0[3]); w.z = cvt_pk_bf16(v1[0], v1[1]); w.w = cvt_pk_bf16(v1[2], v1[3]);
                bf16_t* dst;
                if (u.pn < 4) dst = QK + (size_t)row * 1024 + col;
                else if (u.pn < 6) dst = V + (size_t)row * 512 + (col - 1024);
                else { const int cc = col - 1536, gg = cc >> 4, ch = cc & 15, b = row / SEQ, l = row % SEQ;
                    dst = AP + ((size_t)(gg * (NB * NCHUNK) + b * NCHUNK + (l >> 4)) * APK + (l & 15) * 16 + ch); }
                *(u32x4*)dst = w; }
        EPI_ROWS_END
    }
};
struct EpiGluF {
    static constexpr bool PERM = true;
    const bf16_t* Y; bf16_t* MX; float* ss;
    __device__ __forceinline__ void operator()(const f32x4 (&acc)[2][2][4][2], const Unit& u, int wr, int wc, int fr, int fq) const {
        const int colt = u.pn * BM + wc * 32 + 8 * fq;
        EPI_ROWS_BEGIN
            float s = 0.f;
#pragma unroll
            for (int bj = 0; bj < 2; ++bj) { const int col = colt + bj * HALF; const u32x4 yv = *(const u32x4*)(Y + (size_t)row * 512 + col);
                const f32x4 a0 = acc[ai][bj][m][0], a1 = acc[ai][bj][m][1];
                float v[8];
                v[0] = __uint_as_float(yv.x << 16) * sigmoidf(a0[0]); v[1] = __uint_as_float(yv.x & 0xffff0000u) * sigmoidf(a0[1]);
                v[2] = __uint_as_float(yv.y << 16) * sigmoidf(a0[2]); v[3] = __uint_as_float(yv.y & 0xffff0000u) * sigmoidf(a0[3]);
                v[4] = __uint_as_float(yv.z << 16) * sigmoidf(a1[0]); v[5] = __uint_as_float(yv.z & 0xffff0000u) * sigmoidf(a1[1]);
                v[6] = __uint_as_float(yv.w << 16) * sigmoidf(a1[2]); v[7] = __uint_as_float(yv.w & 0xffff0000u) * sigmoidf(a1[3]);
#pragma unroll
                for (int i = 0; i < 8; ++i) s += v[i] * v[i];
                u32x4 w; w.x = cvt_pk_bf16(v[0], v[1]); w.y = cvt_pk_bf16(v[2], v[3]); w.z = cvt_pk_bf16(v[4], v[5]); w.w = cvt_pk_bf16(v[6], v[7]);
                *(u32x4*)(MX + (size_t)row * 1024 + 512 + col) = w; }
            s += __shfl_xor(s, 16); s += __shfl_xor(s, 32);
            if (fq == 0) atomicAdd(ss + row, s);
        EPI_ROWS_END
    }
};
struct EpiWoutF {
    static constexpr bool PERM = false;
    const float* x; const float* mod; float* out; float* ss;
    __device__ __forceinline__ void operator()(const f32x4 (&acc)[2][2][4][2], const Unit& u, int wr, int wc, int fr, int fq) const {
        const int colt = u.pn * BM + wc * 32 + 4 * fq;
        EPI_ROWS_BEGIN
            const int b = row / SEQ; float s = 0.f;
#pragma unroll
            for (int bj = 0; bj < 2; ++bj)
#pragma unroll
                for (int n = 0; n < 2; ++n) { const int col = colt + bj * HALF + n * 16;
                    const f32x4 xv = *(const f32x4*)(x + (size_t)row * DM + col), g1 = *(const f32x4*)(mod + b * 6 * DM + 2 * DM + col);
                    const f32x4 o = xv + g1 * acc[ai][bj][m][n];
                    *(f32x4*)(out + (size_t)row * DM + col) = o; s += o[0] * o[0] + o[1] * o[1] + o[2] * o[2] + o[3] * o[3]; }
            s += __shfl_xor(s, 16); s += __shfl_xor(s, 32);
            if (fq == 0) atomicAdd(ss + row, s);
        EPI_ROWS_END
    }
};
struct EpiRSF {
    static constexpr bool PERM = true;
    float* L; bf16_t* AS;
    __device__ __forceinline__ void operator()(const f32x4 (&acc)[2][2][4][2], const Unit& u, int wr, int wc, int fr, int fq) const {
        const int c8 = wc * 32 + 8 * fq;
        EPI_ROWS_BEGIN
            if (u.pn == 0) {
#pragma unroll
                for (int bj = 0; bj < 2; ++bj) { float* d = L + (size_t)row * 256 + bj * HALF + c8; *(f32x4*)d = acc[ai][bj][m][0]; *(f32x4*)(d + 4) = acc[ai][bj][m][1]; }
            } else {
                const f32x4 g0 = acc[ai][0][m][0], g1 = acc[ai][0][m][1], u0 = acc[ai][1][m][0], u1 = acc[ai][1][m][1];
                u32x4 w; w.x = cvt_pk_bf16(siluf(g0[0]) * u0[0], siluf(g0[1]) * u0[1]); w.y = cvt_pk_bf16(siluf(g0[2]) * u0[2], siluf(g0[3]) * u0[3]);
                w.z = cvt_pk_bf16(siluf(g1[0]) * u1[0], siluf(g1[1]) * u1[1]); w.w = cvt_pk_bf16(siluf(g1[2]) * u1[2], siluf(g1[3]) * u1[3]);
                *(u32x4*)(AS + (size_t)row * 256 + (u.pn - 1) * 128 + c8) = w;
            }
        EPI_ROWS_END
    }
};
struct EpiSDF {
    static constexpr bool PERM = false;
    const float* mod; float* out;
    __device__ __forceinline__ void operator()(const f32x4 (&acc)[2][2][4][2], const Unit& u, int wr, int wc, int fr, int fq) const {
        const int colt = u.pn * BM + wc * 32 + 4 * fq;
        EPI_ROWS_BEGIN
            const int b = row / SEQ;
#pragma unroll
            for (int bj = 0; bj < 2; ++bj)
#pragma unroll
                for (int n = 0; n < 2; ++n) { const int col = colt + bj * HALF + n * 16; const f32x4 g2 = *(const f32x4*)(mod + b * 6 * DM + 5 * DM + col);
                    f32x4* o = (f32x4*)(out + (size_t)row * DM + col); *o = *o + g2 * acc[ai][bj][m][n]; }
        EPI_ROWS_END
    }
};
struct EpiE1F {
    static constexpr bool PERM = true;
    bf16_t* AE;
    __device__ __forceinline__ void operator()(const f32x4 (&acc)[2][2][4][2], const Unit& u, int wr, int wc, int fr, int fq) const {
        const int c8 = u.pn * 128 + wc * 32 + 8 * fq;
        EPI_ROWS_BEGIN
            const f32x4 g0 = acc[ai][0][m][0], g1 = acc[ai][0][m][1], u0 = acc[ai][1][m][0], u1 = acc[ai][1][m][1];
            u32x4 w; w.x = cvt_pk_bf16(siluf(g0[0]) * u0[0], siluf(g0[1]) * u0[1]); w.y = cvt_pk_bf16(siluf(g0[2]) * u0[2], siluf(g0[3]) * u0[3]);
            w.z = cvt_pk_bf16(siluf(g1[0]) * u1[0], siluf(g1[1]) * u1[1]); w.w = cvt_pk_bf16(siluf(g1[2]) * u1[2], siluf(g1[3]) * u1[3]);
            *(u32x4*)(AE + (size_t)row * 256 + c8) = w;
        EPI_ROWS_END
    }
};
struct EpiE2F {
    static constexpr bool PERM = true;
    const int* sasg; const float* sgate; bf16_t* YA;
    __device__ __forceinline__ void operator()(const f32x4 (&acc)[2][2][4][2], const Unit& u, int wr, int wc, int fr, int fq) const {
        const int colt = u.pn * BM + wc * 32 + 8 * fq;
        EPI_ROWS_BEGIN
            const int asg = sasg[row]; const float gt = sgate[row];
            if (asg >= 0) {
#pragma unroll
                for (int bj = 0; bj < 2; ++bj) { const f32x4 v0 = acc[ai][bj][m][0] * gt, v1 = acc[ai][bj][m][1] * gt;
                    u32x4 w; w.x = cvt_pk_bf16(v0[0], v0[1]); w.y = cvt_pk_bf16(v0[2], v0[3]); w.z = cvt_pk_bf16(v1[0], v1[1]); w.w = cvt_pk_bf16(v1[2], v1[3]);
                    *(u32x4*)(YA + (size_t)asg * DM + colt + bj * HALF) = w; }
            }
        EPI_ROWS_END
    }
};
struct EpiSsmA {
    static constexpr bool PERM = false;
    float* DS;
    __device__ __forceinline__ void operator()(const f32x4 (&acc)[2][2][4][2], const Unit& u, int wr, int wc, int fr, int fq) const {
        EPI_ROWS_BEGIN
#pragma unroll
            for (int n = 0; n < 2; ++n) *(f32x4*)(DS + (size_t)row * 128 + wc * 32 + n * 16 + 4 * fq) = acc[ai][0][m][n];
        EPI_ROWS_END
    }
};
struct EpiSsmC {
    static constexpr bool PERM = true;
    bf16_t* Y;
    __device__ __forceinline__ void operator()(const f32x4 (&acc)[2][2][4][2], const Unit& u, int wr, int wc, int fr, int fq) const {
        EPI_ROWS_BEGIN
            const int gg = row >> 11, rem = row & 2047, b = rem >> 8, chunk = rem & 255; const size_t t0 = (size_t)b * SEQ + chunk * 16;
#pragma unroll
            for (int bj = 0; bj < 2; ++bj) { const int c0 = bj * HALF + wc * 32 + 8 * fq, jp = c0 >> 4, co0 = c0 & 15;
                const f32x4 v0 = acc[ai][bj][m][0], v1 = acc[ai][bj][m][1];
                u32x4 w; w.x = cvt_pk_bf16(gelu_tanh(v0[0]), gelu_tanh(v0[1])); w.y = cvt_pk_bf16(gelu_tanh(v0[2]), gelu_tanh(v0[3]));
                w.z = cvt_pk_bf16(gelu_tanh(v1[0]), gelu_tanh(v1[1])); w.w = cvt_pk_bf16(gelu_tanh(v1[2]), gelu_tanh(v1[3]));
                *(u32x4*)(Y + (t0 + jp) * 512 + gg * 16 + co0) = w; }
        EPI_ROWS_END
    }
};
struct SsmOrder {
    int G, vcu;
    __device__ __forceinline__ bool next(int i, Unit& u) const { const int L = i * G + vcu; if (L >= 256) return false; u.pm = L; u.pn = 0; u.pb = L >> 3; return true; }
};
}

__device__ __forceinline__ void transpose_item(const float* W, int K, int N, bf16_t* WT, int kb, int nb, int rowbase, float* scr, int lane) {
    const int k0 = 64 * kb, n0 = 32 * nb;
#pragma unroll 8
    for (int i = 0; i < 32; ++i) { const int kk = 2 * i + (lane >> 5); scr[kk * 33 + (lane & 31)] = W[(size_t)(k0 + kk) * N + n0 + (lane & 31)]; }
    asm volatile("s_waitcnt lgkmcnt(0)" ::: "memory");
    const int cch = lane & 7;
#pragma unroll
    for (int j = 0; j < 4; ++j) { const int n = (lane >> 3) + 8 * j; const float* s = scr + (8 * cch) * 33 + n;
        u32x4 o; o.x = pk2(s[0 * 33], s[1 * 33]); o.y = pk2(s[2 * 33], s[3 * 33]); o.z = pk2(s[4 * 33], s[5 * 33]); o.w = pk2(s[6 * 33], s[7 * 33]);
        *(u32x4*)(WT + (size_t)(rowbase + n) * K + k0 + 8 * cch) = o; }
    asm volatile("s_waitcnt lgkmcnt(0)" ::: "memory");
}
__device__ __forceinline__ int gu_row(int n0, int up) { return (n0 >> 7) * 256 + up * 128 + (n0 & 127); }
__device__ __forceinline__ void ph_convert(const Ctx& c, const Params& p) {
    float* scr = c.lds + c.wave * (64 * 33);
    unsigned char* ws = c.ws;
    constexpr int I0 = 16 * 64, I1 = 16 * 32, I2 = 8 * 16, I3 = 16 * 8, I6 = 4 * 32, IE = 128;
    constexpr int DENSE = I0 + I1 + I2 + 3 * I3 + I6, NITEMS = DENSE + 3 * IE * NE;
    for (int it = c.gwave; it < NITEMS; it += c.gwaves) {
        int r = it;
        if (r < I0) { transpose_item(p.in[I_WIN], DM, 2048, (bf16_t*)(ws + WS_WIN_T), r / 64, r % 64, (r % 64) * 32, scr, c.lane); continue; } r -= I0;
        if (r < I1) { transpose_item(p.in[I_WOUT], DM, DM, (bf16_t*)(ws + WS_WOUT_T), r / 32, r % 32, (r % 32) * 32, scr, c.lane); continue; } r -= I1;
        if (r < I2) { transpose_item(p.in[I_WGLU], 512, 512, (bf16_t*)(ws + WS_WGLU_T), r / 16, r % 16, (r % 16) * 32, scr, c.lane); continue; } r -= I2;
        if (r < I3) { transpose_item(p.in[I_WR], DM, 256, (bf16_t*)(ws + WS_WRS_T), r / 8, r % 8, (r % 8) * 32, scr, c.lane); continue; } r -= I3;
        if (r < I3) { transpose_item(p.in[I_WGS], DM, 256, (bf16_t*)(ws + WS_WRS_T), r / 8, r % 8, 256 + gu_row((r % 8) * 32, 0), scr, c.lane); continue; } r -= I3;
        if (r < I3) { transpose_item(p.in[I_WUS], DM, 256, (bf16_t*)(ws + WS_WRS_T), r / 8, r % 8, 256 + gu_row((r % 8) * 32, 1), scr, c.lane); continue; } r -= I3;
        if (r < I6) { transpose_item(p.in[I_WDS], 256, DM, (bf16_t*)(ws + WS_WDS_T), r / 32, r % 32, (r % 32) * 32, scr, c.lane); continue; } r -= I6;
        const int e = r / (3 * IE), q = r % (3 * IE), which = q / IE, ii = q % IE;
        if (which == 0) transpose_item(p.in[I_WGE] + (size_t)e * DM * ED, DM, ED, (bf16_t*)(ws + WS_WGU) + (size_t)e * 512 * DM, ii / 8, ii % 8, gu_row((ii % 8) * 32, 0), scr, c.lane);
        else if (which == 1) transpose_item(p.in[I_WUE] + (size_t)e * DM * ED, DM, ED, (bf16_t*)(ws + WS_WGU) + (size_t)e * 512 * DM, ii / 8, ii % 8, gu_row((ii % 8) * 32, 1), scr, c.lane);
        else transpose_item(p.in[I_WDE] + (size_t)e * ED * DM, ED, DM, (bf16_t*)(ws + WS_WD) + (size_t)e * DM * ED, ii / 32, ii % 32, (ii % 32) * 32, scr, c.lane);
    }
}

__device__ __forceinline__ void cpowi(float ar, float ai, int n, float& pr, float& pi) { pr = 1.f; pi = 0.f; for (int i = 0; i < n; ++i) { const float t = pr * ar - pi * ai; pi = pr * ai + pi * ar; pr = t; } }
__device__ __forceinline__ void ph_ssm_gen(const Ctx& c, const Params& p) {
    const float* sp = (const float*)(c.ws + WS_SSMP);
    const float* abr = sp, * abi = sp + SG * SP, * bbr = sp + 2 * SG * SP, * bbi = bbr + SG * SP * SC;
    bf16_t* BA = (bf16_t*)(c.ws + WS_SSM_BA); bf16_t* BC = (bf16_t*)(c.ws + WS_SSM_BC);
    for (int idx = c.gtid; idx < SG * 16 * 256; idx += c.gthreads) {
        const int ci = idx & 15, co = (idx >> 4) & 15, d = (idx >> 8) & 15, g = idx >> 12;
        float kv = 0.f;
        for (int pp = 0; pp < SP; ++pp) { float pr, pi; cpowi(abr[g * SP + pp], abi[g * SP + pp], d, pr, pi);
            const float br = bbr[(g * SP + pp) * SC + ci], bi = bbi[(g * SP + pp) * SC + ci];
            const float tr = pr * br - pi * bi, ti = pr * bi + pi * br;
            kv += p.in[I_CRE][(g * SC + co) * SP + pp] * tr - p.in[I_CIM][(g * SC + co) * SP + pp] * ti; }
        if (d == 0 && co == ci) kv += p.in[I_SD][g * SC + co];
        const bf16_t kb = f2bf(kv); bf16_t* base = BC + (size_t)g * 256 * APK;
        for (int j = 0; j + d < 16; ++j) { base[((j + d) * 16 + co) * APK + j * 16 + ci] = kb; if (d > 0) base[(j * 16 + co) * APK + (j + d) * 16 + ci] = 0; }
    }
    for (int idx = c.gtid; idx < SG * 16 * 16 * SP; idx += c.gthreads) {
        const int pp = idx & 63, co = (idx >> 6) & 15, jp = (idx >> 10) & 15, g = idx >> 14;
        float pr, pi; cpowi(abr[g * SP + pp], abi[g * SP + pp], jp + 1, pr, pi);
        const float cr = p.in[I_CRE][(g * SC + co) * SP + pp], ci = p.in[I_CIM][(g * SC + co) * SP + pp];
        bf16_t* row = BC + ((size_t)g * 256 + jp * 16 + co) * APK + 256;
        row[pp] = f2bf(cr * pr - ci * pi); row[64 + pp] = f2bf(-(cr * pi + ci * pr));
    }
    for (int idx = c.gtid; idx < SG * SP * 256; idx += c.gthreads) {
        const int ci = idx & 15, j = (idx >> 4) & 15, pp = (idx >> 8) & 63, g = idx >> 14;
        float pr, pi; cpowi(abr[g * SP + pp], abi[g * SP + pp], 15 - j, pr, pi);
        const float br = bbr[(g * SP + pp) * SC + ci], bi = bbi[(g * SP + pp) * SC + ci];
        bf16_t* base = BA + (size_t)g * 256 * 256;
        base[pp * 256 + j * 16 + ci] = f2bf(pr * br - pi * bi); base[(64 + pp) * 256 + j * 16 + ci] = f2bf(pr * bi + pi * br);
    }
    for (int idx = c.gtid; idx < SG * 128 * 256 / 8; idx += c.gthreads) {
        const int g = idx / (128 * 32), r = idx % (128 * 32);
        *(u32x4*)(BA + (size_t)g * 256 * 256 + 128 * 256 + r * 8) = (u32x4){0u, 0u, 0u, 0u};
    }
}
__device__ __forceinline__ void ph_ssm_scan(const Ctx& c, const Params& p) {
    const float* sp = (const float*)(c.ws + WS_SSMP); const float* abr = sp, * abi = sp + SG * SP;
    const float* DS = (const float*)(c.ws + WS_DS); bf16_t* AP = (bf16_t*)(c.ws + WS_AP);
    float* fw = c.lds;
    for (int it = c.bid; it < NB * SG; it += c.nb) {
        const int g = it % SG, b = it / SG, pp = c.lane, w = c.wave;
        const size_t r0 = (size_t)g * (NB * NCHUNK) + b * NCHUNK + 32 * w;
        float ar = abr[g * SP + pp], ai = abi[g * SP + pp];
#pragma unroll
        for (int i = 0; i < 4; ++i) { const float t = ar * ar - ai * ai; ai = 2.f * ar * ai; ar = t; }
        float lr[32], li[32];
#pragma unroll
        for (int i = 0; i < 32; ++i) { lr[i] = DS[(r0 + i) * 128 + pp]; li[i] = DS[(r0 + i) * 128 + 64 + pp]; }
#pragma unroll
        for (int i = 1; i < 32; ++i) { const float nr = ar * lr[i - 1] - ai * li[i - 1] + lr[i], ni = ar * li[i - 1] + ai * lr[i - 1] + li[i]; lr[i] = nr; li[i] = ni; }
        __syncthreads();
        fw[(w * 64 + pp) * 2] = lr[31]; fw[(w * 64 + pp) * 2 + 1] = li[31];
        __syncthreads();
        float a32r = ar, a32i = ai;
#pragma unroll
        for (int i = 0; i < 5; ++i) { const float t = a32r * a32r - a32i * a32i; a32i = 2.f * a32r * a32i; a32r = t; }
        float cr = 0.f, ci = 0.f;
        for (int w2 = 0; w2 < w; ++w2) { const float fr_ = fw[(w2 * 64 + pp) * 2], fi_ = fw[(w2 * 64 + pp) * 2 + 1];
            const float nr = a32r * cr - a32i * ci + fr_, ni = a32r * ci + a32i * cr + fi_; cr = nr; ci = ni; }
#pragma unroll
        for (int i = 0; i < 32; ++i) {
            const float sr = cr + (i ? lr[i - 1] : 0.f), si = ci + (i ? li[i - 1] : 0.f);
            bf16_t* row = AP + (r0 + i) * APK + 256;
            row[pp] = f2bf(sr); row[64 + pp] = f2bf(si);
            const float nr = ar * cr - ai * ci, ni = ar * ci + ai * cr; cr = nr; ci = ni;
        }
    }
}

namespace att {
typedef short bf16x8 __attribute__((ext_vector_type(8)));
typedef short s16x4 __attribute__((ext_vector_type(4)));
typedef float f32x16 __attribute__((ext_vector_type(16)));
constexpr int NW = 8, QBLK = 32, KVBLK = 64, QB = 128, NQB = SEQ / QB;
constexpr int KP = 1024, VP = 512;
constexpr int SHM_V = KVBLK * 128 * 2, SHM_K = KVBLK * 128 * 2;
constexpr int LDS_WS = 2 * SHM_V + 2 * SHM_K, LDS_EX = LDS_WS + NW * 64 * 4, LDS_END = LDS_EX + 4 * 16384;
#define KSWZ(row, colB) ((row) * 256 + ((colB) ^ (((row) & 7) << 4)))
#define SBAR() __builtin_amdgcn_sched_barrier(0)
__device__ __forceinline__ int v_st(int k, int c) { const int kk = (k & ~0xC) | ((k & 4) << 1) | ((k & 8) >> 1); return ((kk >> 3) * 4 + (c >> 5)) * 512 + ((kk & 7) * 32 + (c & 31)) * 2; }
__device__ __forceinline__ int v_rd_base(int lane) { return ((lane & 3) << 3) | (((lane >> 2) & 3) << 6) | (((lane >> 4) & 1) << 5) | (((lane >> 5) & 1) << 8); }
constexpr int v_rd_off(int d0, int ks, int half) { return d0 * 512 + ks * 4096 + half * 2048; }
__device__ __forceinline__ int crow(int r, int hi) { return (r & 3) + 8 * (r >> 2) + 4 * hi; }
__device__ __forceinline__ unsigned cvtpk(float lo, float hi) { unsigned r; asm volatile("v_cvt_pk_bf16_f32 %0, %1, %2" : "=v"(r) : "v"(lo), "v"(hi)); return r; }
__device__ __forceinline__ void mask_tile(f32x16& p0, f32x16& p1, int dq) {
    const float NEG = -__builtin_inff();
#pragma unroll
    for (int r = 0; r < 16; ++r) { const int c = (r & 3) + 8 * (r >> 2); if (dq - c < 0) p0[r] = NEG; if (dq - c - 32 < 0) p1[r] = NEG; }
}
__device__ __forceinline__ void partialSM(f32x16& p0, f32x16& p1, float C2, float negM) {
#pragma unroll
    for (int r = 0; r < 16; ++r) p0[r] = fmaf(p0[r], C2, negM);
#pragma unroll
    for (int r = 0; r < 16; ++r) p1[r] = fmaf(p1[r], C2, negM);
#pragma unroll
    for (int r = 0; r < 16; ++r) p0[r] = __builtin_amdgcn_exp2f(p0[r]);
}
__device__ __forceinline__ void finishSM(f32x16& p0, f32x16& p1, float& l_reg, bf16x8& pa0, bf16x8& pa1, bf16x8& pa2, bf16x8& pa3) {
#pragma unroll
    for (int r = 0; r < 16; ++r) p1[r] = __builtin_amdgcn_exp2f(p1[r]);
    float ps = 0;
#pragma unroll
    for (int r = 0; r < 16; ++r) ps += p0[r];
#pragma unroll
    for (int r = 0; r < 16; ++r) ps += p1[r];
    { auto rr = __builtin_amdgcn_permlane32_swap(__float_as_uint(ps), __float_as_uint(ps), false, false); ps = __uint_as_float(rr[0]) + __uint_as_float(rr[1]); }
    l_reg += ps;
#define PK4(P, B_, OUT) do { unsigned a0 = cvtpk(P[B_+0], P[B_+1]), a1 = cvtpk(P[B_+2], P[B_+3]);                          \
        unsigned b0 = cvtpk(P[B_+4], P[B_+5]), b1 = cvtpk(P[B_+6], P[B_+7]);                                             \
        auto r0 = __builtin_amdgcn_permlane32_swap(a0, b0, false, false); auto r1 = __builtin_amdgcn_permlane32_swap(a1, b1, false, false); \
        u32x4 w = {r0[0], r1[0], r0[1], r1[1]}; OUT = *reinterpret_cast<bf16x8*>(&w); } while (0)
    PK4(p0, 0, pa0); PK4(p0, 8, pa1); PK4(p1, 0, pa2); PK4(p1, 8, pa3);
#undef PK4
}
template <int KB>
__device__ __forceinline__ void qkt(f32x16& p0, f32x16& p1, const char* K_lds, int r32, int hi, const bf16x8* qr, int cc) {
    p0 = f32x16{}; p1 = f32x16{};
    const char* kb[4];
#pragma unroll
    for (int dd = 0; dd < 4; ++dd) kb[dd] = K_lds + KB * SHM_K + KSWZ(r32, (dd * 16 + hi * 8) * 2) + cc * 128;
#pragma unroll
    for (int d0 = 0; d0 < 4; ++d0) { const char* a = kb[d0];
        bf16x8 b0 = *reinterpret_cast<const bf16x8*>(a);
        bf16x8 b1 = *reinterpret_cast<const bf16x8*>(a + 32 * 256);
        p0 = __builtin_amdgcn_mfma_f32_32x32x16_bf16(b0, qr[d0], p0, 0, 0, 0);
        p1 = __builtin_amdgcn_mfma_f32_32x32x16_bf16(b1, qr[d0], p1, 0, 0, 0); }
}
template <int VB>
__device__ __forceinline__ void pv_tile(f32x16* o, int vb0, bf16x8 pa0, bf16x8 pa1, bf16x8 pa2, bf16x8 pa3) {
#define TRRD(dst, off) asm volatile("ds_read_b64_tr_b16 %0, %1 offset:%2" : "=&v"(dst) : "v"(vb0), "i"(off) : "memory")
#define PV_D0(d0) do { s16x4 l0, l1, l2, l3, h0, h1, h2, h3; constexpr int b_ = VB * SHM_V + v_rd_off(d0, 0, 0); \
        TRRD(l0, b_); TRRD(h0, b_ + 2048); TRRD(l1, b_ + 4096); TRRD(h1, b_ + 6144); TRRD(l2, b_ + 8192); TRRD(h2, b_ + 10240); TRRD(l3, b_ + 12288); TRRD(h3, b_ + 14336); \
        asm volatile("s_waitcnt lgkmcnt(0)" ::: "memory"); SBAR();   \
        o[d0] = __builtin_amdgcn_mfma_f32_32x32x16_bf16(pa0, (bf16x8){l0[0], l0[1], l0[2], l0[3], h0[0], h0[1], h0[2], h0[3]}, o[d0], 0, 0, 0);   \
        o[d0] = __builtin_amdgcn_mfma_f32_32x32x16_bf16(pa1, (bf16x8){l1[0], l1[1], l1[2], l1[3], h1[0], h1[1], h1[2], h1[3]}, o[d0], 0, 0, 0);   \
        o[d0] = __builtin_amdgcn_mfma_f32_32x32x16_bf16(pa2, (bf16x8){l2[0], l2[1], l2[2], l2[3], h2[0], h2[1], h2[2], h2[3]}, o[d0], 0, 0, 0);   \
        o[d0] = __builtin_amdgcn_mfma_f32_32x32x16_bf16(pa3, (bf16x8){l3[0], l3[1], l3[2], l3[3], h3[0], h3[1], h3[2], h3[3]}, o[d0], 0, 0, 0); } while (0)
    PV_D0(0); PV_D0(1); PV_D0(2); PV_D0(3);
#undef PV_D0
#undef TRRD
}
struct BlockRef { const bf16_t* Q; const bf16_t* K; const bf16_t* V; bf16_t* O; int P0; };
struct Seam { bf16x8 qr[4]; bf16x8 st_v0, st_v1, st_k0, st_k1; };
#define ROWK(p, k0, rr) ((p) + (size_t)((k0) + (rr)) * KP + sc)
#define ROWV(p, k0, rr) ((p) + (size_t)((k0) + (rr)) * VP + sc)
#define LD8(ptr) (*reinterpret_cast<const bf16x8*>(ptr))
#define VMW() asm volatile("s_waitcnt vmcnt(0)" ::: "memory")
#define VMWN(n) asm volatile("s_waitcnt vmcnt(%0)" :: "i"(n) : "memory")
#define SLOAD_H(Kp, Vp, k0) do { S.st_v0 = LD8(ROWV(Vp, k0, sr)); S.st_v1 = LD8(ROWV(Vp, k0, 32 + sr)); S.st_k0 = LD8(ROWK(Kp, k0, sr)); S.st_k1 = LD8(ROWK(Kp, k0, 32 + sr)); } while (0)
#define SWRITE_HK(bf) do { *(bf16x8*)(K_lds + (bf) * SHM_K + kws) = S.st_k0; *(bf16x8*)(K_lds + (bf) * SHM_K + kws + 32 * 256) = S.st_k1; } while (0)
#define SWRITE_HV(bf) do { *(bf16x8*)(V_lds + (bf) * SHM_V + vst0) = S.st_v0; *(bf16x8*)(V_lds + (bf) * SHM_V + vst1) = S.st_v1; } while (0)
#define SWRITE_H(bf) do { SWRITE_HV(bf); SWRITE_HK(bf); } while (0)
#define QLOAD(ref) do { _Pragma("unroll") for (int d0 = 0; d0 < 4; ++d0) S.qr[d0] = LD8((ref).Q + (size_t)(qi * QBLK + r32) * KP + cc * 64 + d0 * 16 + hi * 8); } while (0)
__device__ __forceinline__ void prime(const BlockRef& cur, char* lds, Seam& S) {
    const int tid = threadIdx.x, wid = __builtin_amdgcn_readfirstlane(tid >> 6), lane = tid & 63, r32 = lane & 31, hi = lane >> 5, qi = wid >> 1, cc = wid & 1;
    const int sr = tid >> 4, sc = (tid & 15) * 8, kws = KSWZ(sr, sc * 2); char* K_lds = lds + 2 * SHM_V;
    QLOAD(cur);
    SLOAD_H(cur.K, cur.V, 0); VMW(); SWRITE_HK(0);
    __syncthreads();
}
__device__ __forceinline__ void block(const BlockRef& cur, const BlockRef& nxt, char* lds, Seam& S, float lam, float smax, const float* subg, bool lastblk) {
    const int tid = threadIdx.x, wid = __builtin_amdgcn_readfirstlane(tid >> 6), lane = tid & 63, r32 = lane & 31, hi = lane >> 5, qi = wid >> 1, cc = wid & 1;
    const int NT = cur.P0 / KVBLK + 2;
    const int qlo = cur.P0 + qi * QBLK, qm = qlo + r32 - 4 * hi;
    char* V_lds = lds; char* K_lds = lds + 2 * SHM_V;
    float* wsf = (float*)(lds + LDS_WS) + wid * 64; float* li_l = wsf;
    float* exch = (float*)(lds + LDS_EX) + qi * 4096;
    float l_reg = 0; f32x16 o[4] = {};
    const int sr = tid >> 4, sc = (tid & 15) * 8, vst0 = v_st(sr, sc), vst1 = v_st(32 + sr, sc), kws = KSWZ(sr, sc * 2);
    const int vb0 = (int)(uintptr_t)V_lds + v_rd_base(lane);
    const bf16_t* Kh = cur.K; const bf16_t* Vh = cur.V;
    constexpr float C2 = 1.4426950408889634f * 0.125f; const float negM = -smax * 1.4426950408889634f;
#define KBASE(t) ((t) * KVBLK)
#define MASKT(P0_, P1_, t) do { const int kb_ = KBASE(t); if (kb_ + KVBLK - 1 > qlo) mask_tile(P0_, P1_, qm - kb_); } while (0)
    f32x16 pA0, pA1, pB0, pB1; bf16x8 pa0, pa1, pa2, pa3;
    SWRITE_HV(0); SBAR();
    SLOAD_H(Kh, Vh, KBASE(1));
    SBAR(); qkt<0>(pA0, pA1, K_lds, r32, hi, S.qr, cc);
    MASKT(pA0, pA1, 0); partialSM(pA0, pA1, C2, negM);
    VMW(); SWRITE_H(1);
    __syncthreads();
#define HALF_STEP(PX0, PX1, PY0, PY1, t, KB, VB, SB) do {                                                      \
        SBAR(); qkt<KB>(PX0, PX1, K_lds, r32, hi, S.qr, cc);                                                  \
        finishSM(PY0, PY1, l_reg, pa0, pa1, pa2, pa3); SBAR();                                                \
        if ((t) + 1 < NT) { SLOAD_H(Kh, Vh, KBASE((t) + 1)); SBAR(); }                                        \
        pv_tile<VB>(o, vb0, pa0, pa1, pa2, pa3); MASKT(PX0, PX1, (t)); partialSM(PX0, PX1, C2, negM);          \
        __syncthreads();                                                                                       \
        if ((t) + 1 < NT) { VMW(); SWRITE_H(SB); }                                                             \
        __syncthreads(); } while (0)
    for (int t = 1; t + 1 < NT; t += 2) {
        HALF_STEP(pB0, pB1, pA0, pA1, t, 1, 0, 0);
        HALF_STEP(pA0, pA1, pB0, pB1, t + 1, 0, 1, 1);
    }
    SBAR(); qkt<1>(pB0, pB1, K_lds, r32, hi, S.qr, cc); SBAR();
    SLOAD_H(nxt.K, nxt.V, 0); SBAR();
    QLOAD(nxt);
    SBAR();
    finishSM(pA0, pA1, l_reg, pa0, pa1, pa2, pa3); SBAR();
    pv_tile<0>(o, vb0, pa0, pa1, pa2, pa3);
    MASKT(pB0, pB1, NT - 1); partialSM(pB0, pB1, C2, negM); __syncthreads();
    finishSM(pB0, pB1, l_reg, pa0, pa1, pa2, pa3); SBAR(); pv_tile<1>(o, vb0, pa0, pa1, pa2, pa3);
    SBAR(); VMWN(4); SWRITE_HK(0); SBAR();
    if (hi == 0) li_l[r32] = l_reg; asm volatile("s_waitcnt lgkmcnt(0)" ::: "memory");
    float rli[16];
#pragma unroll
    for (int r = 0; r < 16; ++r) rli[r] = __builtin_amdgcn_rcpf(li_l[crow(r, hi)]) * (cc ? lam : 1.f);
#pragma unroll
    for (int d0 = 0; d0 < 4; ++d0)
#pragma unroll
        for (int r = 0; r < 16; ++r) o[d0][r] *= rli[r];
    if (cc == 1) {
#pragma unroll
        for (int d0 = 0; d0 < 4; ++d0)
#pragma unroll
            for (int r = 0; r < 16; ++r) exch[(d0 * 16 + r) * 64 + lane] = o[d0][r];
    }
    __syncthreads();
    if (cc == 0) {
        float gsub[4];
#pragma unroll
        for (int d0 = 0; d0 < 4; ++d0) gsub[d0] = subg[d0 * 32 + r32] * (1.f - LAM_INIT);
        bf16_t* Ow = cur.O + (size_t)(qi * QBLK) * KP;
#pragma unroll
        for (int r = 0; r < 16; ++r) {
            float ss = 0.f;
#pragma unroll
            for (int d0 = 0; d0 < 4; ++d0) { o[d0][r] -= exch[(d0 * 16 + r) * 64 + lane]; ss += o[d0][r] * o[d0][r]; }
#pragma unroll
            for (int of = 1; of < 32; of <<= 1) ss += __shfl_xor(ss, of);
            const float rstd = rsqrtf(ss * (1.f / 128.f) + EPS); const int orow = crow(r, hi);
#pragma unroll
            for (int d0 = 0; d0 < 4; ++d0) { const float v = o[d0][r] * rstd * gsub[d0]; const float vn = __shfl_xor(v, 1);
                if ((r32 & 1) == 0) *(unsigned*)(Ow + (size_t)orow * KP + d0 * 32 + r32) = cvtpk(v, vn); }
        }
    }
    if (lastblk) __syncthreads();
#undef KBASE
#undef MASKT
#undef HALF_STEP
}
__device__ __forceinline__ void phase(char* lds, const bf16_t* QKb, const bf16_t* Vb, bf16_t* MX, float lam, float smax, const float* subg, int G, int vcu) {
    constexpr int NX = NQB / 2, TOTAL = NB * NH * NX;
    int L = vcu; if (L >= TOTAL) return;
    int pass = 0;
#define MKREF(ref, LL, ps) do { const int bh_ = (LL) / NX, x_ = (LL) % NX, qb_ = (ps) ? (NQB - 1 - x_) : x_, b_ = bh_ / NH, h_ = bh_ % NH; \
        const size_t row0_ = (size_t)b_ * SEQ; (ref).P0 = qb_ * QB; \
        (ref).Q = QKb + (row0_ + qb_ * QB) * KP + h_ * 128; (ref).K = QKb + row0_ * KP + 512 + h_ * 128; (ref).V = Vb + row0_ * VP + h_ * 128; \
        (ref).O = MX + (row0_ + qb_ * QB) * KP + h_ * 128; } while (0)
    BlockRef cur, nxt; MKREF(cur, L, 0);
    Seam S;
    prime(cur, lds, S);
    for (;;) {
        const bool more_pass = pass == 0, more_item = L + G < TOTAL, last = !more_pass && !more_item;
        int passn = pass + 1, Ln = L;
        if (!more_pass) { passn = 0; Ln = more_item ? L + G : L; }
        if (last) nxt = cur; else MKREF(nxt, Ln, passn);
        block(cur, nxt, lds, S, lam, smax, subg, last);
        if (last) break;
        cur = nxt; pass = passn; L = Ln;
    }
#undef MKREF
}
#undef ROWK
#undef ROWV
#undef LD8
#undef VMW
#undef VMWN
#undef SLOAD_H
#undef SWRITE_HK
#undef SWRITE_HV
#undef SWRITE_H
#undef QLOAD
#undef KSWZ
#undef SBAR
}

enum { PH_PRO = 0, PH_CONV, PH_H1, PH_WIN, PH_WIN_F, PH_QKN, PH_ATT, PH_ATTC, PH_ATT_F, PH_SSM, PH_SSMGEN, PH_SSMA_F, PH_SCAN, PH_SSMC_F, PH_GLU, PH_GLU_F, PH_NORM, PH_WOUT, PH_WOUT_F, PH_H2,
       PH_RS, PH_RS2, PH_RS_F, PH_SD, PH_SD_F, PH_ROUTE, PH_SLOT, PH_E1, PH_E1_F, PH_E2, PH_E2_F, PH_COMB, PH_COUNT };
constexpr int NTHREADS = 512;
constexpr int LDS_BYTES = 147456;
constexpr int LDS_MISC_OFF = 147456 - 256;
typedef unsigned long long mask_t;
#define PHBIT(k) (1ull << (k))

template <mask_t MASK>
__global__ void __launch_bounds__(NTHREADS, 2) mega(Params p) {
    extern __shared__ __attribute__((aligned(16))) unsigned char lds_raw[];
#define MAKE_CTX() Ctx c; { int t_ = threadIdx.x; asm volatile("" : "+v"(t_)); c.tid = t_; c.lane = c.tid & 63; c.wave = __builtin_amdgcn_readfirstlane(c.tid >> 6); c.bid = blockIdx.x; c.nb = gridDim.x; \
    c.gtid = c.bid * NTHREADS + c.tid; c.gthreads = c.nb * NTHREADS; c.gwave = c.bid * (NTHREADS / 64) + c.wave; c.gwaves = c.nb * (NTHREADS / 64); c.ws = p.ws; c.lds = (float*)lds_raw; }
    unsigned char* ws = p.ws;
    PG8_LAS unsigned char* lds3 = (PG8_LAS unsigned char*)lds_raw;
    const int G = gridDim.x, bid = blockIdx.x, vcu = (G % 8 == 0) ? (bid % 8) * (G / 8) + bid / 8 : bid;
    constexpr bool MULTI = (MASK & (MASK - 1)) != 0;
    XcdBarrier bar; bar.bar = (unsigned*)(ws + WS_CTL) + CW_BAR; bar.x = 0; bar.st = nullptr;
    if constexpr (MULTI) {
        volatile LAS unsigned* misc = (volatile LAS unsigned*)(lds3 + LDS_MISC_OFF);
        if (threadIdx.x < 32) misc[threadIdx.x] = 0u;
        __syncthreads();
        bar = xcd_barrier_post((unsigned*)(ws + WS_CTL) + CW_BAR, misc + 8);
    }
    bool first = true;
#define PHASE(k) if constexpr ((MASK >> (k)) & 1ull) if ((MULTI ? (first ? (first = false, true) : (xcd_barrier(bar), true)) : true))
    PHASE(PH_PRO) { MAKE_CTX(); ph_prologue(c, p); }
    PHASE(PH_CONV) { MAKE_CTX(); ph_convert(c, p); }
    PHASE(PH_H1) { MAKE_CTX(); ph_h1(c, p); }
    PHASE(PH_WIN) { MAKE_CTX(); SG_Args g{(const bf16_t*)(ws + WS_H), DM, nullptr, p.in[I_WIN], nullptr, 2048, 0, nullptr, T, 2048, DM};
        EpiWin E{(bf16_t*)(ws + WS_QK), (bf16_t*)(ws + WS_V), (bf16_t*)(ws + WS_AP)}; sgemm_phase<false>(c, g, E); }
    PHASE(PH_WIN_F) { MAKE_CTX(); pg8::Gemm g{(const bf16_t*)(ws + WS_H), (const bf16_t*)(ws + WS_WIN_T), DM, DM, nullptr}; pg8::DenseOrder S; S.init(T, 2048, G, bid);
        pg8::EpiWinF E{(bf16_t*)(ws + WS_QK), (bf16_t*)(ws + WS_V), (bf16_t*)(ws + WS_AP)}; pg8::gemm_phase<pg8::EpiWinF, pg8::DenseOrder, false, true>(lds3, g, S, E); }
    PHASE(PH_QKN) { MAKE_CTX(); ph_qkn(c, p); }
    PHASE(PH_ATT) { MAKE_CTX(); ph_att_base(c, p); }
    PHASE(PH_ATTC) { MAKE_CTX(); ph_att_comb(c, p); }
    PHASE(PH_ATT_F) { const float* lamp = (const float*)(ws + WS_LAM);
        att::phase((char*)lds_raw, (const bf16_t*)(ws + WS_QK), (const bf16_t*)(ws + WS_V), (bf16_t*)(ws + WS_MIXIN), lamp[0], lamp[1], p.in[I_SUBG], G, vcu); }
    PHASE(PH_SSM) { MAKE_CTX(); ph_ssm_base(c, p); }
    PHASE(PH_SSMGEN) { MAKE_CTX(); ph_ssm_gen(c, p); }
    PHASE(PH_SSMA_F) { pg8::Gemm g{(const bf16_t*)(ws + WS_AP), (const bf16_t*)(ws + WS_SSM_BA), 256, APK, nullptr}; pg8::SsmOrder S{G, vcu};
        pg8::EpiSsmA E{(float*)(ws + WS_DS)}; pg8::gemm_phase<pg8::EpiSsmA, pg8::SsmOrder, false, false>(lds3, g, S, E); }
    PHASE(PH_SCAN) { MAKE_CTX(); ph_ssm_scan(c, p); }
    PHASE(PH_SSMC_F) { pg8::Gemm g{(const bf16_t*)(ws + WS_AP), (const bf16_t*)(ws + WS_SSM_BC), APK, APK, nullptr}; pg8::SsmOrder S{G, vcu};
        pg8::EpiSsmC E{(bf16_t*)(ws + WS_Y)}; pg8::gemm_phase<pg8::EpiSsmC, pg8::SsmOrder, false, false>(lds3, g, S, E); }
    PHASE(PH_GLU) { MAKE_CTX(); SG_Args g{(const bf16_t*)(ws + WS_Y), 512, nullptr, p.in[I_WGLU], nullptr, 512, 0, nullptr, T, 512, 512};
        EpiGlu E{(const bf16_t*)(ws + WS_Y), (bf16_t*)(ws + WS_MIXIN), (float*)(ws + WS_CTL + CTL_SS1)}; sgemm_phase<false>(c, g, E); }
    PHASE(PH_GLU_F) { MAKE_CTX(); pg8::Gemm g{(const bf16_t*)(ws + WS_Y), (const bf16_t*)(ws + WS_WGLU_T), 512, 512, nullptr}; pg8::DenseOrder S; S.init(T, 512, G, bid);
        pg8::EpiGluF E{(const bf16_t*)(ws + WS_Y), (bf16_t*)(ws + WS_MIXIN), (float*)(ws + WS_CTL + CTL_SS1)}; pg8::gemm_phase<pg8::EpiGluF, pg8::DenseOrder, false, true>(lds3, g, S, E); }
    PHASE(PH_NORM) { MAKE_CTX(); ph_ssm_norm(c, p); }
    PHASE(PH_WOUT) { MAKE_CTX(); SG_Args g{(const bf16_t*)(ws + WS_MIXIN), DM, nullptr, p.in[I_WOUT], nullptr, DM, 0, nullptr, T, DM, DM};
        EpiWout E{p.in[I_X], (const float*)(ws + WS_MOD), p.out, (float*)(ws + WS_CTL + CTL_SS2)}; sgemm_phase<false>(c, g, E); }
    PHASE(PH_WOUT_F) { MAKE_CTX(); pg8::Gemm g{(const bf16_t*)(ws + WS_MIXIN), (const bf16_t*)(ws + WS_WOUT_T), DM, DM, nullptr}; pg8::DenseOrder S; S.init(T, DM, G, bid);
        pg8::EpiWoutF E{p.in[I_X], (const float*)(ws + WS_MOD), p.out, (float*)(ws + WS_CTL + CTL_SS2)}; pg8::gemm_phase<pg8::EpiWoutF, pg8::DenseOrder, false, true>(lds3, g, S, E); }
    PHASE(PH_H2) { MAKE_CTX(); ph_h2(c, p); }
    PHASE(PH_RS) { MAKE_CTX(); SG_Args g{(const bf16_t*)(ws + WS_H), DM, nullptr, p.in[I_WR], nullptr, 256, 0, nullptr, T, 256, DM};
        EpiLogits E{(float*)(ws + WS_LOGITS)}; sgemm_phase<false>(c, g, E); }
    PHASE(PH_RS2) { MAKE_CTX(); SG_Args g2{(const bf16_t*)(ws + WS_H), DM, nullptr, p.in[I_WGS], p.in[I_WUS], 256, 0, nullptr, T, 256, DM};
        EpiSwiglu E2{(bf16_t*)(ws + WS_ACTS), 256}; sgemm_phase<true>(c, g2, E2); }
    PHASE(PH_RS_F) { MAKE_CTX(); pg8::Gemm g{(const bf16_t*)(ws + WS_H), (const bf16_t*)(ws + WS_WRS_T), DM, DM, nullptr}; pg8::DenseOrder S; S.init(T, 768, G, bid);
        pg8::EpiRSF E{(float*)(ws + WS_LOGITS), (bf16_t*)(ws + WS_ACTS)}; pg8::gemm_phase<pg8::EpiRSF, pg8::DenseOrder, false, true>(lds3, g, S, E); }
    PHASE(PH_SD) { MAKE_CTX(); SG_Args g{(const bf16_t*)(ws + WS_ACTS), 256, nullptr, p.in[I_WDS], nullptr, DM, 0, nullptr, T, DM, ED};
        EpiSD E{(const float*)(ws + WS_MOD), p.out}; sgemm_phase<false>(c, g, E); }
    PHASE(PH_SD_F) { MAKE_CTX(); pg8::Gemm g{(const bf16_t*)(ws + WS_ACTS), (const bf16_t*)(ws + WS_WDS_T), ED, ED, nullptr}; pg8::DenseOrder S; S.init(T, DM, G, bid);
        pg8::EpiSDF E{(const float*)(ws + WS_MOD), p.out}; pg8::gemm_phase<pg8::EpiSDF, pg8::DenseOrder, false, true>(lds3, g, S, E); }
    PHASE(PH_ROUTE) { MAKE_CTX(); ph_route(c, p); }
    PHASE(PH_SLOT) { MAKE_CTX(); ph_slot(c, p); }
    PHASE(PH_E1) { MAKE_CTX(); SG_Args g{(const bf16_t*)(ws + WS_H), DM, (const int*)(ws + WS_SLOT_TOK), p.in[I_WGE], p.in[I_WUE], 256, (size_t)DM * ED, (const int*)(ws + WS_TILE_E), NS_MAX, ED, DM};
        EpiSwiglu E{(bf16_t*)(ws + WS_ACTE), 256}; sgemm_phase<true>(c, g, E); }
    PHASE(PH_E1_F) { MAKE_CTX(); pg8::Gemm g{(const bf16_t*)(ws + WS_H), (const bf16_t*)(ws + WS_WGU), DM, DM, (const int*)(ws + WS_SLOT_TOK)};
        pg8::GroupedOrder S{(const int*)(ws + WS_TILE_E), (int)((const unsigned*)(ws + WS_CTL))[CW_NTILES], 2, G, vcu};
        pg8::EpiE1F E{(bf16_t*)(ws + WS_ACTE)}; pg8::gemm_phase<pg8::EpiE1F, pg8::GroupedOrder, true, true>(lds3, g, S, E); }
    PHASE(PH_E2) { MAKE_CTX(); SG_Args g{(const bf16_t*)(ws + WS_ACTE), 256, nullptr, p.in[I_WDE], nullptr, DM, (size_t)ED * DM, (const int*)(ws + WS_TILE_E), NS_MAX, DM, ED};
        EpiE2 E{(const int*)(ws + WS_SLOT_ASG), (const float*)(ws + WS_SLOT_GATE), (bf16_t*)(ws + WS_YA)}; sgemm_phase<false>(c, g, E); }
    PHASE(PH_E2_F) { MAKE_CTX(); pg8::Gemm g{(const bf16_t*)(ws + WS_ACTE), (const bf16_t*)(ws + WS_WD), ED, ED, nullptr};
        pg8::GroupedOrder S{(const int*)(ws + WS_TILE_E), (int)((const unsigned*)(ws + WS_CTL))[CW_NTILES], 4, G, vcu};
        pg8::EpiE2F E{(const int*)(ws + WS_SLOT_ASG), (const float*)(ws + WS_SLOT_GATE), (bf16_t*)(ws + WS_YA)}; pg8::gemm_phase<pg8::EpiE2F, pg8::GroupedOrder, false, true>(lds3, g, S, E); }
    PHASE(PH_COMB) { MAKE_CTX(); ph_combine(c, p); }
#undef PHASE
}

#ifndef PLAN
#define PLAN 4
#endif
#if PLAN == 0
#define LAUNCH_LIST X(PHBIT(PH_PRO)) X(PHBIT(PH_H1)) X(PHBIT(PH_WIN)) X(PHBIT(PH_QKN)) X(PHBIT(PH_ATT)) X(PHBIT(PH_ATTC)) X(PHBIT(PH_SSM)) X(PHBIT(PH_GLU)) X(PHBIT(PH_NORM)) \
    X(PHBIT(PH_WOUT)) X(PHBIT(PH_H2)) X(PHBIT(PH_RS)) X(PHBIT(PH_RS2)) X(PHBIT(PH_SD)) X(PHBIT(PH_ROUTE)) X(PHBIT(PH_SLOT)) X(PHBIT(PH_E1)) X(PHBIT(PH_E2)) X(PHBIT(PH_COMB))
#elif PLAN == 1
#define LAUNCH_LIST X(PHBIT(PH_PRO)) X(PHBIT(PH_CONV)) X(PHBIT(PH_H1)) X(PHBIT(PH_WIN_F)) X(PHBIT(PH_QKN)) X(PHBIT(PH_ATT)) X(PHBIT(PH_ATTC)) X(PHBIT(PH_SSM)) X(PHBIT(PH_GLU_F)) X(PHBIT(PH_NORM)) \
    X(PHBIT(PH_WOUT_F)) X(PHBIT(PH_H2)) X(PHBIT(PH_RS_F)) X(PHBIT(PH_SD_F)) X(PHBIT(PH_ROUTE)) X(PHBIT(PH_SLOT)) X(PHBIT(PH_E1_F)) X(PHBIT(PH_E2_F)) X(PHBIT(PH_COMB))
#elif PLAN == 2
#define LAUNCH_LIST X(PHBIT(PH_PRO) | PHBIT(PH_CONV) | PHBIT(PH_H1) | PHBIT(PH_WIN_F) | PHBIT(PH_QKN) | PHBIT(PH_ATT) | PHBIT(PH_ATTC) | PHBIT(PH_SSM) | PHBIT(PH_GLU_F) | PHBIT(PH_NORM) | \
    PHBIT(PH_WOUT_F) | PHBIT(PH_H2) | PHBIT(PH_RS_F) | PHBIT(PH_SD_F) | PHBIT(PH_ROUTE) | PHBIT(PH_SLOT) | PHBIT(PH_E1_F) | PHBIT(PH_E2_F) | PHBIT(PH_COMB))
#elif PLAN == 3
#define LAUNCH_LIST X(PHBIT(PH_PRO) | PHBIT(PH_CONV) | PHBIT(PH_H1) | PHBIT(PH_WIN_F) | PHBIT(PH_QKN) | PHBIT(PH_ATT_F) | PHBIT(PH_SSM) | PHBIT(PH_GLU_F) | PHBIT(PH_NORM) | \
    PHBIT(PH_WOUT_F) | PHBIT(PH_H2) | PHBIT(PH_RS_F) | PHBIT(PH_SD_F) | PHBIT(PH_ROUTE) | PHBIT(PH_SLOT) | PHBIT(PH_E1_F) | PHBIT(PH_E2_F) | PHBIT(PH_COMB))
#elif PLAN == 4
#define LAUNCH_LIST X(PHBIT(PH_PRO) | PHBIT(PH_CONV) | PHBIT(PH_H1) | PHBIT(PH_WIN_F) | PHBIT(PH_QKN) | PHBIT(PH_ATT_F) | PHBIT(PH_SSMGEN) | PHBIT(PH_SSMA_F) | PHBIT(PH_SCAN) | PHBIT(PH_SSMC_F) | PHBIT(PH_GLU_F) | PHBIT(PH_NORM) | \
    PHBIT(PH_WOUT_F) | PHBIT(PH_H2) | PHBIT(PH_RS_F) | PHBIT(PH_SD_F) | PHBIT(PH_ROUTE) | PHBIT(PH_SLOT) | PHBIT(PH_E1_F) | PHBIT(PH_E2_F) | PHBIT(PH_COMB))
#endif

extern "C" void kernel_launch(void* const* d_in, const int* in_sizes, int n_in, void* d_out, int out_size, void* d_ws, size_t ws_size, hipStream_t stream) {
    static int grid = 0;
    if (grid == 0) {
        if (n_in != 33 || out_size != T * DM || ws_size < WS_NEED) { fprintf(stderr, "kernel_launch: unexpected shapes (n_in %d out %d ws %zu)\n", n_in, out_size, ws_size); grid = -1; return; }
        int dev = 0, cus = 0;
        if (hipGetDevice(&dev) != hipSuccess || hipDeviceGetAttribute(&cus, hipDeviceAttributeMultiprocessorCount, dev) != hipSuccess) { grid = -1; return; }
        bool ok = true;
#define X(m) ok = ok && (hipFuncSetAttribute((const void*)mega<(m)>, hipFuncAttributeMaxDynamicSharedMemorySize, LDS_BYTES) == hipSuccess);
        LAUNCH_LIST
#undef X
        if (!ok) { grid = -1; return; }
        grid = cus;
    }
    if (grid < 0) return;
    (void)hipMemsetAsync((char*)d_ws + WS_CTL, 0, CTL_BYTES, stream);
    Params a{};
    for (int i = 0; i < 33; ++i) a.in[i] = (const float*)d_in[i];
    a.out = (float*)d_out; a.ws = (unsigned char*)d_ws;
#define X(m) hipLaunchKernelGGL((mega<(m)>), dim3(grid), dim3(NTHREADS), LDS_BYTES, stream, a);
    LAUNCH_LIST
#undef X
}
```

```cpp
#include <hip/hip_runtime.h>
#include <cstdio>
#include <cstdint>

typedef unsigned short bf16_t;
typedef float f32x4 __attribute__((ext_vector_type(4)));
typedef unsigned u32x4 __attribute__((ext_vector_type(4)));
typedef unsigned u32x2 __attribute__((ext_vector_type(2)));

constexpr int DM = 1024, NB = 8, SEQ = 4096, T = NB * SEQ;
constexpr int NH = 4, HD = 64, VD = 128, QKW = 512, ATTW = 512, SSMW = 512;
constexpr int SG = 32, SC = 16, SP = 64;
constexpr int LC = 16;
constexpr int NCHUNK = SEQ / LC;
constexpr int APK = 384;
constexpr int NE = 256, TOPK = 8, NGRP = 8, TOPG = 4, ED = 256;
constexpr int NS_MAX = 327680;
constexpr float EPS = 1e-6f;
constexpr float LAM_INIT = 0.2f;
constexpr float ROUTED_SCALE = 2.5f;

constexpr size_t MiB = 1u << 20;
constexpr size_t WS_CTL = 0, CTL_BYTES = 1 * MiB;
constexpr int CW_COUNTS = 1024;
constexpr int CW_CURSOR = 1024 + 256;
constexpr int CW_NTILES = 2048;
constexpr int CW_BAR = 4096;
constexpr size_t CTL_SS1 = 256 * 1024;
constexpr size_t CTL_SS2 = 384 * 1024;
constexpr size_t WS_MOD = 512 * 1024;
constexpr size_t WS_LAM = 1 * MiB + 256 * 1024;
constexpr size_t WS_ROPE = 1 * MiB + 512 * 1024;
constexpr size_t WS_SSMP = 2 * MiB + 512 * 1024;
constexpr size_t WS_SS1P = 3 * MiB;
constexpr size_t WS_SS2P = 1008 * MiB;
constexpr size_t WS_EIDX = 4 * MiB;
constexpr size_t WS_GATEW = 5 * MiB;
constexpr size_t WS_SLOT_TOK = 6 * MiB;
constexpr size_t WS_SLOT_ASG = 7 * MiB + 512 * 1024;
constexpr size_t WS_SLOT_GATE = 9 * MiB;
constexpr size_t WS_TILE_E = 10 * MiB + 512 * 1024;
constexpr size_t WS_PADST = 10 * MiB + 768 * 1024;
constexpr size_t WS_WIN_T = 12 * MiB;
constexpr size_t WS_WOUT_T = 16 * MiB;
constexpr size_t WS_WGLU_T = 18 * MiB;
constexpr size_t WS_WRS_T = 19 * MiB;
constexpr size_t WS_WDS_T = 21 * MiB;
constexpr size_t WS_SSM_BA = 22 * MiB;
constexpr size_t WS_SSM_BC = 26 * MiB;
constexpr size_t WS_DS = 496 * MiB;
constexpr size_t WS_WGU = 32 * MiB;
constexpr size_t WS_WD = 704 * MiB;
constexpr size_t WS_YA = 32 * MiB;
constexpr size_t WS_H = 288 * MiB;
constexpr size_t WS_QK = 352 * MiB;
constexpr size_t WS_Y = 976 * MiB;
constexpr size_t WS_V = 416 * MiB;
constexpr size_t WS_AP = 448 * MiB;
constexpr size_t WS_ACTE = 544 * MiB;
constexpr size_t WS_MIXIN = 544 * MiB;
constexpr size_t WS_LOGITS = 608 * MiB;
constexpr size_t WS_ACTS = 960 * MiB;
constexpr size_t WS_ATTO = 832 * MiB;
constexpr size_t WS_NEED = 1024 * MiB;

__device__ __forceinline__ float bf2f(bf16_t v) { return __uint_as_float((unsigned)v << 16); }
__device__ __forceinline__ bf16_t f2bf(float f) { unsigned u = __float_as_uint(f); return (bf16_t)((u + 0x7fffu + ((u >> 16) & 1u)) >> 16); }
__device__ __forceinline__ unsigned pk2(float lo, float hi) { return (unsigned)f2bf(lo) | ((unsigned)f2bf(hi) << 16); }
__device__ __forceinline__ float wave_sum(float v) {
#pragma unroll
    for (int o = 1; o < 64; o <<= 1) v += __shfl_xor(v, o);
    return v;
}
__device__ __forceinline__ float siluf(float v) { return v / (1.f + __expf(-v)); }
__device__ __forceinline__ float sigmoidf(float v) { return 1.f / (1.f + __expf(-v)); }
__device__ __forceinline__ float gelu_tanh(float v) { const float u = 0.7978845608028654f * (v + 0.044715f * v * v * v); return 0.5f * v * (1.f + tanhf(u)); }

constexpr int NTHREADS_ = 512;
struct Params {
    const float* in[33];
    float* out;
    unsigned char* ws;
    int pad0, pad1;
};

struct Ctx {
    int tid, lane, wave, bid, nb;
    int gtid, gthreads, gwave, gwaves;
    unsigned char* ws;
    float* lds;
};

enum { I_X = 0, I_C, I_N1G, I_N2G, I_WADA, I_BADA, I_WIN, I_QNG, I_KNG, I_LQ1, I_LK1, I_LQ2, I_LK2, I_SUBG,
       I_ARE, I_AIM, I_LOGDT, I_BRE, I_BIM, I_CRE, I_CIM, I_SD, I_WGLU, I_SNG, I_WOUT, I_WR, I_RB,
       I_WGE, I_WUE, I_WDE, I_WGS, I_WUS, I_WDS };

struct SG_Args {
    const bf16_t* A; int lda; const int* rowidx;
    const float* W; const float* W2; int ldb;
    size_t wstride;
    const int* tile_e;
    int M, N, K;
};
template <bool DUAL, class Epi>
__device__ __forceinline__ void sgemm_phase(const Ctx& c, const SG_Args g, const Epi& E) {
    float* As = c.lds;
    float* Bs = c.lds + 16 * 132;
    float* Bs2 = Bs + 16 * 128;
    const int tid = c.tid, ty = tid >> 5, tx = tid & 31;
    const int nMt = g.M / 128, nNt = g.N / 128, ntile = nMt * nNt;
    for (int tile = c.bid; tile < ntile; tile += c.nb) {
        const int mt = tile / nNt, nt = tile % nNt;
        const float* W = g.W; const float* W2 = g.W2;
        if (g.tile_e) { const int e = g.tile_e[mt >> 1]; if (e < 0) continue; W += (size_t)e * g.wstride; if (DUAL) W2 += (size_t)e * g.wstride; }
        f32x4 acc[8], acc2[8];
#pragma unroll
        for (int i = 0; i < 8; ++i) { acc[i] = (f32x4){0.f, 0.f, 0.f, 0.f}; acc2[i] = (f32x4){0.f, 0.f, 0.f, 0.f}; }
        const int arow = mt * 128 + (tid >> 2), akq = (tid & 3) * 4;
        const int asrc = g.rowidx ? g.rowidx[arow] : arow;
        const bf16_t* ap = g.A + (size_t)asrc * g.lda + akq;
        const int bk = tid >> 5, bn = (tid & 31) * 4;
        const float* bp = W + (size_t)bk * g.ldb + nt * 128 + bn;
        const float* bp2 = DUAL ? (W2 + (size_t)bk * g.ldb + nt * 128 + bn) : nullptr;
#pragma unroll 1
        for (int k0 = 0; k0 < g.K; k0 += 16) {
            const u32x2 av = *(const u32x2*)(ap + k0);
            const f32x4 bv = *(const f32x4*)(bp + (size_t)k0 * g.ldb);
            f32x4 bv2 = {0.f, 0.f, 0.f, 0.f};
            if (DUAL) bv2 = *(const f32x4*)(bp2 + (size_t)k0 * g.ldb);
            __syncthreads();
            As[(akq + 0) * 132 + (tid >> 2)] = __uint_as_float(av.x << 16);
            As[(akq + 1) * 132 + (tid >> 2)] = __uint_as_float(av.x & 0xffff0000u);
            As[(akq + 2) * 132 + (tid >> 2)] = __uint_as_float(av.y << 16);
            As[(akq + 3) * 132 + (tid >> 2)] = __uint_as_float(av.y & 0xffff0000u);
            *(f32x4*)(Bs + bk * 128 + bn) = bv;
            if (DUAL) *(f32x4*)(Bs2 + bk * 128 + bn) = bv2;
            __syncthreads();
#pragma unroll
            for (int kk = 0; kk < 16; ++kk) {
                const f32x4 a0 = *(const f32x4*)(As + kk * 132 + ty * 8), a1 = *(const f32x4*)(As + kk * 132 + ty * 8 + 4);
                const f32x4 b = *(const f32x4*)(Bs + kk * 128 + tx * 4);
                const float a[8] = {a0.x, a0.y, a0.z, a0.w, a1.x, a1.y, a1.z, a1.w};
#pragma unroll
                for (int i = 0; i < 8; ++i) acc[i] += a[i] * b;
                if (DUAL) {
                    const f32x4 b2 = *(const f32x4*)(Bs2 + kk * 128 + tx * 4);
#pragma unroll
                    for (int i = 0; i < 8; ++i) acc2[i] += a[i] * b2;
                }
            }
        }
#pragma unroll
        for (int i = 0; i < 8; ++i) E(mt * 128 + ty * 8 + i, nt * 128 + tx * 4, acc[i], acc2[i], tx);
    }
}

__device__ __forceinline__ void ph_prologue(const Ctx& c, const Params& p) {
    float* mod = (float*)(c.ws + WS_MOD);
    for (int idx = c.gtid; idx < NB * 6 * DM; idx += c.gthreads) {
        const int b = idx / (6 * DM), j = idx % (6 * DM);
        const float* cc = p.in[I_C] + b * DM; const float* w = p.in[I_WADA] + j;
        float acc = p.in[I_BADA][j];
#pragma unroll 8
        for (int k = 0; k < DM; ++k) acc += siluf(cc[k]) * w[(size_t)k * (6 * DM)];
        mod[idx] = acc;
    }
    float* ropec = (float*)(c.ws + WS_ROPE); float* ropes = ropec + SEQ * 32;
    for (int idx = c.gtid; idx < SEQ * 32; idx += c.gthreads) {
        const int l = idx >> 5, i = idx & 31;
        const double invf = exp(-log(10000.0) * (double)(2 * i) / 64.0);
        const double ang = (double)l * invf;
        ropec[idx] = (float)cos(ang); ropes[idx] = (float)sin(ang);
    }
    float* sp = (float*)(c.ws + WS_SSMP);
    float* abr = sp, * abi = sp + SG * SP, * bbr = sp + 2 * SG * SP, * bbi = bbr + SG * SP * SC;
    for (int idx = c.gtid; idx < SG * SP; idx += c.gthreads) {
        const int g = idx / SP;
        const double are = p.in[I_ARE][idx], aim = p.in[I_AIM][idx], dt = exp((double)p.in[I_LOGDT][g]);
        const double mag = exp(are * dt), ar = mag * cos(aim * dt), ai = mag * sin(aim * dt);
        abr[idx] = (float)ar; abi[idx] = (float)ai;
        const double den = are * are + aim * aim, nr = ar - 1.0;
        const double fre = (nr * are + ai * aim) / den, fim = (ai * are - nr * aim) / den;
        for (int ch = 0; ch < SC; ++ch) {
            const double br = p.in[I_BRE][idx * SC + ch], bi = p.in[I_BIM][idx * SC + ch];
            bbr[idx * SC + ch] = (float)(fre * br - fim * bi); bbi[idx * SC + ch] = (float)(fre * bi + fim * br);
        }
    }
    if (c.gtid == 0) {
        float s1 = 0.f, s2 = 0.f, gq = 0.f, gk = 0.f;
        for (int i = 0; i < HD; ++i) { s1 += p.in[I_LQ1][i] * p.in[I_LK1][i]; s2 += p.in[I_LQ2][i] * p.in[I_LK2][i];
            gq = fmaxf(gq, fabsf(p.in[I_QNG][i])); gk = fmaxf(gk, fabsf(p.in[I_KNG][i])); }
        float* lam = (float*)(c.ws + WS_LAM);
        lam[0] = __expf(s1) - __expf(s2) + LAM_INIT;
        lam[1] = 0.125f * 64.f * gq * gk;
    }
    int* stok = (int*)(c.ws + WS_SLOT_TOK); int* sasg = (int*)(c.ws + WS_SLOT_ASG); float* sgate = (float*)(c.ws + WS_SLOT_GATE);
    for (int idx = c.gtid; idx < NS_MAX; idx += c.gthreads) { stok[idx] = 0; sasg[idx] = -1; sgate[idx] = 0.f; }
    int* te = (int*)(c.ws + WS_TILE_E);
    for (int idx = c.gtid; idx < NS_MAX / 256; idx += c.gthreads) te[idx] = -1;
}

__device__ __forceinline__ void ph_h1(const Ctx& c, const Params& p) {
    const float* mod = (const float*)(c.ws + WS_MOD); bf16_t* H = (bf16_t*)(c.ws + WS_H);
    for (int t = c.gwave; t < T; t += c.gwaves) {
        const int b = t / SEQ; const f32x4* xr = (const f32x4*)(p.in[I_X] + (size_t)t * DM) + c.lane;
        f32x4 v[4]; float s = 0.f;
#pragma unroll
        for (int j = 0; j < 4; ++j) { v[j] = xr[64 * j]; s += v[j].x * v[j].x + v[j].y * v[j].y + v[j].z * v[j].z + v[j].w * v[j].w; }
        const float rstd = rsqrtf(wave_sum(s) * (1.f / DM) + EPS);
        const float* sh = mod + b * 6 * DM, * sc = sh + DM;
#pragma unroll
        for (int j = 0; j < 4; ++j) { const int col = 4 * c.lane + 256 * j;
            const f32x4 g = *(const f32x4*)(p.in[I_N1G] + col), s1 = *(const f32x4*)(sc + col), h1 = *(const f32x4*)(sh + col);
            const f32x4 o = (v[j] * rstd * g) * (1.f + s1) + h1;
            u32x2 w; w.x = pk2(o.x, o.y); w.y = pk2(o.z, o.w); *(u32x2*)(H + (size_t)t * DM + col) = w; }
    }
}

struct EpiWin {
    bf16_t* QK; bf16_t* V; bf16_t* AP;
    __device__ __forceinline__ void operator()(int row, int col, const f32x4& a, const f32x4&, int) const {
        u32x2 w; w.x = pk2(a[0], a[1]); w.y = pk2(a[2], a[3]);
        if (col < 1024) *(u32x2*)(QK + (size_t)row * 1024 + col) = w;
        else if (col < 1536) *(u32x2*)(V + (size_t)row * 512 + (col - 1024)) = w;
        else { const int cc = col - 1536, g = cc >> 4, ch = cc & 15, b = row / SEQ, l = row % SEQ;
            *(u32x2*)(AP + ((size_t)(g * (NB * NCHUNK) + b * NCHUNK + (l >> 4)) * APK + (l & 15) * 16 + ch)) = w; }
    }
};

__device__ __forceinline__ void ph_qkn(const Ctx& c, const Params& p) {
    bf16_t* QK = (bf16_t*)(c.ws + WS_QK);
    const float* ropec = (const float*)(c.ws + WS_ROPE); const float* ropes = ropec + SEQ * 32;
    const int l = c.lane;
    const float gq = p.in[I_QNG][l], gk = p.in[I_KNG][l];
    for (int t = c.gwave; t < T; t += c.gwaves) {
        const int pos = t % SEQ; const float cs = ropec[pos * 32 + (l & 31)], sn = ropes[pos * 32 + (l & 31)];
        bf16_t* r = QK + (size_t)t * 1024;
#pragma unroll 4
        for (int gi = 0; gi < 16; ++gi) {
            const float v = bf2f(r[gi * 64 + l]);
            const float rstd = rsqrtf(wave_sum(v * v) * (1.f / 64.f) + EPS);
            const float y = v * rstd * (gi < 8 ? gq : gk);
            const float o = __shfl_xor(y, 32);
            const float res = (l < 32) ? (y * cs - o * sn) : (o * sn + y * cs);
            r[gi * 64 + l] = f2bf(res);
        }
    }
}

__device__ __forceinline__ void ph_att_base(const Ctx& c, const Params& p) {
    const bf16_t* QK = (const bf16_t*)(c.ws + WS_QK); const bf16_t* V = (const bf16_t*)(c.ws + WS_V); float* AO = (float*)(c.ws + WS_ATTO);
    const float smax = ((const float*)(c.ws + WS_LAM))[1];
    const int nitem = NB * NH * 4 * (SEQ / 64);
    for (int it = c.gwave; it < nitem; it += c.gwaves) {
        const int qb = (SEQ / 64 - 1) - (it / (NB * NH * 4)), bhc = it % (NB * NH * 4), b = bhc / (NH * 4), h = (bhc >> 2) % NH, cc = (bhc >> 1) & 1, vh = bhc & 1;
        const int q = qb * 64 + c.lane; const size_t trow = (size_t)b * SEQ + q;
        float qv[64];
        { const bf16_t* qp = QK + trow * 1024 + h * 128 + cc * 64;
#pragma unroll
          for (int d = 0; d < 64; ++d) qv[d] = bf2f(qp[d]) * 0.125f; }
        float o[64];
#pragma unroll
        for (int d = 0; d < 64; ++d) o[d] = 0.f;
        float lsum = 0.f;
        const int jmax = qb * 64 + 63;
        for (int j = 0; j <= jmax; ++j) {
            const size_t krow = (size_t)b * SEQ + j;
            const u32x4* kp = (const u32x4*)(QK + krow * 1024 + 512 + h * 128 + cc * 64);
            float s = 0.f;
#pragma unroll
            for (int i = 0; i < 8; ++i) { const u32x4 kk = kp[i];
                s += qv[8 * i + 0] * __uint_as_float(kk.x << 16) + qv[8 * i + 1] * __uint_as_float(kk.x & 0xffff0000u)
                   + qv[8 * i + 2] * __uint_as_float(kk.y << 16) + qv[8 * i + 3] * __uint_as_float(kk.y & 0xffff0000u)
                   + qv[8 * i + 4] * __uint_as_float(kk.z << 16) + qv[8 * i + 5] * __uint_as_float(kk.z & 0xffff0000u)
                   + qv[8 * i + 6] * __uint_as_float(kk.w << 16) + qv[8 * i + 7] * __uint_as_float(kk.w & 0xffff0000u); }
            float pe = (j <= q) ? __expf(s - smax) : 0.f;
            lsum += pe;
            const u32x4* vp = (const u32x4*)(V + krow * 512 + h * 128 + vh * 64);
#pragma unroll
            for (int i = 0; i < 8; ++i) { const u32x4 vv = vp[i];
                o[8 * i + 0] += pe * __uint_as_float(vv.x << 16); o[8 * i + 1] += pe * __uint_as_float(vv.x & 0xffff0000u);
                o[8 * i + 2] += pe * __uint_as_float(vv.y << 16); o[8 * i + 3] += pe * __uint_as_float(vv.y & 0xffff0000u);
                o[8 * i + 4] += pe * __uint_as_float(vv.z << 16); o[8 * i + 5] += pe * __uint_as_float(vv.z & 0xffff0000u);
                o[8 * i + 6] += pe * __uint_as_float(vv.w << 16); o[8 * i + 7] += pe * __uint_as_float(vv.w & 0xffff0000u); }
        }
        const float rl = 1.f / lsum;
        float* op = AO + (trow * 8 + h * 2 + cc) * 128 + vh * 64;
#pragma unroll
        for (int d = 0; d < 64; d += 4) *(f32x4*)(op + d) = (f32x4){o[d] * rl, o[d + 1] * rl, o[d + 2] * rl, o[d + 3] * rl};
    }
}
__device__ __forceinline__ void ph_att_comb(const Ctx& c, const Params& p) {
    const float* AO = (const float*)(c.ws + WS_ATTO); bf16_t* MX = (bf16_t*)(c.ws + WS_MIXIN);
    const float lam = ((const float*)(c.ws + WS_LAM))[0];
    for (int it = c.gwave; it < T * NH; it += c.gwaves) {
        const int t = it >> 2, h = it & 3;
        const float* o1 = AO + ((size_t)t * 8 + h * 2) * 128, * o2 = o1 + 128;
        const float a = o1[c.lane] - lam * o2[c.lane], b = o1[64 + c.lane] - lam * o2[64 + c.lane];
        const float rstd = rsqrtf(wave_sum(a * a + b * b) * (1.f / 128.f) + EPS) * (1.f - LAM_INIT);
        MX[(size_t)t * 1024 + h * 128 + c.lane] = f2bf(a * rstd * p.in[I_SUBG][c.lane]);
        MX[(size_t)t * 1024 + h * 128 + 64 + c.lane] = f2bf(b * rstd * p.in[I_SUBG][64 + c.lane]);
    }
}

__device__ __forceinline__ void ph_ssm_base(const Ctx& c, const Params& p) {
    const bf16_t* AP = (const bf16_t*)(c.ws + WS_AP); bf16_t* Y = (bf16_t*)(c.ws + WS_Y);
    const float* sp = (const float*)(c.ws + WS_SSMP);
    const float* abr = sp, * abi = sp + SG * SP, * bbr = sp + 2 * SG * SP, * bbi = bbr + SG * SP * SC;
    for (int it = c.gwave; it < NB * SG; it += c.gwaves) {
        const int b = it / SG, g = it % SG, pp = c.lane;
        const float ar = abr[g * SP + pp], ai = abi[g * SP + pp];
        float br[16], bi[16], cr[16], ci[16];
#pragma unroll
        for (int ch = 0; ch < 16; ++ch) { br[ch] = bbr[(g * SP + pp) * SC + ch]; bi[ch] = bbi[(g * SP + pp) * SC + ch];
            cr[ch] = p.in[I_CRE][(g * SC + ch) * SP + pp]; ci[ch] = p.in[I_CIM][(g * SC + ch) * SP + pp]; }
        const float dsk = (pp < 16) ? p.in[I_SD][g * SC + pp] : 0.f;
        float sr = 0.f, si = 0.f;
        for (int l = 0; l < SEQ; ++l) {
            const bf16_t* up = AP + ((size_t)(g * (NB * NCHUNK) + b * NCHUNK + (l >> 4)) * APK + (l & 15) * 16);
            const u32x4 u0 = *(const u32x4*)up, u1 = *(const u32x4*)(up + 8);
            float u[16] = { __uint_as_float(u0.x << 16), __uint_as_float(u0.x & 0xffff0000u), __uint_as_float(u0.y << 16), __uint_as_float(u0.y & 0xffff0000u),
                            __uint_as_float(u0.z << 16), __uint_as_float(u0.z & 0xffff0000u), __uint_as_float(u0.w << 16), __uint_as_float(u0.w & 0xffff0000u),
                            __uint_as_float(u1.x << 16), __uint_as_float(u1.x & 0xffff0000u), __uint_as_float(u1.y << 16), __uint_as_float(u1.y & 0xffff0000u),
                            __uint_as_float(u1.z << 16), __uint_as_float(u1.z & 0xffff0000u), __uint_as_float(u1.w << 16), __uint_as_float(u1.w & 0xffff0000u) };
            float bur = 0.f, bui = 0.f;
#pragma unroll
            for (int ch = 0; ch < 16; ++ch) { bur += u[ch] * br[ch]; bui += u[ch] * bi[ch]; }
            const float nr = ar * sr - ai * si + bur, ni = ar * si + ai * sr + bui; sr = nr; si = ni;
            float mine = 0.f;
#pragma unroll
            for (int ch = 0; ch < 16; ++ch) { const float v = wave_sum(sr * cr[ch] - si * ci[ch]); if (pp == ch) mine = v + dsk * u[ch]; }
            if (pp < 16) Y[((size_t)b * SEQ + l) * 512 + g * 16 + pp] = f2bf(gelu_tanh(mine));
        }
    }
}

struct EpiGlu {
    const bf16_t* Y; bf16_t* MX; float* ss;
    __device__ __forceinline__ void operator()(int row, int col, const f32x4& a, const f32x4&, int) const {
        const u32x2 yv = *(const u32x2*)(Y + (size_t)row * 512 + col);
        const float y0 = __uint_as_float(yv.x << 16), y1 = __uint_as_float(yv.x & 0xffff0000u), y2 = __uint_as_float(yv.y << 16), y3 = __uint_as_float(yv.y & 0xffff0000u);
        const float v0 = y0 * sigmoidf(a[0]), v1 = y1 * sigmoidf(a[1]), v2 = y2 * sigmoidf(a[2]), v3 = y3 * sigmoidf(a[3]);
        u32x2 w; w.x = pk2(v0, v1); w.y = pk2(v2, v3); *(u32x2*)(MX + (size_t)row * 1024 + 512 + col) = w;
        float s = v0 * v0 + v1 * v1 + v2 * v2 + v3 * v3;
#pragma unroll
        for (int o = 1; o < 32; o <<= 1) s += __shfl_xor(s, o);
        if ((threadIdx.x & 31) == 0) atomicAdd(ss + row, s);
    }
};
__device__ __forceinline__ void ph_ssm_norm(const Ctx& c, const Params& p) {
    bf16_t* MX = (bf16_t*)(c.ws + WS_MIXIN); const float* ss = (const float*)(c.ws + WS_CTL + CTL_SS1);
    for (int t = c.gwave; t < T; t += c.gwaves) {
        const float rstd = rsqrtf(ss[t] * (1.f / 512.f) + EPS);
        bf16_t* r = MX + (size_t)t * 1024 + 512 + c.lane * 8; const float* g = p.in[I_SNG] + c.lane * 8;
        u32x4 w = *(u32x4*)r; unsigned* wp = (unsigned*)&w;
#pragma unroll
        for (int i = 0; i < 4; ++i) { const float a = __uint_as_float(wp[i] << 16) * rstd * g[2 * i], b = __uint_as_float(wp[i] & 0xffff0000u) * rstd * g[2 * i + 1]; wp[i] = pk2(a, b); }
        *(u32x4*)r = w;
    }
}
__device__ __forceinline__ void ph_ssm_norm2(const Ctx& c, const Params& p) {
    bf16_t* MX = (bf16_t*)(c.ws + WS_MIXIN); const float* ss = (const float*)(c.ws + WS_SS1P);
    for (int t = c.gwave; t < T; t += c.gwaves) {
        const f32x4 s0 = *(const f32x4*)(ss + (size_t)t * 8), s1 = *(const f32x4*)(ss + (size_t)t * 8 + 4);
        const float tot = ((s0.x + s0.y) + (s0.z + s0.w)) + ((s1.x + s1.y) + (s1.z + s1.w));
        const float rstd = rsqrtf(tot * (1.f / 512.f) + EPS);
        bf16_t* r = MX + (size_t)t * 1024 + 512 + c.lane * 8; const float* g = p.in[I_SNG] + c.lane * 8;
        u32x4 w = *(u32x4*)r; unsigned* wp = (unsigned*)&w;
#pragma unroll
        for (int i = 0; i < 4; ++i) { const float a = __uint_as_float(wp[i] << 16) * rstd * g[2 * i], b = __uint_as_float(wp[i] & 0xffff0000u) * rstd * g[2 * i + 1]; wp[i] = pk2(a, b); }
        *(u32x4*)r = w;
    }
}
struct EpiWout {
    const float* x; const float* mod; float* out; float* ss;
    __device__ __forceinline__ void operator()(int row, int col, const f32x4& a, const f32x4&, int) const {
        const int b = row / SEQ; const f32x4 xv = *(const f32x4*)(x + (size_t)row * DM + col), g1 = *(const f32x4*)(mod + b * 6 * DM + 2 * DM + col);
        const f32x4 o = {xv.x + g1.x * a[0], xv.y + g1.y * a[1], xv.z + g1.z * a[2], xv.w + g1.w * a[3]};
        *(f32x4*)(out + (size_t)row * DM + col) = o;
        float s = o.x * o.x + o.y * o.y + o.z * o.z + o.w * o.w;
#pragma unroll
        for (int of = 1; of < 32; of <<= 1) s += __shfl_xor(s, of);
        if ((threadIdx.x & 31) == 0) atomicAdd(ss + row, s);
    }
};
__device__ __forceinline__ void ph_h2(const Ctx& c, const Params& p) {
    const float* mod = (const float*)(c.ws + WS_MOD); bf16_t* H = (bf16_t*)(c.ws + WS_H);
    const float* ss = (const float*)(c.ws + WS_CTL + CTL_SS2);
    for (int t = c.gwave; t < T; t += c.gwaves) {
        const int b = t / SEQ; const f32x4* xr = (const f32x4*)(p.out + (size_t)t * DM) + c.lane;
        const float rstd = rsqrtf(ss[t] * (1.f / DM) + EPS);
        const float* sh = mod + b * 6 * DM + 3 * DM, * sc = sh + DM;
#pragma unroll
        for (int j = 0; j < 4; ++j) { const int col = 4 * c.lane + 256 * j; const f32x4 v = xr[64 * j];
            const f32x4 g = *(const f32x4*)(p.in[I_N2G] + col), s1 = *(const f32x4*)(sc + col), h1 = *(const f32x4*)(sh + col);
            const f32x4 o = (v * rstd * g) * (1.f + s1) + h1;
            u32x2 w; w.x = pk2(o.x, o.y); w.y = pk2(o.z, o.w); *(u32x2*)(H + (size_t)t * DM + col) = w; }
    }
}
__device__ __forceinline__ void ph_h2_2(const Ctx& c, const Params& p) {
    const float* mod = (const float*)(c.ws + WS_MOD); bf16_t* H = (bf16_t*)(c.ws + WS_H);
    const float* ss = (const float*)(c.ws + WS_SS2P);
    for (int t = c.gwave; t < T; t += c.gwaves) {
        const int b = t / SEQ; const f32x4* xr = (const f32x4*)(p.out + (size_t)t * DM) + c.lane;
        float tot = 0.f;
#pragma unroll
        for (int i = 0; i < 4; ++i) { const f32x4 sv = *(const f32x4*)(ss + (size_t)t * 16 + 4 * i); tot += (sv.x + sv.y) + (sv.z + sv.w); }
        const float rstd = rsqrtf(tot * (1.f / DM) + EPS);
        const float* sh = mod + b * 6 * DM + 3 * DM, * sc = sh + DM;
#pragma unroll
        for (int j = 0; j < 4; ++j) { const int col = 4 * c.lane + 256 * j; const f32x4 v = xr[64 * j];
            const f32x4 g = *(const f32x4*)(p.in[I_N2G] + col), s1 = *(const f32x4*)(sc + col), h1 = *(const f32x4*)(sh + col);
            const f32x4 o = (v * rstd * g) * (1.f + s1) + h1;
            u32x2 w; w.x = pk2(o.x, o.y); w.y = pk2(o.z, o.w); *(u32x2*)(H + (size_t)t * DM + col) = w; }
    }
}
struct EpiLogits { float* L; __device__ __forceinline__ void operator()(int row, int col, const f32x4& a, const f32x4&, int) const { *(f32x4*)(L + (size_t)row * 256 + col) = (f32x4){a[0], a[1], a[2], a[3]}; } };
struct EpiSwiglu { bf16_t* O; int ldo;
    __device__ __forceinline__ void operator()(int row, int col, const f32x4& a, const f32x4& b, int) const {
        u32x2 w; w.x = pk2(siluf(a[0]) * b[0], siluf(a[1]) * b[1]); w.y = pk2(siluf(a[2]) * b[2], siluf(a[3]) * b[3]); *(u32x2*)(O + (size_t)row * ldo + col) = w; } };

__device__ __forceinline__ void ph_route(const Ctx& c, const Params& p) {
    const float* L = (const float*)(c.ws + WS_LOGITS);
    int* eidx = (int*)(c.ws + WS_EIDX); float* gw = (float*)(c.ws + WS_GATEW); unsigned* counts = (unsigned*)(c.ws + WS_CTL) + CW_COUNTS;
    const int l = c.lane; const float NEG = -__builtin_inff();
    float rb[4];
#pragma unroll
    for (int r = 0; r < 4; ++r) rb[r] = p.in[I_RB][l + 64 * r];
    for (int t = c.gwave; t < T; t += c.gwaves) {
        float s[4], sb[4];
#pragma unroll
        for (int r = 0; r < 4; ++r) { s[r] = sigmoidf(L[(size_t)t * 256 + l + 64 * r]); sb[r] = s[r] + rb[r]; }
        float gs[4];
#pragma unroll
        for (int r = 0; r < 4; ++r) {
            float m1 = sb[r]; int i1 = l;
#pragma unroll
            for (int o = 1; o < 32; o <<= 1) { const float om = __shfl_xor(m1, o); const int oi = __shfl_xor(i1, o); if (om > m1 || (om == m1 && oi < i1)) { m1 = om; i1 = oi; } }
            float m2 = (l == i1) ? NEG : sb[r];
#pragma unroll
            for (int o = 1; o < 32; o <<= 1) m2 = fmaxf(m2, __shfl_xor(m2, o));
            gs[r] = m1 + m2;
        }
        float gsc[8];
#pragma unroll
        for (int r = 0; r < 4; ++r) { gsc[2 * r] = __shfl(gs[r], 0); gsc[2 * r + 1] = __shfl(gs[r], 32); }
        unsigned gmask = 0;
#pragma unroll
        for (int a = 0; a < 8; ++a) { int rank = 0;
#pragma unroll
            for (int b2 = 0; b2 < 8; ++b2) rank += (gsc[b2] > gsc[a] || (gsc[b2] == gsc[a] && b2 < a)) ? 1 : 0;
            if (rank < TOPG) gmask |= 1u << a; }
        float mv[4];
#pragma unroll
        for (int r = 0; r < 4; ++r) mv[r] = ((gmask >> (2 * r + (l >> 5))) & 1u) ? sb[r] : NEG;
        float wsel = 0.f; int esel = -1; float wsum = 0.f;
#pragma unroll
        for (int k = 0; k < TOPK; ++k) {
            float bm = mv[0]; int bi = l;
#pragma unroll
            for (int r = 1; r < 4; ++r) if (mv[r] > bm) { bm = mv[r]; bi = l + 64 * r; }
#pragma unroll
            for (int o = 1; o < 64; o <<= 1) { const float om = __shfl_xor(bm, o); const int oi = __shfl_xor(bi, o); if (om > bm || (om == bm && oi < bi)) { bm = om; bi = oi; } }
            float sv = 0.f;
#pragma unroll
            for (int r = 0; r < 4; ++r) if (bi == l + 64 * r) { sv = s[r]; mv[r] = NEG; }
            sv = __shfl(sv, bi & 63);
            wsum += sv;
            if (l == k) { wsel = sv; esel = bi; }
        }
        if (l < TOPK) { eidx[t * 8 + l] = esel; gw[t * 8 + l] = wsel / wsum * ROUTED_SCALE; atomicAdd(counts + esel, 1u); }
    }
}
__device__ __forceinline__ void ph_slot(const Ctx& c, const Params& p) {
    const unsigned* counts = (const unsigned*)(c.ws + WS_CTL) + CW_COUNTS; unsigned* cursor = (unsigned*)(c.ws + WS_CTL) + CW_CURSOR;
    int* ps = (int*)c.lds;
    if (c.tid == 0) { int acc = 0; for (int e = 0; e < NE; ++e) { ps[e] = acc; acc += ((int)counts[e] + 255) / 256 * 256; } ps[NE] = acc; }
    __syncthreads();
    const int* eidx = (const int*)(c.ws + WS_EIDX); const float* gw = (const float*)(c.ws + WS_GATEW);
    int* stok = (int*)(c.ws + WS_SLOT_TOK); int* sasg = (int*)(c.ws + WS_SLOT_ASG); float* sgate = (float*)(c.ws + WS_SLOT_GATE);
    for (int a = c.gtid; a < T * TOPK; a += c.gthreads) {
        const int e = eidx[a]; const unsigned pos = atomicAdd(cursor + e, 1u); const int slot = ps[e] + (int)pos;
        stok[slot] = a >> 3; sasg[slot] = a; sgate[slot] = gw[a];
    }
    if (c.bid == 0) {
        int* te = (int*)(c.ws + WS_TILE_E); int* padst = (int*)(c.ws + WS_PADST);
        for (int e = c.tid; e <= NE; e += 512) padst[e] = ps[e];
        for (int e = c.tid; e < NE; e += 512) for (int tl = ps[e] / 256; tl < ps[e + 1] / 256; ++tl) te[tl] = e;
        if (c.tid == 0) ((unsigned*)(c.ws + WS_CTL))[CW_NTILES] = (unsigned)(ps[NE] / 256);
    }
}
struct EpiE2 { const int* sasg; const float* sgate; bf16_t* YA;
    __device__ __forceinline__ void operator()(int row, int col, const f32x4& a, const f32x4&, int) const {
        const int asg = sasg[row]; if (asg < 0) return; const float g = sgate[row];
        u32x2 w; w.x = pk2(g * a[0], g * a[1]); w.y = pk2(g * a[2], g * a[3]); *(u32x2*)(YA + (size_t)asg * DM + col) = w; } };
struct EpiSD { const float* mod; float* out;
    __device__ __forceinline__ void operator()(int row, int col, const f32x4& a, const f32x4&, int) const {
        const int b = row / SEQ; const f32x4 g2 = *(const f32x4*)(mod + b * 6 * DM + 5 * DM + col); f32x4* o = (f32x4*)(out + (size_t)row * DM + col);
        f32x4 v = *o; v.x += g2.x * a[0]; v.y += g2.y * a[1]; v.z += g2.z * a[2]; v.w += g2.w * a[3]; *o = v; } };
__device__ __forceinline__ void ph_combine(const Ctx& c, const Params& p) {
    const float* mod = (const float*)(c.ws + WS_MOD); const bf16_t* YA = (const bf16_t*)(c.ws + WS_YA); float* out = p.out;
    for (int idx = c.gtid; idx < T * (DM / 8); idx += c.gthreads) {
        const int t = idx >> 7, col = (idx & 127) * 8, b = t / SEQ;
        float s[8] = {0.f, 0.f, 0.f, 0.f, 0.f, 0.f, 0.f, 0.f};
#pragma unroll
        for (int k = 0; k < 8; ++k) { const u32x4 w = *(const u32x4*)(YA + ((size_t)t * 8 + k) * DM + col); const unsigned* wp = (const unsigned*)&w;
#pragma unroll
            for (int i = 0; i < 4; ++i) { s[2 * i] += __uint_as_float(wp[i] << 16); s[2 * i + 1] += __uint_as_float(wp[i] & 0xffff0000u); } }
        const float* g2 = mod + b * 6 * DM + 5 * DM + col; float* o = out + (size_t)t * DM + col;
        f32x4 o0 = *(f32x4*)o, o1 = *(f32x4*)(o + 4);
        o0.x += g2[0] * s[0]; o0.y += g2[1] * s[1]; o0.z += g2[2] * s[2]; o0.w += g2[3] * s[3];
        o1.x += g2[4] * s[4]; o1.y += g2[5] * s[5]; o1.z += g2[6] * s[6]; o1.w += g2[7] * s[7];
        *(f32x4*)o = o0; *(f32x4*)(o + 4) = o1;
    }
}


#define GAS __attribute__((address_space(1)))
#define LAS __attribute__((address_space(3)))
#define XB_TMO      128
#define XB_XCNT(j)  (256  + 64 * (j))
#define XB_XSUB(j)  (1280 + 64 * (j))
#define XB_XGEN(j)  (2304 + 64 * (j))
#define XB_TOP      3328
#define XB_TOPGEN   3392
#define XCD_BAR_WORDS 3456
#define XB_SPIN_CAP (1u << 18)

__device__ __forceinline__ unsigned xb_ld(unsigned* p)              { return __hip_atomic_load(p, __ATOMIC_RELAXED, __HIP_MEMORY_SCOPE_AGENT); }
__device__ __forceinline__ unsigned xb_add(unsigned* p, unsigned v) { return __hip_atomic_fetch_add(p, v, __ATOMIC_RELAXED, __HIP_MEMORY_SCOPE_AGENT); }
__device__ __forceinline__ unsigned xb_xcc_id() { return (unsigned)__builtin_amdgcn_s_getreg((3 << 11) | 20) & 0xFu; }
#define XB_SPIN(cond, bar) do { unsigned _sp = 0; while (cond) { __builtin_amdgcn_s_sleep(1); \
    if ((++_sp & 255u) == 0u) { if (xb_ld(&(bar)[XB_TMO])) break; if (_sp > XB_SPIN_CAP) { atomicAdd(&(bar)[XB_TMO], 1u); break; } } } } while (0)

struct XcdBarrier {
    unsigned* bar; unsigned x;
    volatile LAS unsigned* st;
};

__device__ __forceinline__ XcdBarrier xcd_barrier_post(unsigned* bar, volatile LAS unsigned* st) {
    XcdBarrier b; b.bar = bar; b.x = xb_xcc_id(); b.st = st;
    if (threadIdx.x == 0) (void)xb_add(&bar[XB_XCNT(b.x)], 1u);
    return b;
}
__device__ __forceinline__ void xcd_barrier_complete(unsigned* bar, unsigned x, unsigned& nloc, unsigned& nx) {
    const unsigned G = gridDim.x * gridDim.y * gridDim.z;
    unsigned sum, cnt, mine, sp = 0u;
    for (;;) {
        sum = 0u; cnt = 0u; mine = 0u;
#pragma unroll
        for (unsigned j = 0; j < 16; ++j) { const unsigned c = xb_ld(&bar[XB_XCNT(j)]); sum += c; cnt += (c > 0u) ? 1u : 0u; mine = (j == x) ? c : mine; }
        if (sum == G) break;
        __builtin_amdgcn_s_sleep(1);
        if ((++sp & 255u) == 0u) { if (xb_ld(&bar[XB_TMO])) break; if (sp > XB_SPIN_CAP) { atomicAdd(&bar[XB_TMO], 1u); break; } }
    }
    nloc = mine > 0u ? mine : 1u; nx = cnt > 0u ? cnt : 1u;
}

__device__ __forceinline__ void xcd_barrier(const XcdBarrier& b) {
    asm volatile("s_waitcnt vmcnt(0)" ::: "memory");
    __syncthreads();
    if (threadIdx.x == 0) {
        unsigned* bar = b.bar;
        __builtin_amdgcn_s_waitcnt(0);
        unsigned nloc = b.st[0], nx = b.st[1];
        if (nloc == 0u) { xcd_barrier_complete(bar, b.x, nloc, nx); b.st[0] = nloc; b.st[1] = nx; }
        const unsigned old = xb_add(&bar[XB_XSUB(b.x)], 1u);
        const unsigned gen = old / nloc;
        if (old + 1u == (gen + 1u) * nloc) {
            __builtin_amdgcn_fence(__ATOMIC_RELEASE, "agent");
            asm volatile("s_waitcnt vmcnt(0)" ::: "memory");
            const unsigned og = xb_add(&bar[XB_TOP], 1u);
            const unsigned tg = og / nx;
            if (og + 1u == (tg + 1u) * nx) xb_add(&bar[XB_TOPGEN], 1u);
            else XB_SPIN(xb_ld(&bar[XB_TOPGEN]) == tg, bar);
            __builtin_amdgcn_fence(__ATOMIC_ACQUIRE, "agent");
            xb_add(&bar[XB_XGEN(b.x)], 1u);
            asm volatile("s_waitcnt vmcnt(0)" ::: "memory");
        } else {
            XB_SPIN(xb_ld(&bar[XB_XGEN(b.x)]) == gen, bar);
            __builtin_amdgcn_fence(__ATOMIC_ACQUIRE, "agent");
            asm volatile("s_waitcnt vmcnt(0)" ::: "memory");
        }
    }
    __syncthreads();
}

namespace pg8 {
#define PG8_LAS __attribute__((address_space(3)))
typedef short bf16x8 __attribute__((ext_vector_type(8)));
constexpr int BM = 256, BK = 64, HALF = 128, HTB = HALF * BK * 2  , STAGE_BYTES = 8 * HTB;

__host__ __device__ __forceinline__ int lds_byte(int r, int c) { const int st = (r >> 4) * 2 + (c >> 5), rr = r & 15, cc = c & 31, ob = rr * 64 + cc * 2; return st * 1024 + (ob ^ (((ob >> 9) & 1) << 5)); }
__host__ __device__ __forceinline__ void stage_rc(int b, int& R, int& C) { const int st = b / 1024, sb = b % 1024, swz = sb ^ (((sb >> 9) & 1) << 5); R = (st >> 1) * 16 + swz / 64; C = (st & 1) * 32 + (swz % 64) / 2; }
__host__ __device__ __forceinline__ int perm32(int rho) { const int n = rho >> 4, i = rho & 15; return 8 * (i >> 2) + 4 * n + (i & 3); }

struct Unit { int pm, pn, pb; };
struct Gemm { const bf16_t* A; const bf16_t* Bt; int K, lda; const int* rowidx; };

__device__ __forceinline__ unsigned cvt_pk_bf16(float lo, float hi) { unsigned r; asm volatile("v_cvt_pk_bf16_f32 %0, %1, %2" : "=v"(r) : "v"(lo), "v"(hi)); return r; }

template <class Epi, class Sched, bool GATHER, bool ALIGN_EPI>
__device__ __forceinline__ void gemm_phase(PG8_LAS unsigned char* lds, const Gemm g, const Sched& S, const Epi& E) {
    int tid_ = threadIdx.x; asm volatile("" : "+v"(tid_));
    const int tid = tid_, wid = __builtin_amdgcn_readfirstlane(tid >> 6), lane = tid & 63, wr = wid >> 2, wc = wid & 3, fr = lane & 15, fq = lane >> 4;
    const int K = g.K, nt = K / BK, lda = g.lda;
    unsigned voffB[2], oc[2][2], on[2][2];
#pragma unroll
    for (int i = 0; i < 2; ++i) { int R, C; stage_rc(tid * 16 + i * 8192, R, C); const int Rb = Epi::PERM ? ((R & ~31) + perm32(R & 31)) : R;
        voffB[i] = (unsigned)(Rb * K + C) * 2u;
        oc[0][i] = (unsigned)(R * lda + C) * 2u; oc[1][i] = (unsigned)((R + HALF) * lda + C) * 2u; on[0][i] = oc[0][i]; on[1][i] = oc[1][i]; }
    const size_t kstep = (size_t)(BK * 2);
    const size_t hstep = (size_t)HALF * K * 2;
    const size_t tstepB = 2 * hstep, tstepA = (size_t)BM * lda * 2;
    const unsigned ldsw = (unsigned)wid * 1024u;
    const int aoff = lds_byte(wr * 64 + fr, fq * 8), boff = lds_byte(wc * 32 + fr, fq * 8);
#define PG8_SA(b, h) (((b) * 2 + (h)) * HTB)
#define PG8_SB(b, h) ((4 + (b) * 2 + (h)) * HTB)
#define PG8_STAGE(bufoff, gbase, voff) do { _Pragma("unroll") for (int _i = 0; _i < 2; ++_i) \
        __builtin_amdgcn_global_load_lds((const unsigned*)((const char*)(gbase) + (voff)[_i]), (PG8_LAS unsigned*)(lds + (bufoff) + ldsw + _i * 8192), 16, 0, 0); } while (0)
#define PG8_LDA(dst, b, h) do { _Pragma("unroll") for (int m = 0; m < 4; ++m) _Pragma("unroll") for (int k = 0; k < 2; ++k) dst[m][k] = *(const PG8_LAS bf16x8*)(lds + PG8_SA(b, h) + aoff + m * 2048 + k * 1024); } while (0)
#define PG8_LDB(dst, b, h) do { _Pragma("unroll") for (int n = 0; n < 2; ++n) _Pragma("unroll") for (int k = 0; k < 2; ++k) dst[n][k] = *(const PG8_LAS bf16x8*)(lds + PG8_SB(b, h) + boff + n * 2048 + k * 1024); } while (0)
#define PG8_MMA(ai, bj, At, Bt) do { __builtin_amdgcn_s_setprio(1); _Pragma("unroll") for (int m = 0; m < 4; ++m) _Pragma("unroll") for (int n = 0; n < 2; ++n) _Pragma("unroll") for (int k = 0; k < 2; ++k) \
        acc[ai][bj][m][n] = __builtin_amdgcn_mfma_f32_16x16x32_bf16(Bt[n][k], At[m][k], acc[ai][bj][m][n], 0, 0, 0); __builtin_amdgcn_s_setprio(0); } while (0)
#define PG8_WAIT_V(n) asm volatile("s_waitcnt vmcnt(" #n ")" ::: "memory")
#define PG8_WAIT_L(n) asm volatile("s_waitcnt lgkmcnt(" #n ")" ::: "memory")
#define PG8_BAR __builtin_amdgcn_s_barrier()
#define PG8_SCHED __builtin_amdgcn_sched_barrier(0)
#define PG8_GIDX(dst, unit) do { _Pragma("unroll") for (int _i = 0; _i < 2; ++_i) { int R_, C_; stage_rc(tid * 16 + _i * 8192, R_, C_); \
        const int r0_ = g.rowidx[(unit).pm * BM + R_], r1_ = g.rowidx[(unit).pm * BM + HALF + R_]; \
        dst[0][_i] = (unsigned)(r0_ * lda + C_) * 2u; dst[1][_i] = (unsigned)(r1_ * lda + C_) * 2u; } } while (0)
    Unit cur, nxt; int ui = 0;
    if (!S.next(0, cur)) return;
    f32x4 acc[2][2][4][2];
#pragma unroll
    for (int a = 0; a < 2; ++a)
#pragma unroll
        for (int b = 0; b < 2; ++b)
#pragma unroll
            for (int m = 0; m < 4; ++m)
#pragma unroll
                for (int n = 0; n < 2; ++n) acc[a][b][m][n] = (f32x4){0.f, 0.f, 0.f, 0.f};
    bf16x8 At[4][2], B0[2][2], B1[2][2];
    if constexpr (GATHER) { PG8_GIDX(oc, cur); }
    const char* cA = GATHER ? (const char*)g.A : (const char*)g.A + (size_t)cur.pm * tstepA; const char* cB = (const char*)g.Bt + (size_t)cur.pb * tstepB;
    PG8_STAGE(PG8_SB(0, 0), cB, voffB); PG8_STAGE(PG8_SB(0, 1), cB + hstep, voffB); PG8_STAGE(PG8_SA(0, 0), cA, oc[0]); PG8_STAGE(PG8_SA(0, 1), cA, oc[1]);
    if (wr == 1) PG8_BAR;
    PG8_WAIT_V(2); PG8_BAR;
    PG8_STAGE(PG8_SB(1, 0), cB + kstep, voffB); PG8_STAGE(PG8_SA(1, 0), cA + kstep, oc[0]); PG8_STAGE(PG8_SB(1, 1), cB + hstep + kstep, voffB);
    PG8_WAIT_V(6); PG8_BAR;
    for (;;) {
        const bool has_next = S.next(ui + 1, nxt);
        if constexpr (GATHER) { if (has_next) { PG8_GIDX(on, nxt); } }
        const char* nA = has_next ? (GATHER ? (const char*)g.A : (const char*)g.A + (size_t)nxt.pm * tstepA) : cA; const char* nB = has_next ? (const char*)g.Bt + (size_t)nxt.pb * tstepB : cB;
#pragma unroll 1
        for (int t = 0; t < nt; t += 2) {
            const bool last = (t == nt - 2);
            const char* a1 = cA + (size_t)(t + 1) * kstep;
            const char* a2 = last ? nA : cA + (size_t)(t + 2) * kstep; const char* b2 = last ? nB : cB + (size_t)(t + 2) * kstep;
            const char* a3 = a2 + kstep; const char* b3 = b2 + kstep;
            PG8_LDB(B0, 0, 0); PG8_LDB(B1, 0, 1); PG8_SCHED; PG8_LDA(At, 0, 0); PG8_STAGE(PG8_SA(1, 1), a1, oc[1]);
            if constexpr (GATHER) { if (last && has_next) { oc[0][0] = on[0][0]; oc[0][1] = on[0][1]; oc[1][0] = on[1][0]; oc[1][1] = on[1][1]; } }
            PG8_WAIT_V(8); PG8_WAIT_L(0); PG8_BAR; PG8_MMA(0, 0, At, B0); PG8_MMA(0, 1, At, B1); PG8_BAR; PG8_SCHED;
            PG8_LDA(At, 0, 1); PG8_STAGE(PG8_SB(0, 0), b2, voffB); PG8_STAGE(PG8_SB(0, 1), b2 + hstep, voffB); PG8_STAGE(PG8_SA(0, 0), a2, oc[0]);
            PG8_WAIT_V(8); PG8_WAIT_L(0); PG8_BAR; PG8_MMA(1, 0, At, B0); PG8_MMA(1, 1, At, B1); PG8_BAR; PG8_SCHED;
            PG8_LDB(B0, 1, 0); PG8_LDB(B1, 1, 1); PG8_SCHED; PG8_LDA(At, 1, 0); PG8_STAGE(PG8_SA(0, 1), a2, oc[1]);
            PG8_WAIT_V(8); PG8_WAIT_L(0); PG8_BAR; PG8_MMA(0, 0, At, B0); PG8_MMA(0, 1, At, B1); PG8_BAR; PG8_SCHED;
            PG8_LDA(At, 1, 1); PG8_STAGE(PG8_SB(1, 0), b3, voffB); PG8_STAGE(PG8_SB(1, 1), b3 + hstep, voffB); PG8_STAGE(PG8_SA(1, 0), a3, oc[0]);
            PG8_WAIT_V(8); PG8_WAIT_L(0); PG8_BAR; PG8_MMA(1, 0, At, B0); PG8_MMA(1, 1, At, B1); PG8_BAR; PG8_SCHED;
        }
        if constexpr (ALIGN_EPI) { if (wr == 0) PG8_BAR; }
        E(acc, cur, wr, wc, fr, fq);
        if (!has_next) break;
#pragma unroll
        for (int a = 0; a < 2; ++a)
#pragma unroll
            for (int b = 0; b < 2; ++b)
#pragma unroll
                for (int m = 0; m < 4; ++m)
#pragma unroll
                    for (int n = 0; n < 2; ++n) acc[a][b][m][n] = (f32x4){0.f, 0.f, 0.f, 0.f};
        cur = nxt; cA = nA; cB = nB; ++ui;
        if constexpr (ALIGN_EPI) { if (wr == 1) PG8_BAR; }
    }
    PG8_WAIT_V(0);
    if constexpr (!ALIGN_EPI) { if (wr == 0) PG8_BAR; }
    PG8_BAR;
#undef PG8_SA
#undef PG8_SB
#undef PG8_STAGE
#undef PG8_LDA
#undef PG8_LDB
#undef PG8_MMA
#undef PG8_WAIT_V
#undef PG8_WAIT_L
#undef PG8_BAR
#undef PG8_SCHED
#undef PG8_GIDX
}

struct DenseOrder {
    int nM, nN, nwg, G, c;
    __device__ __forceinline__ void init(int M, int N, int G_, int c_) { nM = M / BM; nN = N / BM; nwg = nM * nN; G = G_; c = c_; }
    __device__ __forceinline__ bool next(int i, Unit& u) const {
        const long L = (long)i * G + c; if (L >= nwg) return false;
        int wgid = (int)L; { const int q = nwg / 8, r = nwg % 8, xcd = wgid % 8, off = wgid / 8; wgid = (xcd < r ? xcd * (q + 1) : r * (q + 1) + (xcd - r) * q) + off; }
        const int nig = 8 * nN, gid = wgid / nig, fm = gid * 8, gsz = (nM - fm) < 8 ? (nM - fm) : 8;
        u.pm = fm + ((wgid % nig) % gsz); u.pn = (wgid % nig) / gsz; u.pb = u.pn; return true;
    }
};
struct GroupedOrder {
    const int* tile_e; int ntiles, NT, G, vcu;
    __device__ __forceinline__ bool next(int i, Unit& u) const {
        const int L = i * G + vcu; if (L >= ntiles * NT) return false;
        const int mt = L / NT, nn = L - mt * NT; u.pm = mt; u.pn = nn; u.pb = tile_e[mt] * NT + nn; return true;
    }
};

#define EPI_ROWS_BEGIN const int row0 = u.pm * BM + wr * 64 + fr; _Pragma("unroll") for (int ai = 0; ai < 2; ++ai) _Pragma("unroll") for (int m = 0; m < 4; ++m) { const int row = row0 + ai * HALF + m * 16;
#define EPI_ROWS_END }
struct EpiWinF {
    static constexpr bool PERM = true;
    bf16_t* QK; bf16_t* V; bf16_t* AP;
    __device__ __forceinline__ void operator()(const f32x4 (&acc)[2][2][4][2], const Unit& u, int wr, int wc, int fr, int fq) const {
        const int colt = u.pn * BM + wc * 32 + 8 * fq;
        EPI_ROWS_BEGIN
#pragma unroll
            for (int bj = 0; bj < 2; ++bj) { const f32x4 v0 = acc[ai][bj][m][0], v1 = acc[ai][bj][m][1]; const int col = colt + bj * HALF;
                u32x4 w; w.x = cvt_pk_bf16(v0[0], v0[1]); w.y = cvt_pk_bf16(v0[2], v0[3]); w.z = cvt_pk_bf16(v1[0], v1[1]); w.w = cvt_pk_bf16(v1[2], v1[3]);
                bf16_t* dst;
                if (u.pn < 4) dst = QK + (size_t)row * 1024 + col;
                else if (u.pn < 6) dst = V + (size_t)row * 512 + (col - 1024);
                else { const int cc = col - 1536, gg = cc >> 4, ch = cc & 15, b = row / SEQ, l = row % SEQ;
                    dst = AP + ((size_t)(gg * (NB * NCHUNK) + b * NCHUNK + (l >> 4)) * APK + (l & 15) * 16 + ch); }
                *(u32x4*)dst = w; }
        EPI_ROWS_END
    }
};
struct EpiGluF {
    static constexpr bool PERM = true;
    const bf16_t* Y; bf16_t* MX; float* ss;
    __device__ __forceinline__ void operator()(const f32x4 (&acc)[2][2][4][2], const Unit& u, int wr, int wc, int fr, int fq) const {
        const int colt = u.pn * BM + wc * 32 + 8 * fq;
        EPI_ROWS_BEGIN
            float s = 0.f;
#pragma unroll
            for (int bj = 0; bj < 2; ++bj) { const int col = colt + bj * HALF; const u32x4 yv = *(const u32x4*)(Y + (size_t)row * 512 + col);
                const f32x4 a0 = acc[ai][bj][m][0], a1 = acc[ai][bj][m][1];
                float v[8];
                v[0] = __uint_as_float(yv.x << 16) * sigmoidf(a0[0]); v[1] = __uint_as_float(yv.x & 0xffff0000u) * sigmoidf(a0[1]);
                v[2] = __uint_as_float(yv.y << 16) * sigmoidf(a0[2]); v[3] = __uint_as_float(yv.y & 0xffff0000u) * sigmoidf(a0[3]);
                v[4] = __uint_as_float(yv.z << 16) * sigmoidf(a1[0]); v[5] = __uint_as_float(yv.z & 0xffff0000u) * sigmoidf(a1[1]);
                v[6] = __uint_as_float(yv.w << 16) * sigmoidf(a1[2]); v[7] = __uint_as_float(yv.w & 0xffff0000u) * sigmoidf(a1[3]);
#pragma unroll
                for (int i = 0; i < 8; ++i) s += v[i] * v[i];
                u32x4 w; w.x = cvt_pk_bf16(v[0], v[1]); w.y = cvt_pk_bf16(v[2], v[3]); w.z = cvt_pk_bf16(v[4], v[5]); w.w = cvt_pk_bf16(v[6], v[7]);
                *(u32x4*)(MX + (size_t)row * 1024 + 512 + col) = w; }
            s += __shfl_xor(s, 16); s += __shfl_xor(s, 32);
            if (fq == 0) ss[(size_t)row * 8 + u.pn * 4 + wc] = s;
        EPI_ROWS_END
    }
};
struct EpiWoutF {
    static constexpr bool PERM = false;
    const float* x; const float* mod; float* out; float* ss;
    __device__ __forceinline__ void operator()(const f32x4 (&acc)[2][2][4][2], const Unit& u, int wr, int wc, int fr, int fq) const {
        const int colt = u.pn * BM + wc * 32 + 4 * fq;
        EPI_ROWS_BEGIN
            const int b = row / SEQ; float s = 0.f;
#pragma unroll
            for (int bj = 0; bj < 2; ++bj)
#pragma unroll
                for (int n = 0; n < 2; ++n) { const int col = colt + bj * HALF + n * 16;
                    const f32x4 xv = *(const f32x4*)(x + (size_t)row * DM + col), g1 = *(const f32x4*)(mod + b * 6 * DM + 2 * DM + col);
                    const f32x4 o = xv + g1 * acc[ai][bj][m][n];
                    *(f32x4*)(out + (size_t)row * DM + col) = o; s += o[0] * o[0] + o[1] * o[1] + o[2] * o[2] + o[3] * o[3]; }
            s += __shfl_xor(s, 16); s += __shfl_xor(s, 32);
            if (fq == 0) ss[(size_t)row * 16 + u.pn * 4 + wc] = s;
        EPI_ROWS_END
    }
};
struct EpiRSF {
    static constexpr bool PERM = true;
    float* L; bf16_t* AS;
    __device__ __forceinline__ void operator()(const f32x4 (&acc)[2][2][4][2], const Unit& u, int wr, int wc, int fr, int fq) const {
        const int c8 = wc * 32 + 8 * fq;
        EPI_ROWS_BEGIN
            if (u.pn == 0) {
#pragma unroll
                for (int bj = 0; bj < 2; ++bj) { float* d = L + (size_t)row * 256 + bj * HALF + c8; *(f32x4*)d = acc[ai][bj][m][0]; *(f32x4*)(d + 4) = acc[ai][bj][m][1]; }
            } else {
                const f32x4 g0 = acc[ai][0][m][0], g1 = acc[ai][0][m][1], u0 = acc[ai][1][m][0], u1 = acc[ai][1][m][1];
                u32x4 w; w.x = cvt_pk_bf16(siluf(g0[0]) * u0[0], siluf(g0[1]) * u0[1]); w.y = cvt_pk_bf16(siluf(g0[2]) * u0[2], siluf(g0[3]) * u0[3]);
                w.z = cvt_pk_bf16(siluf(g1[0]) * u1[0], siluf(g1[1]) * u1[1]); w.w = cvt_pk_bf16(siluf(g1[2]) * u1[2], siluf(g1[3]) * u1[3]);
                *(u32x4*)(AS + (size_t)row * 256 + (u.pn - 1) * 128 + c8) = w;
            }
        EPI_ROWS_END
    }
};
struct EpiSDF {
    static constexpr bool PERM = false;
    const float* mod; float* out;
    __device__ __forceinline__ void operator()(const f32x4 (&acc)[2][2][4][2], const Unit& u, int wr, int wc, int fr, int fq) const {
        const int colt = u.pn * BM + wc * 32 + 4 * fq;
        EPI_ROWS_BEGIN
            const int b = row / SEQ;
#pragma unroll
            for (int bj = 0; bj < 2; ++bj)
#pragma unroll
                for (int n = 0; n < 2; ++n) { const int col = colt + bj * HALF + n * 16; const f32x4 g2 = *(const f32x4*)(mod + b * 6 * DM + 5 * DM + col);
                    f32x4* o = (f32x4*)(out + (size_t)row * DM + col); *o = *o + g2 * acc[ai][bj][m][n]; }
        EPI_ROWS_END
    }
};
struct EpiE1F {
    static constexpr bool PERM = true;
    bf16_t* AE;
    __device__ __forceinline__ void operator()(const f32x4 (&acc)[2][2][4][2], const Unit& u, int wr, int wc, int fr, int fq) const {
        const int c8 = u.pn * 128 + wc * 32 + 8 * fq;
        EPI_ROWS_BEGIN
            const f32x4 g0 = acc[ai][0][m][0], g1 = acc[ai][0][m][1], u0 = acc[ai][1][m][0], u1 = acc[ai][1][m][1];
            u32x4 w; w.x = cvt_pk_bf16(siluf(g0[0]) * u0[0], siluf(g0[1]) * u0[1]); w.y = cvt_pk_bf16(siluf(g0[2]) * u0[2], siluf(g0[3]) * u0[3]);
            w.z = cvt_pk_bf16(siluf(g1[0]) * u1[0], siluf(g1[1]) * u1[1]); w.w = cvt_pk_bf16(siluf(g1[2]) * u1[2], siluf(g1[3]) * u1[3]);
            *(u32x4*)(AE + (size_t)row * 256 + c8) = w;
        EPI_ROWS_END
    }
};
struct EpiE2F {
    static constexpr bool PERM = true;
    const int* sasg; const float* sgate; bf16_t* YA;
    __device__ __forceinline__ void operator()(const f32x4 (&acc)[2][2][4][2], const Unit& u, int wr, int wc, int fr, int fq) const {
        const int colt = u.pn * BM + wc * 32 + 8 * fq;
        EPI_ROWS_BEGIN
            const int asg = sasg[row]; const float gt = sgate[row];
            if (asg >= 0) {
#pragma unroll
                for (int bj = 0; bj < 2; ++bj) { const f32x4 v0 = acc[ai][bj][m][0] * gt, v1 = acc[ai][bj][m][1] * gt;
                    u32x4 w; w.x = cvt_pk_bf16(v0[0], v0[1]); w.y = cvt_pk_bf16(v0[2], v0[3]); w.z = cvt_pk_bf16(v1[0], v1[1]); w.w = cvt_pk_bf16(v1[2], v1[3]);
                    *(u32x4*)(YA + (size_t)asg * DM + colt + bj * HALF) = w; }
            }
        EPI_ROWS_END
    }
};
struct EpiSsmA {
    static constexpr bool PERM = false;
    float* DS;
    __device__ __forceinline__ void operator()(const f32x4 (&acc)[2][2][4][2], const Unit& u, int wr, int wc, int fr, int fq) const {
        EPI_ROWS_BEGIN
#pragma unroll
            for (int n = 0; n < 2; ++n) *(f32x4*)(DS + (size_t)row * 128 + wc * 32 + n * 16 + 4 * fq) = acc[ai][0][m][n];
        EPI_ROWS_END
    }
};
struct EpiSsmC {
    static constexpr bool PERM = true;
    bf16_t* Y;
    __device__ __forceinline__ void operator()(const f32x4 (&acc)[2][2][4][2], const Unit& u, int wr, int wc, int fr, int fq) const {
        EPI_ROWS_BEGIN
            const int gg = row >> 11, rem = row & 2047, b = rem >> 8, chunk = rem & 255; const size_t t0 = (size_t)b * SEQ + chunk * 16;
#pragma unroll
            for (int bj = 0; bj < 2; ++bj) { const int c0 = bj * HALF + wc * 32 + 8 * fq, jp = c0 >> 4, co0 = c0 & 15;
                const f32x4 v0 = acc[ai][bj][m][0], v1 = acc[ai][bj][m][1];
                u32x4 w; w.x = cvt_pk_bf16(gelu_tanh(v0[0]), gelu_tanh(v0[1])); w.y = cvt_pk_bf16(gelu_tanh(v0[2]), gelu_tanh(v0[3]));
                w.z = cvt_pk_bf16(gelu_tanh(v1[0]), gelu_tanh(v1[1])); w.w = cvt_pk_bf16(gelu_tanh(v1[2]), gelu_tanh(v1[3]));
                *(u32x4*)(Y + (t0 + jp) * 512 + gg * 16 + co0) = w; }
        EPI_ROWS_END
    }
};
struct EpiSDC {
    static constexpr bool PERM = true;
    const float* mod; float* out; const bf16_t* YA;
    __device__ __forceinline__ void operator()(const f32x4 (&acc)[2][2][4][2], const Unit& u, int wr, int wc, int fr, int fq) const {
        const int colt = u.pn * BM + wc * 32 + 8 * fq;
        EPI_ROWS_BEGIN
            const int b = row / SEQ;
#pragma unroll
            for (int bj = 0; bj < 2; ++bj) { const int col = colt + bj * HALF;
                f32x4 s0 = acc[ai][bj][m][0], s1 = acc[ai][bj][m][1];
#pragma unroll
                for (int k = 0; k < 8; ++k) { const u32x4 w = *(const u32x4*)(YA + ((size_t)row * 8 + k) * DM + col);
                    s0[0] += __uint_as_float(w.x << 16); s0[1] += __uint_as_float(w.x & 0xffff0000u); s0[2] += __uint_as_float(w.y << 16); s0[3] += __uint_as_float(w.y & 0xffff0000u);
                    s1[0] += __uint_as_float(w.z << 16); s1[1] += __uint_as_float(w.z & 0xffff0000u); s1[2] += __uint_as_float(w.w << 16); s1[3] += __uint_as_float(w.w & 0xffff0000u); }
                const float* g2 = mod + b * 6 * DM + 5 * DM + col; float* o = out + (size_t)row * DM + col;
                *(f32x4*)o = *(const f32x4*)o + *(const f32x4*)g2 * s0; *(f32x4*)(o + 4) = *(const f32x4*)(o + 4) + *(const f32x4*)(g2 + 4) * s1; }
        EPI_ROWS_END
    }
};
struct SsmOrder {
    int G, vcu;
    __device__ __forceinline__ bool next(int i, Unit& u) const { const int L = i * G + vcu; if (L >= 256) return false; u.pm = L; u.pn = 0; u.pb = L >> 3; return true; }
};
}

__device__ __forceinline__ void transpose_item(const float* W, int K, int N, bf16_t* WT, int kb, int nb, int rowbase, float* scr, int lane) {
    const int k0 = 64 * kb, n0 = 32 * nb;
#pragma unroll 8
    for (int i = 0; i < 32; ++i) { const int kk = 2 * i + (lane >> 5); scr[kk * 33 + (lane & 31)] = W[(size_t)(k0 + kk) * N + n0 + (lane & 31)]; }
    asm volatile("s_waitcnt lgkmcnt(0)" ::: "memory");
    const int cch = lane & 7;
#pragma unroll
    for (int j = 0; j < 4; ++j) { const int n = (lane >> 3) + 8 * j; const float* s = scr + (8 * cch) * 33 + n;
        u32x4 o; o.x = pk2(s[0 * 33], s[1 * 33]); o.y = pk2(s[2 * 33], s[3 * 33]); o.z = pk2(s[4 * 33], s[5 * 33]); o.w = pk2(s[6 * 33], s[7 * 33]);
        *(u32x4*)(WT + (size_t)(rowbase + n) * K + k0 + 8 * cch) = o; }
    asm volatile("s_waitcnt lgkmcnt(0)" ::: "memory");
}
__device__ __forceinline__ int gu_row(int n0, int up) { return (n0 >> 7) * 256 + up * 128 + (n0 & 127); }
__device__ __forceinline__ void ph_convert(const Ctx& c, const Params& p) {
    float* scr = c.lds + c.wave * (64 * 33);
    unsigned char* ws = c.ws;
    constexpr int I0 = 16 * 64, I1 = 16 * 32, I2 = 8 * 16, I3 = 16 * 8, I6 = 4 * 32, IE = 128;
    constexpr int DENSE = I0 + I1 + I2 + 3 * I3 + I6, NITEMS = DENSE + 3 * IE * NE;
    for (int it = c.gwave; it < NITEMS; it += c.gwaves) {
        int r = it;
        if (r < I0) { transpose_item(p.in[I_WIN], DM, 2048, (bf16_t*)(ws + WS_WIN_T), r / 64, r % 64, (r % 64) * 32, scr, c.lane); continue; } r -= I0;
        if (r < I1) { transpose_item(p.in[I_WOUT], DM, DM, (bf16_t*)(ws + WS_WOUT_T), r / 32, r % 32, (r % 32) * 32, scr, c.lane); continue; } r -= I1;
        if (r < I2) { transpose_item(p.in[I_WGLU], 512, 512, (bf16_t*)(ws + WS_WGLU_T), r / 16, r % 16, (r % 16) * 32, scr, c.lane); continue; } r -= I2;
        if (r < I3) { transpose_item(p.in[I_WR], DM, 256, (bf16_t*)(ws + WS_WRS_T), r / 8, r % 8, (r % 8) * 32, scr, c.lane); continue; } r -= I3;
        if (r < I3) { transpose_item(p.in[I_WGS], DM, 256, (bf16_t*)(ws + WS_WRS_T), r / 8, r % 8, 256 + gu_row((r % 8) * 32, 0), scr, c.lane); continue; } r -= I3;
        if (r < I3) { transpose_item(p.in[I_WUS], DM, 256, (bf16_t*)(ws + WS_WRS_T), r / 8, r % 8, 256 + gu_row((r % 8) * 32, 1), scr, c.lane); continue; } r -= I3;
        if (r < I6) { transpose_item(p.in[I_WDS], 256, DM, (bf16_t*)(ws + WS_WDS_T), r / 32, r % 32, (r % 32) * 32, scr, c.lane); continue; } r -= I6;
        const int e = r / (3 * IE), q = r % (3 * IE), which = q / IE, ii = q % IE;
        if (which == 0) transpose_item(p.in[I_WGE] + (size_t)e * DM * ED, DM, ED, (bf16_t*)(ws + WS_WGU) + (size_t)e * 512 * DM, ii / 8, ii % 8, gu_row((ii % 8) * 32, 0), scr, c.lane);
        else if (which == 1) transpose_item(p.in[I_WUE] + (size_t)e * DM * ED, DM, ED, (bf16_t*)(ws + WS_WGU) + (size_t)e * 512 * DM, ii / 8, ii % 8, gu_row((ii % 8) * 32, 1), scr, c.lane);
        else transpose_item(p.in[I_WDE] + (size_t)e * ED * DM, ED, DM, (bf16_t*)(ws + WS_WD) + (size_t)e * DM * ED, ii / 32, ii % 32, (ii % 32) * 32, scr, c.lane);
    }
}

__device__ __forceinline__ void ph_prologue2(const Ctx& c, const Params& p) {
    float* mod = (float*)(c.ws + WS_MOD);
    float* sc = c.lds;
    for (int i = c.tid; i < NB * DM; i += NTHREADS_) sc[i] = siluf(p.in[I_C][i]);
    __syncthreads();
    float* red = c.lds + NB * DM;
    for (int cg = c.bid; cg < 96; cg += c.nb) {
        const int ks = c.wave, col = cg * 64 + c.lane;
        const float* w = p.in[I_WADA] + (size_t)(ks * 128) * (6 * DM) + col;
        float acc[8];
#pragma unroll
        for (int b = 0; b < 8; ++b) acc[b] = 0.f;
#pragma unroll 16
        for (int k = 0; k < 128; ++k) { const float wv = w[(size_t)k * (6 * DM)];
#pragma unroll
            for (int b = 0; b < 8; ++b) acc[b] += sc[b * DM + ks * 128 + k] * wv; }
#pragma unroll
        for (int b = 0; b < 8; ++b) red[(ks * 8 + b) * 64 + c.lane] = acc[b];
        __syncthreads();
        { const int b = c.wave; float sum = p.in[I_BADA][col];
#pragma unroll
          for (int k2 = 0; k2 < 8; ++k2) sum += red[(k2 * 8 + b) * 64 + c.lane];
          mod[b * 6 * DM + col] = sum; }
        __syncthreads();
    }
    float* ropec = (float*)(c.ws + WS_ROPE); float* ropes = ropec + SEQ * 32;
    for (int idx = c.gtid; idx < SEQ * 32; idx += c.gthreads) {
        const int l = idx >> 5, i = idx & 31;
        const double invf = exp(-log(10000.0) * (double)(2 * i) / 64.0);
        const double ang = (double)l * invf;
        ropec[idx] = (float)cos(ang); ropes[idx] = (float)sin(ang);
    }
    float* sp = (float*)(c.ws + WS_SSMP);
    float* abr = sp, * abi = sp + SG * SP, * bbr = sp + 2 * SG * SP, * bbi = bbr + SG * SP * SC;
    for (int idx = c.gtid; idx < SG * SP; idx += c.gthreads) {
        const int g = idx / SP;
        const double are = p.in[I_ARE][idx], aim = p.in[I_AIM][idx], dt = exp((double)p.in[I_LOGDT][g]);
        const double mag = exp(are * dt), ar = mag * cos(aim * dt), ai = mag * sin(aim * dt);
        abr[idx] = (float)ar; abi[idx] = (float)ai;
        const double den = are * are + aim * aim, nr = ar - 1.0;
        const double fre = (nr * are + ai * aim) / den, fim = (ai * are - nr * aim) / den;
        for (int ch = 0; ch < SC; ++ch) {
            const double br = p.in[I_BRE][idx * SC + ch], bi = p.in[I_BIM][idx * SC + ch];
            bbr[idx * SC + ch] = (float)(fre * br - fim * bi); bbi[idx * SC + ch] = (float)(fre * bi + fim * br);
        }
    }
    if (c.gtid == 0) {
        float s1 = 0.f, s2 = 0.f, gq = 0.f, gk = 0.f;
        for (int i = 0; i < HD; ++i) { s1 += p.in[I_LQ1][i] * p.in[I_LK1][i]; s2 += p.in[I_LQ2][i] * p.in[I_LK2][i];
            gq = fmaxf(gq, fabsf(p.in[I_QNG][i])); gk = fmaxf(gk, fabsf(p.in[I_KNG][i])); }
        float* lam = (float*)(c.ws + WS_LAM);
        lam[0] = __expf(s1) - __expf(s2) + LAM_INIT;
        lam[1] = 0.125f * 64.f * gq * gk;
    }
    int* stok = (int*)(c.ws + WS_SLOT_TOK); int* sasg = (int*)(c.ws + WS_SLOT_ASG); float* sgate = (float*)(c.ws + WS_SLOT_GATE);
    for (int idx = c.gtid; idx < NS_MAX; idx += c.gthreads) { stok[idx] = 0; sasg[idx] = -1; sgate[idx] = 0.f; }
    int* te = (int*)(c.ws + WS_TILE_E);
    for (int idx = c.gtid; idx < NS_MAX / 256; idx += c.gthreads) te[idx] = -1;
    __syncthreads();
}
__device__ __forceinline__ void ph_slot2(const Ctx& c, const Params& p) {
    const unsigned* counts = (const unsigned*)(c.ws + WS_CTL) + CW_COUNTS; unsigned* cursor = (unsigned*)(c.ws + WS_CTL) + CW_CURSOR;
    int* pc = (int*)c.lds; int* ps = pc + 256;
    if (c.tid < NE) pc[c.tid] = ((int)counts[c.tid] + 255) / 256 * 256;
    __syncthreads();
    if (c.tid <= NE) { int acc = 0; for (int e = 0; e < c.tid; ++e) acc += pc[e]; ps[c.tid] = acc; }
    __syncthreads();
    const int* eidx = (const int*)(c.ws + WS_EIDX); const float* gw = (const float*)(c.ws + WS_GATEW);
    int* stok = (int*)(c.ws + WS_SLOT_TOK); int* sasg = (int*)(c.ws + WS_SLOT_ASG); float* sgate = (float*)(c.ws + WS_SLOT_GATE);
    for (int a = c.gtid; a < T * TOPK; a += c.gthreads) {
        const int e = eidx[a]; const unsigned pos = atomicAdd(cursor + e, 1u); const int slot = ps[e] + (int)pos;
        stok[slot] = a >> 3; sasg[slot] = a; sgate[slot] = gw[a];
    }
    if (c.bid == 0) {
        int* te = (int*)(c.ws + WS_TILE_E);
        for (int e = c.tid; e < NE; e += NTHREADS_) for (int tl = ps[e] / 256; tl < ps[e + 1] / 256; ++tl) te[tl] = e;
        if (c.tid == 0) ((unsigned*)(c.ws + WS_CTL))[CW_NTILES] = (unsigned)(ps[NE] / 256);
    }
    __syncthreads();
}

__device__ __forceinline__ void cpowi(float ar, float ai, int n, float& pr, float& pi) { pr = 1.f; pi = 0.f; for (int i = 0; i < n; ++i) { const float t = pr * ar - pi * ai; pi = pr * ai + pi * ar; pr = t; } }
__device__ __forceinline__ void ph_ssm_gen(const Ctx& c, const Params& p) {
    const float* sp = (const float*)(c.ws + WS_SSMP);
    const float* abr = sp, * abi = sp + SG * SP, * bbr = sp + 2 * SG * SP, * bbi = bbr + SG * SP * SC;
    bf16_t* BA = (bf16_t*)(c.ws + WS_SSM_BA); bf16_t* BC = (bf16_t*)(c.ws + WS_SSM_BC);
    for (int idx = c.gtid; idx < SG * 16 * 256; idx += c.gthreads) {
        const int ci = idx & 15, co = (idx >> 4) & 15, d = (idx >> 8) & 15, g = idx >> 12;
        float kv = 0.f;
        for (int pp = 0; pp < SP; ++pp) { float pr, pi; cpowi(abr[g * SP + pp], abi[g * SP + pp], d, pr, pi);
            const float br = bbr[(g * SP + pp) * SC + ci], bi = bbi[(g * SP + pp) * SC + ci];
            const float tr = pr * br - pi * bi, ti = pr * bi + pi * br;
            kv += p.in[I_CRE][(g * SC + co) * SP + pp] * tr - p.in[I_CIM][(g * SC + co) * SP + pp] * ti; }
        if (d == 0 && co == ci) kv += p.in[I_SD][g * SC + co];
        const bf16_t kb = f2bf(kv); bf16_t* base = BC + (size_t)g * 256 * APK;
        for (int j = 0; j + d < 16; ++j) { base[((j + d) * 16 + co) * APK + j * 16 + ci] = kb; if (d > 0) base[(j * 16 + co) * APK + (j + d) * 16 + ci] = 0; }
    }
    for (int idx = c.gtid; idx < SG * 16 * 16 * SP; idx += c.gthreads) {
        const int pp = idx & 63, co = (idx >> 6) & 15, jp = (idx >> 10) & 15, g = idx >> 14;
        float pr, pi; cpowi(abr[g * SP + pp], abi[g * SP + pp], jp + 1, pr, pi);
        const float cr = p.in[I_CRE][(g * SC + co) * SP + pp], ci = p.in[I_CIM][(g * SC + co) * SP + pp];
        bf16_t* row = BC + ((size_t)g * 256 + jp * 16 + co) * APK + 256;
        row[pp] = f2bf(cr * pr - ci * pi); row[64 + pp] = f2bf(-(cr * pi + ci * pr));
    }
    for (int idx = c.gtid; idx < SG * SP * 256; idx += c.gthreads) {
        const int ci = idx & 15, j = (idx >> 4) & 15, pp = (idx >> 8) & 63, g = idx >> 14;
        float pr, pi; cpowi(abr[g * SP + pp], abi[g * SP + pp], 15 - j, pr, pi);
        const float br = bbr[(g * SP + pp) * SC + ci], bi = bbi[(g * SP + pp) * SC + ci];
        bf16_t* base = BA + (size_t)g * 256 * 256;
        base[pp * 256 + j * 16 + ci] = f2bf(pr * br - pi * bi); base[(64 + pp) * 256 + j * 16 + ci] = f2bf(pr * bi + pi * br);
    }
    for (int idx = c.gtid; idx < SG * 128 * 256 / 8; idx += c.gthreads) {
        const int g = idx / (128 * 32), r = idx % (128 * 32);
        *(u32x4*)(BA + (size_t)g * 256 * 256 + 128 * 256 + r * 8) = (u32x4){0u, 0u, 0u, 0u};
    }
}
__device__ __forceinline__ void ph_ssm_scan(const Ctx& c, const Params& p, int vcu) {
    const float* sp = (const float*)(c.ws + WS_SSMP); const float* abr = sp, * abi = sp + SG * SP;
    const float* DS = (const float*)(c.ws + WS_DS); bf16_t* AP = (bf16_t*)(c.ws + WS_AP);
    float* fw = c.lds;
    for (int it = vcu; it < NB * SG; it += c.nb) {
        const int g = it >> 3, b = it & 7, pp = c.lane, w = c.wave;
        const size_t r0 = (size_t)g * (NB * NCHUNK) + b * NCHUNK + 32 * w;
        float ar = abr[g * SP + pp], ai = abi[g * SP + pp];
#pragma unroll
        for (int i = 0; i < 4; ++i) { const float t = ar * ar - ai * ai; ai = 2.f * ar * ai; ar = t; }
        float lr[32], li[32];
#pragma unroll
        for (int i = 0; i < 32; ++i) { lr[i] = DS[(r0 + i) * 128 + pp]; li[i] = DS[(r0 + i) * 128 + 64 + pp]; }
#pragma unroll
        for (int i = 1; i < 32; ++i) { const float nr = ar * lr[i - 1] - ai * li[i - 1] + lr[i], ni = ar * li[i - 1] + ai * lr[i - 1] + li[i]; lr[i] = nr; li[i] = ni; }
        __syncthreads();
        fw[(w * 64 + pp) * 2] = lr[31]; fw[(w * 64 + pp) * 2 + 1] = li[31];
        __syncthreads();
        float a32r = ar, a32i = ai;
#pragma unroll
        for (int i = 0; i < 5; ++i) { const float t = a32r * a32r - a32i * a32i; a32i = 2.f * a32r * a32i; a32r = t; }
        float cr = 0.f, ci = 0.f;
        for (int w2 = 0; w2 < w; ++w2) { const float fr_ = fw[(w2 * 64 + pp) * 2], fi_ = fw[(w2 * 64 + pp) * 2 + 1];
            const float nr = a32r * cr - a32i * ci + fr_, ni = a32r * ci + a32i * cr + fi_; cr = nr; ci = ni; }
#pragma unroll
        for (int i = 0; i < 32; ++i) {
            const float sr = cr + (i ? lr[i - 1] : 0.f), si = ci + (i ? li[i - 1] : 0.f);
            bf16_t* row = AP + (r0 + i) * APK + 256;
            row[pp] = f2bf(sr); row[64 + pp] = f2bf(si);
            const float nr = ar * cr - ai * ci, ni = ar * ci + ai * cr; cr = nr; ci = ni;
        }
    }
}

namespace att {
typedef short bf16x8 __attribute__((ext_vector_type(8)));
typedef short s16x4 __attribute__((ext_vector_type(4)));
typedef float f32x16 __attribute__((ext_vector_type(16)));
constexpr int NW = 8, QBLK = 32, KVBLK = 64, QB = 128, NQB = SEQ / QB;
constexpr int KP = 1024, VP = 512;
constexpr int SHM_V = KVBLK * 128 * 2, SHM_K = KVBLK * 128 * 2;
constexpr int LDS_WS = 2 * SHM_V + 2 * SHM_K, LDS_EX = LDS_WS + NW * 64 * 4, LDS_END = LDS_EX + 4 * 16384;
#define KSWZ(row, colB) ((row) * 256 + ((colB) ^ (((row) & 7) << 4)))
#define SBAR() __builtin_amdgcn_sched_barrier(0)
__device__ __forceinline__ int v_st(int k, int c) { const int kk = (k & ~0xC) | ((k & 4) << 1) | ((k & 8) >> 1); return ((kk >> 3) * 4 + (c >> 5)) * 512 + ((kk & 7) * 32 + (c & 31)) * 2; }
__device__ __forceinline__ int v_rd_base(int lane) { return ((lane & 3) << 3) | (((lane >> 2) & 3) << 6) | (((lane >> 4) & 1) << 5) | (((lane >> 5) & 1) << 8); }
constexpr int v_rd_off(int d0, int ks, int half) { return d0 * 512 + ks * 4096 + half * 2048; }
__device__ __forceinline__ int crow(int r, int hi) { return (r & 3) + 8 * (r >> 2) + 4 * hi; }
__device__ __forceinline__ unsigned cvtpk(float lo, float hi) { unsigned r; asm volatile("v_cvt_pk_bf16_f32 %0, %1, %2" : "=v"(r) : "v"(lo), "v"(hi)); return r; }
__device__ __forceinline__ void mask_tile(f32x16& p0, f32x16& p1, int dq) {
    const float NEG = -__builtin_inff();
#pragma unroll
    for (int r = 0; r < 16; ++r) { const int c = (r & 3) + 8 * (r >> 2); if (dq - c < 0) p0[r] = NEG; if (dq - c - 32 < 0) p1[r] = NEG; }
}
__device__ __forceinline__ void partialSM(f32x16& p0, f32x16& p1, float C2, float negM) {
#pragma unroll
    for (int r = 0; r < 16; ++r) p0[r] = fmaf(p0[r], C2, negM);
#pragma unroll
    for (int r = 0; r < 16; ++r) p1[r] = fmaf(p1[r], C2, negM);
#pragma unroll
    for (int r = 0; r < 16; ++r) p0[r] = __builtin_amdgcn_exp2f(p0[r]);
}
__device__ __forceinline__ void finishSM(f32x16& p0, f32x16& p1, float& l_reg, bf16x8& pa0, bf16x8& pa1, bf16x8& pa2, bf16x8& pa3) {
#pragma unroll
    for (int r = 0; r < 16; ++r) p1[r] = __builtin_amdgcn_exp2f(p1[r]);
    float ps = 0;
#pragma unroll
    for (int r = 0; r < 16; ++r) ps += p0[r];
#pragma unroll
    for (int r = 0; r < 16; ++r) ps += p1[r];
    { auto rr = __builtin_amdgcn_permlane32_swap(__float_as_uint(ps), __float_as_uint(ps), false, false); ps = __uint_as_float(rr[0]) + __uint_as_float(rr[1]); }
    l_reg += ps;
#define PK4(P, B_, OUT) do { unsigned a0 = cvtpk(P[B_+0], P[B_+1]), a1 = cvtpk(P[B_+2], P[B_+3]);                          \
        unsigned b0 = cvtpk(P[B_+4], P[B_+5]), b1 = cvtpk(P[B_+6], P[B_+7]);                                             \
        auto r0 = __builtin_amdgcn_permlane32_swap(a0, b0, false, false); auto r1 = __builtin_amdgcn_permlane32_swap(a1, b1, false, false); \
        u32x4 w = {r0[0], r1[0], r0[1], r1[1]}; OUT = *reinterpret_cast<bf16x8*>(&w); } while (0)
    PK4(p0, 0, pa0); PK4(p0, 8, pa1); PK4(p1, 0, pa2); PK4(p1, 8, pa3);
#undef PK4
}
template <int KB>
__device__ __forceinline__ void qkt(f32x16& p0, f32x16& p1, const char* K_lds, int r32, int hi, const bf16x8* qr, int cc) {
    p0 = f32x16{}; p1 = f32x16{};
    const char* kb[4];
#pragma unroll
    for (int dd = 0; dd < 4; ++dd) kb[dd] = K_lds + KB * SHM_K + KSWZ(r32, (dd * 16 + hi * 8) * 2) + cc * 128;
#pragma unroll
    for (int d0 = 0; d0 < 4; ++d0) { const char* a = kb[d0];
        bf16x8 b0 = *reinterpret_cast<const bf16x8*>(a);
        bf16x8 b1 = *reinterpret_cast<const bf16x8*>(a + 32 * 256);
        p0 = __builtin_amdgcn_mfma_f32_32x32x16_bf16(b0, qr[d0], p0, 0, 0, 0);
        p1 = __builtin_amdgcn_mfma_f32_32x32x16_bf16(b1, qr[d0], p1, 0, 0, 0); }
}
template <int VB>
__device__ __forceinline__ void pv_tile(f32x16* o, int vb0, bf16x8 pa0, bf16x8 pa1, bf16x8 pa2, bf16x8 pa3) {
#define TRRD(dst, off) asm volatile("ds_read_b64_tr_b16 %0, %1 offset:%2" : "=&v"(dst) : "v"(vb0), "i"(off) : "memory")
#define PV_D0(d0) do { s16x4 l0, l1, l2, l3, h0, h1, h2, h3; constexpr int b_ = VB * SHM_V + v_rd_off(d0, 0, 0); \
        TRRD(l0, b_); TRRD(h0, b_ + 2048); TRRD(l1, b_ + 4096); TRRD(h1, b_ + 6144); TRRD(l2, b_ + 8192); TRRD(h2, b_ + 10240); TRRD(l3, b_ + 12288); TRRD(h3, b_ + 14336); \
        asm volatile("s_waitcnt lgkmcnt(0)" ::: "memory"); SBAR();   \
        o[d0] = __builtin_amdgcn_mfma_f32_32x32x16_bf16(pa0, (bf16x8){l0[0], l0[1], l0[2], l0[3], h0[0], h0[1], h0[2], h0[3]}, o[d0], 0, 0, 0);   \
        o[d0] = __builtin_amdgcn_mfma_f32_32x32x16_bf16(pa1, (bf16x8){l1[0], l1[1], l1[2], l1[3], h1[0], h1[1], h1[2], h1[3]}, o[d0], 0, 0, 0);   \
        o[d0] = __builtin_amdgcn_mfma_f32_32x32x16_bf16(pa2, (bf16x8){l2[0], l2[1], l2[2], l2[3], h2[0], h2[1], h2[2], h2[3]}, o[d0], 0, 0, 0);   \
        o[d0] = __builtin_amdgcn_mfma_f32_32x32x16_bf16(pa3, (bf16x8){l3[0], l3[1], l3[2], l3[3], h3[0], h3[1], h3[2], h3[3]}, o[d0], 0, 0, 0); } while (0)
    PV_D0(0); PV_D0(1); PV_D0(2); PV_D0(3);
#undef PV_D0
#undef TRRD
}
struct BlockRef { const bf16_t* Q; const bf16_t* K; const bf16_t* V; bf16_t* O; int P0; };
struct Seam { bf16x8 qr[4]; bf16x8 st_v0, st_v1, st_k0, st_k1; };
#define ROWK(p, k0, rr) ((p) + (size_t)((k0) + (rr)) * KP + sc)
#define ROWV(p, k0, rr) ((p) + (size_t)((k0) + (rr)) * VP + sc)
#define LD8(ptr) (*reinterpret_cast<const bf16x8*>(ptr))
#define VMW() asm volatile("s_waitcnt vmcnt(0)" ::: "memory")
#define VMWN(n) asm volatile("s_waitcnt vmcnt(%0)" :: "i"(n) : "memory")
#define SLOAD_H(Kp, Vp, k0) do { S.st_v0 = LD8(ROWV(Vp, k0, sr)); S.st_v1 = LD8(ROWV(Vp, k0, 32 + sr)); S.st_k0 = LD8(ROWK(Kp, k0, sr)); S.st_k1 = LD8(ROWK(Kp, k0, 32 + sr)); } while (0)
#define SWRITE_HK(bf) do { *(bf16x8*)(K_lds + (bf) * SHM_K + kws) = S.st_k0; *(bf16x8*)(K_lds + (bf) * SHM_K + kws + 32 * 256) = S.st_k1; } while (0)
#define SWRITE_HV(bf) do { *(bf16x8*)(V_lds + (bf) * SHM_V + vst0) = S.st_v0; *(bf16x8*)(V_lds + (bf) * SHM_V + vst1) = S.st_v1; } while (0)
#define SWRITE_H(bf) do { SWRITE_HV(bf); SWRITE_HK(bf); } while (0)
#define QLOAD(ref) do { _Pragma("unroll") for (int d0 = 0; d0 < 4; ++d0) S.qr[d0] = LD8((ref).Q + (size_t)(qi * QBLK + r32) * KP + cc * 64 + d0 * 16 + hi * 8); } while (0)
__device__ __forceinline__ void prime(const BlockRef& cur, char* lds, Seam& S) {
    const int tid = threadIdx.x, wid = __builtin_amdgcn_readfirstlane(tid >> 6), lane = tid & 63, r32 = lane & 31, hi = lane >> 5, qi = wid >> 1, cc = wid & 1;
    const int sr = tid >> 4, sc = (tid & 15) * 8, kws = KSWZ(sr, sc * 2); char* K_lds = lds + 2 * SHM_V;
    QLOAD(cur);
    SLOAD_H(cur.K, cur.V, 0); VMW(); SWRITE_HK(0);
    __syncthreads();
}
__device__ __forceinline__ void block(const BlockRef& cur, const BlockRef& nxt, char* lds, Seam& S, float lam, float smax, const float* subg, bool lastblk) {
    const int tid = threadIdx.x, wid = __builtin_amdgcn_readfirstlane(tid >> 6), lane = tid & 63, r32 = lane & 31, hi = lane >> 5, qi = wid >> 1, cc = wid & 1;
    const int NT = cur.P0 / KVBLK + 2;
    const int qlo = cur.P0 + qi * QBLK, qm = qlo + r32 - 4 * hi;
    char* V_lds = lds; char* K_lds = lds + 2 * SHM_V;
    float* wsf = (float*)(lds + LDS_WS) + wid * 64; float* li_l = wsf;
    float* exch = (float*)(lds + LDS_EX) + qi * 4096;
    float l_reg = 0; f32x16 o[4] = {};
    const int sr = tid >> 4, sc = (tid & 15) * 8, vst0 = v_st(sr, sc), vst1 = v_st(32 + sr, sc), kws = KSWZ(sr, sc * 2);
    const int vb0 = (int)(uintptr_t)V_lds + v_rd_base(lane);
    const bf16_t* Kh = cur.K; const bf16_t* Vh = cur.V;
    constexpr float C2 = 1.4426950408889634f * 0.125f; const float negM = -smax * 1.4426950408889634f;
#define KBASE(t) ((t) * KVBLK)
#define MASKT(P0_, P1_, t) do { const int kb_ = KBASE(t); if (kb_ + KVBLK - 1 > qlo) mask_tile(P0_, P1_, qm - kb_); } while (0)
    f32x16 pA0, pA1, pB0, pB1; bf16x8 pa0, pa1, pa2, pa3;
    SWRITE_HV(0); SBAR();
    SLOAD_H(Kh, Vh, KBASE(1));
    SBAR(); qkt<0>(pA0, pA1, K_lds, r32, hi, S.qr, cc);
    MASKT(pA0, pA1, 0); partialSM(pA0, pA1, C2, negM);
    VMW(); SWRITE_H(1);
    __syncthreads();
#define HALF_STEP(PX0, PX1, PY0, PY1, t, KB, VB, SB) do {                                                      \
        SBAR(); qkt<KB>(PX0, PX1, K_lds, r32, hi, S.qr, cc);                                                  \
        finishSM(PY0, PY1, l_reg, pa0, pa1, pa2, pa3); SBAR();                                                \
        if ((t) + 1 < NT) { SLOAD_H(Kh, Vh, KBASE((t) + 1)); SBAR(); }                                        \
        pv_tile<VB>(o, vb0, pa0, pa1, pa2, pa3); MASKT(PX0, PX1, (t)); partialSM(PX0, PX1, C2, negM);          \
        __syncthreads();                                                                                       \
        if ((t) + 1 < NT) { VMW(); SWRITE_H(SB); }                                                             \
        __syncthreads(); } while (0)
    for (int t = 1; t + 1 < NT; t += 2) {
        HALF_STEP(pB0, pB1, pA0, pA1, t, 1, 0, 0);
        HALF_STEP(pA0, pA1, pB0, pB1, t + 1, 0, 1, 1);
    }
    SBAR(); qkt<1>(pB0, pB1, K_lds, r32, hi, S.qr, cc); SBAR();
    SLOAD_H(nxt.K, nxt.V, 0); SBAR();
    QLOAD(nxt);
    SBAR();
    finishSM(pA0, pA1, l_reg, pa0, pa1, pa2, pa3); SBAR();
    pv_tile<0>(o, vb0, pa0, pa1, pa2, pa3);
    MASKT(pB0, pB1, NT - 1); partialSM(pB0, pB1, C2, negM); __syncthreads();
    finishSM(pB0, pB1, l_reg, pa0, pa1, pa2, pa3); SBAR(); pv_tile<1>(o, vb0, pa0, pa1, pa2, pa3);
    SBAR(); VMWN(4); SWRITE_HK(0); SBAR();
    if (hi == 0) li_l[r32] = l_reg; asm volatile("s_waitcnt lgkmcnt(0)" ::: "memory");
    float rli[16];
#pragma unroll
    for (int r = 0; r < 16; ++r) rli[r] = __builtin_amdgcn_rcpf(li_l[crow(r, hi)]) * (cc ? lam : 1.f);
#pragma unroll
    for (int d0 = 0; d0 < 4; ++d0)
#pragma unroll
        for (int r = 0; r < 16; ++r) o[d0][r] *= rli[r];
    if (cc == 1) {
#pragma unroll
        for (int d0 = 0; d0 < 4; ++d0)
#pragma unroll
            for (int r = 0; r < 16; ++r) exch[(d0 * 16 + r) * 64 + lane] = o[d0][r];
    }
    __syncthreads();
    if (cc == 0) {
        float gsub[4];
#pragma unroll
        for (int d0 = 0; d0 < 4; ++d0) gsub[d0] = subg[d0 * 32 + r32] * (1.f - LAM_INIT);
        bf16_t* Ow = cur.O + (size_t)(qi * QBLK) * KP;
#pragma unroll
        for (int r = 0; r < 16; ++r) {
            float ss = 0.f;
#pragma unroll
            for (int d0 = 0; d0 < 4; ++d0) { o[d0][r] -= exch[(d0 * 16 + r) * 64 + lane]; ss += o[d0][r] * o[d0][r]; }
#pragma unroll
            for (int of = 1; of < 32; of <<= 1) ss += __shfl_xor(ss, of);
            const float rstd = rsqrtf(ss * (1.f / 128.f) + EPS); const int orow = crow(r, hi);
#pragma unroll
            for (int d0 = 0; d0 < 4; ++d0) { const float v = o[d0][r] * rstd * gsub[d0]; const float vn = __shfl_xor(v, 1);
                if ((r32 & 1) == 0) *(unsigned*)(Ow + (size_t)orow * KP + d0 * 32 + r32) = cvtpk(v, vn); }
        }
    }
    if (lastblk) __syncthreads();
#undef KBASE
#undef MASKT
#undef HALF_STEP
}
__device__ __forceinline__ void phase(char* lds, const bf16_t* QKb, const bf16_t* Vb, bf16_t* MX, float lam, float smax, const float* subg, int G, int vcu) {
    constexpr int NX = NQB / 2, TOTAL = NB * NH * NX;
    int L = vcu; if (L >= TOTAL) return;
    int pass = 0;
#define MKREF(ref, LL, ps) do { const int bh_ = (LL) / NX, x_ = (LL) % NX, qb_ = (ps) ? (NQB - 1 - x_) : x_, b_ = bh_ / NH, h_ = bh_ % NH; \
        const size_t row0_ = (size_t)b_ * SEQ; (ref).P0 = qb_ * QB; \
        (ref).Q = QKb + (row0_ + qb_ * QB) * KP + h_ * 128; (ref).K = QKb + row0_ * KP + 512 + h_ * 128; (ref).V = Vb + row0_ * VP + h_ * 128; \
        (ref).O = MX + (row0_ + qb_ * QB) * KP + h_ * 128; } while (0)
    BlockRef cur, nxt; MKREF(cur, L, 0);
    Seam S;
    prime(cur, lds, S);
    for (;;) {
        const bool more_pass = pass == 0, more_item = L + G < TOTAL, last = !more_pass && !more_item;
        int passn = pass + 1, Ln = L;
        if (!more_pass) { passn = 0; Ln = more_item ? L + G : L; }
        if (last) nxt = cur; else MKREF(nxt, Ln, passn);
        block(cur, nxt, lds, S, lam, smax, subg, last);
        if (last) break;
        cur = nxt; pass = passn; L = Ln;
    }
#undef MKREF
}
#undef ROWK
#undef ROWV
#undef LD8
#undef VMW
#undef VMWN
#undef SLOAD_H
#undef SWRITE_HK
#undef SWRITE_HV
#undef SWRITE_H
#undef QLOAD
#undef KSWZ
#undef SBAR
}

enum { PH_PRO = 0, PH_CONV, PH_H1, PH_WIN, PH_WIN_F, PH_QKN, PH_ATT, PH_ATTC, PH_ATT_F, PH_SSM, PH_SSMGEN, PH_SSMA_F, PH_SCAN, PH_SSMC_F, PH_GLU, PH_GLU_F, PH_NORM, PH_WOUT, PH_WOUT_F, PH_H2,
       PH_RS, PH_RS2, PH_RS_F, PH_SD, PH_SD_F, PH_ROUTE, PH_SLOT, PH_E1, PH_E1_F, PH_E2, PH_E2_F, PH_COMB, PH_M_A, PH_M_B, PH_M_D, PH_M_E, PH_SLOT2, PH_SDC_F, PH_NORM2, PH_H2_2, PH_COUNT };
constexpr int NTHREADS = 512;
constexpr int LDS_BYTES = 147456;
constexpr int LDS_MISC_OFF = 147456 - 256;
typedef unsigned long long mask_t;
#define PHBIT(k) (1ull << (k))

template <mask_t MASK>
__global__ void __launch_bounds__(NTHREADS, 2) mega(Params p) {
    extern __shared__ __attribute__((aligned(16))) unsigned char lds_raw[];
#define MAKE_CTX() Ctx c; { int t_ = threadIdx.x; asm volatile("" : "+v"(t_)); c.tid = t_; c.lane = c.tid & 63; c.wave = __builtin_amdgcn_readfirstlane(c.tid >> 6); c.bid = blockIdx.x; c.nb = gridDim.x; \
    c.gtid = c.bid * NTHREADS + c.tid; c.gthreads = c.nb * NTHREADS; c.gwave = c.bid * (NTHREADS / 64) + c.wave; c.gwaves = c.nb * (NTHREADS / 64); c.ws = p.ws; c.lds = (float*)lds_raw; }
    unsigned char* ws = p.ws;
    PG8_LAS unsigned char* lds3 = (PG8_LAS unsigned char*)lds_raw;
    const int G = gridDim.x, bid = blockIdx.x, vcu = (G % 8 == 0) ? (bid % 8) * (G / 8) + bid / 8 : bid;
    constexpr bool MULTI = (MASK & (MASK - 1)) != 0;
    XcdBarrier bar; bar.bar = (unsigned*)(ws + WS_CTL) + CW_BAR; bar.x = 0; bar.st = nullptr;
    if constexpr (MULTI) {
        volatile LAS unsigned* misc = (volatile LAS unsigned*)(lds3 + LDS_MISC_OFF);
        if (threadIdx.x < 32) misc[threadIdx.x] = 0u;
        __syncthreads();
        bar = xcd_barrier_post((unsigned*)(ws + WS_CTL) + CW_BAR, misc + 8);
    }
    bool first = true;
#define PHASE(k) if constexpr ((MASK >> (k)) & 1ull) if ((MULTI ? (first ? (first = false, true) : (xcd_barrier(bar), true)) : true))
    PHASE(PH_PRO) { MAKE_CTX(); ph_prologue(c, p); }
    PHASE(PH_M_A) { MAKE_CTX(); ph_prologue2(c, p); ph_convert(c, p); }
    PHASE(PH_CONV) { MAKE_CTX(); ph_convert(c, p); }
    PHASE(PH_H1) { MAKE_CTX(); ph_h1(c, p); }
    PHASE(PH_M_B) { MAKE_CTX(); ph_h1(c, p); ph_ssm_gen(c, p); }
    PHASE(PH_WIN) { MAKE_CTX(); SG_Args g{(const bf16_t*)(ws + WS_H), DM, nullptr, p.in[I_WIN], nullptr, 2048, 0, nullptr, T, 2048, DM};
        EpiWin E{(bf16_t*)(ws + WS_QK), (bf16_t*)(ws + WS_V), (bf16_t*)(ws + WS_AP)}; sgemm_phase<false>(c, g, E); }
    PHASE(PH_WIN_F) { MAKE_CTX(); pg8::Gemm g{(const bf16_t*)(ws + WS_H), (const bf16_t*)(ws + WS_WIN_T), DM, DM, nullptr}; pg8::DenseOrder S; S.init(T, 2048, G, bid);
        pg8::EpiWinF E{(bf16_t*)(ws + WS_QK), (bf16_t*)(ws + WS_V), (bf16_t*)(ws + WS_AP)}; pg8::gemm_phase<pg8::EpiWinF, pg8::DenseOrder, false, true>(lds3, g, S, E); }
    PHASE(PH_QKN) { MAKE_CTX(); ph_qkn(c, p); }
    PHASE(PH_M_D) { { MAKE_CTX(); ph_qkn(c, p); }
        { pg8::Gemm g{(const bf16_t*)(ws + WS_AP), (const bf16_t*)(ws + WS_SSM_BA), 256, APK, nullptr}; pg8::SsmOrder S{G, vcu};
          pg8::EpiSsmA E{(float*)(ws + WS_DS)}; pg8::gemm_phase<pg8::EpiSsmA, pg8::SsmOrder, false, false>(lds3, g, S, E); }
        __builtin_amdgcn_fence(__ATOMIC_ACQUIRE, "agent"); asm volatile("s_waitcnt vmcnt(0)" ::: "memory"); __syncthreads();
        { MAKE_CTX(); ph_ssm_scan(c, p, vcu); }
        asm volatile("s_waitcnt vmcnt(0)" ::: "memory"); __syncthreads(); __builtin_amdgcn_fence(__ATOMIC_ACQUIRE, "agent"); asm volatile("s_waitcnt vmcnt(0)" ::: "memory"); __syncthreads();
        { pg8::Gemm g{(const bf16_t*)(ws + WS_AP), (const bf16_t*)(ws + WS_SSM_BC), APK, APK, nullptr}; pg8::SsmOrder S{G, vcu};
          pg8::EpiSsmC E{(bf16_t*)(ws + WS_Y)}; pg8::gemm_phase<pg8::EpiSsmC, pg8::SsmOrder, false, false>(lds3, g, S, E); } }
    PHASE(PH_ATT) { MAKE_CTX(); ph_att_base(c, p); }
    PHASE(PH_ATTC) { MAKE_CTX(); ph_att_comb(c, p); }
    PHASE(PH_ATT_F) { const float* lamp = (const float*)(ws + WS_LAM);
        att::phase((char*)lds_raw, (const bf16_t*)(ws + WS_QK), (const bf16_t*)(ws + WS_V), (bf16_t*)(ws + WS_MIXIN), lamp[0], lamp[1], p.in[I_SUBG], G, vcu); }
    PHASE(PH_SSM) { MAKE_CTX(); ph_ssm_base(c, p); }
    PHASE(PH_SSMGEN) { MAKE_CTX(); ph_ssm_gen(c, p); }
    PHASE(PH_SSMA_F) { pg8::Gemm g{(const bf16_t*)(ws + WS_AP), (const bf16_t*)(ws + WS_SSM_BA), 256, APK, nullptr}; pg8::SsmOrder S{G, vcu};
        pg8::EpiSsmA E{(float*)(ws + WS_DS)}; pg8::gemm_phase<pg8::EpiSsmA, pg8::SsmOrder, false, false>(lds3, g, S, E); }
    PHASE(PH_SCAN) { MAKE_CTX(); ph_ssm_scan(c, p, vcu); }
    PHASE(PH_SSMC_F) { pg8::Gemm g{(const bf16_t*)(ws + WS_AP), (const bf16_t*)(ws + WS_SSM_BC), APK, APK, nullptr}; pg8::SsmOrder S{G, vcu};
        pg8::EpiSsmC E{(bf16_t*)(ws + WS_Y)}; pg8::gemm_phase<pg8::EpiSsmC, pg8::SsmOrder, false, false>(lds3, g, S, E); }
    PHASE(PH_M_E) { { const float* lamp = (const float*)(ws + WS_LAM);
          att::phase((char*)lds_raw, (const bf16_t*)(ws + WS_QK), (const bf16_t*)(ws + WS_V), (bf16_t*)(ws + WS_MIXIN), lamp[0], lamp[1], p.in[I_SUBG], G, vcu); }
        __syncthreads();
        { pg8::Gemm g{(const bf16_t*)(ws + WS_Y), (const bf16_t*)(ws + WS_WGLU_T), 512, 512, nullptr}; pg8::DenseOrder S; S.init(T, 512, G, bid);
          pg8::EpiGluF E{(const bf16_t*)(ws + WS_Y), (bf16_t*)(ws + WS_MIXIN), (float*)(ws + WS_SS1P)}; pg8::gemm_phase<pg8::EpiGluF, pg8::DenseOrder, false, true>(lds3, g, S, E); } }
    PHASE(PH_GLU) { MAKE_CTX(); SG_Args g{(const bf16_t*)(ws + WS_Y), 512, nullptr, p.in[I_WGLU], nullptr, 512, 0, nullptr, T, 512, 512};
        EpiGlu E{(const bf16_t*)(ws + WS_Y), (bf16_t*)(ws + WS_MIXIN), (float*)(ws + WS_CTL + CTL_SS1)}; sgemm_phase<false>(c, g, E); }
    PHASE(PH_GLU_F) { MAKE_CTX(); pg8::Gemm g{(const bf16_t*)(ws + WS_Y), (const bf16_t*)(ws + WS_WGLU_T), 512, 512, nullptr}; pg8::DenseOrder S; S.init(T, 512, G, bid);
        pg8::EpiGluF E{(const bf16_t*)(ws + WS_Y), (bf16_t*)(ws + WS_MIXIN), (float*)(ws + WS_SS1P)}; pg8::gemm_phase<pg8::EpiGluF, pg8::DenseOrder, false, true>(lds3, g, S, E); }
    PHASE(PH_NORM) { MAKE_CTX(); ph_ssm_norm(c, p); }
    PHASE(PH_NORM2) { MAKE_CTX(); ph_ssm_norm2(c, p); }
    PHASE(PH_WOUT) { MAKE_CTX(); SG_Args g{(const bf16_t*)(ws + WS_MIXIN), DM, nullptr, p.in[I_WOUT], nullptr, DM, 0, nullptr, T, DM, DM};
        EpiWout E{p.in[I_X], (const float*)(ws + WS_MOD), p.out, (float*)(ws + WS_CTL + CTL_SS2)}; sgemm_phase<false>(c, g, E); }
    PHASE(PH_WOUT_F) { MAKE_CTX(); pg8::Gemm g{(const bf16_t*)(ws + WS_MIXIN), (const bf16_t*)(ws + WS_WOUT_T), DM, DM, nullptr}; pg8::DenseOrder S; S.init(T, DM, G, bid);
        pg8::EpiWoutF E{p.in[I_X], (const float*)(ws + WS_MOD), p.out, (float*)(ws + WS_SS2P)}; pg8::gemm_phase<pg8::EpiWoutF, pg8::DenseOrder, false, true>(lds3, g, S, E); }
    PHASE(PH_H2) { MAKE_CTX(); ph_h2(c, p); }
    PHASE(PH_H2_2) { MAKE_CTX(); ph_h2_2(c, p); }
    PHASE(PH_RS) { MAKE_CTX(); SG_Args g{(const bf16_t*)(ws + WS_H), DM, nullptr, p.in[I_WR], nullptr, 256, 0, nullptr, T, 256, DM};
        EpiLogits E{(float*)(ws + WS_LOGITS)}; sgemm_phase<false>(c, g, E); }
    PHASE(PH_RS2) { MAKE_CTX(); SG_Args g2{(const bf16_t*)(ws + WS_H), DM, nullptr, p.in[I_WGS], p.in[I_WUS], 256, 0, nullptr, T, 256, DM};
        EpiSwiglu E2{(bf16_t*)(ws + WS_ACTS), 256}; sgemm_phase<true>(c, g2, E2); }
    PHASE(PH_RS_F) { MAKE_CTX(); pg8::Gemm g{(const bf16_t*)(ws + WS_H), (const bf16_t*)(ws + WS_WRS_T), DM, DM, nullptr}; pg8::DenseOrder S; S.init(T, 768, G, bid);
        pg8::EpiRSF E{(float*)(ws + WS_LOGITS), (bf16_t*)(ws + WS_ACTS)}; pg8::gemm_phase<pg8::EpiRSF, pg8::DenseOrder, false, true>(lds3, g, S, E); }
    PHASE(PH_SD) { MAKE_CTX(); SG_Args g{(const bf16_t*)(ws + WS_ACTS), 256, nullptr, p.in[I_WDS], nullptr, DM, 0, nullptr, T, DM, ED};
        EpiSD E{(const float*)(ws + WS_MOD), p.out}; sgemm_phase<false>(c, g, E); }
    PHASE(PH_SD_F) { MAKE_CTX(); pg8::Gemm g{(const bf16_t*)(ws + WS_ACTS), (const bf16_t*)(ws + WS_WDS_T), ED, ED, nullptr}; pg8::DenseOrder S; S.init(T, DM, G, bid);
        pg8::EpiSDF E{(const float*)(ws + WS_MOD), p.out}; pg8::gemm_phase<pg8::EpiSDF, pg8::DenseOrder, false, true>(lds3, g, S, E); }
    PHASE(PH_ROUTE) { MAKE_CTX(); ph_route(c, p); }
    PHASE(PH_SLOT) { MAKE_CTX(); ph_slot(c, p); }
    PHASE(PH_SLOT2) { MAKE_CTX(); ph_slot2(c, p); }
    PHASE(PH_E1) { MAKE_CTX(); SG_Args g{(const bf16_t*)(ws + WS_H), DM, (const int*)(ws + WS_SLOT_TOK), p.in[I_WGE], p.in[I_WUE], 256, (size_t)DM * ED, (const int*)(ws + WS_TILE_E), NS_MAX, ED, DM};
        EpiSwiglu E{(bf16_t*)(ws + WS_ACTE), 256}; sgemm_phase<true>(c, g, E); }
    PHASE(PH_E1_F) { MAKE_CTX(); pg8::Gemm g{(const bf16_t*)(ws + WS_H), (const bf16_t*)(ws + WS_WGU), DM, DM, (const int*)(ws + WS_SLOT_TOK)};
        pg8::GroupedOrder S{(const int*)(ws + WS_TILE_E), (int)((const unsigned*)(ws + WS_CTL))[CW_NTILES], 2, G, vcu};
        pg8::EpiE1F E{(bf16_t*)(ws + WS_ACTE)}; pg8::gemm_phase<pg8::EpiE1F, pg8::GroupedOrder, true, true>(lds3, g, S, E); }
    PHASE(PH_E2) { MAKE_CTX(); SG_Args g{(const bf16_t*)(ws + WS_ACTE), 256, nullptr, p.in[I_WDE], nullptr, DM, (size_t)ED * DM, (const int*)(ws + WS_TILE_E), NS_MAX, DM, ED};
        EpiE2 E{(const int*)(ws + WS_SLOT_ASG), (const float*)(ws + WS_SLOT_GATE), (bf16_t*)(ws + WS_YA)}; sgemm_phase<false>(c, g, E); }
    PHASE(PH_E2_F) { MAKE_CTX(); pg8::Gemm g{(const bf16_t*)(ws + WS_ACTE), (const bf16_t*)(ws + WS_WD), ED, ED, nullptr};
        pg8::GroupedOrder S{(const int*)(ws + WS_TILE_E), (int)((const unsigned*)(ws + WS_CTL))[CW_NTILES], 4, G, vcu};
        pg8::EpiE2F E{(const int*)(ws + WS_SLOT_ASG), (const float*)(ws + WS_SLOT_GATE), (bf16_t*)(ws + WS_YA)}; pg8::gemm_phase<pg8::EpiE2F, pg8::GroupedOrder, false, true>(lds3, g, S, E); }
    PHASE(PH_COMB) { MAKE_CTX(); ph_combine(c, p); }
    PHASE(PH_SDC_F) { pg8::Gemm g{(const bf16_t*)(ws + WS_ACTS), (const bf16_t*)(ws + WS_WDS_T), ED, ED, nullptr}; pg8::DenseOrder S; S.init(T, DM, G, bid);
        pg8::EpiSDC E{(const float*)(ws + WS_MOD), p.out, (const bf16_t*)(ws + WS_YA)}; pg8::gemm_phase<pg8::EpiSDC, pg8::DenseOrder, false, true>(lds3, g, S, E); }
#undef PHASE
}

#ifndef PLAN
#define PLAN 5
#endif
#if PLAN == 0
#define LAUNCH_LIST X(PHBIT(PH_PRO)) X(PHBIT(PH_H1)) X(PHBIT(PH_WIN)) X(PHBIT(PH_QKN)) X(PHBIT(PH_ATT)) X(PHBIT(PH_ATTC)) X(PHBIT(PH_SSM)) X(PHBIT(PH_GLU)) X(PHBIT(PH_NORM)) \
    X(PHBIT(PH_WOUT)) X(PHBIT(PH_H2)) X(PHBIT(PH_RS)) X(PHBIT(PH_RS2)) X(PHBIT(PH_SD)) X(PHBIT(PH_ROUTE)) X(PHBIT(PH_SLOT)) X(PHBIT(PH_E1)) X(PHBIT(PH_E2)) X(PHBIT(PH_COMB))
#elif PLAN == 1
#define LAUNCH_LIST X(PHBIT(PH_PRO)) X(PHBIT(PH_CONV)) X(PHBIT(PH_H1)) X(PHBIT(PH_WIN_F)) X(PHBIT(PH_QKN)) X(PHBIT(PH_ATT)) X(PHBIT(PH_ATTC)) X(PHBIT(PH_SSM)) X(PHBIT(PH_GLU_F)) X(PHBIT(PH_NORM)) \
    X(PHBIT(PH_WOUT_F)) X(PHBIT(PH_H2)) X(PHBIT(PH_RS_F)) X(PHBIT(PH_SD_F)) X(PHBIT(PH_ROUTE)) X(PHBIT(PH_SLOT)) X(PHBIT(PH_E1_F)) X(PHBIT(PH_E2_F)) X(PHBIT(PH_COMB))
#elif PLAN == 2
#define LAUNCH_LIST X(PHBIT(PH_PRO) | PHBIT(PH_CONV) | PHBIT(PH_H1) | PHBIT(PH_WIN_F) | PHBIT(PH_QKN) | PHBIT(PH_ATT) | PHBIT(PH_ATTC) | PHBIT(PH_SSM) | PHBIT(PH_GLU_F) | PHBIT(PH_NORM) | \
    PHBIT(PH_WOUT_F) | PHBIT(PH_H2) | PHBIT(PH_RS_F) | PHBIT(PH_SD_F) | PHBIT(PH_ROUTE) | PHBIT(PH_SLOT) | PHBIT(PH_E1_F) | PHBIT(PH_E2_F) | PHBIT(PH_COMB))
#elif PLAN == 3
#define LAUNCH_LIST X(PHBIT(PH_PRO) | PHBIT(PH_CONV) | PHBIT(PH_H1) | PHBIT(PH_WIN_F) | PHBIT(PH_QKN) | PHBIT(PH_ATT_F) | PHBIT(PH_SSM) | PHBIT(PH_GLU_F) | PHBIT(PH_NORM) | \
    PHBIT(PH_WOUT_F) | PHBIT(PH_H2) | PHBIT(PH_RS_F) | PHBIT(PH_SD_F) | PHBIT(PH_ROUTE) | PHBIT(PH_SLOT) | PHBIT(PH_E1_F) | PHBIT(PH_E2_F) | PHBIT(PH_COMB))
#elif PLAN == 4
#define LAUNCH_LIST X(PHBIT(PH_PRO) | PHBIT(PH_CONV) | PHBIT(PH_H1) | PHBIT(PH_WIN_F) | PHBIT(PH_QKN) | PHBIT(PH_ATT_F) | PHBIT(PH_SSMGEN) | PHBIT(PH_SSMA_F) | PHBIT(PH_SCAN) | PHBIT(PH_SSMC_F) | PHBIT(PH_GLU_F) | PHBIT(PH_NORM) | \
    PHBIT(PH_WOUT_F) | PHBIT(PH_H2) | PHBIT(PH_RS_F) | PHBIT(PH_SD_F) | PHBIT(PH_ROUTE) | PHBIT(PH_SLOT) | PHBIT(PH_E1_F) | PHBIT(PH_E2_F) | PHBIT(PH_COMB))
#elif PLAN == 5
#define LAUNCH_LIST X(PHBIT(PH_M_A) | PHBIT(PH_M_B) | PHBIT(PH_WIN_F) | PHBIT(PH_M_D) | PHBIT(PH_M_E) | PHBIT(PH_NORM2) | PHBIT(PH_WOUT_F) | PHBIT(PH_H2_2) | PHBIT(PH_RS_F) | PHBIT(PH_ROUTE) | PHBIT(PH_SLOT2) | PHBIT(PH_E1_F) | PHBIT(PH_E2_F) | PHBIT(PH_SDC_F))
#endif

extern "C" void kernel_launch(void* const* d_in, const int* in_sizes, int n_in, void* d_out, int out_size, void* d_ws, size_t ws_size, hipStream_t stream) {
    static int grid = 0;
    if (grid == 0) {
        if (n_in != 33 || out_size != T * DM || ws_size < WS_NEED) { fprintf(stderr, "kernel_launch: unexpected shapes (n_in %d out %d ws %zu)\n", n_in, out_size, ws_size); grid = -1; return; }
        int dev = 0, cus = 0;
        if (hipGetDevice(&dev) != hipSuccess || hipDeviceGetAttribute(&cus, hipDeviceAttributeMultiprocessorCount, dev) != hipSuccess) { grid = -1; return; }
        bool ok = true;
#define X(m) ok = ok && (hipFuncSetAttribute((const void*)mega<(m)>, hipFuncAttributeMaxDynamicSharedMemorySize, LDS_BYTES) == hipSuccess);
        LAUNCH_LIST
#undef X
        if (!ok) { grid = -1; return; }
        grid = cus;
    }
    if (grid < 0) return;
    (void)hipMemsetAsync((char*)d_ws + WS_CTL, 0, CTL_BYTES, stream);
    Params a{};
    for (int i = 0; i < 33; ++i) a.in[i] = (const float*)d_in[i];
    a.out = (float*)d_out; a.ws = (unsigned char*)d_ws;
#define X(m) hipLaunchKernelGGL((mega<(m)>), dim3(grid), dim3(NTHREADS), LDS_BYTES, stream, a);
    LAUNCH_LIST
#undef X
}
```

```cpp
#include <hip/hip_runtime.h>
#include <cstdio>
#include <cstdint>

typedef unsigned short bf16_t;
typedef float f32x4 __attribute__((ext_vector_type(4)));
typedef unsigned u32x4 __attribute__((ext_vector_type(4)));
typedef unsigned u32x2 __attribute__((ext_vector_type(2)));

constexpr int DM = 1024, NB = 8, SEQ = 4096, T = NB * SEQ;
constexpr int NH = 4, HD = 64, VD = 128, QKW = 512, ATTW = 512, SSMW = 512;
constexpr int SG = 32, SC = 16, SP = 64;
constexpr int LC = 16;
constexpr int NCHUNK = SEQ / LC;
constexpr int APK = 384;
constexpr int NE = 256, TOPK = 8, NGRP = 8, TOPG = 4, ED = 256;
constexpr int NS_MAX = 327680;
constexpr float EPS = 1e-6f;
constexpr float LAM_INIT = 0.2f;
constexpr float ROUTED_SCALE = 2.5f;
constexpr float WGU8_SCALE = 64.f, WD8_SCALE = 32.f, ACT8_SCALE = 8.f, Y8_SCALE = 16.f;

constexpr size_t MiB = 1u << 20;
constexpr size_t WS_CTL = 0, CTL_BYTES = 1 * MiB;
constexpr int CW_COUNTS = 1024;
constexpr int CW_CURSOR = 1024 + 256;
constexpr int CW_NTILES = 2048;
constexpr int CW_ATTQ = 2560  , CW_CONVQ = 2176;
constexpr int CW_BAR = 4096;
constexpr size_t CTL_SS1 = 256 * 1024;
constexpr size_t CTL_SS2 = 384 * 1024;
constexpr size_t WS_MOD = 512 * 1024;
constexpr size_t WS_LAM = 1 * MiB + 256 * 1024;
constexpr size_t WS_ROPE = 1 * MiB + 512 * 1024;
constexpr size_t WS_SSMP = 2 * MiB + 512 * 1024;
constexpr size_t WS_SS1P = 3 * MiB;
constexpr size_t WS_SS2P = 528 * MiB;
constexpr size_t WS_HIST = 11 * MiB;
constexpr size_t WS_EIDX = 4 * MiB;
constexpr size_t WS_GATEW = 5 * MiB;
constexpr size_t WS_SLOT_TOK = 6 * MiB;
constexpr size_t WS_SLOT_ASG = 7 * MiB + 512 * 1024;
constexpr size_t WS_SLOT_GATE = 9 * MiB;
constexpr size_t WS_TILE_E = 10 * MiB + 512 * 1024;
constexpr size_t WS_PADST = 10 * MiB + 768 * 1024;
constexpr size_t WS_WIN_T = 12 * MiB;
constexpr size_t WS_WOUT_T = 16 * MiB;
constexpr size_t WS_WGLU_T = 18 * MiB;
constexpr size_t WS_WRS_T = 19 * MiB;
constexpr size_t WS_SSMPW = 20 * MiB + 512 * 1024;
constexpr size_t WS_WDS_T = 21 * MiB;
constexpr size_t WS_SSM_BA = 22 * MiB;
constexpr size_t WS_SSM_BC = 26 * MiB;
constexpr size_t WS_DS = 496 * MiB;
constexpr size_t WS_WGU = 32 * MiB;
constexpr size_t WS_WD = 832 * MiB;
constexpr size_t WS_YS = 32 * MiB;
constexpr size_t WS_YA = 32 * MiB;
constexpr size_t WS_H = 288 * MiB;
constexpr size_t WS_H8 = 352 * MiB;
constexpr size_t WS_QK = 352 * MiB;
constexpr size_t WS_Y = 288 * MiB;
constexpr size_t WS_V = 416 * MiB;
constexpr size_t WS_AP = 448 * MiB;
constexpr size_t WS_ACTE = 672 * MiB;
constexpr size_t WS_MIXIN = 544 * MiB;
constexpr size_t WS_LOGITS = 608 * MiB;
constexpr size_t WS_ACTS = 640 * MiB;
constexpr size_t WS_YSH = 960 * MiB;
constexpr size_t WS_ATTO = 832 * MiB;
constexpr size_t WS_NEED = 1024 * MiB;

__device__ __forceinline__ float bf2f(bf16_t v) { return __uint_as_float((unsigned)v << 16); }
__device__ __forceinline__ bf16_t f2bf(float f) { unsigned u = __float_as_uint(f); return (bf16_t)((u + 0x7fffu + ((u >> 16) & 1u)) >> 16); }
__device__ __forceinline__ unsigned pk2(float lo, float hi) { return (unsigned)f2bf(lo) | ((unsigned)f2bf(hi) << 16); }
__device__ __forceinline__ float wave_sum(float v) {
#pragma unroll
    for (int o = 1; o < 64; o <<= 1) v += __shfl_xor(v, o);
    return v;
}
__device__ __forceinline__ float clamp448(float v) { return __builtin_amdgcn_fmed3f(v, -448.f, 448.f); }
__device__ __forceinline__ unsigned pk4_fp8(float a, float b, float c2, float d) { int w = __builtin_amdgcn_cvt_pk_fp8_f32(clamp448(a), clamp448(b), 0, false); w = __builtin_amdgcn_cvt_pk_fp8_f32(clamp448(c2), clamp448(d), w, true); return (unsigned)w; }
__device__ __forceinline__ float siluf(float v) { return v / (1.f + __expf(-v)); }
__device__ __forceinline__ float sigmoidf(float v) { return 1.f / (1.f + __expf(-v)); }
__device__ __forceinline__ float gelu_tanh(float v) { const float u2 = 1.5957691216057308f * (v + 0.044715f * v * v * v); return v / (1.f + __expf(-u2)); }

constexpr int NTHREADS_ = 512;
struct Params {
    const float* in[33];
    float* out;
    unsigned char* ws;
    int pad0, pad1;
};

struct Ctx {
    int tid, lane, wave, bid, nb;
    int gtid, gthreads, gwave, gwaves;
    unsigned char* ws;
    float* lds;
};

enum { I_X = 0, I_C, I_N1G, I_N2G, I_WADA, I_BADA, I_WIN, I_QNG, I_KNG, I_LQ1, I_LK1, I_LQ2, I_LK2, I_SUBG,
       I_ARE, I_AIM, I_LOGDT, I_BRE, I_BIM, I_CRE, I_CIM, I_SD, I_WGLU, I_SNG, I_WOUT, I_WR, I_RB,
       I_WGE, I_WUE, I_WDE, I_WGS, I_WUS, I_WDS };

struct SG_Args {
    const bf16_t* A; int lda; const int* rowidx;
    const float* W; const float* W2; int ldb;
    size_t wstride;
    const int* tile_e;
    int M, N, K;
};
template <bool DUAL, class Epi>
__device__ __forceinline__ void sgemm_phase(const Ctx& c, const SG_Args g, const Epi& E) {
    float* As = c.lds;
    float* Bs = c.lds + 16 * 132;
    float* Bs2 = Bs + 16 * 128;
    const int tid = c.tid, ty = tid >> 5, tx = tid & 31;
    const int nMt = g.M / 128, nNt = g.N / 128, ntile = nMt * nNt;
    for (int tile = c.bid; tile < ntile; tile += c.nb) {
        const int mt = tile / nNt, nt = tile % nNt;
        const float* W = g.W; const float* W2 = g.W2;
        if (g.tile_e) { const int e = g.tile_e[mt >> 1]; if (e < 0) continue; W += (size_t)e * g.wstride; if (DUAL) W2 += (size_t)e * g.wstride; }
        f32x4 acc[8], acc2[8];
#pragma unroll
        for (int i = 0; i < 8; ++i) { acc[i] = (f32x4){0.f, 0.f, 0.f, 0.f}; acc2[i] = (f32x4){0.f, 0.f, 0.f, 0.f}; }
        const int arow = mt * 128 + (tid >> 2), akq = (tid & 3) * 4;
        const int asrc = g.rowidx ? g.rowidx[arow] : arow;
        const bf16_t* ap = g.A + (size_t)asrc * g.lda + akq;
        const int bk = tid >> 5, bn = (tid & 31) * 4;
        const float* bp = W + (size_t)bk * g.ldb + nt * 128 + bn;
        const float* bp2 = DUAL ? (W2 + (size_t)bk * g.ldb + nt * 128 + bn) : nullptr;
#pragma unroll 1
        for (int k0 = 0; k0 < g.K; k0 += 16) {
            const u32x2 av = *(const u32x2*)(ap + k0);
            const f32x4 bv = *(const f32x4*)(bp + (size_t)k0 * g.ldb);
            f32x4 bv2 = {0.f, 0.f, 0.f, 0.f};
            if (DUAL) bv2 = *(const f32x4*)(bp2 + (size_t)k0 * g.ldb);
            __syncthreads();
            As[(akq + 0) * 132 + (tid >> 2)] = __uint_as_float(av.x << 16);
            As[(akq + 1) * 132 + (tid >> 2)] = __uint_as_float(av.x & 0xffff0000u);
            As[(akq + 2) * 132 + (tid >> 2)] = __uint_as_float(av.y << 16);
            As[(akq + 3) * 132 + (tid >> 2)] = __uint_as_float(av.y & 0xffff0000u);
            *(f32x4*)(Bs + bk * 128 + bn) = bv;
            if (DUAL) *(f32x4*)(Bs2 + bk * 128 + bn) = bv2;
            __syncthreads();
#pragma unroll
            for (int kk = 0; kk < 16; ++kk) {
                const f32x4 a0 = *(const f32x4*)(As + kk * 132 + ty * 8), a1 = *(const f32x4*)(As + kk * 132 + ty * 8 + 4);
                const f32x4 b = *(const f32x4*)(Bs + kk * 128 + tx * 4);
                const float a[8] = {a0.x, a0.y, a0.z, a0.w, a1.x, a1.y, a1.z, a1.w};
#pragma unroll
                for (int i = 0; i < 8; ++i) acc[i] += a[i] * b;
                if (DUAL) {
                    const f32x4 b2 = *(const f32x4*)(Bs2 + kk * 128 + tx * 4);
#pragma unroll
                    for (int i = 0; i < 8; ++i) acc2[i] += a[i] * b2;
                }
            }
        }
#pragma unroll
        for (int i = 0; i < 8; ++i) E(mt * 128 + ty * 8 + i, nt * 128 + tx * 4, acc[i], acc2[i], tx);
    }
}

__device__ __forceinline__ void ph_prologue(const Ctx& c, const Params& p) {
    float* mod = (float*)(c.ws + WS_MOD);
    for (int idx = c.gtid; idx < NB * 6 * DM; idx += c.gthreads) {
        const int b = idx / (6 * DM), j = idx % (6 * DM);
        const float* cc = p.in[I_C] + b * DM; const float* w = p.in[I_WADA] + j;
        float acc = p.in[I_BADA][j];
#pragma unroll 8
        for (int k = 0; k < DM; ++k) acc += siluf(cc[k]) * w[(size_t)k * (6 * DM)];
        mod[idx] = acc;
    }
    float* ropec = (float*)(c.ws + WS_ROPE); float* ropes = ropec + SEQ * 32;
    for (int idx = c.gtid; idx < SEQ * 32; idx += c.gthreads) {
        const int l = idx >> 5, i = idx & 31;
        const double invf = exp(-log(10000.0) * (double)(2 * i) / 64.0);
        const double ang = (double)l * invf;
        ropec[idx] = (float)cos(ang); ropes[idx] = (float)sin(ang);
    }
    float* sp = (float*)(c.ws + WS_SSMP);
    float* abr = sp, * abi = sp + SG * SP, * bbr = sp + 2 * SG * SP, * bbi = bbr + SG * SP * SC;
    for (int idx = c.gtid; idx < SG * SP; idx += c.gthreads) {
        const int g = idx / SP;
        const double are = p.in[I_ARE][idx], aim = p.in[I_AIM][idx], dt = exp((double)p.in[I_LOGDT][g]);
        const double mag = exp(are * dt), ar = mag * cos(aim * dt), ai = mag * sin(aim * dt);
        abr[idx] = (float)ar; abi[idx] = (float)ai;
        const double den = are * are + aim * aim, nr = ar - 1.0;
        const double fre = (nr * are + ai * aim) / den, fim = (ai * are - nr * aim) / den;
        for (int ch = 0; ch < SC; ++ch) {
            const double br = p.in[I_BRE][idx * SC + ch], bi = p.in[I_BIM][idx * SC + ch];
            bbr[idx * SC + ch] = (float)(fre * br - fim * bi); bbi[idx * SC + ch] = (float)(fre * bi + fim * br);
        }
    }
    if (c.gtid == 0) {
        float s1 = 0.f, s2 = 0.f, gq = 0.f, gk = 0.f;
        for (int i = 0; i < HD; ++i) { s1 += p.in[I_LQ1][i] * p.in[I_LK1][i]; s2 += p.in[I_LQ2][i] * p.in[I_LK2][i];
            gq = fmaxf(gq, fabsf(p.in[I_QNG][i])); gk = fmaxf(gk, fabsf(p.in[I_KNG][i])); }
        float* lam = (float*)(c.ws + WS_LAM);
        lam[0] = __expf(s1) - __expf(s2) + LAM_INIT;
        lam[1] = 0.125f * 64.f * gq * gk;
    }
    int* stok = (int*)(c.ws + WS_SLOT_TOK); int* sasg = (int*)(c.ws + WS_SLOT_ASG); float* sgate = (float*)(c.ws + WS_SLOT_GATE);
    for (int idx = c.gtid; idx < NS_MAX; idx += c.gthreads) { stok[idx] = 0; sasg[idx] = -1; sgate[idx] = 0.f; }
    int* te = (int*)(c.ws + WS_TILE_E);
    for (int idx = c.gtid; idx < NS_MAX / 256; idx += c.gthreads) te[idx] = -1;
}

__device__ __forceinline__ void ph_h1(const Ctx& c, const Params& p) {
    const float* mod = (const float*)(c.ws + WS_MOD); bf16_t* H = (bf16_t*)(c.ws + WS_H);
    constexpr int R = 4;
    for (int t0 = c.gwave * R; t0 < T; t0 += c.gwaves * R) {
        const int b = t0 / SEQ;
        f32x4 v[R][4]; float sq[R];
#pragma unroll
        for (int j = 0; j < R; ++j) { const f32x4* xr = (const f32x4*)(p.in[I_X] + (size_t)(t0 + j) * DM) + c.lane;
#pragma unroll
            for (int q = 0; q < 4; ++q) v[j][q] = xr[64 * q]; }
        const float* sh = mod + b * 6 * DM, * sc = sh + DM;
        f32x4 ca[4], cb[4];
#pragma unroll
        for (int q = 0; q < 4; ++q) { const int col = 4 * c.lane + 256 * q; ca[q] = *(const f32x4*)(p.in[I_N1G] + col) * (1.f + *(const f32x4*)(sc + col)); cb[q] = *(const f32x4*)(sh + col); }
#pragma unroll
        for (int j = 0; j < R; ++j) { float s_ = 0.f;
#pragma unroll
            for (int q = 0; q < 4; ++q) s_ += v[j][q].x * v[j][q].x + v[j][q].y * v[j][q].y + v[j][q].z * v[j][q].z + v[j][q].w * v[j][q].w;
            sq[j] = s_; }
#pragma unroll
        for (int o = 1; o < 64; o <<= 1) {
#pragma unroll
            for (int j = 0; j < R; ++j) sq[j] += __shfl_xor(sq[j], o); }
#pragma unroll
        for (int j = 0; j < R; ++j) { const float rstd = rsqrtf(sq[j] * (1.f / DM) + EPS);
#pragma unroll
            for (int q = 0; q < 4; ++q) { const int col = 4 * c.lane + 256 * q; const f32x4 o = (v[j][q] * rstd) * ca[q] + cb[q];
                u32x2 w; w.x = pk2(o.x, o.y); w.y = pk2(o.z, o.w); *(u32x2*)(H + (size_t)(t0 + j) * DM + col) = w; } }
    }
}

struct EpiWin {
    bf16_t* QK; bf16_t* V; bf16_t* AP;
    __device__ __forceinline__ void operator()(int row, int col, const f32x4& a, const f32x4&, int) const {
        u32x2 w; w.x = pk2(a[0], a[1]); w.y = pk2(a[2], a[3]);
        if (col < 1024) *(u32x2*)(QK + (size_t)row * 1024 + col) = w;
        else if (col < 1536) *(u32x2*)(V + (size_t)row * 512 + (col - 1024)) = w;
        else { const int cc = col - 1536, g = cc >> 4, ch = cc & 15, b = row / SEQ, l = row % SEQ;
            *(u32x2*)(AP + ((size_t)(g * (NB * NCHUNK) + b * NCHUNK + (l >> 4)) * APK + (l & 15) * 16 + ch)) = w; }
    }
};

__device__ __forceinline__ void ph_qkn(const Ctx& c, const Params& p) {
    bf16_t* QK = (bf16_t*)(c.ws + WS_QK);
    const float* ropec = (const float*)(c.ws + WS_ROPE); const float* ropes = ropec + SEQ * 32;
    const int l = c.lane;
    const float gq = p.in[I_QNG][l], gk = p.in[I_KNG][l];
    for (int t = c.gwave; t < T; t += c.gwaves) {
        const int pos = t % SEQ; const float cs = ropec[pos * 32 + (l & 31)], sn = ropes[pos * 32 + (l & 31)];
        bf16_t* r = QK + (size_t)t * 1024;
#pragma unroll 4
        for (int gi = 0; gi < 16; ++gi) {
            const float v = bf2f(r[gi * 64 + l]);
            const float rstd = rsqrtf(wave_sum(v * v) * (1.f / 64.f) + EPS);
            const float y = v * rstd * (gi < 8 ? gq : gk);
            const float o = __shfl_xor(y, 32);
            const float res = (l < 32) ? (y * cs - o * sn) : (o * sn + y * cs);
            r[gi * 64 + l] = f2bf(res);
        }
    }
}

__device__ __forceinline__ void ph_att_base(const Ctx& c, const Params& p) {
    const bf16_t* QK = (const bf16_t*)(c.ws + WS_QK); const bf16_t* V = (const bf16_t*)(c.ws + WS_V); float* AO = (float*)(c.ws + WS_ATTO);
    const float smax = ((const float*)(c.ws + WS_LAM))[1];
    const int nitem = NB * NH * 4 * (SEQ / 64);
    for (int it = c.gwave; it < nitem; it += c.gwaves) {
        const int qb = (SEQ / 64 - 1) - (it / (NB * NH * 4)), bhc = it % (NB * NH * 4), b = bhc / (NH * 4), h = (bhc >> 2) % NH, cc = (bhc >> 1) & 1, vh = bhc & 1;
        const int q = qb * 64 + c.lane; const size_t trow = (size_t)b * SEQ + q;
        float qv[64];
        { const bf16_t* qp = QK + trow * 1024 + h * 128 + cc * 64;
#pragma unroll
          for (int d = 0; d < 64; ++d) qv[d] = bf2f(qp[d]) * 0.125f; }
        float o[64];
#pragma unroll
        for (int d = 0; d < 64; ++d) o[d] = 0.f;
        float lsum = 0.f;
        const int jmax = qb * 64 + 63;
        for (int j = 0; j <= jmax; ++j) {
            const size_t krow = (size_t)b * SEQ + j;
            const u32x4* kp = (const u32x4*)(QK + krow * 1024 + 512 + h * 128 + cc * 64);
            float s = 0.f;
#pragma unroll
            for (int i = 0; i < 8; ++i) { const u32x4 kk = kp[i];
                s += qv[8 * i + 0] * __uint_as_float(kk.x << 16) + qv[8 * i + 1] * __uint_as_float(kk.x & 0xffff0000u)
                   + qv[8 * i + 2] * __uint_as_float(kk.y << 16) + qv[8 * i + 3] * __uint_as_float(kk.y & 0xffff0000u)
                   + qv[8 * i + 4] * __uint_as_float(kk.z << 16) + qv[8 * i + 5] * __uint_as_float(kk.z & 0xffff0000u)
                   + qv[8 * i + 6] * __uint_as_float(kk.w << 16) + qv[8 * i + 7] * __uint_as_float(kk.w & 0xffff0000u); }
            float pe = (j <= q) ? __expf(s - smax) : 0.f;
            lsum += pe;
            const u32x4* vp = (const u32x4*)(V + krow * 512 + h * 128 + vh * 64);
#pragma unroll
            for (int i = 0; i < 8; ++i) { const u32x4 vv = vp[i];
                o[8 * i + 0] += pe * __uint_as_float(vv.x << 16); o[8 * i + 1] += pe * __uint_as_float(vv.x & 0xffff0000u);
                o[8 * i + 2] += pe * __uint_as_float(vv.y << 16); o[8 * i + 3] += pe * __uint_as_float(vv.y & 0xffff0000u);
                o[8 * i + 4] += pe * __uint_as_float(vv.z << 16); o[8 * i + 5] += pe * __uint_as_float(vv.z & 0xffff0000u);
                o[8 * i + 6] += pe * __uint_as_float(vv.w << 16); o[8 * i + 7] += pe * __uint_as_float(vv.w & 0xffff0000u); }
        }
        const float rl = 1.f / lsum;
        float* op = AO + (trow * 8 + h * 2 + cc) * 128 + vh * 64;
#pragma unroll
        for (int d = 0; d < 64; d += 4) *(f32x4*)(op + d) = (f32x4){o[d] * rl, o[d + 1] * rl, o[d + 2] * rl, o[d + 3] * rl};
    }
}
__device__ __forceinline__ void ph_att_comb(const Ctx& c, const Params& p) {
    const float* AO = (const float*)(c.ws + WS_ATTO); bf16_t* MX = (bf16_t*)(c.ws + WS_MIXIN);
    const float lam = ((const float*)(c.ws + WS_LAM))[0];
    for (int it = c.gwave; it < T * NH; it += c.gwaves) {
        const int t = it >> 2, h = it & 3;
        const float* o1 = AO + ((size_t)t * 8 + h * 2) * 128, * o2 = o1 + 128;
        const float a = o1[c.lane] - lam * o2[c.lane], b = o1[64 + c.lane] - lam * o2[64 + c.lane];
        const float rstd = rsqrtf(wave_sum(a * a + b * b) * (1.f / 128.f) + EPS) * (1.f - LAM_INIT);
        MX[(size_t)t * 1024 + h * 128 + c.lane] = f2bf(a * rstd * p.in[I_SUBG][c.lane]);
        MX[(size_t)t * 1024 + h * 128 + 64 + c.lane] = f2bf(b * rstd * p.in[I_SUBG][64 + c.lane]);
    }
}

__device__ __forceinline__ void ph_ssm_base(const Ctx& c, const Params& p) {
    const bf16_t* AP = (const bf16_t*)(c.ws + WS_AP); bf16_t* Y = (bf16_t*)(c.ws + WS_Y);
    const float* sp = (const float*)(c.ws + WS_SSMP);
    const float* abr = sp, * abi = sp + SG * SP, * bbr = sp + 2 * SG * SP, * bbi = bbr + SG * SP * SC;
    for (int it = c.gwave; it < NB * SG; it += c.gwaves) {
        const int b = it / SG, g = it % SG, pp = c.lane;
        const float ar = abr[g * SP + pp], ai = abi[g * SP + pp];
        float br[16], bi[16], cr[16], ci[16];
#pragma unroll
        for (int ch = 0; ch < 16; ++ch) { br[ch] = bbr[(g * SP + pp) * SC + ch]; bi[ch] = bbi[(g * SP + pp) * SC + ch];
            cr[ch] = p.in[I_CRE][(g * SC + ch) * SP + pp]; ci[ch] = p.in[I_CIM][(g * SC + ch) * SP + pp]; }
        const float dsk = (pp < 16) ? p.in[I_SD][g * SC + pp] : 0.f;
        float sr = 0.f, si = 0.f;
        for (int l = 0; l < SEQ; ++l) {
            const bf16_t* up = AP + ((size_t)(g * (NB * NCHUNK) + b * NCHUNK + (l >> 4)) * APK + (l & 15) * 16);
            const u32x4 u0 = *(const u32x4*)up, u1 = *(const u32x4*)(up + 8);
            float u[16] = { __uint_as_float(u0.x << 16), __uint_as_float(u0.x & 0xffff0000u), __uint_as_float(u0.y << 16), __uint_as_float(u0.y & 0xffff0000u),
                            __uint_as_float(u0.z << 16), __uint_as_float(u0.z & 0xffff0000u), __uint_as_float(u0.w << 16), __uint_as_float(u0.w & 0xffff0000u),
                            __uint_as_float(u1.x << 16), __uint_as_float(u1.x & 0xffff0000u), __uint_as_float(u1.y << 16), __uint_as_float(u1.y & 0xffff0000u),
                            __uint_as_float(u1.z << 16), __uint_as_float(u1.z & 0xffff0000u), __uint_as_float(u1.w << 16), __uint_as_float(u1.w & 0xffff0000u) };
            float bur = 0.f, bui = 0.f;
#pragma unroll
            for (int ch = 0; ch < 16; ++ch) { bur += u[ch] * br[ch]; bui += u[ch] * bi[ch]; }
            const float nr = ar * sr - ai * si + bur, ni = ar * si + ai * sr + bui; sr = nr; si = ni;
            float mine = 0.f;
#pragma unroll
            for (int ch = 0; ch < 16; ++ch) { const float v = wave_sum(sr * cr[ch] - si * ci[ch]); if (pp == ch) mine = v + dsk * u[ch]; }
            if (pp < 16) Y[((size_t)b * SEQ + l) * 512 + g * 16 + pp] = f2bf(gelu_tanh(mine));
        }
    }
}

struct EpiGlu {
    const bf16_t* Y; bf16_t* MX; float* ss;
    __device__ __forceinline__ void operator()(int row, int col, const f32x4& a, const f32x4&, int) const {
        const u32x2 yv = *(const u32x2*)(Y + (size_t)row * 512 + col);
        const float y0 = __uint_as_float(yv.x << 16), y1 = __uint_as_float(yv.x & 0xffff0000u), y2 = __uint_as_float(yv.y << 16), y3 = __uint_as_float(yv.y & 0xffff0000u);
        const float v0 = y0 * sigmoidf(a[0]), v1 = y1 * sigmoidf(a[1]), v2 = y2 * sigmoidf(a[2]), v3 = y3 * sigmoidf(a[3]);
        u32x2 w; w.x = pk2(v0, v1); w.y = pk2(v2, v3); *(u32x2*)(MX + (size_t)row * 1024 + 512 + col) = w;
        float s = v0 * v0 + v1 * v1 + v2 * v2 + v3 * v3;
#pragma unroll
        for (int o = 1; o < 32; o <<= 1) s += __shfl_xor(s, o);
        if ((threadIdx.x & 31) == 0) atomicAdd(ss + row, s);
    }
};
__device__ __forceinline__ void ph_ssm_norm(const Ctx& c, const Params& p) {
    bf16_t* MX = (bf16_t*)(c.ws + WS_MIXIN); const float* ss = (const float*)(c.ws + WS_CTL + CTL_SS1);
    for (int t = c.gwave; t < T; t += c.gwaves) {
        const float rstd = rsqrtf(ss[t] * (1.f / 512.f) + EPS);
        bf16_t* r = MX + (size_t)t * 1024 + 512 + c.lane * 8; const float* g = p.in[I_SNG] + c.lane * 8;
        u32x4 w = *(u32x4*)r; unsigned* wp = (unsigned*)&w;
#pragma unroll
        for (int i = 0; i < 4; ++i) { const float a = __uint_as_float(wp[i] << 16) * rstd * g[2 * i], b = __uint_as_float(wp[i] & 0xffff0000u) * rstd * g[2 * i + 1]; wp[i] = pk2(a, b); }
        *(u32x4*)r = w;
    }
}
__device__ __forceinline__ void ph_ssm_norm2(const Ctx& c, const Params& p) {
    bf16_t* MX = (bf16_t*)(c.ws + WS_MIXIN); const float* ss = (const float*)(c.ws + WS_SS1P);
    constexpr int R = 8;
    float g[8];
#pragma unroll
    for (int i = 0; i < 8; ++i) g[i] = p.in[I_SNG][c.lane * 8 + i];
    for (int t0 = c.gwave * R; t0 < T; t0 += c.gwaves * R) {
        u32x4 w[R]; f32x4 s0[R], s1[R];
#pragma unroll
        for (int j = 0; j < R; ++j) { const size_t t = (size_t)(t0 + j); w[j] = *(const u32x4*)(MX + t * 1024 + 512 + c.lane * 8); s0[j] = *(const f32x4*)(ss + t * 8); s1[j] = *(const f32x4*)(ss + t * 8 + 4); }
#pragma unroll
        for (int j = 0; j < R; ++j) {
            const float tot = ((s0[j].x + s0[j].y) + (s0[j].z + s0[j].w)) + ((s1[j].x + s1[j].y) + (s1[j].z + s1[j].w));
            const float rstd = rsqrtf(tot * (1.f / 512.f) + EPS);
            unsigned* wp = (unsigned*)&w[j];
#pragma unroll
            for (int i = 0; i < 4; ++i) { const float a = __uint_as_float(wp[i] << 16) * rstd * g[2 * i], b = __uint_as_float(wp[i] & 0xffff0000u) * rstd * g[2 * i + 1]; wp[i] = pk2(a, b); }
            *(u32x4*)(MX + (size_t)(t0 + j) * 1024 + 512 + c.lane * 8) = w[j];
        }
    }
}
struct EpiWout {
    const float* x; const float* mod; float* out; float* ss;
    __device__ __forceinline__ void operator()(int row, int col, const f32x4& a, const f32x4&, int) const {
        const int b = row / SEQ; const f32x4 xv = *(const f32x4*)(x + (size_t)row * DM + col), g1 = *(const f32x4*)(mod + b * 6 * DM + 2 * DM + col);
        const f32x4 o = {xv.x + g1.x * a[0], xv.y + g1.y * a[1], xv.z + g1.z * a[2], xv.w + g1.w * a[3]};
        *(f32x4*)(out + (size_t)row * DM + col) = o;
        float s = o.x * o.x + o.y * o.y + o.z * o.z + o.w * o.w;
#pragma unroll
        for (int of = 1; of < 32; of <<= 1) s += __shfl_xor(s, of);
        if ((threadIdx.x & 31) == 0) atomicAdd(ss + row, s);
    }
};
__device__ __forceinline__ void ph_h2(const Ctx& c, const Params& p) {
    const float* mod = (const float*)(c.ws + WS_MOD); bf16_t* H = (bf16_t*)(c.ws + WS_H);
    const float* ss = (const float*)(c.ws + WS_CTL + CTL_SS2);
    for (int t = c.gwave; t < T; t += c.gwaves) {
        const int b = t / SEQ; const f32x4* xr = (const f32x4*)(p.out + (size_t)t * DM) + c.lane;
        const float rstd = rsqrtf(ss[t] * (1.f / DM) + EPS);
        const float* sh = mod + b * 6 * DM + 3 * DM, * sc = sh + DM;
#pragma unroll
        for (int j = 0; j < 4; ++j) { const int col = 4 * c.lane + 256 * j; const f32x4 v = xr[64 * j];
            const f32x4 g = *(const f32x4*)(p.in[I_N2G] + col), s1 = *(const f32x4*)(sc + col), h1 = *(const f32x4*)(sh + col);
            const f32x4 o = (v * rstd * g) * (1.f + s1) + h1;
            u32x2 w; w.x = pk2(o.x, o.y); w.y = pk2(o.z, o.w); *(u32x2*)(H + (size_t)t * DM + col) = w; }
    }
}
__device__ __forceinline__ void ph_h2_2(const Ctx& c, const Params& p) {
    const float* mod = (const float*)(c.ws + WS_MOD); bf16_t* H = (bf16_t*)(c.ws + WS_H);
    const float* ss = (const float*)(c.ws + WS_SS2P);
    constexpr int R = 4;
    for (int t0 = c.gwave * R; t0 < T; t0 += c.gwaves * R) {
        const int b = t0 / SEQ;
        f32x4 v[R][4], sv[R][4];
#pragma unroll
        for (int j = 0; j < R; ++j) { const f32x4* xr = (const f32x4*)(p.out + (size_t)(t0 + j) * DM) + c.lane;
#pragma unroll
            for (int q = 0; q < 4; ++q) { v[j][q] = xr[64 * q]; sv[j][q] = *(const f32x4*)(ss + (size_t)(t0 + j) * 16 + 4 * q); } }
        const float* sh = mod + b * 6 * DM + 3 * DM, * sc = sh + DM;
        f32x4 ca[4], cb[4];
#pragma unroll
        for (int q = 0; q < 4; ++q) { const int col = 4 * c.lane + 256 * q; ca[q] = *(const f32x4*)(p.in[I_N2G] + col) * (1.f + *(const f32x4*)(sc + col)); cb[q] = *(const f32x4*)(sh + col); }
#pragma unroll
        for (int j = 0; j < R; ++j) {
            float tot = 0.f;
#pragma unroll
            for (int q = 0; q < 4; ++q) tot += (sv[j][q].x + sv[j][q].y) + (sv[j][q].z + sv[j][q].w);
            const float rstd = rsqrtf(tot * (1.f / DM) + EPS);
#pragma unroll
            for (int q = 0; q < 4; ++q) { const int col = 4 * c.lane + 256 * q; const f32x4 o = (v[j][q] * rstd) * ca[q] + cb[q];
                u32x2 w; w.x = pk2(o.x, o.y); w.y = pk2(o.z, o.w); *(u32x2*)(H + (size_t)(t0 + j) * DM + col) = w; }
        }
    }
}
__device__ __forceinline__ void ph_h2_3(const Ctx& c, const Params& p) {
    const float* mod = (const float*)(c.ws + WS_MOD); bf16_t* H = (bf16_t*)(c.ws + WS_H); unsigned char* H8 = c.ws + WS_H8;
    const float* ss = (const float*)(c.ws + WS_SS2P);
    constexpr int R = 4;
    for (int t0 = c.gwave * R; t0 < T; t0 += c.gwaves * R) {
        const int b = t0 / SEQ;
        f32x4 v[R][4], sv[R][4];
#pragma unroll
        for (int j = 0; j < R; ++j) { const f32x4* xr = (const f32x4*)(p.out + (size_t)(t0 + j) * DM) + c.lane;
#pragma unroll
            for (int q = 0; q < 4; ++q) { v[j][q] = xr[64 * q]; sv[j][q] = *(const f32x4*)(ss + (size_t)(t0 + j) * 16 + 4 * q); } }
        const float* sh = mod + b * 6 * DM + 3 * DM, * sc = sh + DM;
        f32x4 ca[4], cb[4];
#pragma unroll
        for (int q = 0; q < 4; ++q) { const int col = 4 * c.lane + 256 * q; ca[q] = *(const f32x4*)(p.in[I_N2G] + col) * (1.f + *(const f32x4*)(sc + col)); cb[q] = *(const f32x4*)(sh + col); }
#pragma unroll
        for (int j = 0; j < R; ++j) {
            float tot = 0.f;
#pragma unroll
            for (int q = 0; q < 4; ++q) tot += (sv[j][q].x + sv[j][q].y) + (sv[j][q].z + sv[j][q].w);
            const float rstd = rsqrtf(tot * (1.f / DM) + EPS);
#pragma unroll
            for (int q = 0; q < 4; ++q) { const int col = 4 * c.lane + 256 * q; const f32x4 o = (v[j][q] * rstd) * ca[q] + cb[q];
                u32x2 w; w.x = pk2(o.x, o.y); w.y = pk2(o.z, o.w); *(u32x2*)(H + (size_t)(t0 + j) * DM + col) = w;
                *(unsigned*)(H8 + (size_t)(t0 + j) * DM + col) = pk4_fp8(o.x, o.y, o.z, o.w); }
        }
    }
}
struct EpiLogits { float* L; __device__ __forceinline__ void operator()(int row, int col, const f32x4& a, const f32x4&, int) const { *(f32x4*)(L + (size_t)row * 256 + col) = (f32x4){a[0], a[1], a[2], a[3]}; } };
struct EpiSwiglu { bf16_t* O; int ldo;
    __device__ __forceinline__ void operator()(int row, int col, const f32x4& a, const f32x4& b, int) const {
        u32x2 w; w.x = pk2(siluf(a[0]) * b[0], siluf(a[1]) * b[1]); w.y = pk2(siluf(a[2]) * b[2], siluf(a[3]) * b[3]); *(u32x2*)(O + (size_t)row * ldo + col) = w; } };

__device__ __forceinline__ void ph_route(const Ctx& c, const Params& p) {
    const float* L = (const float*)(c.ws + WS_LOGITS);
    int* eidx = (int*)(c.ws + WS_EIDX); float* gw = (float*)(c.ws + WS_GATEW); unsigned* counts = (unsigned*)(c.ws + WS_CTL) + CW_COUNTS;
    const int l = c.lane; const float NEG = -__builtin_inff();
    float rb[4];
#pragma unroll
    for (int r = 0; r < 4; ++r) rb[r] = p.in[I_RB][l + 64 * r];
    for (int t = c.gwave; t < T; t += c.gwaves) {
        float s[4], sb[4];
#pragma unroll
        for (int r = 0; r < 4; ++r) { s[r] = sigmoidf(L[(size_t)t * 256 + l + 64 * r]); sb[r] = s[r] + rb[r]; }
        float gs[4];
#pragma unroll
        for (int r = 0; r < 4; ++r) {
            float m1 = sb[r]; int i1 = l;
#pragma unroll
            for (int o = 1; o < 32; o <<= 1) { const float om = __shfl_xor(m1, o); const int oi = __shfl_xor(i1, o); if (om > m1 || (om == m1 && oi < i1)) { m1 = om; i1 = oi; } }
            float m2 = (l == i1) ? NEG : sb[r];
#pragma unroll
            for (int o = 1; o < 32; o <<= 1) m2 = fmaxf(m2, __shfl_xor(m2, o));
            gs[r] = m1 + m2;
        }
        float gsc[8];
#pragma unroll
        for (int r = 0; r < 4; ++r) { gsc[2 * r] = __shfl(gs[r], 0); gsc[2 * r + 1] = __shfl(gs[r], 32); }
        unsigned gmask = 0;
#pragma unroll
        for (int a = 0; a < 8; ++a) { int rank = 0;
#pragma unroll
            for (int b2 = 0; b2 < 8; ++b2) rank += (gsc[b2] > gsc[a] || (gsc[b2] == gsc[a] && b2 < a)) ? 1 : 0;
            if (rank < TOPG) gmask |= 1u << a; }
        float mv[4];
#pragma unroll
        for (int r = 0; r < 4; ++r) mv[r] = ((gmask >> (2 * r + (l >> 5))) & 1u) ? sb[r] : NEG;
        float wsel = 0.f; int esel = -1; float wsum = 0.f;
#pragma unroll
        for (int k = 0; k < TOPK; ++k) {
            float bm = mv[0]; int bi = l;
#pragma unroll
            for (int r = 1; r < 4; ++r) if (mv[r] > bm) { bm = mv[r]; bi = l + 64 * r; }
#pragma unroll
            for (int o = 1; o < 64; o <<= 1) { const float om = __shfl_xor(bm, o); const int oi = __shfl_xor(bi, o); if (om > bm || (om == bm && oi < bi)) { bm = om; bi = oi; } }
            float sv = 0.f;
#pragma unroll
            for (int r = 0; r < 4; ++r) if (bi == l + 64 * r) { sv = s[r]; mv[r] = NEG; }
            sv = __shfl(sv, bi & 63);
            wsum += sv;
            if (l == k) { wsel = sv; esel = bi; }
        }
        if (l < TOPK) { eidx[t * 8 + l] = esel; gw[t * 8 + l] = wsel / wsum * ROUTED_SCALE; atomicAdd(counts + esel, 1u); }
    }
}
__device__ __forceinline__ void ph_slot(const Ctx& c, const Params& p) {
    const unsigned* counts = (const unsigned*)(c.ws + WS_CTL) + CW_COUNTS; unsigned* cursor = (unsigned*)(c.ws + WS_CTL) + CW_CURSOR;
    int* ps = (int*)c.lds;
    if (c.tid == 0) { int acc = 0; for (int e = 0; e < NE; ++e) { ps[e] = acc; acc += ((int)counts[e] + 255) / 256 * 256; } ps[NE] = acc; }
    __syncthreads();
    const int* eidx = (const int*)(c.ws + WS_EIDX); const float* gw = (const float*)(c.ws + WS_GATEW);
    int* stok = (int*)(c.ws + WS_SLOT_TOK); int* sasg = (int*)(c.ws + WS_SLOT_ASG); float* sgate = (float*)(c.ws + WS_SLOT_GATE);
    for (int a = c.gtid; a < T * TOPK; a += c.gthreads) {
        const int e = eidx[a]; const unsigned pos = atomicAdd(cursor + e, 1u); const int slot = ps[e] + (int)pos;
        stok[slot] = a >> 3; sasg[slot] = a; sgate[slot] = gw[a];
    }
    if (c.bid == 0) {
        int* te = (int*)(c.ws + WS_TILE_E); int* padst = (int*)(c.ws + WS_PADST);
        for (int e = c.tid; e <= NE; e += 512) padst[e] = ps[e];
        for (int e = c.tid; e < NE; e += 512) for (int tl = ps[e] / 256; tl < ps[e + 1] / 256; ++tl) te[tl] = e;
        if (c.tid == 0) ((unsigned*)(c.ws + WS_CTL))[CW_NTILES] = (unsigned)(ps[NE] / 256);
    }
}
struct EpiE2 { const int* sasg; const float* sgate; bf16_t* YA;
    __device__ __forceinline__ void operator()(int row, int col, const f32x4& a, const f32x4&, int) const {
        const int asg = sasg[row]; if (asg < 0) return; const float g = sgate[row];
        u32x2 w; w.x = pk2(g * a[0], g * a[1]); w.y = pk2(g * a[2], g * a[3]); *(u32x2*)(YA + (size_t)asg * DM + col) = w; } };
struct EpiSD { const float* mod; float* out;
    __device__ __forceinline__ void operator()(int row, int col, const f32x4& a, const f32x4&, int) const {
        const int b = row / SEQ; const f32x4 g2 = *(const f32x4*)(mod + b * 6 * DM + 5 * DM + col); f32x4* o = (f32x4*)(out + (size_t)row * DM + col);
        f32x4 v = *o; v.x += g2.x * a[0]; v.y += g2.y * a[1]; v.z += g2.z * a[2]; v.w += g2.w * a[3]; *o = v; } };
__device__ __forceinline__ void ph_combine(const Ctx& c, const Params& p) {
    const float* mod = (const float*)(c.ws + WS_MOD); const bf16_t* YA = (const bf16_t*)(c.ws + WS_YA); float* out = p.out;
    for (int idx = c.gtid; idx < T * (DM / 8); idx += c.gthreads) {
        const int t = idx >> 7, col = (idx & 127) * 8, b = t / SEQ;
        float s[8] = {0.f, 0.f, 0.f, 0.f, 0.f, 0.f, 0.f, 0.f};
#pragma unroll
        for (int k = 0; k < 8; ++k) { const u32x4 w = *(const u32x4*)(YA + ((size_t)t * 8 + k) * DM + col); const unsigned* wp = (const unsigned*)&w;
#pragma unroll
            for (int i = 0; i < 4; ++i) { s[2 * i] += __uint_as_float(wp[i] << 16); s[2 * i + 1] += __uint_as_float(wp[i] & 0xffff0000u); } }
        const float* g2 = mod + b * 6 * DM + 5 * DM + col; float* o = out + (size_t)t * DM + col;
        f32x4 o0 = *(f32x4*)o, o1 = *(f32x4*)(o + 4);
        o0.x += g2[0] * s[0]; o0.y += g2[1] * s[1]; o0.z += g2[2] * s[2]; o0.w += g2[3] * s[3];
        o1.x += g2[4] * s[4]; o1.y += g2[5] * s[5]; o1.z += g2[6] * s[6]; o1.w += g2[7] * s[7];
        *(f32x4*)o = o0; *(f32x4*)(o + 4) = o1;
    }
}


#define GAS __attribute__((address_space(1)))
#define LAS __attribute__((address_space(3)))
#define XB_TMO      128
#define XB_XCNT(j)  (256  + 64 * (j))
#define XB_XSUB(j)  (1280 + 64 * (j))
#define XB_XGEN(j)  (2304 + 64 * (j))
#define XB_TOP      3328
#define XB_TOPGEN   3392
#define XCD_BAR_WORDS 3456
#define XB_SPIN_CAP (1u << 18)

__device__ __forceinline__ unsigned xb_ld(unsigned* p)              { return __hip_atomic_load(p, __ATOMIC_RELAXED, __HIP_MEMORY_SCOPE_AGENT); }
__device__ __forceinline__ unsigned xb_add(unsigned* p, unsigned v) { return __hip_atomic_fetch_add(p, v, __ATOMIC_RELAXED, __HIP_MEMORY_SCOPE_AGENT); }
__device__ __forceinline__ unsigned xb_xcc_id() { return (unsigned)__builtin_amdgcn_s_getreg((3 << 11) | 20) & 0xFu; }
#define XB_SPIN(cond, bar) do { unsigned _sp = 0; while (cond) { __builtin_amdgcn_s_sleep(1); \
    if ((++_sp & 255u) == 0u) { if (xb_ld(&(bar)[XB_TMO])) break; if (_sp > XB_SPIN_CAP) { atomicAdd(&(bar)[XB_TMO], 1u); break; } } } } while (0)

struct XcdBarrier {
    unsigned* bar; unsigned x;
    volatile LAS unsigned* st;
};

__device__ __forceinline__ XcdBarrier xcd_barrier_post(unsigned* bar, volatile LAS unsigned* st) {
    XcdBarrier b; b.bar = bar; b.x = xb_xcc_id(); b.st = st;
    if (threadIdx.x == 0) (void)xb_add(&bar[XB_XCNT(b.x)], 1u);
    return b;
}
__device__ __forceinline__ void xcd_barrier_complete(unsigned* bar, unsigned x, unsigned& nloc, unsigned& nx) {
    const unsigned G = gridDim.x * gridDim.y * gridDim.z;
    unsigned sum, cnt, mine, sp = 0u;
    for (;;) {
        sum = 0u; cnt = 0u; mine = 0u;
#pragma unroll
        for (unsigned j = 0; j < 16; ++j) { const unsigned c = xb_ld(&bar[XB_XCNT(j)]); sum += c; cnt += (c > 0u) ? 1u : 0u; mine = (j == x) ? c : mine; }
        if (sum == G) break;
        __builtin_amdgcn_s_sleep(1);
        if ((++sp & 255u) == 0u) { if (xb_ld(&bar[XB_TMO])) break; if (sp > XB_SPIN_CAP) { atomicAdd(&bar[XB_TMO], 1u); break; } }
    }
    nloc = mine > 0u ? mine : 1u; nx = cnt > 0u ? cnt : 1u;
}

__device__ __forceinline__ void xcd_barrier(const XcdBarrier& b) {
    asm volatile("s_waitcnt vmcnt(0)" ::: "memory");
    __syncthreads();
    if (threadIdx.x == 0) {
        unsigned* bar = b.bar;
        __builtin_amdgcn_s_waitcnt(0);
        unsigned nloc = b.st[0], nx = b.st[1];
        if (nloc == 0u) { xcd_barrier_complete(bar, b.x, nloc, nx); b.st[0] = nloc; b.st[1] = nx; }
        const unsigned old = xb_add(&bar[XB_XSUB(b.x)], 1u);
        const unsigned gen = old / nloc;
        if (old + 1u == (gen + 1u) * nloc) {
            __builtin_amdgcn_fence(__ATOMIC_RELEASE, "agent");
            asm volatile("s_waitcnt vmcnt(0)" ::: "memory");
            const unsigned og = xb_add(&bar[XB_TOP], 1u);
            const unsigned tg = og / nx;
            if (og + 1u == (tg + 1u) * nx) xb_add(&bar[XB_TOPGEN], 1u);
            else XB_SPIN(xb_ld(&bar[XB_TOPGEN]) == tg, bar);
            __builtin_amdgcn_fence(__ATOMIC_ACQUIRE, "agent");
            xb_add(&bar[XB_XGEN(b.x)], 1u);
            asm volatile("s_waitcnt vmcnt(0)" ::: "memory");
        } else {
            XB_SPIN(xb_ld(&bar[XB_XGEN(b.x)]) == gen, bar);
            __builtin_amdgcn_fence(__ATOMIC_ACQUIRE, "agent");
            asm volatile("s_waitcnt vmcnt(0)" ::: "memory");
        }
    }
    __syncthreads();
}

namespace pg8 {
#define PG8_LAS __attribute__((address_space(3)))
typedef short bf16x8 __attribute__((ext_vector_type(8)));
typedef int v4i __attribute__((ext_vector_type(4)));
typedef int v8i __attribute__((ext_vector_type(8)));
constexpr int BM = 256, BK = 64, HALF = 128, HTB = HALF * BK * 2  , STAGE_BYTES = 8 * HTB;

__host__ __device__ __forceinline__ int lds_byte(int r, int c) { const int st = (r >> 4) * 2 + (c >> 5), rr = r & 15, cc = c & 31, ob = rr * 64 + cc * 2; return st * 1024 + (ob ^ (((ob >> 9) & 1) << 5)); }
__host__ __device__ __forceinline__ void stage_rc(int b, int& R, int& C) { const int st = b / 1024, sb = b % 1024, swz = sb ^ (((sb >> 9) & 1) << 5); R = (st >> 1) * 16 + swz / 64; C = (st & 1) * 32 + (swz % 64) / 2; }
__host__ __device__ __forceinline__ int perm32(int rho) { const int n = rho >> 4, i = rho & 15; return 8 * (i >> 2) + 4 * n + (i & 3); }

struct Unit { int pm, pn, pb; };
struct Gemm { const bf16_t* A; const bf16_t* Bt; int K, lda; const int* rowidx; unsigned scale_b = 0x7F7F7F7Fu, scale_a = 0x7F7F7F7Fu; };

__device__ __forceinline__ unsigned cvt_pk_bf16(float lo, float hi) { unsigned r; asm volatile("v_cvt_pk_bf16_f32 %0, %1, %2" : "=v"(r) : "v"(lo), "v"(hi)); return r; }

template <class Epi, class Sched, bool GATHER, bool ALIGN_EPI, bool FP8 = false, int FIXED_NT = 0>
__device__ __forceinline__ void gemm_phase(PG8_LAS unsigned char* lds, const Gemm g, const Sched& S, const Epi& E) {
    int tid_ = threadIdx.x; asm volatile("" : "+v"(tid_));
    const int tid = tid_, wid = __builtin_amdgcn_readfirstlane(tid >> 6), lane = tid & 63, wr = wid >> 2, wc = wid & 3, fr = lane & 15, fq = lane >> 4;
    int K_ = g.K; asm volatile("" : "+s"(K_));
    const int K = K_, nt = K / BK, lda = g.lda;
    unsigned voffB[2], oc[2][2], on[2][2];
#pragma unroll
    for (int i = 0; i < 2; ++i) { int R, C; stage_rc(tid * 16 + i * 8192, R, C); const int Rb = Epi::PERM ? ((R & ~31) + perm32(R & 31)) : R;
        voffB[i] = (unsigned)(Rb * K + C) * 2u;
        oc[0][i] = (unsigned)(R * lda + C) * 2u; oc[1][i] = (unsigned)((R + HALF) * lda + C) * 2u; on[0][i] = oc[0][i]; on[1][i] = oc[1][i]; }
    const size_t kstep = (size_t)(BK * 2);
    const size_t hstep = (size_t)HALF * K * 2;
    const size_t tstepB = 2 * hstep, tstepA = (size_t)BM * lda * 2;
    const unsigned ldsw = (unsigned)wid * 1024u;
    const int aoff = lds_byte(wr * 64 + fr, fq * 8), boff = lds_byte(wc * 32 + fr, fq * 8);
#define PG8_SA(b, h) (((b) * 2 + (h)) * HTB)
#define PG8_SB(b, h) ((4 + (b) * 2 + (h)) * HTB)
#define PG8_STAGE(bufoff, gbase, voff) do { _Pragma("unroll") for (int _i = 0; _i < 2; ++_i) \
        __builtin_amdgcn_global_load_lds((const unsigned*)((const char*)(gbase) + (voff)[_i]), (PG8_LAS unsigned*)(lds + (bufoff) + ldsw + _i * 8192), 16, 0, 0); } while (0)
#define PG8_LDA(dst, b, h) do { if constexpr (FP8) { _Pragma("unroll") for (int m = 0; m < 4; ++m) { const v4i lo_ = *(const PG8_LAS v4i*)(lds + PG8_SA(b, h) + aoff + m * 2048), hi_ = *(const PG8_LAS v4i*)(lds + PG8_SA(b, h) + aoff + m * 2048 + 1024); \
            dst##8[m] = __builtin_shufflevector(lo_, hi_, 0, 1, 2, 3, 4, 5, 6, 7); } } \
        else { _Pragma("unroll") for (int m = 0; m < 4; ++m) _Pragma("unroll") for (int k = 0; k < 2; ++k) dst[m][k] = *(const PG8_LAS bf16x8*)(lds + PG8_SA(b, h) + aoff + m * 2048 + k * 1024); } } while (0)
#define PG8_LDB(dst, b, h) do { if constexpr (FP8) { _Pragma("unroll") for (int n = 0; n < 2; ++n) { const v4i lo_ = *(const PG8_LAS v4i*)(lds + PG8_SB(b, h) + boff + n * 2048), hi_ = *(const PG8_LAS v4i*)(lds + PG8_SB(b, h) + boff + n * 2048 + 1024); \
            dst##8[n] = __builtin_shufflevector(lo_, hi_, 0, 1, 2, 3, 4, 5, 6, 7); } } \
        else { _Pragma("unroll") for (int n = 0; n < 2; ++n) _Pragma("unroll") for (int k = 0; k < 2; ++k) dst[n][k] = *(const PG8_LAS bf16x8*)(lds + PG8_SB(b, h) + boff + n * 2048 + k * 1024); } } while (0)
#define PG8_MMA(ai, bj, At, Bt) do { __builtin_amdgcn_s_setprio(1); \
        if constexpr (FP8) {   \
            _Pragma("unroll") for (int m = 0; m < 4; ++m) _Pragma("unroll") for (int n = 0; n < 2; ++n) { \
                acc[ai][bj][m][n] = __builtin_amdgcn_mfma_scale_f32_16x16x128_f8f6f4(Bt##8[n], At##8[m], acc[ai][bj][m][n], 0, 0, 0, (int)g.scale_b, 0, (int)g.scale_a); } \
        } else { \
            _Pragma("unroll") for (int m = 0; m < 4; ++m) _Pragma("unroll") for (int n = 0; n < 2; ++n) _Pragma("unroll") for (int k = 0; k < 2; ++k) \
                acc[ai][bj][m][n] = __builtin_amdgcn_mfma_f32_16x16x32_bf16(Bt[n][k], At[m][k], acc[ai][bj][m][n], 0, 0, 0); } \
        __builtin_amdgcn_s_setprio(0); } while (0)
#define PG8_WAIT_V(n) asm volatile("s_waitcnt vmcnt(" #n ")" ::: "memory")
#define PG8_WAIT_V8S() do { if (FIXED_NT == 2 || (Epi::NSTORE > 0 && fresh)) asm volatile("s_waitcnt vmcnt(%0)" :: "i"(8 + Epi::NSTORE) : "memory"); else asm volatile("s_waitcnt vmcnt(8)" ::: "memory"); } while (0)
#define PG8_WAIT_L(n) asm volatile("s_waitcnt lgkmcnt(" #n ")" ::: "memory")
#define PG8_BAR __builtin_amdgcn_s_barrier()
#define PG8_SCHED __builtin_amdgcn_sched_barrier(0)
#define PG8_GIDX(dst, unit) do { _Pragma("unroll") for (int _i = 0; _i < 2; ++_i) { int R_, C_; stage_rc(tid * 16 + _i * 8192, R_, C_); \
        const int r0_ = g.rowidx ? g.rowidx[(unit).pm * BM + R_] : (unit).pm * BM + R_, r1_ = g.rowidx ? g.rowidx[(unit).pm * BM + HALF + R_] : (unit).pm * BM + HALF + R_; \
        dst[0][_i] = (unsigned)(r0_ * lda + C_) * 2u; dst[1][_i] = (unsigned)(r1_ * lda + C_) * 2u; } } while (0)
    Unit cur, nxt; int ui = 0;
    if (!S.next(0, cur)) return;
    f32x4 acc[2][2][4][2];
#pragma unroll
    for (int a = 0; a < 2; ++a)
#pragma unroll
        for (int b = 0; b < 2; ++b)
#pragma unroll
            for (int m = 0; m < 4; ++m)
#pragma unroll
                for (int n = 0; n < 2; ++n) acc[a][b][m][n] = (f32x4){0.f, 0.f, 0.f, 0.f};
    bf16x8 At[4][2], B0[2][2], B1[2][2]; v8i At8[4], B08[2], B18[2];
    if constexpr (GATHER) { PG8_GIDX(oc, cur); }
    const char* cA = GATHER ? (const char*)g.A : (const char*)g.A + (size_t)cur.pm * tstepA; const char* cB = (const char*)g.Bt + (size_t)cur.pb * tstepB;
    PG8_STAGE(PG8_SB(0, 0), cB, voffB); PG8_STAGE(PG8_SB(0, 1), cB + hstep, voffB); PG8_STAGE(PG8_SA(0, 0), cA, oc[0]); PG8_STAGE(PG8_SA(0, 1), cA, oc[1]);
    if (wr == 1) PG8_BAR;
    PG8_WAIT_V(2); PG8_BAR;
    PG8_STAGE(PG8_SB(1, 0), cB + kstep, voffB); PG8_STAGE(PG8_SA(1, 0), cA + kstep, oc[0]); PG8_STAGE(PG8_SB(1, 1), cB + hstep + kstep, voffB);
    PG8_WAIT_V(6); PG8_BAR;
    if constexpr (FIXED_NT == 2) { PG8_WAIT_V(0); PG8_BAR; }
    bool fresh = false;
    for (;;) {
        const bool has_next = S.next(ui + 1, nxt);
        if constexpr (GATHER) { if (has_next) { PG8_GIDX(on, nxt); } }
        const char* nA = has_next ? (GATHER ? (const char*)g.A : (const char*)g.A + (size_t)nxt.pm * tstepA) : cA; const char* nB = has_next ? (const char*)g.Bt + (size_t)nxt.pb * tstepB : cB;
#pragma unroll 1
        for (int t = 0; t < nt; t += 2) {
            const bool last = (t == nt - 2);
            const char* a1 = cA + (size_t)(t + 1) * kstep;
            const char* a2 = last ? nA : cA + (size_t)(t + 2) * kstep; const char* b2 = last ? nB : cB + (size_t)(t + 2) * kstep;
            const char* a3 = a2 + kstep; const char* b3 = b2 + kstep;
            PG8_LDB(B0, 0, 0); PG8_LDB(B1, 0, 1); PG8_SCHED; PG8_LDA(At, 0, 0); PG8_STAGE(PG8_SA(1, 1), a1, oc[1]);
            if constexpr (GATHER) { if (last && has_next) { oc[0][0] = on[0][0]; oc[0][1] = on[0][1]; oc[1][0] = on[1][0]; oc[1][1] = on[1][1]; } }
            PG8_WAIT_V8S(); PG8_WAIT_L(0); PG8_BAR; PG8_MMA(0, 0, At, B0); PG8_MMA(0, 1, At, B1); PG8_BAR; PG8_SCHED;
            PG8_LDA(At, 0, 1); PG8_STAGE(PG8_SB(0, 0), b2, voffB); PG8_STAGE(PG8_SB(0, 1), b2 + hstep, voffB); PG8_STAGE(PG8_SA(0, 0), a2, oc[0]);
            PG8_WAIT_V8S(); fresh = false; PG8_WAIT_L(0); PG8_BAR; PG8_MMA(1, 0, At, B0); PG8_MMA(1, 1, At, B1); PG8_BAR; PG8_SCHED;
            PG8_LDB(B0, 1, 0); PG8_LDB(B1, 1, 1); PG8_SCHED; PG8_LDA(At, 1, 0); PG8_STAGE(PG8_SA(0, 1), a2, oc[1]);
            PG8_WAIT_V(8); PG8_WAIT_L(0); PG8_BAR; PG8_MMA(0, 0, At, B0); PG8_MMA(0, 1, At, B1); PG8_BAR; PG8_SCHED;
            PG8_LDA(At, 1, 1); PG8_STAGE(PG8_SB(1, 0), b3, voffB); PG8_STAGE(PG8_SB(1, 1), b3 + hstep, voffB); PG8_STAGE(PG8_SA(1, 0), a3, oc[0]);
            PG8_WAIT_V(8); PG8_WAIT_L(0); PG8_BAR; PG8_MMA(1, 0, At, B0); PG8_MMA(1, 1, At, B1); PG8_BAR; PG8_SCHED;
        }
        if constexpr (ALIGN_EPI) { if (wr == 0) PG8_BAR; }
        E(acc, cur, wr, wc, fr, fq);
        if (!has_next) break;
#pragma unroll
        for (int a = 0; a < 2; ++a)
#pragma unroll
            for (int b = 0; b < 2; ++b)
#pragma unroll
                for (int m = 0; m < 4; ++m)
#pragma unroll
                    for (int n = 0; n < 2; ++n) acc[a][b][m][n] = (f32x4){0.f, 0.f, 0.f, 0.f};
        cur = nxt; cA = nA; cB = nB; ++ui; fresh = true;
        if constexpr (ALIGN_EPI) { if (wr == 1) PG8_BAR; }
    }
    PG8_WAIT_V(0);
    if constexpr (!ALIGN_EPI) { if (wr == 0) PG8_BAR; }
    PG8_BAR;
#undef PG8_SA
#undef PG8_SB
#undef PG8_STAGE
#undef PG8_LDA
#undef PG8_LDB
#undef PG8_MMA
#undef PG8_WAIT_V
#undef PG8_WAIT_V8S
#undef PG8_WAIT_L
#undef PG8_BAR
#undef PG8_SCHED
#undef PG8_GIDX
}

struct DenseOrder {
    int nM, nN, nwg, G, c;
    __device__ __forceinline__ void init(int M, int N, int G_, int c_) { nM = M / BM; nN = N / BM; nwg = nM * nN; G = G_; c = c_; }
    __device__ __forceinline__ bool next(int i, Unit& u) const {
        const long L = (long)i * G + c; if (L >= nwg) return false;
        int wgid = (int)L; { const int q = nwg / 8, r = nwg % 8, xcd = wgid % 8, off = wgid / 8; wgid = (xcd < r ? xcd * (q + 1) : r * (q + 1) + (xcd - r) * q) + off; }
        const int nig = 8 * nN, gid = wgid / nig, fm = gid * 8, gsz = (nM - fm) < 8 ? (nM - fm) : 8;
        u.pm = fm + ((wgid % nig) % gsz); u.pn = (wgid % nig) / gsz; u.pb = u.pn; return true;
    }
};
struct GroupedOrder {
    const int* tile_e; int ntiles, NT, G, vcu;
    __device__ __forceinline__ bool next(int i, Unit& u) const {
        const int L = i * G + vcu; if (L >= ntiles * NT) return false;
        const int mt = L / NT, nn = L - mt * NT; u.pm = mt; u.pn = nn; u.pb = tile_e[mt] * NT + nn; return true;
    }
};

#define EPI_ROWS_BEGIN const int row0 = u.pm * BM + wr * 64 + fr; _Pragma("unroll") for (int ai = 0; ai < 2; ++ai) _Pragma("unroll") for (int m = 0; m < 4; ++m) { const int row = row0 + ai * HALF + m * 16;
#define EPI_ROWS_END }
struct EpiWinF {
    static constexpr bool PERM = true; static constexpr int NSTORE = 16;
    bf16_t* QK; bf16_t* V; bf16_t* AP;
    __device__ __forceinline__ void operator()(const f32x4 (&acc)[2][2][4][2], const Unit& u, int wr, int wc, int fr, int fq) const {
        const int colt = u.pn * BM + wc * 32 + 8 * fq;
        EPI_ROWS_BEGIN
#pragma unroll
            for (int bj = 0; bj < 2; ++bj) { const f32x4 v0 = acc[ai][bj][m][0], v1 = acc[ai][bj][m][1]; const int col = colt + bj * HALF;
                u32x4 w; w.x = cvt_pk_bf16(v0[0], v0[1]); w.y = cvt_pk_bf16(v0[2], v0[3]); w.z = cvt_pk_bf16(v1[0], v1[1]); w.w = cvt_pk_bf16(v1[2], v1[3]);
                bf16_t* dst;
                if (u.pn < 4) dst = QK + (size_t)row * 1024 + col;
                else if (u.pn < 6) dst = V + (size_t)row * 512 + (col - 1024);
                else { const int cc = col - 1536, gg = cc >> 4, ch = cc & 15, b = row / SEQ, l = row % SEQ;
                    dst = AP + ((size_t)(gg * (NB * NCHUNK) + b * NCHUNK + (l >> 4)) * APK + (l & 15) * 16 + ch); }
                *(u32x4*)dst = w; }
        EPI_ROWS_END
    }
};
struct EpiGluF {
    static constexpr bool PERM = true; static constexpr int NSTORE = 0;
    const bf16_t* Y; bf16_t* MX; float* ss;
    __device__ __forceinline__ void operator()(const f32x4 (&acc)[2][2][4][2], const Unit& u, int wr, int wc, int fr, int fq) const {
        const int colt = u.pn * BM + wc * 32 + 8 * fq;
        EPI_ROWS_BEGIN
            float s = 0.f;
#pragma unroll
            for (int bj = 0; bj < 2; ++bj) { const int col = colt + bj * HALF; const u32x4 yv = *(const u32x4*)(Y + (size_t)row * 512 + col);
                const f32x4 a0 = acc[ai][bj][m][0], a1 = acc[ai][bj][m][1];
                float v[8];
                v[0] = __uint_as_float(yv.x << 16) * sigmoidf(a0[0]); v[1] = __uint_as_float(yv.x & 0xffff0000u) * sigmoidf(a0[1]);
                v[2] = __uint_as_float(yv.y << 16) * sigmoidf(a0[2]); v[3] = __uint_as_float(yv.y & 0xffff0000u) * sigmoidf(a0[3]);
                v[4] = __uint_as_float(yv.z << 16) * sigmoidf(a1[0]); v[5] = __uint_as_float(yv.z & 0xffff0000u) * sigmoidf(a1[1]);
                v[6] = __uint_as_float(yv.w << 16) * sigmoidf(a1[2]); v[7] = __uint_as_float(yv.w & 0xffff0000u) * sigmoidf(a1[3]);
#pragma unroll
                for (int i = 0; i < 8; ++i) s += v[i] * v[i];
                u32x4 w; w.x = cvt_pk_bf16(v[0], v[1]); w.y = cvt_pk_bf16(v[2], v[3]); w.z = cvt_pk_bf16(v[4], v[5]); w.w = cvt_pk_bf16(v[6], v[7]);
                *(u32x4*)(MX + (size_t)row * 1024 + 512 + col) = w; }
            s += __shfl_xor(s, 16); s += __shfl_xor(s, 32);
            if (fq == 0) ss[(size_t)row * 8 + u.pn * 4 + wc] = s;
        EPI_ROWS_END
    }
};
struct EpiWoutF {
    static constexpr bool PERM = false; static constexpr int NSTORE = 0;
    const float* x; const float* mod; float* out; float* ss;
    __device__ __forceinline__ void operator()(const f32x4 (&acc)[2][2][4][2], const Unit& u, int wr, int wc, int fr, int fq) const {
        const int colt = u.pn * BM + wc * 32 + 4 * fq;
        EPI_ROWS_BEGIN
            const int b = row / SEQ; float s = 0.f;
#pragma unroll
            for (int bj = 0; bj < 2; ++bj)
#pragma unroll
                for (int n = 0; n < 2; ++n) { const int col = colt + bj * HALF + n * 16;
                    const f32x4 xv = *(const f32x4*)(x + (size_t)row * DM + col), g1 = *(const f32x4*)(mod + b * 6 * DM + 2 * DM + col);
                    const f32x4 o = xv + g1 * acc[ai][bj][m][n];
                    *(f32x4*)(out + (size_t)row * DM + col) = o; s += o[0] * o[0] + o[1] * o[1] + o[2] * o[2] + o[3] * o[3]; }
            s += __shfl_xor(s, 16); s += __shfl_xor(s, 32);
            if (fq == 0) ss[(size_t)row * 16 + u.pn * 4 + wc] = s;
        EPI_ROWS_END
    }
};
struct EpiRSF {
    static constexpr bool PERM = true; static constexpr int NSTORE = 0;
    float* L; bf16_t* AS;
    __device__ __forceinline__ void operator()(const f32x4 (&acc)[2][2][4][2], const Unit& u, int wr, int wc, int fr, int fq) const {
        const int c8 = wc * 32 + 8 * fq;
        EPI_ROWS_BEGIN
            if (u.pn == 0) {
#pragma unroll
                for (int bj = 0; bj < 2; ++bj) { float* d = L + (size_t)row * 256 + bj * HALF + c8; *(f32x4*)d = acc[ai][bj][m][0]; *(f32x4*)(d + 4) = acc[ai][bj][m][1]; }
            } else {
                const f32x4 g0 = acc[ai][0][m][0], g1 = acc[ai][0][m][1], u0 = acc[ai][1][m][0], u1 = acc[ai][1][m][1];
                u32x4 w; w.x = cvt_pk_bf16(siluf(g0[0]) * u0[0], siluf(g0[1]) * u0[1]); w.y = cvt_pk_bf16(siluf(g0[2]) * u0[2], siluf(g0[3]) * u0[3]);
                w.z = cvt_pk_bf16(siluf(g1[0]) * u1[0], siluf(g1[1]) * u1[1]); w.w = cvt_pk_bf16(siluf(g1[2]) * u1[2], siluf(g1[3]) * u1[3]);
                *(u32x4*)(AS + (size_t)row * 256 + (u.pn - 1) * 128 + c8) = w;
            }
        EPI_ROWS_END
    }
};
struct EpiSDF {
    static constexpr bool PERM = false; static constexpr int NSTORE = 0;
    const float* mod; float* out;
    __device__ __forceinline__ void operator()(const f32x4 (&acc)[2][2][4][2], const Unit& u, int wr, int wc, int fr, int fq) const {
        const int colt = u.pn * BM + wc * 32 + 4 * fq;
        EPI_ROWS_BEGIN
            const int b = row / SEQ;
#pragma unroll
            for (int bj = 0; bj < 2; ++bj)
#pragma unroll
                for (int n = 0; n < 2; ++n) { const int col = colt + bj * HALF + n * 16; const f32x4 g2 = *(const f32x4*)(mod + b * 6 * DM + 5 * DM + col);
                    f32x4* o = (f32x4*)(out + (size_t)row * DM + col); *o = *o + g2 * acc[ai][bj][m][n]; }
        EPI_ROWS_END
    }
};
struct EpiE1F {
    static constexpr bool PERM = true; static constexpr int NSTORE = 0;
    bf16_t* AE;
    __device__ __forceinline__ void operator()(const f32x4 (&acc)[2][2][4][2], const Unit& u, int wr, int wc, int fr, int fq) const {
        const int c8 = u.pn * 128 + wc * 32 + 8 * fq;
        EPI_ROWS_BEGIN
            const f32x4 g0 = acc[ai][0][m][0], g1 = acc[ai][0][m][1], u0 = acc[ai][1][m][0], u1 = acc[ai][1][m][1];
            u32x4 w; w.x = cvt_pk_bf16(siluf(g0[0]) * u0[0], siluf(g0[1]) * u0[1]); w.y = cvt_pk_bf16(siluf(g0[2]) * u0[2], siluf(g0[3]) * u0[3]);
            w.z = cvt_pk_bf16(siluf(g1[0]) * u1[0], siluf(g1[1]) * u1[1]); w.w = cvt_pk_bf16(siluf(g1[2]) * u1[2], siluf(g1[3]) * u1[3]);
            *(u32x4*)(AE + (size_t)row * 256 + c8) = w;
        EPI_ROWS_END
    }
};
struct EpiE2F {
    static constexpr bool PERM = true; static constexpr int NSTORE = 0;
    const int* sasg; const float* sgate; bf16_t* YA;
    __device__ __forceinline__ void operator()(const f32x4 (&acc)[2][2][4][2], const Unit& u, int wr, int wc, int fr, int fq) const {
        const int colt = u.pn * BM + wc * 32 + 8 * fq;
        EPI_ROWS_BEGIN
            const int asg = sasg[row]; const float gt = sgate[row];
            if (asg >= 0) {
#pragma unroll
                for (int bj = 0; bj < 2; ++bj) { const f32x4 v0 = acc[ai][bj][m][0] * gt, v1 = acc[ai][bj][m][1] * gt;
                    u32x4 w; w.x = cvt_pk_bf16(v0[0], v0[1]); w.y = cvt_pk_bf16(v0[2], v0[3]); w.z = cvt_pk_bf16(v1[0], v1[1]); w.w = cvt_pk_bf16(v1[2], v1[3]);
                    *(u32x4*)(YA + (size_t)asg * DM + colt + bj * HALF) = w; }
            }
        EPI_ROWS_END
    }
};
struct EpiSsmA {
    static constexpr bool PERM = false; static constexpr int NSTORE = 0;
    float* DS;
    __device__ __forceinline__ void operator()(const f32x4 (&acc)[2][2][4][2], const Unit& u, int wr, int wc, int fr, int fq) const {
        EPI_ROWS_BEGIN
#pragma unroll
            for (int n = 0; n < 2; ++n) *(f32x4*)(DS + (size_t)row * 128 + wc * 32 + n * 16 + 4 * fq) = acc[ai][0][m][n];
        EPI_ROWS_END
    }
};
struct EpiSsmC {
    static constexpr bool PERM = true; static constexpr int NSTORE = 0;
    bf16_t* Y;
    __device__ __forceinline__ void operator()(const f32x4 (&acc)[2][2][4][2], const Unit& u, int wr, int wc, int fr, int fq) const {
        EPI_ROWS_BEGIN
            const int gg = row >> 11, rem = row & 2047, b = rem >> 8, chunk = rem & 255; const size_t t0 = (size_t)b * SEQ + chunk * 16;
#pragma unroll
            for (int bj = 0; bj < 2; ++bj) { const int c0 = bj * HALF + wc * 32 + 8 * fq, jp = c0 >> 4, co0 = c0 & 15;
                const f32x4 v0 = acc[ai][bj][m][0], v1 = acc[ai][bj][m][1];
                u32x4 w; w.x = cvt_pk_bf16(gelu_tanh(v0[0]), gelu_tanh(v0[1])); w.y = cvt_pk_bf16(gelu_tanh(v0[2]), gelu_tanh(v0[3]));
                w.z = cvt_pk_bf16(gelu_tanh(v1[0]), gelu_tanh(v1[1])); w.w = cvt_pk_bf16(gelu_tanh(v1[2]), gelu_tanh(v1[3]));
                *(u32x4*)(Y + (t0 + jp) * 512 + gg * 16 + co0) = w; }
        EPI_ROWS_END
    }
};
struct EpiSDC {
    static constexpr bool PERM = true; static constexpr int NSTORE = 0;
    const float* mod; float* out; const bf16_t* YA;
    __device__ __forceinline__ void operator()(const f32x4 (&acc)[2][2][4][2], const Unit& u, int wr, int wc, int fr, int fq) const {
        const int colt = u.pn * BM + wc * 32 + 8 * fq;
        EPI_ROWS_BEGIN
            const int b = row / SEQ;
#pragma unroll
            for (int bj = 0; bj < 2; ++bj) { const int col = colt + bj * HALF;
                f32x4 s0 = acc[ai][bj][m][0], s1 = acc[ai][bj][m][1];
#pragma unroll
                for (int k = 0; k < 8; ++k) { const u32x4 w = *(const u32x4*)(YA + ((size_t)row * 8 + k) * DM + col);
                    s0[0] += __uint_as_float(w.x << 16); s0[1] += __uint_as_float(w.x & 0xffff0000u); s0[2] += __uint_as_float(w.y << 16); s0[3] += __uint_as_float(w.y & 0xffff0000u);
                    s1[0] += __uint_as_float(w.z << 16); s1[1] += __uint_as_float(w.z & 0xffff0000u); s1[2] += __uint_as_float(w.w << 16); s1[3] += __uint_as_float(w.w & 0xffff0000u); }
                const float* g2 = mod + b * 6 * DM + 5 * DM + col; float* o = out + (size_t)row * DM + col;
                *(f32x4*)o = *(const f32x4*)o + *(const f32x4*)g2 * s0; *(f32x4*)(o + 4) = *(const f32x4*)(o + 4) + *(const f32x4*)(g2 + 4) * s1; }
        EPI_ROWS_END
    }
};
struct EpiSDY {
    static constexpr bool PERM = true; static constexpr int NSTORE = 16;
    bf16_t* Y;
    __device__ __forceinline__ void operator()(const f32x4 (&acc)[2][2][4][2], const Unit& u, int wr, int wc, int fr, int fq) const {
        const int colt = u.pn * BM + wc * 32 + 8 * fq;
        EPI_ROWS_BEGIN
#pragma unroll
            for (int bj = 0; bj < 2; ++bj) { const f32x4 v0 = acc[ai][bj][m][0], v1 = acc[ai][bj][m][1];
                u32x4 w; w.x = cvt_pk_bf16(v0[0], v0[1]); w.y = cvt_pk_bf16(v0[2], v0[3]); w.z = cvt_pk_bf16(v1[0], v1[1]); w.w = cvt_pk_bf16(v1[2], v1[3]);
                *(u32x4*)(Y + (size_t)row * DM + colt + bj * HALF) = w; }
        EPI_ROWS_END
    }
};
struct EpiNone { static constexpr bool PERM = true; static constexpr int NSTORE = 0; float* sink;
    __device__ __forceinline__ void operator()(const f32x4 (&acc)[2][2][4][2], const Unit& u, int wr, int wc, int fr, int fq) const {
        float s = 0.f;
#pragma unroll
        for (int ai = 0; ai < 2; ++ai)
#pragma unroll
            for (int bj = 0; bj < 2; ++bj)
#pragma unroll
                for (int m = 0; m < 4; ++m)
#pragma unroll
                    for (int n = 0; n < 2; ++n) s += acc[ai][bj][m][n][0] + acc[ai][bj][m][n][1] + acc[ai][bj][m][n][2] + acc[ai][bj][m][n][3];
        if (s == 1234567.875f) sink[threadIdx.x] = s; } };
struct EpiDense { static constexpr bool PERM = true; static constexpr int NSTORE = 0; bf16_t* Y;
    __device__ __forceinline__ void operator()(const f32x4 (&acc)[2][2][4][2], const Unit& u, int wr, int wc, int fr, int fq) const {
        const int colt = u.pn * BM + wc * 32 + 8 * fq;
        EPI_ROWS_BEGIN
            if (row < T * 8) {
#pragma unroll
            for (int bj = 0; bj < 2; ++bj) { const f32x4 v0 = acc[ai][bj][m][0], v1 = acc[ai][bj][m][1];
                u32x4 w; w.x = cvt_pk_bf16(v0[0], v0[1]); w.y = cvt_pk_bf16(v0[2], v0[3]); w.z = cvt_pk_bf16(v1[0], v1[1]); w.w = cvt_pk_bf16(v1[2], v1[3]);
                *(u32x4*)(Y + (size_t)row * DM + colt + bj * HALF) = w; } }
        EPI_ROWS_END
    } };
struct ProbeOrder { int nunits, G, vcu;
    __device__ __forceinline__ bool next(int i, Unit& u) const { const int L = i * G + vcu; if (L >= nunits) return false; u.pm = vcu & 7; u.pn = 0; u.pb = vcu & 3; return true; } };
struct EpiE2S {
    static constexpr bool PERM = true; static constexpr int NSTORE = 16;
    const int* sasg; const float* sgate; bf16_t* YS;
    __device__ __forceinline__ void operator()(const f32x4 (&acc)[2][2][4][2], const Unit& u, int wr, int wc, int fr, int fq) const {
        const int colt = u.pn * BM + wc * 32 + 8 * fq; const int row0 = u.pm * BM + wr * 64 + fr;
        float gt[2][4];
#pragma unroll
        for (int ai = 0; ai < 2; ++ai)
#pragma unroll
            for (int m = 0; m < 4; ++m) gt[ai][m] = sgate[row0 + ai * HALF + m * 16];
        asm volatile("s_waitcnt vmcnt(0)" : "+v"(gt[0][0]), "+v"(gt[0][1]), "+v"(gt[0][2]), "+v"(gt[0][3]), "+v"(gt[1][0]), "+v"(gt[1][1]), "+v"(gt[1][2]), "+v"(gt[1][3]) :: "memory");
#pragma unroll
        for (int ai = 0; ai < 2; ++ai)
#pragma unroll
            for (int m = 0; m < 4; ++m) { const int row = row0 + ai * HALF + m * 16;
#pragma unroll
                for (int bj = 0; bj < 2; ++bj) { const f32x4 v0 = acc[ai][bj][m][0] * gt[ai][m], v1 = acc[ai][bj][m][1] * gt[ai][m];
                    u32x4 w; w.x = cvt_pk_bf16(v0[0], v0[1]); w.y = cvt_pk_bf16(v0[2], v0[3]); w.z = cvt_pk_bf16(v1[0], v1[1]); w.w = cvt_pk_bf16(v1[2], v1[3]);
                    *(u32x4*)(YS + (size_t)row * DM + colt + bj * HALF) = w; } }
    }
};
struct EpiE1F8 {
    static constexpr bool PERM = true; static constexpr int NSTORE = 0;
    unsigned char* AE;
    __device__ __forceinline__ void operator()(const f32x4 (&acc)[2][2][4][2], const Unit& u, int wr, int wc, int fr, int fq) const {
        const int c8 = u.pn * 128 + wc * 32 + 8 * fq;
        EPI_ROWS_BEGIN
            const f32x4 g0 = acc[ai][0][m][0], g1 = acc[ai][0][m][1], u0 = acc[ai][1][m][0], u1 = acc[ai][1][m][1];
            u32x2 w; w.x = pk4_fp8(ACT8_SCALE * siluf(g0[0]) * u0[0], ACT8_SCALE * siluf(g0[1]) * u0[1], ACT8_SCALE * siluf(g0[2]) * u0[2], ACT8_SCALE * siluf(g0[3]) * u0[3]);
            w.y = pk4_fp8(ACT8_SCALE * siluf(g1[0]) * u1[0], ACT8_SCALE * siluf(g1[1]) * u1[1], ACT8_SCALE * siluf(g1[2]) * u1[2], ACT8_SCALE * siluf(g1[3]) * u1[3]);
            *(u32x2*)(AE + (size_t)row * 256 + c8) = w;
        EPI_ROWS_END
    }
};
struct EpiE2S8 {
    static constexpr bool PERM = true; static constexpr int NSTORE = 16;
    const float* sgate; unsigned char* YS;
    __device__ __forceinline__ void operator()(const f32x4 (&acc)[2][2][4][2], const Unit& u, int wr, int wc, int fr, int fq) const {
        const int colt = u.pn * BM + wc * 32 + 8 * fq; const int row0 = u.pm * BM + wr * 64 + fr;
        float gt[2][4];
#pragma unroll
        for (int ai = 0; ai < 2; ++ai)
#pragma unroll
            for (int m = 0; m < 4; ++m) gt[ai][m] = sgate[row0 + ai * HALF + m * 16] * Y8_SCALE;
        asm volatile("s_waitcnt vmcnt(0)" : "+v"(gt[0][0]), "+v"(gt[0][1]), "+v"(gt[0][2]), "+v"(gt[0][3]), "+v"(gt[1][0]), "+v"(gt[1][1]), "+v"(gt[1][2]), "+v"(gt[1][3]) :: "memory");
#pragma unroll
        for (int ai = 0; ai < 2; ++ai)
#pragma unroll
            for (int m = 0; m < 4; ++m) { const int row = row0 + ai * HALF + m * 16;
#pragma unroll
                for (int bj = 0; bj < 2; ++bj) { const f32x4 v0 = acc[ai][bj][m][0] * gt[ai][m], v1 = acc[ai][bj][m][1] * gt[ai][m];
                    u32x2 w; w.x = pk4_fp8(v0[0], v0[1], v0[2], v0[3]); w.y = pk4_fp8(v1[0], v1[1], v1[2], v1[3]);
                    *(u32x2*)(YS + (size_t)row * DM + colt + bj * HALF) = w; } }
    }
};
struct EpiE2S8b {
    static constexpr bool PERM = true; static constexpr int NSTORE = 0;
    const float* sgate; unsigned char* YS;
    __device__ __forceinline__ void operator()(const f32x4 (&acc)[2][2][4][2], const Unit& u, int wr, int wc, int fr, int fq) const {
        const int colt = u.pn * BM + wc * 32 + 8 * fq;
        EPI_ROWS_BEGIN
            const float gt = sgate[row] * Y8_SCALE;
#pragma unroll
            for (int bj = 0; bj < 2; ++bj) { const f32x4 v0 = acc[ai][bj][m][0] * gt, v1 = acc[ai][bj][m][1] * gt;
                u32x2 w; w.x = pk4_fp8(v0[0], v0[1], v0[2], v0[3]); w.y = pk4_fp8(v1[0], v1[1], v1[2], v1[3]);
                *(u32x2*)(YS + (size_t)row * DM + colt + bj * HALF) = w; }
        EPI_ROWS_END
    }
};
struct EpiE1G8 {
    static constexpr bool PERM = true; static constexpr int NSTORE = 0;
    const float* sgate; unsigned char* AE;
    __device__ __forceinline__ void operator()(const f32x4 (&acc)[2][2][4][2], const Unit& u, int wr, int wc, int fr, int fq) const {
        const int c8 = u.pn * 128 + wc * 32 + 8 * fq;
        EPI_ROWS_BEGIN
            const float gs = sgate[row] * ACT8_SCALE;
            const f32x4 g0 = acc[ai][0][m][0], g1 = acc[ai][0][m][1], u0 = acc[ai][1][m][0], u1 = acc[ai][1][m][1];
            u32x2 w; w.x = pk4_fp8(gs * siluf(g0[0]) * u0[0], gs * siluf(g0[1]) * u0[1], gs * siluf(g0[2]) * u0[2], gs * siluf(g0[3]) * u0[3]);
            w.y = pk4_fp8(gs * siluf(g1[0]) * u1[0], gs * siluf(g1[1]) * u1[1], gs * siluf(g1[2]) * u1[2], gs * siluf(g1[3]) * u1[3]);
            *(u32x2*)(AE + (size_t)row * 256 + c8) = w;
        EPI_ROWS_END
    }
};
struct EpiE2P8 {
    static constexpr bool PERM = true; static constexpr int NSTORE = 16;
    unsigned char* YS;
    __device__ __forceinline__ void operator()(const f32x4 (&acc)[2][2][4][2], const Unit& u, int wr, int wc, int fr, int fq) const {
        const int colt = u.pn * BM + wc * 32 + 8 * fq;
        unsigned char* ptr = YS + (size_t)(u.pm * BM + wr * 64 + fr) * DM + colt;
#pragma unroll
        for (int ai = 0; ai < 2; ++ai) {
#pragma unroll
            for (int m = 0; m < 4; ++m) {
#pragma unroll
                for (int bj = 0; bj < 2; ++bj) { const f32x4 v0 = acc[ai][bj][m][0], v1 = acc[ai][bj][m][1];
                    u32x2 w; w.x = pk4_fp8(v0[0], v0[1], v0[2], v0[3]); w.y = pk4_fp8(v1[0], v1[1], v1[2], v1[3]);
                    *(u32x2*)(ptr + bj * HALF) = w; }
                ptr += 16 * DM; asm volatile("" : "+v"(ptr)); __builtin_amdgcn_sched_barrier(0); }
            ptr += (HALF - 64) * DM; }
    }
};
struct GroupedOrderL {
    const PG8_LAS int* le; int ntiles, NT, G, vcu;
    __device__ __forceinline__ void fill(const int* tile_e, PG8_LAS int* dst) { le = dst; const int tot = ntiles * NT;
        for (int i = threadIdx.x; i * G + vcu < tot; i += blockDim.x) dst[i] = tile_e[(i * G + vcu) / NT];
        __syncthreads(); }
    __device__ __forceinline__ bool next(int i, Unit& u) const {
        const int L = i * G + vcu; if (L >= ntiles * NT) return false;
        const int mt = L / NT, nn = L - mt * NT; u.pm = mt; u.pn = nn; u.pb = le[i] * NT + nn; return true;
    }
};
struct SsmOrder {
    int G, vcu;
    __device__ __forceinline__ bool next(int i, Unit& u) const { const int L = i * G + vcu; if (L >= 256) return false; u.pm = L; u.pn = 0; u.pb = L >> 3; return true; }
};
}

__device__ __forceinline__ void transpose_item(const float* W, int K, int N, bf16_t* WT, int kb, int nb, int rowbase, float* scr, int lane) {
    const int k0 = 64 * kb, n0 = 32 * nb;
#pragma unroll 8
    for (int i = 0; i < 32; ++i) { const int kk = 2 * i + (lane >> 5); scr[kk * 33 + (lane & 31)] = W[(size_t)(k0 + kk) * N + n0 + (lane & 31)]; }
    asm volatile("s_waitcnt lgkmcnt(0)" ::: "memory");
    const int cch = lane & 7;
#pragma unroll
    for (int j = 0; j < 4; ++j) { const int n = (lane >> 3) + 8 * j; const float* s = scr + (8 * cch) * 33 + n;
        u32x4 o; o.x = pk2(s[0 * 33], s[1 * 33]); o.y = pk2(s[2 * 33], s[3 * 33]); o.z = pk2(s[4 * 33], s[5 * 33]); o.w = pk2(s[6 * 33], s[7 * 33]);
        *(u32x4*)(WT + (size_t)(rowbase + n) * K + k0 + 8 * cch) = o; }
    asm volatile("s_waitcnt lgkmcnt(0)" ::: "memory");
}
__device__ __forceinline__ int gu_row(int n0, int up) { return (n0 >> 7) * 256 + up * 128 + (n0 & 127); }
template <bool EXPERTS>
__device__ __forceinline__ void ph_convert(const Ctx& c, const Params& p) {
    float* scr = c.lds + c.wave * (64 * 33);
    unsigned char* ws = c.ws;
    constexpr int I0 = 16 * 64, I1 = 16 * 32, I2 = 8 * 16, I3 = 16 * 8, I6 = 4 * 32, IE = 128;
    constexpr int DENSE = I0 + I1 + I2 + 3 * I3 + I6, NITEMS = EXPERTS ? DENSE + 3 * IE * NE : DENSE;
    for (int it = c.gwave; it < NITEMS; it += c.gwaves) {
        int r = it;
        if (r < I0) { transpose_item(p.in[I_WIN], DM, 2048, (bf16_t*)(ws + WS_WIN_T), r / 64, r % 64, (r % 64) * 32, scr, c.lane); continue; } r -= I0;
        if (r < I1) { transpose_item(p.in[I_WOUT], DM, DM, (bf16_t*)(ws + WS_WOUT_T), r / 32, r % 32, (r % 32) * 32, scr, c.lane); continue; } r -= I1;
        if (r < I2) { transpose_item(p.in[I_WGLU], 512, 512, (bf16_t*)(ws + WS_WGLU_T), r / 16, r % 16, (r % 16) * 32, scr, c.lane); continue; } r -= I2;
        if (r < I3) { transpose_item(p.in[I_WR], DM, 256, (bf16_t*)(ws + WS_WRS_T), r / 8, r % 8, (r % 8) * 32, scr, c.lane); continue; } r -= I3;
        if (r < I3) { transpose_item(p.in[I_WGS], DM, 256, (bf16_t*)(ws + WS_WRS_T), r / 8, r % 8, 256 + gu_row((r % 8) * 32, 0), scr, c.lane); continue; } r -= I3;
        if (r < I3) { transpose_item(p.in[I_WUS], DM, 256, (bf16_t*)(ws + WS_WRS_T), r / 8, r % 8, 256 + gu_row((r % 8) * 32, 1), scr, c.lane); continue; } r -= I3;
        if (r < I6) { transpose_item(p.in[I_WDS], 256, DM, (bf16_t*)(ws + WS_WDS_T), r / 32, r % 32, (r % 32) * 32, scr, c.lane); continue; } r -= I6;
        const int e = r / (3 * IE), q = r % (3 * IE), which = q / IE, ii = q % IE;
        if (which == 0) transpose_item(p.in[I_WGE] + (size_t)e * DM * ED, DM, ED, (bf16_t*)(ws + WS_WGU) + (size_t)e * 512 * DM, ii / 8, ii % 8, gu_row((ii % 8) * 32, 0), scr, c.lane);
        else if (which == 1) transpose_item(p.in[I_WUE] + (size_t)e * DM * ED, DM, ED, (bf16_t*)(ws + WS_WGU) + (size_t)e * 512 * DM, ii / 8, ii % 8, gu_row((ii % 8) * 32, 1), scr, c.lane);
        else transpose_item(p.in[I_WDE] + (size_t)e * ED * DM, ED, DM, (bf16_t*)(ws + WS_WD) + (size_t)e * DM * ED, ii / 32, ii % 32, (ii % 32) * 32, scr, c.lane);
    }
}

__device__ __forceinline__ void transpose_tile64(const float* W, int K, int N, bf16_t* WT, int kb, int nb, int rowbase, float* scr, int lane) {
    const int k0 = 64 * kb, n0 = 64 * nb;
    f32x4 v[16];
#pragma unroll
    for (int i = 0; i < 16; ++i) v[i] = *(const f32x4*)(W + (size_t)(k0 + 4 * i + (lane >> 4)) * N + n0 + (lane & 15) * 4);
#pragma unroll
    for (int i = 0; i < 16; ++i) { float* d = scr + (4 * i + (lane >> 4)) * 65 + (lane & 15) * 4; d[0] = v[i].x; d[1] = v[i].y; d[2] = v[i].z; d[3] = v[i].w; }
    asm volatile("s_waitcnt lgkmcnt(0)" ::: "memory");
    const int cch = lane & 7;
#pragma unroll
    for (int jj = 0; jj < 8; ++jj) { const int n = (lane >> 3) + 8 * jj; const float* s_ = scr + (8 * cch) * 65 + n;
        u32x4 o; o.x = pk2(s_[0 * 65], s_[1 * 65]); o.y = pk2(s_[2 * 65], s_[3 * 65]); o.z = pk2(s_[4 * 65], s_[5 * 65]); o.w = pk2(s_[6 * 65], s_[7 * 65]);
        *(u32x4*)(WT + (size_t)(rowbase + n) * K + k0 + 8 * cch) = o; }
    asm volatile("s_waitcnt lgkmcnt(0)" ::: "memory");
}
struct ConvTile { const float* W; bf16_t* WT; int K, N, k0, n0, rowbase; bool f8; float scale; };
template <int GU8>
__device__ __forceinline__ ConvTile conv_tile_ref(const Ctx& c, const Params& p, int id) {
    const int e = id / 192, q = id % 192, which = q >> 6, ii = q & 63; ConvTile t; t.f8 = (GU8 >= 1 && which < 2) || (GU8 == 2); t.scale = which < 2 ? WGU8_SCALE : WD8_SCALE;
    if (which == 0) { t.W = p.in[I_WGE] + (size_t)e * DM * ED; t.WT = (bf16_t*)(c.ws + WS_WGU) + (size_t)e * 512 * (GU8 ? DM / 2 : DM); t.K = DM; t.N = ED; t.k0 = 64 * (ii >> 2); t.n0 = 64 * (ii & 3); t.rowbase = gu_row(t.n0, 0); }
    else if (which == 1) { t.W = p.in[I_WUE] + (size_t)e * DM * ED; t.WT = (bf16_t*)(c.ws + WS_WGU) + (size_t)e * 512 * (GU8 ? DM / 2 : DM); t.K = DM; t.N = ED; t.k0 = 64 * (ii >> 2); t.n0 = 64 * (ii & 3); t.rowbase = gu_row(t.n0, 1); }
    else { t.W = p.in[I_WDE] + (size_t)e * ED * DM; t.WT = (bf16_t*)(c.ws + WS_WD) + (size_t)e * DM * (GU8 == 2 ? ED / 2 : ED); t.K = ED; t.N = DM; t.k0 = 64 * (ii >> 4); t.n0 = 64 * (ii & 15); t.rowbase = t.n0; }
    return t;
}
#define CONV_LOAD(v, t) do { const float* p_ = (t).W + (size_t)((t).k0 + (c.lane >> 4)) * (t).N + (t).n0 + (c.lane & 15) * 4; const size_t st_ = (size_t)4 * (t).N; \
        _Pragma("unroll") for (int i_ = 0; i_ < 16; ++i_) { v[i_] = *(const f32x4*)p_; p_ += st_; asm volatile("" : "+v"(p_)); } } while (0)
#define CONV_FINISH(v, t) do { _Pragma("unroll") for (int i_ = 0; i_ < 16; ++i_) { float* d_ = scr + (4 * i_ + (c.lane >> 4)) * 65 + (c.lane & 15) * 4; d_[0] = v[i_].x; d_[1] = v[i_].y; d_[2] = v[i_].z; d_[3] = v[i_].w; } \
        asm volatile("s_waitcnt lgkmcnt(0)" ::: "memory"); \
        { const int esz_ = (t).f8 ? 1 : 2; unsigned char* q_ = (unsigned char*)(t).WT + ((size_t)((t).rowbase + (c.lane >> 3)) * (t).K + (t).k0 + 8 * (c.lane & 7)) * esz_; const size_t qs_ = (size_t)8 * (t).K * esz_; \
        _Pragma("unroll") for (int jj_ = 0; jj_ < 8; ++jj_) { const float* s_ = scr + (8 * (c.lane & 7)) * 65 + (c.lane >> 3) + 8 * jj_; \
            if ((t).f8) { u32x2 o_; o_.x = pk4_fp8(s_[0 * 65] * (t).scale, s_[1 * 65] * (t).scale, s_[2 * 65] * (t).scale, s_[3 * 65] * (t).scale); \
                o_.y = pk4_fp8(s_[4 * 65] * (t).scale, s_[5 * 65] * (t).scale, s_[6 * 65] * (t).scale, s_[7 * 65] * (t).scale); \
                *(u32x2*)q_ = o_; } \
            else { u32x4 o_; o_.x = pk2(s_[0 * 65], s_[1 * 65]); o_.y = pk2(s_[2 * 65], s_[3 * 65]); o_.z = pk2(s_[4 * 65], s_[5 * 65]); o_.w = pk2(s_[6 * 65], s_[7 * 65]); \
                *(u32x4*)q_ = o_; } \
            q_ += qs_; asm volatile("" : "+v"(q_)); } } \
        asm volatile("s_waitcnt lgkmcnt(0)" ::: "memory"); } while (0)
template <int GU8>
__device__ __forceinline__ void conv_range(const Ctx& c, const Params& p, int first, int end, int stride, float* scr) {
    if (first >= end) return;
    f32x4 va[16], vb[16];
    ConvTile ta = conv_tile_ref<GU8>(c, p, first), tb = ta;
    CONV_LOAD(va, ta);
    for (int id = first; id < end; id += 2 * stride) {
        const bool hb = id + stride < end;
        if (hb) { tb = conv_tile_ref<GU8>(c, p, id + stride); CONV_LOAD(vb, tb); }
        CONV_FINISH(va, ta);
        if (!hb) break;
        const bool ha = id + 2 * stride < end;
        if (ha) { ta = conv_tile_ref<GU8>(c, p, id + 2 * stride); CONV_LOAD(va, ta); }
        CONV_FINISH(vb, tb);
        if (!ha) break;
    }
}
__device__ __forceinline__ void conv_tile_by_id(const Ctx& c, const Params& p, int id, float* scr) { conv_range<0>(c, p, id, id + 1, 1, scr); }
__device__ __forceinline__ void conv_queue(const Ctx& c, const Params& p, unsigned* qctr) {
    float* scr = c.lds + c.wave * (64 * 65);
    constexpr int NTILES = NE * 192, CHUNK = 16;
    for (;;) {
        int tk = 0; if (c.lane == 0) tk = (int)atomicAdd(qctr, 1u);
        tk = __builtin_amdgcn_readfirstlane(tk);
        if (tk * CHUNK >= NTILES) break;
        conv_range<0>(c, p, tk * CHUNK, tk * CHUNK + CHUNK, 1, scr);
    }
}
__device__ __forceinline__ void ph_prologue2(const Ctx& c, const Params& p) {
    float* mod = (float*)(c.ws + WS_MOD);
    float* sc = c.lds;
    for (int i = c.tid; i < NB * DM; i += NTHREADS_) sc[i] = siluf(p.in[I_C][i]);
    __syncthreads();
    float* red = c.lds + NB * DM;
    for (int cg = c.bid; cg < 96; cg += c.nb) {
        const int ks = c.wave, col = cg * 64 + c.lane;
        const float* w = p.in[I_WADA] + (size_t)(ks * 128) * (6 * DM) + col;
        float acc[8];
#pragma unroll
        for (int b = 0; b < 8; ++b) acc[b] = 0.f;
#pragma unroll 16
        for (int k = 0; k < 128; ++k) { const float wv = w[(size_t)k * (6 * DM)];
#pragma unroll
            for (int b = 0; b < 8; ++b) acc[b] += sc[b * DM + ks * 128 + k] * wv; }
#pragma unroll
        for (int b = 0; b < 8; ++b) red[(ks * 8 + b) * 64 + c.lane] = acc[b];
        __syncthreads();
        { const int b = c.wave; float sum = p.in[I_BADA][col];
#pragma unroll
          for (int k2 = 0; k2 < 8; ++k2) sum += red[(k2 * 8 + b) * 64 + c.lane];
          mod[b * 6 * DM + col] = sum; }
        __syncthreads();
    }
    float* ropec = (float*)(c.ws + WS_ROPE); float* ropes = ropec + SEQ * 32;
    for (int idx = c.gtid; idx < SEQ * 32; idx += c.gthreads) {
        const int l = idx >> 5, i = idx & 31;
        const double invf = exp(-log(10000.0) * (double)(2 * i) / 64.0);
        const double ang = (double)l * invf;
        ropec[idx] = (float)cos(ang); ropes[idx] = (float)sin(ang);
    }
    float* sp = (float*)(c.ws + WS_SSMP);
    float* abr = sp, * abi = sp + SG * SP, * bbr = sp + 2 * SG * SP, * bbi = bbr + SG * SP * SC;
    for (int idx = c.gtid; idx < SG * SP; idx += c.gthreads) {
        const int g = idx / SP;
        const double are = p.in[I_ARE][idx], aim = p.in[I_AIM][idx], dt = exp((double)p.in[I_LOGDT][g]);
        const double mag = exp(are * dt), ar = mag * cos(aim * dt), ai = mag * sin(aim * dt);
        abr[idx] = (float)ar; abi[idx] = (float)ai;
        const double den = are * are + aim * aim, nr = ar - 1.0;
        const double fre = (nr * are + ai * aim) / den, fim = (ai * are - nr * aim) / den;
        for (int ch = 0; ch < SC; ++ch) {
            const double br = p.in[I_BRE][idx * SC + ch], bi = p.in[I_BIM][idx * SC + ch];
            bbr[idx * SC + ch] = (float)(fre * br - fim * bi); bbi[idx * SC + ch] = (float)(fre * bi + fim * br);
        }
    }
    for (int idx = c.gthreads - 1 - c.gtid; idx < SG * SP * 17; idx += c.gthreads) {
        const int gp = idx / 17, d = idx % 17, g = gp / SP;
        const double are = p.in[I_ARE][gp], aim = p.in[I_AIM][gp], dt = exp((double)p.in[I_LOGDT][g]);
        const double m = exp(are * dt * d); float* pw = (float*)(c.ws + WS_SSMPW) + (size_t)gp * 34;
        pw[2 * d] = (float)(m * cos(aim * dt * d)); pw[2 * d + 1] = (float)(m * sin(aim * dt * d));
    }
    if (c.gtid == 0) {
        float s1 = 0.f, s2 = 0.f, gq = 0.f, gk = 0.f;
        for (int i = 0; i < HD; ++i) { s1 += p.in[I_LQ1][i] * p.in[I_LK1][i]; s2 += p.in[I_LQ2][i] * p.in[I_LK2][i];
            gq = fmaxf(gq, fabsf(p.in[I_QNG][i])); gk = fmaxf(gk, fabsf(p.in[I_KNG][i])); }
        float* lam = (float*)(c.ws + WS_LAM);
        lam[0] = __expf(s1) - __expf(s2) + LAM_INIT;
        lam[1] = 0.125f * 64.f * gq * gk;
    }
    int* stok = (int*)(c.ws + WS_SLOT_TOK); int* sasg = (int*)(c.ws + WS_SLOT_ASG); float* sgate = (float*)(c.ws + WS_SLOT_GATE);
    for (int idx = c.gtid; idx < NS_MAX; idx += c.gthreads) { stok[idx] = 0; sasg[idx] = -1; sgate[idx] = 0.f; }
    int* te = (int*)(c.ws + WS_TILE_E);
    for (int idx = c.gtid; idx < NS_MAX / 256; idx += c.gthreads) te[idx] = -1;
    __syncthreads();
}
__device__ __forceinline__ void ph_slot2(const Ctx& c, const Params& p) {
    const unsigned* counts = (const unsigned*)(c.ws + WS_CTL) + CW_COUNTS; unsigned* cursor = (unsigned*)(c.ws + WS_CTL) + CW_CURSOR;
    int* pc = (int*)c.lds; int* ps = pc + 256;
    if (c.tid < NE) pc[c.tid] = ((int)counts[c.tid] + 255) / 256 * 256;
    __syncthreads();
    if (c.tid <= NE) { int acc = 0; for (int e = 0; e < c.tid; ++e) acc += pc[e]; ps[c.tid] = acc; }
    __syncthreads();
    const int* eidx = (const int*)(c.ws + WS_EIDX); const float* gw = (const float*)(c.ws + WS_GATEW);
    int* stok = (int*)(c.ws + WS_SLOT_TOK); int* sasg = (int*)(c.ws + WS_SLOT_ASG); float* sgate = (float*)(c.ws + WS_SLOT_GATE);
    for (int a = c.gtid; a < T * TOPK; a += c.gthreads) {
        const int e = eidx[a]; const unsigned pos = atomicAdd(cursor + e, 1u); const int slot = ps[e] + (int)pos;
        stok[slot] = a >> 3; sasg[slot] = a; sgate[slot] = gw[a];
    }
    if (c.bid == 0) {
        int* te = (int*)(c.ws + WS_TILE_E);
        for (int e = c.tid; e < NE; e += NTHREADS_) for (int tl = ps[e] / 256; tl < ps[e + 1] / 256; ++tl) te[tl] = e;
        if (c.tid == 0) ((unsigned*)(c.ws + WS_CTL))[CW_NTILES] = (unsigned)(ps[NE] / 256);
    }
    __syncthreads();
}

template <int CTRL> __device__ __forceinline__ float dpp_f(float v) { return __builtin_bit_cast(float, __builtin_amdgcn_update_dpp(0, __builtin_bit_cast(int, v), CTRL, 0xF, 0xF, false)); }
template <int CTRL> __device__ __forceinline__ int dpp_i(int v) { return __builtin_amdgcn_update_dpp(0, v, CTRL, 0xF, 0xF, false); }
#define DPP_XOR1 0xB1
#define DPP_XOR2 0x4E
#define DPP_HMIR 0x141
#define DPP_MIR 0x140
__device__ __forceinline__ void ph_qkn2(const Ctx& c, const Params& p) {
    bf16_t* QK = (bf16_t*)(c.ws + WS_QK);
    const float* ropec = (const float*)(c.ws + WS_ROPE); const float* ropes = ropec + SEQ * 32;
    const int l = c.lane, qt = l & 3; const bool hi_half = qt >= 2;
    const float qsc = l < 32 ? 0.125f * 1.4426950408889634f : 1.f;
    float g[16];
#pragma unroll
    for (int j = 0; j < 16; ++j) g[j] = (l < 32 ? p.in[I_QNG] : p.in[I_KNG])[16 * qt + j];
    constexpr int R = 2;
    for (int t0 = c.gwave * R; t0 < T; t0 += c.gwaves * R) {
        u32x4 w[R][2]; f32x4 cs[R][4], sn[R][4];
#pragma unroll
        for (int r = 0; r < R; ++r) { const int t = t0 + r, pos = t % SEQ;
            w[r][0] = *(const u32x4*)(QK + (size_t)t * 1024 + l * 16); w[r][1] = *(const u32x4*)(QK + (size_t)t * 1024 + l * 16 + 8);
#pragma unroll
            for (int q = 0; q < 4; ++q) { cs[r][q] = *(const f32x4*)(ropec + pos * 32 + 16 * (qt & 1) + 4 * q); sn[r][q] = *(const f32x4*)(ropes + pos * 32 + 16 * (qt & 1) + 4 * q); } }
#pragma unroll
        for (int r = 0; r < R; ++r) {
            float v[16]; const unsigned* wp = (const unsigned*)&w[r][0];
#pragma unroll
            for (int i = 0; i < 8; ++i) { v[2 * i] = __uint_as_float(wp[i] << 16); v[2 * i + 1] = __uint_as_float(wp[i] & 0xffff0000u); }
            float ss = 0.f;
#pragma unroll
            for (int j = 0; j < 16; ++j) ss += v[j] * v[j];
            ss += dpp_f<DPP_XOR1>(ss); ss += dpp_f<DPP_XOR2>(ss);
            const float rstd = rsqrtf(ss * (1.f / 64.f) + EPS);
            unsigned o[8];
#pragma unroll
            for (int i = 0; i < 8; ++i) { float res[2];
#pragma unroll
                for (int e = 0; e < 2; ++e) { const int j = 2 * i + e; const float y = v[j] * rstd * g[j]; const float pr = dpp_f<DPP_XOR2>(y);
                    const float cc_ = cs[r][j >> 2][j & 3], s_ = sn[r][j >> 2][j & 3];
                    res[e] = (hi_half ? (pr * s_ + y * cc_) : (y * cc_ - pr * s_)) * qsc; }
                o[i] = pk2(res[0], res[1]); }
            *(u32x4*)(QK + (size_t)(t0 + r) * 1024 + l * 16) = (u32x4){o[0], o[1], o[2], o[3]}; *(u32x4*)(QK + (size_t)(t0 + r) * 1024 + l * 16 + 8) = (u32x4){o[4], o[5], o[6], o[7]};
        }
    }
}
template <bool ATOMIC_BASE>
__device__ __forceinline__ void ph_route2(const Ctx& c, const Params& p) {
    const float* L = (const float*)(c.ws + WS_LOGITS);
    int* eidx = (int*)(c.ws + WS_EIDX); float* gw = (float*)(c.ws + WS_GATEW); int* HIST = (int*)(c.ws + WS_HIST);
    int* hist = (int*)c.lds;
    if (c.tid < NE) hist[c.tid] = 0;
    __syncthreads();
    const int j = c.lane & 15, r = c.lane >> 4, g = j >> 1; const float NEG = -__builtin_inff();
    float rb[16];
#pragma unroll
    for (int i = 0; i < 16; ++i) rb[i] = p.in[I_RB][16 * j + i];
    for (int blk = c.bid; blk < T / 128; blk += c.nb) {
        for (int it = 0; it < 4; ++it) {
            const int t = blk * 128 + it * 32 + c.wave * 4 + r;
            float s[16], mv[16];
            { const f32x4* lp = (const f32x4*)(L + (size_t)t * 256 + 16 * j);
#pragma unroll
              for (int q = 0; q < 4; ++q) { const f32x4 x = lp[q]; s[4 * q] = sigmoidf(x.x); s[4 * q + 1] = sigmoidf(x.y); s[4 * q + 2] = sigmoidf(x.z); s[4 * q + 3] = sigmoidf(x.w); } }
            float m1 = NEG, m2 = NEG;
#pragma unroll
            for (int i = 0; i < 16; ++i) { mv[i] = s[i] + rb[i]; m2 = fmaxf(m2, fminf(m1, mv[i])); m1 = fmaxf(m1, mv[i]); }
            const float pm1 = dpp_f<DPP_XOR1>(m1), pm2 = dpp_f<DPP_XOR1>(m2);
            const float gs = fmaxf(m1, pm1) + fmaxf(fminf(m1, pm1), fmaxf(m2, pm2));
            int rank = 0;
#define RANK_STEP(N) { const float os = dpp_f<0x120 + (N)>(gs); const int og = dpp_i<0x120 + (N)>(g); rank += (os > gs || (os == gs && og < g)) ? 1 : 0; }
            RANK_STEP(2) RANK_STEP(4) RANK_STEP(6) RANK_STEP(8) RANK_STEP(10) RANK_STEP(12) RANK_STEP(14)
#undef RANK_STEP
            if (rank >= TOPG) {
#pragma unroll
                for (int i = 0; i < 16; ++i) mv[i] = NEG;
            }
            float wsel = 0.f, wsum = 0.f; int esel = 0;
#pragma unroll
            for (int k = 0; k < TOPK; ++k) {
                float bm = mv[0], bs = s[0]; int bi = 16 * j;
#pragma unroll
                for (int i = 1; i < 16; ++i) { const bool gt = mv[i] > bm; bm = gt ? mv[i] : bm; bs = gt ? s[i] : bs; bi = gt ? 16 * j + i : bi; }
#define ARG_STEP(CT) { const float om = dpp_f<CT>(bm), os = dpp_f<CT>(bs); const int oi = dpp_i<CT>(bi); const bool tk = (om > bm) || (om == bm && oi < bi); bm = tk ? om : bm; bs = tk ? os : bs; bi = tk ? oi : bi; }
                ARG_STEP(DPP_XOR1) ARG_STEP(DPP_XOR2) ARG_STEP(DPP_HMIR) ARG_STEP(DPP_MIR)
#undef ARG_STEP
#pragma unroll
                for (int i = 0; i < 16; ++i) mv[i] = (bi == 16 * j + i) ? NEG : mv[i];
                wsum += bs;
                if (j == k) { wsel = bs; esel = bi; }
            }
            if (j < TOPK) { eidx[t * 8 + j] = esel; gw[t * 8 + j] = wsel / wsum * ROUTED_SCALE; atomicAdd(hist + esel, 1); }
        }
        __syncthreads();
        if (c.tid < NE) { const int h = hist[c.tid];
            if (ATOMIC_BASE) { unsigned* counts = (unsigned*)(c.ws + WS_CTL) + CW_COUNTS; HIST[blk * NE + c.tid] = h ? (int)atomicAdd(counts + c.tid, (unsigned)h) : 0; }
            else HIST[blk * NE + c.tid] = h;
            hist[c.tid] = 0; }
        __syncthreads();
    }
}
template <bool INV>
__device__ __forceinline__ void ph_slot3(const Ctx& c, const Params& p) {
    const int* HIST = (const int*)(c.ws + WS_HIST);
    int* pc = (int*)c.lds; int* base = pc + 256; int* cnt = base + 257;
    const int* eidx = (const int*)(c.ws + WS_EIDX); const float* gw = (const float*)(c.ws + WS_GATEW);
    int* stok = (int*)(c.ws + WS_SLOT_TOK); int* sasg = (int*)(c.ws + WS_SLOT_ASG); float* sgate = (float*)(c.ws + WS_SLOT_GATE);
    for (int blk = c.bid; blk < T / 128; blk += c.nb) {
        int before = 0;
        if (c.tid < NE) { int tot = 0;
#pragma unroll 16
            for (int b2 = 0; b2 < T / 128; ++b2) { const int h = HIST[b2 * NE + c.tid]; tot += h; before += (b2 < blk) ? h : 0; }
            pc[c.tid] = (tot + 255) / 256 * 256; cnt[c.tid] = 0; }
        __syncthreads();
        if (c.tid <= NE) { int acc = 0; for (int e = 0; e < c.tid; ++e) acc += pc[e]; base[c.tid] = acc + (c.tid < NE ? before : 0); }
        __syncthreads();
        for (int i = c.tid; i < 128 * TOPK; i += NTHREADS_) {
            const int a = blk * 128 * TOPK + i, e = eidx[a]; const int pos = atomicAdd(cnt + e, 1); const int slot = base[e] + pos;
            stok[slot] = a >> 3; sasg[slot] = a; sgate[slot] = gw[a]; if (INV) ((int*)eidx)[a] = slot;
        }
        if (blk == 0) {
            int* te = (int*)(c.ws + WS_TILE_E);
            for (int e = c.tid; e < NE; e += NTHREADS_) for (int tl = base[e] / 256; tl < (base[e] + pc[e]) / 256; ++tl) te[tl] = e;
            if (c.tid == 0) ((unsigned*)(c.ws + WS_CTL))[CW_NTILES] = (unsigned)(base[NE] / 256);
        }
        __syncthreads();
    }
}
__device__ __forceinline__ void ph_slot5(const Ctx& c, const Params& p) {
    const int* HIST = (const int*)(c.ws + WS_HIST); const unsigned* counts = (const unsigned*)(c.ws + WS_CTL) + CW_COUNTS;
    int* pc = (int*)c.lds; int* base = pc + 256; int* cnt = base + 257; int* pst = cnt + 256;
    const int* eidx = (const int*)(c.ws + WS_EIDX); const float* gw = (const float*)(c.ws + WS_GATEW);
    int* stok = (int*)(c.ws + WS_SLOT_TOK); int* sasg = (int*)(c.ws + WS_SLOT_ASG); float* sgate = (float*)(c.ws + WS_SLOT_GATE);
    for (int blk = c.bid; blk < T / 128; blk += c.nb) {
        int before = 0;
        if (c.tid < NE) { pc[c.tid] = ((int)counts[c.tid] + 255) / 256 * 256; before = HIST[blk * NE + c.tid]; cnt[c.tid] = 0; }
        __syncthreads();
        if (c.tid <= NE) { int acc = 0; for (int e = 0; e < c.tid; ++e) acc += pc[e]; pst[c.tid] = acc; base[c.tid] = acc + before; }
        __syncthreads();
        for (int i = c.tid; i < 128 * TOPK; i += NTHREADS_) {
            const int a = blk * 128 * TOPK + i, e = eidx[a]; const int pos = atomicAdd(cnt + e, 1); const int slot = base[e] + pos;
            stok[slot] = a >> 3; sasg[slot] = a; sgate[slot] = gw[a]; ((int*)eidx)[a] = slot;
        }
        if (blk == 0) {
            int* te = (int*)(c.ws + WS_TILE_E);
            for (int e = c.tid; e < NE; e += NTHREADS_) for (int tl = pst[e] / 256; tl < (pst[e] + pc[e]) / 256; ++tl) te[tl] = e;
            if (c.tid == 0) ((unsigned*)(c.ws + WS_CTL))[CW_NTILES] = (unsigned)(pst[NE] / 256);
        }
        __syncthreads();
    }
}
__device__ __forceinline__ void ph_combine2(const Ctx& c, const Params& p) {
    const float* mod = (const float*)(c.ws + WS_MOD); const bf16_t* YA = (const bf16_t*)(c.ws + WS_YA); const bf16_t* YS = (const bf16_t*)(c.ws + WS_YSH); float* out = p.out;
    for (int t = c.gwave; t < T; t += c.gwaves) {
        const int b = t / SEQ;
        u32x4 y[9][2]; f32x4 xv[2][2], gv[2][2];
#pragma unroll
        for (int q = 0; q < 2; ++q) { const int col = q * 512 + c.lane * 8;
#pragma unroll
            for (int k = 0; k < 8; ++k) y[k][q] = *(const u32x4*)(YA + ((size_t)t * 8 + k) * DM + col);
            y[8][q] = *(const u32x4*)(YS + (size_t)t * DM + col);
            xv[q][0] = *(const f32x4*)(out + (size_t)t * DM + col); xv[q][1] = *(const f32x4*)(out + (size_t)t * DM + col + 4);
            gv[q][0] = *(const f32x4*)(mod + b * 6 * DM + 5 * DM + col); gv[q][1] = *(const f32x4*)(mod + b * 6 * DM + 5 * DM + col + 4); }
#pragma unroll
        for (int q = 0; q < 2; ++q) { const int col = q * 512 + c.lane * 8;
            f32x4 s0 = {0.f, 0.f, 0.f, 0.f}, s1 = {0.f, 0.f, 0.f, 0.f};
#pragma unroll
            for (int k = 0; k < 9; ++k) { const u32x4 w = y[k][q];
                s0[0] += __uint_as_float(w.x << 16); s0[1] += __uint_as_float(w.x & 0xffff0000u); s0[2] += __uint_as_float(w.y << 16); s0[3] += __uint_as_float(w.y & 0xffff0000u);
                s1[0] += __uint_as_float(w.z << 16); s1[1] += __uint_as_float(w.z & 0xffff0000u); s1[2] += __uint_as_float(w.w << 16); s1[3] += __uint_as_float(w.w & 0xffff0000u); }
            *(f32x4*)(out + (size_t)t * DM + col) = xv[q][0] + gv[q][0] * s0; *(f32x4*)(out + (size_t)t * DM + col + 4) = xv[q][1] + gv[q][1] * s1; }
    }
}
__device__ __forceinline__ void ph_combine3(const Ctx& c, const Params& p) {
    const float* mod = (const float*)(c.ws + WS_MOD); const bf16_t* YS = (const bf16_t*)(c.ws + WS_YS); const bf16_t* YH = (const bf16_t*)(c.ws + WS_YSH); float* out = p.out;
    const int* inv = (const int*)(c.ws + WS_EIDX);
    for (int t = c.gwave; t < T; t += c.gwaves) {
        const int b = t / SEQ;
        int sl[8];
#pragma unroll
        for (int k = 0; k < 8; ++k) sl[k] = inv[t * 8 + k];
        u32x4 y[9][2]; f32x4 xv[2][2], gv[2][2];
#pragma unroll
        for (int q = 0; q < 2; ++q) { const int col = q * 512 + c.lane * 8;
#pragma unroll
            for (int k = 0; k < 8; ++k) y[k][q] = *(const u32x4*)(YS + (size_t)sl[k] * DM + col);
            y[8][q] = *(const u32x4*)(YH + (size_t)t * DM + col);
            xv[q][0] = *(const f32x4*)(out + (size_t)t * DM + col); xv[q][1] = *(const f32x4*)(out + (size_t)t * DM + col + 4);
            gv[q][0] = *(const f32x4*)(mod + b * 6 * DM + 5 * DM + col); gv[q][1] = *(const f32x4*)(mod + b * 6 * DM + 5 * DM + col + 4); }
#pragma unroll
        for (int q = 0; q < 2; ++q) { const int col = q * 512 + c.lane * 8;
            f32x4 s0 = {0.f, 0.f, 0.f, 0.f}, s1 = {0.f, 0.f, 0.f, 0.f};
#pragma unroll
            for (int k = 0; k < 9; ++k) { const u32x4 w = y[k][q];
                s0[0] += __uint_as_float(w.x << 16); s0[1] += __uint_as_float(w.x & 0xffff0000u); s0[2] += __uint_as_float(w.y << 16); s0[3] += __uint_as_float(w.y & 0xffff0000u);
                s1[0] += __uint_as_float(w.z << 16); s1[1] += __uint_as_float(w.z & 0xffff0000u); s1[2] += __uint_as_float(w.w << 16); s1[3] += __uint_as_float(w.w & 0xffff0000u); }
            *(f32x4*)(out + (size_t)t * DM + col) = xv[q][0] + gv[q][0] * s0; *(f32x4*)(out + (size_t)t * DM + col + 4) = xv[q][1] + gv[q][1] * s1; }
    }
}
__device__ __forceinline__ void ph_combine4(const Ctx& c, const Params& p) {
    const float* mod = (const float*)(c.ws + WS_MOD); const unsigned char* YS = c.ws + WS_YS; const bf16_t* YH = (const bf16_t*)(c.ws + WS_YSH); float* out = p.out;
    const int* inv = (const int*)(c.ws + WS_EIDX);
    typedef float f32x2 __attribute__((ext_vector_type(2)));
    for (int t = c.gwave; t < T; t += c.gwaves) {
        const int b = t / SEQ, col = c.lane * 16;
        int sl[8];
#pragma unroll
        for (int k = 0; k < 8; ++k) sl[k] = inv[t * 8 + k];
        u32x4 y[8], yh[2]; f32x4 xv[4], gv[4];
#pragma unroll
        for (int k = 0; k < 8; ++k) y[k] = *(const u32x4*)(YS + (size_t)sl[k] * DM + col);
#pragma unroll
        for (int q = 0; q < 2; ++q) yh[q] = *(const u32x4*)(YH + (size_t)t * DM + col + 8 * q);
#pragma unroll
        for (int q = 0; q < 4; ++q) { xv[q] = *(const f32x4*)(out + (size_t)t * DM + col + 4 * q); gv[q] = *(const f32x4*)(mod + b * 6 * DM + 5 * DM + col + 4 * q); }
        float sacc[16];
#pragma unroll
        for (int i = 0; i < 16; ++i) sacc[i] = 0.f;
#pragma unroll
        for (int k = 0; k < 8; ++k) { const unsigned* wp = (const unsigned*)&y[k];
#pragma unroll
            for (int i = 0; i < 4; ++i) { const f32x2 lo = __builtin_amdgcn_cvt_pk_f32_fp8((int)wp[i], false), hi2 = __builtin_amdgcn_cvt_pk_f32_fp8((int)wp[i], true);
                sacc[4 * i] += lo[0]; sacc[4 * i + 1] += lo[1]; sacc[4 * i + 2] += hi2[0]; sacc[4 * i + 3] += hi2[1]; } }
#pragma unroll
        for (int q = 0; q < 2; ++q) { const unsigned* wp = (const unsigned*)&yh[q];
#pragma unroll
            for (int i = 0; i < 4; ++i) { sacc[8 * q + 2 * i] = sacc[8 * q + 2 * i] * (1.f / Y8_SCALE) + __uint_as_float(wp[i] << 16); sacc[8 * q + 2 * i + 1] = sacc[8 * q + 2 * i + 1] * (1.f / Y8_SCALE) + __uint_as_float(wp[i] & 0xffff0000u); } }
#pragma unroll
        for (int q = 0; q < 4; ++q) { f32x4 o = xv[q]; o[0] += gv[q][0] * sacc[4 * q]; o[1] += gv[q][1] * sacc[4 * q + 1]; o[2] += gv[q][2] * sacc[4 * q + 2]; o[3] += gv[q][3] * sacc[4 * q + 3];
            *(f32x4*)(out + (size_t)t * DM + col + 4 * q) = o; }
    }
}
__device__ __forceinline__ void ph_combine5(const Ctx& c, const Params& p) {
    const float* mod = (const float*)(c.ws + WS_MOD); const unsigned char* YS = c.ws + WS_YS; const bf16_t* YH = (const bf16_t*)(c.ws + WS_YSH); float* out = p.out;
    const int* inv = (const int*)(c.ws + WS_EIDX); const float* gwp = (const float*)(c.ws + WS_GATEW);
    typedef float f32x2 __attribute__((ext_vector_type(2)));
    for (int t = c.gwave; t < T; t += c.gwaves) {
        const int b = t / SEQ, col = c.lane * 16;
        int sl[8]; float gk[8];
#pragma unroll
        for (int k = 0; k < 8; ++k) { sl[k] = inv[t * 8 + k]; gk[k] = gwp[t * 8 + k]; }
        u32x4 y[8], yh[2]; f32x4 xv[4], gv[4];
#pragma unroll
        for (int k = 0; k < 8; ++k) y[k] = *(const u32x4*)(YS + (size_t)sl[k] * DM + col);
#pragma unroll
        for (int q = 0; q < 2; ++q) yh[q] = *(const u32x4*)(YH + (size_t)t * DM + col + 8 * q);
#pragma unroll
        for (int q = 0; q < 4; ++q) { xv[q] = *(const f32x4*)(out + (size_t)t * DM + col + 4 * q); gv[q] = *(const f32x4*)(mod + b * 6 * DM + 5 * DM + col + 4 * q); }
        float sacc[16];
#pragma unroll
        for (int i = 0; i < 16; ++i) sacc[i] = 0.f;
#pragma unroll
        for (int k = 0; k < 8; ++k) { const unsigned* wp = (const unsigned*)&y[k];
#pragma unroll
            for (int i = 0; i < 4; ++i) { const f32x2 lo = __builtin_amdgcn_cvt_pk_f32_fp8((int)wp[i], false), hi2 = __builtin_amdgcn_cvt_pk_f32_fp8((int)wp[i], true);
                sacc[4 * i] += gk[k] * lo[0]; sacc[4 * i + 1] += gk[k] * lo[1]; sacc[4 * i + 2] += gk[k] * hi2[0]; sacc[4 * i + 3] += gk[k] * hi2[1]; } }
#pragma unroll
        for (int q = 0; q < 2; ++q) { const unsigned* wp = (const unsigned*)&yh[q];
#pragma unroll
            for (int i = 0; i < 4; ++i) { sacc[8 * q + 2 * i] = sacc[8 * q + 2 * i] * (1.f / Y8_SCALE) + __uint_as_float(wp[i] << 16); sacc[8 * q + 2 * i + 1] = sacc[8 * q + 2 * i + 1] * (1.f / Y8_SCALE) + __uint_as_float(wp[i] & 0xffff0000u); } }
#pragma unroll
        for (int q = 0; q < 4; ++q) { f32x4 o = xv[q]; o[0] += gv[q][0] * sacc[4 * q]; o[1] += gv[q][1] * sacc[4 * q + 1]; o[2] += gv[q][2] * sacc[4 * q + 2]; o[3] += gv[q][3] * sacc[4 * q + 3];
            *(f32x4*)(out + (size_t)t * DM + col + 4 * q) = o; }
    }
}
__device__ __forceinline__ void cpowi(float ar, float ai, int n, float& pr, float& pi) { pr = 1.f; pi = 0.f; for (int i = 0; i < n; ++i) { const float t = pr * ar - pi * ai; pi = pr * ai + pi * ar; pr = t; } }
__device__ __forceinline__ void ph_ssm_gen(const Ctx& c, const Params& p) {
    const float* sp = (const float*)(c.ws + WS_SSMP);
    const float* bbr = sp + 2 * SG * SP, * bbi = bbr + SG * SP * SC; const float* PWg = (const float*)(c.ws + WS_SSMPW);
    bf16_t* BA = (bf16_t*)(c.ws + WS_SSM_BA); bf16_t* BC = (bf16_t*)(c.ws + WS_SSM_BC);
    float* Lpw = c.lds; float* Lbb = Lpw + SP * 34; float* Lcc = Lbb + SP * 32;
    for (int w = c.bid; w < SG * 8; w += c.nb) {
        const int g = w & 31, part = w >> 5;
        __syncthreads();
        for (int i = c.tid; i < SP * 34; i += NTHREADS_) Lpw[i] = PWg[(size_t)g * SP * 34 + i];
        for (int i = c.tid; i < SP * 16; i += NTHREADS_) { Lbb[2 * i] = bbr[g * SP * SC + i]; Lbb[2 * i + 1] = bbi[g * SP * SC + i]; }
        for (int i = c.tid; i < 16 * SP; i += NTHREADS_) { Lcc[2 * i] = p.in[I_CRE][g * SC * SP + i]; Lcc[2 * i + 1] = p.in[I_CIM][g * SC * SP + i]; }
        __syncthreads();
        bf16_t* baseC = BC + (size_t)g * 256 * APK; bf16_t* baseA = BA + (size_t)g * 256 * 256;
        { const int idx = part * 512 + c.tid, ci = idx & 15, co = (idx >> 4) & 15, d = idx >> 8;
          float kv = 0.f;
#pragma unroll 8
          for (int pp = 0; pp < SP; ++pp) { const float pr = Lpw[pp * 34 + 2 * d], pi = Lpw[pp * 34 + 2 * d + 1], br = Lbb[(pp * 16 + ci) * 2], bi = Lbb[(pp * 16 + ci) * 2 + 1];
              const float tr = pr * br - pi * bi, ti = pr * bi + pi * br;
              kv += Lcc[(co * SP + pp) * 2] * tr - Lcc[(co * SP + pp) * 2 + 1] * ti; }
          if (d == 0 && co == ci) kv += p.in[I_SD][g * SC + co];
          const bf16_t kb = f2bf(kv);
          for (int j = 0; j + d < 16; ++j) { baseC[((j + d) * 16 + co) * APK + j * 16 + ci] = kb; if (d > 0) baseC[(j * 16 + co) * APK + (j + d) * 16 + ci] = 0; } }
        for (int q = c.tid; q < 2048; q += NTHREADS_) { const int idx = part * 2048 + q;
            { const int pp = idx & 63, co = (idx >> 6) & 15, jp = idx >> 10;
              const float pr = Lpw[pp * 34 + 2 * (jp + 1)], pi = Lpw[pp * 34 + 2 * (jp + 1) + 1], cr = Lcc[(co * SP + pp) * 2], ci2 = Lcc[(co * SP + pp) * 2 + 1];
              bf16_t* row = baseC + (size_t)(jp * 16 + co) * APK + 256;
              row[pp] = f2bf(cr * pr - ci2 * pi); row[64 + pp] = f2bf(-(cr * pi + ci2 * pr)); }
            { const int ci = idx & 15, j = (idx >> 4) & 15, pp = idx >> 8;
              const float pr = Lpw[pp * 34 + 2 * (15 - j)], pi = Lpw[pp * 34 + 2 * (15 - j) + 1], br = Lbb[(pp * 16 + ci) * 2], bi = Lbb[(pp * 16 + ci) * 2 + 1];
              baseA[pp * 256 + j * 16 + ci] = f2bf(pr * br - pi * bi); baseA[(64 + pp) * 256 + j * 16 + ci] = f2bf(pr * bi + pi * br); } }
        for (int q = c.tid; q < 512; q += NTHREADS_) *(u32x4*)(baseA + 128 * 256 + (part * 512 + q) * 8) = (u32x4){0u, 0u, 0u, 0u};
    }
    __syncthreads();
}
__device__ __forceinline__ void ph_ssm_scan(const Ctx& c, const Params& p, int vcu) {
    const float* sp = (const float*)(c.ws + WS_SSMP); const float* abr = sp, * abi = sp + SG * SP;
    const float* DS = (const float*)(c.ws + WS_DS); bf16_t* AP = (bf16_t*)(c.ws + WS_AP);
    float* fw = c.lds;
    for (int it = vcu; it < NB * SG; it += c.nb) {
        const int g = it >> 3, b = it & 7, pp = c.lane, w = c.wave;
        const size_t r0 = (size_t)g * (NB * NCHUNK) + b * NCHUNK + 32 * w;
        float ar = abr[g * SP + pp], ai = abi[g * SP + pp];
#pragma unroll
        for (int i = 0; i < 4; ++i) { const float t = ar * ar - ai * ai; ai = 2.f * ar * ai; ar = t; }
        float lr[32], li[32];
#pragma unroll
        for (int i = 0; i < 32; ++i) { lr[i] = DS[(r0 + i) * 128 + pp]; li[i] = DS[(r0 + i) * 128 + 64 + pp]; }
#pragma unroll
        for (int i = 1; i < 32; ++i) { const float nr = ar * lr[i - 1] - ai * li[i - 1] + lr[i], ni = ar * li[i - 1] + ai * lr[i - 1] + li[i]; lr[i] = nr; li[i] = ni; }
        __syncthreads();
        fw[(w * 64 + pp) * 2] = lr[31]; fw[(w * 64 + pp) * 2 + 1] = li[31];
        __syncthreads();
        float a32r = ar, a32i = ai;
#pragma unroll
        for (int i = 0; i < 5; ++i) { const float t = a32r * a32r - a32i * a32i; a32i = 2.f * a32r * a32i; a32r = t; }
        float cr = 0.f, ci = 0.f;
        for (int w2 = 0; w2 < w; ++w2) { const float fr_ = fw[(w2 * 64 + pp) * 2], fi_ = fw[(w2 * 64 + pp) * 2 + 1];
            const float nr = a32r * cr - a32i * ci + fr_, ni = a32r * ci + a32i * cr + fi_; cr = nr; ci = ni; }
        bf16_t* row = AP + r0 * APK + 256 + pp;
#pragma unroll
        for (int i = 0; i < 32; ++i) {
            const float sr = cr + (i ? lr[i - 1] : 0.f), si = ci + (i ? li[i - 1] : 0.f);
            row[0] = f2bf(sr); row[64] = f2bf(si);
            row += APK; asm volatile("" : "+v"(row));
            const float nr = ar * cr - ai * ci, ni = ar * ci + ai * cr; cr = nr; ci = ni;
        }
    }
}

namespace att {
typedef short bf16x8 __attribute__((ext_vector_type(8)));
typedef short s16x4 __attribute__((ext_vector_type(4)));
typedef float f32x16 __attribute__((ext_vector_type(16)));
constexpr int NW = 8, QBLK = 32, KVBLK = 64, QB = 128, NQB = SEQ / QB;
constexpr int KP = 1024, VP = 512;
constexpr int SHM_V = KVBLK * 128 * 2, SHM_K = KVBLK * 128 * 2;
constexpr int LDS_WS = 2 * SHM_V + 2 * SHM_K, LDS_EX = LDS_WS + NW * 64 * 4, LDS_END = LDS_EX + 4 * 16384;
#define KSWZ(row, colB) ((row) * 256 + ((colB) ^ (((row) & 7) << 4)))
#define SBAR() __builtin_amdgcn_sched_barrier(0)
__device__ __forceinline__ int v_st(int k, int c) { const int kk = (k & ~0xC) | ((k & 4) << 1) | ((k & 8) >> 1); return ((kk >> 3) * 4 + (c >> 5)) * 512 + ((kk & 7) * 32 + (c & 31)) * 2; }
__device__ __forceinline__ int v_rd_base(int lane) { return ((lane & 3) << 3) | (((lane >> 2) & 3) << 6) | (((lane >> 4) & 1) << 5) | (((lane >> 5) & 1) << 8); }
constexpr int v_rd_off(int d0, int ks, int half) { return d0 * 512 + ks * 4096 + half * 2048; }
__device__ __forceinline__ int crow(int r, int hi) { return (r & 3) + 8 * (r >> 2) + 4 * hi; }
__device__ __forceinline__ unsigned cvtpk(float lo, float hi) { unsigned r; asm volatile("v_cvt_pk_bf16_f32 %0, %1, %2" : "=v"(r) : "v"(lo), "v"(hi)); return r; }
__device__ __forceinline__ void mask_tile(f32x16& p0, f32x16& p1, int dq) {
    const float NEG = -__builtin_inff();
#pragma unroll
    for (int r = 0; r < 16; ++r) { const int c = (r & 3) + 8 * (r >> 2); if (dq - c < 0) p0[r] = NEG; if (dq - c - 32 < 0) p1[r] = NEG; }
}
template <bool ZC>
__device__ __forceinline__ void partialSM(f32x16& p0, f32x16& p1, float C2, float negM) {
    if constexpr (!ZC) {
#pragma unroll
        for (int r = 0; r < 16; ++r) { p0[r] += negM; p1[r] += negM; } }
#pragma unroll
    for (int r = 0; r < 16; ++r) p0[r] = __builtin_amdgcn_exp2f(p0[r]);
}
__device__ __forceinline__ void finishSM(f32x16& p0, f32x16& p1, float& l_reg, bf16x8& pa0, bf16x8& pa1, bf16x8& pa2, bf16x8& pa3) {
#pragma unroll
    for (int r = 0; r < 16; ++r) p1[r] = __builtin_amdgcn_exp2f(p1[r]);
    float ps = 0;
#pragma unroll
    for (int r = 0; r < 16; ++r) ps += p0[r];
#pragma unroll
    for (int r = 0; r < 16; ++r) ps += p1[r];
    { auto rr = __builtin_amdgcn_permlane32_swap(__float_as_uint(ps), __float_as_uint(ps), false, false); ps = __uint_as_float(rr[0]) + __uint_as_float(rr[1]); }
    l_reg += ps;
#define PK4(P, B_, OUT) do { unsigned a0 = cvtpk(P[B_+0], P[B_+1]), a1 = cvtpk(P[B_+2], P[B_+3]);                          \
        unsigned b0 = cvtpk(P[B_+4], P[B_+5]), b1 = cvtpk(P[B_+6], P[B_+7]);                                             \
        auto r0 = __builtin_amdgcn_permlane32_swap(a0, b0, false, false); auto r1 = __builtin_amdgcn_permlane32_swap(a1, b1, false, false); \
        u32x4 w = {r0[0], r1[0], r0[1], r1[1]}; OUT = *reinterpret_cast<bf16x8*>(&w); } while (0)
    PK4(p0, 0, pa0); PK4(p0, 8, pa1); PK4(p1, 0, pa2); PK4(p1, 8, pa3);
#undef PK4
}
template <int KB>
__device__ __forceinline__ void qkt(f32x16& p0, f32x16& p1, const char* K_lds, int r32, int hi, const bf16x8* qr, int cc) {
    p0 = f32x16{}; p1 = f32x16{};
    const char* kb[4];
#pragma unroll
    for (int dd = 0; dd < 4; ++dd) kb[dd] = K_lds + KB * SHM_K + KSWZ(r32, (dd * 16 + hi * 8) * 2) + cc * 128;
#pragma unroll
    for (int d0 = 0; d0 < 4; ++d0) { const char* a = kb[d0];
        bf16x8 b0 = *reinterpret_cast<const bf16x8*>(a);
        bf16x8 b1 = *reinterpret_cast<const bf16x8*>(a + 32 * 256);
        p0 = __builtin_amdgcn_mfma_f32_32x32x16_bf16(b0, qr[d0], p0, 0, 0, 0);
        p1 = __builtin_amdgcn_mfma_f32_32x32x16_bf16(b1, qr[d0], p1, 0, 0, 0); }
}
template <int VB>
__device__ __forceinline__ void pv_tile(f32x16* o, int vb0, bf16x8 pa0, bf16x8 pa1, bf16x8 pa2, bf16x8 pa3) {
#define TRRD(dst, off) asm volatile("ds_read_b64_tr_b16 %0, %1 offset:%2" : "=&v"(dst) : "v"(vb0), "i"(off) : "memory")
#define PV_D0(d0) do { s16x4 l0, l1, l2, l3, h0, h1, h2, h3; constexpr int b_ = VB * SHM_V + v_rd_off(d0, 0, 0); \
        TRRD(l0, b_); TRRD(h0, b_ + 2048); TRRD(l1, b_ + 4096); TRRD(h1, b_ + 6144); TRRD(l2, b_ + 8192); TRRD(h2, b_ + 10240); TRRD(l3, b_ + 12288); TRRD(h3, b_ + 14336); \
        asm volatile("s_waitcnt lgkmcnt(0)" ::: "memory"); SBAR();   \
        o[d0] = __builtin_amdgcn_mfma_f32_32x32x16_bf16(pa0, (bf16x8){l0[0], l0[1], l0[2], l0[3], h0[0], h0[1], h0[2], h0[3]}, o[d0], 0, 0, 0);   \
        o[d0] = __builtin_amdgcn_mfma_f32_32x32x16_bf16(pa1, (bf16x8){l1[0], l1[1], l1[2], l1[3], h1[0], h1[1], h1[2], h1[3]}, o[d0], 0, 0, 0);   \
        o[d0] = __builtin_amdgcn_mfma_f32_32x32x16_bf16(pa2, (bf16x8){l2[0], l2[1], l2[2], l2[3], h2[0], h2[1], h2[2], h2[3]}, o[d0], 0, 0, 0);   \
        o[d0] = __builtin_amdgcn_mfma_f32_32x32x16_bf16(pa3, (bf16x8){l3[0], l3[1], l3[2], l3[3], h3[0], h3[1], h3[2], h3[3]}, o[d0], 0, 0, 0); } while (0)
    PV_D0(0); PV_D0(1); PV_D0(2); PV_D0(3);
#undef PV_D0
#undef TRRD
}
struct BlockRef { const bf16_t* Q; const bf16_t* K; const bf16_t* V; bf16_t* O; int P0; };
struct Seam { bf16x8 qr[4]; bf16x8 st_v0, st_v1, st_k0, st_k1; };
#define ROWK(p, k0, rr) ((p) + (size_t)((k0) + (rr)) * KP + sc)
#define ROWV(p, k0, rr) ((p) + (size_t)((k0) + (rr)) * VP + sc)
#define LD8(ptr) (*reinterpret_cast<const bf16x8*>(ptr))
#define VMW() asm volatile("s_waitcnt vmcnt(0)" ::: "memory")
#define VMWN(n) asm volatile("s_waitcnt vmcnt(%0)" :: "i"(n) : "memory")
#define SLOAD_H(Kp, Vp, k0) do { S.st_v0 = LD8(ROWV(Vp, k0, sr)); S.st_v1 = LD8(ROWV(Vp, k0, 32 + sr)); S.st_k0 = LD8(ROWK(Kp, k0, sr)); S.st_k1 = LD8(ROWK(Kp, k0, 32 + sr)); } while (0)
#define SWRITE_HK(bf) do { *(bf16x8*)(K_lds + (bf) * SHM_K + kws) = S.st_k0; *(bf16x8*)(K_lds + (bf) * SHM_K + kws + 32 * 256) = S.st_k1; } while (0)
#define SWRITE_HV(bf) do { *(bf16x8*)(V_lds + (bf) * SHM_V + vst0) = S.st_v0; *(bf16x8*)(V_lds + (bf) * SHM_V + vst1) = S.st_v1; } while (0)
#define SWRITE_H(bf) do { SWRITE_HV(bf); SWRITE_HK(bf); } while (0)
#define QLOAD(ref) do { _Pragma("unroll") for (int d0 = 0; d0 < 4; ++d0) S.qr[d0] = LD8((ref).Q + (size_t)(qi * QBLK + r32) * KP + cc * 64 + d0 * 16 + hi * 8); } while (0)
__device__ __forceinline__ void prime(const BlockRef& cur, char* lds, Seam& S, int tid) {
    const int  wid = __builtin_amdgcn_readfirstlane(tid >> 6), lane = tid & 63, r32 = lane & 31, hi = lane >> 5, qi = wid >> 1, cc = wid & 1;
    const int sr = tid >> 4, sc = (tid & 15) * 8, kws = KSWZ(sr, sc * 2); char* K_lds = lds + 2 * SHM_V;
    QLOAD(cur);
    SLOAD_H(cur.K, cur.V, 0); VMW(); SWRITE_HK(0);
    __syncthreads();
}
template <bool ZC, int ORD>
__device__ __forceinline__ void block(const BlockRef& cur, const BlockRef& nxt, char* lds, Seam& S, float lam, float smax, const float* subg, bool lastblk, int tid) {
    const int  wid = __builtin_amdgcn_readfirstlane(tid >> 6), lane = tid & 63, r32 = lane & 31, hi = lane >> 5, qi = wid >> 1, cc = wid & 1;
    const int NT = cur.P0 / KVBLK + 2;
    const int qlo = cur.P0 + qi * QBLK, qm = qlo + r32 - 4 * hi;
    char* V_lds = lds; char* K_lds = lds + 2 * SHM_V;
    float* wsf = (float*)(lds + LDS_WS) + wid * 64; float* li_l = wsf;
    float* exch = (float*)(lds + LDS_EX) + qi * 4096;
    float l_reg = 0; f32x16 o[4] = {};
    const int sr = tid >> 4, sc = (tid & 15) * 8, vst0 = v_st(sr, sc), vst1 = v_st(32 + sr, sc), kws = KSWZ(sr, sc * 2);
    const int vb0 = (int)(uintptr_t)V_lds + v_rd_base(lane);
    const bf16_t* Kh = cur.K; const bf16_t* Vh = cur.V;
    constexpr float C2 = 1.4426950408889634f * 0.125f; const float negM = -smax * 1.4426950408889634f;
#define KBASE(t) ((t) * KVBLK)
#define MASKT(P0_, P1_, t) do { const int kb_ = KBASE(t); if (kb_ + KVBLK - 1 > qlo) mask_tile(P0_, P1_, qm - kb_); } while (0)
    f32x16 pA0, pA1, pB0, pB1; bf16x8 pa0, pa1, pa2, pa3;
    SWRITE_HV(0); SBAR();
    SLOAD_H(Kh, Vh, KBASE(1));
    SBAR(); qkt<0>(pA0, pA1, K_lds, r32, hi, S.qr, cc);
    MASKT(pA0, pA1, 0); partialSM<ZC>(pA0, pA1, C2, negM);
    VMW(); SWRITE_H(1);
    __syncthreads();
#define HALF_STEP(ORD, PX0, PX1, PY0, PY1, t, KB, VB, SB) do {                                                 \
        SBAR();                                                                                                \
        if constexpr (ORD == 0) { qkt<KB>(PX0, PX1, K_lds, r32, hi, S.qr, cc); SBAR(); finishSM(PY0, PY1, l_reg, pa0, pa1, pa2, pa3); }     \
        else { finishSM(PY0, PY1, l_reg, pa0, pa1, pa2, pa3); SBAR(); qkt<KB>(PX0, PX1, K_lds, r32, hi, S.qr, cc); }              \
        SBAR();                                                                                                \
        if ((t) + 1 < NT) { SLOAD_H(Kh, Vh, KBASE((t) + 1)); SBAR(); }                                        \
        if constexpr (ORD == 0) { pv_tile<VB>(o, vb0, pa0, pa1, pa2, pa3); SBAR(); MASKT(PX0, PX1, (t)); partialSM<ZC>(PX0, PX1, C2, negM); }   \
        else { MASKT(PX0, PX1, (t)); partialSM<ZC>(PX0, PX1, C2, negM); SBAR(); pv_tile<VB>(o, vb0, pa0, pa1, pa2, pa3); }            \
        __syncthreads();                                                                                       \
        if ((t) + 1 < NT) { VMW(); SWRITE_H(SB); }                                                             \
        __syncthreads(); } while (0)
    for (int t = 1; t + 1 < NT; t += 2) {
        HALF_STEP(ORD, pB0, pB1, pA0, pA1, t, 1, 0, 0);
        HALF_STEP(ORD, pA0, pA1, pB0, pB1, t + 1, 0, 1, 1);
    }
    SBAR(); qkt<1>(pB0, pB1, K_lds, r32, hi, S.qr, cc); SBAR();
    SLOAD_H(nxt.K, nxt.V, 0); SBAR();
    QLOAD(nxt);
    SBAR();
    finishSM(pA0, pA1, l_reg, pa0, pa1, pa2, pa3); SBAR();
    pv_tile<0>(o, vb0, pa0, pa1, pa2, pa3);
    MASKT(pB0, pB1, NT - 1); partialSM<ZC>(pB0, pB1, C2, negM); __syncthreads();
    finishSM(pB0, pB1, l_reg, pa0, pa1, pa2, pa3); SBAR(); pv_tile<1>(o, vb0, pa0, pa1, pa2, pa3);
    SBAR(); VMWN(4); SWRITE_HK(0); SBAR();
    if (hi == 0) li_l[r32] = l_reg; asm volatile("s_waitcnt lgkmcnt(0)" ::: "memory");
    float rli[16];
#pragma unroll
    for (int r = 0; r < 16; ++r) rli[r] = __builtin_amdgcn_rcpf(li_l[crow(r, hi)]) * (cc ? lam : 1.f);
#pragma unroll
    for (int d0 = 0; d0 < 4; ++d0)
#pragma unroll
        for (int r = 0; r < 16; ++r) o[d0][r] *= rli[r];
    if (cc == 1) {
#pragma unroll
        for (int d0 = 0; d0 < 4; ++d0)
#pragma unroll
            for (int r = 0; r < 16; ++r) exch[(d0 * 16 + r) * 64 + lane] = o[d0][r];
    }
    __syncthreads();
    if (cc == 0) {
        float gsub[4];
#pragma unroll
        for (int d0 = 0; d0 < 4; ++d0) gsub[d0] = subg[d0 * 32 + r32] * (1.f - LAM_INIT);
        bf16_t* Ow = cur.O + (size_t)(qi * QBLK) * KP;
#pragma unroll
        for (int r = 0; r < 16; ++r) {
            float ss = 0.f;
#pragma unroll
            for (int d0 = 0; d0 < 4; ++d0) { o[d0][r] -= exch[(d0 * 16 + r) * 64 + lane]; ss += o[d0][r] * o[d0][r]; }
#pragma unroll
            for (int of = 1; of < 32; of <<= 1) ss += __shfl_xor(ss, of);
            const float rstd = rsqrtf(ss * (1.f / 128.f) + EPS); const int orow = crow(r, hi);
#pragma unroll
            for (int d0 = 0; d0 < 4; ++d0) { const float v = o[d0][r] * rstd * gsub[d0]; const float vn = __shfl_xor(v, 1);
                if ((r32 & 1) == 0) *(unsigned*)(Ow + (size_t)orow * KP + d0 * 32 + r32) = cvtpk(v, vn); }
        }
    }
    if (lastblk) __syncthreads();
#undef KBASE
#undef MASKT
#undef HALF_STEP
}
template <bool ZC = false, int ORD = 0>
__device__ __forceinline__ void phase(char* lds, const bf16_t* QKb, const bf16_t* Vb, bf16_t* MX, float lam, float smax, const float* subg, int G, int vcu, int L0 = -1, int Lend = 1 << 30) {
    constexpr int NX = NQB / 2; const int TOTAL = (NB * NH * NX) < Lend ? (NB * NH * NX) : Lend;
    int L = L0 < 0 ? vcu : L0; if (L >= TOTAL) return;
    int pass = 0;
#define MKREF(ref, LL, ps) do { const int bh_ = (LL) / NX, x_ = (LL) % NX, qb_ = (ps) ? (NQB - 1 - x_) : x_, b_ = bh_ / NH, h_ = bh_ % NH; \
        const size_t row0_ = (size_t)b_ * SEQ; (ref).P0 = qb_ * QB; \
        (ref).Q = QKb + (row0_ + qb_ * QB) * KP + h_ * 128; (ref).K = QKb + row0_ * KP + 512 + h_ * 128; (ref).V = Vb + row0_ * VP + h_ * 128; \
        (ref).O = MX + (row0_ + qb_ * QB) * KP + h_ * 128; } while (0)
    BlockRef cur, nxt; MKREF(cur, L, 0);
    Seam S;
    int tid_ = threadIdx.x; asm volatile("" : "+v"(tid_));
    prime(cur, lds, S, tid_);
    for (;;) {
        const bool more_pass = pass == 0, more_item = L + G < TOTAL, last = !more_pass && !more_item;
        int passn = pass + 1, Ln = L;
        if (!more_pass) { passn = 0; Ln = more_item ? L + G : L; }
        if (last) nxt = cur; else MKREF(nxt, Ln, passn);
        block<ZC, ORD>(cur, nxt, lds, S, lam, smax, subg, last, tid_);
        if (last) break;
        cur = nxt; pass = passn; L = Ln;
    }
#undef MKREF
}
__device__ __forceinline__ void phase_queue(char* lds, const bf16_t* QKb, const bf16_t* Vb, bf16_t* MX, float lam, float smax, const float* subg, unsigned* qctr, int xg) {
    constexpr int TOTAL = NB * NH * NQB / 8;
    volatile int* tk = (volatile int*)(lds + LDS_END);
#define MKREFQ(ref, kk) do { const int hf_ = (kk) >> 6, k6_ = (kk) & 63, bh_ = 4 * xg + 2 * hf_ + (k6_ & 1), qb_ = NQB - 1 - (k6_ >> 1), b_ = bh_ / NH, h_ = bh_ % NH; \
        const size_t row0_ = (size_t)b_ * SEQ; (ref).P0 = qb_ * QB; \
        (ref).Q = QKb + (row0_ + qb_ * QB) * KP + h_ * 128; (ref).K = QKb + row0_ * KP + 512 + h_ * 128; (ref).V = Vb + row0_ * VP + h_ * 128; \
        (ref).O = MX + (row0_ + qb_ * QB) * KP + h_ * 128; } while (0)
    if (threadIdx.x == 0) { tk[0] = (int)atomicAdd(qctr, 1u); tk[1] = (int)atomicAdd(qctr, 1u); }
    __syncthreads();
    int tc = tk[0];
    if (tc >= TOTAL) { __syncthreads(); return; }
    BlockRef cur, nxt; MKREFQ(cur, tc);
    Seam S;
    int tid_ = threadIdx.x; asm volatile("" : "+v"(tid_));
    prime(cur, lds, S, tid_);
    for (int i = 0;; ++i) {
        const int tn = tk[(i + 1) & 1];
        if (threadIdx.x == 0) tk[i & 1] = (int)atomicAdd(qctr, 1u);
        const bool last = tn >= TOTAL;
        if (last) nxt = cur; else MKREFQ(nxt, tn);
        block<false, 0>(cur, nxt, lds, S, lam, smax, subg, last, tid_);
        if (last) break;
        cur = nxt;
    }
    __syncthreads();
#undef MKREFQ
}
#undef ROWK
#undef ROWV
#undef LD8
#undef VMW
#undef VMWN
#undef SLOAD_H
#undef SWRITE_HK
#undef SWRITE_HV
#undef SWRITE_H
#undef QLOAD
#undef KSWZ
#undef SBAR
}

namespace att3 {
using att::bf16x8; using att::s16x4; using att::f32x16;
using att::crow; using att::cvtpk; using att::mask_tile; using att::partialSM; using att::finishSM; using att::v_rd_base; using att::v_rd_off;
constexpr int NW = 8, QBLK = 32, KVBLK = 64, QB = 128, NQB = SEQ / QB, KP = 1024, VP = 512;
constexpr int SLOTB = 16384, LDS_K = 0, LDS_V = 3 * SLOTB, LDS_WS = 6 * SLOTB, LDS_EX = LDS_WS + NW * 64 * 4, LDS_END = LDS_EX + 4 * 8192;
#define KSWZ(row, colB) ((row) * 256 + ((colB) ^ (((row) & 7) << 4)))
#define SBAR() __builtin_amdgcn_sched_barrier(0)
#define WAITBAR(N) asm volatile("s_waitcnt vmcnt(" #N ") lgkmcnt(0)\n\ts_barrier" ::: "memory")
typedef __attribute__((address_space(3))) unsigned las_u32;
__device__ __forceinline__ void qkt(f32x16& p0, f32x16& p1, const char* Kslot, int r32, int hi, const bf16x8* qr, int cc) {
    p0 = f32x16{}; p1 = f32x16{};
#pragma unroll
    for (int d0 = 0; d0 < 4; ++d0) { const char* a = Kslot + KSWZ(r32, (d0 * 16 + hi * 8) * 2) + cc * 128;
        bf16x8 b0 = *reinterpret_cast<const bf16x8*>(a);
        bf16x8 b1 = *reinterpret_cast<const bf16x8*>(a + 32 * 256);
        p0 = __builtin_amdgcn_mfma_f32_32x32x16_bf16(b0, qr[d0], p0, 0, 0, 0);
        p1 = __builtin_amdgcn_mfma_f32_32x32x16_bf16(b1, qr[d0], p1, 0, 0, 0); }
}
__device__ __forceinline__ void pv_tile(f32x16* o, int vb, bf16x8 pa0, bf16x8 pa1, bf16x8 pa2, bf16x8 pa3) {
#define TRRD(dst, off) asm volatile("ds_read_b64_tr_b16 %0, %1 offset:%2" : "=&v"(dst) : "v"(vb), "i"(off) : "memory")
#define PV_D0(d0) do { s16x4 l0, l1, l2, l3, h0, h1, h2, h3; constexpr int b_ = v_rd_off(d0, 0, 0); \
        TRRD(l0, b_); TRRD(h0, b_ + 2048); TRRD(l1, b_ + 4096); TRRD(h1, b_ + 6144); TRRD(l2, b_ + 8192); TRRD(h2, b_ + 10240); TRRD(l3, b_ + 12288); TRRD(h3, b_ + 14336); \
        asm volatile("s_waitcnt lgkmcnt(0)" ::: "memory"); SBAR();   \
        o[d0] = __builtin_amdgcn_mfma_f32_32x32x16_bf16(pa0, (bf16x8){l0[0], l0[1], l0[2], l0[3], h0[0], h0[1], h0[2], h0[3]}, o[d0], 0, 0, 0);   \
        o[d0] = __builtin_amdgcn_mfma_f32_32x32x16_bf16(pa1, (bf16x8){l1[0], l1[1], l1[2], l1[3], h1[0], h1[1], h1[2], h1[3]}, o[d0], 0, 0, 0);   \
        o[d0] = __builtin_amdgcn_mfma_f32_32x32x16_bf16(pa2, (bf16x8){l2[0], l2[1], l2[2], l2[3], h2[0], h2[1], h2[2], h2[3]}, o[d0], 0, 0, 0);   \
        o[d0] = __builtin_amdgcn_mfma_f32_32x32x16_bf16(pa3, (bf16x8){l3[0], l3[1], l3[2], l3[3], h3[0], h3[1], h3[2], h3[3]}, o[d0], 0, 0, 0); } while (0)
    PV_D0(0); PV_D0(1); PV_D0(2); PV_D0(3);
#undef PV_D0
#undef TRRD
}
struct BlockRef { const bf16_t* Q; const bf16_t* K; const bf16_t* V; bf16_t* O; int P0; };
struct Stream { bf16x8 qr[4]; int g; unsigned ksrc[2], vsrc[2]; };
__device__ __forceinline__ void dma_k(const Stream& S, char* lds, const bf16_t* Kh, int tile, int gg, int wid) {
    const int slot = (gg % 3) * SLOTB;
#pragma unroll
    for (int i = 0; i < 2; ++i)
        __builtin_amdgcn_global_load_lds((const unsigned*)(Kh + (size_t)tile * KVBLK * KP + S.ksrc[i]), (las_u32*)(lds + LDS_K + slot + (wid + 8 * i) * 1024), 16, 0, 0);
}
__device__ __forceinline__ void dma_v(const Stream& S, char* lds, const bf16_t* Vh, int tile, int gg, int wid) {
    const int slot = (gg % 3) * SLOTB;
#pragma unroll
    for (int i = 0; i < 2; ++i)
        __builtin_amdgcn_global_load_lds((const unsigned*)(Vh + (size_t)tile * KVBLK * VP + S.vsrc[i]), (las_u32*)(lds + LDS_V + slot + (wid + 8 * i) * 1024), 16, 0, 0);
}
__device__ __forceinline__ void stream_init(Stream& S, int lane, int wid) {
#pragma unroll
    for (int i = 0; i < 2; ++i) { const int pk = wid + 8 * i;
        { const int row = 4 * pk + (lane >> 4), ch = (lane & 15) ^ (row & 7); S.ksrc[i] = (unsigned)(row * KP + ch * 8); }
        { const int o = lane * 16, sub = 2 * pk + (o >> 9), within = o & 511, kk = (sub >> 2) * 8 + (within >> 6), cN = (sub & 3) * 32 + ((within & 63) >> 1);
          const int k = (kk & ~0xC) | ((kk & 4) << 1) | ((kk & 8) >> 1); S.vsrc[i] = (unsigned)(k * VP + cN); } }
    S.g = 0;
}
#define LD8(ptr) (*reinterpret_cast<const bf16x8*>(ptr))
#define QLOAD(ref) do { _Pragma("unroll") for (int d0 = 0; d0 < 4; ++d0) S.qr[d0] = LD8((ref).Q + (size_t)(qi * QBLK + r32) * KP + cc * 64 + d0 * 16 + hi * 8); } while (0)
__device__ __forceinline__ void prime(const BlockRef& cur, char* lds, Stream& S) {
    const int tid = threadIdx.x, wid = __builtin_amdgcn_readfirstlane(tid >> 6), lane = tid & 63, r32 = lane & 31, hi = lane >> 5, qi = wid >> 1, cc = wid & 1;
    stream_init(S, lane, wid);
    QLOAD(cur);
    dma_k(S, lds, cur.K, 0, 0, wid); dma_k(S, lds, cur.K, 1, 1, wid); dma_v(S, lds, cur.V, 0, 0, wid);
    asm volatile("s_waitcnt vmcnt(0) lgkmcnt(0)\n\ts_barrier" ::: "memory");
}
__device__ __forceinline__ void block(const BlockRef& cur, const BlockRef& nxt, char* lds, Stream& S, float lam, float smax, const float* subg) {
    const int tid = threadIdx.x, wid = __builtin_amdgcn_readfirstlane(tid >> 6), lane = tid & 63, r32 = lane & 31, hi = lane >> 5, qi = wid >> 1, cc = wid & 1;
    const int NT = cur.P0 / KVBLK + 2;
    const int qlo = cur.P0 + qi * QBLK, qm = qlo + r32 - 4 * hi, g0 = __builtin_amdgcn_readfirstlane(S.g);
    float* wsf = (float*)(lds + LDS_WS) + wid * 64; float* li_l = wsf;
    unsigned* exch = (unsigned*)(lds + LDS_EX) + qi * 2048;
    float l_reg = 0; f32x16 o[4] = {};
    const int vrb = (int)(uintptr_t)(lds + LDS_V) + v_rd_base(lane);
    constexpr float C2 = 1.4426950408889634f * 0.125f; const float negM = -smax * 1.4426950408889634f;
    { asm volatile("" : "+v"(S.qr[0]), "+v"(S.qr[1]), "+v"(S.qr[2]), "+v"(S.qr[3])); }
#define KBASE(t) ((t) * KVBLK)
#define MASKT(P0_, P1_, t) do { const int kb_ = KBASE(t); if (kb_ + KVBLK - 1 > qlo) mask_tile(P0_, P1_, qm - kb_); } while (0)
#define KSLOT(t) (lds + LDS_K + ((g0 + (t)) % 3) * SLOTB)
#define VBASE(t) (vrb + ((g0 + (t)) % 3) * SLOTB)
#define ISSUE(t) do { const int tk_ = (t) + 2, tv_ = (t) + 1;                                            \
        if (tk_ < NT) dma_k(S, lds, cur.K, tk_, g0 + tk_, wid); else dma_k(S, lds, nxt.K, tk_ - NT, g0 + tk_, wid);                \
        if (tv_ < NT) dma_v(S, lds, cur.V, tv_, g0 + tv_, wid); else dma_v(S, lds, nxt.V, tv_ - NT, g0 + tv_, wid); } while (0)
    f32x16 pA0, pA1, pB0, pB1; bf16x8 pa0, pa1, pa2, pa3;
    ISSUE(0); SBAR();
    qkt(pA0, pA1, KSLOT(0), r32, hi, S.qr, cc);
    MASKT(pA0, pA1, 0); partialSM<false>(pA0, pA1, C2, negM);
    WAITBAR(4);
#define STEP(PX0, PX1, PY0, PY1, t) do {                                                                        \
        ISSUE(t); SBAR();                                                                                      \
        qkt(PX0, PX1, KSLOT(t), r32, hi, S.qr, cc);                                                            \
        finishSM(PY0, PY1, l_reg, pa0, pa1, pa2, pa3); SBAR();                                                 \
        pv_tile(o, VBASE((t) - 1), pa0, pa1, pa2, pa3); MASKT(PX0, PX1, (t)); partialSM<false>(PX0, PX1, C2, negM);    \
        WAITBAR(4); } while (0)
    for (int t = 1; t + 1 < NT; t += 2) {
        STEP(pB0, pB1, pA0, pA1, t);
        STEP(pA0, pA1, pB0, pB1, t + 1);
    }
    STEP(pB0, pB1, pA0, pA1, NT - 1);
    QLOAD(nxt); SBAR();
    finishSM(pB0, pB1, l_reg, pa0, pa1, pa2, pa3); SBAR();
    pv_tile(o, VBASE(NT - 1), pa0, pa1, pa2, pa3);
    S.g = (g0 + NT) % 3;
    if (hi == 0) li_l[r32] = l_reg; asm volatile("s_waitcnt lgkmcnt(0)" ::: "memory");
    float rli[16];
#pragma unroll
    for (int r = 0; r < 16; ++r) rli[r] = __builtin_amdgcn_rcpf(li_l[crow(r, hi)]) * (cc ? lam : 1.f);
#pragma unroll
    for (int d0 = 0; d0 < 4; ++d0)
#pragma unroll
        for (int r = 0; r < 16; ++r) o[d0][r] *= rli[r];
    if (cc == 1) {
#pragma unroll
        for (int d0 = 0; d0 < 4; ++d0)
#pragma unroll
            for (int r = 0; r < 16; r += 2) exch[(d0 * 8 + (r >> 1)) * 64 + lane] = cvtpk(o[d0][r], o[d0][r + 1]);
    }
    asm volatile("s_waitcnt vmcnt(0) lgkmcnt(0)\n\ts_barrier" ::: "memory");
    if (cc == 0) {
        float gsub[4];
#pragma unroll
        for (int d0 = 0; d0 < 4; ++d0) gsub[d0] = subg[d0 * 32 + r32] * (1.f - LAM_INIT);
        bf16_t* Ow = cur.O + (size_t)(qi * QBLK) * KP;
#pragma unroll
        for (int r = 0; r < 16; r += 2) {
            float ss0 = 0.f, ss1 = 0.f;
#pragma unroll
            for (int d0 = 0; d0 < 4; ++d0) { const unsigned w = exch[(d0 * 8 + (r >> 1)) * 64 + lane];
                o[d0][r] -= __uint_as_float(w << 16); o[d0][r + 1] -= __uint_as_float(w & 0xffff0000u); ss0 += o[d0][r] * o[d0][r]; ss1 += o[d0][r + 1] * o[d0][r + 1]; }
#pragma unroll
            for (int of = 1; of < 32; of <<= 1) { ss0 += __shfl_xor(ss0, of); ss1 += __shfl_xor(ss1, of); }
            const float rs0 = rsqrtf(ss0 * (1.f / 128.f) + EPS), rs1 = rsqrtf(ss1 * (1.f / 128.f) + EPS);
#pragma unroll
            for (int e = 0; e < 2; ++e) { const int orow = crow(r + e, hi); const float rs = e ? rs1 : rs0;
#pragma unroll
                for (int d0 = 0; d0 < 4; ++d0) { const float v = o[d0][r + e] * rs * gsub[d0]; const float vn = __shfl_xor(v, 1);
                    if ((r32 & 1) == 0) *(unsigned*)(Ow + (size_t)orow * KP + d0 * 32 + r32) = cvtpk(v, vn); } }
        }
    }
#undef KBASE
#undef MASKT
#undef KSLOT
#undef VBASE
#undef ISSUE
#undef STEP
}
__device__ __forceinline__ void phase(char* lds, const bf16_t* QKb, const bf16_t* Vb, bf16_t* MX, float lam, float smax, const float* subg, int G, int L0, int Lend) {
    constexpr int NX = NQB / 2; const int TOTAL = (NB * NH * NX) < Lend ? (NB * NH * NX) : Lend;
    int L = L0; if (L >= TOTAL) return;
    int pass = 0;
#define MKREF(ref, LL, ps) do { const int bh_ = (LL) / NX, x_ = (LL) % NX, qb_ = (ps) ? (NQB - 1 - x_) : x_, b_ = bh_ / NH, h_ = bh_ % NH; \
        const size_t row0_ = (size_t)b_ * SEQ; (ref).P0 = qb_ * QB; \
        (ref).Q = QKb + (row0_ + qb_ * QB) * KP + h_ * 128; (ref).K = QKb + row0_ * KP + 512 + h_ * 128; (ref).V = Vb + row0_ * VP + h_ * 128; \
        (ref).O = MX + (row0_ + qb_ * QB) * KP + h_ * 128; } while (0)
    BlockRef cur, nxt; MKREF(cur, L, 0);
    Stream S;
    prime(cur, lds, S);
    for (;;) {
        const bool more_pass = pass == 0, more_item = L + G < TOTAL, last = !more_pass && !more_item;
        int passn = pass + 1, Ln = L;
        if (!more_pass) { passn = 0; Ln = more_item ? L + G : L; }
        if (last) nxt = cur; else MKREF(nxt, Ln, passn);
        block(cur, nxt, lds, S, lam, smax, subg);
        if (last) break;
        cur = nxt; pass = passn; L = Ln;
    }
    asm volatile("s_waitcnt vmcnt(0) lgkmcnt(0)\n\ts_barrier" ::: "memory");
#undef MKREF
}
#undef LD8
#undef QLOAD
#undef KSWZ
#undef SBAR
#undef WAITBAR
}

enum { PH_PRO = 0, PH_H1, PH_WIN, PH_WIN_F, PH_QKN, PH_ATT, PH_ATTC, PH_SSM, PH_GLU, PH_NORM, PH_WOUT, PH_WOUT_F, PH_H2, PH_RS, PH_RS2, PH_RS_F, PH_SD, PH_ROUTE, PH_SLOT, PH_E1, PH_E1_F, PH_E2, PH_COMB, PH_M_B, PH_M_D, PH_NORM2, PH_H2_2, PH_M_J2, PH_X1, PH_X2, PH_M_A2, PH_M_E3, PH_SLOT4, PH_E2S_F, PH_COMB3, PH_M_E4, PH_H2_3, PH_E1_8, PH_M_E5, PH_E1_88, PH_E2_8, PH_COMB4, PH_E2_B8, PH_E1_G8, PH_E2_P8, PH_M_J3, PH_SLOT5, PH_COMB5, PH_M_E6, PH_COUNT };
constexpr int NTHREADS = 512;
constexpr int LDS_BYTES = 147456;
constexpr int LDS_MISC_OFF = 147456 - 256;
typedef unsigned long long mask_t;
#define PHBIT(k) (1ull << (k))

template <mask_t MASK>
__global__ void __launch_bounds__(NTHREADS, 2) mega(Params p) {
    extern __shared__ __attribute__((aligned(16))) unsigned char lds_raw[];
#define MAKE_CTX() Ctx c; { int t_ = threadIdx.x; asm volatile("" : "+v"(t_)); c.tid = t_; c.lane = c.tid & 63; c.wave = __builtin_amdgcn_readfirstlane(c.tid >> 6); c.bid = blockIdx.x; c.nb = gridDim.x; \
    c.gtid = c.bid * NTHREADS + c.tid; c.gthreads = c.nb * NTHREADS; c.gwave = c.bid * (NTHREADS / 64) + c.wave; c.gwaves = c.nb * (NTHREADS / 64); c.ws = p.ws; c.lds = (float*)lds_raw; }
    unsigned char* ws = p.ws;
    PG8_LAS unsigned char* lds3 = (PG8_LAS unsigned char*)lds_raw;
    const int G = gridDim.x, bid = blockIdx.x, vcu = (G % 8 == 0) ? (bid % 8) * (G / 8) + bid / 8 : bid;
    constexpr bool MULTI = (MASK & (MASK - 1)) != 0;
    XcdBarrier bar; bar.bar = (unsigned*)(ws + WS_CTL) + CW_BAR; bar.x = 0; bar.st = nullptr;
    if constexpr (MULTI) {
        volatile LAS unsigned* misc = (volatile LAS unsigned*)(lds3 + LDS_MISC_OFF);
        if (threadIdx.x < 32) misc[threadIdx.x] = 0u;
        __syncthreads();
        bar = xcd_barrier_post((unsigned*)(ws + WS_CTL) + CW_BAR, misc + 8);
    }
    bool first = true;
#ifndef TIME_A
#define TIME_A -1
#endif
#ifndef TIME_B
#define TIME_B -1
#endif
    constexpr bool TIMING = (TIME_A >= 0) || (TIME_B >= 0);
    unsigned long long tstart = 0, t_a = 0, t_b = 0; int pidx = 0;
#define STAMP() ({ if constexpr (TIMING) { const unsigned long long now_ = __builtin_amdgcn_s_memrealtime(); \
        if (pidx > 0 && pidx - 1 == TIME_A) t_a = now_ - tstart; if (pidx > 0 && pidx - 1 == TIME_B) t_b = now_ - tstart; tstart = now_; ++pidx; } true; })
#define PHASE(k) if constexpr ((MASK >> (k)) & 1ull) if ((MULTI ? (first ? (first = false, true) : (xcd_barrier(bar), true)) : true)) if (STAMP())
    PHASE(PH_PRO) { MAKE_CTX(); ph_prologue(c, p); }
    PHASE(PH_M_A2) { MAKE_CTX(); ph_prologue2(c, p); ph_convert<false>(c, p); }
    PHASE(PH_H1) { MAKE_CTX(); ph_h1(c, p); }
    PHASE(PH_M_B) { MAKE_CTX(); ph_h1(c, p); ph_ssm_gen(c, p); }
    PHASE(PH_WIN) { MAKE_CTX(); SG_Args g{(const bf16_t*)(ws + WS_H), DM, nullptr, p.in[I_WIN], nullptr, 2048, 0, nullptr, T, 2048, DM};
        EpiWin E{(bf16_t*)(ws + WS_QK), (bf16_t*)(ws + WS_V), (bf16_t*)(ws + WS_AP)}; sgemm_phase<false>(c, g, E); }
    PHASE(PH_WIN_F) { MAKE_CTX(); pg8::Gemm g{(const bf16_t*)(ws + WS_H), (const bf16_t*)(ws + WS_WIN_T), DM, DM, nullptr}; pg8::DenseOrder S; S.init(T, 2048, G, bid);
        pg8::EpiWinF E{(bf16_t*)(ws + WS_QK), (bf16_t*)(ws + WS_V), (bf16_t*)(ws + WS_AP)}; pg8::gemm_phase<pg8::EpiWinF, pg8::DenseOrder, false, true>(lds3, g, S, E); }
    PHASE(PH_QKN) { MAKE_CTX(); ph_qkn(c, p); }
    PHASE(PH_M_D) { { MAKE_CTX(); ph_qkn2(c, p); }
        { pg8::Gemm g{(const bf16_t*)(ws + WS_AP), (const bf16_t*)(ws + WS_SSM_BA), 256, APK, nullptr}; pg8::SsmOrder S{G, vcu};
          pg8::EpiSsmA E{(float*)(ws + WS_DS)}; pg8::gemm_phase<pg8::EpiSsmA, pg8::SsmOrder, false, false>(lds3, g, S, E); }
        __builtin_amdgcn_fence(__ATOMIC_ACQUIRE, "agent"); asm volatile("s_waitcnt vmcnt(0)" ::: "memory"); __syncthreads();
        { MAKE_CTX(); ph_ssm_scan(c, p, vcu); }
        asm volatile("s_waitcnt vmcnt(0)" ::: "memory"); __syncthreads(); __builtin_amdgcn_fence(__ATOMIC_ACQUIRE, "agent"); asm volatile("s_waitcnt vmcnt(0)" ::: "memory"); __syncthreads();
        { pg8::Gemm g{(const bf16_t*)(ws + WS_AP), (const bf16_t*)(ws + WS_SSM_BC), APK, APK, nullptr}; pg8::SsmOrder S{G, vcu};
          pg8::EpiSsmC E{(bf16_t*)(ws + WS_Y)}; pg8::gemm_phase<pg8::EpiSsmC, pg8::SsmOrder, false, false>(lds3, g, S, E); } }
    PHASE(PH_ATT) { MAKE_CTX(); ph_att_base(c, p); }
    PHASE(PH_ATTC) { MAKE_CTX(); ph_att_comb(c, p); }
    PHASE(PH_SSM) { MAKE_CTX(); ph_ssm_base(c, p); }
    PHASE(PH_M_E3) { { constexpr int GU8E = 0; MAKE_CTX(); const float* lamp = (const float*)(ws + WS_LAM); const float lam_ = lamp[0], smax_ = lamp[1];
          float* scr = c.lds + c.wave * (64 * 65);
          const int grp = vcu & 3;
          const unsigned prog = grp == 0 ? 0x0213u : grp == 1 ? 0x0231u : grp == 2 ? 0x0321u : 0x2514u;
          for (int step = 0; step < 4; ++step) {
              const int code = (int)((prog >> (4 * step)) & 15u);
              if (code == 1 || code == 2) { const int i_ = code - 1;
                  att::phase((char*)lds_raw, (const bf16_t*)(ws + WS_QK), (const bf16_t*)(ws + WS_V), (bf16_t*)(ws + WS_MIXIN), lam_, smax_, p.in[I_SUBG], G, vcu, vcu + i_ * G, vcu + i_ * G + 1); }
              else if (code >= 3) { const int lo = code == 5 ? 96 : 0, hi = code == 4 ? 96 : 192;
                  conv_range<GU8E>(c, p, vcu * 192 + lo + c.wave, vcu * 192 + hi, 8, scr); }
              __syncthreads();
          }
        }
        { pg8::Gemm g{(const bf16_t*)(ws + WS_Y), (const bf16_t*)(ws + WS_WGLU_T), 512, 512, nullptr}; pg8::DenseOrder S; S.init(T, 512, G, bid);
          pg8::EpiGluF E{(const bf16_t*)(ws + WS_Y), (bf16_t*)(ws + WS_MIXIN), (float*)(ws + WS_SS1P)}; pg8::gemm_phase<pg8::EpiGluF, pg8::DenseOrder, false, true>(lds3, g, S, E); } }
    PHASE(PH_M_E4) { { constexpr int GU8E = 1; MAKE_CTX(); const float* lamp = (const float*)(ws + WS_LAM); const float lam_ = lamp[0], smax_ = lamp[1];
          float* scr = c.lds + c.wave * (64 * 65);
          const int grp = vcu & 3;
          const unsigned prog = grp == 0 ? 0x0213u : grp == 1 ? 0x0231u : grp == 2 ? 0x0321u : 0x2514u;
          for (int step = 0; step < 4; ++step) {
              const int code = (int)((prog >> (4 * step)) & 15u);
              if (code == 1 || code == 2) { const int i_ = code - 1;
                  att::phase((char*)lds_raw, (const bf16_t*)(ws + WS_QK), (const bf16_t*)(ws + WS_V), (bf16_t*)(ws + WS_MIXIN), lam_, smax_, p.in[I_SUBG], G, vcu, vcu + i_ * G, vcu + i_ * G + 1); }
              else if (code >= 3) { const int lo = code == 5 ? 96 : 0, hi = code == 4 ? 96 : 192;
                  conv_range<GU8E>(c, p, vcu * 192 + lo + c.wave, vcu * 192 + hi, 8, scr); }
              __syncthreads();
          }
        }
        { pg8::Gemm g{(const bf16_t*)(ws + WS_Y), (const bf16_t*)(ws + WS_WGLU_T), 512, 512, nullptr}; pg8::DenseOrder S; S.init(T, 512, G, bid);
          pg8::EpiGluF E{(const bf16_t*)(ws + WS_Y), (bf16_t*)(ws + WS_MIXIN), (float*)(ws + WS_SS1P)}; pg8::gemm_phase<pg8::EpiGluF, pg8::DenseOrder, false, true>(lds3, g, S, E); } }
    PHASE(PH_M_E5) { { constexpr int GU8E = 2; MAKE_CTX(); const float* lamp = (const float*)(ws + WS_LAM); const float lam_ = lamp[0], smax_ = lamp[1];
          float* scr = c.lds + c.wave * (64 * 65);
          const int grp = vcu & 3;
          const unsigned prog = grp == 0 ? 0x0213u : grp == 1 ? 0x0231u : grp == 2 ? 0x0321u : 0x2514u;
#define E5_STEPS(ZC_) \
          for (int step = 0; step < 4; ++step) { \
              const int code = (int)((prog >> (4 * step)) & 15u); \
              if (code == 1 || code == 2) { const int i_ = code - 1; \
                  if (c.wave < 4) { att::phase<ZC_, 0>((char*)lds_raw, (const bf16_t*)(ws + WS_QK), (const bf16_t*)(ws + WS_V), (bf16_t*)(ws + WS_MIXIN), lam_, smax_, p.in[I_SUBG], G, vcu, vcu + i_ * G, vcu + i_ * G + 1); } else { att::phase<ZC_, 1>((char*)lds_raw, (const bf16_t*)(ws + WS_QK), (const bf16_t*)(ws + WS_V), (bf16_t*)(ws + WS_MIXIN), lam_, smax_, p.in[I_SUBG], G, vcu, vcu + i_ * G, vcu + i_ * G + 1); } } \
              else if (code >= 3) { const int lo = code == 5 ? 96 : 0, hi = code == 4 ? 96 : 192; \
                  conv_range<GU8E>(c, p, vcu * 192 + lo + c.wave, vcu * 192 + hi, 8, scr); } \
              __syncthreads(); \
          }
          if (smax_ * 1.4426950408889634f <= 64.f) { E5_STEPS(true); }
          else { E5_STEPS(false); }
#undef E5_STEPS
        }
        { pg8::Gemm g{(const bf16_t*)(ws + WS_Y), (const bf16_t*)(ws + WS_WGLU_T), 512, 512, nullptr}; pg8::DenseOrder S; S.init(T, 512, G, bid);
          pg8::EpiGluF E{(const bf16_t*)(ws + WS_Y), (bf16_t*)(ws + WS_MIXIN), (float*)(ws + WS_SS1P)}; pg8::gemm_phase<pg8::EpiGluF, pg8::DenseOrder, false, true>(lds3, g, S, E); } }
    PHASE(PH_M_E6) { { constexpr int GU8E = 2; MAKE_CTX(); const float* lamp = (const float*)(ws + WS_LAM); const float lam_ = lamp[0], smax_ = lamp[1];
          float* scr = c.lds + c.wave * (64 * 65);
          const int grp = vcu & 3;
          const unsigned prog = grp == 0 ? 0x0213u : grp == 1 ? 0x0231u : grp == 2 ? 0x0321u : 0x2514u;
          for (int step = 0; step < 4; ++step) {
              const int code = (int)((prog >> (4 * step)) & 15u);
              if (code == 1 || code == 2) { const int i_ = code - 1;
                  att3::phase((char*)lds_raw, (const bf16_t*)(ws + WS_QK), (const bf16_t*)(ws + WS_V), (bf16_t*)(ws + WS_MIXIN), lam_, smax_, p.in[I_SUBG], G, vcu + i_ * G, vcu + i_ * G + 1); }
              else if (code >= 3) { const int lo = code == 5 ? 96 : 0, hi = code == 4 ? 96 : 192;
                  conv_range<GU8E>(c, p, vcu * 192 + lo + c.wave, vcu * 192 + hi, 8, scr); }
              __syncthreads();
          }
        }
        { pg8::Gemm g{(const bf16_t*)(ws + WS_Y), (const bf16_t*)(ws + WS_WGLU_T), 512, 512, nullptr}; pg8::DenseOrder S; S.init(T, 512, G, bid);
          pg8::EpiGluF E{(const bf16_t*)(ws + WS_Y), (bf16_t*)(ws + WS_MIXIN), (float*)(ws + WS_SS1P)}; pg8::gemm_phase<pg8::EpiGluF, pg8::DenseOrder, false, true>(lds3, g, S, E); } }
    PHASE(PH_GLU) { MAKE_CTX(); SG_Args g{(const bf16_t*)(ws + WS_Y), 512, nullptr, p.in[I_WGLU], nullptr, 512, 0, nullptr, T, 512, 512};
        EpiGlu E{(const bf16_t*)(ws + WS_Y), (bf16_t*)(ws + WS_MIXIN), (float*)(ws + WS_CTL + CTL_SS1)}; sgemm_phase<false>(c, g, E); }
    PHASE(PH_NORM) { MAKE_CTX(); ph_ssm_norm(c, p); }
    PHASE(PH_NORM2) { MAKE_CTX(); ph_ssm_norm2(c, p); }
    PHASE(PH_WOUT) { MAKE_CTX(); SG_Args g{(const bf16_t*)(ws + WS_MIXIN), DM, nullptr, p.in[I_WOUT], nullptr, DM, 0, nullptr, T, DM, DM};
        EpiWout E{p.in[I_X], (const float*)(ws + WS_MOD), p.out, (float*)(ws + WS_CTL + CTL_SS2)}; sgemm_phase<false>(c, g, E); }
    PHASE(PH_WOUT_F) { MAKE_CTX(); pg8::Gemm g{(const bf16_t*)(ws + WS_MIXIN), (const bf16_t*)(ws + WS_WOUT_T), DM, DM, nullptr}; pg8::DenseOrder S; S.init(T, DM, G, bid);
        pg8::EpiWoutF E{p.in[I_X], (const float*)(ws + WS_MOD), p.out, (float*)(ws + WS_SS2P)}; pg8::gemm_phase<pg8::EpiWoutF, pg8::DenseOrder, false, true>(lds3, g, S, E); }
    PHASE(PH_H2) { MAKE_CTX(); ph_h2(c, p); }
    PHASE(PH_H2_2) { MAKE_CTX(); ph_h2_2(c, p); }
    PHASE(PH_H2_3) { MAKE_CTX(); ph_h2_3(c, p); }
    PHASE(PH_RS) { MAKE_CTX(); SG_Args g{(const bf16_t*)(ws + WS_H), DM, nullptr, p.in[I_WR], nullptr, 256, 0, nullptr, T, 256, DM};
        EpiLogits E{(float*)(ws + WS_LOGITS)}; sgemm_phase<false>(c, g, E); }
    PHASE(PH_RS2) { MAKE_CTX(); SG_Args g2{(const bf16_t*)(ws + WS_H), DM, nullptr, p.in[I_WGS], p.in[I_WUS], 256, 0, nullptr, T, 256, DM};
        EpiSwiglu E2{(bf16_t*)(ws + WS_ACTS), 256}; sgemm_phase<true>(c, g2, E2); }
    PHASE(PH_RS_F) { MAKE_CTX(); pg8::Gemm g{(const bf16_t*)(ws + WS_H), (const bf16_t*)(ws + WS_WRS_T), DM, DM, nullptr}; pg8::DenseOrder S; S.init(T, 768, G, bid);
        pg8::EpiRSF E{(float*)(ws + WS_LOGITS), (bf16_t*)(ws + WS_ACTS)}; pg8::gemm_phase<pg8::EpiRSF, pg8::DenseOrder, false, true>(lds3, g, S, E); }
    PHASE(PH_SD) { MAKE_CTX(); SG_Args g{(const bf16_t*)(ws + WS_ACTS), 256, nullptr, p.in[I_WDS], nullptr, DM, 0, nullptr, T, DM, ED};
        EpiSD E{(const float*)(ws + WS_MOD), p.out}; sgemm_phase<false>(c, g, E); }
    PHASE(PH_ROUTE) { MAKE_CTX(); ph_route(c, p); }
    PHASE(PH_M_J2) { { MAKE_CTX(); ph_route2<false>(c, p); }
        { pg8::Gemm g{(const bf16_t*)(ws + WS_ACTS), (const bf16_t*)(ws + WS_WDS_T), ED, ED, nullptr}; pg8::DenseOrder S; S.init(T, DM, G, bid);
          pg8::EpiSDY E{(bf16_t*)(ws + WS_YSH)}; pg8::gemm_phase<pg8::EpiSDY, pg8::DenseOrder, false, true>(lds3, g, S, E); } }
    PHASE(PH_M_J3) { { MAKE_CTX(); ph_route2<true>(c, p); }
        { pg8::Gemm g{(const bf16_t*)(ws + WS_ACTS), (const bf16_t*)(ws + WS_WDS_T), ED, ED, nullptr}; pg8::DenseOrder S; S.init(T, DM, G, bid);
          pg8::EpiSDY E{(bf16_t*)(ws + WS_YSH)}; pg8::gemm_phase<pg8::EpiSDY, pg8::DenseOrder, false, true>(lds3, g, S, E); } }
    PHASE(PH_SLOT5) { MAKE_CTX(); ph_slot5(c, p); }
    PHASE(PH_SLOT) { MAKE_CTX(); ph_slot(c, p); }
    PHASE(PH_SLOT4) { MAKE_CTX(); ph_slot3<true>(c, p); }
    PHASE(PH_E1) { MAKE_CTX(); SG_Args g{(const bf16_t*)(ws + WS_H), DM, (const int*)(ws + WS_SLOT_TOK), p.in[I_WGE], p.in[I_WUE], 256, (size_t)DM * ED, (const int*)(ws + WS_TILE_E), NS_MAX, ED, DM};
        EpiSwiglu E{(bf16_t*)(ws + WS_ACTE), 256}; sgemm_phase<true>(c, g, E); }
    PHASE(PH_E1_F) { MAKE_CTX(); pg8::Gemm g{(const bf16_t*)(ws + WS_H), (const bf16_t*)(ws + WS_WGU), DM, DM, (const int*)(ws + WS_SLOT_TOK)};
        pg8::GroupedOrder S{(const int*)(ws + WS_TILE_E), (int)((const unsigned*)(ws + WS_CTL))[CW_NTILES], 2, G, vcu};
        pg8::EpiE1F E{(bf16_t*)(ws + WS_ACTE)}; pg8::gemm_phase<pg8::EpiE1F, pg8::GroupedOrder, true, true>(lds3, g, S, E); }
    PHASE(PH_X1) { pg8::Gemm g{(const bf16_t*)(ws + WS_ACTE), (const bf16_t*)(ws + WS_WD), ED / 2, ED / 2, nullptr, 0x7A7A7A7Au, 0x7C7C7C7Cu};
        pg8::GroupedOrder S{(const int*)(ws + WS_TILE_E), (int)((const unsigned*)(ws + WS_CTL))[CW_NTILES], 4, G, vcu};
        pg8::EpiNone E{(float*)(ws + WS_DS)}; pg8::gemm_phase<pg8::EpiNone, pg8::GroupedOrder, true, true, true>(lds3, g, S, E); }
    PHASE(PH_X2) { pg8::Gemm g{(const bf16_t*)(ws + WS_ACTE), (const bf16_t*)(ws + WS_WD), ED, ED, nullptr};
        pg8::GroupedOrder S{(const int*)(ws + WS_TILE_E), (int)((const unsigned*)(ws + WS_CTL))[CW_NTILES], 4, G, vcu};
        pg8::EpiDense E{(bf16_t*)(ws + WS_YA)}; pg8::gemm_phase<pg8::EpiDense, pg8::GroupedOrder, false, true>(lds3, g, S, E); }
    PHASE(PH_E1_8) { pg8::Gemm g{(const bf16_t*)(ws + WS_H8), (const bf16_t*)(ws + WS_WGU), DM / 2, DM / 2, (const int*)(ws + WS_SLOT_TOK), 0x79797979u};
        pg8::GroupedOrder S{(const int*)(ws + WS_TILE_E), (int)((const unsigned*)(ws + WS_CTL))[CW_NTILES], 2, G, vcu};
        pg8::EpiE1F E{(bf16_t*)(ws + WS_ACTE)}; pg8::gemm_phase<pg8::EpiE1F, pg8::GroupedOrder, true, true, true>(lds3, g, S, E); }
    PHASE(PH_E1_88) { pg8::Gemm g{(const bf16_t*)(ws + WS_H8), (const bf16_t*)(ws + WS_WGU), DM / 2, DM / 2, (const int*)(ws + WS_SLOT_TOK), 0x79797979u};
        pg8::GroupedOrderL S{nullptr, (int)((const unsigned*)(ws + WS_CTL))[CW_NTILES], 2, G, vcu}; S.fill((const int*)(ws + WS_TILE_E), (PG8_LAS int*)(lds3 + 131072));
        pg8::EpiE1F8 E{ws + WS_ACTE}; pg8::gemm_phase<pg8::EpiE1F8, pg8::GroupedOrderL, true, true, true>(lds3, g, S, E); }
    PHASE(PH_E2_8) { pg8::Gemm g{(const bf16_t*)(ws + WS_ACTE), (const bf16_t*)(ws + WS_WD), ED / 2, ED / 2, nullptr, 0x7A7A7A7Au, 0x7C7C7C7Cu};
        pg8::GroupedOrder S{(const int*)(ws + WS_TILE_E), (int)((const unsigned*)(ws + WS_CTL))[CW_NTILES], 4, G, vcu};
        pg8::EpiE2S8b E{(const float*)(ws + WS_SLOT_GATE), ws + WS_YS}; pg8::gemm_phase<pg8::EpiE2S8b, pg8::GroupedOrder, true, true, true>(lds3, g, S, E); }
    PHASE(PH_E2_B8) { pg8::Gemm g{(const bf16_t*)(ws + WS_ACTE), (const bf16_t*)(ws + WS_WD), ED, ED, nullptr};
        pg8::GroupedOrder S{(const int*)(ws + WS_TILE_E), (int)((const unsigned*)(ws + WS_CTL))[CW_NTILES], 4, G, vcu};
        pg8::EpiE2S8 E{(const float*)(ws + WS_SLOT_GATE), ws + WS_YS}; pg8::gemm_phase<pg8::EpiE2S8, pg8::GroupedOrder, false, true>(lds3, g, S, E); }
    PHASE(PH_E1_G8) { pg8::Gemm g{(const bf16_t*)(ws + WS_H8), (const bf16_t*)(ws + WS_WGU), DM / 2, DM / 2, (const int*)(ws + WS_SLOT_TOK), 0x79797979u};
        pg8::GroupedOrder S{(const int*)(ws + WS_TILE_E), (int)((const unsigned*)(ws + WS_CTL))[CW_NTILES], 2, G, vcu};
        pg8::EpiE1G8 E{(const float*)(ws + WS_SLOT_GATE), ws + WS_ACTE}; pg8::gemm_phase<pg8::EpiE1G8, pg8::GroupedOrder, true, true, true>(lds3, g, S, E); }
    static_assert(Y8_SCALE == 16.f && ACT8_SCALE == 8.f && WD8_SCALE == 32.f, "E8M0 scales below");
    PHASE(PH_E2_P8) { pg8::Gemm g{(const bf16_t*)(ws + WS_ACTE), (const bf16_t*)(ws + WS_WD), ED / 2, ED / 2, nullptr, 0x7A7A7A7Au, 0x80808080u};
        pg8::GroupedOrderL S{nullptr, (int)((const unsigned*)(ws + WS_CTL))[CW_NTILES], 4, G, vcu}; S.fill((const int*)(ws + WS_TILE_E), (PG8_LAS int*)(lds3 + 131072));
        pg8::EpiE2P8 E{ws + WS_YS}; pg8::gemm_phase<pg8::EpiE2P8, pg8::GroupedOrderL, true, true, true, 2>(lds3, g, S, E); }
    PHASE(PH_COMB5) { MAKE_CTX(); ph_combine5(c, p); }
    PHASE(PH_COMB4) { MAKE_CTX(); ph_combine4(c, p); }
    PHASE(PH_E2) { MAKE_CTX(); SG_Args g{(const bf16_t*)(ws + WS_ACTE), 256, nullptr, p.in[I_WDE], nullptr, DM, (size_t)ED * DM, (const int*)(ws + WS_TILE_E), NS_MAX, DM, ED};
        EpiE2 E{(const int*)(ws + WS_SLOT_ASG), (const float*)(ws + WS_SLOT_GATE), (bf16_t*)(ws + WS_YA)}; sgemm_phase<false>(c, g, E); }
    PHASE(PH_E2S_F) { pg8::Gemm g{(const bf16_t*)(ws + WS_ACTE), (const bf16_t*)(ws + WS_WD), ED, ED, nullptr};
        pg8::GroupedOrder S{(const int*)(ws + WS_TILE_E), (int)((const unsigned*)(ws + WS_CTL))[CW_NTILES], 4, G, vcu};
        pg8::EpiE2S E{(const int*)(ws + WS_SLOT_ASG), (const float*)(ws + WS_SLOT_GATE), (bf16_t*)(ws + WS_YS)}; pg8::gemm_phase<pg8::EpiE2S, pg8::GroupedOrder, false, true>(lds3, g, S, E); }
    PHASE(PH_COMB3) { MAKE_CTX(); ph_combine3(c, p); }
    PHASE(PH_COMB) { MAKE_CTX(); ph_combine(c, p); }
    if constexpr (TIMING) {
        xcd_barrier(bar); (void)STAMP();
        if (blockIdx.x == 0 && threadIdx.x == 0) {
            const unsigned long long qb = (t_b + 400) / 800;
            const unsigned long long wait = t_a + qb * 102400ull, t0 = __builtin_amdgcn_s_memrealtime();
            while (__builtin_amdgcn_s_memrealtime() - t0 < wait) __builtin_amdgcn_s_sleep(8);
        }
    }
#undef PHASE
}

#ifndef PLAN
#define PLAN 18
#endif
#if PLAN == 0
#define LAUNCH_LIST X(PHBIT(PH_PRO)) X(PHBIT(PH_H1)) X(PHBIT(PH_WIN)) X(PHBIT(PH_QKN)) X(PHBIT(PH_ATT)) X(PHBIT(PH_ATTC)) X(PHBIT(PH_SSM)) X(PHBIT(PH_GLU)) X(PHBIT(PH_NORM)) \
    X(PHBIT(PH_WOUT)) X(PHBIT(PH_H2)) X(PHBIT(PH_RS)) X(PHBIT(PH_RS2)) X(PHBIT(PH_SD)) X(PHBIT(PH_ROUTE)) X(PHBIT(PH_SLOT)) X(PHBIT(PH_E1)) X(PHBIT(PH_E2)) X(PHBIT(PH_COMB))
#elif PLAN == 12
#define LAUNCH_LIST X(PHBIT(PH_M_A2) | PHBIT(PH_M_B) | PHBIT(PH_WIN_F) | PHBIT(PH_M_D) | PHBIT(PH_M_E3) | PHBIT(PH_NORM2) | PHBIT(PH_WOUT_F) | PHBIT(PH_H2_2) | PHBIT(PH_RS_F) | PHBIT(PH_M_J2) | PHBIT(PH_SLOT4) | PHBIT(PH_E1_F) | PHBIT(PH_E2S_F) | PHBIT(PH_COMB3))
#elif PLAN == 13
#define LAUNCH_LIST X(PHBIT(PH_M_A2) | PHBIT(PH_M_B) | PHBIT(PH_WIN_F) | PHBIT(PH_M_D) | PHBIT(PH_M_E3) | PHBIT(PH_NORM2) | PHBIT(PH_WOUT_F) | PHBIT(PH_H2_2) | PHBIT(PH_RS_F) | PHBIT(PH_M_J2) | PHBIT(PH_SLOT4) | PHBIT(PH_E1_F) | PHBIT(PH_X1) | PHBIT(PH_E2S_F) | PHBIT(PH_COMB3))
#elif PLAN == 14
#define LAUNCH_LIST X(PHBIT(PH_M_A2) | PHBIT(PH_M_B) | PHBIT(PH_WIN_F) | PHBIT(PH_M_D) | PHBIT(PH_M_E4) | PHBIT(PH_NORM2) | PHBIT(PH_WOUT_F) | PHBIT(PH_H2_3) | PHBIT(PH_RS_F) | PHBIT(PH_M_J2) | PHBIT(PH_SLOT4) | PHBIT(PH_E1_8) | PHBIT(PH_E2S_F) | PHBIT(PH_COMB3))
#elif PLAN == 15
#define LAUNCH_LIST X(PHBIT(PH_M_A2) | PHBIT(PH_M_B) | PHBIT(PH_WIN_F) | PHBIT(PH_M_D) | PHBIT(PH_M_E5) | PHBIT(PH_NORM2) | PHBIT(PH_WOUT_F) | PHBIT(PH_H2_3) | PHBIT(PH_RS_F) | PHBIT(PH_M_J2) | PHBIT(PH_SLOT4) | PHBIT(PH_E1_88) | PHBIT(PH_E2_8) | PHBIT(PH_COMB4))
#elif PLAN == 99
#define LAUNCH_LIST X(PHBIT(PH_M_E5)) X(PHBIT(PH_E1_88)) X(PHBIT(PH_E2_8)) X(PHBIT(PH_COMB4)) X(PHBIT(PH_H2_3)) X(PHBIT(PH_M_D)) X(PHBIT(PH_WIN_F)) X(PHBIT(PH_WOUT_F)) X(PHBIT(PH_RS_F)) X(PHBIT(PH_M_J2))
#elif PLAN == 16
#define LAUNCH_LIST X(PHBIT(PH_M_A2) | PHBIT(PH_M_B) | PHBIT(PH_WIN_F) | PHBIT(PH_M_D) | PHBIT(PH_M_E4) | PHBIT(PH_NORM2) | PHBIT(PH_WOUT_F) | PHBIT(PH_H2_3) | PHBIT(PH_RS_F) | PHBIT(PH_M_J2) | PHBIT(PH_SLOT4) | PHBIT(PH_E1_8) | PHBIT(PH_E2_B8) | PHBIT(PH_COMB4))
#elif PLAN == 17
#define LAUNCH_LIST X(PHBIT(PH_M_A2) | PHBIT(PH_M_B) | PHBIT(PH_WIN_F) | PHBIT(PH_M_D) | PHBIT(PH_M_E5) | PHBIT(PH_NORM2) | PHBIT(PH_WOUT_F) | PHBIT(PH_H2_3) | PHBIT(PH_RS_F) | PHBIT(PH_M_J2) | PHBIT(PH_SLOT4) | PHBIT(PH_E1_G8) | PHBIT(PH_E2_P8) | PHBIT(PH_COMB4))
#elif PLAN == 18
#define LAUNCH_LIST X(PHBIT(PH_M_A2) | PHBIT(PH_M_B) | PHBIT(PH_WIN_F) | PHBIT(PH_M_D) | PHBIT(PH_M_E5) | PHBIT(PH_NORM2) | PHBIT(PH_WOUT_F) | PHBIT(PH_H2_3) | PHBIT(PH_RS_F) | PHBIT(PH_M_J3) | PHBIT(PH_SLOT5) | PHBIT(PH_E1_88) | PHBIT(PH_E2_P8) | PHBIT(PH_COMB5))
#elif PLAN == 19
#define LAUNCH_LIST X(PHBIT(PH_M_A2) | PHBIT(PH_M_B) | PHBIT(PH_WIN_F) | PHBIT(PH_M_D) | PHBIT(PH_M_E6) | PHBIT(PH_NORM2) | PHBIT(PH_WOUT_F) | PHBIT(PH_H2_3) | PHBIT(PH_RS_F) | PHBIT(PH_M_J3) | PHBIT(PH_SLOT5) | PHBIT(PH_E1_88) | PHBIT(PH_E2_P8) | PHBIT(PH_COMB5))
#elif PLAN == 20
#define LAUNCH_LIST X(PHBIT(PH_M_A2) | PHBIT(PH_M_B) | PHBIT(PH_WIN_F) | PHBIT(PH_M_D) | PHBIT(PH_M_E5) | PHBIT(PH_NORM2) | PHBIT(PH_WOUT_F) | PHBIT(PH_H2_3) | PHBIT(PH_RS_F) | PHBIT(PH_M_J3) | PHBIT(PH_SLOT5) | PHBIT(PH_E1_88) | PHBIT(PH_X1) | PHBIT(PH_E2_P8) | PHBIT(PH_COMB5))
#endif

extern "C" void kernel_launch(void* const* d_in, const int* in_sizes, int n_in, void* d_out, int out_size, void* d_ws, size_t ws_size, hipStream_t stream) {
    static int grid = 0;
    if (grid == 0) {
        if (n_in != 33 || out_size != T * DM || ws_size < WS_NEED) { fprintf(stderr, "kernel_launch: unexpected shapes (n_in %d out %d ws %zu)\n", n_in, out_size, ws_size); grid = -1; return; }
        int dev = 0, cus = 0;
        if (hipGetDevice(&dev) != hipSuccess || hipDeviceGetAttribute(&cus, hipDeviceAttributeMultiprocessorCount, dev) != hipSuccess) { grid = -1; return; }
        bool ok = true;
#define X(m) ok = ok && (hipFuncSetAttribute((const void*)mega<(m)>, hipFuncAttributeMaxDynamicSharedMemorySize, LDS_BYTES) == hipSuccess);
        LAUNCH_LIST
#undef X
        if (!ok) { grid = -1; return; }
        grid = cus;
    }
    if (grid < 0) return;
    (void)hipMemsetAsync((char*)d_ws + WS_CTL, 0, CTL_BYTES, stream);
    Params a{};
    for (int i = 0; i < 33; ++i) a.in[i] = (const float*)d_in[i];
    a.out = (float*)d_out; a.ws = (unsigned char*)d_ws;
#define X(m) hipLaunchKernelGGL((mega<(m)>), dim3(grid), dim3(NTHREADS), LDS_BYTES, stream, a);
    LAUNCH_LIST
#undef X
}
```

```cpp
#include <hip/hip_runtime.h>
#include <cstdio>
#include <cstdint>

typedef unsigned short bf16_t;
typedef float f32x4 __attribute__((ext_vector_type(4)));
typedef unsigned u32x4 __attribute__((ext_vector_type(4)));
typedef unsigned u32x2 __attribute__((ext_vector_type(2)));

constexpr int DM = 1024, NB = 8, SEQ = 4096, T = NB * SEQ;
constexpr int NH = 4, HD = 64, VD = 128, QKW = 512, ATTW = 512, SSMW = 512;
constexpr int SG = 32, SC = 16, SP = 64;
constexpr int LC = 16;
constexpr int NCHUNK = SEQ / LC;
constexpr int APK = 384;
constexpr int NE = 256, TOPK = 8, NGRP = 8, TOPG = 4, ED = 256;
constexpr int NS_MAX = 327680;
constexpr float EPS = 1e-6f;
constexpr float LAM_INIT = 0.2f;
constexpr float ROUTED_SCALE = 2.5f;
constexpr float WGU8_SCALE = 64.f, WD8_SCALE = 32.f, ACT8_SCALE = 8.f, Y8_SCALE = 16.f;

constexpr size_t MiB = 1u << 20;
constexpr size_t WS_CTL = 0, CTL_BYTES = 1 * MiB;
constexpr int CW_COUNTS = 1024;
constexpr int CW_CURSOR = 1024 + 256;
constexpr int CW_NTILES = 2048;
constexpr int CW_ATTQ = 2560  , CW_CONVQ = 2176;
constexpr int CW_BAR = 4096;
constexpr size_t CTL_SS1 = 256 * 1024;
constexpr size_t CTL_SS2 = 384 * 1024;
constexpr size_t WS_MOD = 512 * 1024;
constexpr size_t WS_LAM = 1 * MiB + 256 * 1024;
constexpr size_t WS_ROPE = 1 * MiB + 512 * 1024;
constexpr size_t WS_SSMP = 2 * MiB + 512 * 1024;
constexpr size_t WS_SS1P = 3 * MiB;
constexpr size_t WS_SS2P = 528 * MiB;
constexpr size_t WS_HIST = 11 * MiB;
constexpr size_t WS_EIDX = 4 * MiB;
constexpr size_t WS_GATEW = 5 * MiB;
constexpr size_t WS_SLOT_TOK = 6 * MiB;
constexpr size_t WS_SLOT_ASG = 7 * MiB + 512 * 1024;
constexpr size_t WS_SLOT_GATE = 9 * MiB;
constexpr size_t WS_TILE_E = 10 * MiB + 512 * 1024;
constexpr size_t WS_PADST = 10 * MiB + 768 * 1024;
constexpr size_t WS_WIN_T = 12 * MiB;
constexpr size_t WS_WOUT_T = 16 * MiB;
constexpr size_t WS_WGLU_T = 18 * MiB;
constexpr size_t WS_WRS_T = 19 * MiB;
constexpr size_t WS_SSMPW = 20 * MiB + 512 * 1024;
constexpr size_t WS_WDS_T = 21 * MiB;
constexpr size_t WS_SSM_BA = 22 * MiB;
constexpr size_t WS_SSM_BC = 26 * MiB;
constexpr size_t WS_DS = 496 * MiB;
constexpr size_t WS_WGU = 32 * MiB;
constexpr size_t WS_WD = 832 * MiB;
constexpr size_t WS_YS = 32 * MiB;
constexpr size_t WS_YA = 32 * MiB;
constexpr size_t WS_H = 288 * MiB;
constexpr size_t WS_H8 = 352 * MiB;
constexpr size_t WS_QK = 352 * MiB;
constexpr size_t WS_Y = 288 * MiB;
constexpr size_t WS_V = 416 * MiB;
constexpr size_t WS_AP = 448 * MiB;
constexpr size_t WS_ACTE = 672 * MiB;
constexpr size_t WS_MIXIN = 544 * MiB;
constexpr size_t WS_LOGITS = 608 * MiB;
constexpr size_t WS_ACTS = 640 * MiB;
constexpr size_t WS_YSH = 960 * MiB;
constexpr size_t WS_ATTO = 832 * MiB;
constexpr size_t WS_NEED = 1024 * MiB;

__device__ __forceinline__ float bf2f(bf16_t v) { return __uint_as_float((unsigned)v << 16); }
__device__ __forceinline__ bf16_t f2bf(float f) { unsigned u = __float_as_uint(f); return (bf16_t)((u + 0x7fffu + ((u >> 16) & 1u)) >> 16); }
__device__ __forceinline__ unsigned pk2(float lo, float hi) { return (unsigned)f2bf(lo) | ((unsigned)f2bf(hi) << 16); }
__device__ __forceinline__ float wave_sum(float v) {
#pragma unroll
    for (int o = 1; o < 64; o <<= 1) v += __shfl_xor(v, o);
    return v;
}
__device__ __forceinline__ float clamp448(float v) { return __builtin_amdgcn_fmed3f(v, -448.f, 448.f); }
__device__ __forceinline__ unsigned pk4_fp8(float a, float b, float c2, float d) { int w = __builtin_amdgcn_cvt_pk_fp8_f32(clamp448(a), clamp448(b), 0, false); w = __builtin_amdgcn_cvt_pk_fp8_f32(clamp448(c2), clamp448(d), w, true); return (unsigned)w; }
__device__ __forceinline__ float siluf(float v) { return v / (1.f + __expf(-v)); }
__device__ __forceinline__ float sigmoidf(float v) { return 1.f / (1.f + __expf(-v)); }
__device__ __forceinline__ float gelu_tanh(float v) { const float u2 = 1.5957691216057308f * (v + 0.044715f * v * v * v); return v / (1.f + __expf(-u2)); }

constexpr int NTHREADS_ = 512;
struct Params {
    const float* in[33];
    float* out;
    unsigned char* ws;
    int pad0, pad1;
};

struct Ctx {
    int tid, lane, wave, bid, nb;
    int gtid, gthreads, gwave, gwaves;
    unsigned char* ws;
    float* lds;
};

enum { I_X = 0, I_C, I_N1G, I_N2G, I_WADA, I_BADA, I_WIN, I_QNG, I_KNG, I_LQ1, I_LK1, I_LQ2, I_LK2, I_SUBG,
       I_ARE, I_AIM, I_LOGDT, I_BRE, I_BIM, I_CRE, I_CIM, I_SD, I_WGLU, I_SNG, I_WOUT, I_WR, I_RB,
       I_WGE, I_WUE, I_WDE, I_WGS, I_WUS, I_WDS };

struct SG_Args {
    const bf16_t* A; int lda; const int* rowidx;
    const float* W; const float* W2; int ldb;
    size_t wstride;
    const int* tile_e;
    int M, N, K;
};
template <bool DUAL, class Epi>
__device__ __forceinline__ void sgemm_phase(const Ctx& c, const SG_Args g, const Epi& E) {
    float* As = c.lds;
    float* Bs = c.lds + 16 * 132;
    float* Bs2 = Bs + 16 * 128;
    const int tid = c.tid, ty = tid >> 5, tx = tid & 31;
    const int nMt = g.M / 128, nNt = g.N / 128, ntile = nMt * nNt;
    for (int tile = c.bid; tile < ntile; tile += c.nb) {
        const int mt = tile / nNt, nt = tile % nNt;
        const float* W = g.W; const float* W2 = g.W2;
        if (g.tile_e) { const int e = g.tile_e[mt >> 1]; if (e < 0) continue; W += (size_t)e * g.wstride; if (DUAL) W2 += (size_t)e * g.wstride; }
        f32x4 acc[8], acc2[8];
#pragma unroll
        for (int i = 0; i < 8; ++i) { acc[i] = (f32x4){0.f, 0.f, 0.f, 0.f}; acc2[i] = (f32x4){0.f, 0.f, 0.f, 0.f}; }
        const int arow = mt * 128 + (tid >> 2), akq = (tid & 3) * 4;
        const int asrc = g.rowidx ? g.rowidx[arow] : arow;
        const bf16_t* ap = g.A + (size_t)asrc * g.lda + akq;
        const int bk = tid >> 5, bn = (tid & 31) * 4;
        const float* bp = W + (size_t)bk * g.ldb + nt * 128 + bn;
        const float* bp2 = DUAL ? (W2 + (size_t)bk * g.ldb + nt * 128 + bn) : nullptr;
#pragma unroll 1
        for (int k0 = 0; k0 < g.K; k0 += 16) {
            const u32x2 av = *(const u32x2*)(ap + k0);
            const f32x4 bv = *(const f32x4*)(bp + (size_t)k0 * g.ldb);
            f32x4 bv2 = {0.f, 0.f, 0.f, 0.f};
            if (DUAL) bv2 = *(const f32x4*)(bp2 + (size_t)k0 * g.ldb);
            __syncthreads();
            As[(akq + 0) * 132 + (tid >> 2)] = __uint_as_float(av.x << 16);
            As[(akq + 1) * 132 + (tid >> 2)] = __uint_as_float(av.x & 0xffff0000u);
            As[(akq + 2) * 132 + (tid >> 2)] = __uint_as_float(av.y << 16);
            As[(akq + 3) * 132 + (tid >> 2)] = __uint_as_float(av.y & 0xffff0000u);
            *(f32x4*)(Bs + bk * 128 + bn) = bv;
            if (DUAL) *(f32x4*)(Bs2 + bk * 128 + bn) = bv2;
            __syncthreads();
#pragma unroll
            for (int kk = 0; kk < 16; ++kk) {
                const f32x4 a0 = *(const f32x4*)(As + kk * 132 + ty * 8), a1 = *(const f32x4*)(As + kk * 132 + ty * 8 + 4);
                const f32x4 b = *(const f32x4*)(Bs + kk * 128 + tx * 4);
                const float a[8] = {a0.x, a0.y, a0.z, a0.w, a1.x, a1.y, a1.z, a1.w};
#pragma unroll
                for (int i = 0; i < 8; ++i) acc[i] += a[i] * b;
                if (DUAL) {
                    const f32x4 b2 = *(const f32x4*)(Bs2 + kk * 128 + tx * 4);
#pragma unroll
                    for (int i = 0; i < 8; ++i) acc2[i] += a[i] * b2;
                }
            }
        }
#pragma unroll
        for (int i = 0; i < 8; ++i) E(mt * 128 + ty * 8 + i, nt * 128 + tx * 4, acc[i], acc2[i], tx);
    }
}

__device__ __forceinline__ void ph_prologue(const Ctx& c, const Params& p) {
    float* mod = (float*)(c.ws + WS_MOD);
    for (int idx = c.gtid; idx < NB * 6 * DM; idx += c.gthreads) {
        const int b = idx / (6 * DM), j = idx % (6 * DM);
        const float* cc = p.in[I_C] + b * DM; const float* w = p.in[I_WADA] + j;
        float acc = p.in[I_BADA][j];
#pragma unroll 8
        for (int k = 0; k < DM; ++k) acc += siluf(cc[k]) * w[(size_t)k * (6 * DM)];
        mod[idx] = acc;
    }
    float* ropec = (float*)(c.ws + WS_ROPE); float* ropes = ropec + SEQ * 32;
    for (int idx = c.gtid; idx < SEQ * 32; idx += c.gthreads) {
        const int l = idx >> 5, i = idx & 31;
        const double invf = exp(-log(10000.0) * (double)(2 * i) / 64.0);
        const double ang = (double)l * invf;
        ropec[idx] = (float)cos(ang); ropes[idx] = (float)sin(ang);
    }
    float* sp = (float*)(c.ws + WS_SSMP);
    float* abr = sp, * abi = sp + SG * SP, * bbr = sp + 2 * SG * SP, * bbi = bbr + SG * SP * SC;
    for (int idx = c.gtid; idx < SG * SP; idx += c.gthreads) {
        const int g = idx / SP;
        const double are = p.in[I_ARE][idx], aim = p.in[I_AIM][idx], dt = exp((double)p.in[I_LOGDT][g]);
        const double mag = exp(are * dt), ar = mag * cos(aim * dt), ai = mag * sin(aim * dt);
        abr[idx] = (float)ar; abi[idx] = (float)ai;
        const double den = are * are + aim * aim, nr = ar - 1.0;
        const double fre = (nr * are + ai * aim) / den, fim = (ai * are - nr * aim) / den;
        for (int ch = 0; ch < SC; ++ch) {
            const double br = p.in[I_BRE][idx * SC + ch], bi = p.in[I_BIM][idx * SC + ch];
            bbr[idx * SC + ch] = (float)(fre * br - fim * bi); bbi[idx * SC + ch] = (float)(fre * bi + fim * br);
        }
    }
    if (c.gtid == 0) {
        float s1 = 0.f, s2 = 0.f, gq = 0.f, gk = 0.f;
        for (int i = 0; i < HD; ++i) { s1 += p.in[I_LQ1][i] * p.in[I_LK1][i]; s2 += p.in[I_LQ2][i] * p.in[I_LK2][i];
            gq = fmaxf(gq, fabsf(p.in[I_QNG][i])); gk = fmaxf(gk, fabsf(p.in[I_KNG][i])); }
        float* lam = (float*)(c.ws + WS_LAM);
        lam[0] = __expf(s1) - __expf(s2) + LAM_INIT;
        lam[1] = 0.125f * 64.f * gq * gk;
    }
    int* stok = (int*)(c.ws + WS_SLOT_TOK); int* sasg = (int*)(c.ws + WS_SLOT_ASG); float* sgate = (float*)(c.ws + WS_SLOT_GATE);
    for (int idx = c.gtid; idx < NS_MAX; idx += c.gthreads) { stok[idx] = 0; sasg[idx] = -1; sgate[idx] = 0.f; }
    int* te = (int*)(c.ws + WS_TILE_E);
    for (int idx = c.gtid; idx < NS_MAX / 256; idx += c.gthreads) te[idx] = -1;
}

__device__ __forceinline__ void ph_h1(const Ctx& c, const Params& p) {
    const float* mod = (const float*)(c.ws + WS_MOD); bf16_t* H = (bf16_t*)(c.ws + WS_H);
    constexpr int R = 4;
    for (int t0 = c.gwave * R; t0 < T; t0 += c.gwaves * R) {
        const int b = t0 / SEQ;
        f32x4 v[R][4]; float sq[R];
#pragma unroll
        for (int j = 0; j < R; ++j) { const f32x4* xr = (const f32x4*)(p.in[I_X] + (size_t)(t0 + j) * DM) + c.lane;
#pragma unroll
            for (int q = 0; q < 4; ++q) v[j][q] = xr[64 * q]; }
        const float* sh = mod + b * 6 * DM, * sc = sh + DM;
        f32x4 ca[4], cb[4];
#pragma unroll
        for (int q = 0; q < 4; ++q) { const int col = 4 * c.lane + 256 * q; ca[q] = *(const f32x4*)(p.in[I_N1G] + col) * (1.f + *(const f32x4*)(sc + col)); cb[q] = *(const f32x4*)(sh + col); }
#pragma unroll
        for (int j = 0; j < R; ++j) { float s_ = 0.f;
#pragma unroll
            for (int q = 0; q < 4; ++q) s_ += v[j][q].x * v[j][q].x + v[j][q].y * v[j][q].y + v[j][q].z * v[j][q].z + v[j][q].w * v[j][q].w;
            sq[j] = s_; }
#pragma unroll
        for (int o = 1; o < 64; o <<= 1) {
#pragma unroll
            for (int j = 0; j < R; ++j) sq[j] += __shfl_xor(sq[j], o); }
#pragma unroll
        for (int j = 0; j < R; ++j) { const float rstd = rsqrtf(sq[j] * (1.f / DM) + EPS);
#pragma unroll
            for (int q = 0; q < 4; ++q) { const int col = 4 * c.lane + 256 * q; const f32x4 o = (v[j][q] * rstd) * ca[q] + cb[q];
                u32x2 w; w.x = pk2(o.x, o.y); w.y = pk2(o.z, o.w); *(u32x2*)(H + (size_t)(t0 + j) * DM + col) = w; } }
    }
}

struct EpiWin {
    bf16_t* QK; bf16_t* V; bf16_t* AP;
    __device__ __forceinline__ void operator()(int row, int col, const f32x4& a, const f32x4&, int) const {
        u32x2 w; w.x = pk2(a[0], a[1]); w.y = pk2(a[2], a[3]);
        if (col < 1024) *(u32x2*)(QK + (size_t)row * 1024 + col) = w;
        else if (col < 1536) *(u32x2*)(V + (size_t)row * 512 + (col - 1024)) = w;
        else { const int cc = col - 1536, g = cc >> 4, ch = cc & 15, b = row / SEQ, l = row % SEQ;
            *(u32x2*)(AP + ((size_t)(g * (NB * NCHUNK) + b * NCHUNK + (l >> 4)) * APK + (l & 15) * 16 + ch)) = w; }
    }
};

__device__ __forceinline__ void ph_qkn(const Ctx& c, const Params& p) {
    bf16_t* QK = (bf16_t*)(c.ws + WS_QK);
    const float* ropec = (const float*)(c.ws + WS_ROPE); const float* ropes = ropec + SEQ * 32;
    const int l = c.lane;
    const float gq = p.in[I_QNG][l], gk = p.in[I_KNG][l];
    for (int t = c.gwave; t < T; t += c.gwaves) {
        const int pos = t % SEQ; const float cs = ropec[pos * 32 + (l & 31)], sn = ropes[pos * 32 + (l & 31)];
        bf16_t* r = QK + (size_t)t * 1024;
#pragma unroll 4
        for (int gi = 0; gi < 16; ++gi) {
            const float v = bf2f(r[gi * 64 + l]);
            const float rstd = rsqrtf(wave_sum(v * v) * (1.f / 64.f) + EPS);
            const float y = v * rstd * (gi < 8 ? gq : gk);
            const float o = __shfl_xor(y, 32);
            const float res = (l < 32) ? (y * cs - o * sn) : (o * sn + y * cs);
            r[gi * 64 + l] = f2bf(res);
        }
    }
}

__device__ __forceinline__ void ph_att_base(const Ctx& c, const Params& p) {
    const bf16_t* QK = (const bf16_t*)(c.ws + WS_QK); const bf16_t* V = (const bf16_t*)(c.ws + WS_V); float* AO = (float*)(c.ws + WS_ATTO);
    const float smax = ((const float*)(c.ws + WS_LAM))[1];
    const int nitem = NB * NH * 4 * (SEQ / 64);
    for (int it = c.gwave; it < nitem; it += c.gwaves) {
        const int qb = (SEQ / 64 - 1) - (it / (NB * NH * 4)), bhc = it % (NB * NH * 4), b = bhc / (NH * 4), h = (bhc >> 2) % NH, cc = (bhc >> 1) & 1, vh = bhc & 1;
        const int q = qb * 64 + c.lane; const size_t trow = (size_t)b * SEQ + q;
        float qv[64];
        { const bf16_t* qp = QK + trow * 1024 + h * 128 + cc * 64;
#pragma unroll
          for (int d = 0; d < 64; ++d) qv[d] = bf2f(qp[d]) * 0.125f; }
        float o[64];
#pragma unroll
        for (int d = 0; d < 64; ++d) o[d] = 0.f;
        float lsum = 0.f;
        const int jmax = qb * 64 + 63;
        for (int j = 0; j <= jmax; ++j) {
            const size_t krow = (size_t)b * SEQ + j;
            const u32x4* kp = (const u32x4*)(QK + krow * 1024 + 512 + h * 128 + cc * 64);
            float s = 0.f;
#pragma unroll
            for (int i = 0; i < 8; ++i) { const u32x4 kk = kp[i];
                s += qv[8 * i + 0] * __uint_as_float(kk.x << 16) + qv[8 * i + 1] * __uint_as_float(kk.x & 0xffff0000u)
                   + qv[8 * i + 2] * __uint_as_float(kk.y << 16) + qv[8 * i + 3] * __uint_as_float(kk.y & 0xffff0000u)
                   + qv[8 * i + 4] * __uint_as_float(kk.z << 16) + qv[8 * i + 5] * __uint_as_float(kk.z & 0xffff0000u)
                   + qv[8 * i + 6] * __uint_as_float(kk.w << 16) + qv[8 * i + 7] * __uint_as_float(kk.w & 0xffff0000u); }
            float pe = (j <= q) ? __expf(s - smax) : 0.f;
            lsum += pe;
            const u32x4* vp = (const u32x4*)(V + krow * 512 + h * 128 + vh * 64);
#pragma unroll
            for (int i = 0; i < 8; ++i) { const u32x4 vv = vp[i];
                o[8 * i + 0] += pe * __uint_as_float(vv.x << 16); o[8 * i + 1] += pe * __uint_as_float(vv.x & 0xffff0000u);
                o[8 * i + 2] += pe * __uint_as_float(vv.y << 16); o[8 * i + 3] += pe * __uint_as_float(vv.y & 0xffff0000u);
                o[8 * i + 4] += pe * __uint_as_float(vv.z << 16); o[8 * i + 5] += pe * __uint_as_float(vv.z & 0xffff0000u);
                o[8 * i + 6] += pe * __uint_as_float(vv.w << 16); o[8 * i + 7] += pe * __uint_as_float(vv.w & 0xffff0000u); }
        }
        const float rl = 1.f / lsum;
        float* op = AO + (trow * 8 + h * 2 + cc) * 128 + vh * 64;
#pragma unroll
        for (int d = 0; d < 64; d += 4) *(f32x4*)(op + d) = (f32x4){o[d] * rl, o[d + 1] * rl, o[d + 2] * rl, o[d + 3] * rl};
    }
}
__device__ __forceinline__ void ph_att_comb(const Ctx& c, const Params& p) {
    const float* AO = (const float*)(c.ws + WS_ATTO); bf16_t* MX = (bf16_t*)(c.ws + WS_MIXIN);
    const float lam = ((const float*)(c.ws + WS_LAM))[0];
    for (int it = c.gwave; it < T * NH; it += c.gwaves) {
        const int t = it >> 2, h = it & 3;
        const float* o1 = AO + ((size_t)t * 8 + h * 2) * 128, * o2 = o1 + 128;
        const float a = o1[c.lane] - lam * o2[c.lane], b = o1[64 + c.lane] - lam * o2[64 + c.lane];
        const float rstd = rsqrtf(wave_sum(a * a + b * b) * (1.f / 128.f) + EPS) * (1.f - LAM_INIT);
        MX[(size_t)t * 1024 + h * 128 + c.lane] = f2bf(a * rstd * p.in[I_SUBG][c.lane]);
        MX[(size_t)t * 1024 + h * 128 + 64 + c.lane] = f2bf(b * rstd * p.in[I_SUBG][64 + c.lane]);
    }
}

__device__ __forceinline__ void ph_ssm_base(const Ctx& c, const Params& p) {
    const bf16_t* AP = (const bf16_t*)(c.ws + WS_AP); bf16_t* Y = (bf16_t*)(c.ws + WS_Y);
    const float* sp = (const float*)(c.ws + WS_SSMP);
    const float* abr = sp, * abi = sp + SG * SP, * bbr = sp + 2 * SG * SP, * bbi = bbr + SG * SP * SC;
    for (int it = c.gwave; it < NB * SG; it += c.gwaves) {
        const int b = it / SG, g = it % SG, pp = c.lane;
        const float ar = abr[g * SP + pp], ai = abi[g * SP + pp];
        float br[16], bi[16], cr[16], ci[16];
#pragma unroll
        for (int ch = 0; ch < 16; ++ch) { br[ch] = bbr[(g * SP + pp) * SC + ch]; bi[ch] = bbi[(g * SP + pp) * SC + ch];
            cr[ch] = p.in[I_CRE][(g * SC + ch) * SP + pp]; ci[ch] = p.in[I_CIM][(g * SC + ch) * SP + pp]; }
        const float dsk = (pp < 16) ? p.in[I_SD][g * SC + pp] : 0.f;
        float sr = 0.f, si = 0.f;
        for (int l = 0; l < SEQ; ++l) {
            const bf16_t* up = AP + ((size_t)(g * (NB * NCHUNK) + b * NCHUNK + (l >> 4)) * APK + (l & 15) * 16);
            const u32x4 u0 = *(const u32x4*)up, u1 = *(const u32x4*)(up + 8);
            float u[16] = { __uint_as_float(u0.x << 16), __uint_as_float(u0.x & 0xffff0000u), __uint_as_float(u0.y << 16), __uint_as_float(u0.y & 0xffff0000u),
                            __uint_as_float(u0.z << 16), __uint_as_float(u0.z & 0xffff0000u), __uint_as_float(u0.w << 16), __uint_as_float(u0.w & 0xffff0000u),
                            __uint_as_float(u1.x << 16), __uint_as_float(u1.x & 0xffff0000u), __uint_as_float(u1.y << 16), __uint_as_float(u1.y & 0xffff0000u),
                            __uint_as_float(u1.z << 16), __uint_as_float(u1.z & 0xffff0000u), __uint_as_float(u1.w << 16), __uint_as_float(u1.w & 0xffff0000u) };
            float bur = 0.f, bui = 0.f;
#pragma unroll
            for (int ch = 0; ch < 16; ++ch) { bur += u[ch] * br[ch]; bui += u[ch] * bi[ch]; }
            const float nr = ar * sr - ai * si + bur, ni = ar * si + ai * sr + bui; sr = nr; si = ni;
            float mine = 0.f;
#pragma unroll
            for (int ch = 0; ch < 16; ++ch) { const float v = wave_sum(sr * cr[ch] - si * ci[ch]); if (pp == ch) mine = v + dsk * u[ch]; }
            if (pp < 16) Y[((size_t)b * SEQ + l) * 512 + g * 16 + pp] = f2bf(gelu_tanh(mine));
        }
    }
}

struct EpiGlu {
    const bf16_t* Y; bf16_t* MX; float* ss;
    __device__ __forceinline__ void operator()(int row, int col, const f32x4& a, const f32x4&, int) const {
        const u32x2 yv = *(const u32x2*)(Y + (size_t)row * 512 + col);
        const float y0 = __uint_as_float(yv.x << 16), y1 = __uint_as_float(yv.x & 0xffff0000u), y2 = __uint_as_float(yv.y << 16), y3 = __uint_as_float(yv.y & 0xffff0000u);
        const float v0 = y0 * sigmoidf(a[0]), v1 = y1 * sigmoidf(a[1]), v2 = y2 * sigmoidf(a[2]), v3 = y3 * sigmoidf(a[3]);
        u32x2 w; w.x = pk2(v0, v1); w.y = pk2(v2, v3); *(u32x2*)(MX + (size_t)row * 1024 + 512 + col) = w;
        float s = v0 * v0 + v1 * v1 + v2 * v2 + v3 * v3;
#pragma unroll
        for (int o = 1; o < 32; o <<= 1) s += __shfl_xor(s, o);
        if ((threadIdx.x & 31) == 0) atomicAdd(ss + row, s);
    }
};
__device__ __forceinline__ void ph_ssm_norm(const Ctx& c, const Params& p) {
    bf16_t* MX = (bf16_t*)(c.ws + WS_MIXIN); const float* ss = (const float*)(c.ws + WS_CTL + CTL_SS1);
    for (int t = c.gwave; t < T; t += c.gwaves) {
        const float rstd = rsqrtf(ss[t] * (1.f / 512.f) + EPS);
        bf16_t* r = MX + (size_t)t * 1024 + 512 + c.lane * 8; const float* g = p.in[I_SNG] + c.lane * 8;
        u32x4 w = *(u32x4*)r; unsigned* wp = (unsigned*)&w;
#pragma unroll
        for (int i = 0; i < 4; ++i) { const float a = __uint_as_float(wp[i] << 16) * rstd * g[2 * i], b = __uint_as_float(wp[i] & 0xffff0000u) * rstd * g[2 * i + 1]; wp[i] = pk2(a, b); }
        *(u32x4*)r = w;
    }
}
__device__ __forceinline__ void ph_ssm_norm2(const Ctx& c, const Params& p) {
    bf16_t* MX = (bf16_t*)(c.ws + WS_MIXIN); const float* ss = (const float*)(c.ws + WS_SS1P);
    constexpr int R = 8;
    float g[8];
#pragma unroll
    for (int i = 0; i < 8; ++i) g[i] = p.in[I_SNG][c.lane * 8 + i];
    for (int t0 = c.gwave * R; t0 < T; t0 += c.gwaves * R) {
        u32x4 w[R]; f32x4 s0[R], s1[R];
#pragma unroll
        for (int j = 0; j < R; ++j) { const size_t t = (size_t)(t0 + j); w[j] = *(const u32x4*)(MX + t * 1024 + 512 + c.lane * 8); s0[j] = *(const f32x4*)(ss + t * 8); s1[j] = *(const f32x4*)(ss + t * 8 + 4); }
#pragma unroll
        for (int j = 0; j < R; ++j) {
            const float tot = ((s0[j].x + s0[j].y) + (s0[j].z + s0[j].w)) + ((s1[j].x + s1[j].y) + (s1[j].z + s1[j].w));
            const float rstd = rsqrtf(tot * (1.f / 512.f) + EPS);
            unsigned* wp = (unsigned*)&w[j];
#pragma unroll
            for (int i = 0; i < 4; ++i) { const float a = __uint_as_float(wp[i] << 16) * rstd * g[2 * i], b = __uint_as_float(wp[i] & 0xffff0000u) * rstd * g[2 * i + 1]; wp[i] = pk2(a, b); }
            *(u32x4*)(MX + (size_t)(t0 + j) * 1024 + 512 + c.lane * 8) = w[j];
        }
    }
}
struct EpiWout {
    const float* x; const float* mod; float* out; float* ss;
    __device__ __forceinline__ void operator()(int row, int col, const f32x4& a, const f32x4&, int) const {
        const int b = row / SEQ; const f32x4 xv = *(const f32x4*)(x + (size_t)row * DM + col), g1 = *(const f32x4*)(mod + b * 6 * DM + 2 * DM + col);
        const f32x4 o = {xv.x + g1.x * a[0], xv.y + g1.y * a[1], xv.z + g1.z * a[2], xv.w + g1.w * a[3]};
        *(f32x4*)(out + (size_t)row * DM + col) = o;
        float s = o.x * o.x + o.y * o.y + o.z * o.z + o.w * o.w;
#pragma unroll
        for (int of = 1; of < 32; of <<= 1) s += __shfl_xor(s, of);
        if ((threadIdx.x & 31) == 0) atomicAdd(ss + row, s);
    }
};
__device__ __forceinline__ void ph_h2(const Ctx& c, const Params& p) {
    const float* mod = (const float*)(c.ws + WS_MOD); bf16_t* H = (bf16_t*)(c.ws + WS_H);
    const float* ss = (const float*)(c.ws + WS_CTL + CTL_SS2);
    for (int t = c.gwave; t < T; t += c.gwaves) {
        const int b = t / SEQ; const f32x4* xr = (const f32x4*)(p.out + (size_t)t * DM) + c.lane;
        const float rstd = rsqrtf(ss[t] * (1.f / DM) + EPS);
        const float* sh = mod + b * 6 * DM + 3 * DM, * sc = sh + DM;
#pragma unroll
        for (int j = 0; j < 4; ++j) { const int col = 4 * c.lane + 256 * j; const f32x4 v = xr[64 * j];
            const f32x4 g = *(const f32x4*)(p.in[I_N2G] + col), s1 = *(const f32x4*)(sc + col), h1 = *(const f32x4*)(sh + col);
            const f32x4 o = (v * rstd * g) * (1.f + s1) + h1;
            u32x2 w; w.x = pk2(o.x, o.y); w.y = pk2(o.z, o.w); *(u32x2*)(H + (size_t)t * DM + col) = w; }
    }
}
__device__ __forceinline__ void ph_h2_2(const Ctx& c, const Params& p) {
    const float* mod = (const float*)(c.ws + WS_MOD); bf16_t* H = (bf16_t*)(c.ws + WS_H);
    const float* ss = (const float*)(c.ws + WS_SS2P);
    constexpr int R = 4;
    for (int t0 = c.gwave * R; t0 < T; t0 += c.gwaves * R) {
        const int b = t0 / SEQ;
        f32x4 v[R][4], sv[R][4];
#pragma unroll
        for (int j = 0; j < R; ++j) { const f32x4* xr = (const f32x4*)(p.out + (size_t)(t0 + j) * DM) + c.lane;
#pragma unroll
            for (int q = 0; q < 4; ++q) { v[j][q] = xr[64 * q]; sv[j][q] = *(const f32x4*)(ss + (size_t)(t0 + j) * 16 + 4 * q); } }
        const float* sh = mod + b * 6 * DM + 3 * DM, * sc = sh + DM;
        f32x4 ca[4], cb[4];
#pragma unroll
        for (int q = 0; q < 4; ++q) { const int col = 4 * c.lane + 256 * q; ca[q] = *(const f32x4*)(p.in[I_N2G] + col) * (1.f + *(const f32x4*)(sc + col)); cb[q] = *(const f32x4*)(sh + col); }
#pragma unroll
        for (int j = 0; j < R; ++j) {
            float tot = 0.f;
#pragma unroll
            for (int q = 0; q < 4; ++q) tot += (sv[j][q].x + sv[j][q].y) + (sv[j][q].z + sv[j][q].w);
            const float rstd = rsqrtf(tot * (1.f / DM) + EPS);
#pragma unroll
            for (int q = 0; q < 4; ++q) { const int col = 4 * c.lane + 256 * q; const f32x4 o = (v[j][q] * rstd) * ca[q] + cb[q];
                u32x2 w; w.x = pk2(o.x, o.y); w.y = pk2(o.z, o.w); *(u32x2*)(H + (size_t)(t0 + j) * DM + col) = w; }
        }
    }
}
__device__ __forceinline__ void ph_h2_3(const Ctx& c, const Params& p) {
    const float* mod = (const float*)(c.ws + WS_MOD); bf16_t* H = (bf16_t*)(c.ws + WS_H); unsigned char* H8 = c.ws + WS_H8;
    const float* ss = (const float*)(c.ws + WS_SS2P);
    constexpr int R = 4;
    for (int t0 = c.gwave * R; t0 < T; t0 += c.gwaves * R) {
        const int b = t0 / SEQ;
        f32x4 v[R][4], sv[R][4];
#pragma unroll
        for (int j = 0; j < R; ++j) { const f32x4* xr = (const f32x4*)(p.out + (size_t)(t0 + j) * DM) + c.lane;
#pragma unroll
            for (int q = 0; q < 4; ++q) { v[j][q] = xr[64 * q]; sv[j][q] = *(const f32x4*)(ss + (size_t)(t0 + j) * 16 + 4 * q); } }
        const float* sh = mod + b * 6 * DM + 3 * DM, * sc = sh + DM;
        f32x4 ca[4], cb[4];
#pragma unroll
        for (int q = 0; q < 4; ++q) { const int col = 4 * c.lane + 256 * q; ca[q] = *(const f32x4*)(p.in[I_N2G] + col) * (1.f + *(const f32x4*)(sc + col)); cb[q] = *(const f32x4*)(sh + col); }
#pragma unroll
        for (int j = 0; j < R; ++j) {
            float tot = 0.f;
#pragma unroll
            for (int q = 0; q < 4; ++q) tot += (sv[j][q].x + sv[j][q].y) + (sv[j][q].z + sv[j][q].w);
            const float rstd = rsqrtf(tot * (1.f / DM) + EPS);
#pragma unroll
            for (int q = 0; q < 4; ++q) { const int col = 4 * c.lane + 256 * q; const f32x4 o = (v[j][q] * rstd) * ca[q] + cb[q];
                u32x2 w; w.x = pk2(o.x, o.y); w.y = pk2(o.z, o.w); *(u32x2*)(H + (size_t)(t0 + j) * DM + col) = w;
                *(unsigned*)(H8 + (size_t)(t0 + j) * DM + col) = pk4_fp8(o.x, o.y, o.z, o.w); }
        }
    }
}
struct EpiLogits { float* L; __device__ __forceinline__ void operator()(int row, int col, const f32x4& a, const f32x4&, int) const { *(f32x4*)(L + (size_t)row * 256 + col) = (f32x4){a[0], a[1], a[2], a[3]}; } };
struct EpiSwiglu { bf16_t* O; int ldo;
    __device__ __forceinline__ void operator()(int row, int col, const f32x4& a, const f32x4& b, int) const {
        u32x2 w; w.x = pk2(siluf(a[0]) * b[0], siluf(a[1]) * b[1]); w.y = pk2(siluf(a[2]) * b[2], siluf(a[3]) * b[3]); *(u32x2*)(O + (size_t)row * ldo + col) = w; } };

__device__ __forceinline__ void ph_route(const Ctx& c, const Params& p) {
    const float* L = (const float*)(c.ws + WS_LOGITS);
    int* eidx = (int*)(c.ws + WS_EIDX); float* gw = (float*)(c.ws + WS_GATEW); unsigned* counts = (unsigned*)(c.ws + WS_CTL) + CW_COUNTS;
    const int l = c.lane; const float NEG = -__builtin_inff();
    float rb[4];
#pragma unroll
    for (int r = 0; r < 4; ++r) rb[r] = p.in[I_RB][l + 64 * r];
    for (int t = c.gwave; t < T; t += c.gwaves) {
        float s[4], sb[4];
#pragma unroll
        for (int r = 0; r < 4; ++r) { s[r] = sigmoidf(L[(size_t)t * 256 + l + 64 * r]); sb[r] = s[r] + rb[r]; }
        float gs[4];
#pragma unroll
        for (int r = 0; r < 4; ++r) {
            float m1 = sb[r]; int i1 = l;
#pragma unroll
            for (int o = 1; o < 32; o <<= 1) { const float om = __shfl_xor(m1, o); const int oi = __shfl_xor(i1, o); if (om > m1 || (om == m1 && oi < i1)) { m1 = om; i1 = oi; } }
            float m2 = (l == i1) ? NEG : sb[r];
#pragma unroll
            for (int o = 1; o < 32; o <<= 1) m2 = fmaxf(m2, __shfl_xor(m2, o));
            gs[r] = m1 + m2;
        }
        float gsc[8];
#pragma unroll
        for (int r = 0; r < 4; ++r) { gsc[2 * r] = __shfl(gs[r], 0); gsc[2 * r + 1] = __shfl(gs[r], 32); }
        unsigned gmask = 0;
#pragma unroll
        for (int a = 0; a < 8; ++a) { int rank = 0;
#pragma unroll
            for (int b2 = 0; b2 < 8; ++b2) rank += (gsc[b2] > gsc[a] || (gsc[b2] == gsc[a] && b2 < a)) ? 1 : 0;
            if (rank < TOPG) gmask |= 1u << a; }
        float mv[4];
#pragma unroll
        for (int r = 0; r < 4; ++r) mv[r] = ((gmask >> (2 * r + (l >> 5))) & 1u) ? sb[r] : NEG;
        float wsel = 0.f; int esel = -1; float wsum = 0.f;
#pragma unroll
        for (int k = 0; k < TOPK; ++k) {
            float bm = mv[0]; int bi = l;
#pragma unroll
            for (int r = 1; r < 4; ++r) if (mv[r] > bm) { bm = mv[r]; bi = l + 64 * r; }
#pragma unroll
            for (int o = 1; o < 64; o <<= 1) { const float om = __shfl_xor(bm, o); const int oi = __shfl_xor(bi, o); if (om > bm || (om == bm && oi < bi)) { bm = om; bi = oi; } }
            float sv = 0.f;
#pragma unroll
            for (int r = 0; r < 4; ++r) if (bi == l + 64 * r) { sv = s[r]; mv[r] = NEG; }
            sv = __shfl(sv, bi & 63);
            wsum += sv;
            if (l == k) { wsel = sv; esel = bi; }
        }
        if (l < TOPK) { eidx[t * 8 + l] = esel; gw[t * 8 + l] = wsel / wsum * ROUTED_SCALE; atomicAdd(counts + esel, 1u); }
    }
}
__device__ __forceinline__ void ph_slot(const Ctx& c, const Params& p) {
    const unsigned* counts = (const unsigned*)(c.ws + WS_CTL) + CW_COUNTS; unsigned* cursor = (unsigned*)(c.ws + WS_CTL) + CW_CURSOR;
    int* ps = (int*)c.lds;
    if (c.tid == 0) { int acc = 0; for (int e = 0; e < NE; ++e) { ps[e] = acc; acc += ((int)counts[e] + 255) / 256 * 256; } ps[NE] = acc; }
    __syncthreads();
    const int* eidx = (const int*)(c.ws + WS_EIDX); const float* gw = (const float*)(c.ws + WS_GATEW);
    int* stok = (int*)(c.ws + WS_SLOT_TOK); int* sasg = (int*)(c.ws + WS_SLOT_ASG); float* sgate = (float*)(c.ws + WS_SLOT_GATE);
    for (int a = c.gtid; a < T * TOPK; a += c.gthreads) {
        const int e = eidx[a]; const unsigned pos = atomicAdd(cursor + e, 1u); const int slot = ps[e] + (int)pos;
        stok[slot] = a >> 3; sasg[slot] = a; sgate[slot] = gw[a];
    }
    if (c.bid == 0) {
        int* te = (int*)(c.ws + WS_TILE_E); int* padst = (int*)(c.ws + WS_PADST);
        for (int e = c.tid; e <= NE; e += 512) padst[e] = ps[e];
        for (int e = c.tid; e < NE; e += 512) for (int tl = ps[e] / 256; tl < ps[e + 1] / 256; ++tl) te[tl] = e;
        if (c.tid == 0) ((unsigned*)(c.ws + WS_CTL))[CW_NTILES] = (unsigned)(ps[NE] / 256);
    }
}
struct EpiE2 { const int* sasg; const float* sgate; bf16_t* YA;
    __device__ __forceinline__ void operator()(int row, int col, const f32x4& a, const f32x4&, int) const {
        const int asg = sasg[row]; if (asg < 0) return; const float g = sgate[row];
        u32x2 w; w.x = pk2(g * a[0], g * a[1]); w.y = pk2(g * a[2], g * a[3]); *(u32x2*)(YA + (size_t)asg * DM + col) = w; } };
struct EpiSD { const float* mod; float* out;
    __device__ __forceinline__ void operator()(int row, int col, const f32x4& a, const f32x4&, int) const {
        const int b = row / SEQ; const f32x4 g2 = *(const f32x4*)(mod + b * 6 * DM + 5 * DM + col); f32x4* o = (f32x4*)(out + (size_t)row * DM + col);
        f32x4 v = *o; v.x += g2.x * a[0]; v.y += g2.y * a[1]; v.z += g2.z * a[2]; v.w += g2.w * a[3]; *o = v; } };
__device__ __forceinline__ void ph_combine(const Ctx& c, const Params& p) {
    const float* mod = (const float*)(c.ws + WS_MOD); const bf16_t* YA = (const bf16_t*)(c.ws + WS_YA); float* out = p.out;
    for (int idx = c.gtid; idx < T * (DM / 8); idx += c.gthreads) {
        const int t = idx >> 7, col = (idx & 127) * 8, b = t / SEQ;
        float s[8] = {0.f, 0.f, 0.f, 0.f, 0.f, 0.f, 0.f, 0.f};
#pragma unroll
        for (int k = 0; k < 8; ++k) { const u32x4 w = *(const u32x4*)(YA + ((size_t)t * 8 + k) * DM + col); const unsigned* wp = (const unsigned*)&w;
#pragma unroll
            for (int i = 0; i < 4; ++i) { s[2 * i] += __uint_as_float(wp[i] << 16); s[2 * i + 1] += __uint_as_float(wp[i] & 0xffff0000u); } }
        const float* g2 = mod + b * 6 * DM + 5 * DM + col; float* o = out + (size_t)t * DM + col;
        f32x4 o0 = *(f32x4*)o, o1 = *(f32x4*)(o + 4);
        o0.x += g2[0] * s[0]; o0.y += g2[1] * s[1]; o0.z += g2[2] * s[2]; o0.w += g2[3] * s[3];
        o1.x += g2[4] * s[4]; o1.y += g2[5] * s[5]; o1.z += g2[6] * s[6]; o1.w += g2[7] * s[7];
        *(f32x4*)o = o0; *(f32x4*)(o + 4) = o1;
    }
}


#define GAS __attribute__((address_space(1)))
#define LAS __attribute__((address_space(3)))
#define XB_TMO      128
#define XB_XCNT(j)  (256  + 64 * (j))
#define XB_XSUB(j)  (1280 + 64 * (j))
#define XB_XGEN(j)  (2304 + 64 * (j))
#define XB_TOP      3328
#define XB_TOPGEN   3392
#define XCD_BAR_WORDS 3456
#define XB_SPIN_CAP (1u << 18)

__device__ __forceinline__ unsigned xb_ld(unsigned* p)              { return __hip_atomic_load(p, __ATOMIC_RELAXED, __HIP_MEMORY_SCOPE_AGENT); }
__device__ __forceinline__ unsigned xb_add(unsigned* p, unsigned v) { return __hip_atomic_fetch_add(p, v, __ATOMIC_RELAXED, __HIP_MEMORY_SCOPE_AGENT); }
__device__ __forceinline__ unsigned xb_xcc_id() { return (unsigned)__builtin_amdgcn_s_getreg((3 << 11) | 20) & 0xFu; }
#define XB_SPIN(cond, bar) do { unsigned _sp = 0; while (cond) { __builtin_amdgcn_s_sleep(1); \
    if ((++_sp & 255u) == 0u) { if (xb_ld(&(bar)[XB_TMO])) break; if (_sp > XB_SPIN_CAP) { atomicAdd(&(bar)[XB_TMO], 1u); break; } } } } while (0)

struct XcdBarrier {
    unsigned* bar; unsigned x;
    volatile LAS unsigned* st;
};

__device__ __forceinline__ XcdBarrier xcd_barrier_post(unsigned* bar, volatile LAS unsigned* st) {
    XcdBarrier b; b.bar = bar; b.x = xb_xcc_id(); b.st = st;
    if (threadIdx.x == 0) (void)xb_add(&bar[XB_XCNT(b.x)], 1u);
    return b;
}
__device__ __forceinline__ void xcd_barrier_complete(unsigned* bar, unsigned x, unsigned& nloc, unsigned& nx) {
    const unsigned G = gridDim.x * gridDim.y * gridDim.z;
    unsigned sum, cnt, mine, sp = 0u;
    for (;;) {
        sum = 0u; cnt = 0u; mine = 0u;
#pragma unroll
        for (unsigned j = 0; j < 16; ++j) { const unsigned c = xb_ld(&bar[XB_XCNT(j)]); sum += c; cnt += (c > 0u) ? 1u : 0u; mine = (j == x) ? c : mine; }
        if (sum == G) break;
        __builtin_amdgcn_s_sleep(1);
        if ((++sp & 255u) == 0u) { if (xb_ld(&bar[XB_TMO])) break; if (sp > XB_SPIN_CAP) { atomicAdd(&bar[XB_TMO], 1u); break; } }
    }
    nloc = mine > 0u ? mine : 1u; nx = cnt > 0u ? cnt : 1u;
}

__device__ __forceinline__ void xcd_barrier(const XcdBarrier& b) {
    asm volatile("s_waitcnt vmcnt(0)" ::: "memory");
    __syncthreads();
    if (threadIdx.x == 0) {
        unsigned* bar = b.bar;
        __builtin_amdgcn_s_waitcnt(0);
        unsigned nloc = b.st[0], nx = b.st[1];
        if (nloc == 0u) { xcd_barrier_complete(bar, b.x, nloc, nx); b.st[0] = nloc; b.st[1] = nx; }
        const unsigned old = xb_add(&bar[XB_XSUB(b.x)], 1u);
        const unsigned gen = old / nloc;
        if (old + 1u == (gen + 1u) * nloc) {
            __builtin_amdgcn_fence(__ATOMIC_RELEASE, "agent");
            asm volatile("s_waitcnt vmcnt(0)" ::: "memory");
            const unsigned og = xb_add(&bar[XB_TOP], 1u);
            const unsigned tg = og / nx;
            if (og + 1u == (tg + 1u) * nx) xb_add(&bar[XB_TOPGEN], 1u);
            else XB_SPIN(xb_ld(&bar[XB_TOPGEN]) == tg, bar);
            __builtin_amdgcn_fence(__ATOMIC_ACQUIRE, "agent");
            xb_add(&bar[XB_XGEN(b.x)], 1u);
            asm volatile("s_waitcnt vmcnt(0)" ::: "memory");
        } else {
            XB_SPIN(xb_ld(&bar[XB_XGEN(b.x)]) == gen, bar);
            __builtin_amdgcn_fence(__ATOMIC_ACQUIRE, "agent");
            asm volatile("s_waitcnt vmcnt(0)" ::: "memory");
        }
    }
    __syncthreads();
}

namespace pg8 {
#define PG8_LAS __attribute__((address_space(3)))
typedef short bf16x8 __attribute__((ext_vector_type(8)));
typedef int v4i __attribute__((ext_vector_type(4)));
typedef int v8i __attribute__((ext_vector_type(8)));
constexpr int BM = 256, BK = 64, HALF = 128, HTB = HALF * BK * 2  , STAGE_BYTES = 8 * HTB;

__host__ __device__ __forceinline__ int lds_byte(int r, int c) { const int st = (r >> 4) * 2 + (c >> 5), rr = r & 15, cc = c & 31, ob = rr * 64 + cc * 2; return st * 1024 + (ob ^ (((ob >> 9) & 1) << 5)); }
__host__ __device__ __forceinline__ void stage_rc(int b, int& R, int& C) { const int st = b / 1024, sb = b % 1024, swz = sb ^ (((sb >> 9) & 1) << 5); R = (st >> 1) * 16 + swz / 64; C = (st & 1) * 32 + (swz % 64) / 2; }
__host__ __device__ __forceinline__ int perm32(int rho) { const int n = rho >> 4, i = rho & 15; return 8 * (i >> 2) + 4 * n + (i & 3); }

struct Unit { int pm, pn, pb; };
struct Gemm { const bf16_t* A; const bf16_t* Bt; int K, lda; const int* rowidx; unsigned scale_b = 0x7F7F7F7Fu, scale_a = 0x7F7F7F7Fu; };

__device__ __forceinline__ unsigned cvt_pk_bf16(float lo, float hi) { unsigned r; asm volatile("v_cvt_pk_bf16_f32 %0, %1, %2" : "=v"(r) : "v"(lo), "v"(hi)); return r; }

template <class Epi, class Sched, bool GATHER, bool ALIGN_EPI, bool FP8 = false, int FIXED_NT = 0>
__device__ __forceinline__ void gemm_phase(PG8_LAS unsigned char* lds, const Gemm g, const Sched& S, const Epi& E) {
    int tid_ = threadIdx.x; asm volatile("" : "+v"(tid_));
    const int tid = tid_, wid = __builtin_amdgcn_readfirstlane(tid >> 6), lane = tid & 63, wr = wid >> 2, wc = wid & 3, fr = lane & 15, fq = lane >> 4;
    int K_ = g.K; asm volatile("" : "+s"(K_));
    const int K = K_, nt = K / BK, lda = g.lda;
    unsigned voffB[2], oc[2][2], on[2][2];
#pragma unroll
    for (int i = 0; i < 2; ++i) { int R, C; stage_rc(tid * 16 + i * 8192, R, C); const int Rb = Epi::PERM ? ((R & ~31) + perm32(R & 31)) : R;
        voffB[i] = (unsigned)(Rb * K + C) * 2u;
        oc[0][i] = (unsigned)(R * lda + C) * 2u; oc[1][i] = (unsigned)((R + HALF) * lda + C) * 2u; on[0][i] = oc[0][i]; on[1][i] = oc[1][i]; }
    const size_t kstep = (size_t)(BK * 2);
    const size_t hstep = (size_t)HALF * K * 2;
    const size_t tstepB = 2 * hstep, tstepA = (size_t)BM * lda * 2;
    const unsigned ldsw = (unsigned)wid * 1024u;
    const int aoff = lds_byte(wr * 64 + fr, fq * 8), boff = lds_byte(wc * 32 + fr, fq * 8);
#define PG8_SA(b, h) (((b) * 2 + (h)) * HTB)
#define PG8_SB(b, h) ((4 + (b) * 2 + (h)) * HTB)
#define PG8_STAGE(bufoff, gbase, voff) do { _Pragma("unroll") for (int _i = 0; _i < 2; ++_i) \
        __builtin_amdgcn_global_load_lds((const unsigned*)((const char*)(gbase) + (voff)[_i]), (PG8_LAS unsigned*)(lds + (bufoff) + ldsw + _i * 8192), 16, 0, 0); } while (0)
#define PG8_LDA(dst, b, h) do { if constexpr (FP8) { _Pragma("unroll") for (int m = 0; m < 4; ++m) { const v4i lo_ = *(const PG8_LAS v4i*)(lds + PG8_SA(b, h) + aoff + m * 2048), hi_ = *(const PG8_LAS v4i*)(lds + PG8_SA(b, h) + aoff + m * 2048 + 1024); \
            dst##8[m] = __builtin_shufflevector(lo_, hi_, 0, 1, 2, 3, 4, 5, 6, 7); } } \
        else { _Pragma("unroll") for (int m = 0; m < 4; ++m) _Pragma("unroll") for (int k = 0; k < 2; ++k) dst[m][k] = *(const PG8_LAS bf16x8*)(lds + PG8_SA(b, h) + aoff + m * 2048 + k * 1024); } } while (0)
#define PG8_LDB(dst, b, h) do { if constexpr (FP8) { _Pragma("unroll") for (int n = 0; n < 2; ++n) { const v4i lo_ = *(const PG8_LAS v4i*)(lds + PG8_SB(b, h) + boff + n * 2048), hi_ = *(const PG8_LAS v4i*)(lds + PG8_SB(b, h) + boff + n * 2048 + 1024); \
            dst##8[n] = __builtin_shufflevector(lo_, hi_, 0, 1, 2, 3, 4, 5, 6, 7); } } \
        else { _Pragma("unroll") for (int n = 0; n < 2; ++n) _Pragma("unroll") for (int k = 0; k < 2; ++k) dst[n][k] = *(const PG8_LAS bf16x8*)(lds + PG8_SB(b, h) + boff + n * 2048 + k * 1024); } } while (0)
#define PG8_MMA(ai, bj, At, Bt) do { __builtin_amdgcn_s_setprio(1); \
        if constexpr (FP8) {   \
            _Pragma("unroll") for (int m = 0; m < 4; ++m) _Pragma("unroll") for (int n = 0; n < 2; ++n) { \
                acc[ai][bj][m][n] = __builtin_amdgcn_mfma_scale_f32_16x16x128_f8f6f4(Bt##8[n], At##8[m], acc[ai][bj][m][n], 0, 0, 0, (int)g.scale_b, 0, (int)g.scale_a); } \
        } else { \
            _Pragma("unroll") for (int m = 0; m < 4; ++m) _Pragma("unroll") for (int n = 0; n < 2; ++n) _Pragma("unroll") for (int k = 0; k < 2; ++k) \
                acc[ai][bj][m][n] = __builtin_amdgcn_mfma_f32_16x16x32_bf16(Bt[n][k], At[m][k], acc[ai][bj][m][n], 0, 0, 0); } \
        __builtin_amdgcn_s_setprio(0); } while (0)
#define PG8_WAIT_V(n) asm volatile("s_waitcnt vmcnt(" #n ")" ::: "memory")
#define PG8_WAIT_V8S() do { if (FIXED_NT == 2 || (Epi::NSTORE > 0 && fresh)) asm volatile("s_waitcnt vmcnt(%0)" :: "i"(8 + Epi::NSTORE) : "memory"); else asm volatile("s_waitcnt vmcnt(8)" ::: "memory"); } while (0)
#define PG8_WAIT_L(n) asm volatile("s_waitcnt lgkmcnt(" #n ")" ::: "memory")
#define PG8_BAR __builtin_amdgcn_s_barrier()
#define PG8_SCHED __builtin_amdgcn_sched_barrier(0)
#define PG8_GIDX(dst, unit) do { _Pragma("unroll") for (int _i = 0; _i < 2; ++_i) { int R_, C_; stage_rc(tid * 16 + _i * 8192, R_, C_); \
        const int r0_ = g.rowidx ? g.rowidx[(unit).pm * BM + R_] : (unit).pm * BM + R_, r1_ = g.rowidx ? g.rowidx[(unit).pm * BM + HALF + R_] : (unit).pm * BM + HALF + R_; \
        dst[0][_i] = (unsigned)(r0_ * lda + C_) * 2u; dst[1][_i] = (unsigned)(r1_ * lda + C_) * 2u; } } while (0)
    Unit cur, nxt; int ui = 0;
    if (!S.next(0, cur)) return;
    f32x4 acc[2][2][4][2];
#pragma unroll
    for (int a = 0; a < 2; ++a)
#pragma unroll
        for (int b = 0; b < 2; ++b)
#pragma unroll
            for (int m = 0; m < 4; ++m)
#pragma unroll
                for (int n = 0; n < 2; ++n) acc[a][b][m][n] = (f32x4){0.f, 0.f, 0.f, 0.f};
    bf16x8 At[4][2], B0[2][2], B1[2][2]; v8i At8[4], B08[2], B18[2];
    if constexpr (GATHER) { PG8_GIDX(oc, cur); }
    const char* cA = GATHER ? (const char*)g.A : (const char*)g.A + (size_t)cur.pm * tstepA; const char* cB = (const char*)g.Bt + (size_t)cur.pb * tstepB;
    PG8_STAGE(PG8_SB(0, 0), cB, voffB); PG8_STAGE(PG8_SB(0, 1), cB + hstep, voffB); PG8_STAGE(PG8_SA(0, 0), cA, oc[0]); PG8_STAGE(PG8_SA(0, 1), cA, oc[1]);
    if (wr == 1) PG8_BAR;
    PG8_WAIT_V(2); PG8_BAR;
    PG8_STAGE(PG8_SB(1, 0), cB + kstep, voffB); PG8_STAGE(PG8_SA(1, 0), cA + kstep, oc[0]); PG8_STAGE(PG8_SB(1, 1), cB + hstep + kstep, voffB);
    PG8_WAIT_V(6); PG8_BAR;
    if constexpr (FIXED_NT == 2) { PG8_WAIT_V(0); PG8_BAR; }
    bool fresh = false;
    for (;;) {
        const bool has_next = S.next(ui + 1, nxt);
        if constexpr (GATHER) { if (has_next) { PG8_GIDX(on, nxt); } }
        const char* nA = has_next ? (GATHER ? (const char*)g.A : (const char*)g.A + (size_t)nxt.pm * tstepA) : cA; const char* nB = has_next ? (const char*)g.Bt + (size_t)nxt.pb * tstepB : cB;
#pragma unroll 1
        for (int t = 0; t < nt; t += 2) {
            const bool last = (t == nt - 2);
            const char* a1 = cA + (size_t)(t + 1) * kstep;
            const char* a2 = last ? nA : cA + (size_t)(t + 2) * kstep; const char* b2 = last ? nB : cB + (size_t)(t + 2) * kstep;
            const char* a3 = a2 + kstep; const char* b3 = b2 + kstep;
            PG8_LDB(B0, 0, 0); PG8_LDB(B1, 0, 1); PG8_SCHED; PG8_LDA(At, 0, 0); PG8_STAGE(PG8_SA(1, 1), a1, oc[1]);
            if constexpr (GATHER) { if (last && has_next) { oc[0][0] = on[0][0]; oc[0][1] = on[0][1]; oc[1][0] = on[1][0]; oc[1][1] = on[1][1]; } }
            PG8_WAIT_V8S(); PG8_WAIT_L(0); PG8_BAR; PG8_MMA(0, 0, At, B0); PG8_MMA(0, 1, At, B1); PG8_BAR; PG8_SCHED;
            PG8_LDA(At, 0, 1); PG8_STAGE(PG8_SB(0, 0), b2, voffB); PG8_STAGE(PG8_SB(0, 1), b2 + hstep, voffB); PG8_STAGE(PG8_SA(0, 0), a2, oc[0]);
            PG8_WAIT_V8S(); fresh = false; PG8_WAIT_L(0); PG8_BAR; PG8_MMA(1, 0, At, B0); PG8_MMA(1, 1, At, B1); PG8_BAR; PG8_SCHED;
            PG8_LDB(B0, 1, 0); PG8_LDB(B1, 1, 1); PG8_SCHED; PG8_LDA(At, 1, 0); PG8_STAGE(PG8_SA(0, 1), a2, oc[1]);
            PG8_WAIT_V(8); PG8_WAIT_L(0); PG8_BAR; PG8_MMA(0, 0, At, B0); PG8_MMA(0, 1, At, B1); PG8_BAR; PG8_SCHED;
            PG8_LDA(At, 1, 1); PG8_STAGE(PG8_SB(1, 0), b3, voffB); PG8_STAGE(PG8_SB(1, 1), b3 + hstep, voffB); PG8_STAGE(PG8_SA(1, 0), a3, oc[0]);
            PG8_WAIT_V(8); PG8_WAIT_L(0); PG8_BAR; PG8_MMA(1, 0, At, B0); PG8_MMA(1, 1, At, B1); PG8_BAR; PG8_SCHED;
        }
        if constexpr (ALIGN_EPI) { if (wr == 0) PG8_BAR; }
        E(acc, cur, wr, wc, fr, fq);
        if (!has_next) break;
#pragma unroll
        for (int a = 0; a < 2; ++a)
#pragma unroll
            for (int b = 0; b < 2; ++b)
#pragma unroll
                for (int m = 0; m < 4; ++m)
#pragma unroll
                    for (int n = 0; n < 2; ++n) acc[a][b][m][n] = (f32x4){0.f, 0.f, 0.f, 0.f};
        cur = nxt; cA = nA; cB = nB; ++ui; fresh = true;
        if constexpr (ALIGN_EPI) { if (wr == 1) PG8_BAR; }
    }
    PG8_WAIT_V(0);
    if constexpr (!ALIGN_EPI) { if (wr == 0) PG8_BAR; }
    PG8_BAR;
#undef PG8_SA
#undef PG8_SB
#undef PG8_STAGE
#undef PG8_LDA
#undef PG8_LDB
#undef PG8_MMA
#undef PG8_WAIT_V
#undef PG8_WAIT_V8S
#undef PG8_WAIT_L
#undef PG8_BAR
#undef PG8_SCHED
#undef PG8_GIDX
}

struct DenseOrder {
    int nM, nN, nwg, G, c;
    __device__ __forceinline__ void init(int M, int N, int G_, int c_) { nM = M / BM; nN = N / BM; nwg = nM * nN; G = G_; c = c_; }
    __device__ __forceinline__ bool next(int i, Unit& u) const {
        const long L = (long)i * G + c; if (L >= nwg) return false;
        int wgid = (int)L; { const int q = nwg / 8, r = nwg % 8, xcd = wgid % 8, off = wgid / 8; wgid = (xcd < r ? xcd * (q + 1) : r * (q + 1) + (xcd - r) * q) + off; }
        const int nig = 8 * nN, gid = wgid / nig, fm = gid * 8, gsz = (nM - fm) < 8 ? (nM - fm) : 8;
        u.pm = fm + ((wgid % nig) % gsz); u.pn = (wgid % nig) / gsz; u.pb = u.pn; return true;
    }
};
struct GroupedOrder {
    const int* tile_e; int ntiles, NT, G, vcu;
    __device__ __forceinline__ bool next(int i, Unit& u) const {
        const int L = i * G + vcu; if (L >= ntiles * NT) return false;
        const int mt = L / NT, nn = L - mt * NT; u.pm = mt; u.pn = nn; u.pb = tile_e[mt] * NT + nn; return true;
    }
};

#define EPI_ROWS_BEGIN const int row0 = u.pm * BM + wr * 64 + fr; _Pragma("unroll") for (int ai = 0; ai < 2; ++ai) _Pragma("unroll") for (int m = 0; m < 4; ++m) { const int row = row0 + ai * HALF + m * 16;
#define EPI_ROWS_END }
struct EpiWinF {
    static constexpr bool PERM = true; static constexpr int NSTORE = 16;
    bf16_t* QK; bf16_t* V; bf16_t* AP;
    __device__ __forceinline__ void operator()(const f32x4 (&acc)[2][2][4][2], const Unit& u, int wr, int wc, int fr, int fq) const {
        const int colt = u.pn * BM + wc * 32 + 8 * fq;
        EPI_ROWS_BEGIN
#pragma unroll
            for (int bj = 0; bj < 2; ++bj) { const f32x4 v0 = acc[ai][bj][m][0], v1 = acc[ai][bj][m][1]; const int col = colt + bj * HALF;
                u32x4 w; w.x = cvt_pk_bf16(v0[0], v0[1]); w.y = cvt_pk_bf16(v0[2], v0[3]); w.z = cvt_pk_bf16(v1[0], v1[1]); w.w = cvt_pk_bf16(v1[2], v1[3]);
                bf16_t* dst;
                if (u.pn < 4) dst = QK + (size_t)row * 1024 + col;
                else if (u.pn < 6) dst = V + (size_t)row * 512 + (col - 1024);
                else { const int cc = col - 1536, gg = cc >> 4, ch = cc & 15, b = row / SEQ, l = row % SEQ;
                    dst = AP + ((size_t)(gg * (NB * NCHUNK) + b * NCHUNK + (l >> 4)) * APK + (l & 15) * 16 + ch); }
                *(u32x4*)dst = w; }
        EPI_ROWS_END
    }
};
struct EpiGluF {
    static constexpr bool PERM = true; static constexpr int NSTORE = 0;
    const bf16_t* Y; bf16_t* MX; float* ss;
    __device__ __forceinline__ void operator()(const f32x4 (&acc)[2][2][4][2], const Unit& u, int wr, int wc, int fr, int fq) const {
        const int colt = u.pn * BM + wc * 32 + 8 * fq;
        EPI_ROWS_BEGIN
            float s = 0.f;
#pragma unroll
            for (int bj = 0; bj < 2; ++bj) { const int col = colt + bj * HALF; const u32x4 yv = *(const u32x4*)(Y + (size_t)row * 512 + col);
                const f32x4 a0 = acc[ai][bj][m][0], a1 = acc[ai][bj][m][1];
                float v[8];
                v[0] = __uint_as_float(yv.x << 16) * sigmoidf(a0[0]); v[1] = __uint_as_float(yv.x & 0xffff0000u) * sigmoidf(a0[1]);
                v[2] = __uint_as_float(yv.y << 16) * sigmoidf(a0[2]); v[3] = __uint_as_float(yv.y & 0xffff0000u) * sigmoidf(a0[3]);
                v[4] = __uint_as_float(yv.z << 16) * sigmoidf(a1[0]); v[5] = __uint_as_float(yv.z & 0xffff0000u) * sigmoidf(a1[1]);
                v[6] = __uint_as_float(yv.w << 16) * sigmoidf(a1[2]); v[7] = __uint_as_float(yv.w & 0xffff0000u) * sigmoidf(a1[3]);
#pragma unroll
                for (int i = 0; i < 8; ++i) s += v[i] * v[i];
                u32x4 w; w.x = cvt_pk_bf16(v[0], v[1]); w.y = cvt_pk_bf16(v[2], v[3]); w.z = cvt_pk_bf16(v[4], v[5]); w.w = cvt_pk_bf16(v[6], v[7]);
                *(u32x4*)(MX + (size_t)row * 1024 + 512 + col) = w; }
            s += __shfl_xor(s, 16); s += __shfl_xor(s, 32);
            if (fq == 0) ss[(size_t)row * 8 + u.pn * 4 + wc] = s;
        EPI_ROWS_END
    }
};
struct EpiWoutF {
    static constexpr bool PERM = false; static constexpr int NSTORE = 0;
    const float* x; const float* mod; float* out; float* ss;
    __device__ __forceinline__ void operator()(const f32x4 (&acc)[2][2][4][2], const Unit& u, int wr, int wc, int fr, int fq) const {
        const int colt = u.pn * BM + wc * 32 + 4 * fq;
        EPI_ROWS_BEGIN
            const int b = row / SEQ; float s = 0.f;
#pragma unroll
            for (int bj = 0; bj < 2; ++bj)
#pragma unroll
                for (int n = 0; n < 2; ++n) { const int col = colt + bj * HALF + n * 16;
                    const f32x4 xv = *(const f32x4*)(x + (size_t)row * DM + col), g1 = *(const f32x4*)(mod + b * 6 * DM + 2 * DM + col);
                    const f32x4 o = xv + g1 * acc[ai][bj][m][n];
                    *(f32x4*)(out + (size_t)row * DM + col) = o; s += o[0] * o[0] + o[1] * o[1] + o[2] * o[2] + o[3] * o[3]; }
            s += __shfl_xor(s, 16); s += __shfl_xor(s, 32);
            if (fq == 0) ss[(size_t)row * 16 + u.pn * 4 + wc] = s;
        EPI_ROWS_END
    }
};
struct EpiRSF {
    static constexpr bool PERM = true; static constexpr int NSTORE = 0;
    float* L; bf16_t* AS;
    __device__ __forceinline__ void operator()(const f32x4 (&acc)[2][2][4][2], const Unit& u, int wr, int wc, int fr, int fq) const {
        const int c8 = wc * 32 + 8 * fq;
        EPI_ROWS_BEGIN
            if (u.pn == 0) {
#pragma unroll
                for (int bj = 0; bj < 2; ++bj) { float* d = L + (size_t)row * 256 + bj * HALF + c8; *(f32x4*)d = acc[ai][bj][m][0]; *(f32x4*)(d + 4) = acc[ai][bj][m][1]; }
            } else {
                const f32x4 g0 = acc[ai][0][m][0], g1 = acc[ai][0][m][1], u0 = acc[ai][1][m][0], u1 = acc[ai][1][m][1];
                u32x4 w; w.x = cvt_pk_bf16(siluf(g0[0]) * u0[0], siluf(g0[1]) * u0[1]); w.y = cvt_pk_bf16(siluf(g0[2]) * u0[2], siluf(g0[3]) * u0[3]);
                w.z = cvt_pk_bf16(siluf(g1[0]) * u1[0], siluf(g1[1]) * u1[1]); w.w = cvt_pk_bf16(siluf(g1[2]) * u1[2], siluf(g1[3]) * u1[3]);
                *(u32x4*)(AS + (size_t)row * 256 + (u.pn - 1) * 128 + c8) = w;
            }
        EPI_ROWS_END
    }
};
struct EpiSDF {
    static constexpr bool PERM = false; static constexpr int NSTORE = 0;
    const float* mod; float* out;
    __device__ __forceinline__ void operator()(const f32x4 (&acc)[2][2][4][2], const Unit& u, int wr, int wc, int fr, int fq) const {
        const int colt = u.pn * BM + wc * 32 + 4 * fq;
        EPI_ROWS_BEGIN
            const int b = row / SEQ;
#pragma unroll
            for (int bj = 0; bj < 2; ++bj)
#pragma unroll
                for (int n = 0; n < 2; ++n) { const int col = colt + bj * HALF + n * 16; const f32x4 g2 = *(const f32x4*)(mod + b * 6 * DM + 5 * DM + col);
                    f32x4* o = (f32x4*)(out + (size_t)row * DM + col); *o = *o + g2 * acc[ai][bj][m][n]; }
        EPI_ROWS_END
    }
};
struct EpiE1F {
    static constexpr bool PERM = true; static constexpr int NSTORE = 0;
    bf16_t* AE;
    __device__ __forceinline__ void operator()(const f32x4 (&acc)[2][2][4][2], const Unit& u, int wr, int wc, int fr, int fq) const {
        const int c8 = u.pn * 128 + wc * 32 + 8 * fq;
        EPI_ROWS_BEGIN
            const f32x4 g0 = acc[ai][0][m][0], g1 = acc[ai][0][m][1], u0 = acc[ai][1][m][0], u1 = acc[ai][1][m][1];
            u32x4 w; w.x = cvt_pk_bf16(siluf(g0[0]) * u0[0], siluf(g0[1]) * u0[1]); w.y = cvt_pk_bf16(siluf(g0[2]) * u0[2], siluf(g0[3]) * u0[3]);
            w.z = cvt_pk_bf16(siluf(g1[0]) * u1[0], siluf(g1[1]) * u1[1]); w.w = cvt_pk_bf16(siluf(g1[2]) * u1[2], siluf(g1[3]) * u1[3]);
            *(u32x4*)(AE + (size_t)row * 256 + c8) = w;
        EPI_ROWS_END
    }
};
struct EpiE2F {
    static constexpr bool PERM = true; static constexpr int NSTORE = 0;
    const int* sasg; const float* sgate; bf16_t* YA;
    __device__ __forceinline__ void operator()(const f32x4 (&acc)[2][2][4][2], const Unit& u, int wr, int wc, int fr, int fq) const {
        const int colt = u.pn * BM + wc * 32 + 8 * fq;
        EPI_ROWS_BEGIN
            const int asg = sasg[row]; const float gt = sgate[row];
            if (asg >= 0) {
#pragma unroll
                for (int bj = 0; bj < 2; ++bj) { const f32x4 v0 = acc[ai][bj][m][0] * gt, v1 = acc[ai][bj][m][1] * gt;
                    u32x4 w; w.x = cvt_pk_bf16(v0[0], v0[1]); w.y = cvt_pk_bf16(v0[2], v0[3]); w.z = cvt_pk_bf16(v1[0], v1[1]); w.w = cvt_pk_bf16(v1[2], v1[3]);
                    *(u32x4*)(YA + (size_t)asg * DM + colt + bj * HALF) = w; }
            }
        EPI_ROWS_END
    }
};
struct EpiSsmA {
    static constexpr bool PERM = false; static constexpr int NSTORE = 0;
    float* DS;
    __device__ __forceinline__ void operator()(const f32x4 (&acc)[2][2][4][2], const Unit& u, int wr, int wc, int fr, int fq) const {
        EPI_ROWS_BEGIN
#pragma unroll
            for (int n = 0; n < 2; ++n) *(f32x4*)(DS + (size_t)row * 128 + wc * 32 + n * 16 + 4 * fq) = acc[ai][0][m][n];
        EPI_ROWS_END
    }
};
struct EpiSsmC {
    static constexpr bool PERM = true; static constexpr int NSTORE = 0;
    bf16_t* Y;
    __device__ __forceinline__ void operator()(const f32x4 (&acc)[2][2][4][2], const Unit& u, int wr, int wc, int fr, int fq) const {
        EPI_ROWS_BEGIN
            const int gg = row >> 11, rem = row & 2047, b = rem >> 8, chunk = rem & 255; const size_t t0 = (size_t)b * SEQ + chunk * 16;
#pragma unroll
            for (int bj = 0; bj < 2; ++bj) { const int c0 = bj * HALF + wc * 32 + 8 * fq, jp = c0 >> 4, co0 = c0 & 15;
                const f32x4 v0 = acc[ai][bj][m][0], v1 = acc[ai][bj][m][1];
                u32x4 w; w.x = cvt_pk_bf16(gelu_tanh(v0[0]), gelu_tanh(v0[1])); w.y = cvt_pk_bf16(gelu_tanh(v0[2]), gelu_tanh(v0[3]));
                w.z = cvt_pk_bf16(gelu_tanh(v1[0]), gelu_tanh(v1[1])); w.w = cvt_pk_bf16(gelu_tanh(v1[2]), gelu_tanh(v1[3]));
                *(u32x4*)(Y + (t0 + jp) * 512 + gg * 16 + co0) = w; }
        EPI_ROWS_END
    }
};
struct EpiSDC {
    static constexpr bool PERM = true; static constexpr int NSTORE = 0;
    const float* mod; float* out; const bf16_t* YA;
    __device__ __forceinline__ void operator()(const f32x4 (&acc)[2][2][4][2], const Unit& u, int wr, int wc, int fr, int fq) const {
        const int colt = u.pn * BM + wc * 32 + 8 * fq;
        EPI_ROWS_BEGIN
            const int b = row / SEQ;
#pragma unroll
            for (int bj = 0; bj < 2; ++bj) { const int col = colt + bj * HALF;
                f32x4 s0 = acc[ai][bj][m][0], s1 = acc[ai][bj][m][1];
#pragma unroll
                for (int k = 0; k < 8; ++k) { const u32x4 w = *(const u32x4*)(YA + ((size_t)row * 8 + k) * DM + col);
                    s0[0] += __uint_as_float(w.x << 16); s0[1] += __uint_as_float(w.x & 0xffff0000u); s0[2] += __uint_as_float(w.y << 16); s0[3] += __uint_as_float(w.y & 0xffff0000u);
                    s1[0] += __uint_as_float(w.z << 16); s1[1] += __uint_as_float(w.z & 0xffff0000u); s1[2] += __uint_as_float(w.w << 16); s1[3] += __uint_as_float(w.w & 0xffff0000u); }
                const float* g2 = mod + b * 6 * DM + 5 * DM + col; float* o = out + (size_t)row * DM + col;
                *(f32x4*)o = *(const f32x4*)o + *(const f32x4*)g2 * s0; *(f32x4*)(o + 4) = *(const f32x4*)(o + 4) + *(const f32x4*)(g2 + 4) * s1; }
        EPI_ROWS_END
    }
};
struct EpiSDY {
    static constexpr bool PERM = true; static constexpr int NSTORE = 16;
    bf16_t* Y;
    __device__ __forceinline__ void operator()(const f32x4 (&acc)[2][2][4][2], const Unit& u, int wr, int wc, int fr, int fq) const {
        const int colt = u.pn * BM + wc * 32 + 8 * fq;
        EPI_ROWS_BEGIN
#pragma unroll
            for (int bj = 0; bj < 2; ++bj) { const f32x4 v0 = acc[ai][bj][m][0], v1 = acc[ai][bj][m][1];
                u32x4 w; w.x = cvt_pk_bf16(v0[0], v0[1]); w.y = cvt_pk_bf16(v0[2], v0[3]); w.z = cvt_pk_bf16(v1[0], v1[1]); w.w = cvt_pk_bf16(v1[2], v1[3]);
                *(u32x4*)(Y + (size_t)row * DM + colt + bj * HALF) = w; }
        EPI_ROWS_END
    }
};
struct EpiNone { static constexpr bool PERM = true; static constexpr int NSTORE = 0; float* sink;
    __device__ __forceinline__ void operator()(const f32x4 (&acc)[2][2][4][2], const Unit& u, int wr, int wc, int fr, int fq) const {
        float s = 0.f;
#pragma unroll
        for (int ai = 0; ai < 2; ++ai)
#pragma unroll
            for (int bj = 0; bj < 2; ++bj)
#pragma unroll
                for (int m = 0; m < 4; ++m)
#pragma unroll
                    for (int n = 0; n < 2; ++n) s += acc[ai][bj][m][n][0] + acc[ai][bj][m][n][1] + acc[ai][bj][m][n][2] + acc[ai][bj][m][n][3];
        if (s == 1234567.875f) sink[threadIdx.x] = s; } };
struct EpiDense { static constexpr bool PERM = true; static constexpr int NSTORE = 0; bf16_t* Y;
    __device__ __forceinline__ void operator()(const f32x4 (&acc)[2][2][4][2], const Unit& u, int wr, int wc, int fr, int fq) const {
        const int colt = u.pn * BM + wc * 32 + 8 * fq;
        EPI_ROWS_BEGIN
            if (row < T * 8) {
#pragma unroll
            for (int bj = 0; bj < 2; ++bj) { const f32x4 v0 = acc[ai][bj][m][0], v1 = acc[ai][bj][m][1];
                u32x4 w; w.x = cvt_pk_bf16(v0[0], v0[1]); w.y = cvt_pk_bf16(v0[2], v0[3]); w.z = cvt_pk_bf16(v1[0], v1[1]); w.w = cvt_pk_bf16(v1[2], v1[3]);
                *(u32x4*)(Y + (size_t)row * DM + colt + bj * HALF) = w; } }
        EPI_ROWS_END
    } };
struct ProbeOrder { int nunits, G, vcu;
    __device__ __forceinline__ bool next(int i, Unit& u) const { const int L = i * G + vcu; if (L >= nunits) return false; u.pm = vcu & 7; u.pn = 0; u.pb = vcu & 3; return true; } };
struct EpiE2S {
    static constexpr bool PERM = true; static constexpr int NSTORE = 16;
    const int* sasg; const float* sgate; bf16_t* YS;
    __device__ __forceinline__ void operator()(const f32x4 (&acc)[2][2][4][2], const Unit& u, int wr, int wc, int fr, int fq) const {
        const int colt = u.pn * BM + wc * 32 + 8 * fq; const int row0 = u.pm * BM + wr * 64 + fr;
        float gt[2][4];
#pragma unroll
        for (int ai = 0; ai < 2; ++ai)
#pragma unroll
            for (int m = 0; m < 4; ++m) gt[ai][m] = sgate[row0 + ai * HALF + m * 16];
        asm volatile("s_waitcnt vmcnt(0)" : "+v"(gt[0][0]), "+v"(gt[0][1]), "+v"(gt[0][2]), "+v"(gt[0][3]), "+v"(gt[1][0]), "+v"(gt[1][1]), "+v"(gt[1][2]), "+v"(gt[1][3]) :: "memory");
#pragma unroll
        for (int ai = 0; ai < 2; ++ai)
#pragma unroll
            for (int m = 0; m < 4; ++m) { const int row = row0 + ai * HALF + m * 16;
#pragma unroll
                for (int bj = 0; bj < 2; ++bj) { const f32x4 v0 = acc[ai][bj][m][0] * gt[ai][m], v1 = acc[ai][bj][m][1] * gt[ai][m];
                    u32x4 w; w.x = cvt_pk_bf16(v0[0], v0[1]); w.y = cvt_pk_bf16(v0[2], v0[3]); w.z = cvt_pk_bf16(v1[0], v1[1]); w.w = cvt_pk_bf16(v1[2], v1[3]);
                    *(u32x4*)(YS + (size_t)row * DM + colt + bj * HALF) = w; } }
    }
};
struct EpiE1F8 {
    static constexpr bool PERM = true; static constexpr int NSTORE = 0;
    unsigned char* AE;
    __device__ __forceinline__ void operator()(const f32x4 (&acc)[2][2][4][2], const Unit& u, int wr, int wc, int fr, int fq) const {
        const int c8 = u.pn * 128 + wc * 32 + 8 * fq;
        EPI_ROWS_BEGIN
            const f32x4 g0 = acc[ai][0][m][0], g1 = acc[ai][0][m][1], u0 = acc[ai][1][m][0], u1 = acc[ai][1][m][1];
            u32x2 w; w.x = pk4_fp8(ACT8_SCALE * siluf(g0[0]) * u0[0], ACT8_SCALE * siluf(g0[1]) * u0[1], ACT8_SCALE * siluf(g0[2]) * u0[2], ACT8_SCALE * siluf(g0[3]) * u0[3]);
            w.y = pk4_fp8(ACT8_SCALE * siluf(g1[0]) * u1[0], ACT8_SCALE * siluf(g1[1]) * u1[1], ACT8_SCALE * siluf(g1[2]) * u1[2], ACT8_SCALE * siluf(g1[3]) * u1[3]);
            *(u32x2*)(AE + (size_t)row * 256 + c8) = w;
        EPI_ROWS_END
    }
};
struct EpiE2S8 {
    static constexpr bool PERM = true; static constexpr int NSTORE = 16;
    const float* sgate; unsigned char* YS;
    __device__ __forceinline__ void operator()(const f32x4 (&acc)[2][2][4][2], const Unit& u, int wr, int wc, int fr, int fq) const {
        const int colt = u.pn * BM + wc * 32 + 8 * fq; const int row0 = u.pm * BM + wr * 64 + fr;
        float gt[2][4];
#pragma unroll
        for (int ai = 0; ai < 2; ++ai)
#pragma unroll
            for (int m = 0; m < 4; ++m) gt[ai][m] = sgate[row0 + ai * HALF + m * 16] * Y8_SCALE;
        asm volatile("s_waitcnt vmcnt(0)" : "+v"(gt[0][0]), "+v"(gt[0][1]), "+v"(gt[0][2]), "+v"(gt[0][3]), "+v"(gt[1][0]), "+v"(gt[1][1]), "+v"(gt[1][2]), "+v"(gt[1][3]) :: "memory");
#pragma unroll
        for (int ai = 0; ai < 2; ++ai)
#pragma unroll
            for (int m = 0; m < 4; ++m) { const int row = row0 + ai * HALF + m * 16;
#pragma unroll
                for (int bj = 0; bj < 2; ++bj) { const f32x4 v0 = acc[ai][bj][m][0] * gt[ai][m], v1 = acc[ai][bj][m][1] * gt[ai][m];
                    u32x2 w; w.x = pk4_fp8(v0[0], v0[1], v0[2], v0[3]); w.y = pk4_fp8(v1[0], v1[1], v1[2], v1[3]);
                    *(u32x2*)(YS + (size_t)row * DM + colt + bj * HALF) = w; } }
    }
};
struct EpiE2S8b {
    static constexpr bool PERM = true; static constexpr int NSTORE = 0;
    const float* sgate; unsigned char* YS;
    __device__ __forceinline__ void operator()(const f32x4 (&acc)[2][2][4][2], const Unit& u, int wr, int wc, int fr, int fq) const {
        const int colt = u.pn * BM + wc * 32 + 8 * fq;
        EPI_ROWS_BEGIN
            const float gt = sgate[row] * Y8_SCALE;
#pragma unroll
            for (int bj = 0; bj < 2; ++bj) { const f32x4 v0 = acc[ai][bj][m][0] * gt, v1 = acc[ai][bj][m][1] * gt;
                u32x2 w; w.x = pk4_fp8(v0[0], v0[1], v0[2], v0[3]); w.y = pk4_fp8(v1[0], v1[1], v1[2], v1[3]);
                *(u32x2*)(YS + (size_t)row * DM + colt + bj * HALF) = w; }
        EPI_ROWS_END
    }
};
struct EpiE1G8 {
    static constexpr bool PERM = true; static constexpr int NSTORE = 0;
    const float* sgate; unsigned char* AE;
    __device__ __forceinline__ void operator()(const f32x4 (&acc)[2][2][4][2], const Unit& u, int wr, int wc, int fr, int fq) const {
        const int c8 = u.pn * 128 + wc * 32 + 8 * fq;
        EPI_ROWS_BEGIN
            const float gs = sgate[row] * ACT8_SCALE;
            const f32x4 g0 = acc[ai][0][m][0], g1 = acc[ai][0][m][1], u0 = acc[ai][1][m][0], u1 = acc[ai][1][m][1];
            u32x2 w; w.x = pk4_fp8(gs * siluf(g0[0]) * u0[0], gs * siluf(g0[1]) * u0[1], gs * siluf(g0[2]) * u0[2], gs * siluf(g0[3]) * u0[3]);
            w.y = pk4_fp8(gs * siluf(g1[0]) * u1[0], gs * siluf(g1[1]) * u1[1], gs * siluf(g1[2]) * u1[2], gs * siluf(g1[3]) * u1[3]);
            *(u32x2*)(AE + (size_t)row * 256 + c8) = w;
        EPI_ROWS_END
    }
};
struct EpiE2P8 {
    static constexpr bool PERM = true; static constexpr int NSTORE = 16;
    unsigned char* YS;
    __device__ __forceinline__ void operator()(const f32x4 (&acc)[2][2][4][2], const Unit& u, int wr, int wc, int fr, int fq) const {
        const int colt = u.pn * BM + wc * 32 + 8 * fq;
        unsigned char* ptr = YS + (size_t)(u.pm * BM + wr * 64 + fr) * DM + colt;
#pragma unroll
        for (int ai = 0; ai < 2; ++ai) {
#pragma unroll
            for (int m = 0; m < 4; ++m) {
#pragma unroll
                for (int bj = 0; bj < 2; ++bj) { const f32x4 v0 = acc[ai][bj][m][0], v1 = acc[ai][bj][m][1];
                    u32x2 w; w.x = pk4_fp8(v0[0], v0[1], v0[2], v0[3]); w.y = pk4_fp8(v1[0], v1[1], v1[2], v1[3]);
                    *(u32x2*)(ptr + bj * HALF) = w; }
                ptr += 16 * DM; asm volatile("" : "+v"(ptr)); __builtin_amdgcn_sched_barrier(0); }
            ptr += (HALF - 64) * DM; }
    }
};
struct GroupedOrderL {
    const PG8_LAS int* le; int ntiles, NT, G, vcu;
    __device__ __forceinline__ void fill(const int* tile_e, PG8_LAS int* dst) { le = dst; const int tot = ntiles * NT;
        for (int i = threadIdx.x; i * G + vcu < tot; i += blockDim.x) dst[i] = tile_e[(i * G + vcu) / NT];
        __syncthreads(); }
    __device__ __forceinline__ bool next(int i, Unit& u) const {
        const int L = i * G + vcu; if (L >= ntiles * NT) return false;
        const int mt = L / NT, nn = L - mt * NT; u.pm = mt; u.pn = nn; u.pb = le[i] * NT + nn; return true;
    }
};
struct SsmOrder {
    int G, vcu;
    __device__ __forceinline__ bool next(int i, Unit& u) const { const int L = i * G + vcu; if (L >= 256) return false; u.pm = L; u.pn = 0; u.pb = L >> 3; return true; }
};
}

__device__ __forceinline__ void transpose_item(const float* W, int K, int N, bf16_t* WT, int kb, int nb, int rowbase, float* scr, int lane) {
    const int k0 = 64 * kb, n0 = 32 * nb;
#pragma unroll 8
    for (int i = 0; i < 32; ++i) { const int kk = 2 * i + (lane >> 5); scr[kk * 33 + (lane & 31)] = W[(size_t)(k0 + kk) * N + n0 + (lane & 31)]; }
    asm volatile("s_waitcnt lgkmcnt(0)" ::: "memory");
    const int cch = lane & 7;
#pragma unroll
    for (int j = 0; j < 4; ++j) { const int n = (lane >> 3) + 8 * j; const float* s = scr + (8 * cch) * 33 + n;
        u32x4 o; o.x = pk2(s[0 * 33], s[1 * 33]); o.y = pk2(s[2 * 33], s[3 * 33]); o.z = pk2(s[4 * 33], s[5 * 33]); o.w = pk2(s[6 * 33], s[7 * 33]);
        *(u32x4*)(WT + (size_t)(rowbase + n) * K + k0 + 8 * cch) = o; }
    asm volatile("s_waitcnt lgkmcnt(0)" ::: "memory");
}
__device__ __forceinline__ int gu_row(int n0, int up) { return (n0 >> 7) * 256 + up * 128 + (n0 & 127); }
template <bool EXPERTS>
__device__ __forceinline__ void ph_convert(const Ctx& c, const Params& p) {
    float* scr = c.lds + c.wave * (64 * 33);
    unsigned char* ws = c.ws;
    constexpr int I0 = 16 * 64, I1 = 16 * 32, I2 = 8 * 16, I3 = 16 * 8, I6 = 4 * 32, IE = 128;
    constexpr int DENSE = I0 + I1 + I2 + 3 * I3 + I6, NITEMS = EXPERTS ? DENSE + 3 * IE * NE : DENSE;
    for (int it = c.gwave; it < NITEMS; it += c.gwaves) {
        int r = it;
        if (r < I0) { transpose_item(p.in[I_WIN], DM, 2048, (bf16_t*)(ws + WS_WIN_T), r / 64, r % 64, (r % 64) * 32, scr, c.lane); continue; } r -= I0;
        if (r < I1) { transpose_item(p.in[I_WOUT], DM, DM, (bf16_t*)(ws + WS_WOUT_T), r / 32, r % 32, (r % 32) * 32, scr, c.lane); continue; } r -= I1;
        if (r < I2) { transpose_item(p.in[I_WGLU], 512, 512, (bf16_t*)(ws + WS_WGLU_T), r / 16, r % 16, (r % 16) * 32, scr, c.lane); continue; } r -= I2;
        if (r < I3) { transpose_item(p.in[I_WR], DM, 256, (bf16_t*)(ws + WS_WRS_T), r / 8, r % 8, (r % 8) * 32, scr, c.lane); continue; } r -= I3;
        if (r < I3) { transpose_item(p.in[I_WGS], DM, 256, (bf16_t*)(ws + WS_WRS_T), r / 8, r % 8, 256 + gu_row((r % 8) * 32, 0), scr, c.lane); continue; } r -= I3;
        if (r < I3) { transpose_item(p.in[I_WUS], DM, 256, (bf16_t*)(ws + WS_WRS_T), r / 8, r % 8, 256 + gu_row((r % 8) * 32, 1), scr, c.lane); continue; } r -= I3;
        if (r < I6) { transpose_item(p.in[I_WDS], 256, DM, (bf16_t*)(ws + WS_WDS_T), r / 32, r % 32, (r % 32) * 32, scr, c.lane); continue; } r -= I6;
        const int e = r / (3 * IE), q = r % (3 * IE), which = q / IE, ii = q % IE;
        if (which == 0) transpose_item(p.in[I_WGE] + (size_t)e * DM * ED, DM, ED, (bf16_t*)(ws + WS_WGU) + (size_t)e * 512 * DM, ii / 8, ii % 8, gu_row((ii % 8) * 32, 0), scr, c.lane);
        else if (which == 1) transpose_item(p.in[I_WUE] + (size_t)e * DM * ED, DM, ED, (bf16_t*)(ws + WS_WGU) + (size_t)e * 512 * DM, ii / 8, ii % 8, gu_row((ii % 8) * 32, 1), scr, c.lane);
        else transpose_item(p.in[I_WDE] + (size_t)e * ED * DM, ED, DM, (bf16_t*)(ws + WS_WD) + (size_t)e * DM * ED, ii / 32, ii % 32, (ii % 32) * 32, scr, c.lane);
    }
}

__device__ __forceinline__ void transpose_tile64(const float* W, int K, int N, bf16_t* WT, int kb, int nb, int rowbase, float* scr, int lane) {
    const int k0 = 64 * kb, n0 = 64 * nb;
    f32x4 v[16];
#pragma unroll
    for (int i = 0; i < 16; ++i) v[i] = *(const f32x4*)(W + (size_t)(k0 + 4 * i + (lane >> 4)) * N + n0 + (lane & 15) * 4);
#pragma unroll
    for (int i = 0; i < 16; ++i) { float* d = scr + (4 * i + (lane >> 4)) * 65 + (lane & 15) * 4; d[0] = v[i].x; d[1] = v[i].y; d[2] = v[i].z; d[3] = v[i].w; }
    asm volatile("s_waitcnt lgkmcnt(0)" ::: "memory");
    const int cch = lane & 7;
#pragma unroll
    for (int jj = 0; jj < 8; ++jj) { const int n = (lane >> 3) + 8 * jj; const float* s_ = scr + (8 * cch) * 65 + n;
        u32x4 o; o.x = pk2(s_[0 * 65], s_[1 * 65]); o.y = pk2(s_[2 * 65], s_[3 * 65]); o.z = pk2(s_[4 * 65], s_[5 * 65]); o.w = pk2(s_[6 * 65], s_[7 * 65]);
        *(u32x4*)(WT + (size_t)(rowbase + n) * K + k0 + 8 * cch) = o; }
    asm volatile("s_waitcnt lgkmcnt(0)" ::: "memory");
}
struct ConvTile { const float* W; bf16_t* WT; int K, N, k0, n0, rowbase; bool f8; float scale; };
template <int GU8>
__device__ __forceinline__ ConvTile conv_tile_ref(const Ctx& c, const Params& p, int id) {
    const int e = id / 192, q = id % 192, which = q >> 6, ii = q & 63; ConvTile t; t.f8 = (GU8 >= 1 && which < 2) || (GU8 == 2); t.scale = which < 2 ? WGU8_SCALE : WD8_SCALE;
    if (which == 0) { t.W = p.in[I_WGE] + (size_t)e * DM * ED; t.WT = (bf16_t*)(c.ws + WS_WGU) + (size_t)e * 512 * (GU8 ? DM / 2 : DM); t.K = DM; t.N = ED; t.k0 = 64 * (ii >> 2); t.n0 = 64 * (ii & 3); t.rowbase = gu_row(t.n0, 0); }
    else if (which == 1) { t.W = p.in[I_WUE] + (size_t)e * DM * ED; t.WT = (bf16_t*)(c.ws + WS_WGU) + (size_t)e * 512 * (GU8 ? DM / 2 : DM); t.K = DM; t.N = ED; t.k0 = 64 * (ii >> 2); t.n0 = 64 * (ii & 3); t.rowbase = gu_row(t.n0, 1); }
    else { t.W = p.in[I_WDE] + (size_t)e * ED * DM; t.WT = (bf16_t*)(c.ws + WS_WD) + (size_t)e * DM * (GU8 == 2 ? ED / 2 : ED); t.K = ED; t.N = DM; t.k0 = 64 * (ii >> 4); t.n0 = 64 * (ii & 15); t.rowbase = t.n0; }
    return t;
}
#define CONV_LOAD(v, t) do { const float* p_ = (t).W + (size_t)((t).k0 + (c.lane >> 4)) * (t).N + (t).n0 + (c.lane & 15) * 4; const size_t st_ = (size_t)4 * (t).N; \
        _Pragma("unroll") for (int i_ = 0; i_ < 16; ++i_) { v[i_] = *(const f32x4*)p_; p_ += st_; asm volatile("" : "+v"(p_)); } } while (0)
#define CONV_FINISH(v, t) do { _Pragma("unroll") for (int i_ = 0; i_ < 16; ++i_) { float* d_ = scr + (4 * i_ + (c.lane >> 4)) * 65 + (c.lane & 15) * 4; d_[0] = v[i_].x; d_[1] = v[i_].y; d_[2] = v[i_].z; d_[3] = v[i_].w; } \
        asm volatile("s_waitcnt lgkmcnt(0)" ::: "memory"); \
        { const int esz_ = (t).f8 ? 1 : 2; unsigned char* q_ = (unsigned char*)(t).WT + ((size_t)((t).rowbase + (c.lane >> 3)) * (t).K + (t).k0 + 8 * (c.lane & 7)) * esz_; const size_t qs_ = (size_t)8 * (t).K * esz_; \
        _Pragma("unroll") for (int jj_ = 0; jj_ < 8; ++jj_) { const float* s_ = scr + (8 * (c.lane & 7)) * 65 + (c.lane >> 3) + 8 * jj_; \
            if ((t).f8) { u32x2 o_; o_.x = pk4_fp8(s_[0 * 65] * (t).scale, s_[1 * 65] * (t).scale, s_[2 * 65] * (t).scale, s_[3 * 65] * (t).scale); \
                o_.y = pk4_fp8(s_[4 * 65] * (t).scale, s_[5 * 65] * (t).scale, s_[6 * 65] * (t).scale, s_[7 * 65] * (t).scale); \
                *(u32x2*)q_ = o_; } \
            else { u32x4 o_; o_.x = pk2(s_[0 * 65], s_[1 * 65]); o_.y = pk2(s_[2 * 65], s_[3 * 65]); o_.z = pk2(s_[4 * 65], s_[5 * 65]); o_.w = pk2(s_[6 * 65], s_[7 * 65]); \
                *(u32x4*)q_ = o_; } \
            q_ += qs_; asm volatile("" : "+v"(q_)); } } \
        asm volatile("s_waitcnt lgkmcnt(0)" ::: "memory"); } while (0)
template <int GU8>
__device__ __forceinline__ void conv_range(const Ctx& c, const Params& p, int first, int end, int stride, float* scr) {
    if (first >= end) return;
    f32x4 va[16], vb[16];
    ConvTile ta = conv_tile_ref<GU8>(c, p, first), tb = ta;
    CONV_LOAD(va, ta);
    for (int id = first; id < end; id += 2 * stride) {
        const bool hb = id + stride < end;
        if (hb) { tb = conv_tile_ref<GU8>(c, p, id + stride); CONV_LOAD(vb, tb); }
        CONV_FINISH(va, ta);
        if (!hb) break;
        const bool ha = id + 2 * stride < end;
        if (ha) { ta = conv_tile_ref<GU8>(c, p, id + 2 * stride); CONV_LOAD(va, ta); }
        CONV_FINISH(vb, tb);
        if (!ha) break;
    }
}
__device__ __forceinline__ void conv_tile_by_id(const Ctx& c, const Params& p, int id, float* scr) { conv_range<0>(c, p, id, id + 1, 1, scr); }
__device__ __forceinline__ void conv_queue(const Ctx& c, const Params& p, unsigned* qctr) {
    float* scr = c.lds + c.wave * (64 * 65);
    constexpr int NTILES = NE * 192, CHUNK = 16;
    for (;;) {
        int tk = 0; if (c.lane == 0) tk = (int)atomicAdd(qctr, 1u);
        tk = __builtin_amdgcn_readfirstlane(tk);
        if (tk * CHUNK >= NTILES) break;
        conv_range<0>(c, p, tk * CHUNK, tk * CHUNK + CHUNK, 1, scr);
    }
}
__device__ __forceinline__ void ph_prologue2(const Ctx& c, const Params& p) {
    float* mod = (float*)(c.ws + WS_MOD);
    float* sc = c.lds;
    for (int i = c.tid; i < NB * DM; i += NTHREADS_) sc[i] = siluf(p.in[I_C][i]);
    __syncthreads();
    float* red = c.lds + NB * DM;
    for (int cg = c.bid; cg < 96; cg += c.nb) {
        const int ks = c.wave, col = cg * 64 + c.lane;
        const float* w = p.in[I_WADA] + (size_t)(ks * 128) * (6 * DM) + col;
        float acc[8];
#pragma unroll
        for (int b = 0; b < 8; ++b) acc[b] = 0.f;
#pragma unroll 16
        for (int k = 0; k < 128; ++k) { const float wv = w[(size_t)k * (6 * DM)];
#pragma unroll
            for (int b = 0; b < 8; ++b) acc[b] += sc[b * DM + ks * 128 + k] * wv; }
#pragma unroll
        for (int b = 0; b < 8; ++b) red[(ks * 8 + b) * 64 + c.lane] = acc[b];
        __syncthreads();
        { const int b = c.wave; float sum = p.in[I_BADA][col];
#pragma unroll
          for (int k2 = 0; k2 < 8; ++k2) sum += red[(k2 * 8 + b) * 64 + c.lane];
          mod[b * 6 * DM + col] = sum; }
        __syncthreads();
    }
    float* ropec = (float*)(c.ws + WS_ROPE); float* ropes = ropec + SEQ * 32;
    for (int idx = c.gtid; idx < SEQ * 32; idx += c.gthreads) {
        const int l = idx >> 5, i = idx & 31;
        const double invf = exp(-log(10000.0) * (double)(2 * i) / 64.0);
        const double ang = (double)l * invf;
        ropec[idx] = (float)cos(ang); ropes[idx] = (float)sin(ang);
    }
    float* sp = (float*)(c.ws + WS_SSMP);
    float* abr = sp, * abi = sp + SG * SP, * bbr = sp + 2 * SG * SP, * bbi = bbr + SG * SP * SC;
    for (int idx = c.gtid; idx < SG * SP; idx += c.gthreads) {
        const int g = idx / SP;
        const double are = p.in[I_ARE][idx], aim = p.in[I_AIM][idx], dt = exp((double)p.in[I_LOGDT][g]);
        const double mag = exp(are * dt), ar = mag * cos(aim * dt), ai = mag * sin(aim * dt);
        abr[idx] = (float)ar; abi[idx] = (float)ai;
        const double den = are * are + aim * aim, nr = ar - 1.0;
        const double fre = (nr * are + ai * aim) / den, fim = (ai * are - nr * aim) / den;
        for (int ch = 0; ch < SC; ++ch) {
            const double br = p.in[I_BRE][idx * SC + ch], bi = p.in[I_BIM][idx * SC + ch];
            bbr[idx * SC + ch] = (float)(fre * br - fim * bi); bbi[idx * SC + ch] = (float)(fre * bi + fim * br);
        }
    }
    for (int idx = c.gthreads - 1 - c.gtid; idx < SG * SP * 17; idx += c.gthreads) {
        const int gp = idx / 17, d = idx % 17, g = gp / SP;
        const double are = p.in[I_ARE][gp], aim = p.in[I_AIM][gp], dt = exp((double)p.in[I_LOGDT][g]);
        const double m = exp(are * dt * d); float* pw = (float*)(c.ws + WS_SSMPW) + (size_t)gp * 34;
        pw[2 * d] = (float)(m * cos(aim * dt * d)); pw[2 * d + 1] = (float)(m * sin(aim * dt * d));
    }
    if (c.gtid == 0) {
        float s1 = 0.f, s2 = 0.f, gq = 0.f, gk = 0.f;
        for (int i = 0; i < HD; ++i) { s1 += p.in[I_LQ1][i] * p.in[I_LK1][i]; s2 += p.in[I_LQ2][i] * p.in[I_LK2][i];
            gq = fmaxf(gq, fabsf(p.in[I_QNG][i])); gk = fmaxf(gk, fabsf(p.in[I_KNG][i])); }
        float* lam = (float*)(c.ws + WS_LAM);
        lam[0] = __expf(s1) - __expf(s2) + LAM_INIT;
        lam[1] = 0.125f * 64.f * gq * gk;
    }
    int* stok = (int*)(c.ws + WS_SLOT_TOK); int* sasg = (int*)(c.ws + WS_SLOT_ASG); float* sgate = (float*)(c.ws + WS_SLOT_GATE);
    for (int idx = c.gtid; idx < NS_MAX; idx += c.gthreads) { stok[idx] = 0; sasg[idx] = -1; sgate[idx] = 0.f; }
    int* te = (int*)(c.ws + WS_TILE_E);
    for (int idx = c.gtid; idx < NS_MAX / 256; idx += c.gthreads) te[idx] = -1;
    __syncthreads();
}
__device__ __forceinline__ void ph_slot2(const Ctx& c, const Params& p) {
    const unsigned* counts = (const unsigned*)(c.ws + WS_CTL) + CW_COUNTS; unsigned* cursor = (unsigned*)(c.ws + WS_CTL) + CW_CURSOR;
    int* pc = (int*)c.lds; int* ps = pc + 256;
    if (c.tid < NE) pc[c.tid] = ((int)counts[c.tid] + 255) / 256 * 256;
    __syncthreads();
    if (c.tid <= NE) { int acc = 0; for (int e = 0; e < c.tid; ++e) acc += pc[e]; ps[c.tid] = acc; }
    __syncthreads();
    const int* eidx = (const int*)(c.ws + WS_EIDX); const float* gw = (const float*)(c.ws + WS_GATEW);
    int* stok = (int*)(c.ws + WS_SLOT_TOK); int* sasg = (int*)(c.ws + WS_SLOT_ASG); float* sgate = (float*)(c.ws + WS_SLOT_GATE);
    for (int a = c.gtid; a < T * TOPK; a += c.gthreads) {
        const int e = eidx[a]; const unsigned pos = atomicAdd(cursor + e, 1u); const int slot = ps[e] + (int)pos;
        stok[slot] = a >> 3; sasg[slot] = a; sgate[slot] = gw[a];
    }
    if (c.bid == 0) {
        int* te = (int*)(c.ws + WS_TILE_E);
        for (int e = c.tid; e < NE; e += NTHREADS_) for (int tl = ps[e] / 256; tl < ps[e + 1] / 256; ++tl) te[tl] = e;
        if (c.tid == 0) ((unsigned*)(c.ws + WS_CTL))[CW_NTILES] = (unsigned)(ps[NE] / 256);
    }
    __syncthreads();
}

template <int CTRL> __device__ __forceinline__ float dpp_f(float v) { return __builtin_bit_cast(float, __builtin_amdgcn_update_dpp(0, __builtin_bit_cast(int, v), CTRL, 0xF, 0xF, false)); }
template <int CTRL> __device__ __forceinline__ int dpp_i(int v) { return __builtin_amdgcn_update_dpp(0, v, CTRL, 0xF, 0xF, false); }
#define DPP_XOR1 0xB1
#define DPP_XOR2 0x4E
#define DPP_HMIR 0x141
#define DPP_MIR 0x140
__device__ __forceinline__ void ph_qkn2(const Ctx& c, const Params& p) {
    bf16_t* QK = (bf16_t*)(c.ws + WS_QK);
    const float* ropec = (const float*)(c.ws + WS_ROPE); const float* ropes = ropec + SEQ * 32;
    const int l = c.lane, qt = l & 3; const bool hi_half = qt >= 2;
    const float qsc = l < 32 ? 0.125f * 1.4426950408889634f : 1.f;
    float g[16];
#pragma unroll
    for (int j = 0; j < 16; ++j) g[j] = (l < 32 ? p.in[I_QNG] : p.in[I_KNG])[16 * qt + j];
    constexpr int R = 2;
    for (int t0 = c.gwave * R; t0 < T; t0 += c.gwaves * R) {
        u32x4 w[R][2]; f32x4 cs[R][4], sn[R][4];
#pragma unroll
        for (int r = 0; r < R; ++r) { const int t = t0 + r, pos = t % SEQ;
            w[r][0] = *(const u32x4*)(QK + (size_t)t * 1024 + l * 16); w[r][1] = *(const u32x4*)(QK + (size_t)t * 1024 + l * 16 + 8);
#pragma unroll
            for (int q = 0; q < 4; ++q) { cs[r][q] = *(const f32x4*)(ropec + pos * 32 + 16 * (qt & 1) + 4 * q); sn[r][q] = *(const f32x4*)(ropes + pos * 32 + 16 * (qt & 1) + 4 * q); } }
#pragma unroll
        for (int r = 0; r < R; ++r) {
            float v[16]; const unsigned* wp = (const unsigned*)&w[r][0];
#pragma unroll
            for (int i = 0; i < 8; ++i) { v[2 * i] = __uint_as_float(wp[i] << 16); v[2 * i + 1] = __uint_as_float(wp[i] & 0xffff0000u); }
            float ss = 0.f;
#pragma unroll
            for (int j = 0; j < 16; ++j) ss += v[j] * v[j];
            ss += dpp_f<DPP_XOR1>(ss); ss += dpp_f<DPP_XOR2>(ss);
            const float rstd = rsqrtf(ss * (1.f / 64.f) + EPS);
            unsigned o[8];
#pragma unroll
            for (int i = 0; i < 8; ++i) { float res[2];
#pragma unroll
                for (int e = 0; e < 2; ++e) { const int j = 2 * i + e; const float y = v[j] * rstd * g[j]; const float pr = dpp_f<DPP_XOR2>(y);
                    const float cc_ = cs[r][j >> 2][j & 3], s_ = sn[r][j >> 2][j & 3];
                    res[e] = (hi_half ? (pr * s_ + y * cc_) : (y * cc_ - pr * s_)) * qsc; }
                o[i] = pk2(res[0], res[1]); }
            *(u32x4*)(QK + (size_t)(t0 + r) * 1024 + l * 16) = (u32x4){o[0], o[1], o[2], o[3]}; *(u32x4*)(QK + (size_t)(t0 + r) * 1024 + l * 16 + 8) = (u32x4){o[4], o[5], o[6], o[7]};
        }
    }
}
template <bool ATOMIC_BASE>
__device__ __forceinline__ void ph_route2(const Ctx& c, const Params& p) {
    const float* L = (const float*)(c.ws + WS_LOGITS);
    int* eidx = (int*)(c.ws + WS_EIDX); float* gw = (float*)(c.ws + WS_GATEW); int* HIST = (int*)(c.ws + WS_HIST);
    int* hist = (int*)c.lds;
    if (c.tid < NE) hist[c.tid] = 0;
    __syncthreads();
    const int j = c.lane & 15, r = c.lane >> 4, g = j >> 1; const float NEG = -__builtin_inff();
    float rb[16];
#pragma unroll
    for (int i = 0; i < 16; ++i) rb[i] = p.in[I_RB][16 * j + i];
    for (int blk = c.bid; blk < T / 128; blk += c.nb) {
        for (int it = 0; it < 4; ++it) {
            const int t = blk * 128 + it * 32 + c.wave * 4 + r;
            float s[16], mv[16];
            { const f32x4* lp = (const f32x4*)(L + (size_t)t * 256 + 16 * j);
#pragma unroll
              for (int q = 0; q < 4; ++q) { const f32x4 x = lp[q]; s[4 * q] = sigmoidf(x.x); s[4 * q + 1] = sigmoidf(x.y); s[4 * q + 2] = sigmoidf(x.z); s[4 * q + 3] = sigmoidf(x.w); } }
            float m1 = NEG, m2 = NEG;
#pragma unroll
            for (int i = 0; i < 16; ++i) { mv[i] = s[i] + rb[i]; m2 = fmaxf(m2, fminf(m1, mv[i])); m1 = fmaxf(m1, mv[i]); }
            const float pm1 = dpp_f<DPP_XOR1>(m1), pm2 = dpp_f<DPP_XOR1>(m2);
            const float gs = fmaxf(m1, pm1) + fmaxf(fminf(m1, pm1), fmaxf(m2, pm2));
            int rank = 0;
#define RANK_STEP(N) { const float os = dpp_f<0x120 + (N)>(gs); const int og = dpp_i<0x120 + (N)>(g); rank += (os > gs || (os == gs && og < g)) ? 1 : 0; }
            RANK_STEP(2) RANK_STEP(4) RANK_STEP(6) RANK_STEP(8) RANK_STEP(10) RANK_STEP(12) RANK_STEP(14)
#undef RANK_STEP
            if (rank >= TOPG) {
#pragma unroll
                for (int i = 0; i < 16; ++i) mv[i] = NEG;
            }
            float wsel = 0.f, wsum = 0.f; int esel = 0;
#pragma unroll
            for (int k = 0; k < TOPK; ++k) {
                float bm = mv[0], bs = s[0]; int bi = 16 * j;
#pragma unroll
                for (int i = 1; i < 16; ++i) { const bool gt = mv[i] > bm; bm = gt ? mv[i] : bm; bs = gt ? s[i] : bs; bi = gt ? 16 * j + i : bi; }
#define ARG_STEP(CT) { const float om = dpp_f<CT>(bm), os = dpp_f<CT>(bs); const int oi = dpp_i<CT>(bi); const bool tk = (om > bm) || (om == bm && oi < bi); bm = tk ? om : bm; bs = tk ? os : bs; bi = tk ? oi : bi; }
                ARG_STEP(DPP_XOR1) ARG_STEP(DPP_XOR2) ARG_STEP(DPP_HMIR) ARG_STEP(DPP_MIR)
#undef ARG_STEP
#pragma unroll
                for (int i = 0; i < 16; ++i) mv[i] = (bi == 16 * j + i) ? NEG : mv[i];
                wsum += bs;
                if (j == k) { wsel = bs; esel = bi; }
            }
            if (j < TOPK) { eidx[t * 8 + j] = esel; gw[t * 8 + j] = wsel / wsum * ROUTED_SCALE; atomicAdd(hist + esel, 1); }
        }
        __syncthreads();
        if (c.tid < NE) { const int h = hist[c.tid];
            if (ATOMIC_BASE) { unsigned* counts = (unsigned*)(c.ws + WS_CTL) + CW_COUNTS; HIST[blk * NE + c.tid] = h ? (int)atomicAdd(counts + c.tid, (unsigned)h) : 0; }
            else HIST[blk * NE + c.tid] = h;
            hist[c.tid] = 0; }
        __syncthreads();
    }
}
template <bool INV>
__device__ __forceinline__ void ph_slot3(const Ctx& c, const Params& p) {
    const int* HIST = (const int*)(c.ws + WS_HIST);
    int* pc = (int*)c.lds; int* base = pc + 256; int* cnt = base + 257;
    const int* eidx = (const int*)(c.ws + WS_EIDX); const float* gw = (const float*)(c.ws + WS_GATEW);
    int* stok = (int*)(c.ws + WS_SLOT_TOK); int* sasg = (int*)(c.ws + WS_SLOT_ASG); float* sgate = (float*)(c.ws + WS_SLOT_GATE);
    for (int blk = c.bid; blk < T / 128; blk += c.nb) {
        int before = 0;
        if (c.tid < NE) { int tot = 0;
#pragma unroll 16
            for (int b2 = 0; b2 < T / 128; ++b2) { const int h = HIST[b2 * NE + c.tid]; tot += h; before += (b2 < blk) ? h : 0; }
            pc[c.tid] = (tot + 255) / 256 * 256; cnt[c.tid] = 0; }
        __syncthreads();
        if (c.tid <= NE) { int acc = 0; for (int e = 0; e < c.tid; ++e) acc += pc[e]; base[c.tid] = acc + (c.tid < NE ? before : 0); }
        __syncthreads();
        for (int i = c.tid; i < 128 * TOPK; i += NTHREADS_) {
            const int a = blk * 128 * TOPK + i, e = eidx[a]; const int pos = atomicAdd(cnt + e, 1); const int slot = base[e] + pos;
            stok[slot] = a >> 3; sasg[slot] = a; sgate[slot] = gw[a]; if (INV) ((int*)eidx)[a] = slot;
        }
        if (blk == 0) {
            int* te = (int*)(c.ws + WS_TILE_E);
            for (int e = c.tid; e < NE; e += NTHREADS_) for (int tl = base[e] / 256; tl < (base[e] + pc[e]) / 256; ++tl) te[tl] = e;
            if (c.tid == 0) ((unsigned*)(c.ws + WS_CTL))[CW_NTILES] = (unsigned)(base[NE] / 256);
        }
        __syncthreads();
    }
}
__device__ __forceinline__ void ph_slot5(const Ctx& c, const Params& p) {
    const int* HIST = (const int*)(c.ws + WS_HIST); const unsigned* counts = (const unsigned*)(c.ws + WS_CTL) + CW_COUNTS;
    int* pc = (int*)c.lds; int* base = pc + 256; int* cnt = base + 257; int* pst = cnt + 256;
    const int* eidx = (const int*)(c.ws + WS_EIDX); const float* gw = (const float*)(c.ws + WS_GATEW);
    int* stok = (int*)(c.ws + WS_SLOT_TOK); int* sasg = (int*)(c.ws + WS_SLOT_ASG); float* sgate = (float*)(c.ws + WS_SLOT_GATE);
    for (int blk = c.bid; blk < T / 128; blk += c.nb) {
        int before = 0;
        if (c.tid < NE) { pc[c.tid] = ((int)counts[c.tid] + 255) / 256 * 256; before = HIST[blk * NE + c.tid]; cnt[c.tid] = 0; }
        __syncthreads();
        if (c.tid <= NE) { int acc = 0; for (int e = 0; e < c.tid; ++e) acc += pc[e]; pst[c.tid] = acc; base[c.tid] = acc + before; }
        __syncthreads();
        for (int i = c.tid; i < 128 * TOPK; i += NTHREADS_) {
            const int a = blk * 128 * TOPK + i, e = eidx[a]; const int pos = atomicAdd(cnt + e, 1); const int slot = base[e] + pos;
            stok[slot] = a >> 3; sasg[slot] = a; sgate[slot] = gw[a]; ((int*)eidx)[a] = slot;
        }
        if (blk == 0) {
            int* te = (int*)(c.ws + WS_TILE_E);
            for (int e = c.tid; e < NE; e += NTHREADS_) for (int tl = pst[e] / 256; tl < (pst[e] + pc[e]) / 256; ++tl) te[tl] = e;
            if (c.tid == 0) ((unsigned*)(c.ws + WS_CTL))[CW_NTILES] = (unsigned)(pst[NE] / 256);
        }
        __syncthreads();
    }
}
__device__ __forceinline__ void ph_combine2(const Ctx& c, const Params& p) {
    const float* mod = (const float*)(c.ws + WS_MOD); const bf16_t* YA = (const bf16_t*)(c.ws + WS_YA); const bf16_t* YS = (const bf16_t*)(c.ws + WS_YSH); float* out = p.out;
    for (int t = c.gwave; t < T; t += c.gwaves) {
        const int b = t / SEQ;
        u32x4 y[9][2]; f32x4 xv[2][2], gv[2][2];
#pragma unroll
        for (int q = 0; q < 2; ++q) { const int col = q * 512 + c.lane * 8;
#pragma unroll
            for (int k = 0; k < 8; ++k) y[k][q] = *(const u32x4*)(YA + ((size_t)t * 8 + k) * DM + col);
            y[8][q] = *(const u32x4*)(YS + (size_t)t * DM + col);
            xv[q][0] = *(const f32x4*)(out + (size_t)t * DM + col); xv[q][1] = *(const f32x4*)(out + (size_t)t * DM + col + 4);
            gv[q][0] = *(const f32x4*)(mod + b * 6 * DM + 5 * DM + col); gv[q][1] = *(const f32x4*)(mod + b * 6 * DM + 5 * DM + col + 4); }
#pragma unroll
        for (int q = 0; q < 2; ++q) { const int col = q * 512 + c.lane * 8;
            f32x4 s0 = {0.f, 0.f, 0.f, 0.f}, s1 = {0.f, 0.f, 0.f, 0.f};
#pragma unroll
            for (int k = 0; k < 9; ++k) { const u32x4 w = y[k][q];
                s0[0] += __uint_as_float(w.x << 16); s0[1] += __uint_as_float(w.x & 0xffff0000u); s0[2] += __uint_as_float(w.y << 16); s0[3] += __uint_as_float(w.y & 0xffff0000u);
                s1[0] += __uint_as_float(w.z << 16); s1[1] += __uint_as_float(w.z & 0xffff0000u); s1[2] += __uint_as_float(w.w << 16); s1[3] += __uint_as_float(w.w & 0xffff0000u); }
            *(f32x4*)(out + (size_t)t * DM + col) = xv[q][0] + gv[q][0] * s0; *(f32x4*)(out + (size_t)t * DM + col + 4) = xv[q][1] + gv[q][1] * s1; }
    }
}
__device__ __forceinline__ void ph_combine3(const Ctx& c, const Params& p) {
    const float* mod = (const float*)(c.ws + WS_MOD); const bf16_t* YS = (const bf16_t*)(c.ws + WS_YS); const bf16_t* YH = (const bf16_t*)(c.ws + WS_YSH); float* out = p.out;
    const int* inv = (const int*)(c.ws + WS_EIDX);
    for (int t = c.gwave; t < T; t += c.gwaves) {
        const int b = t / SEQ;
        int sl[8];
#pragma unroll
        for (int k = 0; k < 8; ++k) sl[k] = inv[t * 8 + k];
        u32x4 y[9][2]; f32x4 xv[2][2], gv[2][2];
#pragma unroll
        for (int q = 0; q < 2; ++q) { const int col = q * 512 + c.lane * 8;
#pragma unroll
            for (int k = 0; k < 8; ++k) y[k][q] = *(const u32x4*)(YS + (size_t)sl[k] * DM + col);
            y[8][q] = *(const u32x4*)(YH + (size_t)t * DM + col);
            xv[q][0] = *(const f32x4*)(out + (size_t)t * DM + col); xv[q][1] = *(const f32x4*)(out + (size_t)t * DM + col + 4);
            gv[q][0] = *(const f32x4*)(mod + b * 6 * DM + 5 * DM + col); gv[q][1] = *(const f32x4*)(mod + b * 6 * DM + 5 * DM + col + 4); }
#pragma unroll
        for (int q = 0; q < 2; ++q) { const int col = q * 512 + c.lane * 8;
            f32x4 s0 = {0.f, 0.f, 0.f, 0.f}, s1 = {0.f, 0.f, 0.f, 0.f};
#pragma unroll
            for (int k = 0; k < 9; ++k) { const u32x4 w = y[k][q];
                s0[0] += __uint_as_float(w.x << 16); s0[1] += __uint_as_float(w.x & 0xffff0000u); s0[2] += __uint_as_float(w.y << 16); s0[3] += __uint_as_float(w.y & 0xffff0000u);
                s1[0] += __uint_as_float(w.z << 16); s1[1] += __uint_as_float(w.z & 0xffff0000u); s1[2] += __uint_as_float(w.w << 16); s1[3] += __uint_as_float(w.w & 0xffff0000u); }
            *(f32x4*)(out + (size_t)t * DM + col) = xv[q][0] + gv[q][0] * s0; *(f32x4*)(out + (size_t)t * DM + col + 4) = xv[q][1] + gv[q][1] * s1; }
    }
}
__device__ __forceinline__ void ph_combine4(const Ctx& c, const Params& p) {
    const float* mod = (const float*)(c.ws + WS_MOD); const unsigned char* YS = c.ws + WS_YS; const bf16_t* YH = (const bf16_t*)(c.ws + WS_YSH); float* out = p.out;
    const int* inv = (const int*)(c.ws + WS_EIDX);
    typedef float f32x2 __attribute__((ext_vector_type(2)));
    for (int t = c.gwave; t < T; t += c.gwaves) {
        const int b = t / SEQ, col = c.lane * 16;
        int sl[8];
#pragma unroll
        for (int k = 0; k < 8; ++k) sl[k] = inv[t * 8 + k];
        u32x4 y[8], yh[2]; f32x4 xv[4], gv[4];
#pragma unroll
        for (int k = 0; k < 8; ++k) y[k] = *(const u32x4*)(YS + (size_t)sl[k] * DM + col);
#pragma unroll
        for (int q = 0; q < 2; ++q) yh[q] = *(const u32x4*)(YH + (size_t)t * DM + col + 8 * q);
#pragma unroll
        for (int q = 0; q < 4; ++q) { xv[q] = *(const f32x4*)(out + (size_t)t * DM + col + 4 * q); gv[q] = *(const f32x4*)(mod + b * 6 * DM + 5 * DM + col + 4 * q); }
        float sacc[16];
#pragma unroll
        for (int i = 0; i < 16; ++i) sacc[i] = 0.f;
#pragma unroll
        for (int k = 0; k < 8; ++k) { const unsigned* wp = (const unsigned*)&y[k];
#pragma unroll
            for (int i = 0; i < 4; ++i) { const f32x2 lo = __builtin_amdgcn_cvt_pk_f32_fp8((int)wp[i], false), hi2 = __builtin_amdgcn_cvt_pk_f32_fp8((int)wp[i], true);
                sacc[4 * i] += lo[0]; sacc[4 * i + 1] += lo[1]; sacc[4 * i + 2] += hi2[0]; sacc[4 * i + 3] += hi2[1]; } }
#pragma unroll
        for (int q = 0; q < 2; ++q) { const unsigned* wp = (const unsigned*)&yh[q];
#pragma unroll
            for (int i = 0; i < 4; ++i) { sacc[8 * q + 2 * i] = sacc[8 * q + 2 * i] * (1.f / Y8_SCALE) + __uint_as_float(wp[i] << 16); sacc[8 * q + 2 * i + 1] = sacc[8 * q + 2 * i + 1] * (1.f / Y8_SCALE) + __uint_as_float(wp[i] & 0xffff0000u); } }
#pragma unroll
        for (int q = 0; q < 4; ++q) { f32x4 o = xv[q]; o[0] += gv[q][0] * sacc[4 * q]; o[1] += gv[q][1] * sacc[4 * q + 1]; o[2] += gv[q][2] * sacc[4 * q + 2]; o[3] += gv[q][3] * sacc[4 * q + 3];
            *(f32x4*)(out + (size_t)t * DM + col + 4 * q) = o; }
    }
}
__device__ __forceinline__ void ph_combine5(const Ctx& c, const Params& p) {
    const float* mod = (const float*)(c.ws + WS_MOD); const unsigned char* YS = c.ws + WS_YS; const bf16_t* YH = (const bf16_t*)(c.ws + WS_YSH); float* out = p.out;
    const int* inv = (const int*)(c.ws + WS_EIDX); const float* gwp = (const float*)(c.ws + WS_GATEW);
    typedef float f32x2 __attribute__((ext_vector_type(2)));
    for (int t = c.gwave; t < T; t += c.gwaves) {
        const int b = t / SEQ, col = c.lane * 16;
        int sl[8]; float gk[8];
#pragma unroll
        for (int k = 0; k < 8; ++k) { sl[k] = inv[t * 8 + k]; gk[k] = gwp[t * 8 + k]; }
        u32x4 y[8], yh[2]; f32x4 xv[4], gv[4];
#pragma unroll
        for (int k = 0; k < 8; ++k) y[k] = *(const u32x4*)(YS + (size_t)sl[k] * DM + col);
#pragma unroll
        for (int q = 0; q < 2; ++q) yh[q] = *(const u32x4*)(YH + (size_t)t * DM + col + 8 * q);
#pragma unroll
        for (int q = 0; q < 4; ++q) { xv[q] = *(const f32x4*)(out + (size_t)t * DM + col + 4 * q); gv[q] = *(const f32x4*)(mod + b * 6 * DM + 5 * DM + col + 4 * q); }
        float sacc[16];
#pragma unroll
        for (int i = 0; i < 16; ++i) sacc[i] = 0.f;
#pragma unroll
        for (int k = 0; k < 8; ++k) { const unsigned* wp = (const unsigned*)&y[k];
#pragma unroll
            for (int i = 0; i < 4; ++i) { const f32x2 lo = __builtin_amdgcn_cvt_pk_f32_fp8((int)wp[i], false), hi2 = __builtin_amdgcn_cvt_pk_f32_fp8((int)wp[i], true);
                sacc[4 * i] += gk[k] * lo[0]; sacc[4 * i + 1] += gk[k] * lo[1]; sacc[4 * i + 2] += gk[k] * hi2[0]; sacc[4 * i + 3] += gk[k] * hi2[1]; } }
#pragma unroll
        for (int q = 0; q < 2; ++q) { const unsigned* wp = (const unsigned*)&yh[q];
#pragma unroll
            for (int i = 0; i < 4; ++i) { sacc[8 * q + 2 * i] = sacc[8 * q + 2 * i] * (1.f / Y8_SCALE) + __uint_as_float(wp[i] << 16); sacc[8 * q + 2 * i + 1] = sacc[8 * q + 2 * i + 1] * (1.f / Y8_SCALE) + __uint_as_float(wp[i] & 0xffff0000u); } }
#pragma unroll
        for (int q = 0; q < 4; ++q) { f32x4 o = xv[q]; o[0] += gv[q][0] * sacc[4 * q]; o[1] += gv[q][1] * sacc[4 * q + 1]; o[2] += gv[q][2] * sacc[4 * q + 2]; o[3] += gv[q][3] * sacc[4 * q + 3];
            *(f32x4*)(out + (size_t)t * DM + col + 4 * q) = o; }
    }
}
__device__ __forceinline__ void cpowi(float ar, float ai, int n, float& pr, float& pi) { pr = 1.f; pi = 0.f; for (int i = 0; i < n; ++i) { const float t = pr * ar - pi * ai; pi = pr * ai + pi * ar; pr = t; } }
__device__ __forceinline__ void ph_ssm_gen(const Ctx& c, const Params& p) {
    const float* sp = (const float*)(c.ws + WS_SSMP);
    const float* bbr = sp + 2 * SG * SP, * bbi = bbr + SG * SP * SC; const float* PWg = (const float*)(c.ws + WS_SSMPW);
    bf16_t* BA = (bf16_t*)(c.ws + WS_SSM_BA); bf16_t* BC = (bf16_t*)(c.ws + WS_SSM_BC);
    float* Lpw = c.lds; float* Lbb = Lpw + SP * 34; float* Lcc = Lbb + SP * 32;
    for (int w = c.bid; w < SG * 8; w += c.nb) {
        const int g = w & 31, part = w >> 5;
        __syncthreads();
        for (int i = c.tid; i < SP * 34; i += NTHREADS_) Lpw[i] = PWg[(size_t)g * SP * 34 + i];
        for (int i = c.tid; i < SP * 16; i += NTHREADS_) { Lbb[2 * i] = bbr[g * SP * SC + i]; Lbb[2 * i + 1] = bbi[g * SP * SC + i]; }
        for (int i = c.tid; i < 16 * SP; i += NTHREADS_) { Lcc[2 * i] = p.in[I_CRE][g * SC * SP + i]; Lcc[2 * i + 1] = p.in[I_CIM][g * SC * SP + i]; }
        __syncthreads();
        bf16_t* baseC = BC + (size_t)g * 256 * APK; bf16_t* baseA = BA + (size_t)g * 256 * 256;
        { const int idx = part * 512 + c.tid, ci = idx & 15, co = (idx >> 4) & 15, d = idx >> 8;
          float kv = 0.f;
#pragma unroll 8
          for (int pp = 0; pp < SP; ++pp) { const float pr = Lpw[pp * 34 + 2 * d], pi = Lpw[pp * 34 + 2 * d + 1], br = Lbb[(pp * 16 + ci) * 2], bi = Lbb[(pp * 16 + ci) * 2 + 1];
              const float tr = pr * br - pi * bi, ti = pr * bi + pi * br;
              kv += Lcc[(co * SP + pp) * 2] * tr - Lcc[(co * SP + pp) * 2 + 1] * ti; }
          if (d == 0 && co == ci) kv += p.in[I_SD][g * SC + co];
          const bf16_t kb = f2bf(kv);
          for (int j = 0; j + d < 16; ++j) { baseC[((j + d) * 16 + co) * APK + j * 16 + ci] = kb; if (d > 0) baseC[(j * 16 + co) * APK + (j + d) * 16 + ci] = 0; } }
        for (int q = c.tid; q < 2048; q += NTHREADS_) { const int idx = part * 2048 + q;
            { const int pp = idx & 63, co = (idx >> 6) & 15, jp = idx >> 10;
              const float pr = Lpw[pp * 34 + 2 * (jp + 1)], pi = Lpw[pp * 34 + 2 * (jp + 1) + 1], cr = Lcc[(co * SP + pp) * 2], ci2 = Lcc[(co * SP + pp) * 2 + 1];
              bf16_t* row = baseC + (size_t)(jp * 16 + co) * APK + 256;
              row[pp] = f2bf(cr * pr - ci2 * pi); row[64 + pp] = f2bf(-(cr * pi + ci2 * pr)); }
            { const int ci = idx & 15, j = (idx >> 4) & 15, pp = idx >> 8;
              const float pr = Lpw[pp * 34 + 2 * (15 - j)], pi = Lpw[pp * 34 + 2 * (15 - j) + 1], br = Lbb[(pp * 16 + ci) * 2], bi = Lbb[(pp * 16 + ci) * 2 + 1];
              baseA[pp * 256 + j * 16 + ci] = f2bf(pr * br - pi * bi); baseA[(64 + pp) * 256 + j * 16 + ci] = f2bf(pr * bi + pi * br); } }
        for (int q = c.tid; q < 512; q += NTHREADS_) *(u32x4*)(baseA + 128 * 256 + (part * 512 + q) * 8) = (u32x4){0u, 0u, 0u, 0u};
    }
    __syncthreads();
}
__device__ __forceinline__ void ph_ssm_scan(const Ctx& c, const Params& p, int vcu) {
    const float* sp = (const float*)(c.ws + WS_SSMP); const float* abr = sp, * abi = sp + SG * SP;
    const float* DS = (const float*)(c.ws + WS_DS); bf16_t* AP = (bf16_t*)(c.ws + WS_AP);
    float* fw = c.lds;
    for (int it = vcu; it < NB * SG; it += c.nb) {
        const int g = it >> 3, b = it & 7, pp = c.lane, w = c.wave;
        const size_t r0 = (size_t)g * (NB * NCHUNK) + b * NCHUNK + 32 * w;
        float ar = abr[g * SP + pp], ai = abi[g * SP + pp];
#pragma unroll
        for (int i = 0; i < 4; ++i) { const float t = ar * ar - ai * ai; ai = 2.f * ar * ai; ar = t; }
        float lr[32], li[32];
#pragma unroll
        for (int i = 0; i < 32; ++i) { lr[i] = DS[(r0 + i) * 128 + pp]; li[i] = DS[(r0 + i) * 128 + 64 + pp]; }
#pragma unroll
        for (int i = 1; i < 32; ++i) { const float nr = ar * lr[i - 1] - ai * li[i - 1] + lr[i], ni = ar * li[i - 1] + ai * lr[i - 1] + li[i]; lr[i] = nr; li[i] = ni; }
        __syncthreads();
        fw[(w * 64 + pp) * 2] = lr[31]; fw[(w * 64 + pp) * 2 + 1] = li[31];
        __syncthreads();
        float a32r = ar, a32i = ai;
#pragma unroll
        for (int i = 0; i < 5; ++i) { const float t = a32r * a32r - a32i * a32i; a32i = 2.f * a32r * a32i; a32r = t; }
        float cr = 0.f, ci = 0.f;
        for (int w2 = 0; w2 < w; ++w2) { const float fr_ = fw[(w2 * 64 + pp) * 2], fi_ = fw[(w2 * 64 + pp) * 2 + 1];
            const float nr = a32r * cr - a32i * ci + fr_, ni = a32r * ci + a32i * cr + fi_; cr = nr; ci = ni; }
        bf16_t* row = AP + r0 * APK + 256 + pp;
#pragma unroll
        for (int i = 0; i < 32; ++i) {
            const float sr = cr + (i ? lr[i - 1] : 0.f), si = ci + (i ? li[i - 1] : 0.f);
            row[0] = f2bf(sr); row[64] = f2bf(si);
            row += APK; asm volatile("" : "+v"(row));
            const float nr = ar * cr - ai * ci, ni = ar * ci + ai * cr; cr = nr; ci = ni;
        }
    }
}

namespace att {
typedef short bf16x8 __attribute__((ext_vector_type(8)));
typedef short s16x4 __attribute__((ext_vector_type(4)));
typedef float f32x16 __attribute__((ext_vector_type(16)));
typedef float f32x2 __attribute__((ext_vector_type(2)));
constexpr int NW = 8, QBLK = 32, KVBLK = 64, QB = 128, NQB = SEQ / QB;
constexpr int KP = 1024, VP = 512;
constexpr int SHM_V = KVBLK * 128 * 2, SHM_K = KVBLK * 128 * 2;
constexpr int LDS_WS = 2 * SHM_V + 2 * SHM_K, LDS_EX = LDS_WS + NW * 64 * 4, LDS_END = LDS_EX + 4 * 16384;
#define KSWZ(row, colB) ((row) * 256 + ((colB) ^ (((row) & 7) << 4)))
#define SBAR() __builtin_amdgcn_sched_barrier(0)
__device__ __forceinline__ int v_st(int k, int c) { const int kk = (k & ~0xC) | ((k & 4) << 1) | ((k & 8) >> 1); return ((kk >> 3) * 4 + (c >> 5)) * 512 + ((kk & 7) * 32 + (c & 31)) * 2; }
__device__ __forceinline__ int v_rd_base(int lane) { return ((lane & 3) << 3) | (((lane >> 2) & 3) << 6) | (((lane >> 4) & 1) << 5) | (((lane >> 5) & 1) << 8); }
constexpr int v_rd_off(int d0, int ks, int half) { return d0 * 512 + ks * 4096 + half * 2048; }
__device__ __forceinline__ int crow(int r, int hi) { return (r & 3) + 8 * (r >> 2) + 4 * hi; }
__device__ __forceinline__ unsigned cvtpk(float lo, float hi) { unsigned r; asm volatile("v_cvt_pk_bf16_f32 %0, %1, %2" : "=v"(r) : "v"(lo), "v"(hi)); return r; }
__device__ __forceinline__ void mask_tile(f32x16& p0, f32x16& p1, int dq) {
    const float NEG = -__builtin_inff();
#pragma unroll
    for (int r = 0; r < 16; ++r) { const int c = (r & 3) + 8 * (r >> 2); if (dq - c < 0) p0[r] = NEG; if (dq - c - 32 < 0) p1[r] = NEG; }
}
template <bool ZC>
__device__ __forceinline__ void partialSM(f32x16& p0, f32x16& p1, float C2, float negM) {
    if constexpr (!ZC) {
#pragma unroll
        for (int r = 0; r < 16; ++r) { p0[r] += negM; p1[r] += negM; } }
#pragma unroll
    for (int r = 0; r < 16; ++r) p0[r] = __builtin_amdgcn_exp2f(p0[r]);
}
__device__ __forceinline__ void finishSM(f32x16& p0, f32x16& p1, float& l_reg, bf16x8& pa0, bf16x8& pa1, bf16x8& pa2, bf16x8& pa3) {
#pragma unroll
    for (int r = 0; r < 16; ++r) p1[r] = __builtin_amdgcn_exp2f(p1[r]);
    float ps = 0;
#pragma unroll
    for (int r = 0; r < 16; ++r) ps += p0[r];
#pragma unroll
    for (int r = 0; r < 16; ++r) ps += p1[r];
    { auto rr = __builtin_amdgcn_permlane32_swap(__float_as_uint(ps), __float_as_uint(ps), false, false); ps = __uint_as_float(rr[0]) + __uint_as_float(rr[1]); }
    l_reg += ps;
#define PK4(P, B_, OUT) do { unsigned a0 = cvtpk(P[B_+0], P[B_+1]), a1 = cvtpk(P[B_+2], P[B_+3]);                          \
        unsigned b0 = cvtpk(P[B_+4], P[B_+5]), b1 = cvtpk(P[B_+6], P[B_+7]);                                             \
        auto r0 = __builtin_amdgcn_permlane32_swap(a0, b0, false, false); auto r1 = __builtin_amdgcn_permlane32_swap(a1, b1, false, false); \
        u32x4 w = {r0[0], r1[0], r0[1], r1[1]}; OUT = *reinterpret_cast<bf16x8*>(&w); } while (0)
    PK4(p0, 0, pa0); PK4(p0, 8, pa1); PK4(p1, 0, pa2); PK4(p1, 8, pa3);
#undef PK4
}
template <int KB>
__device__ __forceinline__ void qkt(f32x16& p0, f32x16& p1, const char* K_lds, int r32, int hi, const bf16x8* qr, int cc) {
    p0 = f32x16{}; p1 = f32x16{};
    const char* kb[4];
#pragma unroll
    for (int dd = 0; dd < 4; ++dd) kb[dd] = K_lds + KB * SHM_K + KSWZ(r32, (dd * 16 + hi * 8) * 2) + cc * 128;
#pragma unroll
    for (int d0 = 0; d0 < 4; ++d0) { const char* a = kb[d0];
        bf16x8 b0 = *reinterpret_cast<const bf16x8*>(a);
        bf16x8 b1 = *reinterpret_cast<const bf16x8*>(a + 32 * 256);
        p0 = __builtin_amdgcn_mfma_f32_32x32x16_bf16(b0, qr[d0], p0, 0, 0, 0);
        p1 = __builtin_amdgcn_mfma_f32_32x32x16_bf16(b1, qr[d0], p1, 0, 0, 0); }
}
template <int VB>
__device__ __forceinline__ void pv_tile(f32x16* o, int vb0, bf16x8 pa0, bf16x8 pa1, bf16x8 pa2, bf16x8 pa3) {
#define TRRD(dst, off) asm volatile("ds_read_b64_tr_b16 %0, %1 offset:%2" : "=&v"(dst) : "v"(vb0), "i"(off) : "memory")
#define PV_D0(d0) do { s16x4 l0, l1, l2, l3, h0, h1, h2, h3; constexpr int b_ = VB * SHM_V + v_rd_off(d0, 0, 0); \
        TRRD(l0, b_); TRRD(h0, b_ + 2048); TRRD(l1, b_ + 4096); TRRD(h1, b_ + 6144); TRRD(l2, b_ + 8192); TRRD(h2, b_ + 10240); TRRD(l3, b_ + 12288); TRRD(h3, b_ + 14336); \
        asm volatile("s_waitcnt lgkmcnt(0)" ::: "memory"); SBAR();   \
        o[d0] = __builtin_amdgcn_mfma_f32_32x32x16_bf16(pa0, (bf16x8){l0[0], l0[1], l0[2], l0[3], h0[0], h0[1], h0[2], h0[3]}, o[d0], 0, 0, 0);   \
        o[d0] = __builtin_amdgcn_mfma_f32_32x32x16_bf16(pa1, (bf16x8){l1[0], l1[1], l1[2], l1[3], h1[0], h1[1], h1[2], h1[3]}, o[d0], 0, 0, 0);   \
        o[d0] = __builtin_amdgcn_mfma_f32_32x32x16_bf16(pa2, (bf16x8){l2[0], l2[1], l2[2], l2[3], h2[0], h2[1], h2[2], h2[3]}, o[d0], 0, 0, 0);   \
        o[d0] = __builtin_amdgcn_mfma_f32_32x32x16_bf16(pa3, (bf16x8){l3[0], l3[1], l3[2], l3[3], h3[0], h3[1], h3[2], h3[3]}, o[d0], 0, 0, 0); } while (0)
    PV_D0(0); PV_D0(1); PV_D0(2); PV_D0(3);
#undef PV_D0
#undef TRRD
}
struct BlockRef { const bf16_t* Q; const bf16_t* K; const bf16_t* V; bf16_t* O; int P0; };
struct Seam { bf16x8 qr[4]; bf16x8 st_v0, st_v1, st_k0, st_k1; };
#define ROWK(p, k0, rr) ((p) + (size_t)((k0) + (rr)) * KP + sc)
#define ROWV(p, k0, rr) ((p) + (size_t)((k0) + (rr)) * VP + sc)
#define LD8(ptr) (*reinterpret_cast<const bf16x8*>(ptr))
#define VMW() asm volatile("s_waitcnt vmcnt(0)" ::: "memory")
#define VMWN(n) asm volatile("s_waitcnt vmcnt(%0)" :: "i"(n) : "memory")
#define SLOAD_H(Kp, Vp, k0) do { S.st_v0 = LD8(ROWV(Vp, k0, sr)); S.st_v1 = LD8(ROWV(Vp, k0, 32 + sr)); S.st_k0 = LD8(ROWK(Kp, k0, sr)); S.st_k1 = LD8(ROWK(Kp, k0, 32 + sr)); } while (0)
#define SWRITE_HK(bf) do { *(bf16x8*)(K_lds + (bf) * SHM_K + kws) = S.st_k0; *(bf16x8*)(K_lds + (bf) * SHM_K + kws + 32 * 256) = S.st_k1; } while (0)
#define SWRITE_HV(bf) do { *(bf16x8*)(V_lds + (bf) * SHM_V + vst0) = S.st_v0; *(bf16x8*)(V_lds + (bf) * SHM_V + vst1) = S.st_v1; } while (0)
#define SWRITE_H(bf) do { SWRITE_HV(bf); SWRITE_HK(bf); } while (0)
#define QLOAD(ref) do { _Pragma("unroll") for (int d0 = 0; d0 < 4; ++d0) S.qr[d0] = LD8((ref).Q + (size_t)(qi * QBLK + r32) * KP + cc * 64 + d0 * 16 + hi * 8); } while (0)
__device__ __forceinline__ void prime(const BlockRef& cur, char* lds, Seam& S, int tid) {
    const int  wid = __builtin_amdgcn_readfirstlane(tid >> 6), lane = tid & 63, r32 = lane & 31, hi = lane >> 5, qi = wid >> 1, cc = wid & 1;
    const int sr = tid >> 4, sc = (tid & 15) * 8, kws = KSWZ(sr, sc * 2); char* K_lds = lds + 2 * SHM_V;
    QLOAD(cur);
    SLOAD_H(cur.K, cur.V, 0); VMW(); SWRITE_HK(0);
    __syncthreads();
}
template <bool ZC>
__device__ __forceinline__ void block(const BlockRef& cur, const BlockRef& nxt, char* lds, Seam& S, float lam, float smax, const float* subg, bool lastblk, int tid) {
    const int  wid = __builtin_amdgcn_readfirstlane(tid >> 6), lane = tid & 63, r32 = lane & 31, hi = lane >> 5, qi = wid >> 1, cc = wid & 1;
    const int NT = cur.P0 / KVBLK + 2;
    const int qlo = cur.P0 + qi * QBLK, qm = qlo + r32 - 4 * hi;
    char* V_lds = lds; char* K_lds = lds + 2 * SHM_V;
    float* wsf = (float*)(lds + LDS_WS) + wid * 64; float* li_l = wsf;
    float* exch = (float*)(lds + LDS_EX) + qi * 4096;
    float l_reg = 0; f32x16 o[4] = {};
    const int sr = tid >> 4, sc = (tid & 15) * 8, vst0 = v_st(sr, sc), vst1 = v_st(32 + sr, sc), kws = KSWZ(sr, sc * 2);
    const int vb0 = (int)(uintptr_t)V_lds + v_rd_base(lane);
    const bf16_t* Kh = cur.K; const bf16_t* Vh = cur.V;
    constexpr float C2 = 1.4426950408889634f * 0.125f; const float negM = -smax * 1.4426950408889634f;
#define KBASE(t) ((t) * KVBLK)
#define MASKT(P0_, P1_, t) do { const int kb_ = KBASE(t); if (kb_ + KVBLK - 1 > qlo) mask_tile(P0_, P1_, qm - kb_); } while (0)
    f32x16 pA0, pA1, pB0, pB1; bf16x8 pa0, pa1, pa2, pa3;
    SWRITE_HV(0); SBAR();
    SLOAD_H(Kh, Vh, KBASE(1));
    SBAR(); qkt<0>(pA0, pA1, K_lds, r32, hi, S.qr, cc);
    MASKT(pA0, pA1, 0); partialSM<ZC>(pA0, pA1, C2, negM);
    VMW(); SWRITE_H(1);
    __syncthreads();
#define HALF_STEP(PX0, PX1, PY0, PY1, t, KB, VB, SB) do {                                                      \
        SBAR(); qkt<KB>(PX0, PX1, K_lds, r32, hi, S.qr, cc);                                                  \
        finishSM(PY0, PY1, l_reg, pa0, pa1, pa2, pa3); SBAR();                                                \
        if ((t) + 1 < NT) { SLOAD_H(Kh, Vh, KBASE((t) + 1)); SBAR(); }                                        \
        pv_tile<VB>(o, vb0, pa0, pa1, pa2, pa3); MASKT(PX0, PX1, (t)); partialSM<ZC>(PX0, PX1, C2, negM);          \
        __syncthreads();                                                                                       \
        if ((t) + 1 < NT) { VMW(); SWRITE_H(SB); }                                                             \
        __syncthreads(); } while (0)
    for (int t = 1; t + 1 < NT; t += 2) {
        HALF_STEP(pB0, pB1, pA0, pA1, t, 1, 0, 0);
        HALF_STEP(pA0, pA1, pB0, pB1, t + 1, 0, 1, 1);
    }
    SBAR(); qkt<1>(pB0, pB1, K_lds, r32, hi, S.qr, cc); SBAR();
    SLOAD_H(nxt.K, nxt.V, 0); SBAR();
    QLOAD(nxt);
    SBAR();
    finishSM(pA0, pA1, l_reg, pa0, pa1, pa2, pa3); SBAR();
    pv_tile<0>(o, vb0, pa0, pa1, pa2, pa3);
    MASKT(pB0, pB1, NT - 1); partialSM<ZC>(pB0, pB1, C2, negM); __syncthreads();
    finishSM(pB0, pB1, l_reg, pa0, pa1, pa2, pa3); SBAR(); pv_tile<1>(o, vb0, pa0, pa1, pa2, pa3);
    SBAR(); VMWN(4); SWRITE_HK(0); SBAR();
    if (hi == 0) li_l[r32] = l_reg; asm volatile("s_waitcnt lgkmcnt(0)" ::: "memory");
    float rli[16];
#pragma unroll
    for (int r = 0; r < 16; ++r) rli[r] = __builtin_amdgcn_rcpf(li_l[crow(r, hi)]) * (cc ? lam : 1.f);
#pragma unroll
    for (int d0 = 0; d0 < 4; ++d0)
#pragma unroll
        for (int r = 0; r < 16; ++r) o[d0][r] *= rli[r];
    if (cc == 1) {
#pragma unroll
        for (int d0 = 0; d0 < 4; ++d0)
#pragma unroll
            for (int r = 0; r < 16; ++r) exch[(d0 * 16 + r) * 64 + lane] = o[d0][r];
    }
    __syncthreads();
    if (cc == 0) {
        float gsub[4];
#pragma unroll
        for (int d0 = 0; d0 < 4; ++d0) gsub[d0] = subg[d0 * 32 + r32] * (1.f - LAM_INIT);
        bf16_t* Ow = cur.O + (size_t)(qi * QBLK) * KP;
#pragma unroll
        for (int r = 0; r < 16; ++r) {
            float ss = 0.f;
#pragma unroll
            for (int d0 = 0; d0 < 4; ++d0) { o[d0][r] -= exch[(d0 * 16 + r) * 64 + lane]; ss += o[d0][r] * o[d0][r]; }
#pragma unroll
            for (int of = 1; of < 32; of <<= 1) ss += __shfl_xor(ss, of);
            const float rstd = rsqrtf(ss * (1.f / 128.f) + EPS); const int orow = crow(r, hi);
#pragma unroll
            for (int d0 = 0; d0 < 4; ++d0) { const float v = o[d0][r] * rstd * gsub[d0]; const float vn = __shfl_xor(v, 1);
                if ((r32 & 1) == 0) *(unsigned*)(Ow + (size_t)orow * KP + d0 * 32 + r32) = cvtpk(v, vn); }
        }
    }
    if (lastblk) __syncthreads();
#undef KBASE
#undef MASKT
#undef HALF_STEP
}
template <bool ZC = false>
__device__ __forceinline__ void phase(char* lds, const bf16_t* QKb, const bf16_t* Vb, bf16_t* MX, float lam, float smax, const float* subg, int G, int vcu, int L0 = -1, int Lend = 1 << 30) {
    constexpr int NX = NQB / 2; const int TOTAL = (NB * NH * NX) < Lend ? (NB * NH * NX) : Lend;
    int L = L0 < 0 ? vcu : L0; if (L >= TOTAL) return;
    int pass = 0;
#define MKREF(ref, LL, ps) do { const int bh_ = (LL) / NX, x_ = (LL) % NX, qb_ = (ps) ? (NQB - 1 - x_) : x_, b_ = bh_ / NH, h_ = bh_ % NH; \
        const size_t row0_ = (size_t)b_ * SEQ; (ref).P0 = qb_ * QB; \
        (ref).Q = QKb + (row0_ + qb_ * QB) * KP + h_ * 128; (ref).K = QKb + row0_ * KP + 512 + h_ * 128; (ref).V = Vb + row0_ * VP + h_ * 128; \
        (ref).O = MX + (row0_ + qb_ * QB) * KP + h_ * 128; } while (0)
    BlockRef cur, nxt; MKREF(cur, L, 0);
    Seam S;
    int tid_ = threadIdx.x; asm volatile("" : "+v"(tid_));
    prime(cur, lds, S, tid_);
    for (;;) {
        const bool more_pass = pass == 0, more_item = L + G < TOTAL, last = !more_pass && !more_item;
        int passn = pass + 1, Ln = L;
        if (!more_pass) { passn = 0; Ln = more_item ? L + G : L; }
        if (last) nxt = cur; else MKREF(nxt, Ln, passn);
        block<ZC>(cur, nxt, lds, S, lam, smax, subg, last, tid_);
        if (last) break;
        cur = nxt; pass = passn; L = Ln;
    }
#undef MKREF
}
__device__ __forceinline__ void phase_queue(char* lds, const bf16_t* QKb, const bf16_t* Vb, bf16_t* MX, float lam, float smax, const float* subg, unsigned* qctr, int xg) {
    constexpr int TOTAL = NB * NH * NQB / 8;
    volatile int* tk = (volatile int*)(lds + LDS_END);
#define MKREFQ(ref, kk) do { const int hf_ = (kk) >> 6, k6_ = (kk) & 63, bh_ = 4 * xg + 2 * hf_ + (k6_ & 1), qb_ = NQB - 1 - (k6_ >> 1), b_ = bh_ / NH, h_ = bh_ % NH; \
        const size_t row0_ = (size_t)b_ * SEQ; (ref).P0 = qb_ * QB; \
        (ref).Q = QKb + (row0_ + qb_ * QB) * KP + h_ * 128; (ref).K = QKb + row0_ * KP + 512 + h_ * 128; (ref).V = Vb + row0_ * VP + h_ * 128; \
        (ref).O = MX + (row0_ + qb_ * QB) * KP + h_ * 128; } while (0)
    if (threadIdx.x == 0) { tk[0] = (int)atomicAdd(qctr, 1u); tk[1] = (int)atomicAdd(qctr, 1u); }
    __syncthreads();
    int tc = tk[0];
    if (tc >= TOTAL) { __syncthreads(); return; }
    BlockRef cur, nxt; MKREFQ(cur, tc);
    Seam S;
    int tid_ = threadIdx.x; asm volatile("" : "+v"(tid_));
    prime(cur, lds, S, tid_);
    for (int i = 0;; ++i) {
        const int tn = tk[(i + 1) & 1];
        if (threadIdx.x == 0) tk[i & 1] = (int)atomicAdd(qctr, 1u);
        const bool last = tn >= TOTAL;
        if (last) nxt = cur; else MKREFQ(nxt, tn);
        block<false>(cur, nxt, lds, S, lam, smax, subg, last, tid_);
        if (last) break;
        cur = nxt;
    }
    __syncthreads();
#undef MKREFQ
}
#undef ROWK
#undef ROWV
#undef LD8
#undef VMW
#undef VMWN
#undef SLOAD_H
#undef SWRITE_HK
#undef SWRITE_HV
#undef SWRITE_H
#undef QLOAD
#undef KSWZ
#undef SBAR
}


enum { PH_PRO = 0, PH_H1, PH_WIN, PH_WIN_F, PH_QKN, PH_ATT, PH_ATTC, PH_SSM, PH_GLU, PH_NORM, PH_WOUT, PH_WOUT_F, PH_H2, PH_RS, PH_RS2, PH_RS_F, PH_SD, PH_ROUTE, PH_SLOT, PH_E1, PH_E1_F, PH_E2, PH_COMB, PH_M_B, PH_M_D, PH_NORM2, PH_H2_2, PH_M_J2, PH_X1, PH_X2, PH_M_A2, PH_M_E3, PH_SLOT4, PH_E2S_F, PH_COMB3, PH_M_E4, PH_H2_3, PH_E1_8, PH_M_E5, PH_E1_88, PH_E2_8, PH_COMB4, PH_E2_B8, PH_E1_G8, PH_E2_P8, PH_M_J3, PH_SLOT5, PH_COMB5, PH_M_E6, PH_COUNT };
constexpr int NTHREADS = 512;
constexpr int LDS_BYTES = 147456;
constexpr int LDS_MISC_OFF = 147456 - 256;
typedef unsigned long long mask_t;
#define PHBIT(k) (1ull << (k))

template <mask_t MASK>
__global__ void __launch_bounds__(NTHREADS, 2) mega(Params p) {
    extern __shared__ __attribute__((aligned(16))) unsigned char lds_raw[];
#define MAKE_CTX() Ctx c; { int t_ = threadIdx.x; asm volatile("" : "+v"(t_)); c.tid = t_; c.lane = c.tid & 63; c.wave = __builtin_amdgcn_readfirstlane(c.tid >> 6); c.bid = blockIdx.x; c.nb = gridDim.x; \
    c.gtid = c.bid * NTHREADS + c.tid; c.gthreads = c.nb * NTHREADS; c.gwave = c.bid * (NTHREADS / 64) + c.wave; c.gwaves = c.nb * (NTHREADS / 64); c.ws = p.ws; c.lds = (float*)lds_raw; }
    unsigned char* ws = p.ws;
    PG8_LAS unsigned char* lds3 = (PG8_LAS unsigned char*)lds_raw;
    const int G = gridDim.x, bid = blockIdx.x, vcu = (G % 8 == 0) ? (bid % 8) * (G / 8) + bid / 8 : bid;
    constexpr bool MULTI = (MASK & (MASK - 1)) != 0;
    XcdBarrier bar; bar.bar = (unsigned*)(ws + WS_CTL) + CW_BAR; bar.x = 0; bar.st = nullptr;
    if constexpr (MULTI) {
        volatile LAS unsigned* misc = (volatile LAS unsigned*)(lds3 + LDS_MISC_OFF);
        if (threadIdx.x < 32) misc[threadIdx.x] = 0u;
        __syncthreads();
        bar = xcd_barrier_post((unsigned*)(ws + WS_CTL) + CW_BAR, misc + 8);
    }
    bool first = true;
#ifndef TIME_A
#define TIME_A -1
#endif
#ifndef TIME_B
#define TIME_B -1
#endif
#ifndef TIME_Q
#define TIME_Q 800
#endif
    constexpr bool TIMING = (TIME_A >= 0) || (TIME_B >= 0);
    unsigned long long tstart = 0, t_a = 0, t_b = 0; int pidx = 0;
#define STAMP() ({ if constexpr (TIMING) { const unsigned long long now_ = __builtin_amdgcn_s_memrealtime(); \
        if (pidx > 0 && pidx - 1 == TIME_A) t_a = now_ - tstart; if (pidx > 0 && pidx - 1 == TIME_B) t_b = now_ - tstart; tstart = now_; ++pidx; } true; })
#define PHASE(k) if constexpr ((MASK >> (k)) & 1ull) if ((MULTI ? (first ? (first = false, true) : (xcd_barrier(bar), true)) : true)) if (STAMP())
    PHASE(PH_PRO) { MAKE_CTX(); ph_prologue(c, p); }
    PHASE(PH_M_A2) { MAKE_CTX(); ph_prologue2(c, p); ph_convert<false>(c, p); }
    PHASE(PH_H1) { MAKE_CTX(); ph_h1(c, p); }
    PHASE(PH_M_B) { MAKE_CTX(); ph_h1(c, p); ph_ssm_gen(c, p); }
    PHASE(PH_WIN) { MAKE_CTX(); SG_Args g{(const bf16_t*)(ws + WS_H), DM, nullptr, p.in[I_WIN], nullptr, 2048, 0, nullptr, T, 2048, DM};
        EpiWin E{(bf16_t*)(ws + WS_QK), (bf16_t*)(ws + WS_V), (bf16_t*)(ws + WS_AP)}; sgemm_phase<false>(c, g, E); }
    PHASE(PH_WIN_F) { MAKE_CTX(); pg8::Gemm g{(const bf16_t*)(ws + WS_H), (const bf16_t*)(ws + WS_WIN_T), DM, DM, nullptr}; pg8::DenseOrder S; S.init(T, 2048, G, bid);
        pg8::EpiWinF E{(bf16_t*)(ws + WS_QK), (bf16_t*)(ws + WS_V), (bf16_t*)(ws + WS_AP)}; pg8::gemm_phase<pg8::EpiWinF, pg8::DenseOrder, false, true>(lds3, g, S, E); }
    PHASE(PH_QKN) { MAKE_CTX(); ph_qkn(c, p); }
    PHASE(PH_M_D) { { MAKE_CTX(); ph_qkn2(c, p); }
        { pg8::Gemm g{(const bf16_t*)(ws + WS_AP), (const bf16_t*)(ws + WS_SSM_BA), 256, APK, nullptr}; pg8::SsmOrder S{G, vcu};
          pg8::EpiSsmA E{(float*)(ws + WS_DS)}; pg8::gemm_phase<pg8::EpiSsmA, pg8::SsmOrder, false, false>(lds3, g, S, E); }
        __builtin_amdgcn_fence(__ATOMIC_ACQUIRE, "agent"); asm volatile("s_waitcnt vmcnt(0)" ::: "memory"); __syncthreads();
        { MAKE_CTX(); ph_ssm_scan(c, p, vcu); }
        asm volatile("s_waitcnt vmcnt(0)" ::: "memory"); __syncthreads(); __builtin_amdgcn_fence(__ATOMIC_ACQUIRE, "agent"); asm volatile("s_waitcnt vmcnt(0)" ::: "memory"); __syncthreads();
        { pg8::Gemm g{(const bf16_t*)(ws + WS_AP), (const bf16_t*)(ws + WS_SSM_BC), APK, APK, nullptr}; pg8::SsmOrder S{G, vcu};
          pg8::EpiSsmC E{(bf16_t*)(ws + WS_Y)}; pg8::gemm_phase<pg8::EpiSsmC, pg8::SsmOrder, false, false>(lds3, g, S, E); } }
    PHASE(PH_ATT) { MAKE_CTX(); ph_att_base(c, p); }
    PHASE(PH_ATTC) { MAKE_CTX(); ph_att_comb(c, p); }
    PHASE(PH_SSM) { MAKE_CTX(); ph_ssm_base(c, p); }
    PHASE(PH_M_E3) { { constexpr int GU8E = 0; MAKE_CTX(); const float* lamp = (const float*)(ws + WS_LAM); const float lam_ = lamp[0], smax_ = lamp[1];
          float* scr = c.lds + c.wave * (64 * 65);
          const int grp = vcu & 3;
          const unsigned prog = grp == 0 ? 0x0213u : grp == 1 ? 0x0231u : grp == 2 ? 0x0321u : 0x2514u;
          for (int step = 0; step < 4; ++step) {
              const int code = (int)((prog >> (4 * step)) & 15u);
              if (code == 1 || code == 2) { const int i_ = code - 1;
                  att::phase((char*)lds_raw, (const bf16_t*)(ws + WS_QK), (const bf16_t*)(ws + WS_V), (bf16_t*)(ws + WS_MIXIN), lam_, smax_, p.in[I_SUBG], G, vcu, vcu + i_ * G, vcu + i_ * G + 1); }
              else if (code >= 3) { const int lo = code == 5 ? 96 : 0, hi = code == 4 ? 96 : 192;
                  conv_range<GU8E>(c, p, vcu * 192 + lo + c.wave, vcu * 192 + hi, 8, scr); }
              __syncthreads();
          }
        }
        { pg8::Gemm g{(const bf16_t*)(ws + WS_Y), (const bf16_t*)(ws + WS_WGLU_T), 512, 512, nullptr}; pg8::DenseOrder S; S.init(T, 512, G, bid);
          pg8::EpiGluF E{(const bf16_t*)(ws + WS_Y), (bf16_t*)(ws + WS_MIXIN), (float*)(ws + WS_SS1P)}; pg8::gemm_phase<pg8::EpiGluF, pg8::DenseOrder, false, true>(lds3, g, S, E); } }
    PHASE(PH_M_E4) { { constexpr int GU8E = 1; MAKE_CTX(); const float* lamp = (const float*)(ws + WS_LAM); const float lam_ = lamp[0], smax_ = lamp[1];
          float* scr = c.lds + c.wave * (64 * 65);
          const int grp = vcu & 3;
          const unsigned prog = grp == 0 ? 0x0213u : grp == 1 ? 0x0231u : grp == 2 ? 0x0321u : 0x2514u;
          for (int step = 0; step < 4; ++step) {
              const int code = (int)((prog >> (4 * step)) & 15u);
              if (code == 1 || code == 2) { const int i_ = code - 1;
                  att::phase((char*)lds_raw, (const bf16_t*)(ws + WS_QK), (const bf16_t*)(ws + WS_V), (bf16_t*)(ws + WS_MIXIN), lam_, smax_, p.in[I_SUBG], G, vcu, vcu + i_ * G, vcu + i_ * G + 1); }
              else if (code >= 3) { const int lo = code == 5 ? 96 : 0, hi = code == 4 ? 96 : 192;
                  conv_range<GU8E>(c, p, vcu * 192 + lo + c.wave, vcu * 192 + hi, 8, scr); }
              __syncthreads();
          }
        }
        { pg8::Gemm g{(const bf16_t*)(ws + WS_Y), (const bf16_t*)(ws + WS_WGLU_T), 512, 512, nullptr}; pg8::DenseOrder S; S.init(T, 512, G, bid);
          pg8::EpiGluF E{(const bf16_t*)(ws + WS_Y), (bf16_t*)(ws + WS_MIXIN), (float*)(ws + WS_SS1P)}; pg8::gemm_phase<pg8::EpiGluF, pg8::DenseOrder, false, true>(lds3, g, S, E); } }
    PHASE(PH_M_E5) { { constexpr int GU8E = 2; MAKE_CTX(); const float* lamp = (const float*)(ws + WS_LAM); const float lam_ = lamp[0], smax_ = lamp[1];
          float* scr = c.lds + c.wave * (64 * 65);
          const int grp = vcu & 3;
          const unsigned prog = grp == 0 ? 0x0213u : grp == 1 ? 0x0231u : grp == 2 ? 0x0321u : 0x2514u;
#define E5_STEPS(ZC_) \
          for (int step = 0; step < 4; ++step) { \
              const int code = (int)((prog >> (4 * step)) & 15u); \
              if (code == 1 || code == 2) { const int i_ = code - 1; \
                  att::phase<ZC_>((char*)lds_raw, (const bf16_t*)(ws + WS_QK), (const bf16_t*)(ws + WS_V), (bf16_t*)(ws + WS_MIXIN), lam_, smax_, p.in[I_SUBG], G, vcu, vcu + i_ * G, vcu + i_ * G + 1); } \
              else if (code >= 3) { const int lo = code == 5 ? 96 : 0, hi = code == 4 ? 96 : 192; \
                  conv_range<GU8E>(c, p, vcu * 192 + lo + c.wave, vcu * 192 + hi, 8, scr); } \
              __syncthreads(); \
          }
          if (smax_ * 1.4426950408889634f <= 64.f) { E5_STEPS(true); }
          else { E5_STEPS(false); }
#undef E5_STEPS
        }
        { pg8::Gemm g{(const bf16_t*)(ws + WS_Y), (const bf16_t*)(ws + WS_WGLU_T), 512, 512, nullptr}; pg8::DenseOrder S; S.init(T, 512, G, bid);
          pg8::EpiGluF E{(const bf16_t*)(ws + WS_Y), (bf16_t*)(ws + WS_MIXIN), (float*)(ws + WS_SS1P)}; pg8::gemm_phase<pg8::EpiGluF, pg8::DenseOrder, false, true>(lds3, g, S, E); } }
    PHASE(PH_GLU) { MAKE_CTX(); SG_Args g{(const bf16_t*)(ws + WS_Y), 512, nullptr, p.in[I_WGLU], nullptr, 512, 0, nullptr, T, 512, 512};
        EpiGlu E{(const bf16_t*)(ws + WS_Y), (bf16_t*)(ws + WS_MIXIN), (float*)(ws + WS_CTL + CTL_SS1)}; sgemm_phase<false>(c, g, E); }
    PHASE(PH_NORM) { MAKE_CTX(); ph_ssm_norm(c, p); }
    PHASE(PH_NORM2) { MAKE_CTX(); ph_ssm_norm2(c, p); }
    PHASE(PH_WOUT) { MAKE_CTX(); SG_Args g{(const bf16_t*)(ws + WS_MIXIN), DM, nullptr, p.in[I_WOUT], nullptr, DM, 0, nullptr, T, DM, DM};
        EpiWout E{p.in[I_X], (const float*)(ws + WS_MOD), p.out, (float*)(ws + WS_CTL + CTL_SS2)}; sgemm_phase<false>(c, g, E); }
    PHASE(PH_WOUT_F) { MAKE_CTX(); pg8::Gemm g{(const bf16_t*)(ws + WS_MIXIN), (const bf16_t*)(ws + WS_WOUT_T), DM, DM, nullptr}; pg8::DenseOrder S; S.init(T, DM, G, bid);
        pg8::EpiWoutF E{p.in[I_X], (const float*)(ws + WS_MOD), p.out, (float*)(ws + WS_SS2P)}; pg8::gemm_phase<pg8::EpiWoutF, pg8::DenseOrder, false, true>(lds3, g, S, E); }
    PHASE(PH_H2) { MAKE_CTX(); ph_h2(c, p); }
    PHASE(PH_H2_2) { MAKE_CTX(); ph_h2_2(c, p); }
    PHASE(PH_H2_3) { MAKE_CTX(); ph_h2_3(c, p); }
    PHASE(PH_RS) { MAKE_CTX(); SG_Args g{(const bf16_t*)(ws + WS_H), DM, nullptr, p.in[I_WR], nullptr, 256, 0, nullptr, T, 256, DM};
        EpiLogits E{(float*)(ws + WS_LOGITS)}; sgemm_phase<false>(c, g, E); }
    PHASE(PH_RS2) { MAKE_CTX(); SG_Args g2{(const bf16_t*)(ws + WS_H), DM, nullptr, p.in[I_WGS], p.in[I_WUS], 256, 0, nullptr, T, 256, DM};
        EpiSwiglu E2{(bf16_t*)(ws + WS_ACTS), 256}; sgemm_phase<true>(c, g2, E2); }
    PHASE(PH_RS_F) { MAKE_CTX(); pg8::Gemm g{(const bf16_t*)(ws + WS_H), (const bf16_t*)(ws + WS_WRS_T), DM, DM, nullptr}; pg8::DenseOrder S; S.init(T, 768, G, bid);
        pg8::EpiRSF E{(float*)(ws + WS_LOGITS), (bf16_t*)(ws + WS_ACTS)}; pg8::gemm_phase<pg8::EpiRSF, pg8::DenseOrder, false, true>(lds3, g, S, E); }
    PHASE(PH_SD) { MAKE_CTX(); SG_Args g{(const bf16_t*)(ws + WS_ACTS), 256, nullptr, p.in[I_WDS], nullptr, DM, 0, nullptr, T, DM, ED};
        EpiSD E{(const float*)(ws + WS_MOD), p.out}; sgemm_phase<false>(c, g, E); }
    PHASE(PH_ROUTE) { MAKE_CTX(); ph_route(c, p); }
    PHASE(PH_M_J2) { { MAKE_CTX(); ph_route2<false>(c, p); }
        { pg8::Gemm g{(const bf16_t*)(ws + WS_ACTS), (const bf16_t*)(ws + WS_WDS_T), ED, ED, nullptr}; pg8::DenseOrder S; S.init(T, DM, G, bid);
          pg8::EpiSDY E{(bf16_t*)(ws + WS_YSH)}; pg8::gemm_phase<pg8::EpiSDY, pg8::DenseOrder, false, true>(lds3, g, S, E); } }
    PHASE(PH_M_J3) { { MAKE_CTX(); ph_route2<true>(c, p); }
        { pg8::Gemm g{(const bf16_t*)(ws + WS_ACTS), (const bf16_t*)(ws + WS_WDS_T), ED, ED, nullptr}; pg8::DenseOrder S; S.init(T, DM, G, bid);
          pg8::EpiSDY E{(bf16_t*)(ws + WS_YSH)}; pg8::gemm_phase<pg8::EpiSDY, pg8::DenseOrder, false, true>(lds3, g, S, E); } }
    PHASE(PH_SLOT5) { MAKE_CTX(); ph_slot5(c, p); }
    PHASE(PH_SLOT) { MAKE_CTX(); ph_slot(c, p); }
    PHASE(PH_SLOT4) { MAKE_CTX(); ph_slot3<true>(c, p); }
    PHASE(PH_E1) { MAKE_CTX(); SG_Args g{(const bf16_t*)(ws + WS_H), DM, (const int*)(ws + WS_SLOT_TOK), p.in[I_WGE], p.in[I_WUE], 256, (size_t)DM * ED, (const int*)(ws + WS_TILE_E), NS_MAX, ED, DM};
        EpiSwiglu E{(bf16_t*)(ws + WS_ACTE), 256}; sgemm_phase<true>(c, g, E); }
    PHASE(PH_E1_F) { MAKE_CTX(); pg8::Gemm g{(const bf16_t*)(ws + WS_H), (const bf16_t*)(ws + WS_WGU), DM, DM, (const int*)(ws + WS_SLOT_TOK)};
        pg8::GroupedOrder S{(const int*)(ws + WS_TILE_E), (int)((const unsigned*)(ws + WS_CTL))[CW_NTILES], 2, G, vcu};
        pg8::EpiE1F E{(bf16_t*)(ws + WS_ACTE)}; pg8::gemm_phase<pg8::EpiE1F, pg8::GroupedOrder, true, true>(lds3, g, S, E); }
    PHASE(PH_X1) { pg8::Gemm g{(const bf16_t*)(ws + WS_ACTE), (const bf16_t*)(ws + WS_WD), ED / 2, ED / 2, nullptr, 0x7A7A7A7Au, 0x7C7C7C7Cu};
        pg8::GroupedOrder S{(const int*)(ws + WS_TILE_E), (int)((const unsigned*)(ws + WS_CTL))[CW_NTILES], 4, G, vcu};
        pg8::EpiNone E{(float*)(ws + WS_DS)}; pg8::gemm_phase<pg8::EpiNone, pg8::GroupedOrder, true, true, true>(lds3, g, S, E); }
    PHASE(PH_X2) { pg8::Gemm g{(const bf16_t*)(ws + WS_ACTE), (const bf16_t*)(ws + WS_WD), ED, ED, nullptr};
        pg8::GroupedOrder S{(const int*)(ws + WS_TILE_E), (int)((const unsigned*)(ws + WS_CTL))[CW_NTILES], 4, G, vcu};
        pg8::EpiDense E{(bf16_t*)(ws + WS_YA)}; pg8::gemm_phase<pg8::EpiDense, pg8::GroupedOrder, false, true>(lds3, g, S, E); }
    PHASE(PH_E1_8) { pg8::Gemm g{(const bf16_t*)(ws + WS_H8), (const bf16_t*)(ws + WS_WGU), DM / 2, DM / 2, (const int*)(ws + WS_SLOT_TOK), 0x79797979u};
        pg8::GroupedOrder S{(const int*)(ws + WS_TILE_E), (int)((const unsigned*)(ws + WS_CTL))[CW_NTILES], 2, G, vcu};
        pg8::EpiE1F E{(bf16_t*)(ws + WS_ACTE)}; pg8::gemm_phase<pg8::EpiE1F, pg8::GroupedOrder, true, true, true>(lds3, g, S, E); }
    PHASE(PH_E1_88) { pg8::Gemm g{(const bf16_t*)(ws + WS_H8), (const bf16_t*)(ws + WS_WGU), DM / 2, DM / 2, (const int*)(ws + WS_SLOT_TOK), 0x79797979u};
        pg8::GroupedOrderL S{nullptr, (int)((const unsigned*)(ws + WS_CTL))[CW_NTILES], 2, G, vcu}; S.fill((const int*)(ws + WS_TILE_E), (PG8_LAS int*)(lds3 + 131072));
        pg8::EpiE1F8 E{ws + WS_ACTE}; pg8::gemm_phase<pg8::EpiE1F8, pg8::GroupedOrderL, true, true, true>(lds3, g, S, E); }
    PHASE(PH_E2_8) { pg8::Gemm g{(const bf16_t*)(ws + WS_ACTE), (const bf16_t*)(ws + WS_WD), ED / 2, ED / 2, nullptr, 0x7A7A7A7Au, 0x7C7C7C7Cu};
        pg8::GroupedOrder S{(const int*)(ws + WS_TILE_E), (int)((const unsigned*)(ws + WS_CTL))[CW_NTILES], 4, G, vcu};
        pg8::EpiE2S8b E{(const float*)(ws + WS_SLOT_GATE), ws + WS_YS}; pg8::gemm_phase<pg8::EpiE2S8b, pg8::GroupedOrder, true, true, true>(lds3, g, S, E); }
    PHASE(PH_E2_B8) { pg8::Gemm g{(const bf16_t*)(ws + WS_ACTE), (const bf16_t*)(ws + WS_WD), ED, ED, nullptr};
        pg8::GroupedOrder S{(const int*)(ws + WS_TILE_E), (int)((const unsigned*)(ws + WS_CTL))[CW_NTILES], 4, G, vcu};
        pg8::EpiE2S8 E{(const float*)(ws + WS_SLOT_GATE), ws + WS_YS}; pg8::gemm_phase<pg8::EpiE2S8, pg8::GroupedOrder, false, true>(lds3, g, S, E); }
    PHASE(PH_E1_G8) { pg8::Gemm g{(const bf16_t*)(ws + WS_H8), (const bf16_t*)(ws + WS_WGU), DM / 2, DM / 2, (const int*)(ws + WS_SLOT_TOK), 0x79797979u};
        pg8::GroupedOrder S{(const int*)(ws + WS_TILE_E), (int)((const unsigned*)(ws + WS_CTL))[CW_NTILES], 2, G, vcu};
        pg8::EpiE1G8 E{(const float*)(ws + WS_SLOT_GATE), ws + WS_ACTE}; pg8::gemm_phase<pg8::EpiE1G8, pg8::GroupedOrder, true, true, true>(lds3, g, S, E); }
    static_assert(Y8_SCALE == 16.f && ACT8_SCALE == 8.f && WD8_SCALE == 32.f, "E8M0 scales below");
    PHASE(PH_E2_P8) { pg8::Gemm g{(const bf16_t*)(ws + WS_ACTE), (const bf16_t*)(ws + WS_WD), ED / 2, ED / 2, nullptr, 0x7A7A7A7Au, 0x80808080u};
        pg8::GroupedOrderL S{nullptr, (int)((const unsigned*)(ws + WS_CTL))[CW_NTILES], 4, G, vcu}; S.fill((const int*)(ws + WS_TILE_E), (PG8_LAS int*)(lds3 + 131072));
        pg8::EpiE2P8 E{ws + WS_YS}; pg8::gemm_phase<pg8::EpiE2P8, pg8::GroupedOrderL, true, true, true, 2>(lds3, g, S, E); }
    PHASE(PH_COMB5) { MAKE_CTX(); ph_combine5(c, p); }
    PHASE(PH_COMB4) { MAKE_CTX(); ph_combine4(c, p); }
    PHASE(PH_E2) { MAKE_CTX(); SG_Args g{(const bf16_t*)(ws + WS_ACTE), 256, nullptr, p.in[I_WDE], nullptr, DM, (size_t)ED * DM, (const int*)(ws + WS_TILE_E), NS_MAX, DM, ED};
        EpiE2 E{(const int*)(ws + WS_SLOT_ASG), (const float*)(ws + WS_SLOT_GATE), (bf16_t*)(ws + WS_YA)}; sgemm_phase<false>(c, g, E); }
    PHASE(PH_E2S_F) { pg8::Gemm g{(const bf16_t*)(ws + WS_ACTE), (const bf16_t*)(ws + WS_WD), ED, ED, nullptr};
        pg8::GroupedOrder S{(const int*)(ws + WS_TILE_E), (int)((const unsigned*)(ws + WS_CTL))[CW_NTILES], 4, G, vcu};
        pg8::EpiE2S E{(const int*)(ws + WS_SLOT_ASG), (const float*)(ws + WS_SLOT_GATE), (bf16_t*)(ws + WS_YS)}; pg8::gemm_phase<pg8::EpiE2S, pg8::GroupedOrder, false, true>(lds3, g, S, E); }
    PHASE(PH_COMB3) { MAKE_CTX(); ph_combine3(c, p); }
    PHASE(PH_COMB) { MAKE_CTX(); ph_combine(c, p); }
    if constexpr (TIMING) {
        xcd_barrier(bar); (void)STAMP();
        if (blockIdx.x == 0 && threadIdx.x == 0) {
            const unsigned long long qb = (t_b + TIME_Q / 2) / TIME_Q;
            const unsigned long long wait = t_a + qb * 102400ull, t0 = __builtin_amdgcn_s_memrealtime();
            while (__builtin_amdgcn_s_memrealtime() - t0 < wait) __builtin_amdgcn_s_sleep(8);
        }
    }
#undef PHASE
}

#ifndef PLAN
#define PLAN 18
#endif
#if PLAN == 0
#define LAUNCH_LIST X(PHBIT(PH_PRO)) X(PHBIT(PH_H1)) X(PHBIT(PH_WIN)) X(PHBIT(PH_QKN)) X(PHBIT(PH_ATT)) X(PHBIT(PH_ATTC)) X(PHBIT(PH_SSM)) X(PHBIT(PH_GLU)) X(PHBIT(PH_NORM)) \
    X(PHBIT(PH_WOUT)) X(PHBIT(PH_H2)) X(PHBIT(PH_RS)) X(PHBIT(PH_RS2)) X(PHBIT(PH_SD)) X(PHBIT(PH_ROUTE)) X(PHBIT(PH_SLOT)) X(PHBIT(PH_E1)) X(PHBIT(PH_E2)) X(PHBIT(PH_COMB))
#elif PLAN == 12
#define LAUNCH_LIST X(PHBIT(PH_M_A2) | PHBIT(PH_M_B) | PHBIT(PH_WIN_F) | PHBIT(PH_M_D) | PHBIT(PH_M_E3) | PHBIT(PH_NORM2) | PHBIT(PH_WOUT_F) | PHBIT(PH_H2_2) | PHBIT(PH_RS_F) | PHBIT(PH_M_J2) | PHBIT(PH_SLOT4) | PHBIT(PH_E1_F) | PHBIT(PH_E2S_F) | PHBIT(PH_COMB3))
#elif PLAN == 13
#define LAUNCH_LIST X(PHBIT(PH_M_A2) | PHBIT(PH_M_B) | PHBIT(PH_WIN_F) | PHBIT(PH_M_D) | PHBIT(PH_M_E3) | PHBIT(PH_NORM2) | PHBIT(PH_WOUT_F) | PHBIT(PH_H2_2) | PHBIT(PH_RS_F) | PHBIT(PH_M_J2) | PHBIT(PH_SLOT4) | PHBIT(PH_E1_F) | PHBIT(PH_X1) | PHBIT(PH_E2S_F) | PHBIT(PH_COMB3))
#elif PLAN == 14
#define LAUNCH_LIST X(PHBIT(PH_M_A2) | PHBIT(PH_M_B) | PHBIT(PH_WIN_F) | PHBIT(PH_M_D) | PHBIT(PH_M_E4) | PHBIT(PH_NORM2) | PHBIT(PH_WOUT_F) | PHBIT(PH_H2_3) | PHBIT(PH_RS_F) | PHBIT(PH_M_J2) | PHBIT(PH_SLOT4) | PHBIT(PH_E1_8) | PHBIT(PH_E2S_F) | PHBIT(PH_COMB3))
#elif PLAN == 15
#define LAUNCH_LIST X(PHBIT(PH_M_A2) | PHBIT(PH_M_B) | PHBIT(PH_WIN_F) | PHBIT(PH_M_D) | PHBIT(PH_M_E5) | PHBIT(PH_NORM2) | PHBIT(PH_WOUT_F) | PHBIT(PH_H2_3) | PHBIT(PH_RS_F) | PHBIT(PH_M_J2) | PHBIT(PH_SLOT4) | PHBIT(PH_E1_88) | PHBIT(PH_E2_8) | PHBIT(PH_COMB4))
#elif PLAN == 99
#define LAUNCH_LIST X(PHBIT(PH_M_E5)) X(PHBIT(PH_E1_88)) X(PHBIT(PH_E2_8)) X(PHBIT(PH_COMB4)) X(PHBIT(PH_H2_3)) X(PHBIT(PH_M_D)) X(PHBIT(PH_WIN_F)) X(PHBIT(PH_WOUT_F)) X(PHBIT(PH_RS_F)) X(PHBIT(PH_M_J2))
#elif PLAN == 16
#define LAUNCH_LIST X(PHBIT(PH_M_A2) | PHBIT(PH_M_B) | PHBIT(PH_WIN_F) | PHBIT(PH_M_D) | PHBIT(PH_M_E4) | PHBIT(PH_NORM2) | PHBIT(PH_WOUT_F) | PHBIT(PH_H2_3) | PHBIT(PH_RS_F) | PHBIT(PH_M_J2) | PHBIT(PH_SLOT4) | PHBIT(PH_E1_8) | PHBIT(PH_E2_B8) | PHBIT(PH_COMB4))
#elif PLAN == 17
#define LAUNCH_LIST X(PHBIT(PH_M_A2) | PHBIT(PH_M_B) | PHBIT(PH_WIN_F) | PHBIT(PH_M_D) | PHBIT(PH_M_E5) | PHBIT(PH_NORM2) | PHBIT(PH_WOUT_F) | PHBIT(PH_H2_3) | PHBIT(PH_RS_F) | PHBIT(PH_M_J2) | PHBIT(PH_SLOT4) | PHBIT(PH_E1_G8) | PHBIT(PH_E2_P8) | PHBIT(PH_COMB4))
#elif PLAN == 18
#define LAUNCH_LIST X(PHBIT(PH_M_A2) | PHBIT(PH_M_B) | PHBIT(PH_WIN_F) | PHBIT(PH_M_D) | PHBIT(PH_M_E5) | PHBIT(PH_NORM2) | PHBIT(PH_WOUT_F) | PHBIT(PH_H2_3) | PHBIT(PH_RS_F) | PHBIT(PH_M_J3) | PHBIT(PH_SLOT5) | PHBIT(PH_E1_88) | PHBIT(PH_E2_P8) | PHBIT(PH_COMB5))
#elif PLAN == 20
#define LAUNCH_LIST X(PHBIT(PH_M_A2) | PHBIT(PH_M_B) | PHBIT(PH_WIN_F) | PHBIT(PH_M_D) | PHBIT(PH_M_E5) | PHBIT(PH_NORM2) | PHBIT(PH_WOUT_F) | PHBIT(PH_H2_3) | PHBIT(PH_RS_F) | PHBIT(PH_M_J3) | PHBIT(PH_SLOT5) | PHBIT(PH_E1_88) | PHBIT(PH_X1) | PHBIT(PH_E2_P8) | PHBIT(PH_COMB5))
#endif

extern "C" void kernel_launch(void* const* d_in, const int* in_sizes, int n_in, void* d_out, int out_size, void* d_ws, size_t ws_size, hipStream_t stream) {
    static int grid = 0;
    if (grid == 0) {
        if (n_in != 33 || out_size != T * DM || ws_size < WS_NEED) { fprintf(stderr, "kernel_launch: unexpected shapes (n_in %d out %d ws %zu)\n", n_in, out_size, ws_size); grid = -1; return; }
        int dev = 0, cus = 0;
        if (hipGetDevice(&dev) != hipSuccess || hipDeviceGetAttribute(&cus, hipDeviceAttributeMultiprocessorCount, dev) != hipSuccess) { grid = -1; return; }
        bool ok = true;
#define X(m) ok = ok && (hipFuncSetAttribute((const void*)mega<(m)>, hipFuncAttributeMaxDynamicSharedMemorySize, LDS_BYTES) == hipSuccess);
        LAUNCH_LIST
#undef X
        if (!ok) { grid = -1; return; }
        grid = cus;
    }
    if (grid < 0) return;
    (void)hipMemsetAsync((char*)d_ws + WS_CTL, 0, CTL_BYTES, stream);
    Params a{};
    for (int i = 0; i < 33; ++i) a.in[i] = (const float*)d_in[i];
    a.out = (float*)d_out; a.ws = (unsigned char*)d_ws;
#define X(m) hipLaunchKernelGGL((mega<(m)>), dim3(grid), dim3(NTHREADS), LDS_BYTES, stream, a);
    LAUNCH_LIST
#undef X
}
```

```cpp
#include <hip/hip_runtime.h>
#include <cstdio>
#include <cstdint>

typedef unsigned short bf16_t;
typedef float f32x4 __attribute__((ext_vector_type(4)));
typedef unsigned u32x4 __attribute__((ext_vector_type(4)));
typedef unsigned u32x2 __attribute__((ext_vector_type(2)));

constexpr int DM = 1024, NB = 8, SEQ = 4096, T = NB * SEQ;
constexpr int NH = 4, HD = 64, VD = 128, QKW = 512, ATTW = 512, SSMW = 512;
constexpr int SG = 32, SC = 16, SP = 64;
constexpr int LC = 16;
constexpr int NCHUNK = SEQ / LC;
constexpr int APK = 384;
constexpr int NE = 256, TOPK = 8, NGRP = 8, TOPG = 4, ED = 256;
constexpr int NS_MAX = 327680;
constexpr float EPS = 1e-6f;
constexpr float LAM_INIT = 0.2f;
constexpr float ROUTED_SCALE = 2.5f;
constexpr float WGU8_SCALE = 64.f, WD8_SCALE = 32.f, ACT8_SCALE = 8.f, Y8_SCALE = 16.f;

constexpr size_t MiB = 1u << 20;
constexpr size_t WS_CTL = 0, CTL_BYTES = 1 * MiB;
constexpr int CW_COUNTS = 1024;
constexpr int CW_CURSOR = 1024 + 256;
constexpr int CW_NTILES = 2048;
constexpr int CW_ATTQ = 2560  , CW_CONVQ = 2176;
constexpr int CW_BAR = 4096;
constexpr size_t CTL_SS1 = 256 * 1024;
constexpr size_t CTL_SS2 = 384 * 1024;
constexpr size_t WS_MOD = 512 * 1024;
constexpr size_t WS_LAM = 1 * MiB + 256 * 1024;
constexpr size_t WS_ROPE = 1 * MiB + 512 * 1024;
constexpr size_t WS_SSMP = 2 * MiB + 512 * 1024;
constexpr size_t WS_SS1P = 3 * MiB;
constexpr size_t WS_SS2P = 528 * MiB;
constexpr size_t WS_HIST = 11 * MiB;
constexpr size_t WS_EIDX = 4 * MiB;
constexpr size_t WS_GATEW = 5 * MiB;
constexpr size_t WS_SLOT_TOK = 6 * MiB;
constexpr size_t WS_SLOT_ASG = 7 * MiB + 512 * 1024;
constexpr size_t WS_SLOT_GATE = 9 * MiB;
constexpr size_t WS_TILE_E = 10 * MiB + 512 * 1024;
constexpr size_t WS_PADST = 10 * MiB + 768 * 1024;
constexpr size_t WS_WIN_T = 12 * MiB;
constexpr size_t WS_WOUT_T = 16 * MiB;
constexpr size_t WS_WGLU_T = 18 * MiB;
constexpr size_t WS_WRS_T = 19 * MiB;
constexpr size_t WS_SSMPW = 20 * MiB + 512 * 1024;
constexpr size_t WS_WDS_T = 21 * MiB;
constexpr size_t WS_SSM_BA = 22 * MiB;
constexpr size_t WS_SSM_BC = 26 * MiB;
constexpr size_t WS_DS = 496 * MiB;
constexpr size_t WS_WGU = 32 * MiB;
constexpr size_t WS_WD = 832 * MiB;
constexpr size_t WS_YS = 32 * MiB;
constexpr size_t WS_YA = 32 * MiB;
constexpr size_t WS_H = 288 * MiB;
constexpr size_t WS_H8 = 352 * MiB;
constexpr size_t WS_QK = 352 * MiB;
constexpr size_t WS_Y = 288 * MiB;
constexpr size_t WS_V = 416 * MiB;
constexpr size_t WS_AP = 448 * MiB;
constexpr size_t WS_ACTE = 672 * MiB;
constexpr size_t WS_MIXIN = 544 * MiB;
constexpr size_t WS_LOGITS = 608 * MiB;
constexpr size_t WS_ACTS = 640 * MiB;
constexpr size_t WS_YSH = 960 * MiB;
constexpr size_t WS_ATTO = 832 * MiB;
constexpr size_t WS_NEED = 1024 * MiB;

__device__ __forceinline__ float bf2f(bf16_t v) { return __uint_as_float((unsigned)v << 16); }
__device__ __forceinline__ bf16_t f2bf(float f) { unsigned u = __float_as_uint(f); return (bf16_t)((u + 0x7fffu + ((u >> 16) & 1u)) >> 16); }
__device__ __forceinline__ unsigned pk2(float lo, float hi) { return (unsigned)f2bf(lo) | ((unsigned)f2bf(hi) << 16); }
__device__ __forceinline__ float wave_sum(float v) {
#pragma unroll
    for (int o = 1; o < 64; o <<= 1) v += __shfl_xor(v, o);
    return v;
}
__device__ __forceinline__ float clamp448(float v) { return __builtin_amdgcn_fmed3f(v, -448.f, 448.f); }
__device__ __forceinline__ unsigned pk4_fp8(float a, float b, float c2, float d) { int w = __builtin_amdgcn_cvt_pk_fp8_f32(clamp448(a), clamp448(b), 0, false); w = __builtin_amdgcn_cvt_pk_fp8_f32(clamp448(c2), clamp448(d), w, true); return (unsigned)w; }
__device__ __forceinline__ float siluf(float v) { return v / (1.f + __expf(-v)); }
__device__ __forceinline__ float sigmoidf(float v) { return 1.f / (1.f + __expf(-v)); }
__device__ __forceinline__ float gelu_tanh(float v) { const float u2 = 1.5957691216057308f * (v + 0.044715f * v * v * v); return v / (1.f + __expf(-u2)); }

constexpr int NTHREADS_ = 512;
struct Params {
    const float* in[33];
    float* out;
    unsigned char* ws;
    int pad0, pad1;
};

struct Ctx {
    int tid, lane, wave, bid, nb;
    int gtid, gthreads, gwave, gwaves;
    unsigned char* ws;
    float* lds;
};

enum { I_X = 0, I_C, I_N1G, I_N2G, I_WADA, I_BADA, I_WIN, I_QNG, I_KNG, I_LQ1, I_LK1, I_LQ2, I_LK2, I_SUBG,
       I_ARE, I_AIM, I_LOGDT, I_BRE, I_BIM, I_CRE, I_CIM, I_SD, I_WGLU, I_SNG, I_WOUT, I_WR, I_RB,
       I_WGE, I_WUE, I_WDE, I_WGS, I_WUS, I_WDS };

struct SG_Args {
    const bf16_t* A; int lda; const int* rowidx;
    const float* W; const float* W2; int ldb;
    size_t wstride;
    const int* tile_e;
    int M, N, K;
};
template <bool DUAL, class Epi>
__device__ __forceinline__ void sgemm_phase(const Ctx& c, const SG_Args g, const Epi& E) {
    float* As = c.lds;
    float* Bs = c.lds + 16 * 132;
    float* Bs2 = Bs + 16 * 128;
    const int tid = c.tid, ty = tid >> 5, tx = tid & 31;
    const int nMt = g.M / 128, nNt = g.N / 128, ntile = nMt * nNt;
    for (int tile = c.bid; tile < ntile; tile += c.nb) {
        const int mt = tile / nNt, nt = tile % nNt;
        const float* W = g.W; const float* W2 = g.W2;
        if (g.tile_e) { const int e = g.tile_e[mt >> 1]; if (e < 0) continue; W += (size_t)e * g.wstride; if (DUAL) W2 += (size_t)e * g.wstride; }
        f32x4 acc[8], acc2[8];
#pragma unroll
        for (int i = 0; i < 8; ++i) { acc[i] = (f32x4){0.f, 0.f, 0.f, 0.f}; acc2[i] = (f32x4){0.f, 0.f, 0.f, 0.f}; }
        const int arow = mt * 128 + (tid >> 2), akq = (tid & 3) * 4;
        const int asrc = g.rowidx ? g.rowidx[arow] : arow;
        const bf16_t* ap = g.A + (size_t)asrc * g.lda + akq;
        const int bk = tid >> 5, bn = (tid & 31) * 4;
        const float* bp = W + (size_t)bk * g.ldb + nt * 128 + bn;
        const float* bp2 = DUAL ? (W2 + (size_t)bk * g.ldb + nt * 128 + bn) : nullptr;
#pragma unroll 1
        for (int k0 = 0; k0 < g.K; k0 += 16) {
            const u32x2 av = *(const u32x2*)(ap + k0);
            const f32x4 bv = *(const f32x4*)(bp + (size_t)k0 * g.ldb);
            f32x4 bv2 = {0.f, 0.f, 0.f, 0.f};
            if (DUAL) bv2 = *(const f32x4*)(bp2 + (size_t)k0 * g.ldb);
            __syncthreads();
            As[(akq + 0) * 132 + (tid >> 2)] = __uint_as_float(av.x << 16);
            As[(akq + 1) * 132 + (tid >> 2)] = __uint_as_float(av.x & 0xffff0000u);
            As[(akq + 2) * 132 + (tid >> 2)] = __uint_as_float(av.y << 16);
            As[(akq + 3) * 132 + (tid >> 2)] = __uint_as_float(av.y & 0xffff0000u);
            *(f32x4*)(Bs + bk * 128 + bn) = bv;
            if (DUAL) *(f32x4*)(Bs2 + bk * 128 + bn) = bv2;
            __syncthreads();
#pragma unroll
            for (int kk = 0; kk < 16; ++kk) {
                const f32x4 a0 = *(const f32x4*)(As + kk * 132 + ty * 8), a1 = *(const f32x4*)(As + kk * 132 + ty * 8 + 4);
                const f32x4 b = *(const f32x4*)(Bs + kk * 128 + tx * 4);
                const float a[8] = {a0.x, a0.y, a0.z, a0.w, a1.x, a1.y, a1.z, a1.w};
#pragma unroll
                for (int i = 0; i < 8; ++i) acc[i] += a[i] * b;
                if (DUAL) {
                    const f32x4 b2 = *(const f32x4*)(Bs2 + kk * 128 + tx * 4);
#pragma unroll
                    for (int i = 0; i < 8; ++i) acc2[i] += a[i] * b2;
                }
            }
        }
#pragma unroll
        for (int i = 0; i < 8; ++i) E(mt * 128 + ty * 8 + i, nt * 128 + tx * 4, acc[i], acc2[i], tx);
    }
}

__device__ __forceinline__ void ph_prologue(const Ctx& c, const Params& p) {
    float* mod = (float*)(c.ws + WS_MOD);
    for (int idx = c.gtid; idx < NB * 6 * DM; idx += c.gthreads) {
        const int b = idx / (6 * DM), j = idx % (6 * DM);
        const float* cc = p.in[I_C] + b * DM; const float* w = p.in[I_WADA] + j;
        float acc = p.in[I_BADA][j];
#pragma unroll 8
        for (int k = 0; k < DM; ++k) acc += siluf(cc[k]) * w[(size_t)k * (6 * DM)];
        mod[idx] = acc;
    }
    float* ropec = (float*)(c.ws + WS_ROPE); float* ropes = ropec + SEQ * 32;
    for (int idx = c.gtid; idx < SEQ * 32; idx += c.gthreads) {
        const int l = idx >> 5, i = idx & 31;
        const double invf = exp(-log(10000.0) * (double)(2 * i) / 64.0);
        const double ang = (double)l * invf;
        ropec[idx] = (float)cos(ang); ropes[idx] = (float)sin(ang);
    }
    float* sp = (float*)(c.ws + WS_SSMP);
    float* abr = sp, * abi = sp + SG * SP, * bbr = sp + 2 * SG * SP, * bbi = bbr + SG * SP * SC;
    for (int idx = c.gtid; idx < SG * SP; idx += c.gthreads) {
        const int g = idx / SP;
        const double are = p.in[I_ARE][idx], aim = p.in[I_AIM][idx], dt = exp((double)p.in[I_LOGDT][g]);
        const double mag = exp(are * dt), ar = mag * cos(aim * dt), ai = mag * sin(aim * dt);
        abr[idx] = (float)ar; abi[idx] = (float)ai;
        const double den = are * are + aim * aim, nr = ar - 1.0;
        const double fre = (nr * are + ai * aim) / den, fim = (ai * are - nr * aim) / den;
        for (int ch = 0; ch < SC; ++ch) {
            const double br = p.in[I_BRE][idx * SC + ch], bi = p.in[I_BIM][idx * SC + ch];
            bbr[idx * SC + ch] = (float)(fre * br - fim * bi); bbi[idx * SC + ch] = (float)(fre * bi + fim * br);
        }
    }
    if (c.gtid == 0) {
        float s1 = 0.f, s2 = 0.f, gq = 0.f, gk = 0.f;
        for (int i = 0; i < HD; ++i) { s1 += p.in[I_LQ1][i] * p.in[I_LK1][i]; s2 += p.in[I_LQ2][i] * p.in[I_LK2][i];
            gq = fmaxf(gq, fabsf(p.in[I_QNG][i])); gk = fmaxf(gk, fabsf(p.in[I_KNG][i])); }
        float* lam = (float*)(c.ws + WS_LAM);
        lam[0] = __expf(s1) - __expf(s2) + LAM_INIT;
        lam[1] = 0.125f * 64.f * gq * gk;
    }
    int* stok = (int*)(c.ws + WS_SLOT_TOK); int* sasg = (int*)(c.ws + WS_SLOT_ASG); float* sgate = (float*)(c.ws + WS_SLOT_GATE);
    for (int idx = c.gtid; idx < NS_MAX; idx += c.gthreads) { stok[idx] = 0; sasg[idx] = -1; sgate[idx] = 0.f; }
    int* te = (int*)(c.ws + WS_TILE_E);
    for (int idx = c.gtid; idx < NS_MAX / 256; idx += c.gthreads) te[idx] = -1;
}

__device__ __forceinline__ void ph_h1(const Ctx& c, const Params& p) {
    const float* mod = (const float*)(c.ws + WS_MOD); bf16_t* H = (bf16_t*)(c.ws + WS_H);
    constexpr int R = 4;
    for (int t0 = c.gwave * R; t0 < T; t0 += c.gwaves * R) {
        const int b = t0 / SEQ;
        f32x4 v[R][4]; float sq[R];
#pragma unroll
        for (int j = 0; j < R; ++j) { const f32x4* xr = (const f32x4*)(p.in[I_X] + (size_t)(t0 + j) * DM) + c.lane;
#pragma unroll
            for (int q = 0; q < 4; ++q) v[j][q] = xr[64 * q]; }
        const float* sh = mod + b * 6 * DM, * sc = sh + DM;
        f32x4 ca[4], cb[4];
#pragma unroll
        for (int q = 0; q < 4; ++q) { const int col = 4 * c.lane + 256 * q; ca[q] = *(const f32x4*)(p.in[I_N1G] + col) * (1.f + *(const f32x4*)(sc + col)); cb[q] = *(const f32x4*)(sh + col); }
#pragma unroll
        for (int j = 0; j < R; ++j) { float s_ = 0.f;
#pragma unroll
            for (int q = 0; q < 4; ++q) s_ += v[j][q].x * v[j][q].x + v[j][q].y * v[j][q].y + v[j][q].z * v[j][q].z + v[j][q].w * v[j][q].w;
            sq[j] = s_; }
#pragma unroll
        for (int o = 1; o < 64; o <<= 1) {
#pragma unroll
            for (int j = 0; j < R; ++j) sq[j] += __shfl_xor(sq[j], o); }
#pragma unroll
        for (int j = 0; j < R; ++j) { const float rstd = rsqrtf(sq[j] * (1.f / DM) + EPS);
#pragma unroll
            for (int q = 0; q < 4; ++q) { const int col = 4 * c.lane + 256 * q; const f32x4 o = (v[j][q] * rstd) * ca[q] + cb[q];
                u32x2 w; w.x = pk2(o.x, o.y); w.y = pk2(o.z, o.w); *(u32x2*)(H + (size_t)(t0 + j) * DM + col) = w; } }
    }
}

struct EpiWin {
    bf16_t* QK; bf16_t* V; bf16_t* AP;
    __device__ __forceinline__ void operator()(int row, int col, const f32x4& a, const f32x4&, int) const {
        u32x2 w; w.x = pk2(a[0], a[1]); w.y = pk2(a[2], a[3]);
        if (col < 1024) *(u32x2*)(QK + (size_t)row * 1024 + col) = w;
        else if (col < 1536) *(u32x2*)(V + (size_t)row * 512 + (col - 1024)) = w;
        else { const int cc = col - 1536, g = cc >> 4, ch = cc & 15, b = row / SEQ, l = row % SEQ;
            *(u32x2*)(AP + ((size_t)(g * (NB * NCHUNK) + b * NCHUNK + (l >> 4)) * APK + (l & 15) * 16 + ch)) = w; }
    }
};

__device__ __forceinline__ void ph_qkn(const Ctx& c, const Params& p) {
    bf16_t* QK = (bf16_t*)(c.ws + WS_QK);
    const float* ropec = (const float*)(c.ws + WS_ROPE); const float* ropes = ropec + SEQ * 32;
    const int l = c.lane;
    const float gq = p.in[I_QNG][l], gk = p.in[I_KNG][l];
    for (int t = c.gwave; t < T; t += c.gwaves) {
        const int pos = t % SEQ; const float cs = ropec[pos * 32 + (l & 31)], sn = ropes[pos * 32 + (l & 31)];
        bf16_t* r = QK + (size_t)t * 1024;
#pragma unroll 4
        for (int gi = 0; gi < 16; ++gi) {
            const float v = bf2f(r[gi * 64 + l]);
            const float rstd = rsqrtf(wave_sum(v * v) * (1.f / 64.f) + EPS);
            const float y = v * rstd * (gi < 8 ? gq : gk);
            const float o = __shfl_xor(y, 32);
            const float res = (l < 32) ? (y * cs - o * sn) : (o * sn + y * cs);
            r[gi * 64 + l] = f2bf(res);
        }
    }
}

__device__ __forceinline__ void ph_att_base(const Ctx& c, const Params& p) {
    const bf16_t* QK = (const bf16_t*)(c.ws + WS_QK); const bf16_t* V = (const bf16_t*)(c.ws + WS_V); float* AO = (float*)(c.ws + WS_ATTO);
    const float smax = ((const float*)(c.ws + WS_LAM))[1];
    const int nitem = NB * NH * 4 * (SEQ / 64);
    for (int it = c.gwave; it < nitem; it += c.gwaves) {
        const int qb = (SEQ / 64 - 1) - (it / (NB * NH * 4)), bhc = it % (NB * NH * 4), b = bhc / (NH * 4), h = (bhc >> 2) % NH, cc = (bhc >> 1) & 1, vh = bhc & 1;
        const int q = qb * 64 + c.lane; const size_t trow = (size_t)b * SEQ + q;
        float qv[64];
        { const bf16_t* qp = QK + trow * 1024 + h * 128 + cc * 64;
#pragma unroll
          for (int d = 0; d < 64; ++d) qv[d] = bf2f(qp[d]) * 0.125f; }
        float o[64];
#pragma unroll
        for (int d = 0; d < 64; ++d) o[d] = 0.f;
        float lsum = 0.f;
        const int jmax = qb * 64 + 63;
        for (int j = 0; j <= jmax; ++j) {
            const size_t krow = (size_t)b * SEQ + j;
            const u32x4* kp = (const u32x4*)(QK + krow * 1024 + 512 + h * 128 + cc * 64);
            float s = 0.f;
#pragma unroll
            for (int i = 0; i < 8; ++i) { const u32x4 kk = kp[i];
                s += qv[8 * i + 0] * __uint_as_float(kk.x << 16) + qv[8 * i + 1] * __uint_as_float(kk.x & 0xffff0000u)
                   + qv[8 * i + 2] * __uint_as_float(kk.y << 16) + qv[8 * i + 3] * __uint_as_float(kk.y & 0xffff0000u)
                   + qv[8 * i + 4] * __uint_as_float(kk.z << 16) + qv[8 * i + 5] * __uint_as_float(kk.z & 0xffff0000u)
                   + qv[8 * i + 6] * __uint_as_float(kk.w << 16) + qv[8 * i + 7] * __uint_as_float(kk.w & 0xffff0000u); }
            float pe = (j <= q) ? __expf(s - smax) : 0.f;
            lsum += pe;
            const u32x4* vp = (const u32x4*)(V + krow * 512 + h * 128 + vh * 64);
#pragma unroll
            for (int i = 0; i < 8; ++i) { const u32x4 vv = vp[i];
                o[8 * i + 0] += pe * __uint_as_float(vv.x << 16); o[8 * i + 1] += pe * __uint_as_float(vv.x & 0xffff0000u);
                o[8 * i + 2] += pe * __uint_as_float(vv.y << 16); o[8 * i + 3] += pe * __uint_as_float(vv.y & 0xffff0000u);
                o[8 * i + 4] += pe * __uint_as_float(vv.z << 16); o[8 * i + 5] += pe * __uint_as_float(vv.z & 0xffff0000u);
                o[8 * i + 6] += pe * __uint_as_float(vv.w << 16); o[8 * i + 7] += pe * __uint_as_float(vv.w & 0xffff0000u); }
        }
        const float rl = 1.f / lsum;
        float* op = AO + (trow * 8 + h * 2 + cc) * 128 + vh * 64;
#pragma unroll
        for (int d = 0; d < 64; d += 4) *(f32x4*)(op + d) = (f32x4){o[d] * rl, o[d + 1] * rl, o[d + 2] * rl, o[d + 3] * rl};
    }
}
__device__ __forceinline__ void ph_att_comb(const Ctx& c, const Params& p) {
    const float* AO = (const float*)(c.ws + WS_ATTO); bf16_t* MX = (bf16_t*)(c.ws + WS_MIXIN);
    const float lam = ((const float*)(c.ws + WS_LAM))[0];
    for (int it = c.gwave; it < T * NH; it += c.gwaves) {
        const int t = it >> 2, h = it & 3;
        const float* o1 = AO + ((size_t)t * 8 + h * 2) * 128, * o2 = o1 + 128;
        const float a = o1[c.lane] - lam * o2[c.lane], b = o1[64 + c.lane] - lam * o2[64 + c.lane];
        const float rstd = rsqrtf(wave_sum(a * a + b * b) * (1.f / 128.f) + EPS) * (1.f - LAM_INIT);
        MX[(size_t)t * 1024 + h * 128 + c.lane] = f2bf(a * rstd * p.in[I_SUBG][c.lane]);
        MX[(size_t)t * 1024 + h * 128 + 64 + c.lane] = f2bf(b * rstd * p.in[I_SUBG][64 + c.lane]);
    }
}

__device__ __forceinline__ void ph_ssm_base(const Ctx& c, const Params& p) {
    const bf16_t* AP = (const bf16_t*)(c.ws + WS_AP); bf16_t* Y = (bf16_t*)(c.ws + WS_Y);
    const float* sp = (const float*)(c.ws + WS_SSMP);
    const float* abr = sp, * abi = sp + SG * SP, * bbr = sp + 2 * SG * SP, * bbi = bbr + SG * SP * SC;
    for (int it = c.gwave; it < NB * SG; it += c.gwaves) {
        const int b = it / SG, g = it % SG, pp = c.lane;
        const float ar = abr[g * SP + pp], ai = abi[g * SP + pp];
        float br[16], bi[16], cr[16], ci[16];
#pragma unroll
        for (int ch = 0; ch < 16; ++ch) { br[ch] = bbr[(g * SP + pp) * SC + ch]; bi[ch] = bbi[(g * SP + pp) * SC + ch];
            cr[ch] = p.in[I_CRE][(g * SC + ch) * SP + pp]; ci[ch] = p.in[I_CIM][(g * SC + ch) * SP + pp]; }
        const float dsk = (pp < 16) ? p.in[I_SD][g * SC + pp] : 0.f;
        float sr = 0.f, si = 0.f;
        for (int l = 0; l < SEQ; ++l) {
            const bf16_t* up = AP + ((size_t)(g * (NB * NCHUNK) + b * NCHUNK + (l >> 4)) * APK + (l & 15) * 16);
            const u32x4 u0 = *(const u32x4*)up, u1 = *(const u32x4*)(up + 8);
            float u[16] = { __uint_as_float(u0.x << 16), __uint_as_float(u0.x & 0xffff0000u), __uint_as_float(u0.y << 16), __uint_as_float(u0.y & 0xffff0000u),
                            __uint_as_float(u0.z << 16), __uint_as_float(u0.z & 0xffff0000u), __uint_as_float(u0.w << 16), __uint_as_float(u0.w & 0xffff0000u),
                            __uint_as_float(u1.x << 16), __uint_as_float(u1.x & 0xffff0000u), __uint_as_float(u1.y << 16), __uint_as_float(u1.y & 0xffff0000u),
                            __uint_as_float(u1.z << 16), __uint_as_float(u1.z & 0xffff0000u), __uint_as_float(u1.w << 16), __uint_as_float(u1.w & 0xffff0000u) };
            float bur = 0.f, bui = 0.f;
#pragma unroll
            for (int ch = 0; ch < 16; ++ch) { bur += u[ch] * br[ch]; bui += u[ch] * bi[ch]; }
            const float nr = ar * sr - ai * si + bur, ni = ar * si + ai * sr + bui; sr = nr; si = ni;
            float mine = 0.f;
#pragma unroll
            for (int ch = 0; ch < 16; ++ch) { const float v = wave_sum(sr * cr[ch] - si * ci[ch]); if (pp == ch) mine = v + dsk * u[ch]; }
            if (pp < 16) Y[((size_t)b * SEQ + l) * 512 + g * 16 + pp] = f2bf(gelu_tanh(mine));
        }
    }
}

struct EpiGlu {
    const bf16_t* Y; bf16_t* MX; float* ss;
    __device__ __forceinline__ void operator()(int row, int col, const f32x4& a, const f32x4&, int) const {
        const u32x2 yv = *(const u32x2*)(Y + (size_t)row * 512 + col);
        const float y0 = __uint_as_float(yv.x << 16), y1 = __uint_as_float(yv.x & 0xffff0000u), y2 = __uint_as_float(yv.y << 16), y3 = __uint_as_float(yv.y & 0xffff0000u);
        const float v0 = y0 * sigmoidf(a[0]), v1 = y1 * sigmoidf(a[1]), v2 = y2 * sigmoidf(a[2]), v3 = y3 * sigmoidf(a[3]);
        u32x2 w; w.x = pk2(v0, v1); w.y = pk2(v2, v3); *(u32x2*)(MX + (size_t)row * 1024 + 512 + col) = w;
        float s = v0 * v0 + v1 * v1 + v2 * v2 + v3 * v3;
#pragma unroll
        for (int o = 1; o < 32; o <<= 1) s += __shfl_xor(s, o);
        if ((threadIdx.x & 31) == 0) atomicAdd(ss + row, s);
    }
};
__device__ __forceinline__ void ph_ssm_norm(const Ctx& c, const Params& p) {
    bf16_t* MX = (bf16_t*)(c.ws + WS_MIXIN); const float* ss = (const float*)(c.ws + WS_CTL + CTL_SS1);
    for (int t = c.gwave; t < T; t += c.gwaves) {
        const float rstd = rsqrtf(ss[t] * (1.f / 512.f) + EPS);
        bf16_t* r = MX + (size_t)t * 1024 + 512 + c.lane * 8; const float* g = p.in[I_SNG] + c.lane * 8;
        u32x4 w = *(u32x4*)r; unsigned* wp = (unsigned*)&w;
#pragma unroll
        for (int i = 0; i < 4; ++i) { const float a = __uint_as_float(wp[i] << 16) * rstd * g[2 * i], b = __uint_as_float(wp[i] & 0xffff0000u) * rstd * g[2 * i + 1]; wp[i] = pk2(a, b); }
        *(u32x4*)r = w;
    }
}
__device__ __forceinline__ void ph_ssm_norm2(const Ctx& c, const Params& p) {
    bf16_t* MX = (bf16_t*)(c.ws + WS_MIXIN); const float* ss = (const float*)(c.ws + WS_SS1P);
    constexpr int R = 8;
    float g[8];
#pragma unroll
    for (int i = 0; i < 8; ++i) g[i] = p.in[I_SNG][c.lane * 8 + i];
    for (int t0 = c.gwave * R; t0 < T; t0 += c.gwaves * R) {
        u32x4 w[R]; f32x4 s0[R], s1[R];
#pragma unroll
        for (int j = 0; j < R; ++j) { const size_t t = (size_t)(t0 + j); w[j] = *(const u32x4*)(MX + t * 1024 + 512 + c.lane * 8); s0[j] = *(const f32x4*)(ss + t * 8); s1[j] = *(const f32x4*)(ss + t * 8 + 4); }
#pragma unroll
        for (int j = 0; j < R; ++j) {
            const float tot = ((s0[j].x + s0[j].y) + (s0[j].z + s0[j].w)) + ((s1[j].x + s1[j].y) + (s1[j].z + s1[j].w));
            const float rstd = rsqrtf(tot * (1.f / 512.f) + EPS);
            unsigned* wp = (unsigned*)&w[j];
#pragma unroll
            for (int i = 0; i < 4; ++i) { const float a = __uint_as_float(wp[i] << 16) * rstd * g[2 * i], b = __uint_as_float(wp[i] & 0xffff0000u) * rstd * g[2 * i + 1]; wp[i] = pk2(a, b); }
            *(u32x4*)(MX + (size_t)(t0 + j) * 1024 + 512 + c.lane * 8) = w[j];
        }
    }
}
struct EpiWout {
    const float* x; const float* mod; float* out; float* ss;
    __device__ __forceinline__ void operator()(int row, int col, const f32x4& a, const f32x4&, int) const {
        const int b = row / SEQ; const f32x4 xv = *(const f32x4*)(x + (size_t)row * DM + col), g1 = *(const f32x4*)(mod + b * 6 * DM + 2 * DM + col);
        const f32x4 o = {xv.x + g1.x * a[0], xv.y + g1.y * a[1], xv.z + g1.z * a[2], xv.w + g1.w * a[3]};
        *(f32x4*)(out + (size_t)row * DM + col) = o;
        float s = o.x * o.x + o.y * o.y + o.z * o.z + o.w * o.w;
#pragma unroll
        for (int of = 1; of < 32; of <<= 1) s += __shfl_xor(s, of);
        if ((threadIdx.x & 31) == 0) atomicAdd(ss + row, s);
    }
};
__device__ __forceinline__ void ph_h2(const Ctx& c, const Params& p) {
    const float* mod = (const float*)(c.ws + WS_MOD); bf16_t* H = (bf16_t*)(c.ws + WS_H);
    const float* ss = (const float*)(c.ws + WS_CTL + CTL_SS2);
    for (int t = c.gwave; t < T; t += c.gwaves) {
        const int b = t / SEQ; const f32x4* xr = (const f32x4*)(p.out + (size_t)t * DM) + c.lane;
        const float rstd = rsqrtf(ss[t] * (1.f / DM) + EPS);
        const float* sh = mod + b * 6 * DM + 3 * DM, * sc = sh + DM;
#pragma unroll
        for (int j = 0; j < 4; ++j) { const int col = 4 * c.lane + 256 * j; const f32x4 v = xr[64 * j];
            const f32x4 g = *(const f32x4*)(p.in[I_N2G] + col), s1 = *(const f32x4*)(sc + col), h1 = *(const f32x4*)(sh + col);
            const f32x4 o = (v * rstd * g) * (1.f + s1) + h1;
            u32x2 w; w.x = pk2(o.x, o.y); w.y = pk2(o.z, o.w); *(u32x2*)(H + (size_t)t * DM + col) = w; }
    }
}
__device__ __forceinline__ void ph_h2_2(const Ctx& c, const Params& p) {
    const float* mod = (const float*)(c.ws + WS_MOD); bf16_t* H = (bf16_t*)(c.ws + WS_H);
    const float* ss = (const float*)(c.ws + WS_SS2P);
    constexpr int R = 4;
    for (int t0 = c.gwave * R; t0 < T; t0 += c.gwaves * R) {
        const int b = t0 / SEQ;
        f32x4 v[R][4], sv[R][4];
#pragma unroll
        for (int j = 0; j < R; ++j) { const f32x4* xr = (const f32x4*)(p.out + (size_t)(t0 + j) * DM) + c.lane;
#pragma unroll
            for (int q = 0; q < 4; ++q) { v[j][q] = xr[64 * q]; sv[j][q] = *(const f32x4*)(ss + (size_t)(t0 + j) * 16 + 4 * q); } }
        const float* sh = mod + b * 6 * DM + 3 * DM, * sc = sh + DM;
        f32x4 ca[4], cb[4];
#pragma unroll
        for (int q = 0; q < 4; ++q) { const int col = 4 * c.lane + 256 * q; ca[q] = *(const f32x4*)(p.in[I_N2G] + col) * (1.f + *(const f32x4*)(sc + col)); cb[q] = *(const f32x4*)(sh + col); }
#pragma unroll
        for (int j = 0; j < R; ++j) {
            float tot = 0.f;
#pragma unroll
            for (int q = 0; q < 4; ++q) tot += (sv[j][q].x + sv[j][q].y) + (sv[j][q].z + sv[j][q].w);
            const float rstd = rsqrtf(tot * (1.f / DM) + EPS);
#pragma unroll
            for (int q = 0; q < 4; ++q) { const int col = 4 * c.lane + 256 * q; const f32x4 o = (v[j][q] * rstd) * ca[q] + cb[q];
                u32x2 w; w.x = pk2(o.x, o.y); w.y = pk2(o.z, o.w); *(u32x2*)(H + (size_t)(t0 + j) * DM + col) = w; }
        }
    }
}
__device__ __forceinline__ void ph_h2_3(const Ctx& c, const Params& p) {
    const float* mod = (const float*)(c.ws + WS_MOD); bf16_t* H = (bf16_t*)(c.ws + WS_H); unsigned char* H8 = c.ws + WS_H8;
    const float* ss = (const float*)(c.ws + WS_SS2P);
    constexpr int R = 4;
    for (int t0 = c.gwave * R; t0 < T; t0 += c.gwaves * R) {
        const int b = t0 / SEQ;
        f32x4 v[R][4], sv[R][4];
#pragma unroll
        for (int j = 0; j < R; ++j) { const f32x4* xr = (const f32x4*)(p.out + (size_t)(t0 + j) * DM) + c.lane;
#pragma unroll
            for (int q = 0; q < 4; ++q) { v[j][q] = xr[64 * q]; sv[j][q] = *(const f32x4*)(ss + (size_t)(t0 + j) * 16 + 4 * q); } }
        const float* sh = mod + b * 6 * DM + 3 * DM, * sc = sh + DM;
        f32x4 ca[4], cb[4];
#pragma unroll
        for (int q = 0; q < 4; ++q) { const int col = 4 * c.lane + 256 * q; ca[q] = *(const f32x4*)(p.in[I_N2G] + col) * (1.f + *(const f32x4*)(sc + col)); cb[q] = *(const f32x4*)(sh + col); }
#pragma unroll
        for (int j = 0; j < R; ++j) {
            float tot = 0.f;
#pragma unroll
            for (int q = 0; q < 4; ++q) tot += (sv[j][q].x + sv[j][q].y) + (sv[j][q].z + sv[j][q].w);
            const float rstd = rsqrtf(tot * (1.f / DM) + EPS);
#pragma unroll
            for (int q = 0; q < 4; ++q) { const int col = 4 * c.lane + 256 * q; const f32x4 o = (v[j][q] * rstd) * ca[q] + cb[q];
                u32x2 w; w.x = pk2(o.x, o.y); w.y = pk2(o.z, o.w); *(u32x2*)(H + (size_t)(t0 + j) * DM + col) = w;
                *(unsigned*)(H8 + (size_t)(t0 + j) * DM + col) = pk4_fp8(o.x, o.y, o.z, o.w); }
        }
    }
}
struct EpiLogits { float* L; __device__ __forceinline__ void operator()(int row, int col, const f32x4& a, const f32x4&, int) const { *(f32x4*)(L + (size_t)row * 256 + col) = (f32x4){a[0], a[1], a[2], a[3]}; } };
struct EpiSwiglu { bf16_t* O; int ldo;
    __device__ __forceinline__ void operator()(int row, int col, const f32x4& a, const f32x4& b, int) const {
        u32x2 w; w.x = pk2(siluf(a[0]) * b[0], siluf(a[1]) * b[1]); w.y = pk2(siluf(a[2]) * b[2], siluf(a[3]) * b[3]); *(u32x2*)(O + (size_t)row * ldo + col) = w; } };

__device__ __forceinline__ void ph_route(const Ctx& c, const Params& p) {
    const float* L = (const float*)(c.ws + WS_LOGITS);
    int* eidx = (int*)(c.ws + WS_EIDX); float* gw = (float*)(c.ws + WS_GATEW); unsigned* counts = (unsigned*)(c.ws + WS_CTL) + CW_COUNTS;
    const int l = c.lane; const float NEG = -__builtin_inff();
    float rb[4];
#pragma unroll
    for (int r = 0; r < 4; ++r) rb[r] = p.in[I_RB][l + 64 * r];
    for (int t = c.gwave; t < T; t += c.gwaves) {
        float s[4], sb[4];
#pragma unroll
        for (int r = 0; r < 4; ++r) { s[r] = sigmoidf(L[(size_t)t * 256 + l + 64 * r]); sb[r] = s[r] + rb[r]; }
        float gs[4];
#pragma unroll
        for (int r = 0; r < 4; ++r) {
            float m1 = sb[r]; int i1 = l;
#pragma unroll
            for (int o = 1; o < 32; o <<= 1) { const float om = __shfl_xor(m1, o); const int oi = __shfl_xor(i1, o); if (om > m1 || (om == m1 && oi < i1)) { m1 = om; i1 = oi; } }
            float m2 = (l == i1) ? NEG : sb[r];
#pragma unroll
            for (int o = 1; o < 32; o <<= 1) m2 = fmaxf(m2, __shfl_xor(m2, o));
            gs[r] = m1 + m2;
        }
        float gsc[8];
#pragma unroll
        for (int r = 0; r < 4; ++r) { gsc[2 * r] = __shfl(gs[r], 0); gsc[2 * r + 1] = __shfl(gs[r], 32); }
        unsigned gmask = 0;
#pragma unroll
        for (int a = 0; a < 8; ++a) { int rank = 0;
#pragma unroll
            for (int b2 = 0; b2 < 8; ++b2) rank += (gsc[b2] > gsc[a] || (gsc[b2] == gsc[a] && b2 < a)) ? 1 : 0;
            if (rank < TOPG) gmask |= 1u << a; }
        float mv[4];
#pragma unroll
        for (int r = 0; r < 4; ++r) mv[r] = ((gmask >> (2 * r + (l >> 5))) & 1u) ? sb[r] : NEG;
        float wsel = 0.f; int esel = -1; float wsum = 0.f;
#pragma unroll
        for (int k = 0; k < TOPK; ++k) {
            float bm = mv[0]; int bi = l;
#pragma unroll
            for (int r = 1; r < 4; ++r) if (mv[r] > bm) { bm = mv[r]; bi = l + 64 * r; }
#pragma unroll
            for (int o = 1; o < 64; o <<= 1) { const float om = __shfl_xor(bm, o); const int oi = __shfl_xor(bi, o); if (om > bm || (om == bm && oi < bi)) { bm = om; bi = oi; } }
            float sv = 0.f;
#pragma unroll
            for (int r = 0; r < 4; ++r) if (bi == l + 64 * r) { sv = s[r]; mv[r] = NEG; }
            sv = __shfl(sv, bi & 63);
            wsum += sv;
            if (l == k) { wsel = sv; esel = bi; }
        }
        if (l < TOPK) { eidx[t * 8 + l] = esel; gw[t * 8 + l] = wsel / wsum * ROUTED_SCALE; atomicAdd(counts + esel, 1u); }
    }
}
__device__ __forceinline__ void ph_slot(const Ctx& c, const Params& p) {
    const unsigned* counts = (const unsigned*)(c.ws + WS_CTL) + CW_COUNTS; unsigned* cursor = (unsigned*)(c.ws + WS_CTL) + CW_CURSOR;
    int* ps = (int*)c.lds;
    if (c.tid == 0) { int acc = 0; for (int e = 0; e < NE; ++e) { ps[e] = acc; acc += ((int)counts[e] + 255) / 256 * 256; } ps[NE] = acc; }
    __syncthreads();
    const int* eidx = (const int*)(c.ws + WS_EIDX); const float* gw = (const float*)(c.ws + WS_GATEW);
    int* stok = (int*)(c.ws + WS_SLOT_TOK); int* sasg = (int*)(c.ws + WS_SLOT_ASG); float* sgate = (float*)(c.ws + WS_SLOT_GATE);
    for (int a = c.gtid; a < T * TOPK; a += c.gthreads) {
        const int e = eidx[a]; const unsigned pos = atomicAdd(cursor + e, 1u); const int slot = ps[e] + (int)pos;
        stok[slot] = a >> 3; sasg[slot] = a; sgate[slot] = gw[a];
    }
    if (c.bid == 0) {
        int* te = (int*)(c.ws + WS_TILE_E); int* padst = (int*)(c.ws + WS_PADST);
        for (int e = c.tid; e <= NE; e += 512) padst[e] = ps[e];
        for (int e = c.tid; e < NE; e += 512) for (int tl = ps[e] / 256; tl < ps[e + 1] / 256; ++tl) te[tl] = e;
        if (c.tid == 0) ((unsigned*)(c.ws + WS_CTL))[CW_NTILES] = (unsigned)(ps[NE] / 256);
    }
}
struct EpiE2 { const int* sasg; const float* sgate; bf16_t* YA;
    __device__ __forceinline__ void operator()(int row, int col, const f32x4& a, const f32x4&, int) const {
        const int asg = sasg[row]; if (asg < 0) return; const float g = sgate[row];
        u32x2 w; w.x = pk2(g * a[0], g * a[1]); w.y = pk2(g * a[2], g * a[3]); *(u32x2*)(YA + (size_t)asg * DM + col) = w; } };
struct EpiSD { const float* mod; float* out;
    __device__ __forceinline__ void operator()(int row, int col, const f32x4& a, const f32x4&, int) const {
        const int b = row / SEQ; const f32x4 g2 = *(const f32x4*)(mod + b * 6 * DM + 5 * DM + col); f32x4* o = (f32x4*)(out + (size_t)row * DM + col);
        f32x4 v = *o; v.x += g2.x * a[0]; v.y += g2.y * a[1]; v.z += g2.z * a[2]; v.w += g2.w * a[3]; *o = v; } };
__device__ __forceinline__ void ph_combine(const Ctx& c, const Params& p) {
    const float* mod = (const float*)(c.ws + WS_MOD); const bf16_t* YA = (const bf16_t*)(c.ws + WS_YA); float* out = p.out;
    for (int idx = c.gtid; idx < T * (DM / 8); idx += c.gthreads) {
        const int t = idx >> 7, col = (idx & 127) * 8, b = t / SEQ;
        float s[8] = {0.f, 0.f, 0.f, 0.f, 0.f, 0.f, 0.f, 0.f};
#pragma unroll
        for (int k = 0; k < 8; ++k) { const u32x4 w = *(const u32x4*)(YA + ((size_t)t * 8 + k) * DM + col); const unsigned* wp = (const unsigned*)&w;
#pragma unroll
            for (int i = 0; i < 4; ++i) { s[2 * i] += __uint_as_float(wp[i] << 16); s[2 * i + 1] += __uint_as_float(wp[i] & 0xffff0000u); } }
        const float* g2 = mod + b * 6 * DM + 5 * DM + col; float* o = out + (size_t)t * DM + col;
        f32x4 o0 = *(f32x4*)o, o1 = *(f32x4*)(o + 4);
        o0.x += g2[0] * s[0]; o0.y += g2[1] * s[1]; o0.z += g2[2] * s[2]; o0.w += g2[3] * s[3];
        o1.x += g2[4] * s[4]; o1.y += g2[5] * s[5]; o1.z += g2[6] * s[6]; o1.w += g2[7] * s[7];
        *(f32x4*)o = o0; *(f32x4*)(o + 4) = o1;
    }
}


#define GAS __attribute__((address_space(1)))
#define LAS __attribute__((address_space(3)))
#define XB_TMO      128
#define XB_XCNT(j)  (256  + 64 * (j))
#define XB_XSUB(j)  (1280 + 64 * (j))
#define XB_XGEN(j)  (2304 + 64 * (j))
#define XB_TOP      3328
#define XB_TOPGEN   3392
#define XCD_BAR_WORDS 3456
#define XB_SPIN_CAP (1u << 18)

__device__ __forceinline__ unsigned xb_ld(unsigned* p)              { return __hip_atomic_load(p, __ATOMIC_RELAXED, __HIP_MEMORY_SCOPE_AGENT); }
__device__ __forceinline__ unsigned xb_add(unsigned* p, unsigned v) { return __hip_atomic_fetch_add(p, v, __ATOMIC_RELAXED, __HIP_MEMORY_SCOPE_AGENT); }
__device__ __forceinline__ unsigned xb_xcc_id() { return (unsigned)__builtin_amdgcn_s_getreg((3 << 11) | 20) & 0xFu; }
#define XB_SPIN(cond, bar) do { unsigned _sp = 0; while (cond) { __builtin_amdgcn_s_sleep(1); \
    if ((++_sp & 255u) == 0u) { if (xb_ld(&(bar)[XB_TMO])) break; if (_sp > XB_SPIN_CAP) { atomicAdd(&(bar)[XB_TMO], 1u); break; } } } } while (0)

struct XcdBarrier {
    unsigned* bar; unsigned x;
    volatile LAS unsigned* st;
};

__device__ __forceinline__ XcdBarrier xcd_barrier_post(unsigned* bar, volatile LAS unsigned* st) {
    XcdBarrier b; b.bar = bar; b.x = xb_xcc_id(); b.st = st;
    if (threadIdx.x == 0) (void)xb_add(&bar[XB_XCNT(b.x)], 1u);
    return b;
}
__device__ __forceinline__ void xcd_barrier_complete(unsigned* bar, unsigned x, unsigned& nloc, unsigned& nx) {
    const unsigned G = gridDim.x * gridDim.y * gridDim.z;
    unsigned sum, cnt, mine, sp = 0u;
    for (;;) {
        sum = 0u; cnt = 0u; mine = 0u;
#pragma unroll
        for (unsigned j = 0; j < 16; ++j) { const unsigned c = xb_ld(&bar[XB_XCNT(j)]); sum += c; cnt += (c > 0u) ? 1u : 0u; mine = (j == x) ? c : mine; }
        if (sum == G) break;
        __builtin_amdgcn_s_sleep(1);
        if ((++sp & 255u) == 0u) { if (xb_ld(&bar[XB_TMO])) break; if (sp > XB_SPIN_CAP) { atomicAdd(&bar[XB_TMO], 1u); break; } }
    }
    nloc = mine > 0u ? mine : 1u; nx = cnt > 0u ? cnt : 1u;
}

__device__ __forceinline__ void xcd_barrier(const XcdBarrier& b) {
    asm volatile("s_waitcnt vmcnt(0)" ::: "memory");
    __syncthreads();
    if (threadIdx.x == 0) {
        unsigned* bar = b.bar;
        __builtin_amdgcn_s_waitcnt(0);
        unsigned nloc = b.st[0], nx = b.st[1];
        if (nloc == 0u) { xcd_barrier_complete(bar, b.x, nloc, nx); b.st[0] = nloc; b.st[1] = nx; }
        const unsigned old = xb_add(&bar[XB_XSUB(b.x)], 1u);
        const unsigned gen = old / nloc;
        if (old + 1u == (gen + 1u) * nloc) {
            __builtin_amdgcn_fence(__ATOMIC_RELEASE, "agent");
            asm volatile("s_waitcnt vmcnt(0)" ::: "memory");
            const unsigned og = xb_add(&bar[XB_TOP], 1u);
            const unsigned tg = og / nx;
            if (og + 1u == (tg + 1u) * nx) xb_add(&bar[XB_TOPGEN], 1u);
            else XB_SPIN(xb_ld(&bar[XB_TOPGEN]) == tg, bar);
            __builtin_amdgcn_fence(__ATOMIC_ACQUIRE, "agent");
            xb_add(&bar[XB_XGEN(b.x)], 1u);
            asm volatile("s_waitcnt vmcnt(0)" ::: "memory");
        } else {
            XB_SPIN(xb_ld(&bar[XB_XGEN(b.x)]) == gen, bar);
            __builtin_amdgcn_fence(__ATOMIC_ACQUIRE, "agent");
            asm volatile("s_waitcnt vmcnt(0)" ::: "memory");
        }
    }
    __syncthreads();
}

namespace pg8 {
#define PG8_LAS __attribute__((address_space(3)))
typedef short bf16x8 __attribute__((ext_vector_type(8)));
typedef int v4i __attribute__((ext_vector_type(4)));
typedef int v8i __attribute__((ext_vector_type(8)));
constexpr int BM = 256, BK = 64, HALF = 128, HTB = HALF * BK * 2  , STAGE_BYTES = 8 * HTB;

__host__ __device__ __forceinline__ int lds_byte(int r, int c) { const int st = (r >> 4) * 2 + (c >> 5), rr = r & 15, cc = c & 31, ob = rr * 64 + cc * 2; return st * 1024 + (ob ^ (((ob >> 9) & 1) << 5)); }
__host__ __device__ __forceinline__ void stage_rc(int b, int& R, int& C) { const int st = b / 1024, sb = b % 1024, swz = sb ^ (((sb >> 9) & 1) << 5); R = (st >> 1) * 16 + swz / 64; C = (st & 1) * 32 + (swz % 64) / 2; }
__host__ __device__ __forceinline__ int perm32(int rho) { const int n = rho >> 4, i = rho & 15; return 8 * (i >> 2) + 4 * n + (i & 3); }

struct Unit { int pm, pn, pb; };
struct Gemm { const bf16_t* A; const bf16_t* Bt; int K, lda; const int* rowidx; unsigned scale_b = 0x7F7F7F7Fu, scale_a = 0x7F7F7F7Fu; };

__device__ __forceinline__ unsigned cvt_pk_bf16(float lo, float hi) { unsigned r; asm volatile("v_cvt_pk_bf16_f32 %0, %1, %2" : "=v"(r) : "v"(lo), "v"(hi)); return r; }

template <class Epi, class Sched, bool GATHER, bool ALIGN_EPI, bool FP8 = false, int FIXED_NT = 0>
__device__ __forceinline__ void gemm_phase(PG8_LAS unsigned char* lds, const Gemm g, const Sched& S, const Epi& E) {
    int tid_ = threadIdx.x; asm volatile("" : "+v"(tid_));
    const int tid = tid_, wid = __builtin_amdgcn_readfirstlane(tid >> 6), lane = tid & 63, wr = wid >> 2, wc = wid & 3, fr = lane & 15, fq = lane >> 4;
    int K_ = g.K; asm volatile("" : "+s"(K_));
    const int K = K_, nt = K / BK, lda = g.lda;
    unsigned voffB[2], oc[2][2], on[2][2];
#pragma unroll
    for (int i = 0; i < 2; ++i) { int R, C; stage_rc(tid * 16 + i * 8192, R, C); const int Rb = Epi::PERM ? ((R & ~31) + perm32(R & 31)) : R;
        voffB[i] = (unsigned)(Rb * K + C) * 2u;
        oc[0][i] = (unsigned)(R * lda + C) * 2u; oc[1][i] = (unsigned)((R + HALF) * lda + C) * 2u; on[0][i] = oc[0][i]; on[1][i] = oc[1][i]; }
    const size_t kstep = (size_t)(BK * 2);
    const size_t hstep = (size_t)HALF * K * 2;
    const size_t tstepB = 2 * hstep, tstepA = (size_t)BM * lda * 2;
    const unsigned ldsw = (unsigned)wid * 1024u;
    const int aoff = lds_byte(wr * 64 + fr, fq * 8), boff = lds_byte(wc * 32 + fr, fq * 8);
#define PG8_SA(b, h) (((b) * 2 + (h)) * HTB)
#define PG8_SB(b, h) ((4 + (b) * 2 + (h)) * HTB)
#define PG8_STAGE(bufoff, gbase, voff) do { _Pragma("unroll") for (int _i = 0; _i < 2; ++_i) \
        __builtin_amdgcn_global_load_lds((const unsigned*)((const char*)(gbase) + (voff)[_i]), (PG8_LAS unsigned*)(lds + (bufoff) + ldsw + _i * 8192), 16, 0, 0); } while (0)
#define PG8_LDA(dst, b, h) do { if constexpr (FP8) { _Pragma("unroll") for (int m = 0; m < 4; ++m) { const v4i lo_ = *(const PG8_LAS v4i*)(lds + PG8_SA(b, h) + aoff + m * 2048), hi_ = *(const PG8_LAS v4i*)(lds + PG8_SA(b, h) + aoff + m * 2048 + 1024); \
            dst##8[m] = __builtin_shufflevector(lo_, hi_, 0, 1, 2, 3, 4, 5, 6, 7); } } \
        else { _Pragma("unroll") for (int m = 0; m < 4; ++m) _Pragma("unroll") for (int k = 0; k < 2; ++k) dst[m][k] = *(const PG8_LAS bf16x8*)(lds + PG8_SA(b, h) + aoff + m * 2048 + k * 1024); } } while (0)
#define PG8_LDB(dst, b, h) do { if constexpr (FP8) { _Pragma("unroll") for (int n = 0; n < 2; ++n) { const v4i lo_ = *(const PG8_LAS v4i*)(lds + PG8_SB(b, h) + boff + n * 2048), hi_ = *(const PG8_LAS v4i*)(lds + PG8_SB(b, h) + boff + n * 2048 + 1024); \
            dst##8[n] = __builtin_shufflevector(lo_, hi_, 0, 1, 2, 3, 4, 5, 6, 7); } } \
        else { _Pragma("unroll") for (int n = 0; n < 2; ++n) _Pragma("unroll") for (int k = 0; k < 2; ++k) dst[n][k] = *(const PG8_LAS bf16x8*)(lds + PG8_SB(b, h) + boff + n * 2048 + k * 1024); } } while (0)
#define PG8_MMA(ai, bj, At, Bt) do { __builtin_amdgcn_s_setprio(1); \
        if constexpr (FP8) {   \
            _Pragma("unroll") for (int m = 0; m < 4; ++m) _Pragma("unroll") for (int n = 0; n < 2; ++n) { \
                acc[ai][bj][m][n] = __builtin_amdgcn_mfma_scale_f32_16x16x128_f8f6f4(Bt##8[n], At##8[m], acc[ai][bj][m][n], 0, 0, 0, (int)g.scale_b, 0, (int)g.scale_a); } \
        } else { \
            _Pragma("unroll") for (int m = 0; m < 4; ++m) _Pragma("unroll") for (int n = 0; n < 2; ++n) _Pragma("unroll") for (int k = 0; k < 2; ++k) \
                acc[ai][bj][m][n] = __builtin_amdgcn_mfma_f32_16x16x32_bf16(Bt[n][k], At[m][k], acc[ai][bj][m][n], 0, 0, 0); } \
        __builtin_amdgcn_s_setprio(0); } while (0)
#define PG8_WAIT_V(n) asm volatile("s_waitcnt vmcnt(" #n ")" ::: "memory")
#define PG8_WAIT_V8S() do { if (FIXED_NT == 2 || (Epi::NSTORE > 0 && fresh)) asm volatile("s_waitcnt vmcnt(%0)" :: "i"(8 + Epi::NSTORE) : "memory"); else asm volatile("s_waitcnt vmcnt(8)" ::: "memory"); } while (0)
#define PG8_WAIT_L(n) asm volatile("s_waitcnt lgkmcnt(" #n ")" ::: "memory")
#define PG8_BAR __builtin_amdgcn_s_barrier()
#define PG8_SCHED __builtin_amdgcn_sched_barrier(0)
#define PG8_GIDX(dst, unit) do { _Pragma("unroll") for (int _i = 0; _i < 2; ++_i) { int R_, C_; stage_rc(tid * 16 + _i * 8192, R_, C_); \
        const int r0_ = g.rowidx ? g.rowidx[(unit).pm * BM + R_] : (unit).pm * BM + R_, r1_ = g.rowidx ? g.rowidx[(unit).pm * BM + HALF + R_] : (unit).pm * BM + HALF + R_; \
        dst[0][_i] = (unsigned)(r0_ * lda + C_) * 2u; dst[1][_i] = (unsigned)(r1_ * lda + C_) * 2u; } } while (0)
    Unit cur, nxt; int ui = 0;
    if (!S.next(0, cur)) return;
    f32x4 acc[2][2][4][2];
#pragma unroll
    for (int a = 0; a < 2; ++a)
#pragma unroll
        for (int b = 0; b < 2; ++b)
#pragma unroll
            for (int m = 0; m < 4; ++m)
#pragma unroll
                for (int n = 0; n < 2; ++n) acc[a][b][m][n] = (f32x4){0.f, 0.f, 0.f, 0.f};
    bf16x8 At[4][2], B0[2][2], B1[2][2]; v8i At8[4], B08[2], B18[2];
    if constexpr (GATHER) { PG8_GIDX(oc, cur); }
    const char* cA = GATHER ? (const char*)g.A : (const char*)g.A + (size_t)cur.pm * tstepA; const char* cB = (const char*)g.Bt + (size_t)cur.pb * tstepB;
    PG8_STAGE(PG8_SB(0, 0), cB, voffB); PG8_STAGE(PG8_SB(0, 1), cB + hstep, voffB); PG8_STAGE(PG8_SA(0, 0), cA, oc[0]); PG8_STAGE(PG8_SA(0, 1), cA, oc[1]);
    if (wr == 1) PG8_BAR;
    PG8_WAIT_V(2); PG8_BAR;
    PG8_STAGE(PG8_SB(1, 0), cB + kstep, voffB); PG8_STAGE(PG8_SA(1, 0), cA + kstep, oc[0]); PG8_STAGE(PG8_SB(1, 1), cB + hstep + kstep, voffB);
    PG8_WAIT_V(6); PG8_BAR;
    if constexpr (FIXED_NT == 2) { PG8_WAIT_V(0); PG8_BAR; }
    bool fresh = false;
    for (;;) {
        const bool has_next = S.next(ui + 1, nxt);
        if constexpr (GATHER) { if (has_next) { PG8_GIDX(on, nxt); } }
        const char* nA = has_next ? (GATHER ? (const char*)g.A : (const char*)g.A + (size_t)nxt.pm * tstepA) : cA; const char* nB = has_next ? (const char*)g.Bt + (size_t)nxt.pb * tstepB : cB;
#pragma unroll 1
        for (int t = 0; t < nt; t += 2) {
            const bool last = (t == nt - 2);
            const char* a1 = cA + (size_t)(t + 1) * kstep;
            const char* a2 = last ? nA : cA + (size_t)(t + 2) * kstep; const char* b2 = last ? nB : cB + (size_t)(t + 2) * kstep;
            const char* a3 = a2 + kstep; const char* b3 = b2 + kstep;
            PG8_LDB(B0, 0, 0); PG8_LDB(B1, 0, 1); PG8_SCHED; PG8_LDA(At, 0, 0); PG8_STAGE(PG8_SA(1, 1), a1, oc[1]);
            if constexpr (GATHER) { if (last && has_next) { oc[0][0] = on[0][0]; oc[0][1] = on[0][1]; oc[1][0] = on[1][0]; oc[1][1] = on[1][1]; } }
            PG8_WAIT_V8S(); PG8_WAIT_L(0); PG8_BAR; PG8_MMA(0, 0, At, B0); PG8_MMA(0, 1, At, B1); PG8_BAR; PG8_SCHED;
            PG8_LDA(At, 0, 1); PG8_STAGE(PG8_SB(0, 0), b2, voffB); PG8_STAGE(PG8_SB(0, 1), b2 + hstep, voffB); PG8_STAGE(PG8_SA(0, 0), a2, oc[0]);
            PG8_WAIT_V8S(); fresh = false; PG8_WAIT_L(0); PG8_BAR; PG8_MMA(1, 0, At, B0); PG8_MMA(1, 1, At, B1); PG8_BAR; PG8_SCHED;
            PG8_LDB(B0, 1, 0); PG8_LDB(B1, 1, 1); PG8_SCHED; PG8_LDA(At, 1, 0); PG8_STAGE(PG8_SA(0, 1), a2, oc[1]);
            PG8_WAIT_V(8); PG8_WAIT_L(0); PG8_BAR; PG8_MMA(0, 0, At, B0); PG8_MMA(0, 1, At, B1); PG8_BAR; PG8_SCHED;
            PG8_LDA(At, 1, 1); PG8_STAGE(PG8_SB(1, 0), b3, voffB); PG8_STAGE(PG8_SB(1, 1), b3 + hstep, voffB); PG8_STAGE(PG8_SA(1, 0), a3, oc[0]);
            PG8_WAIT_V(8); PG8_WAIT_L(0); PG8_BAR; PG8_MMA(1, 0, At, B0); PG8_MMA(1, 1, At, B1); PG8_BAR; PG8_SCHED;
        }
        if constexpr (ALIGN_EPI) { if (wr == 0) PG8_BAR; }
        E(acc, cur, wr, wc, fr, fq);
        if (!has_next) break;
#pragma unroll
        for (int a = 0; a < 2; ++a)
#pragma unroll
            for (int b = 0; b < 2; ++b)
#pragma unroll
                for (int m = 0; m < 4; ++m)
#pragma unroll
                    for (int n = 0; n < 2; ++n) acc[a][b][m][n] = (f32x4){0.f, 0.f, 0.f, 0.f};
        cur = nxt; cA = nA; cB = nB; ++ui; fresh = true;
        if constexpr (ALIGN_EPI) { if (wr == 1) PG8_BAR; }
    }
    PG8_WAIT_V(0);
    if constexpr (!ALIGN_EPI) { if (wr == 0) PG8_BAR; }
    PG8_BAR;
#undef PG8_SA
#undef PG8_SB
#undef PG8_STAGE
#undef PG8_LDA
#undef PG8_LDB
#undef PG8_MMA
#undef PG8_WAIT_V
#undef PG8_WAIT_V8S
#undef PG8_WAIT_L
#undef PG8_BAR
#undef PG8_SCHED
#undef PG8_GIDX
}

struct DenseOrder {
    int nM, nN, nwg, G, c;
    __device__ __forceinline__ void init(int M, int N, int G_, int c_) { nM = M / BM; nN = N / BM; nwg = nM * nN; G = G_; c = c_; }
    __device__ __forceinline__ bool next(int i, Unit& u) const {
        const long L = (long)i * G + c; if (L >= nwg) return false;
        int wgid = (int)L; { const int q = nwg / 8, r = nwg % 8, xcd = wgid % 8, off = wgid / 8; wgid = (xcd < r ? xcd * (q + 1) : r * (q + 1) + (xcd - r) * q) + off; }
        const int nig = 8 * nN, gid = wgid / nig, fm = gid * 8, gsz = (nM - fm) < 8 ? (nM - fm) : 8;
        u.pm = fm + ((wgid % nig) % gsz); u.pn = (wgid % nig) / gsz; u.pb = u.pn; return true;
    }
};
struct GroupedOrder {
    const int* tile_e; int ntiles, NT, G, vcu;
    __device__ __forceinline__ bool next(int i, Unit& u) const {
        const int L = i * G + vcu; if (L >= ntiles * NT) return false;
        const int mt = L / NT, nn = L - mt * NT; u.pm = mt; u.pn = nn; u.pb = tile_e[mt] * NT + nn; return true;
    }
};

#define EPI_ROWS_BEGIN const int row0 = u.pm * BM + wr * 64 + fr; _Pragma("unroll") for (int ai = 0; ai < 2; ++ai) _Pragma("unroll") for (int m = 0; m < 4; ++m) { const int row = row0 + ai * HALF + m * 16;
#define EPI_ROWS_END }
struct EpiWinF {
    static constexpr bool PERM = true; static constexpr int NSTORE = 16;
    bf16_t* QK; bf16_t* V; bf16_t* AP;
    __device__ __forceinline__ void operator()(const f32x4 (&acc)[2][2][4][2], const Unit& u, int wr, int wc, int fr, int fq) const {
        const int colt = u.pn * BM + wc * 32 + 8 * fq;
        EPI_ROWS_BEGIN
#pragma unroll
            for (int bj = 0; bj < 2; ++bj) { const f32x4 v0 = acc[ai][bj][m][0], v1 = acc[ai][bj][m][1]; const int col = colt + bj * HALF;
                u32x4 w; w.x = cvt_pk_bf16(v0[0], v0[1]); w.y = cvt_pk_bf16(v0[2], v0[3]); w.z = cvt_pk_bf16(v1[0], v1[1]); w.w = cvt_pk_bf16(v1[2], v1[3]);
                bf16_t* dst;
                if (u.pn < 4) dst = QK + (size_t)row * 1024 + col;
                else if (u.pn < 6) dst = V + (size_t)row * 512 + (col - 1024);
                else { const int cc = col - 1536, gg = cc >> 4, ch = cc & 15, b = row / SEQ, l = row % SEQ;
                    dst = AP + ((size_t)(gg * (NB * NCHUNK) + b * NCHUNK + (l >> 4)) * APK + (l & 15) * 16 + ch); }
                *(u32x4*)dst = w; }
        EPI_ROWS_END
    }
};
struct EpiGluF {
    static constexpr bool PERM = true; static constexpr int NSTORE = 0;
    const bf16_t* Y; bf16_t* MX; float* ss;
    __device__ __forceinline__ void operator()(const f32x4 (&acc)[2][2][4][2], const Unit& u, int wr, int wc, int fr, int fq) const {
        const int colt = u.pn * BM + wc * 32 + 8 * fq;
        EPI_ROWS_BEGIN
            float s = 0.f;
#pragma unroll
            for (int bj = 0; bj < 2; ++bj) { const int col = colt + bj * HALF; const u32x4 yv = *(const u32x4*)(Y + (size_t)row * 512 + col);
                const f32x4 a0 = acc[ai][bj][m][0], a1 = acc[ai][bj][m][1];
                float v[8];
                v[0] = __uint_as_float(yv.x << 16) * sigmoidf(a0[0]); v[1] = __uint_as_float(yv.x & 0xffff0000u) * sigmoidf(a0[1]);
                v[2] = __uint_as_float(yv.y << 16) * sigmoidf(a0[2]); v[3] = __uint_as_float(yv.y & 0xffff0000u) * sigmoidf(a0[3]);
                v[4] = __uint_as_float(yv.z << 16) * sigmoidf(a1[0]); v[5] = __uint_as_float(yv.z & 0xffff0000u) * sigmoidf(a1[1]);
                v[6] = __uint_as_float(yv.w << 16) * sigmoidf(a1[2]); v[7] = __uint_as_float(yv.w & 0xffff0000u) * sigmoidf(a1[3]);
#pragma unroll
                for (int i = 0; i < 8; ++i) s += v[i] * v[i];
                u32x4 w; w.x = cvt_pk_bf16(v[0], v[1]); w.y = cvt_pk_bf16(v[2], v[3]); w.z = cvt_pk_bf16(v[4], v[5]); w.w = cvt_pk_bf16(v[6], v[7]);
                *(u32x4*)(MX + (size_t)row * 1024 + 512 + col) = w; }
            s += __shfl_xor(s, 16); s += __shfl_xor(s, 32);
            if (fq == 0) ss[(size_t)row * 8 + u.pn * 4 + wc] = s;
        EPI_ROWS_END
    }
};
struct EpiWoutF {
    static constexpr bool PERM = false; static constexpr int NSTORE = 0;
    const float* x; const float* mod; float* out; float* ss;
    __device__ __forceinline__ void operator()(const f32x4 (&acc)[2][2][4][2], const Unit& u, int wr, int wc, int fr, int fq) const {
        const int colt = u.pn * BM + wc * 32 + 4 * fq;
        EPI_ROWS_BEGIN
            const int b = row / SEQ; float s = 0.f;
#pragma unroll
            for (int bj = 0; bj < 2; ++bj)
#pragma unroll
                for (int n = 0; n < 2; ++n) { const int col = colt + bj * HALF + n * 16;
                    const f32x4 xv = *(const f32x4*)(x + (size_t)row * DM + col), g1 = *(const f32x4*)(mod + b * 6 * DM + 2 * DM + col);
                    const f32x4 o = xv + g1 * acc[ai][bj][m][n];
                    *(f32x4*)(out + (size_t)row * DM + col) = o; s += o[0] * o[0] + o[1] * o[1] + o[2] * o[2] + o[3] * o[3]; }
            s += __shfl_xor(s, 16); s += __shfl_xor(s, 32);
            if (fq == 0) ss[(size_t)row * 16 + u.pn * 4 + wc] = s;
        EPI_ROWS_END
    }
};
struct EpiRSF {
    static constexpr bool PERM = true; static constexpr int NSTORE = 0;
    float* L; bf16_t* AS;
    __device__ __forceinline__ void operator()(const f32x4 (&acc)[2][2][4][2], const Unit& u, int wr, int wc, int fr, int fq) const {
        const int c8 = wc * 32 + 8 * fq;
        EPI_ROWS_BEGIN
            if (u.pn == 0) {
#pragma unroll
                for (int bj = 0; bj < 2; ++bj) { float* d = L + (size_t)row * 256 + bj * HALF + c8; *(f32x4*)d = acc[ai][bj][m][0]; *(f32x4*)(d + 4) = acc[ai][bj][m][1]; }
            } else {
                const f32x4 g0 = acc[ai][0][m][0], g1 = acc[ai][0][m][1], u0 = acc[ai][1][m][0], u1 = acc[ai][1][m][1];
                u32x4 w; w.x = cvt_pk_bf16(siluf(g0[0]) * u0[0], siluf(g0[1]) * u0[1]); w.y = cvt_pk_bf16(siluf(g0[2]) * u0[2], siluf(g0[3]) * u0[3]);
                w.z = cvt_pk_bf16(siluf(g1[0]) * u1[0], siluf(g1[1]) * u1[1]); w.w = cvt_pk_bf16(siluf(g1[2]) * u1[2], siluf(g1[3]) * u1[3]);
                *(u32x4*)(AS + (size_t)row * 256 + (u.pn - 1) * 128 + c8) = w;
            }
        EPI_ROWS_END
    }
};
struct EpiSDF {
    static constexpr bool PERM = false; static constexpr int NSTORE = 0;
    const float* mod; float* out;
    __device__ __forceinline__ void operator()(const f32x4 (&acc)[2][2][4][2], const Unit& u, int wr, int wc, int fr, int fq) const {
        const int colt = u.pn * BM + wc * 32 + 4 * fq;
        EPI_ROWS_BEGIN
            const int b = row / SEQ;
#pragma unroll
            for (int bj = 0; bj < 2; ++bj)
#pragma unroll
                for (int n = 0; n < 2; ++n) { const int col = colt + bj * HALF + n * 16; const f32x4 g2 = *(const f32x4*)(mod + b * 6 * DM + 5 * DM + col);
                    f32x4* o = (f32x4*)(out + (size_t)row * DM + col); *o = *o + g2 * acc[ai][bj][m][n]; }
        EPI_ROWS_END
    }
};
struct EpiE1F {
    static constexpr bool PERM = true; static constexpr int NSTORE = 0;
    bf16_t* AE;
    __device__ __forceinline__ void operator()(const f32x4 (&acc)[2][2][4][2], const Unit& u, int wr, int wc, int fr, int fq) const {
        const int c8 = u.pn * 128 + wc * 32 + 8 * fq;
        EPI_ROWS_BEGIN
            const f32x4 g0 = acc[ai][0][m][0], g1 = acc[ai][0][m][1], u0 = acc[ai][1][m][0], u1 = acc[ai][1][m][1];
            u32x4 w; w.x = cvt_pk_bf16(siluf(g0[0]) * u0[0], siluf(g0[1]) * u0[1]); w.y = cvt_pk_bf16(siluf(g0[2]) * u0[2], siluf(g0[3]) * u0[3]);
            w.z = cvt_pk_bf16(siluf(g1[0]) * u1[0], siluf(g1[1]) * u1[1]); w.w = cvt_pk_bf16(siluf(g1[2]) * u1[2], siluf(g1[3]) * u1[3]);
            *(u32x4*)(AE + (size_t)row * 256 + c8) = w;
        EPI_ROWS_END
    }
};
struct EpiE2F {
    static constexpr bool PERM = true; static constexpr int NSTORE = 0;
    const int* sasg; const float* sgate; bf16_t* YA;
    __device__ __forceinline__ void operator()(const f32x4 (&acc)[2][2][4][2], const Unit& u, int wr, int wc, int fr, int fq) const {
        const int colt = u.pn * BM + wc * 32 + 8 * fq;
        EPI_ROWS_BEGIN
            const int asg = sasg[row]; const float gt = sgate[row];
            if (asg >= 0) {
#pragma unroll
                for (int bj = 0; bj < 2; ++bj) { const f32x4 v0 = acc[ai][bj][m][0] * gt, v1 = acc[ai][bj][m][1] * gt;
                    u32x4 w; w.x = cvt_pk_bf16(v0[0], v0[1]); w.y = cvt_pk_bf16(v0[2], v0[3]); w.z = cvt_pk_bf16(v1[0], v1[1]); w.w = cvt_pk_bf16(v1[2], v1[3]);
                    *(u32x4*)(YA + (size_t)asg * DM + colt + bj * HALF) = w; }
            }
        EPI_ROWS_END
    }
};
struct EpiSsmA {
    static constexpr bool PERM = false; static constexpr int NSTORE = 0;
    float* DS;
    __device__ __forceinline__ void operator()(const f32x4 (&acc)[2][2][4][2], const Unit& u, int wr, int wc, int fr, int fq) const {
        EPI_ROWS_BEGIN
#pragma unroll
            for (int n = 0; n < 2; ++n) *(f32x4*)(DS + (size_t)row * 128 + wc * 32 + n * 16 + 4 * fq) = acc[ai][0][m][n];
        EPI_ROWS_END
    }
};
struct EpiSsmC {
    static constexpr bool PERM = true; static constexpr int NSTORE = 0;
    bf16_t* Y;
    __device__ __forceinline__ void operator()(const f32x4 (&acc)[2][2][4][2], const Unit& u, int wr, int wc, int fr, int fq) const {
        EPI_ROWS_BEGIN
            const int gg = row >> 11, rem = row & 2047, b = rem >> 8, chunk = rem & 255; const size_t t0 = (size_t)b * SEQ + chunk * 16;
#pragma unroll
            for (int bj = 0; bj < 2; ++bj) { const int c0 = bj * HALF + wc * 32 + 8 * fq, jp = c0 >> 4, co0 = c0 & 15;
                const f32x4 v0 = acc[ai][bj][m][0], v1 = acc[ai][bj][m][1];
                u32x4 w; w.x = cvt_pk_bf16(gelu_tanh(v0[0]), gelu_tanh(v0[1])); w.y = cvt_pk_bf16(gelu_tanh(v0[2]), gelu_tanh(v0[3]));
                w.z = cvt_pk_bf16(gelu_tanh(v1[0]), gelu_tanh(v1[1])); w.w = cvt_pk_bf16(gelu_tanh(v1[2]), gelu_tanh(v1[3]));
                *(u32x4*)(Y + (t0 + jp) * 512 + gg * 16 + co0) = w; }
        EPI_ROWS_END
    }
};
struct EpiSDC {
    static constexpr bool PERM = true; static constexpr int NSTORE = 0;
    const float* mod; float* out; const bf16_t* YA;
    __device__ __forceinline__ void operator()(const f32x4 (&acc)[2][2][4][2], const Unit& u, int wr, int wc, int fr, int fq) const {
        const int colt = u.pn * BM + wc * 32 + 8 * fq;
        EPI_ROWS_BEGIN
            const int b = row / SEQ;
#pragma unroll
            for (int bj = 0; bj < 2; ++bj) { const int col = colt + bj * HALF;
                f32x4 s0 = acc[ai][bj][m][0], s1 = acc[ai][bj][m][1];
#pragma unroll
                for (int k = 0; k < 8; ++k) { const u32x4 w = *(const u32x4*)(YA + ((size_t)row * 8 + k) * DM + col);
                    s0[0] += __uint_as_float(w.x << 16); s0[1] += __uint_as_float(w.x & 0xffff0000u); s0[2] += __uint_as_float(w.y << 16); s0[3] += __uint_as_float(w.y & 0xffff0000u);
                    s1[0] += __uint_as_float(w.z << 16); s1[1] += __uint_as_float(w.z & 0xffff0000u); s1[2] += __uint_as_float(w.w << 16); s1[3] += __uint_as_float(w.w & 0xffff0000u); }
                const float* g2 = mod + b * 6 * DM + 5 * DM + col; float* o = out + (size_t)row * DM + col;
                *(f32x4*)o = *(const f32x4*)o + *(const f32x4*)g2 * s0; *(f32x4*)(o + 4) = *(const f32x4*)(o + 4) + *(const f32x4*)(g2 + 4) * s1; }
        EPI_ROWS_END
    }
};
struct EpiSDY {
    static constexpr bool PERM = true; static constexpr int NSTORE = 16;
    bf16_t* Y;
    __device__ __forceinline__ void operator()(const f32x4 (&acc)[2][2][4][2], const Unit& u, int wr, int wc, int fr, int fq) const {
        const int colt = u.pn * BM + wc * 32 + 8 * fq;
        EPI_ROWS_BEGIN
#pragma unroll
            for (int bj = 0; bj < 2; ++bj) { const f32x4 v0 = acc[ai][bj][m][0], v1 = acc[ai][bj][m][1];
                u32x4 w; w.x = cvt_pk_bf16(v0[0], v0[1]); w.y = cvt_pk_bf16(v0[2], v0[3]); w.z = cvt_pk_bf16(v1[0], v1[1]); w.w = cvt_pk_bf16(v1[2], v1[3]);
                *(u32x4*)(Y + (size_t)row * DM + colt + bj * HALF) = w; }
        EPI_ROWS_END
    }
};
struct EpiNone { static constexpr bool PERM = true; static constexpr int NSTORE = 0; float* sink;
    __device__ __forceinline__ void operator()(const f32x4 (&acc)[2][2][4][2], const Unit& u, int wr, int wc, int fr, int fq) const {
        float s = 0.f;
#pragma unroll
        for (int ai = 0; ai < 2; ++ai)
#pragma unroll
            for (int bj = 0; bj < 2; ++bj)
#pragma unroll
                for (int m = 0; m < 4; ++m)
#pragma unroll
                    for (int n = 0; n < 2; ++n) s += acc[ai][bj][m][n][0] + acc[ai][bj][m][n][1] + acc[ai][bj][m][n][2] + acc[ai][bj][m][n][3];
        if (s == 1234567.875f) sink[threadIdx.x] = s; } };
struct EpiDense { static constexpr bool PERM = true; static constexpr int NSTORE = 0; bf16_t* Y;
    __device__ __forceinline__ void operator()(const f32x4 (&acc)[2][2][4][2], const Unit& u, int wr, int wc, int fr, int fq) const {
        const int colt = u.pn * BM + wc * 32 + 8 * fq;
        EPI_ROWS_BEGIN
            if (row < T * 8) {
#pragma unroll
            for (int bj = 0; bj < 2; ++bj) { const f32x4 v0 = acc[ai][bj][m][0], v1 = acc[ai][bj][m][1];
                u32x4 w; w.x = cvt_pk_bf16(v0[0], v0[1]); w.y = cvt_pk_bf16(v0[2], v0[3]); w.z = cvt_pk_bf16(v1[0], v1[1]); w.w = cvt_pk_bf16(v1[2], v1[3]);
                *(u32x4*)(Y + (size_t)row * DM + colt + bj * HALF) = w; } }
        EPI_ROWS_END
    } };
struct ProbeOrder { int nunits, G, vcu;
    __device__ __forceinline__ bool next(int i, Unit& u) const { const int L = i * G + vcu; if (L >= nunits) return false; u.pm = vcu & 7; u.pn = 0; u.pb = vcu & 3; return true; } };
struct EpiE2S {
    static constexpr bool PERM = true; static constexpr int NSTORE = 16;
    const int* sasg; const float* sgate; bf16_t* YS;
    __device__ __forceinline__ void operator()(const f32x4 (&acc)[2][2][4][2], const Unit& u, int wr, int wc, int fr, int fq) const {
        const int colt = u.pn * BM + wc * 32 + 8 * fq; const int row0 = u.pm * BM + wr * 64 + fr;
        float gt[2][4];
#pragma unroll
        for (int ai = 0; ai < 2; ++ai)
#pragma unroll
            for (int m = 0; m < 4; ++m) gt[ai][m] = sgate[row0 + ai * HALF + m * 16];
        asm volatile("s_waitcnt vmcnt(0)" : "+v"(gt[0][0]), "+v"(gt[0][1]), "+v"(gt[0][2]), "+v"(gt[0][3]), "+v"(gt[1][0]), "+v"(gt[1][1]), "+v"(gt[1][2]), "+v"(gt[1][3]) :: "memory");
#pragma unroll
        for (int ai = 0; ai < 2; ++ai)
#pragma unroll
            for (int m = 0; m < 4; ++m) { const int row = row0 + ai * HALF + m * 16;
#pragma unroll
                for (int bj = 0; bj < 2; ++bj) { const f32x4 v0 = acc[ai][bj][m][0] * gt[ai][m], v1 = acc[ai][bj][m][1] * gt[ai][m];
                    u32x4 w; w.x = cvt_pk_bf16(v0[0], v0[1]); w.y = cvt_pk_bf16(v0[2], v0[3]); w.z = cvt_pk_bf16(v1[0], v1[1]); w.w = cvt_pk_bf16(v1[2], v1[3]);
                    *(u32x4*)(YS + (size_t)row * DM + colt + bj * HALF) = w; } }
    }
};
struct EpiE1F8 {
    static constexpr bool PERM = true; static constexpr int NSTORE = 0;
    unsigned char* AE;
    __device__ __forceinline__ void operator()(const f32x4 (&acc)[2][2][4][2], const Unit& u, int wr, int wc, int fr, int fq) const {
        const int c8 = u.pn * 128 + wc * 32 + 8 * fq;
        EPI_ROWS_BEGIN
            const f32x4 g0 = acc[ai][0][m][0], g1 = acc[ai][0][m][1], u0 = acc[ai][1][m][0], u1 = acc[ai][1][m][1];
            u32x2 w; w.x = pk4_fp8(ACT8_SCALE * siluf(g0[0]) * u0[0], ACT8_SCALE * siluf(g0[1]) * u0[1], ACT8_SCALE * siluf(g0[2]) * u0[2], ACT8_SCALE * siluf(g0[3]) * u0[3]);
            w.y = pk4_fp8(ACT8_SCALE * siluf(g1[0]) * u1[0], ACT8_SCALE * siluf(g1[1]) * u1[1], ACT8_SCALE * siluf(g1[2]) * u1[2], ACT8_SCALE * siluf(g1[3]) * u1[3]);
            *(u32x2*)(AE + (size_t)row * 256 + c8) = w;
        EPI_ROWS_END
    }
};
struct EpiE2S8 {
    static constexpr bool PERM = true; static constexpr int NSTORE = 16;
    const float* sgate; unsigned char* YS;
    __device__ __forceinline__ void operator()(const f32x4 (&acc)[2][2][4][2], const Unit& u, int wr, int wc, int fr, int fq) const {
        const int colt = u.pn * BM + wc * 32 + 8 * fq; const int row0 = u.pm * BM + wr * 64 + fr;
        float gt[2][4];
#pragma unroll
        for (int ai = 0; ai < 2; ++ai)
#pragma unroll
            for (int m = 0; m < 4; ++m) gt[ai][m] = sgate[row0 + ai * HALF + m * 16] * Y8_SCALE;
        asm volatile("s_waitcnt vmcnt(0)" : "+v"(gt[0][0]), "+v"(gt[0][1]), "+v"(gt[0][2]), "+v"(gt[0][3]), "+v"(gt[1][0]), "+v"(gt[1][1]), "+v"(gt[1][2]), "+v"(gt[1][3]) :: "memory");
#pragma unroll
        for (int ai = 0; ai < 2; ++ai)
#pragma unroll
            for (int m = 0; m < 4; ++m) { const int row = row0 + ai * HALF + m * 16;
#pragma unroll
                for (int bj = 0; bj < 2; ++bj) { const f32x4 v0 = acc[ai][bj][m][0] * gt[ai][m], v1 = acc[ai][bj][m][1] * gt[ai][m];
                    u32x2 w; w.x = pk4_fp8(v0[0], v0[1], v0[2], v0[3]); w.y = pk4_fp8(v1[0], v1[1], v1[2], v1[3]);
                    *(u32x2*)(YS + (size_t)row * DM + colt + bj * HALF) = w; } }
    }
};
struct EpiE2S8b {
    static constexpr bool PERM = true; static constexpr int NSTORE = 0;
    const float* sgate; unsigned char* YS;
    __device__ __forceinline__ void operator()(const f32x4 (&acc)[2][2][4][2], const Unit& u, int wr, int wc, int fr, int fq) const {
        const int colt = u.pn * BM + wc * 32 + 8 * fq;
        EPI_ROWS_BEGIN
            const float gt = sgate[row] * Y8_SCALE;
#pragma unroll
            for (int bj = 0; bj < 2; ++bj) { const f32x4 v0 = acc[ai][bj][m][0] * gt, v1 = acc[ai][bj][m][1] * gt;
                u32x2 w; w.x = pk4_fp8(v0[0], v0[1], v0[2], v0[3]); w.y = pk4_fp8(v1[0], v1[1], v1[2], v1[3]);
                *(u32x2*)(YS + (size_t)row * DM + colt + bj * HALF) = w; }
        EPI_ROWS_END
    }
};
struct EpiE1G8 {
    static constexpr bool PERM = true; static constexpr int NSTORE = 0;
    const float* sgate; unsigned char* AE;
    __device__ __forceinline__ void operator()(const f32x4 (&acc)[2][2][4][2], const Unit& u, int wr, int wc, int fr, int fq) const {
        const int c8 = u.pn * 128 + wc * 32 + 8 * fq;
        EPI_ROWS_BEGIN
            const float gs = sgate[row] * ACT8_SCALE;
            const f32x4 g0 = acc[ai][0][m][0], g1 = acc[ai][0][m][1], u0 = acc[ai][1][m][0], u1 = acc[ai][1][m][1];
            u32x2 w; w.x = pk4_fp8(gs * siluf(g0[0]) * u0[0], gs * siluf(g0[1]) * u0[1], gs * siluf(g0[2]) * u0[2], gs * siluf(g0[3]) * u0[3]);
            w.y = pk4_fp8(gs * siluf(g1[0]) * u1[0], gs * siluf(g1[1]) * u1[1], gs * siluf(g1[2]) * u1[2], gs * siluf(g1[3]) * u1[3]);
            *(u32x2*)(AE + (size_t)row * 256 + c8) = w;
        EPI_ROWS_END
    }
};
struct EpiE2P8 {
    static constexpr bool PERM = true; static constexpr int NSTORE = 16;
    unsigned char* YS;
    __device__ __forceinline__ void operator()(const f32x4 (&acc)[2][2][4][2], const Unit& u, int wr, int wc, int fr, int fq) const {
        const int colt = u.pn * BM + wc * 32 + 8 * fq;
        unsigned char* ptr = YS + (size_t)(u.pm * BM + wr * 64 + fr) * DM + colt;
#pragma unroll
        for (int ai = 0; ai < 2; ++ai) {
#pragma unroll
            for (int m = 0; m < 4; ++m) {
#pragma unroll
                for (int bj = 0; bj < 2; ++bj) { const f32x4 v0 = acc[ai][bj][m][0], v1 = acc[ai][bj][m][1];
                    u32x2 w; w.x = pk4_fp8(v0[0], v0[1], v0[2], v0[3]); w.y = pk4_fp8(v1[0], v1[1], v1[2], v1[3]);
                    *(u32x2*)(ptr + bj * HALF) = w; }
                ptr += 16 * DM; asm volatile("" : "+v"(ptr)); __builtin_amdgcn_sched_barrier(0); }
            ptr += (HALF - 64) * DM; }
    }
};
struct GroupedOrderL {
    const PG8_LAS int* le; int ntiles, NT, G, vcu;
    __device__ __forceinline__ void fill(const int* tile_e, PG8_LAS int* dst) { le = dst; const int tot = ntiles * NT;
        for (int i = threadIdx.x; i * G + vcu < tot; i += blockDim.x) dst[i] = tile_e[(i * G + vcu) / NT];
        __syncthreads(); }
    __device__ __forceinline__ bool next(int i, Unit& u) const {
        const int L = i * G + vcu; if (L >= ntiles * NT) return false;
        const int mt = L / NT, nn = L - mt * NT; u.pm = mt; u.pn = nn; u.pb = le[i] * NT + nn; return true;
    }
};
struct SsmOrder {
    int G, vcu;
    __device__ __forceinline__ bool next(int i, Unit& u) const { const int L = i * G + vcu; if (L >= 256) return false; u.pm = L; u.pn = 0; u.pb = L >> 3; return true; }
};
}

__device__ __forceinline__ void transpose_item(const float* W, int K, int N, bf16_t* WT, int kb, int nb, int rowbase, float* scr, int lane) {
    const int k0 = 64 * kb, n0 = 32 * nb;
#pragma unroll 8
    for (int i = 0; i < 32; ++i) { const int kk = 2 * i + (lane >> 5); scr[kk * 33 + (lane & 31)] = W[(size_t)(k0 + kk) * N + n0 + (lane & 31)]; }
    asm volatile("s_waitcnt lgkmcnt(0)" ::: "memory");
    const int cch = lane & 7;
#pragma unroll
    for (int j = 0; j < 4; ++j) { const int n = (lane >> 3) + 8 * j; const float* s = scr + (8 * cch) * 33 + n;
        u32x4 o; o.x = pk2(s[0 * 33], s[1 * 33]); o.y = pk2(s[2 * 33], s[3 * 33]); o.z = pk2(s[4 * 33], s[5 * 33]); o.w = pk2(s[6 * 33], s[7 * 33]);
        *(u32x4*)(WT + (size_t)(rowbase + n) * K + k0 + 8 * cch) = o; }
    asm volatile("s_waitcnt lgkmcnt(0)" ::: "memory");
}
__device__ __forceinline__ int gu_row(int n0, int up) { return (n0 >> 7) * 256 + up * 128 + (n0 & 127); }
template <bool EXPERTS>
__device__ __forceinline__ void ph_convert(const Ctx& c, const Params& p) {
    float* scr = c.lds + c.wave * (64 * 33);
    unsigned char* ws = c.ws;
    constexpr int I0 = 16 * 64, I1 = 16 * 32, I2 = 8 * 16, I3 = 16 * 8, I6 = 4 * 32, IE = 128;
    constexpr int DENSE = I0 + I1 + I2 + 3 * I3 + I6, NITEMS = EXPERTS ? DENSE + 3 * IE * NE : DENSE;
    for (int it = c.gwave; it < NITEMS; it += c.gwaves) {
        int r = it;
        if (r < I0) { transpose_item(p.in[I_WIN], DM, 2048, (bf16_t*)(ws + WS_WIN_T), r / 64, r % 64, (r % 64) * 32, scr, c.lane); continue; } r -= I0;
        if (r < I1) { transpose_item(p.in[I_WOUT], DM, DM, (bf16_t*)(ws + WS_WOUT_T), r / 32, r % 32, (r % 32) * 32, scr, c.lane); continue; } r -= I1;
        if (r < I2) { transpose_item(p.in[I_WGLU], 512, 512, (bf16_t*)(ws + WS_WGLU_T), r / 16, r % 16, (r % 16) * 32, scr, c.lane); continue; } r -= I2;
        if (r < I3) { transpose_item(p.in[I_WR], DM, 256, (bf16_t*)(ws + WS_WRS_T), r / 8, r % 8, (r % 8) * 32, scr, c.lane); continue; } r -= I3;
        if (r < I3) { transpose_item(p.in[I_WGS], DM, 256, (bf16_t*)(ws + WS_WRS_T), r / 8, r % 8, 256 + gu_row((r % 8) * 32, 0), scr, c.lane); continue; } r -= I3;
        if (r < I3) { transpose_item(p.in[I_WUS], DM, 256, (bf16_t*)(ws + WS_WRS_T), r / 8, r % 8, 256 + gu_row((r % 8) * 32, 1), scr, c.lane); continue; } r -= I3;
        if (r < I6) { transpose_item(p.in[I_WDS], 256, DM, (bf16_t*)(ws + WS_WDS_T), r / 32, r % 32, (r % 32) * 32, scr, c.lane); continue; } r -= I6;
        const int e = r / (3 * IE), q = r % (3 * IE), which = q / IE, ii = q % IE;
        if (which == 0) transpose_item(p.in[I_WGE] + (size_t)e * DM * ED, DM, ED, (bf16_t*)(ws + WS_WGU) + (size_t)e * 512 * DM, ii / 8, ii % 8, gu_row((ii % 8) * 32, 0), scr, c.lane);
        else if (which == 1) transpose_item(p.in[I_WUE] + (size_t)e * DM * ED, DM, ED, (bf16_t*)(ws + WS_WGU) + (size_t)e * 512 * DM, ii / 8, ii % 8, gu_row((ii % 8) * 32, 1), scr, c.lane);
        else transpose_item(p.in[I_WDE] + (size_t)e * ED * DM, ED, DM, (bf16_t*)(ws + WS_WD) + (size_t)e * DM * ED, ii / 32, ii % 32, (ii % 32) * 32, scr, c.lane);
    }
}

__device__ __forceinline__ void transpose_tile64(const float* W, int K, int N, bf16_t* WT, int kb, int nb, int rowbase, float* scr, int lane) {
    const int k0 = 64 * kb, n0 = 64 * nb;
    f32x4 v[16];
#pragma unroll
    for (int i = 0; i < 16; ++i) v[i] = *(const f32x4*)(W + (size_t)(k0 + 4 * i + (lane >> 4)) * N + n0 + (lane & 15) * 4);
#pragma unroll
    for (int i = 0; i < 16; ++i) { float* d = scr + (4 * i + (lane >> 4)) * 65 + (lane & 15) * 4; d[0] = v[i].x; d[1] = v[i].y; d[2] = v[i].z; d[3] = v[i].w; }
    asm volatile("s_waitcnt lgkmcnt(0)" ::: "memory");
    const int cch = lane & 7;
#pragma unroll
    for (int jj = 0; jj < 8; ++jj) { const int n = (lane >> 3) + 8 * jj; const float* s_ = scr + (8 * cch) * 65 + n;
        u32x4 o; o.x = pk2(s_[0 * 65], s_[1 * 65]); o.y = pk2(s_[2 * 65], s_[3 * 65]); o.z = pk2(s_[4 * 65], s_[5 * 65]); o.w = pk2(s_[6 * 65], s_[7 * 65]);
        *(u32x4*)(WT + (size_t)(rowbase + n) * K + k0 + 8 * cch) = o; }
    asm volatile("s_waitcnt lgkmcnt(0)" ::: "memory");
}
struct ConvTile { const float* W; bf16_t* WT; int K, N, k0, n0, rowbase; bool f8; float scale; };
template <int GU8>
__device__ __forceinline__ ConvTile conv_tile_ref(const Ctx& c, const Params& p, int id) {
    const int e = id / 192, q = id % 192, which = q >> 6, ii = q & 63; ConvTile t; t.f8 = (GU8 >= 1 && which < 2) || (GU8 == 2); t.scale = which < 2 ? WGU8_SCALE : WD8_SCALE;
    if (which == 0) { t.W = p.in[I_WGE] + (size_t)e * DM * ED; t.WT = (bf16_t*)(c.ws + WS_WGU) + (size_t)e * 512 * (GU8 ? DM / 2 : DM); t.K = DM; t.N = ED; t.k0 = 64 * (ii >> 2); t.n0 = 64 * (ii & 3); t.rowbase = gu_row(t.n0, 0); }
    else if (which == 1) { t.W = p.in[I_WUE] + (size_t)e * DM * ED; t.WT = (bf16_t*)(c.ws + WS_WGU) + (size_t)e * 512 * (GU8 ? DM / 2 : DM); t.K = DM; t.N = ED; t.k0 = 64 * (ii >> 2); t.n0 = 64 * (ii & 3); t.rowbase = gu_row(t.n0, 1); }
    else { t.W = p.in[I_WDE] + (size_t)e * ED * DM; t.WT = (bf16_t*)(c.ws + WS_WD) + (size_t)e * DM * (GU8 == 2 ? ED / 2 : ED); t.K = ED; t.N = DM; t.k0 = 64 * (ii >> 4); t.n0 = 64 * (ii & 15); t.rowbase = t.n0; }
    return t;
}
#define CONV_LOAD(v, t) do { const float* p_ = (t).W + (size_t)((t).k0 + (c.lane >> 4)) * (t).N + (t).n0 + (c.lane & 15) * 4; const size_t st_ = (size_t)4 * (t).N; \
        _Pragma("unroll") for (int i_ = 0; i_ < 16; ++i_) { v[i_] = *(const f32x4*)p_; p_ += st_; asm volatile("" : "+v"(p_)); } } while (0)
#define CONV_FINISH(v, t) do { _Pragma("unroll") for (int i_ = 0; i_ < 16; ++i_) { float* d_ = scr + (4 * i_ + (c.lane >> 4)) * 65 + (c.lane & 15) * 4; d_[0] = v[i_].x; d_[1] = v[i_].y; d_[2] = v[i_].z; d_[3] = v[i_].w; } \
        asm volatile("s_waitcnt lgkmcnt(0)" ::: "memory"); \
        { const int esz_ = (t).f8 ? 1 : 2; unsigned char* q_ = (unsigned char*)(t).WT + ((size_t)((t).rowbase + (c.lane >> 3)) * (t).K + (t).k0 + 8 * (c.lane & 7)) * esz_; const size_t qs_ = (size_t)8 * (t).K * esz_; \
        _Pragma("unroll") for (int jj_ = 0; jj_ < 8; ++jj_) { const float* s_ = scr + (8 * (c.lane & 7)) * 65 + (c.lane >> 3) + 8 * jj_; \
            if ((t).f8) { u32x2 o_; o_.x = pk4_fp8(s_[0 * 65] * (t).scale, s_[1 * 65] * (t).scale, s_[2 * 65] * (t).scale, s_[3 * 65] * (t).scale); \
                o_.y = pk4_fp8(s_[4 * 65] * (t).scale, s_[5 * 65] * (t).scale, s_[6 * 65] * (t).scale, s_[7 * 65] * (t).scale); \
                *(u32x2*)q_ = o_; } \
            else { u32x4 o_; o_.x = pk2(s_[0 * 65], s_[1 * 65]); o_.y = pk2(s_[2 * 65], s_[3 * 65]); o_.z = pk2(s_[4 * 65], s_[5 * 65]); o_.w = pk2(s_[6 * 65], s_[7 * 65]); \
                *(u32x4*)q_ = o_; } \
            q_ += qs_; asm volatile("" : "+v"(q_)); } } \
        asm volatile("s_waitcnt lgkmcnt(0)" ::: "memory"); } while (0)
template <int GU8>
__device__ __forceinline__ void conv_range(const Ctx& c, const Params& p, int first, int end, int stride, float* scr) {
    if (first >= end) return;
    f32x4 va[16], vb[16];
    ConvTile ta = conv_tile_ref<GU8>(c, p, first), tb = ta;
    CONV_LOAD(va, ta);
    for (int id = first; id < end; id += 2 * stride) {
        const bool hb = id + stride < end;
        if (hb) { tb = conv_tile_ref<GU8>(c, p, id + stride); CONV_LOAD(vb, tb); }
        CONV_FINISH(va, ta);
        if (!hb) break;
        const bool ha = id + 2 * stride < end;
        if (ha) { ta = conv_tile_ref<GU8>(c, p, id + 2 * stride); CONV_LOAD(va, ta); }
        CONV_FINISH(vb, tb);
        if (!ha) break;
    }
}
__device__ __forceinline__ void conv_tile_by_id(const Ctx& c, const Params& p, int id, float* scr) { conv_range<0>(c, p, id, id + 1, 1, scr); }
__device__ __forceinline__ void conv_queue(const Ctx& c, const Params& p, unsigned* qctr) {
    float* scr = c.lds + c.wave * (64 * 65);
    constexpr int NTILES = NE * 192, CHUNK = 16;
    for (;;) {
        int tk = 0; if (c.lane == 0) tk = (int)atomicAdd(qctr, 1u);
        tk = __builtin_amdgcn_readfirstlane(tk);
        if (tk * CHUNK >= NTILES) break;
        conv_range<0>(c, p, tk * CHUNK, tk * CHUNK + CHUNK, 1, scr);
    }
}
__device__ __forceinline__ void ph_prologue2(const Ctx& c, const Params& p) {
    float* mod = (float*)(c.ws + WS_MOD);
    const bool split = c.nb >= 2 * 96;
    const bool is_mod = c.bid < 96 || !split, is_helper = c.bid >= 96 || !split;
    const int hid = split ? (c.bid - 96) * NTHREADS_ + c.tid : c.gtid, hn = split ? (c.nb - 96) * NTHREADS_ : c.gthreads;
    float* sc = c.lds;
    if (is_mod) { for (int i = c.tid; i < NB * DM; i += NTHREADS_) sc[i] = siluf(p.in[I_C][i]); }
    __syncthreads();
    float* red = c.lds + NB * DM;
    if (is_mod) for (int cg = c.bid; cg < 96; cg += c.nb) {
        const int ks = c.wave, col = cg * 64 + c.lane;
        const float* w = p.in[I_WADA] + (size_t)(ks * 128) * (6 * DM) + col;
        float acc[8];
#pragma unroll
        for (int b = 0; b < 8; ++b) acc[b] = 0.f;
#pragma unroll 16
        for (int k = 0; k < 128; ++k) { const float wv = w[(size_t)k * (6 * DM)];
#pragma unroll
            for (int b = 0; b < 8; ++b) acc[b] += sc[b * DM + ks * 128 + k] * wv; }
#pragma unroll
        for (int b = 0; b < 8; ++b) red[(ks * 8 + b) * 64 + c.lane] = acc[b];
        __syncthreads();
        { const int b = c.wave; float sum = p.in[I_BADA][col];
#pragma unroll
          for (int k2 = 0; k2 < 8; ++k2) sum += red[(k2 * 8 + b) * 64 + c.lane];
          mod[b * 6 * DM + col] = sum; }
        __syncthreads();
    }
    float* ropec = (float*)(c.ws + WS_ROPE); float* ropes = ropec + SEQ * 32;
    if (is_helper) for (int idx = hid; idx < SEQ * 32; idx += hn) {
        const int l = idx >> 5, i = idx & 31;
        const double invf = exp(-log(10000.0) * (double)(2 * i) / 64.0);
        const double ang = (double)l * invf;
        ropec[idx] = (float)cos(ang); ropes[idx] = (float)sin(ang);
    }
    float* sp = (float*)(c.ws + WS_SSMP);
    float* abr = sp, * abi = sp + SG * SP, * bbr = sp + 2 * SG * SP, * bbi = bbr + SG * SP * SC;
    if (is_helper) for (int idx = hid; idx < SG * SP; idx += hn) {
        const int g = idx / SP;
        const double are = p.in[I_ARE][idx], aim = p.in[I_AIM][idx], dt = exp((double)p.in[I_LOGDT][g]);
        const double mag = exp(are * dt), ar = mag * cos(aim * dt), ai = mag * sin(aim * dt);
        abr[idx] = (float)ar; abi[idx] = (float)ai;
        const double den = are * are + aim * aim, nr = ar - 1.0;
        const double fre = (nr * are + ai * aim) / den, fim = (ai * are - nr * aim) / den;
        for (int ch = 0; ch < SC; ++ch) {
            const double br = p.in[I_BRE][idx * SC + ch], bi = p.in[I_BIM][idx * SC + ch];
            bbr[idx * SC + ch] = (float)(fre * br - fim * bi); bbi[idx * SC + ch] = (float)(fre * bi + fim * br);
        }
    }
    if (is_helper) for (int idx = hn - 1 - hid; idx < SG * SP * 17; idx += hn) {
        const int gp = idx / 17, d = idx % 17, g = gp / SP;
        const double are = p.in[I_ARE][gp], aim = p.in[I_AIM][gp], dt = exp((double)p.in[I_LOGDT][g]);
        const double m = exp(are * dt * d); float* pw = (float*)(c.ws + WS_SSMPW) + (size_t)gp * 34;
        pw[2 * d] = (float)(m * cos(aim * dt * d)); pw[2 * d + 1] = (float)(m * sin(aim * dt * d));
    }
    if (is_helper && hid == hn - 1) {
        float s1 = 0.f, s2 = 0.f, gq = 0.f, gk = 0.f;
        for (int i = 0; i < HD; ++i) { s1 += p.in[I_LQ1][i] * p.in[I_LK1][i]; s2 += p.in[I_LQ2][i] * p.in[I_LK2][i];
            gq = fmaxf(gq, fabsf(p.in[I_QNG][i])); gk = fmaxf(gk, fabsf(p.in[I_KNG][i])); }
        float* lam = (float*)(c.ws + WS_LAM);
        lam[0] = __expf(s1) - __expf(s2) + LAM_INIT;
        lam[1] = 0.125f * 64.f * gq * gk;
    }
    int* stok = (int*)(c.ws + WS_SLOT_TOK); int* sasg = (int*)(c.ws + WS_SLOT_ASG); float* sgate = (float*)(c.ws + WS_SLOT_GATE);
    if (is_helper) for (int idx = hid; idx < NS_MAX; idx += hn) { stok[idx] = 0; sasg[idx] = -1; sgate[idx] = 0.f; }
    int* te = (int*)(c.ws + WS_TILE_E);
    if (is_helper) for (int idx = hid; idx < NS_MAX / 256; idx += hn) te[idx] = -1;
    __syncthreads();
}
__device__ __forceinline__ void ph_slot2(const Ctx& c, const Params& p) {
    const unsigned* counts = (const unsigned*)(c.ws + WS_CTL) + CW_COUNTS; unsigned* cursor = (unsigned*)(c.ws + WS_CTL) + CW_CURSOR;
    int* pc = (int*)c.lds; int* ps = pc + 256;
    if (c.tid < NE) pc[c.tid] = ((int)counts[c.tid] + 255) / 256 * 256;
    __syncthreads();
    if (c.tid <= NE) { int acc = 0; for (int e = 0; e < c.tid; ++e) acc += pc[e]; ps[c.tid] = acc; }
    __syncthreads();
    const int* eidx = (const int*)(c.ws + WS_EIDX); const float* gw = (const float*)(c.ws + WS_GATEW);
    int* stok = (int*)(c.ws + WS_SLOT_TOK); int* sasg = (int*)(c.ws + WS_SLOT_ASG); float* sgate = (float*)(c.ws + WS_SLOT_GATE);
    for (int a = c.gtid; a < T * TOPK; a += c.gthreads) {
        const int e = eidx[a]; const unsigned pos = atomicAdd(cursor + e, 1u); const int slot = ps[e] + (int)pos;
        stok[slot] = a >> 3; sasg[slot] = a; sgate[slot] = gw[a];
    }
    if (c.bid == 0) {
        int* te = (int*)(c.ws + WS_TILE_E);
        for (int e = c.tid; e < NE; e += NTHREADS_) for (int tl = ps[e] / 256; tl < ps[e + 1] / 256; ++tl) te[tl] = e;
        if (c.tid == 0) ((unsigned*)(c.ws + WS_CTL))[CW_NTILES] = (unsigned)(ps[NE] / 256);
    }
    __syncthreads();
}

template <int CTRL> __device__ __forceinline__ float dpp_f(float v) { return __builtin_bit_cast(float, __builtin_amdgcn_update_dpp(0, __builtin_bit_cast(int, v), CTRL, 0xF, 0xF, false)); }
template <int CTRL> __device__ __forceinline__ int dpp_i(int v) { return __builtin_amdgcn_update_dpp(0, v, CTRL, 0xF, 0xF, false); }
#define DPP_XOR1 0xB1
#define DPP_XOR2 0x4E
#define DPP_HMIR 0x141
#define DPP_MIR 0x140
__device__ __forceinline__ void ph_qkn2(const Ctx& c, const Params& p) {
    bf16_t* QK = (bf16_t*)(c.ws + WS_QK);
    const float* ropec = (const float*)(c.ws + WS_ROPE); const float* ropes = ropec + SEQ * 32;
    const int l = c.lane, qt = l & 3; const bool hi_half = qt >= 2;
    const float qsc = l < 32 ? 0.125f * 1.4426950408889634f : 1.f;
    float g[16];
#pragma unroll
    for (int j = 0; j < 16; ++j) g[j] = (l < 32 ? p.in[I_QNG] : p.in[I_KNG])[16 * qt + j];
    constexpr int R = 2;
    for (int t0 = c.gwave * R; t0 < T; t0 += c.gwaves * R) {
        u32x4 w[R][2]; f32x4 cs[R][4], sn[R][4];
#pragma unroll
        for (int r = 0; r < R; ++r) { const int t = t0 + r, pos = t % SEQ;
            w[r][0] = *(const u32x4*)(QK + (size_t)t * 1024 + l * 16); w[r][1] = *(const u32x4*)(QK + (size_t)t * 1024 + l * 16 + 8);
#pragma unroll
            for (int q = 0; q < 4; ++q) { cs[r][q] = *(const f32x4*)(ropec + pos * 32 + 16 * (qt & 1) + 4 * q); sn[r][q] = *(const f32x4*)(ropes + pos * 32 + 16 * (qt & 1) + 4 * q); } }
#pragma unroll
        for (int r = 0; r < R; ++r) {
            float v[16]; const unsigned* wp = (const unsigned*)&w[r][0];
#pragma unroll
            for (int i = 0; i < 8; ++i) { v[2 * i] = __uint_as_float(wp[i] << 16); v[2 * i + 1] = __uint_as_float(wp[i] & 0xffff0000u); }
            float ss = 0.f;
#pragma unroll
            for (int j = 0; j < 16; ++j) ss += v[j] * v[j];
            ss += dpp_f<DPP_XOR1>(ss); ss += dpp_f<DPP_XOR2>(ss);
            const float rstd = rsqrtf(ss * (1.f / 64.f) + EPS);
            unsigned o[8];
#pragma unroll
            for (int i = 0; i < 8; ++i) { float res[2];
#pragma unroll
                for (int e = 0; e < 2; ++e) { const int j = 2 * i + e; const float y = v[j] * rstd * g[j]; const float pr = dpp_f<DPP_XOR2>(y);
                    const float cc_ = cs[r][j >> 2][j & 3], s_ = sn[r][j >> 2][j & 3];
                    res[e] = (hi_half ? (pr * s_ + y * cc_) : (y * cc_ - pr * s_)) * qsc; }
                o[i] = pk2(res[0], res[1]); }
            *(u32x4*)(QK + (size_t)(t0 + r) * 1024 + l * 16) = (u32x4){o[0], o[1], o[2], o[3]}; *(u32x4*)(QK + (size_t)(t0 + r) * 1024 + l * 16 + 8) = (u32x4){o[4], o[5], o[6], o[7]};
        }
    }
}
template <bool ATOMIC_BASE>
__device__ __forceinline__ void ph_route2(const Ctx& c, const Params& p) {
    const float* L = (const float*)(c.ws + WS_LOGITS);
    int* eidx = (int*)(c.ws + WS_EIDX); float* gw = (float*)(c.ws + WS_GATEW); int* HIST = (int*)(c.ws + WS_HIST);
    int* hist = (int*)c.lds;
    if (c.tid < NE) hist[c.tid] = 0;
    __syncthreads();
    const int j = c.lane & 15, r = c.lane >> 4, g = j >> 1; const float NEG = -__builtin_inff();
    float rb[16];
#pragma unroll
    for (int i = 0; i < 16; ++i) rb[i] = p.in[I_RB][16 * j + i];
    for (int blk = c.bid; blk < T / 128; blk += c.nb) {
        for (int it = 0; it < 4; ++it) {
            const int t = blk * 128 + it * 32 + c.wave * 4 + r;
            float s[16], mv[16];
            { const f32x4* lp = (const f32x4*)(L + (size_t)t * 256 + 16 * j);
#pragma unroll
              for (int q = 0; q < 4; ++q) { const f32x4 x = lp[q]; s[4 * q] = sigmoidf(x.x); s[4 * q + 1] = sigmoidf(x.y); s[4 * q + 2] = sigmoidf(x.z); s[4 * q + 3] = sigmoidf(x.w); } }
            float m1 = NEG, m2 = NEG;
#pragma unroll
            for (int i = 0; i < 16; ++i) { mv[i] = s[i] + rb[i]; m2 = fmaxf(m2, fminf(m1, mv[i])); m1 = fmaxf(m1, mv[i]); }
            const float pm1 = dpp_f<DPP_XOR1>(m1), pm2 = dpp_f<DPP_XOR1>(m2);
            const float gs = fmaxf(m1, pm1) + fmaxf(fminf(m1, pm1), fmaxf(m2, pm2));
            int rank = 0;
#define RANK_STEP(N) { const float os = dpp_f<0x120 + (N)>(gs); const int og = dpp_i<0x120 + (N)>(g); rank += (os > gs || (os == gs && og < g)) ? 1 : 0; }
            RANK_STEP(2) RANK_STEP(4) RANK_STEP(6) RANK_STEP(8) RANK_STEP(10) RANK_STEP(12) RANK_STEP(14)
#undef RANK_STEP
            if (rank >= TOPG) {
#pragma unroll
                for (int i = 0; i < 16; ++i) mv[i] = NEG;
            }
            float wsel = 0.f, wsum = 0.f; int esel = 0;
#pragma unroll
            for (int k = 0; k < TOPK; ++k) {
                float bm = mv[0], bs = s[0]; int bi = 16 * j;
#pragma unroll
                for (int i = 1; i < 16; ++i) { const bool gt = mv[i] > bm; bm = gt ? mv[i] : bm; bs = gt ? s[i] : bs; bi = gt ? 16 * j + i : bi; }
#define ARG_STEP(CT) { const float om = dpp_f<CT>(bm), os = dpp_f<CT>(bs); const int oi = dpp_i<CT>(bi); const bool tk = (om > bm) || (om == bm && oi < bi); bm = tk ? om : bm; bs = tk ? os : bs; bi = tk ? oi : bi; }
                ARG_STEP(DPP_XOR1) ARG_STEP(DPP_XOR2) ARG_STEP(DPP_HMIR) ARG_STEP(DPP_MIR)
#undef ARG_STEP
#pragma unroll
                for (int i = 0; i < 16; ++i) mv[i] = (bi == 16 * j + i) ? NEG : mv[i];
                wsum += bs;
                if (j == k) { wsel = bs; esel = bi; }
            }
            if (j < TOPK) { eidx[t * 8 + j] = esel; gw[t * 8 + j] = wsel / wsum * ROUTED_SCALE; atomicAdd(hist + esel, 1); }
        }
        __syncthreads();
        if (c.tid < NE) { const int h = hist[c.tid];
            if (ATOMIC_BASE) { unsigned* counts = (unsigned*)(c.ws + WS_CTL) + CW_COUNTS; HIST[blk * NE + c.tid] = h ? (int)atomicAdd(counts + c.tid, (unsigned)h) : 0; }
            else HIST[blk * NE + c.tid] = h;
            hist[c.tid] = 0; }
        __syncthreads();
    }
}
template <bool INV>
__device__ __forceinline__ void ph_slot3(const Ctx& c, const Params& p) {
    const int* HIST = (const int*)(c.ws + WS_HIST);
    int* pc = (int*)c.lds; int* base = pc + 256; int* cnt = base + 257;
    const int* eidx = (const int*)(c.ws + WS_EIDX); const float* gw = (const float*)(c.ws + WS_GATEW);
    int* stok = (int*)(c.ws + WS_SLOT_TOK); int* sasg = (int*)(c.ws + WS_SLOT_ASG); float* sgate = (float*)(c.ws + WS_SLOT_GATE);
    for (int blk = c.bid; blk < T / 128; blk += c.nb) {
        int before = 0;
        if (c.tid < NE) { int tot = 0;
#pragma unroll 16
            for (int b2 = 0; b2 < T / 128; ++b2) { const int h = HIST[b2 * NE + c.tid]; tot += h; before += (b2 < blk) ? h : 0; }
            pc[c.tid] = (tot + 255) / 256 * 256; cnt[c.tid] = 0; }
        __syncthreads();
        if (c.tid <= NE) { int acc = 0; for (int e = 0; e < c.tid; ++e) acc += pc[e]; base[c.tid] = acc + (c.tid < NE ? before : 0); }
        __syncthreads();
        for (int i = c.tid; i < 128 * TOPK; i += NTHREADS_) {
            const int a = blk * 128 * TOPK + i, e = eidx[a]; const int pos = atomicAdd(cnt + e, 1); const int slot = base[e] + pos;
            stok[slot] = a >> 3; sasg[slot] = a; sgate[slot] = gw[a]; if (INV) ((int*)eidx)[a] = slot;
        }
        if (blk == 0) {
            int* te = (int*)(c.ws + WS_TILE_E);
            for (int e = c.tid; e < NE; e += NTHREADS_) for (int tl = base[e] / 256; tl < (base[e] + pc[e]) / 256; ++tl) te[tl] = e;
            if (c.tid == 0) ((unsigned*)(c.ws + WS_CTL))[CW_NTILES] = (unsigned)(base[NE] / 256);
        }
        __syncthreads();
    }
}
__device__ __forceinline__ void ph_slot5(const Ctx& c, const Params& p) {
    const int* HIST = (const int*)(c.ws + WS_HIST); const unsigned* counts = (const unsigned*)(c.ws + WS_CTL) + CW_COUNTS;
    int* pc = (int*)c.lds; int* base = pc + 256; int* cnt = base + 257; int* pst = cnt + 256;
    const int* eidx = (const int*)(c.ws + WS_EIDX); const float* gw = (const float*)(c.ws + WS_GATEW);
    int* stok = (int*)(c.ws + WS_SLOT_TOK); int* sasg = (int*)(c.ws + WS_SLOT_ASG); float* sgate = (float*)(c.ws + WS_SLOT_GATE);
    for (int blk = c.bid; blk < T / 128; blk += c.nb) {
        int before = 0;
        if (c.tid < NE) { pc[c.tid] = ((int)counts[c.tid] + 255) / 256 * 256; before = HIST[blk * NE + c.tid]; cnt[c.tid] = 0; }
        __syncthreads();
        if (c.tid <= NE) { int acc = 0; for (int e = 0; e < c.tid; ++e) acc += pc[e]; pst[c.tid] = acc; base[c.tid] = acc + before; }
        __syncthreads();
        for (int i = c.tid; i < 128 * TOPK; i += NTHREADS_) {
            const int a = blk * 128 * TOPK + i, e = eidx[a]; const int pos = atomicAdd(cnt + e, 1); const int slot = base[e] + pos;
            stok[slot] = a >> 3; sasg[slot] = a; sgate[slot] = gw[a]; ((int*)eidx)[a] = slot;
        }
        if (blk == 0) {
            int* te = (int*)(c.ws + WS_TILE_E);
            for (int e = c.tid; e < NE; e += NTHREADS_) for (int tl = pst[e] / 256; tl < (pst[e] + pc[e]) / 256; ++tl) te[tl] = e;
            if (c.tid == 0) ((unsigned*)(c.ws + WS_CTL))[CW_NTILES] = (unsigned)(pst[NE] / 256);
        }
        __syncthreads();
    }
}
__device__ __forceinline__ void ph_combine2(const Ctx& c, const Params& p) {
    const float* mod = (const float*)(c.ws + WS_MOD); const bf16_t* YA = (const bf16_t*)(c.ws + WS_YA); const bf16_t* YS = (const bf16_t*)(c.ws + WS_YSH); float* out = p.out;
    for (int t = c.gwave; t < T; t += c.gwaves) {
        const int b = t / SEQ;
        u32x4 y[9][2]; f32x4 xv[2][2], gv[2][2];
#pragma unroll
        for (int q = 0; q < 2; ++q) { const int col = q * 512 + c.lane * 8;
#pragma unroll
            for (int k = 0; k < 8; ++k) y[k][q] = *(const u32x4*)(YA + ((size_t)t * 8 + k) * DM + col);
            y[8][q] = *(const u32x4*)(YS + (size_t)t * DM + col);
            xv[q][0] = *(const f32x4*)(out + (size_t)t * DM + col); xv[q][1] = *(const f32x4*)(out + (size_t)t * DM + col + 4);
            gv[q][0] = *(const f32x4*)(mod + b * 6 * DM + 5 * DM + col); gv[q][1] = *(const f32x4*)(mod + b * 6 * DM + 5 * DM + col + 4); }
#pragma unroll
        for (int q = 0; q < 2; ++q) { const int col = q * 512 + c.lane * 8;
            f32x4 s0 = {0.f, 0.f, 0.f, 0.f}, s1 = {0.f, 0.f, 0.f, 0.f};
#pragma unroll
            for (int k = 0; k < 9; ++k) { const u32x4 w = y[k][q];
                s0[0] += __uint_as_float(w.x << 16); s0[1] += __uint_as_float(w.x & 0xffff0000u); s0[2] += __uint_as_float(w.y << 16); s0[3] += __uint_as_float(w.y & 0xffff0000u);
                s1[0] += __uint_as_float(w.z << 16); s1[1] += __uint_as_float(w.z & 0xffff0000u); s1[2] += __uint_as_float(w.w << 16); s1[3] += __uint_as_float(w.w & 0xffff0000u); }
            *(f32x4*)(out + (size_t)t * DM + col) = xv[q][0] + gv[q][0] * s0; *(f32x4*)(out + (size_t)t * DM + col + 4) = xv[q][1] + gv[q][1] * s1; }
    }
}
__device__ __forceinline__ void ph_combine3(const Ctx& c, const Params& p) {
    const float* mod = (const float*)(c.ws + WS_MOD); const bf16_t* YS = (const bf16_t*)(c.ws + WS_YS); const bf16_t* YH = (const bf16_t*)(c.ws + WS_YSH); float* out = p.out;
    const int* inv = (const int*)(c.ws + WS_EIDX);
    for (int t = c.gwave; t < T; t += c.gwaves) {
        const int b = t / SEQ;
        int sl[8];
#pragma unroll
        for (int k = 0; k < 8; ++k) sl[k] = inv[t * 8 + k];
        u32x4 y[9][2]; f32x4 xv[2][2], gv[2][2];
#pragma unroll
        for (int q = 0; q < 2; ++q) { const int col = q * 512 + c.lane * 8;
#pragma unroll
            for (int k = 0; k < 8; ++k) y[k][q] = *(const u32x4*)(YS + (size_t)sl[k] * DM + col);
            y[8][q] = *(const u32x4*)(YH + (size_t)t * DM + col);
            xv[q][0] = *(const f32x4*)(out + (size_t)t * DM + col); xv[q][1] = *(const f32x4*)(out + (size_t)t * DM + col + 4);
            gv[q][0] = *(const f32x4*)(mod + b * 6 * DM + 5 * DM + col); gv[q][1] = *(const f32x4*)(mod + b * 6 * DM + 5 * DM + col + 4); }
#pragma unroll
        for (int q = 0; q < 2; ++q) { const int col = q * 512 + c.lane * 8;
            f32x4 s0 = {0.f, 0.f, 0.f, 0.f}, s1 = {0.f, 0.f, 0.f, 0.f};
#pragma unroll
            for (int k = 0; k < 9; ++k) { const u32x4 w = y[k][q];
                s0[0] += __uint_as_float(w.x << 16); s0[1] += __uint_as_float(w.x & 0xffff0000u); s0[2] += __uint_as_float(w.y << 16); s0[3] += __uint_as_float(w.y & 0xffff0000u);
                s1[0] += __uint_as_float(w.z << 16); s1[1] += __uint_as_float(w.z & 0xffff0000u); s1[2] += __uint_as_float(w.w << 16); s1[3] += __uint_as_float(w.w & 0xffff0000u); }
            *(f32x4*)(out + (size_t)t * DM + col) = xv[q][0] + gv[q][0] * s0; *(f32x4*)(out + (size_t)t * DM + col + 4) = xv[q][1] + gv[q][1] * s1; }
    }
}
__device__ __forceinline__ void ph_combine4(const Ctx& c, const Params& p) {
    const float* mod = (const float*)(c.ws + WS_MOD); const unsigned char* YS = c.ws + WS_YS; const bf16_t* YH = (const bf16_t*)(c.ws + WS_YSH); float* out = p.out;
    const int* inv = (const int*)(c.ws + WS_EIDX);
    typedef float f32x2 __attribute__((ext_vector_type(2)));
    for (int t = c.gwave; t < T; t += c.gwaves) {
        const int b = t / SEQ, col = c.lane * 16;
        int sl[8];
#pragma unroll
        for (int k = 0; k < 8; ++k) sl[k] = inv[t * 8 + k];
        u32x4 y[8], yh[2]; f32x4 xv[4], gv[4];
#pragma unroll
        for (int k = 0; k < 8; ++k) y[k] = *(const u32x4*)(YS + (size_t)sl[k] * DM + col);
#pragma unroll
        for (int q = 0; q < 2; ++q) yh[q] = *(const u32x4*)(YH + (size_t)t * DM + col + 8 * q);
#pragma unroll
        for (int q = 0; q < 4; ++q) { xv[q] = *(const f32x4*)(out + (size_t)t * DM + col + 4 * q); gv[q] = *(const f32x4*)(mod + b * 6 * DM + 5 * DM + col + 4 * q); }
        float sacc[16];
#pragma unroll
        for (int i = 0; i < 16; ++i) sacc[i] = 0.f;
#pragma unroll
        for (int k = 0; k < 8; ++k) { const unsigned* wp = (const unsigned*)&y[k];
#pragma unroll
            for (int i = 0; i < 4; ++i) { const f32x2 lo = __builtin_amdgcn_cvt_pk_f32_fp8((int)wp[i], false), hi2 = __builtin_amdgcn_cvt_pk_f32_fp8((int)wp[i], true);
                sacc[4 * i] += lo[0]; sacc[4 * i + 1] += lo[1]; sacc[4 * i + 2] += hi2[0]; sacc[4 * i + 3] += hi2[1]; } }
#pragma unroll
        for (int q = 0; q < 2; ++q) { const unsigned* wp = (const unsigned*)&yh[q];
#pragma unroll
            for (int i = 0; i < 4; ++i) { sacc[8 * q + 2 * i] = sacc[8 * q + 2 * i] * (1.f / Y8_SCALE) + __uint_as_float(wp[i] << 16); sacc[8 * q + 2 * i + 1] = sacc[8 * q + 2 * i + 1] * (1.f / Y8_SCALE) + __uint_as_float(wp[i] & 0xffff0000u); } }
#pragma unroll
        for (int q = 0; q < 4; ++q) { f32x4 o = xv[q]; o[0] += gv[q][0] * sacc[4 * q]; o[1] += gv[q][1] * sacc[4 * q + 1]; o[2] += gv[q][2] * sacc[4 * q + 2]; o[3] += gv[q][3] * sacc[4 * q + 3];
            *(f32x4*)(out + (size_t)t * DM + col + 4 * q) = o; }
    }
}
__device__ __forceinline__ void ph_combine5(const Ctx& c, const Params& p) {
    const float* mod = (const float*)(c.ws + WS_MOD); const unsigned char* YS = c.ws + WS_YS; const bf16_t* YH = (const bf16_t*)(c.ws + WS_YSH); float* out = p.out;
    const int* inv = (const int*)(c.ws + WS_EIDX); const float* gwp = (const float*)(c.ws + WS_GATEW);
    typedef float f32x2 __attribute__((ext_vector_type(2)));
    for (int t = c.gwave; t < T; t += c.gwaves) {
        const int b = t / SEQ, col = c.lane * 16;
        int sl[8]; float gk[8];
#pragma unroll
        for (int k = 0; k < 8; ++k) { sl[k] = inv[t * 8 + k]; gk[k] = gwp[t * 8 + k]; }
        u32x4 y[8], yh[2]; f32x4 xv[4], gv[4];
#pragma unroll
        for (int k = 0; k < 8; ++k) y[k] = *(const u32x4*)(YS + (size_t)sl[k] * DM + col);
#pragma unroll
        for (int q = 0; q < 2; ++q) yh[q] = *(const u32x4*)(YH + (size_t)t * DM + col + 8 * q);
#pragma unroll
        for (int q = 0; q < 4; ++q) { xv[q] = *(const f32x4*)(out + (size_t)t * DM + col + 4 * q); gv[q] = *(const f32x4*)(mod + b * 6 * DM + 5 * DM + col + 4 * q); }
        float sacc[16];
#pragma unroll
        for (int i = 0; i < 16; ++i) sacc[i] = 0.f;
#pragma unroll
        for (int k = 0; k < 8; ++k) { const unsigned* wp = (const unsigned*)&y[k];
#pragma unroll
            for (int i = 0; i < 4; ++i) { const f32x2 lo = __builtin_amdgcn_cvt_pk_f32_fp8((int)wp[i], false), hi2 = __builtin_amdgcn_cvt_pk_f32_fp8((int)wp[i], true);
                sacc[4 * i] += gk[k] * lo[0]; sacc[4 * i + 1] += gk[k] * lo[1]; sacc[4 * i + 2] += gk[k] * hi2[0]; sacc[4 * i + 3] += gk[k] * hi2[1]; } }
#pragma unroll
        for (int q = 0; q < 2; ++q) { const unsigned* wp = (const unsigned*)&yh[q];
#pragma unroll
            for (int i = 0; i < 4; ++i) { sacc[8 * q + 2 * i] = sacc[8 * q + 2 * i] * (1.f / Y8_SCALE) + __uint_as_float(wp[i] << 16); sacc[8 * q + 2 * i + 1] = sacc[8 * q + 2 * i + 1] * (1.f / Y8_SCALE) + __uint_as_float(wp[i] & 0xffff0000u); } }
#pragma unroll
        for (int q = 0; q < 4; ++q) { f32x4 o = xv[q]; o[0] += gv[q][0] * sacc[4 * q]; o[1] += gv[q][1] * sacc[4 * q + 1]; o[2] += gv[q][2] * sacc[4 * q + 2]; o[3] += gv[q][3] * sacc[4 * q + 3];
            *(f32x4*)(out + (size_t)t * DM + col + 4 * q) = o; }
    }
}
__device__ __forceinline__ void cpowi(float ar, float ai, int n, float& pr, float& pi) { pr = 1.f; pi = 0.f; for (int i = 0; i < n; ++i) { const float t = pr * ar - pi * ai; pi = pr * ai + pi * ar; pr = t; } }
__device__ __forceinline__ void ph_ssm_gen(const Ctx& c, const Params& p) {
    const float* sp = (const float*)(c.ws + WS_SSMP);
    const float* bbr = sp + 2 * SG * SP, * bbi = bbr + SG * SP * SC; const float* PWg = (const float*)(c.ws + WS_SSMPW);
    bf16_t* BA = (bf16_t*)(c.ws + WS_SSM_BA); bf16_t* BC = (bf16_t*)(c.ws + WS_SSM_BC);
    float* Lpw = c.lds; float* Lbb = Lpw + SP * 34; float* Lcc = Lbb + SP * 32;
    for (int w = c.bid; w < SG * 8; w += c.nb) {
        const int g = w & 31, part = w >> 5;
        __syncthreads();
        for (int i = c.tid; i < SP * 34; i += NTHREADS_) Lpw[i] = PWg[(size_t)g * SP * 34 + i];
        for (int i = c.tid; i < SP * 16; i += NTHREADS_) { Lbb[2 * i] = bbr[g * SP * SC + i]; Lbb[2 * i + 1] = bbi[g * SP * SC + i]; }
        for (int i = c.tid; i < 16 * SP; i += NTHREADS_) { Lcc[2 * i] = p.in[I_CRE][g * SC * SP + i]; Lcc[2 * i + 1] = p.in[I_CIM][g * SC * SP + i]; }
        __syncthreads();
        bf16_t* baseC = BC + (size_t)g * 256 * APK; bf16_t* baseA = BA + (size_t)g * 256 * 256;
        { const int idx = part * 512 + c.tid, ci = idx & 15, co = (idx >> 4) & 15, d = idx >> 8;
          float kv = 0.f;
#pragma unroll 8
          for (int pp = 0; pp < SP; ++pp) { const float pr = Lpw[pp * 34 + 2 * d], pi = Lpw[pp * 34 + 2 * d + 1], br = Lbb[(pp * 16 + ci) * 2], bi = Lbb[(pp * 16 + ci) * 2 + 1];
              const float tr = pr * br - pi * bi, ti = pr * bi + pi * br;
              kv += Lcc[(co * SP + pp) * 2] * tr - Lcc[(co * SP + pp) * 2 + 1] * ti; }
          if (d == 0 && co == ci) kv += p.in[I_SD][g * SC + co];
          const bf16_t kb = f2bf(kv);
          for (int j = 0; j + d < 16; ++j) { baseC[((j + d) * 16 + co) * APK + j * 16 + ci] = kb; if (d > 0) baseC[(j * 16 + co) * APK + (j + d) * 16 + ci] = 0; } }
        for (int q = c.tid; q < 2048; q += NTHREADS_) { const int idx = part * 2048 + q;
            { const int pp = idx & 63, co = (idx >> 6) & 15, jp = idx >> 10;
              const float pr = Lpw[pp * 34 + 2 * (jp + 1)], pi = Lpw[pp * 34 + 2 * (jp + 1) + 1], cr = Lcc[(co * SP + pp) * 2], ci2 = Lcc[(co * SP + pp) * 2 + 1];
              bf16_t* row = baseC + (size_t)(jp * 16 + co) * APK + 256;
              row[pp] = f2bf(cr * pr - ci2 * pi); row[64 + pp] = f2bf(-(cr * pi + ci2 * pr)); }
            { const int ci = idx & 15, j = (idx >> 4) & 15, pp = idx >> 8;
              const float pr = Lpw[pp * 34 + 2 * (15 - j)], pi = Lpw[pp * 34 + 2 * (15 - j) + 1], br = Lbb[(pp * 16 + ci) * 2], bi = Lbb[(pp * 16 + ci) * 2 + 1];
              baseA[pp * 256 + j * 16 + ci] = f2bf(pr * br - pi * bi); baseA[(64 + pp) * 256 + j * 16 + ci] = f2bf(pr * bi + pi * br); } }
        for (int q = c.tid; q < 512; q += NTHREADS_) *(u32x4*)(baseA + 128 * 256 + (part * 512 + q) * 8) = (u32x4){0u, 0u, 0u, 0u};
    }
    __syncthreads();
}
__device__ __forceinline__ void ph_ssm_scan(const Ctx& c, const Params& p, int vcu) {
    const float* sp = (const float*)(c.ws + WS_SSMP); const float* abr = sp, * abi = sp + SG * SP;
    const float* DS = (const float*)(c.ws + WS_DS); bf16_t* AP = (bf16_t*)(c.ws + WS_AP);
    float* fw = c.lds;
    for (int it = vcu; it < NB * SG; it += c.nb) {
        const int g = it >> 3, b = it & 7, pp = c.lane, w = c.wave;
        const size_t r0 = (size_t)g * (NB * NCHUNK) + b * NCHUNK + 32 * w;
        float ar = abr[g * SP + pp], ai = abi[g * SP + pp];
#pragma unroll
        for (int i = 0; i < 4; ++i) { const float t = ar * ar - ai * ai; ai = 2.f * ar * ai; ar = t; }
        float lr[32], li[32];
#pragma unroll
        for (int i = 0; i < 32; ++i) { lr[i] = DS[(r0 + i) * 128 + pp]; li[i] = DS[(r0 + i) * 128 + 64 + pp]; }
#pragma unroll
        for (int i = 1; i < 32; ++i) { const float nr = ar * lr[i - 1] - ai * li[i - 1] + lr[i], ni = ar * li[i - 1] + ai * lr[i - 1] + li[i]; lr[i] = nr; li[i] = ni; }
        __syncthreads();
        fw[(w * 64 + pp) * 2] = lr[31]; fw[(w * 64 + pp) * 2 + 1] = li[31];
        __syncthreads();
        float a32r = ar, a32i = ai;
#pragma unroll
        for (int i = 0; i < 5; ++i) { const float t = a32r * a32r - a32i * a32i; a32i = 2.f * a32r * a32i; a32r = t; }
        float cr = 0.f, ci = 0.f;
        for (int w2 = 0; w2 < w; ++w2) { const float fr_ = fw[(w2 * 64 + pp) * 2], fi_ = fw[(w2 * 64 + pp) * 2 + 1];
            const float nr = a32r * cr - a32i * ci + fr_, ni = a32r * ci + a32i * cr + fi_; cr = nr; ci = ni; }
        bf16_t* row = AP + r0 * APK + 256 + pp;
#pragma unroll
        for (int i = 0; i < 32; ++i) {
            const float sr = cr + (i ? lr[i - 1] : 0.f), si = ci + (i ? li[i - 1] : 0.f);
            row[0] = f2bf(sr); row[64] = f2bf(si);
            row += APK; asm volatile("" : "+v"(row));
            const float nr = ar * cr - ai * ci, ni = ar * ci + ai * cr; cr = nr; ci = ni;
        }
    }
}

namespace att {
typedef short bf16x8 __attribute__((ext_vector_type(8)));
typedef short s16x4 __attribute__((ext_vector_type(4)));
typedef float f32x16 __attribute__((ext_vector_type(16)));
typedef float f32x2 __attribute__((ext_vector_type(2)));
constexpr int NW = 8, QBLK = 32, KVBLK = 64, QB = 128, NQB = SEQ / QB;
constexpr int KP = 1024, VP = 512;
constexpr int SHM_V = KVBLK * 128 * 2, SHM_K = KVBLK * 128 * 2;
constexpr int LDS_WS = 2 * SHM_V + 2 * SHM_K, LDS_EX = LDS_WS + NW * 64 * 4, LDS_END = LDS_EX + 4 * 16384;
#define KSWZ(row, colB) ((row) * 256 + ((colB) ^ (((row) & 7) << 4)))
#define SBAR() __builtin_amdgcn_sched_barrier(0)
__device__ __forceinline__ int v_st(int k, int c) { const int kk = (k & ~0xC) | ((k & 4) << 1) | ((k & 8) >> 1); return ((kk >> 3) * 4 + (c >> 5)) * 512 + ((kk & 7) * 32 + (c & 31)) * 2; }
__device__ __forceinline__ int v_rd_base(int lane) { return ((lane & 3) << 3) | (((lane >> 2) & 3) << 6) | (((lane >> 4) & 1) << 5) | (((lane >> 5) & 1) << 8); }
constexpr int v_rd_off(int d0, int ks, int half) { return d0 * 512 + ks * 4096 + half * 2048; }
__device__ __forceinline__ int crow(int r, int hi) { return (r & 3) + 8 * (r >> 2) + 4 * hi; }
__device__ __forceinline__ unsigned cvtpk(float lo, float hi) { unsigned r; asm volatile("v_cvt_pk_bf16_f32 %0, %1, %2" : "=v"(r) : "v"(lo), "v"(hi)); return r; }
__device__ __forceinline__ void mask_tile(f32x16& p0, f32x16& p1, int dq) {
    const float NEG = -__builtin_inff();
#pragma unroll
    for (int r = 0; r < 16; ++r) { const int c = (r & 3) + 8 * (r >> 2); if (dq - c < 0) p0[r] = NEG; if (dq - c - 32 < 0) p1[r] = NEG; }
}
template <bool ZC>
__device__ __forceinline__ void partialSM(f32x16& p0, f32x16& p1, float C2, float negM) {
    if constexpr (!ZC) {
#pragma unroll
        for (int r = 0; r < 16; ++r) { p0[r] += negM; p1[r] += negM; } }
#pragma unroll
    for (int r = 0; r < 16; ++r) p0[r] = __builtin_amdgcn_exp2f(p0[r]);
}
__device__ __forceinline__ void finishSM(f32x16& p0, f32x16& p1, float& l_reg, bf16x8& pa0, bf16x8& pa1, bf16x8& pa2, bf16x8& pa3) {
#pragma unroll
    for (int r = 0; r < 16; ++r) p1[r] = __builtin_amdgcn_exp2f(p1[r]);
    float ps = 0;
#pragma unroll
    for (int r = 0; r < 16; ++r) ps += p0[r];
#pragma unroll
    for (int r = 0; r < 16; ++r) ps += p1[r];
    { auto rr = __builtin_amdgcn_permlane32_swap(__float_as_uint(ps), __float_as_uint(ps), false, false); ps = __uint_as_float(rr[0]) + __uint_as_float(rr[1]); }
    l_reg += ps;
#define PK4(P, B_, OUT) do { unsigned a0 = cvtpk(P[B_+0], P[B_+1]), a1 = cvtpk(P[B_+2], P[B_+3]);                          \
        unsigned b0 = cvtpk(P[B_+4], P[B_+5]), b1 = cvtpk(P[B_+6], P[B_+7]);                                             \
        auto r0 = __builtin_amdgcn_permlane32_swap(a0, b0, false, false); auto r1 = __builtin_amdgcn_permlane32_swap(a1, b1, false, false); \
        u32x4 w = {r0[0], r1[0], r0[1], r1[1]}; OUT = *reinterpret_cast<bf16x8*>(&w); } while (0)
    PK4(p0, 0, pa0); PK4(p0, 8, pa1); PK4(p1, 0, pa2); PK4(p1, 8, pa3);
#undef PK4
}
template <int KB>
__device__ __forceinline__ void qkt(f32x16& p0, f32x16& p1, const char* K_lds, int r32, int hi, const bf16x8* qr, int cc) {
    p0 = f32x16{}; p1 = f32x16{};
    const char* kb[4];
#pragma unroll
    for (int dd = 0; dd < 4; ++dd) kb[dd] = K_lds + KB * SHM_K + KSWZ(r32, (dd * 16 + hi * 8) * 2) + cc * 128;
#pragma unroll
    for (int d0 = 0; d0 < 4; ++d0) { const char* a = kb[d0];
        bf16x8 b0 = *reinterpret_cast<const bf16x8*>(a);
        bf16x8 b1 = *reinterpret_cast<const bf16x8*>(a + 32 * 256);
        p0 = __builtin_amdgcn_mfma_f32_32x32x16_bf16(b0, qr[d0], p0, 0, 0, 0);
        p1 = __builtin_amdgcn_mfma_f32_32x32x16_bf16(b1, qr[d0], p1, 0, 0, 0); }
}
template <int VB>
__device__ __forceinline__ void pv_tile(f32x16* o, int vb0, bf16x8 pa0, bf16x8 pa1, bf16x8 pa2, bf16x8 pa3) {
#define TRRD(dst, off) asm volatile("ds_read_b64_tr_b16 %0, %1 offset:%2" : "=&v"(dst) : "v"(vb0), "i"(off) : "memory")
#define PV_D0(d0) do { s16x4 l0, l1, l2, l3, h0, h1, h2, h3; constexpr int b_ = VB * SHM_V + v_rd_off(d0, 0, 0); \
        TRRD(l0, b_); TRRD(h0, b_ + 2048); TRRD(l1, b_ + 4096); TRRD(h1, b_ + 6144); TRRD(l2, b_ + 8192); TRRD(h2, b_ + 10240); TRRD(l3, b_ + 12288); TRRD(h3, b_ + 14336); \
        asm volatile("s_waitcnt lgkmcnt(0)" ::: "memory"); SBAR();   \
        o[d0] = __builtin_amdgcn_mfma_f32_32x32x16_bf16(pa0, (bf16x8){l0[0], l0[1], l0[2], l0[3], h0[0], h0[1], h0[2], h0[3]}, o[d0], 0, 0, 0);   \
        o[d0] = __builtin_amdgcn_mfma_f32_32x32x16_bf16(pa1, (bf16x8){l1[0], l1[1], l1[2], l1[3], h1[0], h1[1], h1[2], h1[3]}, o[d0], 0, 0, 0);   \
        o[d0] = __builtin_amdgcn_mfma_f32_32x32x16_bf16(pa2, (bf16x8){l2[0], l2[1], l2[2], l2[3], h2[0], h2[1], h2[2], h2[3]}, o[d0], 0, 0, 0);   \
        o[d0] = __builtin_amdgcn_mfma_f32_32x32x16_bf16(pa3, (bf16x8){l3[0], l3[1], l3[2], l3[3], h3[0], h3[1], h3[2], h3[3]}, o[d0], 0, 0, 0); } while (0)
    PV_D0(0); PV_D0(1); PV_D0(2); PV_D0(3);
#undef PV_D0
#undef TRRD
}
struct BlockRef { const bf16_t* Q; const bf16_t* K; const bf16_t* V; bf16_t* O; int P0; };
struct Seam { bf16x8 qr[4]; bf16x8 st_v0, st_v1, st_k0, st_k1; };
#define ROWK(p, k0, rr) ((p) + (size_t)((k0) + (rr)) * KP + sc)
#define ROWV(p, k0, rr) ((p) + (size_t)((k0) + (rr)) * VP + sc)
#define LD8(ptr) (*reinterpret_cast<const bf16x8*>(ptr))
#define VMW() asm volatile("s_waitcnt vmcnt(0)" ::: "memory")
#define VMWN(n) asm volatile("s_waitcnt vmcnt(%0)" :: "i"(n) : "memory")
#define SLOAD_H(Kp, Vp, k0) do { S.st_v0 = LD8(ROWV(Vp, k0, sr)); S.st_v1 = LD8(ROWV(Vp, k0, 32 + sr)); S.st_k0 = LD8(ROWK(Kp, k0, sr)); S.st_k1 = LD8(ROWK(Kp, k0, 32 + sr)); } while (0)
#define SWRITE_HK(bf) do { *(bf16x8*)(K_lds + (bf) * SHM_K + kws) = S.st_k0; *(bf16x8*)(K_lds + (bf) * SHM_K + kws + 32 * 256) = S.st_k1; } while (0)
#define SWRITE_HV(bf) do { *(bf16x8*)(V_lds + (bf) * SHM_V + vst0) = S.st_v0; *(bf16x8*)(V_lds + (bf) * SHM_V + vst1) = S.st_v1; } while (0)
#define SWRITE_H(bf) do { SWRITE_HV(bf); SWRITE_HK(bf); } while (0)
#define QLOAD(ref) do { _Pragma("unroll") for (int d0 = 0; d0 < 4; ++d0) S.qr[d0] = LD8((ref).Q + (size_t)(qi * QBLK + r32) * KP + cc * 64 + d0 * 16 + hi * 8); } while (0)
__device__ __forceinline__ void prime(const BlockRef& cur, char* lds, Seam& S, int tid) {
    const int  wid = __builtin_amdgcn_readfirstlane(tid >> 6), lane = tid & 63, r32 = lane & 31, hi = lane >> 5, qi = wid >> 1, cc = wid & 1;
    const int sr = tid >> 4, sc = (tid & 15) * 8, kws = KSWZ(sr, sc * 2); char* K_lds = lds + 2 * SHM_V;
    QLOAD(cur);
    SLOAD_H(cur.K, cur.V, 0); VMW(); SWRITE_HK(0);
    __syncthreads();
}
template <bool ZC>
__device__ __forceinline__ void block(const BlockRef& cur, const BlockRef& nxt, char* lds, Seam& S, float lam, float smax, const float* subg, bool lastblk, int tid) {
    const int  wid = __builtin_amdgcn_readfirstlane(tid >> 6), lane = tid & 63, r32 = lane & 31, hi = lane >> 5, qi = wid >> 1, cc = wid & 1;
    const int NT = cur.P0 / KVBLK + 2;
    const int qlo = cur.P0 + qi * QBLK, qm = qlo + r32 - 4 * hi;
    char* V_lds = lds; char* K_lds = lds + 2 * SHM_V;
    float* wsf = (float*)(lds + LDS_WS) + wid * 64; float* li_l = wsf;
    float* exch = (float*)(lds + LDS_EX) + qi * 4096;
    float l_reg = 0; f32x16 o[4] = {};
    const int sr = tid >> 4, sc = (tid & 15) * 8, vst0 = v_st(sr, sc), vst1 = v_st(32 + sr, sc), kws = KSWZ(sr, sc * 2);
    const int vb0 = (int)(uintptr_t)V_lds + v_rd_base(lane);
    const bf16_t* Kh = cur.K; const bf16_t* Vh = cur.V;
    constexpr float C2 = 1.4426950408889634f * 0.125f; const float negM = -smax * 1.4426950408889634f;
#define KBASE(t) ((t) * KVBLK)
#define MASKT(P0_, P1_, t) do { const int kb_ = KBASE(t); if (kb_ + KVBLK - 1 > qlo) mask_tile(P0_, P1_, qm - kb_); } while (0)
    f32x16 pA0, pA1, pB0, pB1; bf16x8 pa0, pa1, pa2, pa3;
    SWRITE_HV(0); SBAR();
    SLOAD_H(Kh, Vh, KBASE(1));
    SBAR(); qkt<0>(pA0, pA1, K_lds, r32, hi, S.qr, cc);
    MASKT(pA0, pA1, 0); partialSM<ZC>(pA0, pA1, C2, negM);
    VMW(); SWRITE_H(1);
    __syncthreads();
#define HALF_STEP(PX0, PX1, PY0, PY1, t, KB, VB, SB) do {                                                      \
        SBAR(); qkt<KB>(PX0, PX1, K_lds, r32, hi, S.qr, cc);                                                  \
        finishSM(PY0, PY1, l_reg, pa0, pa1, pa2, pa3); SBAR();                                                \
        if ((t) + 1 < NT) { SLOAD_H(Kh, Vh, KBASE((t) + 1)); SBAR(); }                                        \
        pv_tile<VB>(o, vb0, pa0, pa1, pa2, pa3); MASKT(PX0, PX1, (t)); partialSM<ZC>(PX0, PX1, C2, negM);          \
        __syncthreads();                                                                                       \
        if ((t) + 1 < NT) { VMW(); SWRITE_H(SB); }                                                             \
        __syncthreads(); } while (0)
    for (int t = 1; t + 1 < NT; t += 2) {
        HALF_STEP(pB0, pB1, pA0, pA1, t, 1, 0, 0);
        HALF_STEP(pA0, pA1, pB0, pB1, t + 1, 0, 1, 1);
    }
    SBAR(); qkt<1>(pB0, pB1, K_lds, r32, hi, S.qr, cc); SBAR();
    SLOAD_H(nxt.K, nxt.V, 0); SBAR();
    QLOAD(nxt);
    SBAR();
    finishSM(pA0, pA1, l_reg, pa0, pa1, pa2, pa3); SBAR();
    pv_tile<0>(o, vb0, pa0, pa1, pa2, pa3);
    MASKT(pB0, pB1, NT - 1); partialSM<ZC>(pB0, pB1, C2, negM); __syncthreads();
    finishSM(pB0, pB1, l_reg, pa0, pa1, pa2, pa3); SBAR(); pv_tile<1>(o, vb0, pa0, pa1, pa2, pa3);
    SBAR(); VMWN(4); SWRITE_HK(0); SBAR();
    if (hi == 0) li_l[r32] = l_reg; asm volatile("s_waitcnt lgkmcnt(0)" ::: "memory");
    float rli[16];
#pragma unroll
    for (int r = 0; r < 16; ++r) rli[r] = __builtin_amdgcn_rcpf(li_l[crow(r, hi)]) * (cc ? lam : 1.f);
#pragma unroll
    for (int d0 = 0; d0 < 4; ++d0)
#pragma unroll
        for (int r = 0; r < 16; ++r) o[d0][r] *= rli[r];
    if (cc == 1) {
#pragma unroll
        for (int d0 = 0; d0 < 4; ++d0)
#pragma unroll
            for (int r = 0; r < 16; ++r) exch[(d0 * 16 + r) * 64 + lane] = o[d0][r];
    }
    __syncthreads();
    if (cc == 0) {
        float gsub[4];
#pragma unroll
        for (int d0 = 0; d0 < 4; ++d0) gsub[d0] = subg[d0 * 32 + r32] * (1.f - LAM_INIT);
        bf16_t* Ow = cur.O + (size_t)(qi * QBLK) * KP;
#pragma unroll
        for (int r = 0; r < 16; ++r) {
            float ss = 0.f;
#pragma unroll
            for (int d0 = 0; d0 < 4; ++d0) { o[d0][r] -= exch[(d0 * 16 + r) * 64 + lane]; ss += o[d0][r] * o[d0][r]; }
#pragma unroll
            for (int of = 1; of < 32; of <<= 1) ss += __shfl_xor(ss, of);
            const float rstd = rsqrtf(ss * (1.f / 128.f) + EPS); const int orow = crow(r, hi);
#pragma unroll
            for (int d0 = 0; d0 < 4; ++d0) { const float v = o[d0][r] * rstd * gsub[d0]; const float vn = __shfl_xor(v, 1);
                if ((r32 & 1) == 0) *(unsigned*)(Ow + (size_t)orow * KP + d0 * 32 + r32) = cvtpk(v, vn); }
        }
    }
    if (lastblk) __syncthreads();
#undef KBASE
#undef MASKT
#undef HALF_STEP
}
template <bool ZC = false>
__device__ __forceinline__ void phase(char* lds, const bf16_t* QKb, const bf16_t* Vb, bf16_t* MX, float lam, float smax, const float* subg, int G, int vcu, int L0 = -1, int Lend = 1 << 30) {
    constexpr int NX = NQB / 2; const int TOTAL = (NB * NH * NX) < Lend ? (NB * NH * NX) : Lend;
    int L = L0 < 0 ? vcu : L0; if (L >= TOTAL) return;
    int pass = 0;
#define MKREF(ref, LL, ps) do { const int bh_ = (LL) / NX, x_ = (LL) % NX, qb_ = (ps) ? (NQB - 1 - x_) : x_, b_ = bh_ / NH, h_ = bh_ % NH; \
        const size_t row0_ = (size_t)b_ * SEQ; (ref).P0 = qb_ * QB; \
        (ref).Q = QKb + (row0_ + qb_ * QB) * KP + h_ * 128; (ref).K = QKb + row0_ * KP + 512 + h_ * 128; (ref).V = Vb + row0_ * VP + h_ * 128; \
        (ref).O = MX + (row0_ + qb_ * QB) * KP + h_ * 128; } while (0)
    BlockRef cur, nxt; MKREF(cur, L, 0);
    Seam S;
    int tid_ = threadIdx.x; asm volatile("" : "+v"(tid_));
    prime(cur, lds, S, tid_);
    for (;;) {
        const bool more_pass = pass == 0, more_item = L + G < TOTAL, last = !more_pass && !more_item;
        int passn = pass + 1, Ln = L;
        if (!more_pass) { passn = 0; Ln = more_item ? L + G : L; }
        if (last) nxt = cur; else MKREF(nxt, Ln, passn);
        block<ZC>(cur, nxt, lds, S, lam, smax, subg, last, tid_);
        if (last) break;
        cur = nxt; pass = passn; L = Ln;
    }
#undef MKREF
}
__device__ __forceinline__ void phase_queue(char* lds, const bf16_t* QKb, const bf16_t* Vb, bf16_t* MX, float lam, float smax, const float* subg, unsigned* qctr, int xg) {
    constexpr int TOTAL = NB * NH * NQB / 8;
    volatile int* tk = (volatile int*)(lds + LDS_END);
#define MKREFQ(ref, kk) do { const int hf_ = (kk) >> 6, k6_ = (kk) & 63, bh_ = 4 * xg + 2 * hf_ + (k6_ & 1), qb_ = NQB - 1 - (k6_ >> 1), b_ = bh_ / NH, h_ = bh_ % NH; \
        const size_t row0_ = (size_t)b_ * SEQ; (ref).P0 = qb_ * QB; \
        (ref).Q = QKb + (row0_ + qb_ * QB) * KP + h_ * 128; (ref).K = QKb + row0_ * KP + 512 + h_ * 128; (ref).V = Vb + row0_ * VP + h_ * 128; \
        (ref).O = MX + (row0_ + qb_ * QB) * KP + h_ * 128; } while (0)
    if (threadIdx.x == 0) { tk[0] = (int)atomicAdd(qctr, 1u); tk[1] = (int)atomicAdd(qctr, 1u); }
    __syncthreads();
    int tc = tk[0];
    if (tc >= TOTAL) { __syncthreads(); return; }
    BlockRef cur, nxt; MKREFQ(cur, tc);
    Seam S;
    int tid_ = threadIdx.x; asm volatile("" : "+v"(tid_));
    prime(cur, lds, S, tid_);
    for (int i = 0;; ++i) {
        const int tn = tk[(i + 1) & 1];
        if (threadIdx.x == 0) tk[i & 1] = (int)atomicAdd(qctr, 1u);
        const bool last = tn >= TOTAL;
        if (last) nxt = cur; else MKREFQ(nxt, tn);
        block<false>(cur, nxt, lds, S, lam, smax, subg, last, tid_);
        if (last) break;
        cur = nxt;
    }
    __syncthreads();
#undef MKREFQ
}
#undef ROWK
#undef ROWV
#undef LD8
#undef VMW
#undef VMWN
#undef SLOAD_H
#undef SWRITE_HK
#undef SWRITE_HV
#undef SWRITE_H
#undef QLOAD
#undef KSWZ
#undef SBAR
}


enum { PH_PRO = 0, PH_H1, PH_WIN, PH_WIN_F, PH_QKN, PH_ATT, PH_ATTC, PH_SSM, PH_GLU, PH_NORM, PH_WOUT, PH_WOUT_F, PH_H2, PH_RS, PH_RS2, PH_RS_F, PH_SD, PH_ROUTE, PH_SLOT, PH_E1, PH_E1_F, PH_E2, PH_COMB, PH_M_B, PH_M_D, PH_NORM2, PH_H2_2, PH_M_J2, PH_X1, PH_X2, PH_M_A2, PH_M_E3, PH_SLOT4, PH_E2S_F, PH_COMB3, PH_M_E4, PH_H2_3, PH_E1_8, PH_M_E5, PH_E1_88, PH_E2_8, PH_COMB4, PH_E2_B8, PH_E1_G8, PH_E2_P8, PH_M_J3, PH_SLOT5, PH_COMB5, PH_M_E6, PH_COUNT };
constexpr int NTHREADS = 512;
constexpr int LDS_BYTES = 147456;
constexpr int LDS_MISC_OFF = 147456 - 256;
typedef unsigned long long mask_t;
#define PHBIT(k) (1ull << (k))

template <mask_t MASK>
__global__ void __launch_bounds__(NTHREADS, 2) mega(Params p) {
    extern __shared__ __attribute__((aligned(16))) unsigned char lds_raw[];
#define MAKE_CTX() Ctx c; { int t_ = threadIdx.x; asm volatile("" : "+v"(t_)); c.tid = t_; c.lane = c.tid & 63; c.wave = __builtin_amdgcn_readfirstlane(c.tid >> 6); c.bid = blockIdx.x; c.nb = gridDim.x; \
    c.gtid = c.bid * NTHREADS + c.tid; c.gthreads = c.nb * NTHREADS; c.gwave = c.bid * (NTHREADS / 64) + c.wave; c.gwaves = c.nb * (NTHREADS / 64); c.ws = p.ws; c.lds = (float*)lds_raw; }
    unsigned char* ws = p.ws;
    PG8_LAS unsigned char* lds3 = (PG8_LAS unsigned char*)lds_raw;
    const int G = gridDim.x, bid = blockIdx.x, vcu = (G % 8 == 0) ? (bid % 8) * (G / 8) + bid / 8 : bid;
    constexpr bool MULTI = (MASK & (MASK - 1)) != 0;
    XcdBarrier bar; bar.bar = (unsigned*)(ws + WS_CTL) + CW_BAR; bar.x = 0; bar.st = nullptr;
    if constexpr (MULTI) {
        volatile LAS unsigned* misc = (volatile LAS unsigned*)(lds3 + LDS_MISC_OFF);
        if (threadIdx.x < 32) misc[threadIdx.x] = 0u;
        __syncthreads();
        bar = xcd_barrier_post((unsigned*)(ws + WS_CTL) + CW_BAR, misc + 8);
    }
    bool first = true;
#ifndef TIME_A
#define TIME_A -1
#endif
#ifndef TIME_B
#define TIME_B -1
#endif
#ifndef TIME_Q
#define TIME_Q 800
#endif
    constexpr bool TIMING = (TIME_A >= 0) || (TIME_B >= 0);
    unsigned long long tstart = 0, t_a = 0, t_b = 0; int pidx = 0;
#define STAMP() ({ if constexpr (TIMING) { const unsigned long long now_ = __builtin_amdgcn_s_memrealtime(); \
        if (pidx > 0 && pidx - 1 == TIME_A) t_a = now_ - tstart; if (pidx > 0 && pidx - 1 == TIME_B) t_b = now_ - tstart; tstart = now_; ++pidx; } true; })
#define PHASE(k) if constexpr ((MASK >> (k)) & 1ull) if ((MULTI ? (first ? (first = false, true) : (xcd_barrier(bar), true)) : true)) if (STAMP())
    PHASE(PH_PRO) { MAKE_CTX(); ph_prologue(c, p); }
    PHASE(PH_M_A2) { MAKE_CTX(); ph_prologue2(c, p); ph_convert<false>(c, p); }
    PHASE(PH_H1) { MAKE_CTX(); ph_h1(c, p); }
    PHASE(PH_M_B) { MAKE_CTX(); ph_h1(c, p); ph_ssm_gen(c, p); }
    PHASE(PH_WIN) { MAKE_CTX(); SG_Args g{(const bf16_t*)(ws + WS_H), DM, nullptr, p.in[I_WIN], nullptr, 2048, 0, nullptr, T, 2048, DM};
        EpiWin E{(bf16_t*)(ws + WS_QK), (bf16_t*)(ws + WS_V), (bf16_t*)(ws + WS_AP)}; sgemm_phase<false>(c, g, E); }
    PHASE(PH_WIN_F) { MAKE_CTX(); pg8::Gemm g{(const bf16_t*)(ws + WS_H), (const bf16_t*)(ws + WS_WIN_T), DM, DM, nullptr}; pg8::DenseOrder S; S.init(T, 2048, G, bid);
        pg8::EpiWinF E{(bf16_t*)(ws + WS_QK), (bf16_t*)(ws + WS_V), (bf16_t*)(ws + WS_AP)}; pg8::gemm_phase<pg8::EpiWinF, pg8::DenseOrder, false, true>(lds3, g, S, E); }
    PHASE(PH_QKN) { MAKE_CTX(); ph_qkn(c, p); }
    PHASE(PH_M_D) { { MAKE_CTX(); ph_qkn2(c, p); }
        { pg8::Gemm g{(const bf16_t*)(ws + WS_AP), (const bf16_t*)(ws + WS_SSM_BA), 256, APK, nullptr}; pg8::SsmOrder S{G, vcu};
          pg8::EpiSsmA E{(float*)(ws + WS_DS)}; pg8::gemm_phase<pg8::EpiSsmA, pg8::SsmOrder, false, false>(lds3, g, S, E); }
        __builtin_amdgcn_fence(__ATOMIC_ACQUIRE, "agent"); asm volatile("s_waitcnt vmcnt(0)" ::: "memory"); __syncthreads();
        { MAKE_CTX(); ph_ssm_scan(c, p, vcu); }
        asm volatile("s_waitcnt vmcnt(0)" ::: "memory"); __syncthreads(); __builtin_amdgcn_fence(__ATOMIC_ACQUIRE, "agent"); asm volatile("s_waitcnt vmcnt(0)" ::: "memory"); __syncthreads();
        { pg8::Gemm g{(const bf16_t*)(ws + WS_AP), (const bf16_t*)(ws + WS_SSM_BC), APK, APK, nullptr}; pg8::SsmOrder S{G, vcu};
          pg8::EpiSsmC E{(bf16_t*)(ws + WS_Y)}; pg8::gemm_phase<pg8::EpiSsmC, pg8::SsmOrder, false, false>(lds3, g, S, E); } }
    PHASE(PH_ATT) { MAKE_CTX(); ph_att_base(c, p); }
    PHASE(PH_ATTC) { MAKE_CTX(); ph_att_comb(c, p); }
    PHASE(PH_SSM) { MAKE_CTX(); ph_ssm_base(c, p); }
    PHASE(PH_M_E3) { { constexpr int GU8E = 0; MAKE_CTX(); const float* lamp = (const float*)(ws + WS_LAM); const float lam_ = lamp[0], smax_ = lamp[1];
          float* scr = c.lds + c.wave * (64 * 65);
          const int grp = vcu & 3;
          const unsigned prog = grp == 0 ? 0x0213u : grp == 1 ? 0x0231u : grp == 2 ? 0x0321u : 0x2514u;
          for (int step = 0; step < 4; ++step) {
              const int code = (int)((prog >> (4 * step)) & 15u);
              if (code == 1 || code == 2) { const int i_ = code - 1;
                  att::phase((char*)lds_raw, (const bf16_t*)(ws + WS_QK), (const bf16_t*)(ws + WS_V), (bf16_t*)(ws + WS_MIXIN), lam_, smax_, p.in[I_SUBG], G, vcu, vcu + i_ * G, vcu + i_ * G + 1); }
              else if (code >= 3) { const int lo = code == 5 ? 96 : 0, hi = code == 4 ? 96 : 192;
                  conv_range<GU8E>(c, p, vcu * 192 + lo + c.wave, vcu * 192 + hi, 8, scr); }
              __syncthreads();
          }
        }
        { pg8::Gemm g{(const bf16_t*)(ws + WS_Y), (const bf16_t*)(ws + WS_WGLU_T), 512, 512, nullptr}; pg8::DenseOrder S; S.init(T, 512, G, bid);
          pg8::EpiGluF E{(const bf16_t*)(ws + WS_Y), (bf16_t*)(ws + WS_MIXIN), (float*)(ws + WS_SS1P)}; pg8::gemm_phase<pg8::EpiGluF, pg8::DenseOrder, false, true>(lds3, g, S, E); } }
    PHASE(PH_M_E4) { { constexpr int GU8E = 1; MAKE_CTX(); const float* lamp = (const float*)(ws + WS_LAM); const float lam_ = lamp[0], smax_ = lamp[1];
          float* scr = c.lds + c.wave * (64 * 65);
          const int grp = vcu & 3;
          const unsigned prog = grp == 0 ? 0x0213u : grp == 1 ? 0x0231u : grp == 2 ? 0x0321u : 0x2514u;
          for (int step = 0; step < 4; ++step) {
              const int code = (int)((prog >> (4 * step)) & 15u);
              if (code == 1 || code == 2) { const int i_ = code - 1;
                  att::phase((char*)lds_raw, (const bf16_t*)(ws + WS_QK), (const bf16_t*)(ws + WS_V), (bf16_t*)(ws + WS_MIXIN), lam_, smax_, p.in[I_SUBG], G, vcu, vcu + i_ * G, vcu + i_ * G + 1); }
              else if (code >= 3) { const int lo = code == 5 ? 96 : 0, hi = code == 4 ? 96 : 192;
                  conv_range<GU8E>(c, p, vcu * 192 + lo + c.wave, vcu * 192 + hi, 8, scr); }
              __syncthreads();
          }
        }
        { pg8::Gemm g{(const bf16_t*)(ws + WS_Y), (const bf16_t*)(ws + WS_WGLU_T), 512, 512, nullptr}; pg8::DenseOrder S; S.init(T, 512, G, bid);
          pg8::EpiGluF E{(const bf16_t*)(ws + WS_Y), (bf16_t*)(ws + WS_MIXIN), (float*)(ws + WS_SS1P)}; pg8::gemm_phase<pg8::EpiGluF, pg8::DenseOrder, false, true>(lds3, g, S, E); } }
    PHASE(PH_M_E5) { { constexpr int GU8E = 2; MAKE_CTX(); const float* lamp = (const float*)(ws + WS_LAM); const float lam_ = lamp[0], smax_ = lamp[1];
          float* scr = c.lds + c.wave * (64 * 65);
          const int grp = vcu & 3;
          const unsigned prog = grp == 0 ? 0x0213u : grp == 1 ? 0x0231u : grp == 2 ? 0x0321u : 0x2514u;
#define E5_STEPS(ZC_) \
          for (int step = 0; step < 4; ++step) { \
              const int code = (int)((prog >> (4 * step)) & 15u); \
              if (code == 1 || code == 2) { const int i_ = code - 1; \
                  att::phase<ZC_>((char*)lds_raw, (const bf16_t*)(ws + WS_QK), (const bf16_t*)(ws + WS_V), (bf16_t*)(ws + WS_MIXIN), lam_, smax_, p.in[I_SUBG], G, vcu, vcu + i_ * G, vcu + i_ * G + 1); } \
              else if (code >= 3) { const int lo = code == 5 ? 96 : 0, hi = code == 4 ? 96 : 192; \
                  conv_range<GU8E>(c, p, vcu * 192 + lo + c.wave, vcu * 192 + hi, 8, scr); } \
              __syncthreads(); \
          }
          if (smax_ * 1.4426950408889634f <= 64.f) { E5_STEPS(true); }
          else { E5_STEPS(false); }
#undef E5_STEPS
        }
        { pg8::Gemm g{(const bf16_t*)(ws + WS_Y), (const bf16_t*)(ws + WS_WGLU_T), 512, 512, nullptr}; pg8::DenseOrder S; S.init(T, 512, G, bid);
          pg8::EpiGluF E{(const bf16_t*)(ws + WS_Y), (bf16_t*)(ws + WS_MIXIN), (float*)(ws + WS_SS1P)}; pg8::gemm_phase<pg8::EpiGluF, pg8::DenseOrder, false, true>(lds3, g, S, E); } }
    PHASE(PH_GLU) { MAKE_CTX(); SG_Args g{(const bf16_t*)(ws + WS_Y), 512, nullptr, p.in[I_WGLU], nullptr, 512, 0, nullptr, T, 512, 512};
        EpiGlu E{(const bf16_t*)(ws + WS_Y), (bf16_t*)(ws + WS_MIXIN), (float*)(ws + WS_CTL + CTL_SS1)}; sgemm_phase<false>(c, g, E); }
    PHASE(PH_NORM) { MAKE_CTX(); ph_ssm_norm(c, p); }
    PHASE(PH_NORM2) { MAKE_CTX(); ph_ssm_norm2(c, p); }
    PHASE(PH_WOUT) { MAKE_CTX(); SG_Args g{(const bf16_t*)(ws + WS_MIXIN), DM, nullptr, p.in[I_WOUT], nullptr, DM, 0, nullptr, T, DM, DM};
        EpiWout E{p.in[I_X], (const float*)(ws + WS_MOD), p.out, (float*)(ws + WS_CTL + CTL_SS2)}; sgemm_phase<false>(c, g, E); }
    PHASE(PH_WOUT_F) { MAKE_CTX(); pg8::Gemm g{(const bf16_t*)(ws + WS_MIXIN), (const bf16_t*)(ws + WS_WOUT_T), DM, DM, nullptr}; pg8::DenseOrder S; S.init(T, DM, G, bid);
        pg8::EpiWoutF E{p.in[I_X], (const float*)(ws + WS_MOD), p.out, (float*)(ws + WS_SS2P)}; pg8::gemm_phase<pg8::EpiWoutF, pg8::DenseOrder, false, true>(lds3, g, S, E); }
    PHASE(PH_H2) { MAKE_CTX(); ph_h2(c, p); }
    PHASE(PH_H2_2) { MAKE_CTX(); ph_h2_2(c, p); }
    PHASE(PH_H2_3) { MAKE_CTX(); ph_h2_3(c, p); }
    PHASE(PH_RS) { MAKE_CTX(); SG_Args g{(const bf16_t*)(ws + WS_H), DM, nullptr, p.in[I_WR], nullptr, 256, 0, nullptr, T, 256, DM};
        EpiLogits E{(float*)(ws + WS_LOGITS)}; sgemm_phase<false>(c, g, E); }
    PHASE(PH_RS2) { MAKE_CTX(); SG_Args g2{(const bf16_t*)(ws + WS_H), DM, nullptr, p.in[I_WGS], p.in[I_WUS], 256, 0, nullptr, T, 256, DM};
        EpiSwiglu E2{(bf16_t*)(ws + WS_ACTS), 256}; sgemm_phase<true>(c, g2, E2); }
    PHASE(PH_RS_F) { MAKE_CTX(); pg8::Gemm g{(const bf16_t*)(ws + WS_H), (const bf16_t*)(ws + WS_WRS_T), DM, DM, nullptr}; pg8::DenseOrder S; S.init(T, 768, G, bid);
        pg8::EpiRSF E{(float*)(ws + WS_LOGITS), (bf16_t*)(ws + WS_ACTS)}; pg8::gemm_phase<pg8::EpiRSF, pg8::DenseOrder, false, true>(lds3, g, S, E); }
    PHASE(PH_SD) { MAKE_CTX(); SG_Args g{(const bf16_t*)(ws + WS_ACTS), 256, nullptr, p.in[I_WDS], nullptr, DM, 0, nullptr, T, DM, ED};
        EpiSD E{(const float*)(ws + WS_MOD), p.out}; sgemm_phase<false>(c, g, E); }
    PHASE(PH_ROUTE) { MAKE_CTX(); ph_route(c, p); }
    PHASE(PH_M_J2) { { MAKE_CTX(); ph_route2<false>(c, p); }
        { pg8::Gemm g{(const bf16_t*)(ws + WS_ACTS), (const bf16_t*)(ws + WS_WDS_T), ED, ED, nullptr}; pg8::DenseOrder S; S.init(T, DM, G, bid);
          pg8::EpiSDY E{(bf16_t*)(ws + WS_YSH)}; pg8::gemm_phase<pg8::EpiSDY, pg8::DenseOrder, false, true>(lds3, g, S, E); } }
    PHASE(PH_M_J3) { { MAKE_CTX(); ph_route2<true>(c, p); }
        { pg8::Gemm g{(const bf16_t*)(ws + WS_ACTS), (const bf16_t*)(ws + WS_WDS_T), ED, ED, nullptr}; pg8::DenseOrder S; S.init(T, DM, G, bid);
          pg8::EpiSDY E{(bf16_t*)(ws + WS_YSH)}; pg8::gemm_phase<pg8::EpiSDY, pg8::DenseOrder, false, true>(lds3, g, S, E); } }
    PHASE(PH_SLOT5) { MAKE_CTX(); ph_slot5(c, p); }
    PHASE(PH_SLOT) { MAKE_CTX(); ph_slot(c, p); }
    PHASE(PH_SLOT4) { MAKE_CTX(); ph_slot3<true>(c, p); }
    PHASE(PH_E1) { MAKE_CTX(); SG_Args g{(const bf16_t*)(ws + WS_H), DM, (const int*)(ws + WS_SLOT_TOK), p.in[I_WGE], p.in[I_WUE], 256, (size_t)DM * ED, (const int*)(ws + WS_TILE_E), NS_MAX, ED, DM};
        EpiSwiglu E{(bf16_t*)(ws + WS_ACTE), 256}; sgemm_phase<true>(c, g, E); }
    PHASE(PH_E1_F) { MAKE_CTX(); pg8::Gemm g{(const bf16_t*)(ws + WS_H), (const bf16_t*)(ws + WS_WGU), DM, DM, (const int*)(ws + WS_SLOT_TOK)};
        pg8::GroupedOrder S{(const int*)(ws + WS_TILE_E), (int)((const unsigned*)(ws + WS_CTL))[CW_NTILES], 2, G, vcu};
        pg8::EpiE1F E{(bf16_t*)(ws + WS_ACTE)}; pg8::gemm_phase<pg8::EpiE1F, pg8::GroupedOrder, true, true>(lds3, g, S, E); }
    PHASE(PH_X1) { pg8::Gemm g{(const bf16_t*)(ws + WS_ACTE), (const bf16_t*)(ws + WS_WD), ED / 2, ED / 2, nullptr, 0x7A7A7A7Au, 0x7C7C7C7Cu};
        pg8::GroupedOrder S{(const int*)(ws + WS_TILE_E), (int)((const unsigned*)(ws + WS_CTL))[CW_NTILES], 4, G, vcu};
        pg8::EpiNone E{(float*)(ws + WS_DS)}; pg8::gemm_phase<pg8::EpiNone, pg8::GroupedOrder, true, true, true>(lds3, g, S, E); }
    PHASE(PH_X2) { pg8::Gemm g{(const bf16_t*)(ws + WS_ACTE), (const bf16_t*)(ws + WS_WD), ED, ED, nullptr};
        pg8::GroupedOrder S{(const int*)(ws + WS_TILE_E), (int)((const unsigned*)(ws + WS_CTL))[CW_NTILES], 4, G, vcu};
        pg8::EpiDense E{(bf16_t*)(ws + WS_YA)}; pg8::gemm_phase<pg8::EpiDense, pg8::GroupedOrder, false, true>(lds3, g, S, E); }
    PHASE(PH_E1_8) { pg8::Gemm g{(const bf16_t*)(ws + WS_H8), (const bf16_t*)(ws + WS_WGU), DM / 2, DM / 2, (const int*)(ws + WS_SLOT_TOK), 0x79797979u};
        pg8::GroupedOrder S{(const int*)(ws + WS_TILE_E), (int)((const unsigned*)(ws + WS_CTL))[CW_NTILES], 2, G, vcu};
        pg8::EpiE1F E{(bf16_t*)(ws + WS_ACTE)}; pg8::gemm_phase<pg8::EpiE1F, pg8::GroupedOrder, true, true, true>(lds3, g, S, E); }
    PHASE(PH_E1_88) { pg8::Gemm g{(const bf16_t*)(ws + WS_H8), (const bf16_t*)(ws + WS_WGU), DM / 2, DM / 2, (const int*)(ws + WS_SLOT_TOK), 0x79797979u};
        pg8::GroupedOrderL S{nullptr, (int)((const unsigned*)(ws + WS_CTL))[CW_NTILES], 2, G, vcu}; S.fill((const int*)(ws + WS_TILE_E), (PG8_LAS int*)(lds3 + 131072));
        pg8::EpiE1F8 E{ws + WS_ACTE}; pg8::gemm_phase<pg8::EpiE1F8, pg8::GroupedOrderL, true, true, true>(lds3, g, S, E); }
    PHASE(PH_E2_8) { pg8::Gemm g{(const bf16_t*)(ws + WS_ACTE), (const bf16_t*)(ws + WS_WD), ED / 2, ED / 2, nullptr, 0x7A7A7A7Au, 0x7C7C7C7Cu};
        pg8::GroupedOrder S{(const int*)(ws + WS_TILE_E), (int)((const unsigned*)(ws + WS_CTL))[CW_NTILES], 4, G, vcu};
        pg8::EpiE2S8b E{(const float*)(ws + WS_SLOT_GATE), ws + WS_YS}; pg8::gemm_phase<pg8::EpiE2S8b, pg8::GroupedOrder, true, true, true>(lds3, g, S, E); }
    PHASE(PH_E2_B8) { pg8::Gemm g{(const bf16_t*)(ws + WS_ACTE), (const bf16_t*)(ws + WS_WD), ED, ED, nullptr};
        pg8::GroupedOrder S{(const int*)(ws + WS_TILE_E), (int)((const unsigned*)(ws + WS_CTL))[CW_NTILES], 4, G, vcu};
        pg8::EpiE2S8 E{(const float*)(ws + WS_SLOT_GATE), ws + WS_YS}; pg8::gemm_phase<pg8::EpiE2S8, pg8::GroupedOrder, false, true>(lds3, g, S, E); }
    PHASE(PH_E1_G8) { pg8::Gemm g{(const bf16_t*)(ws + WS_H8), (const bf16_t*)(ws + WS_WGU), DM / 2, DM / 2, (const int*)(ws + WS_SLOT_TOK), 0x79797979u};
        pg8::GroupedOrder S{(const int*)(ws + WS_TILE_E), (int)((const unsigned*)(ws + WS_CTL))[CW_NTILES], 2, G, vcu};
        pg8::EpiE1G8 E{(const float*)(ws + WS_SLOT_GATE), ws + WS_ACTE}; pg8::gemm_phase<pg8::EpiE1G8, pg8::GroupedOrder, true, true, true>(lds3, g, S, E); }
    static_assert(Y8_SCALE == 16.f && ACT8_SCALE == 8.f && WD8_SCALE == 32.f, "E8M0 scales below");
    PHASE(PH_E2_P8) { pg8::Gemm g{(const bf16_t*)(ws + WS_ACTE), (const bf16_t*)(ws + WS_WD), ED / 2, ED / 2, nullptr, 0x7A7A7A7Au, 0x80808080u};
        pg8::GroupedOrderL S{nullptr, (int)((const unsigned*)(ws + WS_CTL))[CW_NTILES], 4, G, vcu}; S.fill((const int*)(ws + WS_TILE_E), (PG8_LAS int*)(lds3 + 131072));
        pg8::EpiE2P8 E{ws + WS_YS}; pg8::gemm_phase<pg8::EpiE2P8, pg8::GroupedOrderL, true, true, true, 2>(lds3, g, S, E); }
    PHASE(PH_COMB5) { MAKE_CTX(); ph_combine5(c, p); }
    PHASE(PH_COMB4) { MAKE_CTX(); ph_combine4(c, p); }
    PHASE(PH_E2) { MAKE_CTX(); SG_Args g{(const bf16_t*)(ws + WS_ACTE), 256, nullptr, p.in[I_WDE], nullptr, DM, (size_t)ED * DM, (const int*)(ws + WS_TILE_E), NS_MAX, DM, ED};
        EpiE2 E{(const int*)(ws + WS_SLOT_ASG), (const float*)(ws + WS_SLOT_GATE), (bf16_t*)(ws + WS_YA)}; sgemm_phase<false>(c, g, E); }
    PHASE(PH_E2S_F) { pg8::Gemm g{(const bf16_t*)(ws + WS_ACTE), (const bf16_t*)(ws + WS_WD), ED, ED, nullptr};
        pg8::GroupedOrder S{(const int*)(ws + WS_TILE_E), (int)((const unsigned*)(ws + WS_CTL))[CW_NTILES], 4, G, vcu};
        pg8::EpiE2S E{(const int*)(ws + WS_SLOT_ASG), (const float*)(ws + WS_SLOT_GATE), (bf16_t*)(ws + WS_YS)}; pg8::gemm_phase<pg8::EpiE2S, pg8::GroupedOrder, false, true>(lds3, g, S, E); }
    PHASE(PH_COMB3) { MAKE_CTX(); ph_combine3(c, p); }
    PHASE(PH_COMB) { MAKE_CTX(); ph_combine(c, p); }
    if constexpr (TIMING) {
        xcd_barrier(bar); (void)STAMP();
        if (blockIdx.x == 0 && threadIdx.x == 0) {
            const unsigned long long qb = (t_b + TIME_Q / 2) / TIME_Q;
            const unsigned long long wait = t_a + qb * 102400ull, t0 = __builtin_amdgcn_s_memrealtime();
            while (__builtin_amdgcn_s_memrealtime() - t0 < wait) __builtin_amdgcn_s_sleep(8);
        }
    }
#undef PHASE
}

#ifndef PLAN
#define PLAN 18
#endif
#if PLAN == 0
#define LAUNCH_LIST X(PHBIT(PH_PRO)) X(PHBIT(PH_H1)) X(PHBIT(PH_WIN)) X(PHBIT(PH_QKN)) X(PHBIT(PH_ATT)) X(PHBIT(PH_ATTC)) X(PHBIT(PH_SSM)) X(PHBIT(PH_GLU)) X(PHBIT(PH_NORM)) \
    X(PHBIT(PH_WOUT)) X(PHBIT(PH_H2)) X(PHBIT(PH_RS)) X(PHBIT(PH_RS2)) X(PHBIT(PH_SD)) X(PHBIT(PH_ROUTE)) X(PHBIT(PH_SLOT)) X(PHBIT(PH_E1)) X(PHBIT(PH_E2)) X(PHBIT(PH_COMB))
#elif PLAN == 12
#define LAUNCH_LIST X(PHBIT(PH_M_A2) | PHBIT(PH_M_B) | PHBIT(PH_WIN_F) | PHBIT(PH_M_D) | PHBIT(PH_M_E3) | PHBIT(PH_NORM2) | PHBIT(PH_WOUT_F) | PHBIT(PH_H2_2) | PHBIT(PH_RS_F) | PHBIT(PH_M_J2) | PHBIT(PH_SLOT4) | PHBIT(PH_E1_F) | PHBIT(PH_E2S_F) | PHBIT(PH_COMB3))
#elif PLAN == 13
#define LAUNCH_LIST X(PHBIT(PH_M_A2) | PHBIT(PH_M_B) | PHBIT(PH_WIN_F) | PHBIT(PH_M_D) | PHBIT(PH_M_E3) | PHBIT(PH_NORM2) | PHBIT(PH_WOUT_F) | PHBIT(PH_H2_2) | PHBIT(PH_RS_F) | PHBIT(PH_M_J2) | PHBIT(PH_SLOT4) | PHBIT(PH_E1_F) | PHBIT(PH_X1) | PHBIT(PH_E2S_F) | PHBIT(PH_COMB3))
#elif PLAN == 14
#define LAUNCH_LIST X(PHBIT(PH_M_A2) | PHBIT(PH_M_B) | PHBIT(PH_WIN_F) | PHBIT(PH_M_D) | PHBIT(PH_M_E4) | PHBIT(PH_NORM2) | PHBIT(PH_WOUT_F) | PHBIT(PH_H2_3) | PHBIT(PH_RS_F) | PHBIT(PH_M_J2) | PHBIT(PH_SLOT4) | PHBIT(PH_E1_8) | PHBIT(PH_E2S_F) | PHBIT(PH_COMB3))
#elif PLAN == 15
#define LAUNCH_LIST X(PHBIT(PH_M_A2) | PHBIT(PH_M_B) | PHBIT(PH_WIN_F) | PHBIT(PH_M_D) | PHBIT(PH_M_E5) | PHBIT(PH_NORM2) | PHBIT(PH_WOUT_F) | PHBIT(PH_H2_3) | PHBIT(PH_RS_F) | PHBIT(PH_M_J2) | PHBIT(PH_SLOT4) | PHBIT(PH_E1_88) | PHBIT(PH_E2_8) | PHBIT(PH_COMB4))
#elif PLAN == 99
#define LAUNCH_LIST X(PHBIT(PH_M_E5)) X(PHBIT(PH_E1_88)) X(PHBIT(PH_E2_8)) X(PHBIT(PH_COMB4)) X(PHBIT(PH_H2_3)) X(PHBIT(PH_M_D)) X(PHBIT(PH_WIN_F)) X(PHBIT(PH_WOUT_F)) X(PHBIT(PH_RS_F)) X(PHBIT(PH_M_J2))
#elif PLAN == 16
#define LAUNCH_LIST X(PHBIT(PH_M_A2) | PHBIT(PH_M_B) | PHBIT(PH_WIN_F) | PHBIT(PH_M_D) | PHBIT(PH_M_E4) | PHBIT(PH_NORM2) | PHBIT(PH_WOUT_F) | PHBIT(PH_H2_3) | PHBIT(PH_RS_F) | PHBIT(PH_M_J2) | PHBIT(PH_SLOT4) | PHBIT(PH_E1_8) | PHBIT(PH_E2_B8) | PHBIT(PH_COMB4))
#elif PLAN == 17
#define LAUNCH_LIST X(PHBIT(PH_M_A2) | PHBIT(PH_M_B) | PHBIT(PH_WIN_F) | PHBIT(PH_M_D) | PHBIT(PH_M_E5) | PHBIT(PH_NORM2) | PHBIT(PH_WOUT_F) | PHBIT(PH_H2_3) | PHBIT(PH_RS_F) | PHBIT(PH_M_J2) | PHBIT(PH_SLOT4) | PHBIT(PH_E1_G8) | PHBIT(PH_E2_P8) | PHBIT(PH_COMB4))
#elif PLAN == 18
#define LAUNCH_LIST X(PHBIT(PH_M_A2) | PHBIT(PH_M_B) | PHBIT(PH_WIN_F) | PHBIT(PH_M_D) | PHBIT(PH_M_E5) | PHBIT(PH_NORM2) | PHBIT(PH_WOUT_F) | PHBIT(PH_H2_3) | PHBIT(PH_RS_F) | PHBIT(PH_M_J3) | PHBIT(PH_SLOT5) | PHBIT(PH_E1_88) | PHBIT(PH_E2_P8) | PHBIT(PH_COMB5))
#elif PLAN == 20
#define LAUNCH_LIST X(PHBIT(PH_M_A2) | PHBIT(PH_M_B) | PHBIT(PH_WIN_F) | PHBIT(PH_M_D) | PHBIT(PH_M_E5) | PHBIT(PH_NORM2) | PHBIT(PH_WOUT_F) | PHBIT(PH_H2_3) | PHBIT(PH_RS_F) | PHBIT(PH_M_J3) | PHBIT(PH_SLOT5) | PHBIT(PH_E1_88) | PHBIT(PH_X1) | PHBIT(PH_E2_P8) | PHBIT(PH_COMB5))
#endif

extern "C" void kernel_launch(void* const* d_in, const int* in_sizes, int n_in, void* d_out, int out_size, void* d_ws, size_t ws_size, hipStream_t stream) {
    static int grid = 0;
    if (grid == 0) {
        if (n_in != 33 || out_size != T * DM || ws_size < WS_NEED) { fprintf(stderr, "kernel_launch: unexpected shapes (n_in %d out %d ws %zu)\n", n_in, out_size, ws_size); grid = -1; return; }
        int dev = 0, cus = 0;
        if (hipGetDevice(&dev) != hipSuccess || hipDeviceGetAttribute(&cus, hipDeviceAttributeMultiprocessorCount, dev) != hipSuccess) { grid = -1; return; }
        bool ok = true;
#define X(m) ok = ok && (hipFuncSetAttribute((const void*)mega<(m)>, hipFuncAttributeMaxDynamicSharedMemorySize, LDS_BYTES) == hipSuccess);
        LAUNCH_LIST
#undef X
        if (!ok) { grid = -1; return; }
        grid = cus;
    }
    if (grid < 0) return;
    (void)hipMemsetAsync((char*)d_ws + WS_CTL, 0, CTL_BYTES, stream);
    Params a{};
    for (int i = 0; i < 33; ++i) a.in[i] = (const float*)d_in[i];
    a.out = (float*)d_out; a.ws = (unsigned char*)d_ws;
#define X(m) hipLaunchKernelGGL((mega<(m)>), dim3(grid), dim3(NTHREADS), LDS_BYTES, stream, a);
    LAUNCH_LIST
#undef X
}
```

```cpp
#include <hip/hip_runtime.h>
#include <cstdio>
#include <cstdint>

typedef unsigned short bf16_t;
typedef float f32x4 __attribute__((ext_vector_type(4)));
typedef unsigned u32x4 __attribute__((ext_vector_type(4)));
typedef unsigned u32x2 __attribute__((ext_vector_type(2)));

constexpr int DM = 1024, NB = 8, SEQ = 4096, T = NB * SEQ;
constexpr int NH = 4, HD = 64, VD = 128, QKW = 512, ATTW = 512, SSMW = 512;
constexpr int SG = 32, SC = 16, SP = 64;
constexpr int LC = 16;
constexpr int NCHUNK = SEQ / LC;
constexpr int APK = 384;
constexpr int NE = 256, TOPK = 8, NGRP = 8, TOPG = 4, ED = 256;
constexpr int NS_MAX = 327680;
constexpr float EPS = 1e-6f;
constexpr float LAM_INIT = 0.2f;
constexpr float ROUTED_SCALE = 2.5f;
constexpr float WGU8_SCALE = 64.f, WD8_SCALE = 32.f, ACT8_SCALE = 8.f, Y8_SCALE = 16.f;

constexpr size_t MiB = 1u << 20;
constexpr size_t WS_CTL = 0, CTL_BYTES = 1 * MiB;
constexpr int CW_COUNTS = 1024;
constexpr int CW_CURSOR = 1024 + 256;
constexpr int CW_NTILES = 2048;
constexpr int CW_ATTQ = 2560  , CW_CONVQ = 2176;
constexpr int CW_BAR = 4096;
constexpr size_t CTL_SS1 = 256 * 1024;
constexpr size_t CTL_SS2 = 384 * 1024;
constexpr size_t WS_MOD = 512 * 1024;
constexpr size_t WS_LAM = 1 * MiB + 256 * 1024;
constexpr size_t WS_ROPE = 1 * MiB + 512 * 1024;
constexpr size_t WS_SSMP = 2 * MiB + 512 * 1024;
constexpr size_t WS_SS1P = 3 * MiB;
constexpr size_t WS_SS2P = 528 * MiB;
constexpr size_t WS_HIST = 11 * MiB;
constexpr size_t WS_EIDX = 4 * MiB;
constexpr size_t WS_GATEW = 5 * MiB;
constexpr size_t WS_SLOT_TOK = 6 * MiB;
constexpr size_t WS_SLOT_ASG = 7 * MiB + 512 * 1024;
constexpr size_t WS_SLOT_GATE = 9 * MiB;
constexpr size_t WS_TILE_E = 10 * MiB + 512 * 1024;
constexpr size_t WS_PADST = 10 * MiB + 768 * 1024;
constexpr size_t WS_WIN_T = 12 * MiB;
constexpr size_t WS_WOUT_T = 16 * MiB;
constexpr size_t WS_WGLU_T = 18 * MiB;
constexpr size_t WS_WRS_T = 19 * MiB;
constexpr size_t WS_SSMPW = 20 * MiB + 512 * 1024;
constexpr size_t WS_WDS_T = 21 * MiB;
constexpr size_t WS_SSM_BA = 22 * MiB;
constexpr size_t WS_SSM_BC = 26 * MiB;
constexpr size_t WS_DS = 496 * MiB;
constexpr size_t WS_WGU = 32 * MiB;
constexpr size_t WS_WD = 832 * MiB;
constexpr size_t WS_YS = 32 * MiB;
constexpr size_t WS_YA = 32 * MiB;
constexpr size_t WS_H = 288 * MiB;
constexpr size_t WS_H8 = 352 * MiB;
constexpr size_t WS_QK = 352 * MiB;
constexpr size_t WS_Y = 288 * MiB;
constexpr size_t WS_V = 416 * MiB;
constexpr size_t WS_AP = 448 * MiB;
constexpr size_t WS_ACTE = 672 * MiB;
constexpr size_t WS_MIXIN = 544 * MiB;
constexpr size_t WS_LOGITS = 608 * MiB;
constexpr size_t WS_ACTS = 640 * MiB;
constexpr size_t WS_YSH = 960 * MiB;
constexpr size_t WS_ATTO = 832 * MiB;
constexpr size_t WS_NEED = 1024 * MiB;

__device__ __forceinline__ float bf2f(bf16_t v) { return __uint_as_float((unsigned)v << 16); }
__device__ __forceinline__ bf16_t f2bf(float f) { unsigned u = __float_as_uint(f); return (bf16_t)((u + 0x7fffu + ((u >> 16) & 1u)) >> 16); }
__device__ __forceinline__ unsigned pk2(float lo, float hi) { return (unsigned)f2bf(lo) | ((unsigned)f2bf(hi) << 16); }
__device__ __forceinline__ float wave_sum(float v) {
#pragma unroll
    for (int o = 1; o < 64; o <<= 1) v += __shfl_xor(v, o);
    return v;
}
__device__ __forceinline__ float clamp448(float v) { return __builtin_amdgcn_fmed3f(v, -448.f, 448.f); }
__device__ __forceinline__ unsigned pk4_fp8(float a, float b, float c2, float d) { int w = __builtin_amdgcn_cvt_pk_fp8_f32(clamp448(a), clamp448(b), 0, false); w = __builtin_amdgcn_cvt_pk_fp8_f32(clamp448(c2), clamp448(d), w, true); return (unsigned)w; }
__device__ __forceinline__ float siluf(float v) { return v * __builtin_amdgcn_rcpf(1.f + __expf(-v)); }
__device__ __forceinline__ float sigmoidf(float v) { return __builtin_amdgcn_rcpf(1.f + __expf(-v)); }
__device__ __forceinline__ float gelu_tanh(float v) { const float u2 = 1.5957691216057308f * (v + 0.044715f * v * v * v); return v * __builtin_amdgcn_rcpf(1.f + __expf(-u2)); }

constexpr int NTHREADS_ = 512;
struct Params {
    const float* in[33];
    float* out;
    unsigned char* ws;
    int pad0, pad1;
};

struct Ctx {
    int tid, lane, wave, bid, nb;
    int gtid, gthreads, gwave, gwaves;
    unsigned char* ws;
    float* lds;
};

enum { I_X = 0, I_C, I_N1G, I_N2G, I_WADA, I_BADA, I_WIN, I_QNG, I_KNG, I_LQ1, I_LK1, I_LQ2, I_LK2, I_SUBG,
       I_ARE, I_AIM, I_LOGDT, I_BRE, I_BIM, I_CRE, I_CIM, I_SD, I_WGLU, I_SNG, I_WOUT, I_WR, I_RB,
       I_WGE, I_WUE, I_WDE, I_WGS, I_WUS, I_WDS };

struct SG_Args {
    const bf16_t* A; int lda; const int* rowidx;
    const float* W; const float* W2; int ldb;
    size_t wstride;
    const int* tile_e;
    int M, N, K;
};
template <bool DUAL, class Epi>
__device__ __forceinline__ void sgemm_phase(const Ctx& c, const SG_Args g, const Epi& E) {
    float* As = c.lds;
    float* Bs = c.lds + 16 * 132;
    float* Bs2 = Bs + 16 * 128;
    const int tid = c.tid, ty = tid >> 5, tx = tid & 31;
    const int nMt = g.M / 128, nNt = g.N / 128, ntile = nMt * nNt;
    for (int tile = c.bid; tile < ntile; tile += c.nb) {
        const int mt = tile / nNt, nt = tile % nNt;
        const float* W = g.W; const float* W2 = g.W2;
        if (g.tile_e) { const int e = g.tile_e[mt >> 1]; if (e < 0) continue; W += (size_t)e * g.wstride; if (DUAL) W2 += (size_t)e * g.wstride; }
        f32x4 acc[8], acc2[8];
#pragma unroll
        for (int i = 0; i < 8; ++i) { acc[i] = (f32x4){0.f, 0.f, 0.f, 0.f}; acc2[i] = (f32x4){0.f, 0.f, 0.f, 0.f}; }
        const int arow = mt * 128 + (tid >> 2), akq = (tid & 3) * 4;
        const int asrc = g.rowidx ? g.rowidx[arow] : arow;
        const bf16_t* ap = g.A + (size_t)asrc * g.lda + akq;
        const int bk = tid >> 5, bn = (tid & 31) * 4;
        const float* bp = W + (size_t)bk * g.ldb + nt * 128 + bn;
        const float* bp2 = DUAL ? (W2 + (size_t)bk * g.ldb + nt * 128 + bn) : nullptr;
#pragma unroll 1
        for (int k0 = 0; k0 < g.K; k0 += 16) {
            const u32x2 av = *(const u32x2*)(ap + k0);
            const f32x4 bv = *(const f32x4*)(bp + (size_t)k0 * g.ldb);
            f32x4 bv2 = {0.f, 0.f, 0.f, 0.f};
            if (DUAL) bv2 = *(const f32x4*)(bp2 + (size_t)k0 * g.ldb);
            __syncthreads();
            As[(akq + 0) * 132 + (tid >> 2)] = __uint_as_float(av.x << 16);
            As[(akq + 1) * 132 + (tid >> 2)] = __uint_as_float(av.x & 0xffff0000u);
            As[(akq + 2) * 132 + (tid >> 2)] = __uint_as_float(av.y << 16);
            As[(akq + 3) * 132 + (tid >> 2)] = __uint_as_float(av.y & 0xffff0000u);
            *(f32x4*)(Bs + bk * 128 + bn) = bv;
            if (DUAL) *(f32x4*)(Bs2 + bk * 128 + bn) = bv2;
            __syncthreads();
#pragma unroll
            for (int kk = 0; kk < 16; ++kk) {
                const f32x4 a0 = *(const f32x4*)(As + kk * 132 + ty * 8), a1 = *(const f32x4*)(As + kk * 132 + ty * 8 + 4);
                const f32x4 b = *(const f32x4*)(Bs + kk * 128 + tx * 4);
                const float a[8] = {a0.x, a0.y, a0.z, a0.w, a1.x, a1.y, a1.z, a1.w};
#pragma unroll
                for (int i = 0; i < 8; ++i) acc[i] += a[i] * b;
                if (DUAL) {
                    const f32x4 b2 = *(const f32x4*)(Bs2 + kk * 128 + tx * 4);
#pragma unroll
                    for (int i = 0; i < 8; ++i) acc2[i] += a[i] * b2;
                }
            }
        }
#pragma unroll
        for (int i = 0; i < 8; ++i) E(mt * 128 + ty * 8 + i, nt * 128 + tx * 4, acc[i], acc2[i], tx);
    }
}

__device__ __forceinline__ void ph_prologue(const Ctx& c, const Params& p) {
    float* mod = (float*)(c.ws + WS_MOD);
    for (int idx = c.gtid; idx < NB * 6 * DM; idx += c.gthreads) {
        const int b = idx / (6 * DM), j = idx % (6 * DM);
        const float* cc = p.in[I_C] + b * DM; const float* w = p.in[I_WADA] + j;
        float acc = p.in[I_BADA][j];
#pragma unroll 8
        for (int k = 0; k < DM; ++k) acc += siluf(cc[k]) * w[(size_t)k * (6 * DM)];
        mod[idx] = acc;
    }
    float* ropec = (float*)(c.ws + WS_ROPE); float* ropes = ropec + SEQ * 32;
    for (int idx = c.gtid; idx < SEQ * 32; idx += c.gthreads) {
        const int l = idx >> 5, i = idx & 31;
        const double invf = exp(-log(10000.0) * (double)(2 * i) / 64.0);
        const double ang = (double)l * invf;
        ropec[idx] = (float)cos(ang); ropes[idx] = (float)sin(ang);
    }
    float* sp = (float*)(c.ws + WS_SSMP);
    float* abr = sp, * abi = sp + SG * SP, * bbr = sp + 2 * SG * SP, * bbi = bbr + SG * SP * SC;
    for (int idx = c.gtid; idx < SG * SP; idx += c.gthreads) {
        const int g = idx / SP;
        const double are = p.in[I_ARE][idx], aim = p.in[I_AIM][idx], dt = exp((double)p.in[I_LOGDT][g]);
        const double mag = exp(are * dt), ar = mag * cos(aim * dt), ai = mag * sin(aim * dt);
        abr[idx] = (float)ar; abi[idx] = (float)ai;
        const double den = are * are + aim * aim, nr = ar - 1.0;
        const double fre = (nr * are + ai * aim) / den, fim = (ai * are - nr * aim) / den;
        for (int ch = 0; ch < SC; ++ch) {
            const double br = p.in[I_BRE][idx * SC + ch], bi = p.in[I_BIM][idx * SC + ch];
            bbr[idx * SC + ch] = (float)(fre * br - fim * bi); bbi[idx * SC + ch] = (float)(fre * bi + fim * br);
        }
    }
    if (c.gtid == 0) {
        float s1 = 0.f, s2 = 0.f, gq = 0.f, gk = 0.f;
        for (int i = 0; i < HD; ++i) { s1 += p.in[I_LQ1][i] * p.in[I_LK1][i]; s2 += p.in[I_LQ2][i] * p.in[I_LK2][i];
            gq = fmaxf(gq, fabsf(p.in[I_QNG][i])); gk = fmaxf(gk, fabsf(p.in[I_KNG][i])); }
        float* lam = (float*)(c.ws + WS_LAM);
        lam[0] = __expf(s1) - __expf(s2) + LAM_INIT;
        lam[1] = 0.125f * 64.f * gq * gk;
    }
    int* stok = (int*)(c.ws + WS_SLOT_TOK); int* sasg = (int*)(c.ws + WS_SLOT_ASG); float* sgate = (float*)(c.ws + WS_SLOT_GATE);
    for (int idx = c.gtid; idx < NS_MAX; idx += c.gthreads) { stok[idx] = 0; sasg[idx] = -1; sgate[idx] = 0.f; }
    int* te = (int*)(c.ws + WS_TILE_E);
    for (int idx = c.gtid; idx < NS_MAX / 256; idx += c.gthreads) te[idx] = -1;
}

__device__ __forceinline__ void ph_h1(const Ctx& c, const Params& p) {
    const float* mod = (const float*)(c.ws + WS_MOD); bf16_t* H = (bf16_t*)(c.ws + WS_H);
    constexpr int R = 4;
    for (int t0 = c.gwave * R; t0 < T; t0 += c.gwaves * R) {
        const int b = t0 / SEQ;
        f32x4 v[R][4]; float sq[R];
#pragma unroll
        for (int j = 0; j < R; ++j) { const f32x4* xr = (const f32x4*)(p.in[I_X] + (size_t)(t0 + j) * DM) + c.lane;
#pragma unroll
            for (int q = 0; q < 4; ++q) v[j][q] = xr[64 * q]; }
        const float* sh = mod + b * 6 * DM, * sc = sh + DM;
        f32x4 ca[4], cb[4];
#pragma unroll
        for (int q = 0; q < 4; ++q) { const int col = 4 * c.lane + 256 * q; ca[q] = *(const f32x4*)(p.in[I_N1G] + col) * (1.f + *(const f32x4*)(sc + col)); cb[q] = *(const f32x4*)(sh + col); }
#pragma unroll
        for (int j = 0; j < R; ++j) { float s_ = 0.f;
#pragma unroll
            for (int q = 0; q < 4; ++q) s_ += v[j][q].x * v[j][q].x + v[j][q].y * v[j][q].y + v[j][q].z * v[j][q].z + v[j][q].w * v[j][q].w;
            sq[j] = s_; }
#pragma unroll
        for (int o = 1; o < 64; o <<= 1) {
#pragma unroll
            for (int j = 0; j < R; ++j) sq[j] += __shfl_xor(sq[j], o); }
#pragma unroll
        for (int j = 0; j < R; ++j) { const float rstd = rsqrtf(sq[j] * (1.f / DM) + EPS);
#pragma unroll
            for (int q = 0; q < 4; ++q) { const int col = 4 * c.lane + 256 * q; const f32x4 o = (v[j][q] * rstd) * ca[q] + cb[q];
                u32x2 w; w.x = pk2(o.x, o.y); w.y = pk2(o.z, o.w); *(u32x2*)(H + (size_t)(t0 + j) * DM + col) = w; } }
    }
}

struct EpiWin {
    bf16_t* QK; bf16_t* V; bf16_t* AP;
    __device__ __forceinline__ void operator()(int row, int col, const f32x4& a, const f32x4&, int) const {
        u32x2 w; w.x = pk2(a[0], a[1]); w.y = pk2(a[2], a[3]);
        if (col < 1024) *(u32x2*)(QK + (size_t)row * 1024 + col) = w;
        else if (col < 1536) *(u32x2*)(V + (size_t)row * 512 + (col - 1024)) = w;
        else { const int cc = col - 1536, g = cc >> 4, ch = cc & 15, b = row / SEQ, l = row % SEQ;
            *(u32x2*)(AP + ((size_t)(g * (NB * NCHUNK) + b * NCHUNK + (l >> 4)) * APK + (l & 15) * 16 + ch)) = w; }
    }
};

__device__ __forceinline__ void ph_qkn(const Ctx& c, const Params& p) {
    bf16_t* QK = (bf16_t*)(c.ws + WS_QK);
    const float* ropec = (const float*)(c.ws + WS_ROPE); const float* ropes = ropec + SEQ * 32;
    const int l = c.lane;
    const float gq = p.in[I_QNG][l], gk = p.in[I_KNG][l];
    for (int t = c.gwave; t < T; t += c.gwaves) {
        const int pos = t % SEQ; const float cs = ropec[pos * 32 + (l & 31)], sn = ropes[pos * 32 + (l & 31)];
        bf16_t* r = QK + (size_t)t * 1024;
#pragma unroll 4
        for (int gi = 0; gi < 16; ++gi) {
            const float v = bf2f(r[gi * 64 + l]);
            const float rstd = rsqrtf(wave_sum(v * v) * (1.f / 64.f) + EPS);
            const float y = v * rstd * (gi < 8 ? gq : gk);
            const float o = __shfl_xor(y, 32);
            const float res = (l < 32) ? (y * cs - o * sn) : (o * sn + y * cs);
            r[gi * 64 + l] = f2bf(res);
        }
    }
}

__device__ __forceinline__ void ph_att_base(const Ctx& c, const Params& p) {
    const bf16_t* QK = (const bf16_t*)(c.ws + WS_QK); const bf16_t* V = (const bf16_t*)(c.ws + WS_V); float* AO = (float*)(c.ws + WS_ATTO);
    const float smax = ((const float*)(c.ws + WS_LAM))[1];
    const int nitem = NB * NH * 4 * (SEQ / 64);
    for (int it = c.gwave; it < nitem; it += c.gwaves) {
        const int qb = (SEQ / 64 - 1) - (it / (NB * NH * 4)), bhc = it % (NB * NH * 4), b = bhc / (NH * 4), h = (bhc >> 2) % NH, cc = (bhc >> 1) & 1, vh = bhc & 1;
        const int q = qb * 64 + c.lane; const size_t trow = (size_t)b * SEQ + q;
        float qv[64];
        { const bf16_t* qp = QK + trow * 1024 + h * 128 + cc * 64;
#pragma unroll
          for (int d = 0; d < 64; ++d) qv[d] = bf2f(qp[d]) * 0.125f; }
        float o[64];
#pragma unroll
        for (int d = 0; d < 64; ++d) o[d] = 0.f;
        float lsum = 0.f;
        const int jmax = qb * 64 + 63;
        for (int j = 0; j <= jmax; ++j) {
            const size_t krow = (size_t)b * SEQ + j;
            const u32x4* kp = (const u32x4*)(QK + krow * 1024 + 512 + h * 128 + cc * 64);
            float s = 0.f;
#pragma unroll
            for (int i = 0; i < 8; ++i) { const u32x4 kk = kp[i];
                s += qv[8 * i + 0] * __uint_as_float(kk.x << 16) + qv[8 * i + 1] * __uint_as_float(kk.x & 0xffff0000u)
                   + qv[8 * i + 2] * __uint_as_float(kk.y << 16) + qv[8 * i + 3] * __uint_as_float(kk.y & 0xffff0000u)
                   + qv[8 * i + 4] * __uint_as_float(kk.z << 16) + qv[8 * i + 5] * __uint_as_float(kk.z & 0xffff0000u)
                   + qv[8 * i + 6] * __uint_as_float(kk.w << 16) + qv[8 * i + 7] * __uint_as_float(kk.w & 0xffff0000u); }
            float pe = (j <= q) ? __expf(s - smax) : 0.f;
            lsum += pe;
            const u32x4* vp = (const u32x4*)(V + krow * 512 + h * 128 + vh * 64);
#pragma unroll
            for (int i = 0; i < 8; ++i) { const u32x4 vv = vp[i];
                o[8 * i + 0] += pe * __uint_as_float(vv.x << 16); o[8 * i + 1] += pe * __uint_as_float(vv.x & 0xffff0000u);
                o[8 * i + 2] += pe * __uint_as_float(vv.y << 16); o[8 * i + 3] += pe * __uint_as_float(vv.y & 0xffff0000u);
                o[8 * i + 4] += pe * __uint_as_float(vv.z << 16); o[8 * i + 5] += pe * __uint_as_float(vv.z & 0xffff0000u);
                o[8 * i + 6] += pe * __uint_as_float(vv.w << 16); o[8 * i + 7] += pe * __uint_as_float(vv.w & 0xffff0000u); }
        }
        const float rl = 1.f / lsum;
        float* op = AO + (trow * 8 + h * 2 + cc) * 128 + vh * 64;
#pragma unroll
        for (int d = 0; d < 64; d += 4) *(f32x4*)(op + d) = (f32x4){o[d] * rl, o[d + 1] * rl, o[d + 2] * rl, o[d + 3] * rl};
    }
}
__device__ __forceinline__ void ph_att_comb(const Ctx& c, const Params& p) {
    const float* AO = (const float*)(c.ws + WS_ATTO); bf16_t* MX = (bf16_t*)(c.ws + WS_MIXIN);
    const float lam = ((const float*)(c.ws + WS_LAM))[0];
    for (int it = c.gwave; it < T * NH; it += c.gwaves) {
        const int t = it >> 2, h = it & 3;
        const float* o1 = AO + ((size_t)t * 8 + h * 2) * 128, * o2 = o1 + 128;
        const float a = o1[c.lane] - lam * o2[c.lane], b = o1[64 + c.lane] - lam * o2[64 + c.lane];
        const float rstd = rsqrtf(wave_sum(a * a + b * b) * (1.f / 128.f) + EPS) * (1.f - LAM_INIT);
        MX[(size_t)t * 1024 + h * 128 + c.lane] = f2bf(a * rstd * p.in[I_SUBG][c.lane]);
        MX[(size_t)t * 1024 + h * 128 + 64 + c.lane] = f2bf(b * rstd * p.in[I_SUBG][64 + c.lane]);
    }
}

__device__ __forceinline__ void ph_ssm_base(const Ctx& c, const Params& p) {
    const bf16_t* AP = (const bf16_t*)(c.ws + WS_AP); bf16_t* Y = (bf16_t*)(c.ws + WS_Y);
    const float* sp = (const float*)(c.ws + WS_SSMP);
    const float* abr = sp, * abi = sp + SG * SP, * bbr = sp + 2 * SG * SP, * bbi = bbr + SG * SP * SC;
    for (int it = c.gwave; it < NB * SG; it += c.gwaves) {
        const int b = it / SG, g = it % SG, pp = c.lane;
        const float ar = abr[g * SP + pp], ai = abi[g * SP + pp];
        float br[16], bi[16], cr[16], ci[16];
#pragma unroll
        for (int ch = 0; ch < 16; ++ch) { br[ch] = bbr[(g * SP + pp) * SC + ch]; bi[ch] = bbi[(g * SP + pp) * SC + ch];
            cr[ch] = p.in[I_CRE][(g * SC + ch) * SP + pp]; ci[ch] = p.in[I_CIM][(g * SC + ch) * SP + pp]; }
        const float dsk = (pp < 16) ? p.in[I_SD][g * SC + pp] : 0.f;
        float sr = 0.f, si = 0.f;
        for (int l = 0; l < SEQ; ++l) {
            const bf16_t* up = AP + ((size_t)(g * (NB * NCHUNK) + b * NCHUNK + (l >> 4)) * APK + (l & 15) * 16);
            const u32x4 u0 = *(const u32x4*)up, u1 = *(const u32x4*)(up + 8);
            float u[16] = { __uint_as_float(u0.x << 16), __uint_as_float(u0.x & 0xffff0000u), __uint_as_float(u0.y << 16), __uint_as_float(u0.y & 0xffff0000u),
                            __uint_as_float(u0.z << 16), __uint_as_float(u0.z & 0xffff0000u), __uint_as_float(u0.w << 16), __uint_as_float(u0.w & 0xffff0000u),
                            __uint_as_float(u1.x << 16), __uint_as_float(u1.x & 0xffff0000u), __uint_as_float(u1.y << 16), __uint_as_float(u1.y & 0xffff0000u),
                            __uint_as_float(u1.z << 16), __uint_as_float(u1.z & 0xffff0000u), __uint_as_float(u1.w << 16), __uint_as_float(u1.w & 0xffff0000u) };
            float bur = 0.f, bui = 0.f;
#pragma unroll
            for (int ch = 0; ch < 16; ++ch) { bur += u[ch] * br[ch]; bui += u[ch] * bi[ch]; }
            const float nr = ar * sr - ai * si + bur, ni = ar * si + ai * sr + bui; sr = nr; si = ni;
            float mine = 0.f;
#pragma unroll
            for (int ch = 0; ch < 16; ++ch) { const float v = wave_sum(sr * cr[ch] - si * ci[ch]); if (pp == ch) mine = v + dsk * u[ch]; }
            if (pp < 16) Y[((size_t)b * SEQ + l) * 512 + g * 16 + pp] = f2bf(gelu_tanh(mine));
        }
    }
}

struct EpiGlu {
    const bf16_t* Y; bf16_t* MX; float* ss;
    __device__ __forceinline__ void operator()(int row, int col, const f32x4& a, const f32x4&, int) const {
        const u32x2 yv = *(const u32x2*)(Y + (size_t)row * 512 + col);
        const float y0 = __uint_as_float(yv.x << 16), y1 = __uint_as_float(yv.x & 0xffff0000u), y2 = __uint_as_float(yv.y << 16), y3 = __uint_as_float(yv.y & 0xffff0000u);
        const float v0 = y0 * sigmoidf(a[0]), v1 = y1 * sigmoidf(a[1]), v2 = y2 * sigmoidf(a[2]), v3 = y3 * sigmoidf(a[3]);
        u32x2 w; w.x = pk2(v0, v1); w.y = pk2(v2, v3); *(u32x2*)(MX + (size_t)row * 1024 + 512 + col) = w;
        float s = v0 * v0 + v1 * v1 + v2 * v2 + v3 * v3;
#pragma unroll
        for (int o = 1; o < 32; o <<= 1) s += __shfl_xor(s, o);
        if ((threadIdx.x & 31) == 0) atomicAdd(ss + row, s);
    }
};
__device__ __forceinline__ void ph_ssm_norm(const Ctx& c, const Params& p) {
    bf16_t* MX = (bf16_t*)(c.ws + WS_MIXIN); const float* ss = (const float*)(c.ws + WS_CTL + CTL_SS1);
    for (int t = c.gwave; t < T; t += c.gwaves) {
        const float rstd = rsqrtf(ss[t] * (1.f / 512.f) + EPS);
        bf16_t* r = MX + (size_t)t * 1024 + 512 + c.lane * 8; const float* g = p.in[I_SNG] + c.lane * 8;
        u32x4 w = *(u32x4*)r; unsigned* wp = (unsigned*)&w;
#pragma unroll
        for (int i = 0; i < 4; ++i) { const float a = __uint_as_float(wp[i] << 16) * rstd * g[2 * i], b = __uint_as_float(wp[i] & 0xffff0000u) * rstd * g[2 * i + 1]; wp[i] = pk2(a, b); }
        *(u32x4*)r = w;
    }
}
__device__ __forceinline__ void ph_ssm_norm2(const Ctx& c, const Params& p) {
    bf16_t* MX = (bf16_t*)(c.ws + WS_MIXIN); const float* ss = (const float*)(c.ws + WS_SS1P);
    constexpr int R = 8;
    float g[8];
#pragma unroll
    for (int i = 0; i < 8; ++i) g[i] = p.in[I_SNG][c.lane * 8 + i];
    for (int t0 = c.gwave * R; t0 < T; t0 += c.gwaves * R) {
        u32x4 w[R]; f32x4 s0[R], s1[R];
#pragma unroll
        for (int j = 0; j < R; ++j) { const size_t t = (size_t)(t0 + j); w[j] = *(const u32x4*)(MX + t * 1024 + 512 + c.lane * 8); s0[j] = *(const f32x4*)(ss + t * 8); s1[j] = *(const f32x4*)(ss + t * 8 + 4); }
#pragma unroll
        for (int j = 0; j < R; ++j) {
            const float tot = ((s0[j].x + s0[j].y) + (s0[j].z + s0[j].w)) + ((s1[j].x + s1[j].y) + (s1[j].z + s1[j].w));
            const float rstd = rsqrtf(tot * (1.f / 512.f) + EPS);
            unsigned* wp = (unsigned*)&w[j];
#pragma unroll
            for (int i = 0; i < 4; ++i) { const float a = __uint_as_float(wp[i] << 16) * rstd * g[2 * i], b = __uint_as_float(wp[i] & 0xffff0000u) * rstd * g[2 * i + 1]; wp[i] = pk2(a, b); }
            *(u32x4*)(MX + (size_t)(t0 + j) * 1024 + 512 + c.lane * 8) = w[j];
        }
    }
}
struct EpiWout {
    const float* x; const float* mod; float* out; float* ss;
    __device__ __forceinline__ void operator()(int row, int col, const f32x4& a, const f32x4&, int) const {
        const int b = row / SEQ; const f32x4 xv = *(const f32x4*)(x + (size_t)row * DM + col), g1 = *(const f32x4*)(mod + b * 6 * DM + 2 * DM + col);
        const f32x4 o = {xv.x + g1.x * a[0], xv.y + g1.y * a[1], xv.z + g1.z * a[2], xv.w + g1.w * a[3]};
        *(f32x4*)(out + (size_t)row * DM + col) = o;
        float s = o.x * o.x + o.y * o.y + o.z * o.z + o.w * o.w;
#pragma unroll
        for (int of = 1; of < 32; of <<= 1) s += __shfl_xor(s, of);
        if ((threadIdx.x & 31) == 0) atomicAdd(ss + row, s);
    }
};
__device__ __forceinline__ void ph_h2(const Ctx& c, const Params& p) {
    const float* mod = (const float*)(c.ws + WS_MOD); bf16_t* H = (bf16_t*)(c.ws + WS_H);
    const float* ss = (const float*)(c.ws + WS_CTL + CTL_SS2);
    for (int t = c.gwave; t < T; t += c.gwaves) {
        const int b = t / SEQ; const f32x4* xr = (const f32x4*)(p.out + (size_t)t * DM) + c.lane;
        const float rstd = rsqrtf(ss[t] * (1.f / DM) + EPS);
        const float* sh = mod + b * 6 * DM + 3 * DM, * sc = sh + DM;
#pragma unroll
        for (int j = 0; j < 4; ++j) { const int col = 4 * c.lane + 256 * j; const f32x4 v = xr[64 * j];
            const f32x4 g = *(const f32x4*)(p.in[I_N2G] + col), s1 = *(const f32x4*)(sc + col), h1 = *(const f32x4*)(sh + col);
            const f32x4 o = (v * rstd * g) * (1.f + s1) + h1;
            u32x2 w; w.x = pk2(o.x, o.y); w.y = pk2(o.z, o.w); *(u32x2*)(H + (size_t)t * DM + col) = w; }
    }
}
__device__ __forceinline__ void ph_h2_2(const Ctx& c, const Params& p) {
    const float* mod = (const float*)(c.ws + WS_MOD); bf16_t* H = (bf16_t*)(c.ws + WS_H);
    const float* ss = (const float*)(c.ws + WS_SS2P);
    constexpr int R = 4;
    for (int t0 = c.gwave * R; t0 < T; t0 += c.gwaves * R) {
        const int b = t0 / SEQ;
        f32x4 v[R][4], sv[R][4];
#pragma unroll
        for (int j = 0; j < R; ++j) { const f32x4* xr = (const f32x4*)(p.out + (size_t)(t0 + j) * DM) + c.lane;
#pragma unroll
            for (int q = 0; q < 4; ++q) { v[j][q] = xr[64 * q]; sv[j][q] = *(const f32x4*)(ss + (size_t)(t0 + j) * 16 + 4 * q); } }
        const float* sh = mod + b * 6 * DM + 3 * DM, * sc = sh + DM;
        f32x4 ca[4], cb[4];
#pragma unroll
        for (int q = 0; q < 4; ++q) { const int col = 4 * c.lane + 256 * q; ca[q] = *(const f32x4*)(p.in[I_N2G] + col) * (1.f + *(const f32x4*)(sc + col)); cb[q] = *(const f32x4*)(sh + col); }
#pragma unroll
        for (int j = 0; j < R; ++j) {
            float tot = 0.f;
#pragma unroll
            for (int q = 0; q < 4; ++q) tot += (sv[j][q].x + sv[j][q].y) + (sv[j][q].z + sv[j][q].w);
            const float rstd = rsqrtf(tot * (1.f / DM) + EPS);
#pragma unroll
            for (int q = 0; q < 4; ++q) { const int col = 4 * c.lane + 256 * q; const f32x4 o = (v[j][q] * rstd) * ca[q] + cb[q];
                u32x2 w; w.x = pk2(o.x, o.y); w.y = pk2(o.z, o.w); *(u32x2*)(H + (size_t)(t0 + j) * DM + col) = w; }
        }
    }
}
__device__ __forceinline__ void ph_h2_3(const Ctx& c, const Params& p) {
    const float* mod = (const float*)(c.ws + WS_MOD); bf16_t* H = (bf16_t*)(c.ws + WS_H); unsigned char* H8 = c.ws + WS_H8;
    const float* ss = (const float*)(c.ws + WS_SS2P);
    constexpr int R = 4;
    for (int t0 = c.gwave * R; t0 < T; t0 += c.gwaves * R) {
        const int b = t0 / SEQ;
        f32x4 v[R][4], sv[R][4];
#pragma unroll
        for (int j = 0; j < R; ++j) { const f32x4* xr = (const f32x4*)(p.out + (size_t)(t0 + j) * DM) + c.lane;
#pragma unroll
            for (int q = 0; q < 4; ++q) { v[j][q] = xr[64 * q]; sv[j][q] = *(const f32x4*)(ss + (size_t)(t0 + j) * 16 + 4 * q); } }
        const float* sh = mod + b * 6 * DM + 3 * DM, * sc = sh + DM;
        f32x4 ca[4], cb[4];
#pragma unroll
        for (int q = 0; q < 4; ++q) { const int col = 4 * c.lane + 256 * q; ca[q] = *(const f32x4*)(p.in[I_N2G] + col) * (1.f + *(const f32x4*)(sc + col)); cb[q] = *(const f32x4*)(sh + col); }
#pragma unroll
        for (int j = 0; j < R; ++j) {
            float tot = 0.f;
#pragma unroll
            for (int q = 0; q < 4; ++q) tot += (sv[j][q].x + sv[j][q].y) + (sv[j][q].z + sv[j][q].w);
            const float rstd = rsqrtf(tot * (1.f / DM) + EPS);
#pragma unroll
            for (int q = 0; q < 4; ++q) { const int col = 4 * c.lane + 256 * q; const f32x4 o = (v[j][q] * rstd) * ca[q] + cb[q];
                u32x2 w; w.x = pk2(o.x, o.y); w.y = pk2(o.z, o.w); *(u32x2*)(H + (size_t)(t0 + j) * DM + col) = w;
                *(unsigned*)(H8 + (size_t)(t0 + j) * DM + col) = pk4_fp8(o.x, o.y, o.z, o.w); }
        }
    }
}
struct EpiLogits { float* L; __device__ __forceinline__ void operator()(int row, int col, const f32x4& a, const f32x4&, int) const { *(f32x4*)(L + (size_t)row * 256 + col) = (f32x4){a[0], a[1], a[2], a[3]}; } };
struct EpiSwiglu { bf16_t* O; int ldo;
    __device__ __forceinline__ void operator()(int row, int col, const f32x4& a, const f32x4& b, int) const {
        u32x2 w; w.x = pk2(siluf(a[0]) * b[0], siluf(a[1]) * b[1]); w.y = pk2(siluf(a[2]) * b[2], siluf(a[3]) * b[3]); *(u32x2*)(O + (size_t)row * ldo + col) = w; } };

__device__ __forceinline__ void ph_route(const Ctx& c, const Params& p) {
    const float* L = (const float*)(c.ws + WS_LOGITS);
    int* eidx = (int*)(c.ws + WS_EIDX); float* gw = (float*)(c.ws + WS_GATEW); unsigned* counts = (unsigned*)(c.ws + WS_CTL) + CW_COUNTS;
    const int l = c.lane; const float NEG = -__builtin_inff();
    float rb[4];
#pragma unroll
    for (int r = 0; r < 4; ++r) rb[r] = p.in[I_RB][l + 64 * r];
    for (int t = c.gwave; t < T; t += c.gwaves) {
        float s[4], sb[4];
#pragma unroll
        for (int r = 0; r < 4; ++r) { s[r] = sigmoidf(L[(size_t)t * 256 + l + 64 * r]); sb[r] = s[r] + rb[r]; }
        float gs[4];
#pragma unroll
        for (int r = 0; r < 4; ++r) {
            float m1 = sb[r]; int i1 = l;
#pragma unroll
            for (int o = 1; o < 32; o <<= 1) { const float om = __shfl_xor(m1, o); const int oi = __shfl_xor(i1, o); if (om > m1 || (om == m1 && oi < i1)) { m1 = om; i1 = oi; } }
            float m2 = (l == i1) ? NEG : sb[r];
#pragma unroll
            for (int o = 1; o < 32; o <<= 1) m2 = fmaxf(m2, __shfl_xor(m2, o));
            gs[r] = m1 + m2;
        }
        float gsc[8];
#pragma unroll
        for (int r = 0; r < 4; ++r) { gsc[2 * r] = __shfl(gs[r], 0); gsc[2 * r + 1] = __shfl(gs[r], 32); }
        unsigned gmask = 0;
#pragma unroll
        for (int a = 0; a < 8; ++a) { int rank = 0;
#pragma unroll
            for (int b2 = 0; b2 < 8; ++b2) rank += (gsc[b2] > gsc[a] || (gsc[b2] == gsc[a] && b2 < a)) ? 1 : 0;
            if (rank < TOPG) gmask |= 1u << a; }
        float mv[4];
#pragma unroll
        for (int r = 0; r < 4; ++r) mv[r] = ((gmask >> (2 * r + (l >> 5))) & 1u) ? sb[r] : NEG;
        float wsel = 0.f; int esel = -1; float wsum = 0.f;
#pragma unroll
        for (int k = 0; k < TOPK; ++k) {
            float bm = mv[0]; int bi = l;
#pragma unroll
            for (int r = 1; r < 4; ++r) if (mv[r] > bm) { bm = mv[r]; bi = l + 64 * r; }
#pragma unroll
            for (int o = 1; o < 64; o <<= 1) { const float om = __shfl_xor(bm, o); const int oi = __shfl_xor(bi, o); if (om > bm || (om == bm && oi < bi)) { bm = om; bi = oi; } }
            float sv = 0.f;
#pragma unroll
            for (int r = 0; r < 4; ++r) if (bi == l + 64 * r) { sv = s[r]; mv[r] = NEG; }
            sv = __shfl(sv, bi & 63);
            wsum += sv;
            if (l == k) { wsel = sv; esel = bi; }
        }
        if (l < TOPK) { eidx[t * 8 + l] = esel; gw[t * 8 + l] = wsel / wsum * ROUTED_SCALE; atomicAdd(counts + esel, 1u); }
    }
}
__device__ __forceinline__ void ph_slot(const Ctx& c, const Params& p) {
    const unsigned* counts = (const unsigned*)(c.ws + WS_CTL) + CW_COUNTS; unsigned* cursor = (unsigned*)(c.ws + WS_CTL) + CW_CURSOR;
    int* ps = (int*)c.lds;
    if (c.tid == 0) { int acc = 0; for (int e = 0; e < NE; ++e) { ps[e] = acc; acc += ((int)counts[e] + 255) / 256 * 256; } ps[NE] = acc; }
    __syncthreads();
    const int* eidx = (const int*)(c.ws + WS_EIDX); const float* gw = (const float*)(c.ws + WS_GATEW);
    int* stok = (int*)(c.ws + WS_SLOT_TOK); int* sasg = (int*)(c.ws + WS_SLOT_ASG); float* sgate = (float*)(c.ws + WS_SLOT_GATE);
    for (int a = c.gtid; a < T * TOPK; a += c.gthreads) {
        const int e = eidx[a]; const unsigned pos = atomicAdd(cursor + e, 1u); const int slot = ps[e] + (int)pos;
        stok[slot] = a >> 3; sasg[slot] = a; sgate[slot] = gw[a];
    }
    if (c.bid == 0) {
        int* te = (int*)(c.ws + WS_TILE_E); int* padst = (int*)(c.ws + WS_PADST);
        for (int e = c.tid; e <= NE; e += 512) padst[e] = ps[e];
        for (int e = c.tid; e < NE; e += 512) for (int tl = ps[e] / 256; tl < ps[e + 1] / 256; ++tl) te[tl] = e;
        if (c.tid == 0) ((unsigned*)(c.ws + WS_CTL))[CW_NTILES] = (unsigned)(ps[NE] / 256);
    }
}
struct EpiE2 { const int* sasg; const float* sgate; bf16_t* YA;
    __device__ __forceinline__ void operator()(int row, int col, const f32x4& a, const f32x4&, int) const {
        const int asg = sasg[row]; if (asg < 0) return; const float g = sgate[row];
        u32x2 w; w.x = pk2(g * a[0], g * a[1]); w.y = pk2(g * a[2], g * a[3]); *(u32x2*)(YA + (size_t)asg * DM + col) = w; } };
struct EpiSD { const float* mod; float* out;
    __device__ __forceinline__ void operator()(int row, int col, const f32x4& a, const f32x4&, int) const {
        const int b = row / SEQ; const f32x4 g2 = *(const f32x4*)(mod + b * 6 * DM + 5 * DM + col); f32x4* o = (f32x4*)(out + (size_t)row * DM + col);
        f32x4 v = *o; v.x += g2.x * a[0]; v.y += g2.y * a[1]; v.z += g2.z * a[2]; v.w += g2.w * a[3]; *o = v; } };
__device__ __forceinline__ void ph_combine(const Ctx& c, const Params& p) {
    const float* mod = (const float*)(c.ws + WS_MOD); const bf16_t* YA = (const bf16_t*)(c.ws + WS_YA); float* out = p.out;
    for (int idx = c.gtid; idx < T * (DM / 8); idx += c.gthreads) {
        const int t = idx >> 7, col = (idx & 127) * 8, b = t / SEQ;
        float s[8] = {0.f, 0.f, 0.f, 0.f, 0.f, 0.f, 0.f, 0.f};
#pragma unroll
        for (int k = 0; k < 8; ++k) { const u32x4 w = *(const u32x4*)(YA + ((size_t)t * 8 + k) * DM + col); const unsigned* wp = (const unsigned*)&w;
#pragma unroll
            for (int i = 0; i < 4; ++i) { s[2 * i] += __uint_as_float(wp[i] << 16); s[2 * i + 1] += __uint_as_float(wp[i] & 0xffff0000u); } }
        const float* g2 = mod + b * 6 * DM + 5 * DM + col; float* o = out + (size_t)t * DM + col;
        f32x4 o0 = *(f32x4*)o, o1 = *(f32x4*)(o + 4);
        o0.x += g2[0] * s[0]; o0.y += g2[1] * s[1]; o0.z += g2[2] * s[2]; o0.w += g2[3] * s[3];
        o1.x += g2[4] * s[4]; o1.y += g2[5] * s[5]; o1.z += g2[6] * s[6]; o1.w += g2[7] * s[7];
        *(f32x4*)o = o0; *(f32x4*)(o + 4) = o1;
    }
}


#define GAS __attribute__((address_space(1)))
#define LAS __attribute__((address_space(3)))
#define XB_TMO      128
#define XB_XCNT(j)  (256  + 64 * (j))
#define XB_XSUB(j)  (1280 + 64 * (j))
#define XB_XGEN(j)  (2304 + 64 * (j))
#define XB_TOP      3328
#define XB_TOPGEN   3392
#define XCD_BAR_WORDS 3456
#define XB_SPIN_CAP (1u << 18)

__device__ __forceinline__ unsigned xb_ld(unsigned* p)              { return __hip_atomic_load(p, __ATOMIC_RELAXED, __HIP_MEMORY_SCOPE_AGENT); }
__device__ __forceinline__ unsigned xb_add(unsigned* p, unsigned v) { return __hip_atomic_fetch_add(p, v, __ATOMIC_RELAXED, __HIP_MEMORY_SCOPE_AGENT); }
__device__ __forceinline__ unsigned xb_xcc_id() { return (unsigned)__builtin_amdgcn_s_getreg((3 << 11) | 20) & 0xFu; }
#define XB_SPIN(cond, bar) do { unsigned _sp = 0; while (cond) { __builtin_amdgcn_s_sleep(1); \
    if ((++_sp & 255u) == 0u) { if (xb_ld(&(bar)[XB_TMO])) break; if (_sp > XB_SPIN_CAP) { atomicAdd(&(bar)[XB_TMO], 1u); break; } } } } while (0)

struct XcdBarrier {
    unsigned* bar; unsigned x;
    volatile LAS unsigned* st;
};

__device__ __forceinline__ XcdBarrier xcd_barrier_post(unsigned* bar, volatile LAS unsigned* st) {
    XcdBarrier b; b.bar = bar; b.x = xb_xcc_id(); b.st = st;
    if (threadIdx.x == 0) (void)xb_add(&bar[XB_XCNT(b.x)], 1u);
    return b;
}
__device__ __forceinline__ void xcd_barrier_complete(unsigned* bar, unsigned x, unsigned& nloc, unsigned& nx) {
    const unsigned G = gridDim.x * gridDim.y * gridDim.z;
    unsigned sum, cnt, mine, sp = 0u;
    for (;;) {
        sum = 0u; cnt = 0u; mine = 0u;
#pragma unroll
        for (unsigned j = 0; j < 16; ++j) { const unsigned c = xb_ld(&bar[XB_XCNT(j)]); sum += c; cnt += (c > 0u) ? 1u : 0u; mine = (j == x) ? c : mine; }
        if (sum == G) break;
        __builtin_amdgcn_s_sleep(1);
        if ((++sp & 255u) == 0u) { if (xb_ld(&bar[XB_TMO])) break; if (sp > XB_SPIN_CAP) { atomicAdd(&bar[XB_TMO], 1u); break; } }
    }
    nloc = mine > 0u ? mine : 1u; nx = cnt > 0u ? cnt : 1u;
}

__device__ __forceinline__ void xcd_barrier(const XcdBarrier& b) {
    asm volatile("s_waitcnt vmcnt(0)" ::: "memory");
    __syncthreads();
    if (threadIdx.x == 0) {
        unsigned* bar = b.bar;
        __builtin_amdgcn_s_waitcnt(0);
        unsigned nloc = b.st[0], nx = b.st[1];
        if (nloc == 0u) { xcd_barrier_complete(bar, b.x, nloc, nx); b.st[0] = nloc; b.st[1] = nx; }
        const unsigned old = xb_add(&bar[XB_XSUB(b.x)], 1u);
        const unsigned gen = old / nloc;
        if (old + 1u == (gen + 1u) * nloc) {
            __builtin_amdgcn_fence(__ATOMIC_RELEASE, "agent");
            asm volatile("s_waitcnt vmcnt(0)" ::: "memory");
            const unsigned og = xb_add(&bar[XB_TOP], 1u);
            const unsigned tg = og / nx;
            if (og + 1u == (tg + 1u) * nx) xb_add(&bar[XB_TOPGEN], 1u);
            else XB_SPIN(xb_ld(&bar[XB_TOPGEN]) == tg, bar);
            __builtin_amdgcn_fence(__ATOMIC_ACQUIRE, "agent");
            xb_add(&bar[XB_XGEN(b.x)], 1u);
            asm volatile("s_waitcnt vmcnt(0)" ::: "memory");
        } else {
            XB_SPIN(xb_ld(&bar[XB_XGEN(b.x)]) == gen, bar);
            __builtin_amdgcn_fence(__ATOMIC_ACQUIRE, "agent");
            asm volatile("s_waitcnt vmcnt(0)" ::: "memory");
        }
    }
    __syncthreads();
}

namespace pg8 {
#define PG8_LAS __attribute__((address_space(3)))
typedef short bf16x8 __attribute__((ext_vector_type(8)));
typedef int v4i __attribute__((ext_vector_type(4)));
typedef int v8i __attribute__((ext_vector_type(8)));
constexpr int BM = 256, BK = 64, HALF = 128, HTB = HALF * BK * 2  , STAGE_BYTES = 8 * HTB;

__host__ __device__ __forceinline__ int lds_byte(int r, int c) { const int st = (r >> 4) * 2 + (c >> 5), rr = r & 15, cc = c & 31, ob = rr * 64 + cc * 2; return st * 1024 + (ob ^ (((ob >> 9) & 1) << 5)); }
__host__ __device__ __forceinline__ void stage_rc(int b, int& R, int& C) { const int st = b / 1024, sb = b % 1024, swz = sb ^ (((sb >> 9) & 1) << 5); R = (st >> 1) * 16 + swz / 64; C = (st & 1) * 32 + (swz % 64) / 2; }
__host__ __device__ __forceinline__ int perm32(int rho) { const int n = rho >> 4, i = rho & 15; return 8 * (i >> 2) + 4 * n + (i & 3); }

struct Unit { int pm, pn, pb; };
struct Gemm { const bf16_t* A; const bf16_t* Bt; int K, lda; const int* rowidx; unsigned scale_b = 0x7F7F7F7Fu, scale_a = 0x7F7F7F7Fu; };

__device__ __forceinline__ unsigned cvt_pk_bf16(float lo, float hi) { unsigned r; asm volatile("v_cvt_pk_bf16_f32 %0, %1, %2" : "=v"(r) : "v"(lo), "v"(hi)); return r; }

template <class Epi, class Sched, bool GATHER, bool ALIGN_EPI, bool FP8 = false, int FIXED_NT = 0>
__device__ __forceinline__ void gemm_phase(PG8_LAS unsigned char* lds, const Gemm g, const Sched& S, const Epi& E) {
    int tid_ = threadIdx.x; asm volatile("" : "+v"(tid_));
    const int tid = tid_, wid = __builtin_amdgcn_readfirstlane(tid >> 6), lane = tid & 63, wr = wid >> 2, wc = wid & 3, fr = lane & 15, fq = lane >> 4;
    int K_ = g.K; asm volatile("" : "+s"(K_));
    const int K = K_, nt = K / BK, lda = g.lda;
    unsigned voffB[2], oc[2][2], on[2][2];
#pragma unroll
    for (int i = 0; i < 2; ++i) { int R, C; stage_rc(tid * 16 + i * 8192, R, C); const int Rb = Epi::PERM ? ((R & ~31) + perm32(R & 31)) : R;
        voffB[i] = (unsigned)(Rb * K + C) * 2u;
        oc[0][i] = (unsigned)(R * lda + C) * 2u; oc[1][i] = (unsigned)((R + HALF) * lda + C) * 2u; on[0][i] = oc[0][i]; on[1][i] = oc[1][i]; }
    const size_t kstep = (size_t)(BK * 2);
    const size_t hstep = (size_t)HALF * K * 2;
    const size_t tstepB = 2 * hstep, tstepA = (size_t)BM * lda * 2;
    const unsigned ldsw = (unsigned)wid * 1024u;
    const int aoff = lds_byte(wr * 64 + fr, fq * 8), boff = lds_byte(wc * 32 + fr, fq * 8);
#define PG8_SA(b, h) (((b) * 2 + (h)) * HTB)
#define PG8_SB(b, h) ((4 + (b) * 2 + (h)) * HTB)
#define PG8_STAGE(bufoff, gbase, voff) do { _Pragma("unroll") for (int _i = 0; _i < 2; ++_i) \
        __builtin_amdgcn_global_load_lds((const unsigned*)((const char*)(gbase) + (voff)[_i]), (PG8_LAS unsigned*)(lds + (bufoff) + ldsw + _i * 8192), 16, 0, 0); } while (0)
#define PG8_LDA(dst, b, h) do { if constexpr (FP8) { _Pragma("unroll") for (int m = 0; m < 4; ++m) { const v4i lo_ = *(const PG8_LAS v4i*)(lds + PG8_SA(b, h) + aoff + m * 2048), hi_ = *(const PG8_LAS v4i*)(lds + PG8_SA(b, h) + aoff + m * 2048 + 1024); \
            dst##8[m] = __builtin_shufflevector(lo_, hi_, 0, 1, 2, 3, 4, 5, 6, 7); } } \
        else { _Pragma("unroll") for (int m = 0; m < 4; ++m) _Pragma("unroll") for (int k = 0; k < 2; ++k) dst[m][k] = *(const PG8_LAS bf16x8*)(lds + PG8_SA(b, h) + aoff + m * 2048 + k * 1024); } } while (0)
#define PG8_LDB(dst, b, h) do { if constexpr (FP8) { _Pragma("unroll") for (int n = 0; n < 2; ++n) { const v4i lo_ = *(const PG8_LAS v4i*)(lds + PG8_SB(b, h) + boff + n * 2048), hi_ = *(const PG8_LAS v4i*)(lds + PG8_SB(b, h) + boff + n * 2048 + 1024); \
            dst##8[n] = __builtin_shufflevector(lo_, hi_, 0, 1, 2, 3, 4, 5, 6, 7); } } \
        else { _Pragma("unroll") for (int n = 0; n < 2; ++n) _Pragma("unroll") for (int k = 0; k < 2; ++k) dst[n][k] = *(const PG8_LAS bf16x8*)(lds + PG8_SB(b, h) + boff + n * 2048 + k * 1024); } } while (0)
#define PG8_MMA(ai, bj, At, Bt) do { __builtin_amdgcn_s_setprio(1); \
        if constexpr (FP8) {   \
            _Pragma("unroll") for (int m = 0; m < 4; ++m) _Pragma("unroll") for (int n = 0; n < 2; ++n) { \
                acc[ai][bj][m][n] = __builtin_amdgcn_mfma_scale_f32_16x16x128_f8f6f4(Bt##8[n], At##8[m], acc[ai][bj][m][n], 0, 0, 0, (int)g.scale_b, 0, (int)g.scale_a); } \
        } else { \
            _Pragma("unroll") for (int m = 0; m < 4; ++m) _Pragma("unroll") for (int n = 0; n < 2; ++n) _Pragma("unroll") for (int k = 0; k < 2; ++k) \
                acc[ai][bj][m][n] = __builtin_amdgcn_mfma_f32_16x16x32_bf16(Bt[n][k], At[m][k], acc[ai][bj][m][n], 0, 0, 0); } \
        __builtin_amdgcn_s_setprio(0); } while (0)
#define PG8_WAIT_V(n) asm volatile("s_waitcnt vmcnt(" #n ")" ::: "memory")
#define PG8_WAIT_V8S() do { if (FIXED_NT == 2 || (Epi::NSTORE > 0 && fresh)) asm volatile("s_waitcnt vmcnt(%0)" :: "i"(8 + Epi::NSTORE) : "memory"); else asm volatile("s_waitcnt vmcnt(8)" ::: "memory"); } while (0)
#define PG8_WAIT_L(n) asm volatile("s_waitcnt lgkmcnt(" #n ")" ::: "memory")
#define PG8_BAR __builtin_amdgcn_s_barrier()
#define PG8_SCHED __builtin_amdgcn_sched_barrier(0)
#define PG8_GIDX(dst, unit) do { _Pragma("unroll") for (int _i = 0; _i < 2; ++_i) { int R_, C_; stage_rc(tid * 16 + _i * 8192, R_, C_); \
        const int r0_ = g.rowidx ? g.rowidx[(unit).pm * BM + R_] : (unit).pm * BM + R_, r1_ = g.rowidx ? g.rowidx[(unit).pm * BM + HALF + R_] : (unit).pm * BM + HALF + R_; \
        dst[0][_i] = (unsigned)(r0_ * lda + C_) * 2u; dst[1][_i] = (unsigned)(r1_ * lda + C_) * 2u; } } while (0)
    Unit cur, nxt; int ui = 0;
    if (!S.next(0, cur)) return;
    f32x4 acc[2][2][4][2];
#pragma unroll
    for (int a = 0; a < 2; ++a)
#pragma unroll
        for (int b = 0; b < 2; ++b)
#pragma unroll
            for (int m = 0; m < 4; ++m)
#pragma unroll
                for (int n = 0; n < 2; ++n) acc[a][b][m][n] = (f32x4){0.f, 0.f, 0.f, 0.f};
    bf16x8 At[4][2], B0[2][2], B1[2][2]; v8i At8[4], B08[2], B18[2];
    if constexpr (GATHER) { PG8_GIDX(oc, cur); }
    const char* cA = GATHER ? (const char*)g.A : (const char*)g.A + (size_t)cur.pm * tstepA; const char* cB = (const char*)g.Bt + (size_t)cur.pb * tstepB;
    PG8_STAGE(PG8_SB(0, 0), cB, voffB); PG8_STAGE(PG8_SB(0, 1), cB + hstep, voffB); PG8_STAGE(PG8_SA(0, 0), cA, oc[0]); PG8_STAGE(PG8_SA(0, 1), cA, oc[1]);
    if (wr == 1) PG8_BAR;
    PG8_WAIT_V(2); PG8_BAR;
    PG8_STAGE(PG8_SB(1, 0), cB + kstep, voffB); PG8_STAGE(PG8_SA(1, 0), cA + kstep, oc[0]); PG8_STAGE(PG8_SB(1, 1), cB + hstep + kstep, voffB);
    PG8_WAIT_V(6); PG8_BAR;
    if constexpr (FIXED_NT == 2) { PG8_WAIT_V(0); PG8_BAR; }
    bool fresh = false;
    for (;;) {
        const bool has_next = S.next(ui + 1, nxt);
        if constexpr (GATHER) { if (has_next) { PG8_GIDX(on, nxt); } }
        const char* nA = has_next ? (GATHER ? (const char*)g.A : (const char*)g.A + (size_t)nxt.pm * tstepA) : cA; const char* nB = has_next ? (const char*)g.Bt + (size_t)nxt.pb * tstepB : cB;
#pragma unroll 1
        for (int t = 0; t < nt; t += 2) {
            const bool last = (t == nt - 2);
            const char* a1 = cA + (size_t)(t + 1) * kstep;
            const char* a2 = last ? nA : cA + (size_t)(t + 2) * kstep; const char* b2 = last ? nB : cB + (size_t)(t + 2) * kstep;
            const char* a3 = a2 + kstep; const char* b3 = b2 + kstep;
            PG8_LDB(B0, 0, 0); PG8_LDB(B1, 0, 1); PG8_SCHED; PG8_LDA(At, 0, 0); PG8_STAGE(PG8_SA(1, 1), a1, oc[1]);
            if constexpr (GATHER) { if (last && has_next) { oc[0][0] = on[0][0]; oc[0][1] = on[0][1]; oc[1][0] = on[1][0]; oc[1][1] = on[1][1]; } }
            PG8_WAIT_V8S(); PG8_WAIT_L(0); PG8_BAR; PG8_MMA(0, 0, At, B0); PG8_MMA(0, 1, At, B1); PG8_BAR; PG8_SCHED;
            PG8_LDA(At, 0, 1); PG8_STAGE(PG8_SB(0, 0), b2, voffB); PG8_STAGE(PG8_SB(0, 1), b2 + hstep, voffB); PG8_STAGE(PG8_SA(0, 0), a2, oc[0]);
            PG8_WAIT_V8S(); fresh = false; PG8_WAIT_L(0); PG8_BAR; PG8_MMA(1, 0, At, B0); PG8_MMA(1, 1, At, B1); PG8_BAR; PG8_SCHED;
            PG8_LDB(B0, 1, 0); PG8_LDB(B1, 1, 1); PG8_SCHED; PG8_LDA(At, 1, 0); PG8_STAGE(PG8_SA(0, 1), a2, oc[1]);
            PG8_WAIT_V(8); PG8_WAIT_L(0); PG8_BAR; PG8_MMA(0, 0, At, B0); PG8_MMA(0, 1, At, B1); PG8_BAR; PG8_SCHED;
            PG8_LDA(At, 1, 1); PG8_STAGE(PG8_SB(1, 0), b3, voffB); PG8_STAGE(PG8_SB(1, 1), b3 + hstep, voffB); PG8_STAGE(PG8_SA(1, 0), a3, oc[0]);
            PG8_WAIT_V(8); PG8_WAIT_L(0); PG8_BAR; PG8_MMA(1, 0, At, B0); PG8_MMA(1, 1, At, B1); PG8_BAR; PG8_SCHED;
        }
        if constexpr (ALIGN_EPI) { if (wr == 0) PG8_BAR; }
        E(acc, cur, wr, wc, fr, fq);
        if (!has_next) break;
#pragma unroll
        for (int a = 0; a < 2; ++a)
#pragma unroll
            for (int b = 0; b < 2; ++b)
#pragma unroll
                for (int m = 0; m < 4; ++m)
#pragma unroll
                    for (int n = 0; n < 2; ++n) acc[a][b][m][n] = (f32x4){0.f, 0.f, 0.f, 0.f};
        cur = nxt; cA = nA; cB = nB; ++ui; fresh = true;
        if constexpr (ALIGN_EPI) { if (wr == 1) PG8_BAR; }
    }
    PG8_WAIT_V(0);
    if constexpr (!ALIGN_EPI) { if (wr == 0) PG8_BAR; }
    PG8_BAR;
#undef PG8_SA
#undef PG8_SB
#undef PG8_STAGE
#undef PG8_LDA
#undef PG8_LDB
#undef PG8_MMA
#undef PG8_WAIT_V
#undef PG8_WAIT_V8S
#undef PG8_WAIT_L
#undef PG8_BAR
#undef PG8_SCHED
#undef PG8_GIDX
}

struct DenseOrder {
    int nM, nN, nwg, G, c;
    __device__ __forceinline__ void init(int M, int N, int G_, int c_) { nM = M / BM; nN = N / BM; nwg = nM * nN; G = G_; c = c_; }
    __device__ __forceinline__ bool next(int i, Unit& u) const {
        const long L = (long)i * G + c; if (L >= nwg) return false;
        int wgid = (int)L; { const int q = nwg / 8, r = nwg % 8, xcd = wgid % 8, off = wgid / 8; wgid = (xcd < r ? xcd * (q + 1) : r * (q + 1) + (xcd - r) * q) + off; }
        const int nig = 8 * nN, gid = wgid / nig, fm = gid * 8, gsz = (nM - fm) < 8 ? (nM - fm) : 8;
        u.pm = fm + ((wgid % nig) % gsz); u.pn = (wgid % nig) / gsz; u.pb = u.pn; return true;
    }
};
struct GroupedOrder {
    const int* tile_e; int ntiles, NT, G, vcu;
    __device__ __forceinline__ bool next(int i, Unit& u) const {
        const int L = i * G + vcu; if (L >= ntiles * NT) return false;
        const int mt = L / NT, nn = L - mt * NT; u.pm = mt; u.pn = nn; u.pb = tile_e[mt] * NT + nn; return true;
    }
};

#define EPI_ROWS_BEGIN const int row0 = u.pm * BM + wr * 64 + fr; _Pragma("unroll") for (int ai = 0; ai < 2; ++ai) _Pragma("unroll") for (int m = 0; m < 4; ++m) { const int row = row0 + ai * HALF + m * 16;
#define EPI_ROWS_END }
struct EpiWinF {
    static constexpr bool PERM = true; static constexpr int NSTORE = 16;
    bf16_t* QK; bf16_t* V; bf16_t* AP;
    __device__ __forceinline__ void operator()(const f32x4 (&acc)[2][2][4][2], const Unit& u, int wr, int wc, int fr, int fq) const {
        const int colt = u.pn * BM + wc * 32 + 8 * fq;
        EPI_ROWS_BEGIN
#pragma unroll
            for (int bj = 0; bj < 2; ++bj) { const f32x4 v0 = acc[ai][bj][m][0], v1 = acc[ai][bj][m][1]; const int col = colt + bj * HALF;
                u32x4 w; w.x = cvt_pk_bf16(v0[0], v0[1]); w.y = cvt_pk_bf16(v0[2], v0[3]); w.z = cvt_pk_bf16(v1[0], v1[1]); w.w = cvt_pk_bf16(v1[2], v1[3]);
                bf16_t* dst;
                if (u.pn < 4) dst = QK + (size_t)row * 1024 + col;
                else if (u.pn < 6) dst = V + (size_t)row * 512 + (col - 1024);
                else { const int cc = col - 1536, gg = cc >> 4, ch = cc & 15, b = row / SEQ, l = row % SEQ;
                    dst = AP + ((size_t)(gg * (NB * NCHUNK) + b * NCHUNK + (l >> 4)) * APK + (l & 15) * 16 + ch); }
                *(u32x4*)dst = w; }
        EPI_ROWS_END
    }
};
struct EpiGluF {
    static constexpr bool PERM = true; static constexpr int NSTORE = 0;
    const bf16_t* Y; bf16_t* MX; float* ss;
    __device__ __forceinline__ void operator()(const f32x4 (&acc)[2][2][4][2], const Unit& u, int wr, int wc, int fr, int fq) const {
        const int colt = u.pn * BM + wc * 32 + 8 * fq;
        EPI_ROWS_BEGIN
            float s = 0.f;
#pragma unroll
            for (int bj = 0; bj < 2; ++bj) { const int col = colt + bj * HALF; const u32x4 yv = *(const u32x4*)(Y + (size_t)row * 512 + col);
                const f32x4 a0 = acc[ai][bj][m][0], a1 = acc[ai][bj][m][1];
                float v[8];
                v[0] = __uint_as_float(yv.x << 16) * sigmoidf(a0[0]); v[1] = __uint_as_float(yv.x & 0xffff0000u) * sigmoidf(a0[1]);
                v[2] = __uint_as_float(yv.y << 16) * sigmoidf(a0[2]); v[3] = __uint_as_float(yv.y & 0xffff0000u) * sigmoidf(a0[3]);
                v[4] = __uint_as_float(yv.z << 16) * sigmoidf(a1[0]); v[5] = __uint_as_float(yv.z & 0xffff0000u) * sigmoidf(a1[1]);
                v[6] = __uint_as_float(yv.w << 16) * sigmoidf(a1[2]); v[7] = __uint_as_float(yv.w & 0xffff0000u) * sigmoidf(a1[3]);
#pragma unroll
                for (int i = 0; i < 8; ++i) s += v[i] * v[i];
                u32x4 w; w.x = cvt_pk_bf16(v[0], v[1]); w.y = cvt_pk_bf16(v[2], v[3]); w.z = cvt_pk_bf16(v[4], v[5]); w.w = cvt_pk_bf16(v[6], v[7]);
                *(u32x4*)(MX + (size_t)row * 1024 + 512 + col) = w; }
            s += __shfl_xor(s, 16); s += __shfl_xor(s, 32);
            if (fq == 0) ss[(size_t)row * 8 + u.pn * 4 + wc] = s;
        EPI_ROWS_END
    }
};
struct EpiWoutF {
    static constexpr bool PERM = false; static constexpr int NSTORE = 0;
    const float* x; const float* mod; float* out; float* ss;
    __device__ __forceinline__ void operator()(const f32x4 (&acc)[2][2][4][2], const Unit& u, int wr, int wc, int fr, int fq) const {
        const int colt = u.pn * BM + wc * 32 + 4 * fq;
        EPI_ROWS_BEGIN
            const int b = row / SEQ; float s = 0.f;
#pragma unroll
            for (int bj = 0; bj < 2; ++bj)
#pragma unroll
                for (int n = 0; n < 2; ++n) { const int col = colt + bj * HALF + n * 16;
                    const f32x4 xv = *(const f32x4*)(x + (size_t)row * DM + col), g1 = *(const f32x4*)(mod + b * 6 * DM + 2 * DM + col);
                    const f32x4 o = xv + g1 * acc[ai][bj][m][n];
                    *(f32x4*)(out + (size_t)row * DM + col) = o; s += o[0] * o[0] + o[1] * o[1] + o[2] * o[2] + o[3] * o[3]; }
            s += __shfl_xor(s, 16); s += __shfl_xor(s, 32);
            if (fq == 0) ss[(size_t)row * 16 + u.pn * 4 + wc] = s;
        EPI_ROWS_END
    }
};
struct EpiRSF {
    static constexpr bool PERM = true; static constexpr int NSTORE = 0;
    float* L; bf16_t* AS;
    __device__ __forceinline__ void operator()(const f32x4 (&acc)[2][2][4][2], const Unit& u, int wr, int wc, int fr, int fq) const {
        const int c8 = wc * 32 + 8 * fq;
        EPI_ROWS_BEGIN
            if (u.pn == 0) {
#pragma unroll
                for (int bj = 0; bj < 2; ++bj) { float* d = L + (size_t)row * 256 + bj * HALF + c8; *(f32x4*)d = acc[ai][bj][m][0]; *(f32x4*)(d + 4) = acc[ai][bj][m][1]; }
            } else {
                const f32x4 g0 = acc[ai][0][m][0], g1 = acc[ai][0][m][1], u0 = acc[ai][1][m][0], u1 = acc[ai][1][m][1];
                u32x4 w; w.x = cvt_pk_bf16(siluf(g0[0]) * u0[0], siluf(g0[1]) * u0[1]); w.y = cvt_pk_bf16(siluf(g0[2]) * u0[2], siluf(g0[3]) * u0[3]);
                w.z = cvt_pk_bf16(siluf(g1[0]) * u1[0], siluf(g1[1]) * u1[1]); w.w = cvt_pk_bf16(siluf(g1[2]) * u1[2], siluf(g1[3]) * u1[3]);
                *(u32x4*)(AS + (size_t)row * 256 + (u.pn - 1) * 128 + c8) = w;
            }
        EPI_ROWS_END
    }
};
struct EpiSDF {
    static constexpr bool PERM = false; static constexpr int NSTORE = 0;
    const float* mod; float* out;
    __device__ __forceinline__ void operator()(const f32x4 (&acc)[2][2][4][2], const Unit& u, int wr, int wc, int fr, int fq) const {
        const int colt = u.pn * BM + wc * 32 + 4 * fq;
        EPI_ROWS_BEGIN
            const int b = row / SEQ;
#pragma unroll
            for (int bj = 0; bj < 2; ++bj)
#pragma unroll
                for (int n = 0; n < 2; ++n) { const int col = colt + bj * HALF + n * 16; const f32x4 g2 = *(const f32x4*)(mod + b * 6 * DM + 5 * DM + col);
                    f32x4* o = (f32x4*)(out + (size_t)row * DM + col); *o = *o + g2 * acc[ai][bj][m][n]; }
        EPI_ROWS_END
    }
};
struct EpiE1F {
    static constexpr bool PERM = true; static constexpr int NSTORE = 0;
    bf16_t* AE;
    __device__ __forceinline__ void operator()(const f32x4 (&acc)[2][2][4][2], const Unit& u, int wr, int wc, int fr, int fq) const {
        const int c8 = u.pn * 128 + wc * 32 + 8 * fq;
        EPI_ROWS_BEGIN
            const f32x4 g0 = acc[ai][0][m][0], g1 = acc[ai][0][m][1], u0 = acc[ai][1][m][0], u1 = acc[ai][1][m][1];
            u32x4 w; w.x = cvt_pk_bf16(siluf(g0[0]) * u0[0], siluf(g0[1]) * u0[1]); w.y = cvt_pk_bf16(siluf(g0[2]) * u0[2], siluf(g0[3]) * u0[3]);
            w.z = cvt_pk_bf16(siluf(g1[0]) * u1[0], siluf(g1[1]) * u1[1]); w.w = cvt_pk_bf16(siluf(g1[2]) * u1[2], siluf(g1[3]) * u1[3]);
            *(u32x4*)(AE + (size_t)row * 256 + c8) = w;
        EPI_ROWS_END
    }
};
struct EpiE2F {
    static constexpr bool PERM = true; static constexpr int NSTORE = 0;
    const int* sasg; const float* sgate; bf16_t* YA;
    __device__ __forceinline__ void operator()(const f32x4 (&acc)[2][2][4][2], const Unit& u, int wr, int wc, int fr, int fq) const {
        const int colt = u.pn * BM + wc * 32 + 8 * fq;
        EPI_ROWS_BEGIN
            const int asg = sasg[row]; const float gt = sgate[row];
            if (asg >= 0) {
#pragma unroll
                for (int bj = 0; bj < 2; ++bj) { const f32x4 v0 = acc[ai][bj][m][0] * gt, v1 = acc[ai][bj][m][1] * gt;
                    u32x4 w; w.x = cvt_pk_bf16(v0[0], v0[1]); w.y = cvt_pk_bf16(v0[2], v0[3]); w.z = cvt_pk_bf16(v1[0], v1[1]); w.w = cvt_pk_bf16(v1[2], v1[3]);
                    *(u32x4*)(YA + (size_t)asg * DM + colt + bj * HALF) = w; }
            }
        EPI_ROWS_END
    }
};
struct EpiSsmA {
    static constexpr bool PERM = false; static constexpr int NSTORE = 0;
    float* DS;
    __device__ __forceinline__ void operator()(const f32x4 (&acc)[2][2][4][2], const Unit& u, int wr, int wc, int fr, int fq) const {
        EPI_ROWS_BEGIN
#pragma unroll
            for (int n = 0; n < 2; ++n) *(f32x4*)(DS + (size_t)row * 128 + wc * 32 + n * 16 + 4 * fq) = acc[ai][0][m][n];
        EPI_ROWS_END
    }
};
struct EpiSsmC {
    static constexpr bool PERM = true; static constexpr int NSTORE = 0;
    bf16_t* Y;
    __device__ __forceinline__ void operator()(const f32x4 (&acc)[2][2][4][2], const Unit& u, int wr, int wc, int fr, int fq) const {
        EPI_ROWS_BEGIN
            const int gg = row >> 11, rem = row & 2047, b = rem >> 8, chunk = rem & 255; const size_t t0 = (size_t)b * SEQ + chunk * 16;
#pragma unroll
            for (int bj = 0; bj < 2; ++bj) { const int c0 = bj * HALF + wc * 32 + 8 * fq, jp = c0 >> 4, co0 = c0 & 15;
                const f32x4 v0 = acc[ai][bj][m][0], v1 = acc[ai][bj][m][1];
                u32x4 w; w.x = cvt_pk_bf16(gelu_tanh(v0[0]), gelu_tanh(v0[1])); w.y = cvt_pk_bf16(gelu_tanh(v0[2]), gelu_tanh(v0[3]));
                w.z = cvt_pk_bf16(gelu_tanh(v1[0]), gelu_tanh(v1[1])); w.w = cvt_pk_bf16(gelu_tanh(v1[2]), gelu_tanh(v1[3]));
                *(u32x4*)(Y + (t0 + jp) * 512 + gg * 16 + co0) = w; }
        EPI_ROWS_END
    }
};
struct EpiSDC {
    static constexpr bool PERM = true; static constexpr int NSTORE = 0;
    const float* mod; float* out; const bf16_t* YA;
    __device__ __forceinline__ void operator()(const f32x4 (&acc)[2][2][4][2], const Unit& u, int wr, int wc, int fr, int fq) const {
        const int colt = u.pn * BM + wc * 32 + 8 * fq;
        EPI_ROWS_BEGIN
            const int b = row / SEQ;
#pragma unroll
            for (int bj = 0; bj < 2; ++bj) { const int col = colt + bj * HALF;
                f32x4 s0 = acc[ai][bj][m][0], s1 = acc[ai][bj][m][1];
#pragma unroll
                for (int k = 0; k < 8; ++k) { const u32x4 w = *(const u32x4*)(YA + ((size_t)row * 8 + k) * DM + col);
                    s0[0] += __uint_as_float(w.x << 16); s0[1] += __uint_as_float(w.x & 0xffff0000u); s0[2] += __uint_as_float(w.y << 16); s0[3] += __uint_as_float(w.y & 0xffff0000u);
                    s1[0] += __uint_as_float(w.z << 16); s1[1] += __uint_as_float(w.z & 0xffff0000u); s1[2] += __uint_as_float(w.w << 16); s1[3] += __uint_as_float(w.w & 0xffff0000u); }
                const float* g2 = mod + b * 6 * DM + 5 * DM + col; float* o = out + (size_t)row * DM + col;
                *(f32x4*)o = *(const f32x4*)o + *(const f32x4*)g2 * s0; *(f32x4*)(o + 4) = *(const f32x4*)(o + 4) + *(const f32x4*)(g2 + 4) * s1; }
        EPI_ROWS_END
    }
};
struct EpiSDY {
    static constexpr bool PERM = true; static constexpr int NSTORE = 16;
    bf16_t* Y;
    __device__ __forceinline__ void operator()(const f32x4 (&acc)[2][2][4][2], const Unit& u, int wr, int wc, int fr, int fq) const {
        const int colt = u.pn * BM + wc * 32 + 8 * fq;
        EPI_ROWS_BEGIN
#pragma unroll
            for (int bj = 0; bj < 2; ++bj) { const f32x4 v0 = acc[ai][bj][m][0], v1 = acc[ai][bj][m][1];
                u32x4 w; w.x = cvt_pk_bf16(v0[0], v0[1]); w.y = cvt_pk_bf16(v0[2], v0[3]); w.z = cvt_pk_bf16(v1[0], v1[1]); w.w = cvt_pk_bf16(v1[2], v1[3]);
                *(u32x4*)(Y + (size_t)row * DM + colt + bj * HALF) = w; }
        EPI_ROWS_END
    }
};
struct EpiNone { static constexpr bool PERM = true; static constexpr int NSTORE = 0; float* sink;
    __device__ __forceinline__ void operator()(const f32x4 (&acc)[2][2][4][2], const Unit& u, int wr, int wc, int fr, int fq) const {
        float s = 0.f;
#pragma unroll
        for (int ai = 0; ai < 2; ++ai)
#pragma unroll
            for (int bj = 0; bj < 2; ++bj)
#pragma unroll
                for (int m = 0; m < 4; ++m)
#pragma unroll
                    for (int n = 0; n < 2; ++n) s += acc[ai][bj][m][n][0] + acc[ai][bj][m][n][1] + acc[ai][bj][m][n][2] + acc[ai][bj][m][n][3];
        if (s == 1234567.875f) sink[threadIdx.x] = s; } };
struct EpiDense { static constexpr bool PERM = true; static constexpr int NSTORE = 0; bf16_t* Y;
    __device__ __forceinline__ void operator()(const f32x4 (&acc)[2][2][4][2], const Unit& u, int wr, int wc, int fr, int fq) const {
        const int colt = u.pn * BM + wc * 32 + 8 * fq;
        EPI_ROWS_BEGIN
            if (row < T * 8) {
#pragma unroll
            for (int bj = 0; bj < 2; ++bj) { const f32x4 v0 = acc[ai][bj][m][0], v1 = acc[ai][bj][m][1];
                u32x4 w; w.x = cvt_pk_bf16(v0[0], v0[1]); w.y = cvt_pk_bf16(v0[2], v0[3]); w.z = cvt_pk_bf16(v1[0], v1[1]); w.w = cvt_pk_bf16(v1[2], v1[3]);
                *(u32x4*)(Y + (size_t)row * DM + colt + bj * HALF) = w; } }
        EPI_ROWS_END
    } };
struct ProbeOrder { int nunits, G, vcu;
    __device__ __forceinline__ bool next(int i, Unit& u) const { const int L = i * G + vcu; if (L >= nunits) return false; u.pm = vcu & 7; u.pn = 0; u.pb = vcu & 3; return true; } };
struct EpiE2S {
    static constexpr bool PERM = true; static constexpr int NSTORE = 16;
    const int* sasg; const float* sgate; bf16_t* YS;
    __device__ __forceinline__ void operator()(const f32x4 (&acc)[2][2][4][2], const Unit& u, int wr, int wc, int fr, int fq) const {
        const int colt = u.pn * BM + wc * 32 + 8 * fq; const int row0 = u.pm * BM + wr * 64 + fr;
        float gt[2][4];
#pragma unroll
        for (int ai = 0; ai < 2; ++ai)
#pragma unroll
            for (int m = 0; m < 4; ++m) gt[ai][m] = sgate[row0 + ai * HALF + m * 16];
        asm volatile("s_waitcnt vmcnt(0)" : "+v"(gt[0][0]), "+v"(gt[0][1]), "+v"(gt[0][2]), "+v"(gt[0][3]), "+v"(gt[1][0]), "+v"(gt[1][1]), "+v"(gt[1][2]), "+v"(gt[1][3]) :: "memory");
#pragma unroll
        for (int ai = 0; ai < 2; ++ai)
#pragma unroll
            for (int m = 0; m < 4; ++m) { const int row = row0 + ai * HALF + m * 16;
#pragma unroll
                for (int bj = 0; bj < 2; ++bj) { const f32x4 v0 = acc[ai][bj][m][0] * gt[ai][m], v1 = acc[ai][bj][m][1] * gt[ai][m];
                    u32x4 w; w.x = cvt_pk_bf16(v0[0], v0[1]); w.y = cvt_pk_bf16(v0[2], v0[3]); w.z = cvt_pk_bf16(v1[0], v1[1]); w.w = cvt_pk_bf16(v1[2], v1[3]);
                    *(u32x4*)(YS + (size_t)row * DM + colt + bj * HALF) = w; } }
    }
};
struct EpiE1F8 {
    static constexpr bool PERM = true; static constexpr int NSTORE = 0;
    unsigned char* AE;
    __device__ __forceinline__ void operator()(const f32x4 (&acc)[2][2][4][2], const Unit& u, int wr, int wc, int fr, int fq) const {
        const int c8 = u.pn * 128 + wc * 32 + 8 * fq;
        EPI_ROWS_BEGIN
            const f32x4 g0 = acc[ai][0][m][0], g1 = acc[ai][0][m][1], u0 = acc[ai][1][m][0], u1 = acc[ai][1][m][1];
            u32x2 w; w.x = pk4_fp8(ACT8_SCALE * siluf(g0[0]) * u0[0], ACT8_SCALE * siluf(g0[1]) * u0[1], ACT8_SCALE * siluf(g0[2]) * u0[2], ACT8_SCALE * siluf(g0[3]) * u0[3]);
            w.y = pk4_fp8(ACT8_SCALE * siluf(g1[0]) * u1[0], ACT8_SCALE * siluf(g1[1]) * u1[1], ACT8_SCALE * siluf(g1[2]) * u1[2], ACT8_SCALE * siluf(g1[3]) * u1[3]);
            *(u32x2*)(AE + (size_t)row * 256 + c8) = w;
        EPI_ROWS_END
    }
};
struct EpiE2S8 {
    static constexpr bool PERM = true; static constexpr int NSTORE = 16;
    const float* sgate; unsigned char* YS;
    __device__ __forceinline__ void operator()(const f32x4 (&acc)[2][2][4][2], const Unit& u, int wr, int wc, int fr, int fq) const {
        const int colt = u.pn * BM + wc * 32 + 8 * fq; const int row0 = u.pm * BM + wr * 64 + fr;
        float gt[2][4];
#pragma unroll
        for (int ai = 0; ai < 2; ++ai)
#pragma unroll
            for (int m = 0; m < 4; ++m) gt[ai][m] = sgate[row0 + ai * HALF + m * 16] * Y8_SCALE;
        asm volatile("s_waitcnt vmcnt(0)" : "+v"(gt[0][0]), "+v"(gt[0][1]), "+v"(gt[0][2]), "+v"(gt[0][3]), "+v"(gt[1][0]), "+v"(gt[1][1]), "+v"(gt[1][2]), "+v"(gt[1][3]) :: "memory");
#pragma unroll
        for (int ai = 0; ai < 2; ++ai)
#pragma unroll
            for (int m = 0; m < 4; ++m) { const int row = row0 + ai * HALF + m * 16;
#pragma unroll
                for (int bj = 0; bj < 2; ++bj) { const f32x4 v0 = acc[ai][bj][m][0] * gt[ai][m], v1 = acc[ai][bj][m][1] * gt[ai][m];
                    u32x2 w; w.x = pk4_fp8(v0[0], v0[1], v0[2], v0[3]); w.y = pk4_fp8(v1[0], v1[1], v1[2], v1[3]);
                    *(u32x2*)(YS + (size_t)row * DM + colt + bj * HALF) = w; } }
    }
};
struct EpiE2S8b {
    static constexpr bool PERM = true; static constexpr int NSTORE = 0;
    const float* sgate; unsigned char* YS;
    __device__ __forceinline__ void operator()(const f32x4 (&acc)[2][2][4][2], const Unit& u, int wr, int wc, int fr, int fq) const {
        const int colt = u.pn * BM + wc * 32 + 8 * fq;
        EPI_ROWS_BEGIN
            const float gt = sgate[row] * Y8_SCALE;
#pragma unroll
            for (int bj = 0; bj < 2; ++bj) { const f32x4 v0 = acc[ai][bj][m][0] * gt, v1 = acc[ai][bj][m][1] * gt;
                u32x2 w; w.x = pk4_fp8(v0[0], v0[1], v0[2], v0[3]); w.y = pk4_fp8(v1[0], v1[1], v1[2], v1[3]);
                *(u32x2*)(YS + (size_t)row * DM + colt + bj * HALF) = w; }
        EPI_ROWS_END
    }
};
struct EpiE1G8 {
    static constexpr bool PERM = true; static constexpr int NSTORE = 0;
    const float* sgate; unsigned char* AE;
    __device__ __forceinline__ void operator()(const f32x4 (&acc)[2][2][4][2], const Unit& u, int wr, int wc, int fr, int fq) const {
        const int c8 = u.pn * 128 + wc * 32 + 8 * fq;
        EPI_ROWS_BEGIN
            const float gs = sgate[row] * ACT8_SCALE;
            const f32x4 g0 = acc[ai][0][m][0], g1 = acc[ai][0][m][1], u0 = acc[ai][1][m][0], u1 = acc[ai][1][m][1];
            u32x2 w; w.x = pk4_fp8(gs * siluf(g0[0]) * u0[0], gs * siluf(g0[1]) * u0[1], gs * siluf(g0[2]) * u0[2], gs * siluf(g0[3]) * u0[3]);
            w.y = pk4_fp8(gs * siluf(g1[0]) * u1[0], gs * siluf(g1[1]) * u1[1], gs * siluf(g1[2]) * u1[2], gs * siluf(g1[3]) * u1[3]);
            *(u32x2*)(AE + (size_t)row * 256 + c8) = w;
        EPI_ROWS_END
    }
};
struct EpiE2P8 {
    static constexpr bool PERM = true; static constexpr int NSTORE = 16;
    unsigned char* YS;
    __device__ __forceinline__ void operator()(const f32x4 (&acc)[2][2][4][2], const Unit& u, int wr, int wc, int fr, int fq) const {
        const int colt = u.pn * BM + wc * 32 + 8 * fq;
        unsigned char* ptr = YS + (size_t)(u.pm * BM + wr * 64 + fr) * DM + colt;
#pragma unroll
        for (int ai = 0; ai < 2; ++ai) {
#pragma unroll
            for (int m = 0; m < 4; ++m) {
#pragma unroll
                for (int bj = 0; bj < 2; ++bj) { const f32x4 v0 = acc[ai][bj][m][0], v1 = acc[ai][bj][m][1];
                    u32x2 w; w.x = pk4_fp8(v0[0], v0[1], v0[2], v0[3]); w.y = pk4_fp8(v1[0], v1[1], v1[2], v1[3]);
                    *(u32x2*)(ptr + bj * HALF) = w; }
                ptr += 16 * DM; asm volatile("" : "+v"(ptr)); __builtin_amdgcn_sched_barrier(0); }
            ptr += (HALF - 64) * DM; }
    }
};
struct GroupedOrderL {
    const PG8_LAS int* le; int ntiles, NT, G, vcu;
    __device__ __forceinline__ void fill(const int* tile_e, PG8_LAS int* dst) { le = dst; const int tot = ntiles * NT;
        for (int i = threadIdx.x; i * G + vcu < tot; i += blockDim.x) dst[i] = tile_e[(i * G + vcu) / NT];
        __syncthreads(); }
    __device__ __forceinline__ bool next(int i, Unit& u) const {
        const int L = i * G + vcu; if (L >= ntiles * NT) return false;
        const int mt = L / NT, nn = L - mt * NT; u.pm = mt; u.pn = nn; u.pb = le[i] * NT + nn; return true;
    }
};
struct SsmOrder {
    int G, vcu;
    __device__ __forceinline__ bool next(int i, Unit& u) const { const int L = i * G + vcu; if (L >= 256) return false; u.pm = L; u.pn = 0; u.pb = L >> 3; return true; }
};
}

__device__ __forceinline__ void transpose_item(const float* W, int K, int N, bf16_t* WT, int kb, int nb, int rowbase, float* scr, int lane) {
    const int k0 = 64 * kb, n0 = 32 * nb;
#pragma unroll 8
    for (int i = 0; i < 32; ++i) { const int kk = 2 * i + (lane >> 5); scr[kk * 33 + (lane & 31)] = W[(size_t)(k0 + kk) * N + n0 + (lane & 31)]; }
    asm volatile("s_waitcnt lgkmcnt(0)" ::: "memory");
    const int cch = lane & 7;
#pragma unroll
    for (int j = 0; j < 4; ++j) { const int n = (lane >> 3) + 8 * j; const float* s = scr + (8 * cch) * 33 + n;
        u32x4 o; o.x = pk2(s[0 * 33], s[1 * 33]); o.y = pk2(s[2 * 33], s[3 * 33]); o.z = pk2(s[4 * 33], s[5 * 33]); o.w = pk2(s[6 * 33], s[7 * 33]);
        *(u32x4*)(WT + (size_t)(rowbase + n) * K + k0 + 8 * cch) = o; }
    asm volatile("s_waitcnt lgkmcnt(0)" ::: "memory");
}
__device__ __forceinline__ int gu_row(int n0, int up) { return (n0 >> 7) * 256 + up * 128 + (n0 & 127); }
template <bool EXPERTS>
__device__ __forceinline__ void ph_convert(const Ctx& c, const Params& p) {
    float* scr = c.lds + c.wave * (64 * 33);
    unsigned char* ws = c.ws;
    constexpr int I0 = 16 * 64, I1 = 16 * 32, I2 = 8 * 16, I3 = 16 * 8, I6 = 4 * 32, IE = 128;
    constexpr int DENSE = I0 + I1 + I2 + 3 * I3 + I6, NITEMS = EXPERTS ? DENSE + 3 * IE * NE : DENSE;
    for (int it = c.gwave; it < NITEMS; it += c.gwaves) {
        int r = it;
        if (r < I0) { transpose_item(p.in[I_WIN], DM, 2048, (bf16_t*)(ws + WS_WIN_T), r / 64, r % 64, (r % 64) * 32, scr, c.lane); continue; } r -= I0;
        if (r < I1) { transpose_item(p.in[I_WOUT], DM, DM, (bf16_t*)(ws + WS_WOUT_T), r / 32, r % 32, (r % 32) * 32, scr, c.lane); continue; } r -= I1;
        if (r < I2) { transpose_item(p.in[I_WGLU], 512, 512, (bf16_t*)(ws + WS_WGLU_T), r / 16, r % 16, (r % 16) * 32, scr, c.lane); continue; } r -= I2;
        if (r < I3) { transpose_item(p.in[I_WR], DM, 256, (bf16_t*)(ws + WS_WRS_T), r / 8, r % 8, (r % 8) * 32, scr, c.lane); continue; } r -= I3;
        if (r < I3) { transpose_item(p.in[I_WGS], DM, 256, (bf16_t*)(ws + WS_WRS_T), r / 8, r % 8, 256 + gu_row((r % 8) * 32, 0), scr, c.lane); continue; } r -= I3;
        if (r < I3) { transpose_item(p.in[I_WUS], DM, 256, (bf16_t*)(ws + WS_WRS_T), r / 8, r % 8, 256 + gu_row((r % 8) * 32, 1), scr, c.lane); continue; } r -= I3;
        if (r < I6) { transpose_item(p.in[I_WDS], 256, DM, (bf16_t*)(ws + WS_WDS_T), r / 32, r % 32, (r % 32) * 32, scr, c.lane); continue; } r -= I6;
        const int e = r / (3 * IE), q = r % (3 * IE), which = q / IE, ii = q % IE;
        if (which == 0) transpose_item(p.in[I_WGE] + (size_t)e * DM * ED, DM, ED, (bf16_t*)(ws + WS_WGU) + (size_t)e * 512 * DM, ii / 8, ii % 8, gu_row((ii % 8) * 32, 0), scr, c.lane);
        else if (which == 1) transpose_item(p.in[I_WUE] + (size_t)e * DM * ED, DM, ED, (bf16_t*)(ws + WS_WGU) + (size_t)e * 512 * DM, ii / 8, ii % 8, gu_row((ii % 8) * 32, 1), scr, c.lane);
        else transpose_item(p.in[I_WDE] + (size_t)e * ED * DM, ED, DM, (bf16_t*)(ws + WS_WD) + (size_t)e * DM * ED, ii / 32, ii % 32, (ii % 32) * 32, scr, c.lane);
    }
}

__device__ __forceinline__ void transpose_tile64(const float* W, int K, int N, bf16_t* WT, int kb, int nb, int rowbase, float* scr, int lane) {
    const int k0 = 64 * kb, n0 = 64 * nb;
    f32x4 v[16];
#pragma unroll
    for (int i = 0; i < 16; ++i) v[i] = *(const f32x4*)(W + (size_t)(k0 + 4 * i + (lane >> 4)) * N + n0 + (lane & 15) * 4);
#pragma unroll
    for (int i = 0; i < 16; ++i) { float* d = scr + (4 * i + (lane >> 4)) * 65 + (lane & 15) * 4; d[0] = v[i].x; d[1] = v[i].y; d[2] = v[i].z; d[3] = v[i].w; }
    asm volatile("s_waitcnt lgkmcnt(0)" ::: "memory");
    const int cch = lane & 7;
#pragma unroll
    for (int jj = 0; jj < 8; ++jj) { const int n = (lane >> 3) + 8 * jj; const float* s_ = scr + (8 * cch) * 65 + n;
        u32x4 o; o.x = pk2(s_[0 * 65], s_[1 * 65]); o.y = pk2(s_[2 * 65], s_[3 * 65]); o.z = pk2(s_[4 * 65], s_[5 * 65]); o.w = pk2(s_[6 * 65], s_[7 * 65]);
        *(u32x4*)(WT + (size_t)(rowbase + n) * K + k0 + 8 * cch) = o; }
    asm volatile("s_waitcnt lgkmcnt(0)" ::: "memory");
}
struct ConvTile { const float* W; bf16_t* WT; int K, N, k0, n0, rowbase; bool f8; float scale; };
template <int GU8>
__device__ __forceinline__ ConvTile conv_tile_ref(const Ctx& c, const Params& p, int id) {
    const int e = id / 192, q = id % 192, which = q >> 6, ii = q & 63; ConvTile t; t.f8 = (GU8 >= 1 && which < 2) || (GU8 == 2); t.scale = which < 2 ? WGU8_SCALE : WD8_SCALE;
    if (which == 0) { t.W = p.in[I_WGE] + (size_t)e * DM * ED; t.WT = (bf16_t*)(c.ws + WS_WGU) + (size_t)e * 512 * (GU8 ? DM / 2 : DM); t.K = DM; t.N = ED; t.k0 = 64 * (ii >> 2); t.n0 = 64 * (ii & 3); t.rowbase = gu_row(t.n0, 0); }
    else if (which == 1) { t.W = p.in[I_WUE] + (size_t)e * DM * ED; t.WT = (bf16_t*)(c.ws + WS_WGU) + (size_t)e * 512 * (GU8 ? DM / 2 : DM); t.K = DM; t.N = ED; t.k0 = 64 * (ii >> 2); t.n0 = 64 * (ii & 3); t.rowbase = gu_row(t.n0, 1); }
    else { t.W = p.in[I_WDE] + (size_t)e * ED * DM; t.WT = (bf16_t*)(c.ws + WS_WD) + (size_t)e * DM * (GU8 == 2 ? ED / 2 : ED); t.K = ED; t.N = DM; t.k0 = 64 * (ii >> 4); t.n0 = 64 * (ii & 15); t.rowbase = t.n0; }
    return t;
}
#define CONV_LOAD(v, t) do { const float* p_ = (t).W + (size_t)((t).k0 + (c.lane >> 4)) * (t).N + (t).n0 + (c.lane & 15) * 4; const size_t st_ = (size_t)4 * (t).N; \
        _Pragma("unroll") for (int i_ = 0; i_ < 16; ++i_) { v[i_] = *(const f32x4*)p_; p_ += st_; asm volatile("" : "+v"(p_)); } } while (0)
#define CONV_FINISH(v, t) do { _Pragma("unroll") for (int i_ = 0; i_ < 16; ++i_) { float* d_ = scr + (4 * i_ + (c.lane >> 4)) * 65 + (c.lane & 15) * 4; d_[0] = v[i_].x; d_[1] = v[i_].y; d_[2] = v[i_].z; d_[3] = v[i_].w; } \
        asm volatile("s_waitcnt lgkmcnt(0)" ::: "memory"); \
        { const int esz_ = (t).f8 ? 1 : 2; unsigned char* q_ = (unsigned char*)(t).WT + ((size_t)((t).rowbase + (c.lane >> 3)) * (t).K + (t).k0 + 8 * (c.lane & 7)) * esz_; const size_t qs_ = (size_t)8 * (t).K * esz_; \
        _Pragma("unroll") for (int jj_ = 0; jj_ < 8; ++jj_) { const float* s_ = scr + (8 * (c.lane & 7)) * 65 + (c.lane >> 3) + 8 * jj_; \
            if ((t).f8) { u32x2 o_; o_.x = pk4_fp8(s_[0 * 65] * (t).scale, s_[1 * 65] * (t).scale, s_[2 * 65] * (t).scale, s_[3 * 65] * (t).scale); \
                o_.y = pk4_fp8(s_[4 * 65] * (t).scale, s_[5 * 65] * (t).scale, s_[6 * 65] * (t).scale, s_[7 * 65] * (t).scale); \
                *(u32x2*)q_ = o_; } \
            else { u32x4 o_; o_.x = pk2(s_[0 * 65], s_[1 * 65]); o_.y = pk2(s_[2 * 65], s_[3 * 65]); o_.z = pk2(s_[4 * 65], s_[5 * 65]); o_.w = pk2(s_[6 * 65], s_[7 * 65]); \
                *(u32x4*)q_ = o_; } \
            q_ += qs_; asm volatile("" : "+v"(q_)); } } \
        asm volatile("s_waitcnt lgkmcnt(0)" ::: "memory"); } while (0)
template <int GU8>
__device__ __forceinline__ void conv_range(const Ctx& c, const Params& p, int first, int end, int stride, float* scr) {
    if (first >= end) return;
    f32x4 va[16], vb[16];
    ConvTile ta = conv_tile_ref<GU8>(c, p, first), tb = ta;
    CONV_LOAD(va, ta);
    for (int id = first; id < end; id += 2 * stride) {
        const bool hb = id + stride < end;
        if (hb) { tb = conv_tile_ref<GU8>(c, p, id + stride); CONV_LOAD(vb, tb); }
        CONV_FINISH(va, ta);
        if (!hb) break;
        const bool ha = id + 2 * stride < end;
        if (ha) { ta = conv_tile_ref<GU8>(c, p, id + 2 * stride); CONV_LOAD(va, ta); }
        CONV_FINISH(vb, tb);
        if (!ha) break;
    }
}
__device__ __forceinline__ void conv_tile_by_id(const Ctx& c, const Params& p, int id, float* scr) { conv_range<0>(c, p, id, id + 1, 1, scr); }
__device__ __forceinline__ void conv_queue(const Ctx& c, const Params& p, unsigned* qctr) {
    float* scr = c.lds + c.wave * (64 * 65);
    constexpr int NTILES = NE * 192, CHUNK = 16;
    for (;;) {
        int tk = 0; if (c.lane == 0) tk = (int)atomicAdd(qctr, 1u);
        tk = __builtin_amdgcn_readfirstlane(tk);
        if (tk * CHUNK >= NTILES) break;
        conv_range<0>(c, p, tk * CHUNK, tk * CHUNK + CHUNK, 1, scr);
    }
}
__device__ __forceinline__ void ph_prologue2(const Ctx& c, const Params& p) {
    float* mod = (float*)(c.ws + WS_MOD);
    const bool split = c.nb >= 2 * 96;
    const bool is_mod = c.bid < 96 || !split, is_helper = c.bid >= 96 || !split;
    const int hid = split ? (c.bid - 96) * NTHREADS_ + c.tid : c.gtid, hn = split ? (c.nb - 96) * NTHREADS_ : c.gthreads;
    float* sc = c.lds;
    if (is_mod) { for (int i = c.tid; i < NB * DM; i += NTHREADS_) sc[i] = siluf(p.in[I_C][i]); }
    __syncthreads();
    float* red = c.lds + NB * DM;
    if (is_mod) for (int cg = c.bid; cg < 96; cg += c.nb) {
        const int ks = c.wave, col = cg * 64 + c.lane;
        const float* w = p.in[I_WADA] + (size_t)(ks * 128) * (6 * DM) + col;
        float acc[8];
#pragma unroll
        for (int b = 0; b < 8; ++b) acc[b] = 0.f;
#pragma unroll
        for (int h = 0; h < 2; ++h) {
            float wv[64];
#pragma unroll
            for (int k = 0; k < 64; ++k) wv[k] = w[(size_t)(h * 64 + k) * (6 * DM)];
#pragma unroll
            for (int k = 0; k < 64; k += 4) {
#pragma unroll
                for (int b = 0; b < 8; ++b) { const f32x4 s4 = *(const f32x4*)(sc + b * DM + ks * 128 + h * 64 + k);
                    acc[b] += s4.x * wv[k]; acc[b] += s4.y * wv[k + 1]; acc[b] += s4.z * wv[k + 2]; acc[b] += s4.w * wv[k + 3]; } }
        }
#pragma unroll
        for (int b = 0; b < 8; ++b) red[(ks * 8 + b) * 64 + c.lane] = acc[b];
        __syncthreads();
        { const int b = c.wave; float sum = p.in[I_BADA][col];
#pragma unroll
          for (int k2 = 0; k2 < 8; ++k2) sum += red[(k2 * 8 + b) * 64 + c.lane];
          mod[b * 6 * DM + col] = sum; }
        __syncthreads();
    }
    float* ropec = (float*)(c.ws + WS_ROPE); float* ropes = ropec + SEQ * 32;
    if (is_helper) for (int idx = hid; idx < SEQ * 32; idx += hn) {
        const int l = idx >> 5, i = idx & 31;
        const double invf = exp(-log(10000.0) * (double)(2 * i) / 64.0);
        const double ang = (double)l * invf;
        ropec[idx] = (float)cos(ang); ropes[idx] = (float)sin(ang);
    }
    float* sp = (float*)(c.ws + WS_SSMP);
    float* abr = sp, * abi = sp + SG * SP, * bbr = sp + 2 * SG * SP, * bbi = bbr + SG * SP * SC;
    if (is_helper) for (int idx = hid; idx < SG * SP; idx += hn) {
        const int g = idx / SP;
        const double are = p.in[I_ARE][idx], aim = p.in[I_AIM][idx], dt = exp((double)p.in[I_LOGDT][g]);
        const double mag = exp(are * dt), ar = mag * cos(aim * dt), ai = mag * sin(aim * dt);
        abr[idx] = (float)ar; abi[idx] = (float)ai;
        const double den = are * are + aim * aim, nr = ar - 1.0;
        const double fre = (nr * are + ai * aim) / den, fim = (ai * are - nr * aim) / den;
        for (int ch = 0; ch < SC; ++ch) {
            const double br = p.in[I_BRE][idx * SC + ch], bi = p.in[I_BIM][idx * SC + ch];
            bbr[idx * SC + ch] = (float)(fre * br - fim * bi); bbi[idx * SC + ch] = (float)(fre * bi + fim * br);
        }
    }
    if (is_helper) for (int idx = hn - 1 - hid; idx < SG * SP * 17; idx += hn) {
        const int gp = idx / 17, d = idx % 17, g = gp / SP;
        const double are = p.in[I_ARE][gp], aim = p.in[I_AIM][gp], dt = exp((double)p.in[I_LOGDT][g]);
        const double m = exp(are * dt * d); float* pw = (float*)(c.ws + WS_SSMPW) + (size_t)gp * 34;
        pw[2 * d] = (float)(m * cos(aim * dt * d)); pw[2 * d + 1] = (float)(m * sin(aim * dt * d));
    }
    if (c.bid == c.nb - 1 && c.wave == 0) {
        static_assert(HD == 64, "one lane per head-dim element");
        float s1 = p.in[I_LQ1][c.lane] * p.in[I_LK1][c.lane], s2 = p.in[I_LQ2][c.lane] * p.in[I_LK2][c.lane];
        float gq = fabsf(p.in[I_QNG][c.lane]), gk = fabsf(p.in[I_KNG][c.lane]);
#pragma unroll
        for (int o = 1; o < 64; o <<= 1) { s1 += __shfl_xor(s1, o); s2 += __shfl_xor(s2, o); gq = fmaxf(gq, __shfl_xor(gq, o)); gk = fmaxf(gk, __shfl_xor(gk, o)); }
        if (c.lane == 0) { float* lam = (float*)(c.ws + WS_LAM);
            lam[0] = __expf(s1) - __expf(s2) + LAM_INIT;
            lam[1] = 0.125f * 64.f * gq * gk; }
    }
    int* stok = (int*)(c.ws + WS_SLOT_TOK); int* sasg = (int*)(c.ws + WS_SLOT_ASG); float* sgate = (float*)(c.ws + WS_SLOT_GATE);
    if (is_helper) for (int idx = hid; idx < NS_MAX; idx += hn) { stok[idx] = 0; sasg[idx] = -1; sgate[idx] = 0.f; }
    int* te = (int*)(c.ws + WS_TILE_E);
    if (is_helper) for (int idx = hid; idx < NS_MAX / 256; idx += hn) te[idx] = -1;
    __syncthreads();
}
__device__ __forceinline__ void ph_slot2(const Ctx& c, const Params& p) {
    const unsigned* counts = (const unsigned*)(c.ws + WS_CTL) + CW_COUNTS; unsigned* cursor = (unsigned*)(c.ws + WS_CTL) + CW_CURSOR;
    int* pc = (int*)c.lds; int* ps = pc + 256;
    if (c.tid < NE) pc[c.tid] = ((int)counts[c.tid] + 255) / 256 * 256;
    __syncthreads();
    if (c.tid <= NE) { int acc = 0; for (int e = 0; e < c.tid; ++e) acc += pc[e]; ps[c.tid] = acc; }
    __syncthreads();
    const int* eidx = (const int*)(c.ws + WS_EIDX); const float* gw = (const float*)(c.ws + WS_GATEW);
    int* stok = (int*)(c.ws + WS_SLOT_TOK); int* sasg = (int*)(c.ws + WS_SLOT_ASG); float* sgate = (float*)(c.ws + WS_SLOT_GATE);
    for (int a = c.gtid; a < T * TOPK; a += c.gthreads) {
        const int e = eidx[a]; const unsigned pos = atomicAdd(cursor + e, 1u); const int slot = ps[e] + (int)pos;
        stok[slot] = a >> 3; sasg[slot] = a; sgate[slot] = gw[a];
    }
    if (c.bid == 0) {
        int* te = (int*)(c.ws + WS_TILE_E);
        for (int e = c.tid; e < NE; e += NTHREADS_) for (int tl = ps[e] / 256; tl < ps[e + 1] / 256; ++tl) te[tl] = e;
        if (c.tid == 0) ((unsigned*)(c.ws + WS_CTL))[CW_NTILES] = (unsigned)(ps[NE] / 256);
    }
    __syncthreads();
}

template <int CTRL> __device__ __forceinline__ float dpp_f(float v) { return __builtin_bit_cast(float, __builtin_amdgcn_update_dpp(0, __builtin_bit_cast(int, v), CTRL, 0xF, 0xF, false)); }
template <int CTRL> __device__ __forceinline__ int dpp_i(int v) { return __builtin_amdgcn_update_dpp(0, v, CTRL, 0xF, 0xF, false); }
#define DPP_XOR1 0xB1
#define DPP_XOR2 0x4E
#define DPP_HMIR 0x141
#define DPP_MIR 0x140
__device__ __forceinline__ void ph_qkn2(const Ctx& c, const Params& p) {
    bf16_t* QK = (bf16_t*)(c.ws + WS_QK);
    const float* ropec = (const float*)(c.ws + WS_ROPE); const float* ropes = ropec + SEQ * 32;
    const int l = c.lane, qt = l & 3; const bool hi_half = qt >= 2;
    const float qsc = l < 32 ? 0.125f * 1.4426950408889634f : 1.f;
    float g[16];
#pragma unroll
    for (int j = 0; j < 16; ++j) g[j] = (l < 32 ? p.in[I_QNG] : p.in[I_KNG])[16 * qt + j];
    constexpr int R = 2;
    for (int t0 = c.gwave * R; t0 < T; t0 += c.gwaves * R) {
        u32x4 w[R][2]; f32x4 cs[R][4], sn[R][4];
#pragma unroll
        for (int r = 0; r < R; ++r) { const int t = t0 + r, pos = t % SEQ;
            w[r][0] = *(const u32x4*)(QK + (size_t)t * 1024 + l * 16); w[r][1] = *(const u32x4*)(QK + (size_t)t * 1024 + l * 16 + 8);
#pragma unroll
            for (int q = 0; q < 4; ++q) { cs[r][q] = *(const f32x4*)(ropec + pos * 32 + 16 * (qt & 1) + 4 * q); sn[r][q] = *(const f32x4*)(ropes + pos * 32 + 16 * (qt & 1) + 4 * q); } }
#pragma unroll
        for (int r = 0; r < R; ++r) {
            float v[16]; const unsigned* wp = (const unsigned*)&w[r][0];
#pragma unroll
            for (int i = 0; i < 8; ++i) { v[2 * i] = __uint_as_float(wp[i] << 16); v[2 * i + 1] = __uint_as_float(wp[i] & 0xffff0000u); }
            float ss = 0.f;
#pragma unroll
            for (int j = 0; j < 16; ++j) ss += v[j] * v[j];
            ss += dpp_f<DPP_XOR1>(ss); ss += dpp_f<DPP_XOR2>(ss);
            const float rstd = rsqrtf(ss * (1.f / 64.f) + EPS);
            unsigned o[8];
#pragma unroll
            for (int i = 0; i < 8; ++i) { float res[2];
#pragma unroll
                for (int e = 0; e < 2; ++e) { const int j = 2 * i + e; const float y = v[j] * rstd * g[j]; const float pr = dpp_f<DPP_XOR2>(y);
                    const float cc_ = cs[r][j >> 2][j & 3], s_ = sn[r][j >> 2][j & 3];
                    res[e] = (hi_half ? (pr * s_ + y * cc_) : (y * cc_ - pr * s_)) * qsc; }
                o[i] = pk2(res[0], res[1]); }
            *(u32x4*)(QK + (size_t)(t0 + r) * 1024 + l * 16) = (u32x4){o[0], o[1], o[2], o[3]}; *(u32x4*)(QK + (size_t)(t0 + r) * 1024 + l * 16 + 8) = (u32x4){o[4], o[5], o[6], o[7]};
        }
    }
}
template <bool ATOMIC_BASE>
__device__ __forceinline__ void ph_route2(const Ctx& c, const Params& p) {
    const float* L = (const float*)(c.ws + WS_LOGITS);
    int* eidx = (int*)(c.ws + WS_EIDX); float* gw = (float*)(c.ws + WS_GATEW); int* HIST = (int*)(c.ws + WS_HIST);
    int* hist = (int*)c.lds;
    if (c.tid < NE) hist[c.tid] = 0;
    __syncthreads();
    const int j = c.lane & 15, r = c.lane >> 4, g = j >> 1; const float NEG = -__builtin_inff();
    float rb[16];
#pragma unroll
    for (int i = 0; i < 16; ++i) rb[i] = p.in[I_RB][16 * j + i];
    for (int blk = c.bid; blk < T / 128; blk += c.nb) {
        for (int it = 0; it < 4; ++it) {
            const int t = blk * 128 + it * 32 + c.wave * 4 + r;
            float s[16], mv[16];
            { const f32x4* lp = (const f32x4*)(L + (size_t)t * 256 + 16 * j);
#pragma unroll
              for (int q = 0; q < 4; ++q) { const f32x4 x = lp[q]; s[4 * q] = sigmoidf(x.x); s[4 * q + 1] = sigmoidf(x.y); s[4 * q + 2] = sigmoidf(x.z); s[4 * q + 3] = sigmoidf(x.w); } }
            float m1 = NEG, m2 = NEG;
#pragma unroll
            for (int i = 0; i < 16; ++i) { mv[i] = s[i] + rb[i]; m2 = fmaxf(m2, fminf(m1, mv[i])); m1 = fmaxf(m1, mv[i]); }
            const float pm1 = dpp_f<DPP_XOR1>(m1), pm2 = dpp_f<DPP_XOR1>(m2);
            const float gs = fmaxf(m1, pm1) + fmaxf(fminf(m1, pm1), fmaxf(m2, pm2));
            int rank = 0;
#define RANK_STEP(N) { const float os = dpp_f<0x120 + (N)>(gs); const int og = dpp_i<0x120 + (N)>(g); rank += (os > gs || (os == gs && og < g)) ? 1 : 0; }
            RANK_STEP(2) RANK_STEP(4) RANK_STEP(6) RANK_STEP(8) RANK_STEP(10) RANK_STEP(12) RANK_STEP(14)
#undef RANK_STEP
            if (rank >= TOPG) {
#pragma unroll
                for (int i = 0; i < 16; ++i) mv[i] = NEG;
            }
            float wsel = 0.f, wsum = 0.f; int esel = 0;
#pragma unroll
            for (int k = 0; k < TOPK; ++k) {
                float bm = mv[0], bs = s[0]; int bi = 16 * j;
#pragma unroll
                for (int i = 1; i < 16; ++i) { const bool gt = mv[i] > bm; bm = gt ? mv[i] : bm; bs = gt ? s[i] : bs; bi = gt ? 16 * j + i : bi; }
#define ARG_STEP(CT) { const float om = dpp_f<CT>(bm), os = dpp_f<CT>(bs); const int oi = dpp_i<CT>(bi); const bool tk = (om > bm) || (om == bm && oi < bi); bm = tk ? om : bm; bs = tk ? os : bs; bi = tk ? oi : bi; }
                ARG_STEP(DPP_XOR1) ARG_STEP(DPP_XOR2) ARG_STEP(DPP_HMIR) ARG_STEP(DPP_MIR)
#undef ARG_STEP
#pragma unroll
                for (int i = 0; i < 16; ++i) mv[i] = (bi == 16 * j + i) ? NEG : mv[i];
                wsum += bs;
                if (j == k) { wsel = bs; esel = bi; }
            }
            if (j < TOPK) { eidx[t * 8 + j] = esel; gw[t * 8 + j] = wsel / wsum * ROUTED_SCALE; atomicAdd(hist + esel, 1); }
        }
        __syncthreads();
        if (c.tid < NE) { const int h = hist[c.tid];
            if (ATOMIC_BASE) { unsigned* counts = (unsigned*)(c.ws + WS_CTL) + CW_COUNTS; HIST[blk * NE + c.tid] = h ? (int)atomicAdd(counts + c.tid, (unsigned)h) : 0; }
            else HIST[blk * NE + c.tid] = h;
            hist[c.tid] = 0; }
        __syncthreads();
    }
}
template <bool INV>
__device__ __forceinline__ void ph_slot3(const Ctx& c, const Params& p) {
    const int* HIST = (const int*)(c.ws + WS_HIST);
    int* pc = (int*)c.lds; int* base = pc + 256; int* cnt = base + 257;
    const int* eidx = (const int*)(c.ws + WS_EIDX); const float* gw = (const float*)(c.ws + WS_GATEW);
    int* stok = (int*)(c.ws + WS_SLOT_TOK); int* sasg = (int*)(c.ws + WS_SLOT_ASG); float* sgate = (float*)(c.ws + WS_SLOT_GATE);
    for (int blk = c.bid; blk < T / 128; blk += c.nb) {
        int before = 0;
        if (c.tid < NE) { int tot = 0;
#pragma unroll 16
            for (int b2 = 0; b2 < T / 128; ++b2) { const int h = HIST[b2 * NE + c.tid]; tot += h; before += (b2 < blk) ? h : 0; }
            pc[c.tid] = (tot + 255) / 256 * 256; cnt[c.tid] = 0; }
        __syncthreads();
        if (c.tid <= NE) { int acc = 0; for (int e = 0; e < c.tid; ++e) acc += pc[e]; base[c.tid] = acc + (c.tid < NE ? before : 0); }
        __syncthreads();
        for (int i = c.tid; i < 128 * TOPK; i += NTHREADS_) {
            const int a = blk * 128 * TOPK + i, e = eidx[a]; const int pos = atomicAdd(cnt + e, 1); const int slot = base[e] + pos;
            stok[slot] = a >> 3; sasg[slot] = a; sgate[slot] = gw[a]; if (INV) ((int*)eidx)[a] = slot;
        }
        if (blk == 0) {
            int* te = (int*)(c.ws + WS_TILE_E);
            for (int e = c.tid; e < NE; e += NTHREADS_) for (int tl = base[e] / 256; tl < (base[e] + pc[e]) / 256; ++tl) te[tl] = e;
            if (c.tid == 0) ((unsigned*)(c.ws + WS_CTL))[CW_NTILES] = (unsigned)(base[NE] / 256);
        }
        __syncthreads();
    }
}
__device__ __forceinline__ void ph_slot5(const Ctx& c, const Params& p) {
    const int* HIST = (const int*)(c.ws + WS_HIST); const unsigned* counts = (const unsigned*)(c.ws + WS_CTL) + CW_COUNTS;
    int* pc = (int*)c.lds; int* base = pc + 256; int* cnt = base + 257; int* pst = cnt + 256;
    const int* eidx = (const int*)(c.ws + WS_EIDX); const float* gw = (const float*)(c.ws + WS_GATEW);
    int* stok = (int*)(c.ws + WS_SLOT_TOK); int* sasg = (int*)(c.ws + WS_SLOT_ASG); float* sgate = (float*)(c.ws + WS_SLOT_GATE);
    for (int blk = c.bid; blk < T / 128; blk += c.nb) {
        int before = 0;
        if (c.tid < NE) { pc[c.tid] = ((int)counts[c.tid] + 255) / 256 * 256; before = HIST[blk * NE + c.tid]; cnt[c.tid] = 0; }
        __syncthreads();
        if (c.tid <= NE) { int acc = 0; for (int e = 0; e < c.tid; ++e) acc += pc[e]; pst[c.tid] = acc; base[c.tid] = acc + before; }
        __syncthreads();
        for (int i = c.tid; i < 128 * TOPK; i += NTHREADS_) {
            const int a = blk * 128 * TOPK + i, e = eidx[a]; const int pos = atomicAdd(cnt + e, 1); const int slot = base[e] + pos;
            stok[slot] = a >> 3; sasg[slot] = a; sgate[slot] = gw[a]; ((int*)eidx)[a] = slot;
        }
        if (blk == 0) {
            int* te = (int*)(c.ws + WS_TILE_E);
            for (int e = c.tid; e < NE; e += NTHREADS_) for (int tl = pst[e] / 256; tl < (pst[e] + pc[e]) / 256; ++tl) te[tl] = e;
            if (c.tid == 0) ((unsigned*)(c.ws + WS_CTL))[CW_NTILES] = (unsigned)(pst[NE] / 256);
        }
        __syncthreads();
    }
}
__device__ __forceinline__ void ph_combine2(const Ctx& c, const Params& p) {
    const float* mod = (const float*)(c.ws + WS_MOD); const bf16_t* YA = (const bf16_t*)(c.ws + WS_YA); const bf16_t* YS = (const bf16_t*)(c.ws + WS_YSH); float* out = p.out;
    for (int t = c.gwave; t < T; t += c.gwaves) {
        const int b = t / SEQ;
        u32x4 y[9][2]; f32x4 xv[2][2], gv[2][2];
#pragma unroll
        for (int q = 0; q < 2; ++q) { const int col = q * 512 + c.lane * 8;
#pragma unroll
            for (int k = 0; k < 8; ++k) y[k][q] = *(const u32x4*)(YA + ((size_t)t * 8 + k) * DM + col);
            y[8][q] = *(const u32x4*)(YS + (size_t)t * DM + col);
            xv[q][0] = *(const f32x4*)(out + (size_t)t * DM + col); xv[q][1] = *(const f32x4*)(out + (size_t)t * DM + col + 4);
            gv[q][0] = *(const f32x4*)(mod + b * 6 * DM + 5 * DM + col); gv[q][1] = *(const f32x4*)(mod + b * 6 * DM + 5 * DM + col + 4); }
#pragma unroll
        for (int q = 0; q < 2; ++q) { const int col = q * 512 + c.lane * 8;
            f32x4 s0 = {0.f, 0.f, 0.f, 0.f}, s1 = {0.f, 0.f, 0.f, 0.f};
#pragma unroll
            for (int k = 0; k < 9; ++k) { const u32x4 w = y[k][q];
                s0[0] += __uint_as_float(w.x << 16); s0[1] += __uint_as_float(w.x & 0xffff0000u); s0[2] += __uint_as_float(w.y << 16); s0[3] += __uint_as_float(w.y & 0xffff0000u);
                s1[0] += __uint_as_float(w.z << 16); s1[1] += __uint_as_float(w.z & 0xffff0000u); s1[2] += __uint_as_float(w.w << 16); s1[3] += __uint_as_float(w.w & 0xffff0000u); }
            *(f32x4*)(out + (size_t)t * DM + col) = xv[q][0] + gv[q][0] * s0; *(f32x4*)(out + (size_t)t * DM + col + 4) = xv[q][1] + gv[q][1] * s1; }
    }
}
__device__ __forceinline__ void ph_combine3(const Ctx& c, const Params& p) {
    const float* mod = (const float*)(c.ws + WS_MOD); const bf16_t* YS = (const bf16_t*)(c.ws + WS_YS); const bf16_t* YH = (const bf16_t*)(c.ws + WS_YSH); float* out = p.out;
    const int* inv = (const int*)(c.ws + WS_EIDX);
    for (int t = c.gwave; t < T; t += c.gwaves) {
        const int b = t / SEQ;
        int sl[8];
#pragma unroll
        for (int k = 0; k < 8; ++k) sl[k] = inv[t * 8 + k];
        u32x4 y[9][2]; f32x4 xv[2][2], gv[2][2];
#pragma unroll
        for (int q = 0; q < 2; ++q) { const int col = q * 512 + c.lane * 8;
#pragma unroll
            for (int k = 0; k < 8; ++k) y[k][q] = *(const u32x4*)(YS + (size_t)sl[k] * DM + col);
            y[8][q] = *(const u32x4*)(YH + (size_t)t * DM + col);
            xv[q][0] = *(const f32x4*)(out + (size_t)t * DM + col); xv[q][1] = *(const f32x4*)(out + (size_t)t * DM + col + 4);
            gv[q][0] = *(const f32x4*)(mod + b * 6 * DM + 5 * DM + col); gv[q][1] = *(const f32x4*)(mod + b * 6 * DM + 5 * DM + col + 4); }
#pragma unroll
        for (int q = 0; q < 2; ++q) { const int col = q * 512 + c.lane * 8;
            f32x4 s0 = {0.f, 0.f, 0.f, 0.f}, s1 = {0.f, 0.f, 0.f, 0.f};
#pragma unroll
            for (int k = 0; k < 9; ++k) { const u32x4 w = y[k][q];
                s0[0] += __uint_as_float(w.x << 16); s0[1] += __uint_as_float(w.x & 0xffff0000u); s0[2] += __uint_as_float(w.y << 16); s0[3] += __uint_as_float(w.y & 0xffff0000u);
                s1[0] += __uint_as_float(w.z << 16); s1[1] += __uint_as_float(w.z & 0xffff0000u); s1[2] += __uint_as_float(w.w << 16); s1[3] += __uint_as_float(w.w & 0xffff0000u); }
            *(f32x4*)(out + (size_t)t * DM + col) = xv[q][0] + gv[q][0] * s0; *(f32x4*)(out + (size_t)t * DM + col + 4) = xv[q][1] + gv[q][1] * s1; }
    }
}
__device__ __forceinline__ void ph_combine4(const Ctx& c, const Params& p) {
    const float* mod = (const float*)(c.ws + WS_MOD); const unsigned char* YS = c.ws + WS_YS; const bf16_t* YH = (const bf16_t*)(c.ws + WS_YSH); float* out = p.out;
    const int* inv = (const int*)(c.ws + WS_EIDX);
    typedef float f32x2 __attribute__((ext_vector_type(2)));
    for (int t = c.gwave; t < T; t += c.gwaves) {
        const int b = t / SEQ, col = c.lane * 16;
        int sl[8];
#pragma unroll
        for (int k = 0; k < 8; ++k) sl[k] = inv[t * 8 + k];
        u32x4 y[8], yh[2]; f32x4 xv[4], gv[4];
#pragma unroll
        for (int k = 0; k < 8; ++k) y[k] = *(const u32x4*)(YS + (size_t)sl[k] * DM + col);
#pragma unroll
        for (int q = 0; q < 2; ++q) yh[q] = *(const u32x4*)(YH + (size_t)t * DM + col + 8 * q);
#pragma unroll
        for (int q = 0; q < 4; ++q) { xv[q] = *(const f32x4*)(out + (size_t)t * DM + col + 4 * q); gv[q] = *(const f32x4*)(mod + b * 6 * DM + 5 * DM + col + 4 * q); }
        float sacc[16];
#pragma unroll
        for (int i = 0; i < 16; ++i) sacc[i] = 0.f;
#pragma unroll
        for (int k = 0; k < 8; ++k) { const unsigned* wp = (const unsigned*)&y[k];
#pragma unroll
            for (int i = 0; i < 4; ++i) { const f32x2 lo = __builtin_amdgcn_cvt_pk_f32_fp8((int)wp[i], false), hi2 = __builtin_amdgcn_cvt_pk_f32_fp8((int)wp[i], true);
                sacc[4 * i] += lo[0]; sacc[4 * i + 1] += lo[1]; sacc[4 * i + 2] += hi2[0]; sacc[4 * i + 3] += hi2[1]; } }
#pragma unroll
        for (int q = 0; q < 2; ++q) { const unsigned* wp = (const unsigned*)&yh[q];
#pragma unroll
            for (int i = 0; i < 4; ++i) { sacc[8 * q + 2 * i] = sacc[8 * q + 2 * i] * (1.f / Y8_SCALE) + __uint_as_float(wp[i] << 16); sacc[8 * q + 2 * i + 1] = sacc[8 * q + 2 * i + 1] * (1.f / Y8_SCALE) + __uint_as_float(wp[i] & 0xffff0000u); } }
#pragma unroll
        for (int q = 0; q < 4; ++q) { f32x4 o = xv[q]; o[0] += gv[q][0] * sacc[4 * q]; o[1] += gv[q][1] * sacc[4 * q + 1]; o[2] += gv[q][2] * sacc[4 * q + 2]; o[3] += gv[q][3] * sacc[4 * q + 3];
            *(f32x4*)(out + (size_t)t * DM + col + 4 * q) = o; }
    }
}
__device__ __forceinline__ void ph_combine5(const Ctx& c, const Params& p) {
    const float* mod = (const float*)(c.ws + WS_MOD); const unsigned char* YS = c.ws + WS_YS; const bf16_t* YH = (const bf16_t*)(c.ws + WS_YSH); float* out = p.out;
    const int* inv = (const int*)(c.ws + WS_EIDX); const float* gwp = (const float*)(c.ws + WS_GATEW);
    typedef float f32x2 __attribute__((ext_vector_type(2)));
    for (int t = c.gwave; t < T; t += c.gwaves) {
        const int b = t / SEQ, col = c.lane * 16;
        int sl[8]; float gk[8];
#pragma unroll
        for (int k = 0; k < 8; ++k) { sl[k] = inv[t * 8 + k]; gk[k] = gwp[t * 8 + k]; }
        u32x4 y[8], yh[2]; f32x4 xv[4], gv[4];
#pragma unroll
        for (int k = 0; k < 8; ++k) y[k] = *(const u32x4*)(YS + (size_t)sl[k] * DM + col);
#pragma unroll
        for (int q = 0; q < 2; ++q) yh[q] = *(const u32x4*)(YH + (size_t)t * DM + col + 8 * q);
#pragma unroll
        for (int q = 0; q < 4; ++q) { xv[q] = *(const f32x4*)(out + (size_t)t * DM + col + 4 * q); gv[q] = *(const f32x4*)(mod + b * 6 * DM + 5 * DM + col + 4 * q); }
        float sacc[16];
#pragma unroll
        for (int i = 0; i < 16; ++i) sacc[i] = 0.f;
#pragma unroll
        for (int k = 0; k < 8; ++k) { const unsigned* wp = (const unsigned*)&y[k];
#pragma unroll
            for (int i = 0; i < 4; ++i) { const f32x2 lo = __builtin_amdgcn_cvt_pk_f32_fp8((int)wp[i], false), hi2 = __builtin_amdgcn_cvt_pk_f32_fp8((int)wp[i], true);
                sacc[4 * i] += gk[k] * lo[0]; sacc[4 * i + 1] += gk[k] * lo[1]; sacc[4 * i + 2] += gk[k] * hi2[0]; sacc[4 * i + 3] += gk[k] * hi2[1]; } }
#pragma unroll
        for (int q = 0; q < 2; ++q) { const unsigned* wp = (const unsigned*)&yh[q];
#pragma unroll
            for (int i = 0; i < 4; ++i) { sacc[8 * q + 2 * i] = sacc[8 * q + 2 * i] * (1.f / Y8_SCALE) + __uint_as_float(wp[i] << 16); sacc[8 * q + 2 * i + 1] = sacc[8 * q + 2 * i + 1] * (1.f / Y8_SCALE) + __uint_as_float(wp[i] & 0xffff0000u); } }
#pragma unroll
        for (int q = 0; q < 4; ++q) { f32x4 o = xv[q]; o[0] += gv[q][0] * sacc[4 * q]; o[1] += gv[q][1] * sacc[4 * q + 1]; o[2] += gv[q][2] * sacc[4 * q + 2]; o[3] += gv[q][3] * sacc[4 * q + 3];
            *(f32x4*)(out + (size_t)t * DM + col + 4 * q) = o; }
    }
}
__device__ __forceinline__ void cpowi(float ar, float ai, int n, float& pr, float& pi) { pr = 1.f; pi = 0.f; for (int i = 0; i < n; ++i) { const float t = pr * ar - pi * ai; pi = pr * ai + pi * ar; pr = t; } }
__device__ __forceinline__ void ph_ssm_gen(const Ctx& c, const Params& p) {
    const float* sp = (const float*)(c.ws + WS_SSMP);
    const float* bbr = sp + 2 * SG * SP, * bbi = bbr + SG * SP * SC; const float* PWg = (const float*)(c.ws + WS_SSMPW);
    bf16_t* BA = (bf16_t*)(c.ws + WS_SSM_BA); bf16_t* BC = (bf16_t*)(c.ws + WS_SSM_BC);
    float* Lpw = c.lds; float* Lbb = Lpw + SP * 34; float* Lcc = Lbb + SP * 32;
    for (int w = c.bid; w < SG * 8; w += c.nb) {
        const int g = w & 31, part = w >> 5;
        __syncthreads();
        for (int i = c.tid; i < SP * 34; i += NTHREADS_) Lpw[i] = PWg[(size_t)g * SP * 34 + i];
        for (int i = c.tid; i < SP * 16; i += NTHREADS_) { Lbb[2 * i] = bbr[g * SP * SC + i]; Lbb[2 * i + 1] = bbi[g * SP * SC + i]; }
        for (int i = c.tid; i < 16 * SP; i += NTHREADS_) { Lcc[2 * i] = p.in[I_CRE][g * SC * SP + i]; Lcc[2 * i + 1] = p.in[I_CIM][g * SC * SP + i]; }
        __syncthreads();
        bf16_t* baseC = BC + (size_t)g * 256 * APK; bf16_t* baseA = BA + (size_t)g * 256 * 256;
        { const int idx = part * 512 + c.tid, ci = idx & 15, co = (idx >> 4) & 15, d = idx >> 8;
          float kv = 0.f;
#pragma unroll 8
          for (int pp = 0; pp < SP; ++pp) { const float pr = Lpw[pp * 34 + 2 * d], pi = Lpw[pp * 34 + 2 * d + 1], br = Lbb[(pp * 16 + ci) * 2], bi = Lbb[(pp * 16 + ci) * 2 + 1];
              const float tr = pr * br - pi * bi, ti = pr * bi + pi * br;
              kv += Lcc[(co * SP + pp) * 2] * tr - Lcc[(co * SP + pp) * 2 + 1] * ti; }
          if (d == 0 && co == ci) kv += p.in[I_SD][g * SC + co];
          const bf16_t kb = f2bf(kv);
          for (int j = 0; j + d < 16; ++j) { baseC[((j + d) * 16 + co) * APK + j * 16 + ci] = kb; if (d > 0) baseC[(j * 16 + co) * APK + (j + d) * 16 + ci] = 0; } }
        for (int q = c.tid; q < 2048; q += NTHREADS_) { const int idx = part * 2048 + q;
            { const int pp = idx & 63, co = (idx >> 6) & 15, jp = idx >> 10;
              const float pr = Lpw[pp * 34 + 2 * (jp + 1)], pi = Lpw[pp * 34 + 2 * (jp + 1) + 1], cr = Lcc[(co * SP + pp) * 2], ci2 = Lcc[(co * SP + pp) * 2 + 1];
              bf16_t* row = baseC + (size_t)(jp * 16 + co) * APK + 256;
              row[pp] = f2bf(cr * pr - ci2 * pi); row[64 + pp] = f2bf(-(cr * pi + ci2 * pr)); }
            { const int ci = idx & 15, j = (idx >> 4) & 15, pp = idx >> 8;
              const float pr = Lpw[pp * 34 + 2 * (15 - j)], pi = Lpw[pp * 34 + 2 * (15 - j) + 1], br = Lbb[(pp * 16 + ci) * 2], bi = Lbb[(pp * 16 + ci) * 2 + 1];
              baseA[pp * 256 + j * 16 + ci] = f2bf(pr * br - pi * bi); baseA[(64 + pp) * 256 + j * 16 + ci] = f2bf(pr * bi + pi * br); } }
        for (int q = c.tid; q < 512; q += NTHREADS_) *(u32x4*)(baseA + 128 * 256 + (part * 512 + q) * 8) = (u32x4){0u, 0u, 0u, 0u};
    }
    __syncthreads();
}
__device__ __forceinline__ void ph_ssm_scan(const Ctx& c, const Params& p, int vcu) {
    const float* sp = (const float*)(c.ws + WS_SSMP); const float* abr = sp, * abi = sp + SG * SP;
    const float* DS = (const float*)(c.ws + WS_DS); bf16_t* AP = (bf16_t*)(c.ws + WS_AP);
    float* fw = c.lds;
    for (int it = vcu; it < NB * SG; it += c.nb) {
        const int g = it >> 3, b = it & 7, pp = c.lane, w = c.wave;
        const size_t r0 = (size_t)g * (NB * NCHUNK) + b * NCHUNK + 32 * w;
        float ar = abr[g * SP + pp], ai = abi[g * SP + pp];
#pragma unroll
        for (int i = 0; i < 4; ++i) { const float t = ar * ar - ai * ai; ai = 2.f * ar * ai; ar = t; }
        float lr[32], li[32];
#pragma unroll
        for (int i = 0; i < 32; ++i) { lr[i] = DS[(r0 + i) * 128 + pp]; li[i] = DS[(r0 + i) * 128 + 64 + pp]; }
#pragma unroll
        for (int i = 1; i < 32; ++i) { const float nr = ar * lr[i - 1] - ai * li[i - 1] + lr[i], ni = ar * li[i - 1] + ai * lr[i - 1] + li[i]; lr[i] = nr; li[i] = ni; }
        __syncthreads();
        fw[(w * 64 + pp) * 2] = lr[31]; fw[(w * 64 + pp) * 2 + 1] = li[31];
        __syncthreads();
        float a32r = ar, a32i = ai;
#pragma unroll
        for (int i = 0; i < 5; ++i) { const float t = a32r * a32r - a32i * a32i; a32i = 2.f * a32r * a32i; a32r = t; }
        float cr = 0.f, ci = 0.f;
        for (int w2 = 0; w2 < w; ++w2) { const float fr_ = fw[(w2 * 64 + pp) * 2], fi_ = fw[(w2 * 64 + pp) * 2 + 1];
            const float nr = a32r * cr - a32i * ci + fr_, ni = a32r * ci + a32i * cr + fi_; cr = nr; ci = ni; }
        bf16_t* row = AP + r0 * APK + 256 + pp;
#pragma unroll
        for (int i = 0; i < 32; ++i) {
            const float sr = cr + (i ? lr[i - 1] : 0.f), si = ci + (i ? li[i - 1] : 0.f);
            row[0] = f2bf(sr); row[64] = f2bf(si);
            row += APK; asm volatile("" : "+v"(row));
            const float nr = ar * cr - ai * ci, ni = ar * ci + ai * cr; cr = nr; ci = ni;
        }
    }
}

namespace att {
typedef short bf16x8 __attribute__((ext_vector_type(8)));
typedef short s16x4 __attribute__((ext_vector_type(4)));
typedef float f32x16 __attribute__((ext_vector_type(16)));
typedef float f32x2 __attribute__((ext_vector_type(2)));
constexpr int NW = 8, QBLK = 32, KVBLK = 64, QB = 128, NQB = SEQ / QB;
constexpr int KP = 1024, VP = 512;
constexpr int SHM_V = KVBLK * 128 * 2, SHM_K = KVBLK * 128 * 2;
constexpr int LDS_WS = 2 * SHM_V + 2 * SHM_K, LDS_EX = LDS_WS + NW * 64 * 4, LDS_END = LDS_EX + 4 * 16384;
#define KSWZ(row, colB) ((row) * 256 + ((colB) ^ (((row) & 7) << 4)))
#define SBAR() __builtin_amdgcn_sched_barrier(0)
__device__ __forceinline__ int v_st(int k, int c) { const int kk = (k & ~0xC) | ((k & 4) << 1) | ((k & 8) >> 1); return ((kk >> 3) * 4 + (c >> 5)) * 512 + ((kk & 7) * 32 + (c & 31)) * 2; }
__device__ __forceinline__ int v_rd_base(int lane) { return ((lane & 3) << 3) | (((lane >> 2) & 3) << 6) | (((lane >> 4) & 1) << 5) | (((lane >> 5) & 1) << 8); }
constexpr int v_rd_off(int d0, int ks, int half) { return d0 * 512 + ks * 4096 + half * 2048; }
__device__ __forceinline__ int crow(int r, int hi) { return (r & 3) + 8 * (r >> 2) + 4 * hi; }
__device__ __forceinline__ unsigned cvtpk(float lo, float hi) { unsigned r; asm volatile("v_cvt_pk_bf16_f32 %0, %1, %2" : "=v"(r) : "v"(lo), "v"(hi)); return r; }
__device__ __forceinline__ void mask_tile(f32x16& p0, f32x16& p1, int dq) {
    const float NEG = -__builtin_inff();
#pragma unroll
    for (int r = 0; r < 16; ++r) { const int c = (r & 3) + 8 * (r >> 2); if (dq - c < 0) p0[r] = NEG; if (dq - c - 32 < 0) p1[r] = NEG; }
}
template <bool ZC>
__device__ __forceinline__ void partialSM(f32x16& p0, f32x16& p1, float C2, float negM) {
    if constexpr (!ZC) {
#pragma unroll
        for (int r = 0; r < 16; ++r) { p0[r] += negM; p1[r] += negM; } }
#pragma unroll
    for (int r = 0; r < 16; ++r) p0[r] = __builtin_amdgcn_exp2f(p0[r]);
}
__device__ __forceinline__ void finishSM(f32x16& p0, f32x16& p1, float& l_reg, bf16x8& pa0, bf16x8& pa1, bf16x8& pa2, bf16x8& pa3) {
#pragma unroll
    for (int r = 0; r < 16; ++r) p1[r] = __builtin_amdgcn_exp2f(p1[r]);
    float ps = 0;
#pragma unroll
    for (int r = 0; r < 16; ++r) ps += p0[r];
#pragma unroll
    for (int r = 0; r < 16; ++r) ps += p1[r];
    { auto rr = __builtin_amdgcn_permlane32_swap(__float_as_uint(ps), __float_as_uint(ps), false, false); ps = __uint_as_float(rr[0]) + __uint_as_float(rr[1]); }
    l_reg += ps;
#define PK4(P, B_, OUT) do { unsigned a0 = cvtpk(P[B_+0], P[B_+1]), a1 = cvtpk(P[B_+2], P[B_+3]);                          \
        unsigned b0 = cvtpk(P[B_+4], P[B_+5]), b1 = cvtpk(P[B_+6], P[B_+7]);                                             \
        auto r0 = __builtin_amdgcn_permlane32_swap(a0, b0, false, false); auto r1 = __builtin_amdgcn_permlane32_swap(a1, b1, false, false); \
        u32x4 w = {r0[0], r1[0], r0[1], r1[1]}; OUT = *reinterpret_cast<bf16x8*>(&w); } while (0)
    PK4(p0, 0, pa0); PK4(p0, 8, pa1); PK4(p1, 0, pa2); PK4(p1, 8, pa3);
#undef PK4
}
template <int KB>
__device__ __forceinline__ void qkt(f32x16& p0, f32x16& p1, const char* K_lds, int r32, int hi, const bf16x8* qr, int cc) {
    p0 = f32x16{}; p1 = f32x16{};
    const char* kb[4];
#pragma unroll
    for (int dd = 0; dd < 4; ++dd) kb[dd] = K_lds + KB * SHM_K + KSWZ(r32, (dd * 16 + hi * 8) * 2) + cc * 128;
#pragma unroll
    for (int d0 = 0; d0 < 4; ++d0) { const char* a = kb[d0];
        bf16x8 b0 = *reinterpret_cast<const bf16x8*>(a);
        bf16x8 b1 = *reinterpret_cast<const bf16x8*>(a + 32 * 256);
        p0 = __builtin_amdgcn_mfma_f32_32x32x16_bf16(b0, qr[d0], p0, 0, 0, 0);
        p1 = __builtin_amdgcn_mfma_f32_32x32x16_bf16(b1, qr[d0], p1, 0, 0, 0); }
}
template <int VB>
__device__ __forceinline__ void pv_tile(f32x16* o, int vb0, bf16x8 pa0, bf16x8 pa1, bf16x8 pa2, bf16x8 pa3) {
#define TRRD(dst, off) asm volatile("ds_read_b64_tr_b16 %0, %1 offset:%2" : "=&v"(dst) : "v"(vb0), "i"(off) : "memory")
#define PV_D0(d0) do { s16x4 l0, l1, l2, l3, h0, h1, h2, h3; constexpr int b_ = VB * SHM_V + v_rd_off(d0, 0, 0); \
        TRRD(l0, b_); TRRD(h0, b_ + 2048); TRRD(l1, b_ + 4096); TRRD(h1, b_ + 6144); TRRD(l2, b_ + 8192); TRRD(h2, b_ + 10240); TRRD(l3, b_ + 12288); TRRD(h3, b_ + 14336); \
        asm volatile("s_waitcnt lgkmcnt(0)" ::: "memory"); SBAR();   \
        o[d0] = __builtin_amdgcn_mfma_f32_32x32x16_bf16(pa0, (bf16x8){l0[0], l0[1], l0[2], l0[3], h0[0], h0[1], h0[2], h0[3]}, o[d0], 0, 0, 0);   \
        o[d0] = __builtin_amdgcn_mfma_f32_32x32x16_bf16(pa1, (bf16x8){l1[0], l1[1], l1[2], l1[3], h1[0], h1[1], h1[2], h1[3]}, o[d0], 0, 0, 0);   \
        o[d0] = __builtin_amdgcn_mfma_f32_32x32x16_bf16(pa2, (bf16x8){l2[0], l2[1], l2[2], l2[3], h2[0], h2[1], h2[2], h2[3]}, o[d0], 0, 0, 0);   \
        o[d0] = __builtin_amdgcn_mfma_f32_32x32x16_bf16(pa3, (bf16x8){l3[0], l3[1], l3[2], l3[3], h3[0], h3[1], h3[2], h3[3]}, o[d0], 0, 0, 0); } while (0)
    PV_D0(0); PV_D0(1); PV_D0(2); PV_D0(3);
#undef PV_D0
#undef TRRD
}
struct BlockRef { const bf16_t* Q; const bf16_t* K; const bf16_t* V; bf16_t* O; int P0; };
struct Seam { bf16x8 qr[4]; bf16x8 st_v0, st_v1, st_k0, st_k1; };
#define ROWK(p, k0, rr) ((p) + (size_t)((k0) + (rr)) * KP + sc)
#define ROWV(p, k0, rr) ((p) + (size_t)((k0) + (rr)) * VP + sc)
#define LD8(ptr) (*reinterpret_cast<const bf16x8*>(ptr))
#define VMW() asm volatile("s_waitcnt vmcnt(0)" ::: "memory")
#define VMWN(n) asm volatile("s_waitcnt vmcnt(%0)" :: "i"(n) : "memory")
#define SLOAD_H(Kp, Vp, k0) do { S.st_v0 = LD8(ROWV(Vp, k0, sr)); S.st_v1 = LD8(ROWV(Vp, k0, 32 + sr)); S.st_k0 = LD8(ROWK(Kp, k0, sr)); S.st_k1 = LD8(ROWK(Kp, k0, 32 + sr)); } while (0)
#define SWRITE_HK(bf) do { *(bf16x8*)(K_lds + (bf) * SHM_K + kws) = S.st_k0; *(bf16x8*)(K_lds + (bf) * SHM_K + kws + 32 * 256) = S.st_k1; } while (0)
#define SWRITE_HV(bf) do { *(bf16x8*)(V_lds + (bf) * SHM_V + vst0) = S.st_v0; *(bf16x8*)(V_lds + (bf) * SHM_V + vst1) = S.st_v1; } while (0)
#define SWRITE_H(bf) do { SWRITE_HV(bf); SWRITE_HK(bf); } while (0)
#define QLOAD(ref) do { _Pragma("unroll") for (int d0 = 0; d0 < 4; ++d0) S.qr[d0] = LD8((ref).Q + (size_t)(qi * QBLK + r32) * KP + cc * 64 + d0 * 16 + hi * 8); } while (0)
__device__ __forceinline__ void prime(const BlockRef& cur, char* lds, Seam& S, int tid) {
    const int  wid = __builtin_amdgcn_readfirstlane(tid >> 6), lane = tid & 63, r32 = lane & 31, hi = lane >> 5, qi = wid >> 1, cc = wid & 1;
    const int sr = tid >> 4, sc = (tid & 15) * 8, kws = KSWZ(sr, sc * 2); char* K_lds = lds + 2 * SHM_V;
    QLOAD(cur);
    SLOAD_H(cur.K, cur.V, 0); VMW(); SWRITE_HK(0);
    __syncthreads();
}
template <bool ZC>
__device__ __forceinline__ void block(const BlockRef& cur, const BlockRef& nxt, char* lds, Seam& S, float lam, float smax, const float* subg, bool lastblk, int tid) {
    const int  wid = __builtin_amdgcn_readfirstlane(tid >> 6), lane = tid & 63, r32 = lane & 31, hi = lane >> 5, qi = wid >> 1, cc = wid & 1;
    const int NT = cur.P0 / KVBLK + 2;
    const int qlo = cur.P0 + qi * QBLK, qm = qlo + r32 - 4 * hi;
    char* V_lds = lds; char* K_lds = lds + 2 * SHM_V;
    float* wsf = (float*)(lds + LDS_WS) + wid * 64; float* li_l = wsf;
    float* exch = (float*)(lds + LDS_EX) + qi * 4096;
    float l_reg = 0; f32x16 o[4] = {};
    const int sr = tid >> 4, sc = (tid & 15) * 8, vst0 = v_st(sr, sc), vst1 = v_st(32 + sr, sc), kws = KSWZ(sr, sc * 2);
    const int vb0 = (int)(uintptr_t)V_lds + v_rd_base(lane);
    const bf16_t* Kh = cur.K; const bf16_t* Vh = cur.V;
    constexpr float C2 = 1.4426950408889634f * 0.125f; const float negM = -smax * 1.4426950408889634f;
#define KBASE(t) ((t) * KVBLK)
#define MASKT(P0_, P1_, t) do { const int kb_ = KBASE(t); if (kb_ + KVBLK - 1 > qlo) mask_tile(P0_, P1_, qm - kb_); } while (0)
    f32x16 pA0, pA1, pB0, pB1; bf16x8 pa0, pa1, pa2, pa3;
    SWRITE_HV(0); SBAR();
    SLOAD_H(Kh, Vh, KBASE(1));
    SBAR(); qkt<0>(pA0, pA1, K_lds, r32, hi, S.qr, cc);
    MASKT(pA0, pA1, 0); partialSM<ZC>(pA0, pA1, C2, negM);
    VMW(); SWRITE_H(1);
    __syncthreads();
#define HALF_STEP(PX0, PX1, PY0, PY1, t, KB, VB, SB) do {                                                      \
        SBAR(); qkt<KB>(PX0, PX1, K_lds, r32, hi, S.qr, cc);                                                  \
        finishSM(PY0, PY1, l_reg, pa0, pa1, pa2, pa3); SBAR();                                                \
        if ((t) + 1 < NT) { SLOAD_H(Kh, Vh, KBASE((t) + 1)); SBAR(); }                                        \
        pv_tile<VB>(o, vb0, pa0, pa1, pa2, pa3); MASKT(PX0, PX1, (t)); partialSM<ZC>(PX0, PX1, C2, negM);          \
        __syncthreads();                                                                                       \
        if ((t) + 1 < NT) { VMW(); SWRITE_H(SB); }                                                             \
        __syncthreads(); } while (0)
    for (int t = 1; t + 1 < NT; t += 2) {
        HALF_STEP(pB0, pB1, pA0, pA1, t, 1, 0, 0);
        HALF_STEP(pA0, pA1, pB0, pB1, t + 1, 0, 1, 1);
    }
    SBAR(); qkt<1>(pB0, pB1, K_lds, r32, hi, S.qr, cc); SBAR();
    SLOAD_H(nxt.K, nxt.V, 0); SBAR();
    QLOAD(nxt);
    SBAR();
    finishSM(pA0, pA1, l_reg, pa0, pa1, pa2, pa3); SBAR();
    pv_tile<0>(o, vb0, pa0, pa1, pa2, pa3);
    MASKT(pB0, pB1, NT - 1); partialSM<ZC>(pB0, pB1, C2, negM); __syncthreads();
    finishSM(pB0, pB1, l_reg, pa0, pa1, pa2, pa3); SBAR(); pv_tile<1>(o, vb0, pa0, pa1, pa2, pa3);
    SBAR(); VMWN(4); SWRITE_HK(0); SBAR();
    if (hi == 0) li_l[r32] = l_reg; asm volatile("s_waitcnt lgkmcnt(0)" ::: "memory");
    float rli[16];
#pragma unroll
    for (int r = 0; r < 16; ++r) rli[r] = __builtin_amdgcn_rcpf(li_l[crow(r, hi)]) * (cc ? lam : 1.f);
#pragma unroll
    for (int d0 = 0; d0 < 4; ++d0)
#pragma unroll
        for (int r = 0; r < 16; ++r) o[d0][r] *= rli[r];
    if (cc == 1) {
#pragma unroll
        for (int d0 = 0; d0 < 4; ++d0)
#pragma unroll
            for (int r = 0; r < 16; ++r) exch[(d0 * 16 + r) * 64 + lane] = o[d0][r];
    }
    __syncthreads();
    if (cc == 0) {
        float gsub[4];
#pragma unroll
        for (int d0 = 0; d0 < 4; ++d0) gsub[d0] = subg[d0 * 32 + r32] * (1.f - LAM_INIT);
        bf16_t* Ow = cur.O + (size_t)(qi * QBLK) * KP;
#pragma unroll
        for (int r = 0; r < 16; ++r) {
            float ss = 0.f;
#pragma unroll
            for (int d0 = 0; d0 < 4; ++d0) { o[d0][r] -= exch[(d0 * 16 + r) * 64 + lane]; ss += o[d0][r] * o[d0][r]; }
#pragma unroll
            for (int of = 1; of < 32; of <<= 1) ss += __shfl_xor(ss, of);
            const float rstd = rsqrtf(ss * (1.f / 128.f) + EPS); const int orow = crow(r, hi);
#pragma unroll
            for (int d0 = 0; d0 < 4; ++d0) { const float v = o[d0][r] * rstd * gsub[d0]; const float vn = __shfl_xor(v, 1);
                if ((r32 & 1) == 0) *(unsigned*)(Ow + (size_t)orow * KP + d0 * 32 + r32) = cvtpk(v, vn); }
        }
    }
    if (lastblk) __syncthreads();
#undef KBASE
#undef MASKT
#undef HALF_STEP
}
template <bool ZC = false>
__device__ __forceinline__ void phase(char* lds, const bf16_t* QKb, const bf16_t* Vb, bf16_t* MX, float lam, float smax, const float* subg, int G, int vcu, int L0 = -1, int Lend = 1 << 30) {
    constexpr int NX = NQB / 2; const int TOTAL = (NB * NH * NX) < Lend ? (NB * NH * NX) : Lend;
    int L = L0 < 0 ? vcu : L0; if (L >= TOTAL) return;
    int pass = 0;
#define MKREF(ref, LL, ps) do { const int bh_ = (LL) / NX, x_ = (LL) % NX, qb_ = (ps) ? (NQB - 1 - x_) : x_, b_ = bh_ / NH, h_ = bh_ % NH; \
        const size_t row0_ = (size_t)b_ * SEQ; (ref).P0 = qb_ * QB; \
        (ref).Q = QKb + (row0_ + qb_ * QB) * KP + h_ * 128; (ref).K = QKb + row0_ * KP + 512 + h_ * 128; (ref).V = Vb + row0_ * VP + h_ * 128; \
        (ref).O = MX + (row0_ + qb_ * QB) * KP + h_ * 128; } while (0)
    BlockRef cur, nxt; MKREF(cur, L, 0);
    Seam S;
    int tid_ = threadIdx.x; asm volatile("" : "+v"(tid_));
    prime(cur, lds, S, tid_);
    for (;;) {
        const bool more_pass = pass == 0, more_item = L + G < TOTAL, last = !more_pass && !more_item;
        int passn = pass + 1, Ln = L;
        if (!more_pass) { passn = 0; Ln = more_item ? L + G : L; }
        if (last) nxt = cur; else MKREF(nxt, Ln, passn);
        block<ZC>(cur, nxt, lds, S, lam, smax, subg, last, tid_);
        if (last) break;
        cur = nxt; pass = passn; L = Ln;
    }
#undef MKREF
}
__device__ __forceinline__ void phase_queue(char* lds, const bf16_t* QKb, const bf16_t* Vb, bf16_t* MX, float lam, float smax, const float* subg, unsigned* qctr, int xg) {
    constexpr int TOTAL = NB * NH * NQB / 8;
    volatile int* tk = (volatile int*)(lds + LDS_END);
#define MKREFQ(ref, kk) do { const int hf_ = (kk) >> 6, k6_ = (kk) & 63, bh_ = 4 * xg + 2 * hf_ + (k6_ & 1), qb_ = NQB - 1 - (k6_ >> 1), b_ = bh_ / NH, h_ = bh_ % NH; \
        const size_t row0_ = (size_t)b_ * SEQ; (ref).P0 = qb_ * QB; \
        (ref).Q = QKb + (row0_ + qb_ * QB) * KP + h_ * 128; (ref).K = QKb + row0_ * KP + 512 + h_ * 128; (ref).V = Vb + row0_ * VP + h_ * 128; \
        (ref).O = MX + (row0_ + qb_ * QB) * KP + h_ * 128; } while (0)
    if (threadIdx.x == 0) { tk[0] = (int)atomicAdd(qctr, 1u); tk[1] = (int)atomicAdd(qctr, 1u); }
    __syncthreads();
    int tc = tk[0];
    if (tc >= TOTAL) { __syncthreads(); return; }
    BlockRef cur, nxt; MKREFQ(cur, tc);
    Seam S;
    int tid_ = threadIdx.x; asm volatile("" : "+v"(tid_));
    prime(cur, lds, S, tid_);
    for (int i = 0;; ++i) {
        const int tn = tk[(i + 1) & 1];
        if (threadIdx.x == 0) tk[i & 1] = (int)atomicAdd(qctr, 1u);
        const bool last = tn >= TOTAL;
        if (last) nxt = cur; else MKREFQ(nxt, tn);
        block<false>(cur, nxt, lds, S, lam, smax, subg, last, tid_);
        if (last) break;
        cur = nxt;
    }
    __syncthreads();
#undef MKREFQ
}
#undef ROWK
#undef ROWV
#undef LD8
#undef VMW
#undef VMWN
#undef SLOAD_H
#undef SWRITE_HK
#undef SWRITE_HV
#undef SWRITE_H
#undef QLOAD
#undef KSWZ
#undef SBAR
}


enum { PH_PRO = 0, PH_H1, PH_WIN, PH_WIN_F, PH_QKN, PH_ATT, PH_ATTC, PH_SSM, PH_GLU, PH_NORM, PH_WOUT, PH_WOUT_F, PH_H2, PH_RS, PH_RS2, PH_RS_F, PH_SD, PH_ROUTE, PH_SLOT, PH_E1, PH_E1_F, PH_E2, PH_COMB, PH_M_B, PH_M_D, PH_NORM2, PH_H2_2, PH_M_J2, PH_X1, PH_X2, PH_M_A2, PH_M_E3, PH_SLOT4, PH_E2S_F, PH_COMB3, PH_M_E4, PH_H2_3, PH_E1_8, PH_M_E5, PH_E1_88, PH_E2_8, PH_COMB4, PH_E2_B8, PH_E1_G8, PH_E2_P8, PH_M_J3, PH_SLOT5, PH_COMB5, PH_M_E6, PH_COUNT };
constexpr int NTHREADS = 512;
constexpr int LDS_BYTES = 147456;
constexpr int LDS_MISC_OFF = 147456 - 256;
typedef unsigned long long mask_t;
#define PHBIT(k) (1ull << (k))

template <mask_t MASK>
__global__ void __launch_bounds__(NTHREADS, 2) mega(Params p) {
    extern __shared__ __attribute__((aligned(16))) unsigned char lds_raw[];
#define MAKE_CTX() Ctx c; { int t_ = threadIdx.x; asm volatile("" : "+v"(t_)); c.tid = t_; c.lane = c.tid & 63; c.wave = __builtin_amdgcn_readfirstlane(c.tid >> 6); c.bid = blockIdx.x; c.nb = gridDim.x; \
    c.gtid = c.bid * NTHREADS + c.tid; c.gthreads = c.nb * NTHREADS; c.gwave = c.bid * (NTHREADS / 64) + c.wave; c.gwaves = c.nb * (NTHREADS / 64); c.ws = p.ws; c.lds = (float*)lds_raw; }
    unsigned char* ws = p.ws;
    PG8_LAS unsigned char* lds3 = (PG8_LAS unsigned char*)lds_raw;
    const int G = gridDim.x, bid = blockIdx.x, vcu = (G % 8 == 0) ? (bid % 8) * (G / 8) + bid / 8 : bid;
    constexpr bool MULTI = (MASK & (MASK - 1)) != 0;
    XcdBarrier bar; bar.bar = (unsigned*)(ws + WS_CTL) + CW_BAR; bar.x = 0; bar.st = nullptr;
    if constexpr (MULTI) {
        volatile LAS unsigned* misc = (volatile LAS unsigned*)(lds3 + LDS_MISC_OFF);
        if (threadIdx.x < 32) misc[threadIdx.x] = 0u;
        __syncthreads();
        bar = xcd_barrier_post((unsigned*)(ws + WS_CTL) + CW_BAR, misc + 8);
    }
    bool first = true;
#ifndef TIME_A
#define TIME_A -1
#endif
#ifndef TIME_B
#define TIME_B -1
#endif
#ifndef TIME_Q
#define TIME_Q 800
#endif
    constexpr bool TIMING = (TIME_A >= 0) || (TIME_B >= 0);
    unsigned long long tstart = 0, t_a = 0, t_b = 0; int pidx = 0;
#define STAMP() ({ if constexpr (TIMING) { const unsigned long long now_ = __builtin_amdgcn_s_memrealtime(); \
        if (pidx > 0 && pidx - 1 == TIME_A) t_a = now_ - tstart; if (pidx > 0 && pidx - 1 == TIME_B) t_b = now_ - tstart; tstart = now_; ++pidx; } true; })
#define PHASE(k) if constexpr ((MASK >> (k)) & 1ull) if ((MULTI ? (first ? (first = false, true) : (xcd_barrier(bar), true)) : true)) if (STAMP())
    PHASE(PH_PRO) { MAKE_CTX(); ph_prologue(c, p); }
    PHASE(PH_M_A2) { MAKE_CTX(); ph_prologue2(c, p); ph_convert<false>(c, p); }
    PHASE(PH_H1) { MAKE_CTX(); ph_h1(c, p); }
    PHASE(PH_M_B) { MAKE_CTX(); ph_h1(c, p); ph_ssm_gen(c, p); }
    PHASE(PH_WIN) { MAKE_CTX(); SG_Args g{(const bf16_t*)(ws + WS_H), DM, nullptr, p.in[I_WIN], nullptr, 2048, 0, nullptr, T, 2048, DM};
        EpiWin E{(bf16_t*)(ws + WS_QK), (bf16_t*)(ws + WS_V), (bf16_t*)(ws + WS_AP)}; sgemm_phase<false>(c, g, E); }
    PHASE(PH_WIN_F) { MAKE_CTX(); pg8::Gemm g{(const bf16_t*)(ws + WS_H), (const bf16_t*)(ws + WS_WIN_T), DM, DM, nullptr}; pg8::DenseOrder S; S.init(T, 2048, G, bid);
        pg8::EpiWinF E{(bf16_t*)(ws + WS_QK), (bf16_t*)(ws + WS_V), (bf16_t*)(ws + WS_AP)}; pg8::gemm_phase<pg8::EpiWinF, pg8::DenseOrder, false, true>(lds3, g, S, E); }
    PHASE(PH_QKN) { MAKE_CTX(); ph_qkn(c, p); }
    PHASE(PH_M_D) { { MAKE_CTX(); ph_qkn2(c, p); }
        { pg8::Gemm g{(const bf16_t*)(ws + WS_AP), (const bf16_t*)(ws + WS_SSM_BA), 256, APK, nullptr}; pg8::SsmOrder S{G, vcu};
          pg8::EpiSsmA E{(float*)(ws + WS_DS)}; pg8::gemm_phase<pg8::EpiSsmA, pg8::SsmOrder, false, false>(lds3, g, S, E); }
        __builtin_amdgcn_fence(__ATOMIC_ACQUIRE, "agent"); asm volatile("s_waitcnt vmcnt(0)" ::: "memory"); __syncthreads();
        { MAKE_CTX(); ph_ssm_scan(c, p, vcu); }
        asm volatile("s_waitcnt vmcnt(0)" ::: "memory"); __syncthreads(); __builtin_amdgcn_fence(__ATOMIC_ACQUIRE, "agent"); asm volatile("s_waitcnt vmcnt(0)" ::: "memory"); __syncthreads();
        { pg8::Gemm g{(const bf16_t*)(ws + WS_AP), (const bf16_t*)(ws + WS_SSM_BC), APK, APK, nullptr}; pg8::SsmOrder S{G, vcu};
          pg8::EpiSsmC E{(bf16_t*)(ws + WS_Y)}; pg8::gemm_phase<pg8::EpiSsmC, pg8::SsmOrder, false, false>(lds3, g, S, E); } }
    PHASE(PH_ATT) { MAKE_CTX(); ph_att_base(c, p); }
    PHASE(PH_ATTC) { MAKE_CTX(); ph_att_comb(c, p); }
    PHASE(PH_SSM) { MAKE_CTX(); ph_ssm_base(c, p); }
    PHASE(PH_M_E3) { { constexpr int GU8E = 0; MAKE_CTX(); const float* lamp = (const float*)(ws + WS_LAM); const float lam_ = lamp[0], smax_ = lamp[1];
          float* scr = c.lds + c.wave * (64 * 65);
          const int grp = vcu & 3;
          const unsigned prog = grp == 0 ? 0x0213u : grp == 1 ? 0x0231u : grp == 2 ? 0x0321u : 0x2514u;
          for (int step = 0; step < 4; ++step) {
              const int code = (int)((prog >> (4 * step)) & 15u);
              if (code == 1 || code == 2) { const int i_ = code - 1;
                  att::phase((char*)lds_raw, (const bf16_t*)(ws + WS_QK), (const bf16_t*)(ws + WS_V), (bf16_t*)(ws + WS_MIXIN), lam_, smax_, p.in[I_SUBG], G, vcu, vcu + i_ * G, vcu + i_ * G + 1); }
              else if (code >= 3) { const int lo = code == 5 ? 96 : 0, hi = code == 4 ? 96 : 192;
                  conv_range<GU8E>(c, p, vcu * 192 + lo + c.wave, vcu * 192 + hi, 8, scr); }
              __syncthreads();
          }
        }
        { pg8::Gemm g{(const bf16_t*)(ws + WS_Y), (const bf16_t*)(ws + WS_WGLU_T), 512, 512, nullptr}; pg8::DenseOrder S; S.init(T, 512, G, bid);
          pg8::EpiGluF E{(const bf16_t*)(ws + WS_Y), (bf16_t*)(ws + WS_MIXIN), (float*)(ws + WS_SS1P)}; pg8::gemm_phase<pg8::EpiGluF, pg8::DenseOrder, false, true>(lds3, g, S, E); } }
    PHASE(PH_M_E4) { { constexpr int GU8E = 1; MAKE_CTX(); const float* lamp = (const float*)(ws + WS_LAM); const float lam_ = lamp[0], smax_ = lamp[1];
          float* scr = c.lds + c.wave * (64 * 65);
          const int grp = vcu & 3;
          const unsigned prog = grp == 0 ? 0x0213u : grp == 1 ? 0x0231u : grp == 2 ? 0x0321u : 0x2514u;
          for (int step = 0; step < 4; ++step) {
              const int code = (int)((prog >> (4 * step)) & 15u);
              if (code == 1 || code == 2) { const int i_ = code - 1;
                  att::phase((char*)lds_raw, (const bf16_t*)(ws + WS_QK), (const bf16_t*)(ws + WS_V), (bf16_t*)(ws + WS_MIXIN), lam_, smax_, p.in[I_SUBG], G, vcu, vcu + i_ * G, vcu + i_ * G + 1); }
              else if (code >= 3) { const int lo = code == 5 ? 96 : 0, hi = code == 4 ? 96 : 192;
                  conv_range<GU8E>(c, p, vcu * 192 + lo + c.wave, vcu * 192 + hi, 8, scr); }
              __syncthreads();
          }
        }
        { pg8::Gemm g{(const bf16_t*)(ws + WS_Y), (const bf16_t*)(ws + WS_WGLU_T), 512, 512, nullptr}; pg8::DenseOrder S; S.init(T, 512, G, bid);
          pg8::EpiGluF E{(const bf16_t*)(ws + WS_Y), (bf16_t*)(ws + WS_MIXIN), (float*)(ws + WS_SS1P)}; pg8::gemm_phase<pg8::EpiGluF, pg8::DenseOrder, false, true>(lds3, g, S, E); } }
    PHASE(PH_M_E5) { { constexpr int GU8E = 2; MAKE_CTX(); const float* lamp = (const float*)(ws + WS_LAM); const float lam_ = lamp[0], smax_ = lamp[1];
          float* scr = c.lds + c.wave * (64 * 65);
          const int grp = vcu & 3;
          const unsigned prog = grp == 0 ? 0x0213u : grp == 1 ? 0x0231u : grp == 2 ? 0x0321u : 0x2514u;
#define E5_STEPS(ZC_) \
          for (int step = 0; step < 4; ++step) { \
              const int code = (int)((prog >> (4 * step)) & 15u); \
              if (code == 1 || code == 2) { const int i_ = code - 1; \
                  att::phase<ZC_>((char*)lds_raw, (const bf16_t*)(ws + WS_QK), (const bf16_t*)(ws + WS_V), (bf16_t*)(ws + WS_MIXIN), lam_, smax_, p.in[I_SUBG], G, vcu, vcu + i_ * G, vcu + i_ * G + 1); } \
              else if (code >= 3) { const int lo = code == 5 ? 96 : 0, hi = code == 4 ? 96 : 192; \
                  conv_range<GU8E>(c, p, vcu * 192 + lo + c.wave, vcu * 192 + hi, 8, scr); } \
              __syncthreads(); \
          }
          if (smax_ * 1.4426950408889634f <= 64.f) { E5_STEPS(true); }
          else { E5_STEPS(false); }
#undef E5_STEPS
        }
        { pg8::Gemm g{(const bf16_t*)(ws + WS_Y), (const bf16_t*)(ws + WS_WGLU_T), 512, 512, nullptr}; pg8::DenseOrder S; S.init(T, 512, G, bid);
          pg8::EpiGluF E{(const bf16_t*)(ws + WS_Y), (bf16_t*)(ws + WS_MIXIN), (float*)(ws + WS_SS1P)}; pg8::gemm_phase<pg8::EpiGluF, pg8::DenseOrder, false, true>(lds3, g, S, E); } }
    PHASE(PH_GLU) { MAKE_CTX(); SG_Args g{(const bf16_t*)(ws + WS_Y), 512, nullptr, p.in[I_WGLU], nullptr, 512, 0, nullptr, T, 512, 512};
        EpiGlu E{(const bf16_t*)(ws + WS_Y), (bf16_t*)(ws + WS_MIXIN), (float*)(ws + WS_CTL + CTL_SS1)}; sgemm_phase<false>(c, g, E); }
    PHASE(PH_NORM) { MAKE_CTX(); ph_ssm_norm(c, p); }
    PHASE(PH_NORM2) { MAKE_CTX(); ph_ssm_norm2(c, p); }
    PHASE(PH_WOUT) { MAKE_CTX(); SG_Args g{(const bf16_t*)(ws + WS_MIXIN), DM, nullptr, p.in[I_WOUT], nullptr, DM, 0, nullptr, T, DM, DM};
        EpiWout E{p.in[I_X], (const float*)(ws + WS_MOD), p.out, (float*)(ws + WS_CTL + CTL_SS2)}; sgemm_phase<false>(c, g, E); }
    PHASE(PH_WOUT_F) { MAKE_CTX(); pg8::Gemm g{(const bf16_t*)(ws + WS_MIXIN), (const bf16_t*)(ws + WS_WOUT_T), DM, DM, nullptr}; pg8::DenseOrder S; S.init(T, DM, G, bid);
        pg8::EpiWoutF E{p.in[I_X], (const float*)(ws + WS_MOD), p.out, (float*)(ws + WS_SS2P)}; pg8::gemm_phase<pg8::EpiWoutF, pg8::DenseOrder, false, true>(lds3, g, S, E); }
    PHASE(PH_H2) { MAKE_CTX(); ph_h2(c, p); }
    PHASE(PH_H2_2) { MAKE_CTX(); ph_h2_2(c, p); }
    PHASE(PH_H2_3) { MAKE_CTX(); ph_h2_3(c, p); }
    PHASE(PH_RS) { MAKE_CTX(); SG_Args g{(const bf16_t*)(ws + WS_H), DM, nullptr, p.in[I_WR], nullptr, 256, 0, nullptr, T, 256, DM};
        EpiLogits E{(float*)(ws + WS_LOGITS)}; sgemm_phase<false>(c, g, E); }
    PHASE(PH_RS2) { MAKE_CTX(); SG_Args g2{(const bf16_t*)(ws + WS_H), DM, nullptr, p.in[I_WGS], p.in[I_WUS], 256, 0, nullptr, T, 256, DM};
        EpiSwiglu E2{(bf16_t*)(ws + WS_ACTS), 256}; sgemm_phase<true>(c, g2, E2); }
    PHASE(PH_RS_F) { MAKE_CTX(); pg8::Gemm g{(const bf16_t*)(ws + WS_H), (const bf16_t*)(ws + WS_WRS_T), DM, DM, nullptr}; pg8::DenseOrder S; S.init(T, 768, G, bid);
        pg8::EpiRSF E{(float*)(ws + WS_LOGITS), (bf16_t*)(ws + WS_ACTS)}; pg8::gemm_phase<pg8::EpiRSF, pg8::DenseOrder, false, true>(lds3, g, S, E); }
    PHASE(PH_SD) { MAKE_CTX(); SG_Args g{(const bf16_t*)(ws + WS_ACTS), 256, nullptr, p.in[I_WDS], nullptr, DM, 0, nullptr, T, DM, ED};
        EpiSD E{(const float*)(ws + WS_MOD), p.out}; sgemm_phase<false>(c, g, E); }
    PHASE(PH_ROUTE) { MAKE_CTX(); ph_route(c, p); }
    PHASE(PH_M_J2) { { MAKE_CTX(); ph_route2<false>(c, p); }
        { pg8::Gemm g{(const bf16_t*)(ws + WS_ACTS), (const bf16_t*)(ws + WS_WDS_T), ED, ED, nullptr}; pg8::DenseOrder S; S.init(T, DM, G, bid);
          pg8::EpiSDY E{(bf16_t*)(ws + WS_YSH)}; pg8::gemm_phase<pg8::EpiSDY, pg8::DenseOrder, false, true>(lds3, g, S, E); } }
    PHASE(PH_M_J3) { { MAKE_CTX(); ph_route2<true>(c, p); }
        { pg8::Gemm g{(const bf16_t*)(ws + WS_ACTS), (const bf16_t*)(ws + WS_WDS_T), ED, ED, nullptr}; pg8::DenseOrder S; S.init(T, DM, G, bid);
          pg8::EpiSDY E{(bf16_t*)(ws + WS_YSH)}; pg8::gemm_phase<pg8::EpiSDY, pg8::DenseOrder, false, true>(lds3, g, S, E); } }
    PHASE(PH_SLOT5) { MAKE_CTX(); ph_slot5(c, p); }
    PHASE(PH_SLOT) { MAKE_CTX(); ph_slot(c, p); }
    PHASE(PH_SLOT4) { MAKE_CTX(); ph_slot3<true>(c, p); }
    PHASE(PH_E1) { MAKE_CTX(); SG_Args g{(const bf16_t*)(ws + WS_H), DM, (const int*)(ws + WS_SLOT_TOK), p.in[I_WGE], p.in[I_WUE], 256, (size_t)DM * ED, (const int*)(ws + WS_TILE_E), NS_MAX, ED, DM};
        EpiSwiglu E{(bf16_t*)(ws + WS_ACTE), 256}; sgemm_phase<true>(c, g, E); }
    PHASE(PH_E1_F) { MAKE_CTX(); pg8::Gemm g{(const bf16_t*)(ws + WS_H), (const bf16_t*)(ws + WS_WGU), DM, DM, (const int*)(ws + WS_SLOT_TOK)};
        pg8::GroupedOrder S{(const int*)(ws + WS_TILE_E), (int)((const unsigned*)(ws + WS_CTL))[CW_NTILES], 2, G, vcu};
        pg8::EpiE1F E{(bf16_t*)(ws + WS_ACTE)}; pg8::gemm_phase<pg8::EpiE1F, pg8::GroupedOrder, true, true>(lds3, g, S, E); }
    PHASE(PH_X1) { pg8::Gemm g{(const bf16_t*)(ws + WS_ACTE), (const bf16_t*)(ws + WS_WD), ED / 2, ED / 2, nullptr, 0x7A7A7A7Au, 0x7C7C7C7Cu};
        pg8::GroupedOrder S{(const int*)(ws + WS_TILE_E), (int)((const unsigned*)(ws + WS_CTL))[CW_NTILES], 4, G, vcu};
        pg8::EpiNone E{(float*)(ws + WS_DS)}; pg8::gemm_phase<pg8::EpiNone, pg8::GroupedOrder, true, true, true>(lds3, g, S, E); }
    PHASE(PH_X2) { pg8::Gemm g{(const bf16_t*)(ws + WS_ACTE), (const bf16_t*)(ws + WS_WD), ED, ED, nullptr};
        pg8::GroupedOrder S{(const int*)(ws + WS_TILE_E), (int)((const unsigned*)(ws + WS_CTL))[CW_NTILES], 4, G, vcu};
        pg8::EpiDense E{(bf16_t*)(ws + WS_YA)}; pg8::gemm_phase<pg8::EpiDense, pg8::GroupedOrder, false, true>(lds3, g, S, E); }
    PHASE(PH_E1_8) { pg8::Gemm g{(const bf16_t*)(ws + WS_H8), (const bf16_t*)(ws + WS_WGU), DM / 2, DM / 2, (const int*)(ws + WS_SLOT_TOK), 0x79797979u};
        pg8::GroupedOrder S{(const int*)(ws + WS_TILE_E), (int)((const unsigned*)(ws + WS_CTL))[CW_NTILES], 2, G, vcu};
        pg8::EpiE1F E{(bf16_t*)(ws + WS_ACTE)}; pg8::gemm_phase<pg8::EpiE1F, pg8::GroupedOrder, true, true, true>(lds3, g, S, E); }
    PHASE(PH_E1_88) { pg8::Gemm g{(const bf16_t*)(ws + WS_H8), (const bf16_t*)(ws + WS_WGU), DM / 2, DM / 2, (const int*)(ws + WS_SLOT_TOK), 0x79797979u};
        pg8::GroupedOrderL S{nullptr, (int)((const unsigned*)(ws + WS_CTL))[CW_NTILES], 2, G, vcu}; S.fill((const int*)(ws + WS_TILE_E), (PG8_LAS int*)(lds3 + 131072));
        pg8::EpiE1F8 E{ws + WS_ACTE}; pg8::gemm_phase<pg8::EpiE1F8, pg8::GroupedOrderL, true, true, true>(lds3, g, S, E); }
    PHASE(PH_E2_8) { pg8::Gemm g{(const bf16_t*)(ws + WS_ACTE), (const bf16_t*)(ws + WS_WD), ED / 2, ED / 2, nullptr, 0x7A7A7A7Au, 0x7C7C7C7Cu};
        pg8::GroupedOrder S{(const int*)(ws + WS_TILE_E), (int)((const unsigned*)(ws + WS_CTL))[CW_NTILES], 4, G, vcu};
        pg8::EpiE2S8b E{(const float*)(ws + WS_SLOT_GATE), ws + WS_YS}; pg8::gemm_phase<pg8::EpiE2S8b, pg8::GroupedOrder, true, true, true>(lds3, g, S, E); }
    PHASE(PH_E2_B8) { pg8::Gemm g{(const bf16_t*)(ws + WS_ACTE), (const bf16_t*)(ws + WS_WD), ED, ED, nullptr};
        pg8::GroupedOrder S{(const int*)(ws + WS_TILE_E), (int)((const unsigned*)(ws + WS_CTL))[CW_NTILES], 4, G, vcu};
        pg8::EpiE2S8 E{(const float*)(ws + WS_SLOT_GATE), ws + WS_YS}; pg8::gemm_phase<pg8::EpiE2S8, pg8::GroupedOrder, false, true>(lds3, g, S, E); }
    PHASE(PH_E1_G8) { pg8::Gemm g{(const bf16_t*)(ws + WS_H8), (const bf16_t*)(ws + WS_WGU), DM / 2, DM / 2, (const int*)(ws + WS_SLOT_TOK), 0x79797979u};
        pg8::GroupedOrder S{(const int*)(ws + WS_TILE_E), (int)((const unsigned*)(ws + WS_CTL))[CW_NTILES], 2, G, vcu};
        pg8::EpiE1G8 E{(const float*)(ws + WS_SLOT_GATE), ws + WS_ACTE}; pg8::gemm_phase<pg8::EpiE1G8, pg8::GroupedOrder, true, true, true>(lds3, g, S, E); }
    static_assert(Y8_SCALE == 16.f && ACT8_SCALE == 8.f && WD8_SCALE == 32.f, "E8M0 scales below");
    PHASE(PH_E2_P8) { pg8::Gemm g{(const bf16_t*)(ws + WS_ACTE), (const bf16_t*)(ws + WS_WD), ED / 2, ED / 2, nullptr, 0x7A7A7A7Au, 0x80808080u};
        pg8::GroupedOrderL S{nullptr, (int)((const unsigned*)(ws + WS_CTL))[CW_NTILES], 4, G, vcu}; S.fill((const int*)(ws + WS_TILE_E), (PG8_LAS int*)(lds3 + 131072));
        pg8::EpiE2P8 E{ws + WS_YS}; pg8::gemm_phase<pg8::EpiE2P8, pg8::GroupedOrderL, true, true, true, 2>(lds3, g, S, E); }
    PHASE(PH_COMB5) { MAKE_CTX(); ph_combine5(c, p); }
    PHASE(PH_COMB4) { MAKE_CTX(); ph_combine4(c, p); }
    PHASE(PH_E2) { MAKE_CTX(); SG_Args g{(const bf16_t*)(ws + WS_ACTE), 256, nullptr, p.in[I_WDE], nullptr, DM, (size_t)ED * DM, (const int*)(ws + WS_TILE_E), NS_MAX, DM, ED};
        EpiE2 E{(const int*)(ws + WS_SLOT_ASG), (const float*)(ws + WS_SLOT_GATE), (bf16_t*)(ws + WS_YA)}; sgemm_phase<false>(c, g, E); }
    PHASE(PH_E2S_F) { pg8::Gemm g{(const bf16_t*)(ws + WS_ACTE), (const bf16_t*)(ws + WS_WD), ED, ED, nullptr};
        pg8::GroupedOrder S{(const int*)(ws + WS_TILE_E), (int)((const unsigned*)(ws + WS_CTL))[CW_NTILES], 4, G, vcu};
        pg8::EpiE2S E{(const int*)(ws + WS_SLOT_ASG), (const float*)(ws + WS_SLOT_GATE), (bf16_t*)(ws + WS_YS)}; pg8::gemm_phase<pg8::EpiE2S, pg8::GroupedOrder, false, true>(lds3, g, S, E); }
    PHASE(PH_COMB3) { MAKE_CTX(); ph_combine3(c, p); }
    PHASE(PH_COMB) { MAKE_CTX(); ph_combine(c, p); }
    if constexpr (TIMING) {
        xcd_barrier(bar); (void)STAMP();
        if (blockIdx.x == 0 && threadIdx.x == 0) {
            const unsigned long long qb = (t_b + TIME_Q / 2) / TIME_Q;
            const unsigned long long wait = t_a + qb * 102400ull, t0 = __builtin_amdgcn_s_memrealtime();
            while (__builtin_amdgcn_s_memrealtime() - t0 < wait) __builtin_amdgcn_s_sleep(8);
        }
    }
#undef PHASE
}

#ifndef PLAN
#define PLAN 18
#endif
#if PLAN == 0
#define LAUNCH_LIST X(PHBIT(PH_PRO)) X(PHBIT(PH_H1)) X(PHBIT(PH_WIN)) X(PHBIT(PH_QKN)) X(PHBIT(PH_ATT)) X(PHBIT(PH_ATTC)) X(PHBIT(PH_SSM)) X(PHBIT(PH_GLU)) X(PHBIT(PH_NORM)) \
    X(PHBIT(PH_WOUT)) X(PHBIT(PH_H2)) X(PHBIT(PH_RS)) X(PHBIT(PH_RS2)) X(PHBIT(PH_SD)) X(PHBIT(PH_ROUTE)) X(PHBIT(PH_SLOT)) X(PHBIT(PH_E1)) X(PHBIT(PH_E2)) X(PHBIT(PH_COMB))
#elif PLAN == 12
#define LAUNCH_LIST X(PHBIT(PH_M_A2) | PHBIT(PH_M_B) | PHBIT(PH_WIN_F) | PHBIT(PH_M_D) | PHBIT(PH_M_E3) | PHBIT(PH_NORM2) | PHBIT(PH_WOUT_F) | PHBIT(PH_H2_2) | PHBIT(PH_RS_F) | PHBIT(PH_M_J2) | PHBIT(PH_SLOT4) | PHBIT(PH_E1_F) | PHBIT(PH_E2S_F) | PHBIT(PH_COMB3))
#elif PLAN == 13
#define LAUNCH_LIST X(PHBIT(PH_M_A2) | PHBIT(PH_M_B) | PHBIT(PH_WIN_F) | PHBIT(PH_M_D) | PHBIT(PH_M_E3) | PHBIT(PH_NORM2) | PHBIT(PH_WOUT_F) | PHBIT(PH_H2_2) | PHBIT(PH_RS_F) | PHBIT(PH_M_J2) | PHBIT(PH_SLOT4) | PHBIT(PH_E1_F) | PHBIT(PH_X1) | PHBIT(PH_E2S_F) | PHBIT(PH_COMB3))
#elif PLAN == 14
#define LAUNCH_LIST X(PHBIT(PH_M_A2) | PHBIT(PH_M_B) | PHBIT(PH_WIN_F) | PHBIT(PH_M_D) | PHBIT(PH_M_E4) | PHBIT(PH_NORM2) | PHBIT(PH_WOUT_F) | PHBIT(PH_H2_3) | PHBIT(PH_RS_F) | PHBIT(PH_M_J2) | PHBIT(PH_SLOT4) | PHBIT(PH_E1_8) | PHBIT(PH_E2S_F) | PHBIT(PH_COMB3))
#elif PLAN == 15
#define LAUNCH_LIST X(PHBIT(PH_M_A2) | PHBIT(PH_M_B) | PHBIT(PH_WIN_F) | PHBIT(PH_M_D) | PHBIT(PH_M_E5) | PHBIT(PH_NORM2) | PHBIT(PH_WOUT_F) | PHBIT(PH_H2_3) | PHBIT(PH_RS_F) | PHBIT(PH_M_J2) | PHBIT(PH_SLOT4) | PHBIT(PH_E1_88) | PHBIT(PH_E2_8) | PHBIT(PH_COMB4))
#elif PLAN == 99
#define LAUNCH_LIST X(PHBIT(PH_M_E5)) X(PHBIT(PH_E1_88)) X(PHBIT(PH_E2_8)) X(PHBIT(PH_COMB4)) X(PHBIT(PH_H2_3)) X(PHBIT(PH_M_D)) X(PHBIT(PH_WIN_F)) X(PHBIT(PH_WOUT_F)) X(PHBIT(PH_RS_F)) X(PHBIT(PH_M_J2))
#elif PLAN == 16
#define LAUNCH_LIST X(PHBIT(PH_M_A2) | PHBIT(PH_M_B) | PHBIT(PH_WIN_F) | PHBIT(PH_M_D) | PHBIT(PH_M_E4) | PHBIT(PH_NORM2) | PHBIT(PH_WOUT_F) | PHBIT(PH_H2_3) | PHBIT(PH_RS_F) | PHBIT(PH_M_J2) | PHBIT(PH_SLOT4) | PHBIT(PH_E1_8) | PHBIT(PH_E2_B8) | PHBIT(PH_COMB4))
#elif PLAN == 17
#define LAUNCH_LIST X(PHBIT(PH_M_A2) | PHBIT(PH_M_B) | PHBIT(PH_WIN_F) | PHBIT(PH_M_D) | PHBIT(PH_M_E5) | PHBIT(PH_NORM2) | PHBIT(PH_WOUT_F) | PHBIT(PH_H2_3) | PHBIT(PH_RS_F) | PHBIT(PH_M_J2) | PHBIT(PH_SLOT4) | PHBIT(PH_E1_G8) | PHBIT(PH_E2_P8) | PHBIT(PH_COMB4))
#elif PLAN == 18
#define LAUNCH_LIST X(PHBIT(PH_M_A2) | PHBIT(PH_M_B) | PHBIT(PH_WIN_F) | PHBIT(PH_M_D) | PHBIT(PH_M_E5) | PHBIT(PH_NORM2) | PHBIT(PH_WOUT_F) | PHBIT(PH_H2_3) | PHBIT(PH_RS_F) | PHBIT(PH_M_J3) | PHBIT(PH_SLOT5) | PHBIT(PH_E1_88) | PHBIT(PH_E2_P8) | PHBIT(PH_COMB5))
#elif PLAN == 20
#define LAUNCH_LIST X(PHBIT(PH_M_A2) | PHBIT(PH_M_B) | PHBIT(PH_WIN_F) | PHBIT(PH_M_D) | PHBIT(PH_M_E5) | PHBIT(PH_NORM2) | PHBIT(PH_WOUT_F) | PHBIT(PH_H2_3) | PHBIT(PH_RS_F) | PHBIT(PH_M_J3) | PHBIT(PH_SLOT5) | PHBIT(PH_E1_88) | PHBIT(PH_X1) | PHBIT(PH_E2_P8) | PHBIT(PH_COMB5))
#endif

extern "C" void kernel_launch(void* const* d_in, const int* in_sizes, int n_in, void* d_out, int out_size, void* d_ws, size_t ws_size, hipStream_t stream) {
    static int grid = 0;
    if (grid == 0) {
        if (n_in != 33 || out_size != T * DM || ws_size < WS_NEED) { fprintf(stderr, "kernel_launch: unexpected shapes (n_in %d out %d ws %zu)\n", n_in, out_size, ws_size); grid = -1; return; }
        int dev = 0, cus = 0;
        if (hipGetDevice(&dev) != hipSuccess || hipDeviceGetAttribute(&cus, hipDeviceAttributeMultiprocessorCount, dev) != hipSuccess) { grid = -1; return; }
        bool ok = true;
#define X(m) ok = ok && (hipFuncSetAttribute((const void*)mega<(m)>, hipFuncAttributeMaxDynamicSharedMemorySize, LDS_BYTES) == hipSuccess);
        LAUNCH_LIST
#undef X
        if (!ok) { grid = -1; return; }
        grid = cus;
    }
    if (grid < 0) return;
    (void)hipMemsetAsync((char*)d_ws + WS_CTL, 0, CTL_BYTES, stream);
    Params a{};
    for (int i = 0; i < 33; ++i) a.in[i] = (const float*)d_in[i];
    a.out = (float*)d_out; a.ws = (unsigned char*)d_ws;
#define X(m) hipLaunchKernelGGL((mega<(m)>), dim3(grid), dim3(NTHREADS), LDS_BYTES, stream, a);
    LAUNCH_LIST
#undef X
}
```

```cpp
#include <hip/hip_runtime.h>
#include <cstdio>
#include <cstdint>

typedef unsigned short bf16_t;
typedef float f32x4 __attribute__((ext_vector_type(4)));
typedef unsigned u32x4 __attribute__((ext_vector_type(4)));
typedef unsigned u32x2 __attribute__((ext_vector_type(2)));

constexpr int DM = 1024, NB = 8, SEQ = 4096, T = NB * SEQ;
constexpr int NH = 4, HD = 64, VD = 128, QKW = 512, ATTW = 512, SSMW = 512;
constexpr int SG = 32, SC = 16, SP = 64;
constexpr int LC = 16;
constexpr int NCHUNK = SEQ / LC;
constexpr int APK = 384;
constexpr int NE = 256, TOPK = 8, NGRP = 8, TOPG = 4, ED = 256;
constexpr int NS_MAX = 327680;
constexpr float EPS = 1e-6f;
constexpr float LAM_INIT = 0.2f;
constexpr float ROUTED_SCALE = 2.5f;
constexpr float WGU8_SCALE = 64.f, WD8_SCALE = 32.f, ACT8_SCALE = 8.f, Y8_SCALE = 16.f, WOUT8_SCALE = 64.f, MIXA8_SCALE = 8.f;

constexpr size_t MiB = 1u << 20;
constexpr size_t WS_CTL = 0, CTL_BYTES = 1 * MiB;
constexpr int CW_COUNTS = 1024;
constexpr int CW_COUNTS_S = 16384, CW_COUNTS_STRIDE = 32;
constexpr int CW_CURSOR = 1024 + 256;
constexpr int CW_NTILES = 2048;
constexpr int CW_ATTQ = 2560  , CW_CONVQ = 2176;
constexpr int CW_BAR = 4096;
constexpr size_t CTL_SS1 = 256 * 1024;
constexpr size_t CTL_SS2 = 384 * 1024;
constexpr size_t WS_MOD = 512 * 1024;
constexpr size_t WS_LAM = 1 * MiB + 256 * 1024;
constexpr size_t WS_ROPE = 1 * MiB + 512 * 1024;
constexpr size_t WS_SSMP = 2 * MiB + 512 * 1024;
constexpr size_t WS_SS1P = 3 * MiB;
constexpr size_t WS_SS2P = 528 * MiB;
constexpr size_t WS_HIST = 11 * MiB;
constexpr size_t WS_EIDX = 4 * MiB;
constexpr size_t WS_GATEW = 5 * MiB;
constexpr size_t WS_SLOT_TOK = 6 * MiB;
constexpr size_t WS_SLOT_ASG = 7 * MiB + 512 * 1024;
constexpr size_t WS_SLOT_GATE = 9 * MiB;
constexpr size_t WS_TILE_E = 10 * MiB + 512 * 1024;
constexpr size_t WS_PADST = 10 * MiB + 768 * 1024;
constexpr size_t WS_WIN_T = 12 * MiB;
constexpr size_t WS_WOUT_T = 16 * MiB;
constexpr size_t WS_WGLU_T = 18 * MiB;
constexpr size_t WS_WRS_T = 19 * MiB;
constexpr size_t WS_SSMPW = 20 * MiB + 512 * 1024;
constexpr size_t WS_WDS_T = 21 * MiB;
constexpr size_t WS_H18 = 960 * MiB;
constexpr size_t WS_WIN8 = 14 * MiB;
constexpr size_t WS_WRB = 656 * MiB;
constexpr size_t WS_DUMP = 1 * MiB + 384 * 1024;
constexpr size_t WS_WRT32 = 660 * MiB;
constexpr size_t WS_RBIAS = 1 * MiB + 256 * 1024 + 4096;
constexpr size_t WS_WS8 = 21 * MiB + 512 * 1024;
constexpr size_t WS_SSM_BA = 22 * MiB;
constexpr size_t WS_SSM_BC = 26 * MiB;
constexpr size_t WS_DS = 496 * MiB;
constexpr size_t WS_X1B = 448 * MiB;
constexpr size_t WS_WGU = 32 * MiB;
constexpr size_t WS_WD = 832 * MiB;
constexpr size_t WS_YS = 32 * MiB;
constexpr size_t WS_YA = 32 * MiB;
constexpr size_t WS_H = 288 * MiB;
constexpr size_t WS_H8 = 352 * MiB;
constexpr size_t WS_QK = 352 * MiB;
constexpr size_t WS_Y = 288 * MiB;
constexpr size_t WS_V = 416 * MiB;
constexpr size_t WS_AP = 448 * MiB;
constexpr size_t WS_ACTE = 672 * MiB;
constexpr size_t WS_MIXIN = 544 * MiB;
constexpr size_t WS_LOGITS = 608 * MiB;
constexpr size_t WS_ACTS = 640 * MiB;
constexpr size_t WS_YSH = 960 * MiB;
constexpr size_t WS_ATTO = 832 * MiB;
constexpr size_t WS_NEED = 1024 * MiB;

__device__ __forceinline__ float bf2f(bf16_t v) { return __uint_as_float((unsigned)v << 16); }
__device__ __forceinline__ bf16_t f2bf(float f) { unsigned u = __float_as_uint(f); return (bf16_t)((u + 0x7fffu + ((u >> 16) & 1u)) >> 16); }
__device__ __forceinline__ unsigned pk2(float lo, float hi) { return (unsigned)f2bf(lo) | ((unsigned)f2bf(hi) << 16); }
__device__ __forceinline__ float wave_sum(float v) {
#pragma unroll
    for (int o = 1; o < 64; o <<= 1) v += __shfl_xor(v, o);
    return v;
}
__device__ __forceinline__ unsigned pk4_fp8(float a, float b, float c2, float d) { int w = __builtin_amdgcn_cvt_pk_fp8_f32(a, b, 0, false); w = __builtin_amdgcn_cvt_pk_fp8_f32(c2, d, w, true); return (unsigned)w; }
__device__ __forceinline__ float siluf(float v) { return v * __builtin_amdgcn_rcpf(1.f + __expf(-v)); }
__device__ __forceinline__ float sigmoidf(float v) { return __builtin_amdgcn_rcpf(1.f + __expf(-v)); }
__device__ __forceinline__ float gelu_tanh(float v) { const float u2 = 1.5957691216057308f * (v + 0.044715f * v * v * v); return v * __builtin_amdgcn_rcpf(1.f + __expf(-u2)); }

constexpr int NTHREADS_ = 512;
struct Params {
    const float* in[33];
    float* out;
    unsigned char* ws;
    int pad0, pad1;
};

struct Ctx {
    int tid, lane, wave, bid, nb;
    int gtid, gthreads, gwave, gwaves;
    unsigned char* ws;
    float* lds;
};

enum { I_X = 0, I_C, I_N1G, I_N2G, I_WADA, I_BADA, I_WIN, I_QNG, I_KNG, I_LQ1, I_LK1, I_LQ2, I_LK2, I_SUBG,
       I_ARE, I_AIM, I_LOGDT, I_BRE, I_BIM, I_CRE, I_CIM, I_SD, I_WGLU, I_SNG, I_WOUT, I_WR, I_RB,
       I_WGE, I_WUE, I_WDE, I_WGS, I_WUS, I_WDS };

struct SG_Args {
    const bf16_t* A; int lda; const int* rowidx;
    const float* W; const float* W2; int ldb;
    size_t wstride;
    const int* tile_e;
    int M, N, K;
};
template <bool DUAL, class Epi>
__device__ __forceinline__ void sgemm_phase(const Ctx& c, const SG_Args g, const Epi& E) {
    float* As = c.lds;
    float* Bs = c.lds + 16 * 132;
    float* Bs2 = Bs + 16 * 128;
    const int tid = c.tid, ty = tid >> 5, tx = tid & 31;
    const int nMt = g.M / 128, nNt = g.N / 128, ntile = nMt * nNt;
    for (int tile = c.bid; tile < ntile; tile += c.nb) {
        const int mt = tile / nNt, nt = tile % nNt;
        const float* W = g.W; const float* W2 = g.W2;
        if (g.tile_e) { const int e = g.tile_e[mt >> 1]; if (e < 0) continue; W += (size_t)e * g.wstride; if (DUAL) W2 += (size_t)e * g.wstride; }
        f32x4 acc[8], acc2[8];
#pragma unroll
        for (int i = 0; i < 8; ++i) { acc[i] = (f32x4){0.f, 0.f, 0.f, 0.f}; acc2[i] = (f32x4){0.f, 0.f, 0.f, 0.f}; }
        const int arow = mt * 128 + (tid >> 2), akq = (tid & 3) * 4;
        const int asrc = g.rowidx ? g.rowidx[arow] : arow;
        const bf16_t* ap = g.A + (size_t)asrc * g.lda + akq;
        const int bk = tid >> 5, bn = (tid & 31) * 4;
        const float* bp = W + (size_t)bk * g.ldb + nt * 128 + bn;
        const float* bp2 = DUAL ? (W2 + (size_t)bk * g.ldb + nt * 128 + bn) : nullptr;
#pragma unroll 1
        for (int k0 = 0; k0 < g.K; k0 += 16) {
            const u32x2 av = *(const u32x2*)(ap + k0);
            const f32x4 bv = *(const f32x4*)(bp + (size_t)k0 * g.ldb);
            f32x4 bv2 = {0.f, 0.f, 0.f, 0.f};
            if (DUAL) bv2 = *(const f32x4*)(bp2 + (size_t)k0 * g.ldb);
            __syncthreads();
            As[(akq + 0) * 132 + (tid >> 2)] = __uint_as_float(av.x << 16);
            As[(akq + 1) * 132 + (tid >> 2)] = __uint_as_float(av.x & 0xffff0000u);
            As[(akq + 2) * 132 + (tid >> 2)] = __uint_as_float(av.y << 16);
            As[(akq + 3) * 132 + (tid >> 2)] = __uint_as_float(av.y & 0xffff0000u);
            *(f32x4*)(Bs + bk * 128 + bn) = bv;
            if (DUAL) *(f32x4*)(Bs2 + bk * 128 + bn) = bv2;
            __syncthreads();
#pragma unroll
            for (int kk = 0; kk < 16; ++kk) {
                const f32x4 a0 = *(const f32x4*)(As + kk * 132 + ty * 8), a1 = *(const f32x4*)(As + kk * 132 + ty * 8 + 4);
                const f32x4 b = *(const f32x4*)(Bs + kk * 128 + tx * 4);
                const float a[8] = {a0.x, a0.y, a0.z, a0.w, a1.x, a1.y, a1.z, a1.w};
#pragma unroll
                for (int i = 0; i < 8; ++i) acc[i] += a[i] * b;
                if (DUAL) {
                    const f32x4 b2 = *(const f32x4*)(Bs2 + kk * 128 + tx * 4);
#pragma unroll
                    for (int i = 0; i < 8; ++i) acc2[i] += a[i] * b2;
                }
            }
        }
#pragma unroll
        for (int i = 0; i < 8; ++i) E(mt * 128 + ty * 8 + i, nt * 128 + tx * 4, acc[i], acc2[i], tx);
    }
}

__device__ __forceinline__ void ph_prologue(const Ctx& c, const Params& p) {
    float* mod = (float*)(c.ws + WS_MOD);
    for (int idx = c.gtid; idx < NB * 6 * DM; idx += c.gthreads) {
        const int b = idx / (6 * DM), j = idx % (6 * DM);
        const float* cc = p.in[I_C] + b * DM; const float* w = p.in[I_WADA] + j;
        float acc = p.in[I_BADA][j];
#pragma unroll 8
        for (int k = 0; k < DM; ++k) acc += siluf(cc[k]) * w[(size_t)k * (6 * DM)];
        mod[idx] = acc;
    }
    float* ropec = (float*)(c.ws + WS_ROPE); float* ropes = ropec + SEQ * 32;
    for (int idx = c.gtid; idx < SEQ * 32; idx += c.gthreads) {
        const int l = idx >> 5, i = idx & 31;
        const double invf = exp(-log(10000.0) * (double)(2 * i) / 64.0);
        const double ang = (double)l * invf;
        ropec[idx] = (float)cos(ang); ropes[idx] = (float)sin(ang);
    }
    float* sp = (float*)(c.ws + WS_SSMP);
    float* abr = sp, * abi = sp + SG * SP, * bbr = sp + 2 * SG * SP, * bbi = bbr + SG * SP * SC;
    for (int idx = c.gtid; idx < SG * SP; idx += c.gthreads) {
        const int g = idx / SP;
        const double are = p.in[I_ARE][idx], aim = p.in[I_AIM][idx], dt = exp((double)p.in[I_LOGDT][g]);
        const double mag = exp(are * dt), ar = mag * cos(aim * dt), ai = mag * sin(aim * dt);
        abr[idx] = (float)ar; abi[idx] = (float)ai;
        const double den = are * are + aim * aim, nr = ar - 1.0;
        const double fre = (nr * are + ai * aim) / den, fim = (ai * are - nr * aim) / den;
        for (int ch = 0; ch < SC; ++ch) {
            const double br = p.in[I_BRE][idx * SC + ch], bi = p.in[I_BIM][idx * SC + ch];
            bbr[idx * SC + ch] = (float)(fre * br - fim * bi); bbi[idx * SC + ch] = (float)(fre * bi + fim * br);
        }
    }
    if (c.gtid == 0) {
        float s1 = 0.f, s2 = 0.f, gq = 0.f, gk = 0.f;
        for (int i = 0; i < HD; ++i) { s1 += p.in[I_LQ1][i] * p.in[I_LK1][i]; s2 += p.in[I_LQ2][i] * p.in[I_LK2][i];
            gq = fmaxf(gq, fabsf(p.in[I_QNG][i])); gk = fmaxf(gk, fabsf(p.in[I_KNG][i])); }
        float* lam = (float*)(c.ws + WS_LAM);
        lam[0] = __expf(s1) - __expf(s2) + LAM_INIT;
        lam[1] = 0.125f * 64.f * gq * gk;
    }
    int* stok = (int*)(c.ws + WS_SLOT_TOK); int* sasg = (int*)(c.ws + WS_SLOT_ASG); float* sgate = (float*)(c.ws + WS_SLOT_GATE);
    for (int idx = c.gtid; idx < NS_MAX; idx += c.gthreads) { stok[idx] = 0; sasg[idx] = -1; sgate[idx] = 0.f; }
    int* te = (int*)(c.ws + WS_TILE_E);
    for (int idx = c.gtid; idx < NS_MAX / 256; idx += c.gthreads) te[idx] = -1;
}

__device__ __forceinline__ void ph_h1(const Ctx& c, const Params& p) {
    const float* mod = (const float*)(c.ws + WS_MOD); bf16_t* H = (bf16_t*)(c.ws + WS_H);
    constexpr int R = 4;
    for (int t0 = c.gwave * R; t0 < T; t0 += c.gwaves * R) {
        const int b = t0 / SEQ;
        f32x4 v[R][4]; float sq[R];
#pragma unroll
        for (int j = 0; j < R; ++j) { const f32x4* xr = (const f32x4*)(p.in[I_X] + (size_t)(t0 + j) * DM) + c.lane;
#pragma unroll
            for (int q = 0; q < 4; ++q) v[j][q] = __builtin_nontemporal_load(xr + 64 * q); }
        const float* sh = mod + b * 6 * DM, * sc = sh + DM;
        f32x4 ca[4], cb[4];
#pragma unroll
        for (int q = 0; q < 4; ++q) { const int col = 4 * c.lane + 256 * q; ca[q] = *(const f32x4*)(p.in[I_N1G] + col) * (1.f + *(const f32x4*)(sc + col)); cb[q] = *(const f32x4*)(sh + col); }
#pragma unroll
        for (int j = 0; j < R; ++j) { float s_ = 0.f;
#pragma unroll
            for (int q = 0; q < 4; ++q) s_ += v[j][q].x * v[j][q].x + v[j][q].y * v[j][q].y + v[j][q].z * v[j][q].z + v[j][q].w * v[j][q].w;
            sq[j] = s_; }
#pragma unroll
        for (int o = 1; o < 64; o <<= 1) {
#pragma unroll
            for (int j = 0; j < R; ++j) sq[j] += __shfl_xor(sq[j], o); }
#pragma unroll
        for (int j = 0; j < R; ++j) { const float rstd = rsqrtf(sq[j] * (1.f / DM) + EPS);
#pragma unroll
            for (int q = 0; q < 4; ++q) { const int col = 4 * c.lane + 256 * q; const f32x4 o = (v[j][q] * rstd) * ca[q] + cb[q];
                u32x2 w; w.x = pk2(o.x, o.y); w.y = pk2(o.z, o.w); *(u32x2*)(H + (size_t)(t0 + j) * DM + col) = w;
                *(unsigned*)(c.ws + WS_H18 + (size_t)(t0 + j) * DM + col) = pk4_fp8(MIXA8_SCALE * o.x, MIXA8_SCALE * o.y, MIXA8_SCALE * o.z, MIXA8_SCALE * o.w); } }
    }
}

struct EpiWin {
    bf16_t* QK; bf16_t* V; bf16_t* AP;
    __device__ __forceinline__ void operator()(int row, int col, const f32x4& a, const f32x4&, int) const {
        u32x2 w; w.x = pk2(a[0], a[1]); w.y = pk2(a[2], a[3]);
        if (col < 1024) *(u32x2*)(QK + (size_t)row * 1024 + col) = w;
        else if (col < 1536) *(u32x2*)(V + (size_t)row * 512 + (col - 1024)) = w;
        else { const int cc = col - 1536, g = cc >> 4, ch = cc & 15, b = row / SEQ, l = row % SEQ;
            *(u32x2*)(AP + ((size_t)(g * (NB * NCHUNK) + b * NCHUNK + (l >> 4)) * APK + (l & 15) * 16 + ch)) = w; }
    }
};

__device__ __forceinline__ void ph_qkn(const Ctx& c, const Params& p) {
    bf16_t* QK = (bf16_t*)(c.ws + WS_QK);
    const float* ropec = (const float*)(c.ws + WS_ROPE); const float* ropes = ropec + SEQ * 32;
    const int l = c.lane;
    const float gq = p.in[I_QNG][l], gk = p.in[I_KNG][l];
    for (int t = c.gwave; t < T; t += c.gwaves) {
        const int pos = t % SEQ; const float cs = ropec[pos * 32 + (l & 31)], sn = ropes[pos * 32 + (l & 31)];
        bf16_t* r = QK + (size_t)t * 1024;
#pragma unroll 4
        for (int gi = 0; gi < 16; ++gi) {
            const float v = bf2f(r[gi * 64 + l]);
            const float rstd = rsqrtf(wave_sum(v * v) * (1.f / 64.f) + EPS);
            const float y = v * rstd * (gi < 8 ? gq : gk);
            const float o = __shfl_xor(y, 32);
            const float res = (l < 32) ? (y * cs - o * sn) : (o * sn + y * cs);
            r[gi * 64 + l] = f2bf(res);
        }
    }
}

__device__ __forceinline__ void ph_att_base(const Ctx& c, const Params& p) {
    const bf16_t* QK = (const bf16_t*)(c.ws + WS_QK); const bf16_t* V = (const bf16_t*)(c.ws + WS_V); float* AO = (float*)(c.ws + WS_ATTO);
    const float smax = ((const float*)(c.ws + WS_LAM))[1];
    const int nitem = NB * NH * 4 * (SEQ / 64);
    for (int it = c.gwave; it < nitem; it += c.gwaves) {
        const int qb = (SEQ / 64 - 1) - (it / (NB * NH * 4)), bhc = it % (NB * NH * 4), b = bhc / (NH * 4), h = (bhc >> 2) % NH, cc = (bhc >> 1) & 1, vh = bhc & 1;
        const int q = qb * 64 + c.lane; const size_t trow = (size_t)b * SEQ + q;
        float qv[64];
        { const bf16_t* qp = QK + trow * 1024 + h * 128 + cc * 64;
#pragma unroll
          for (int d = 0; d < 64; ++d) qv[d] = bf2f(qp[d]) * 0.125f; }
        float o[64];
#pragma unroll
        for (int d = 0; d < 64; ++d) o[d] = 0.f;
        float lsum = 0.f;
        const int jmax = qb * 64 + 63;
        for (int j = 0; j <= jmax; ++j) {
            const size_t krow = (size_t)b * SEQ + j;
            const u32x4* kp = (const u32x4*)(QK + krow * 1024 + 512 + h * 128 + cc * 64);
            float s = 0.f;
#pragma unroll
            for (int i = 0; i < 8; ++i) { const u32x4 kk = kp[i];
                s += qv[8 * i + 0] * __uint_as_float(kk.x << 16) + qv[8 * i + 1] * __uint_as_float(kk.x & 0xffff0000u)
                   + qv[8 * i + 2] * __uint_as_float(kk.y << 16) + qv[8 * i + 3] * __uint_as_float(kk.y & 0xffff0000u)
                   + qv[8 * i + 4] * __uint_as_float(kk.z << 16) + qv[8 * i + 5] * __uint_as_float(kk.z & 0xffff0000u)
                   + qv[8 * i + 6] * __uint_as_float(kk.w << 16) + qv[8 * i + 7] * __uint_as_float(kk.w & 0xffff0000u); }
            float pe = (j <= q) ? __expf(s - smax) : 0.f;
            lsum += pe;
            const u32x4* vp = (const u32x4*)(V + krow * 512 + h * 128 + vh * 64);
#pragma unroll
            for (int i = 0; i < 8; ++i) { const u32x4 vv = vp[i];
                o[8 * i + 0] += pe * __uint_as_float(vv.x << 16); o[8 * i + 1] += pe * __uint_as_float(vv.x & 0xffff0000u);
                o[8 * i + 2] += pe * __uint_as_float(vv.y << 16); o[8 * i + 3] += pe * __uint_as_float(vv.y & 0xffff0000u);
                o[8 * i + 4] += pe * __uint_as_float(vv.z << 16); o[8 * i + 5] += pe * __uint_as_float(vv.z & 0xffff0000u);
                o[8 * i + 6] += pe * __uint_as_float(vv.w << 16); o[8 * i + 7] += pe * __uint_as_float(vv.w & 0xffff0000u); }
        }
        const float rl = 1.f / lsum;
        float* op = AO + (trow * 8 + h * 2 + cc) * 128 + vh * 64;
#pragma unroll
        for (int d = 0; d < 64; d += 4) *(f32x4*)(op + d) = (f32x4){o[d] * rl, o[d + 1] * rl, o[d + 2] * rl, o[d + 3] * rl};
    }
}
__device__ __forceinline__ void ph_att_comb(const Ctx& c, const Params& p) {
    const float* AO = (const float*)(c.ws + WS_ATTO); bf16_t* MX = (bf16_t*)(c.ws + WS_MIXIN);
    const float lam = ((const float*)(c.ws + WS_LAM))[0];
    for (int it = c.gwave; it < T * NH; it += c.gwaves) {
        const int t = it >> 2, h = it & 3;
        const float* o1 = AO + ((size_t)t * 8 + h * 2) * 128, * o2 = o1 + 128;
        const float a = o1[c.lane] - lam * o2[c.lane], b = o1[64 + c.lane] - lam * o2[64 + c.lane];
        const float rstd = rsqrtf(wave_sum(a * a + b * b) * (1.f / 128.f) + EPS) * (1.f - LAM_INIT);
        MX[(size_t)t * 1024 + h * 128 + c.lane] = f2bf(a * rstd * p.in[I_SUBG][c.lane]);
        MX[(size_t)t * 1024 + h * 128 + 64 + c.lane] = f2bf(b * rstd * p.in[I_SUBG][64 + c.lane]);
    }
}

__device__ __forceinline__ void ph_ssm_base(const Ctx& c, const Params& p) {
    const bf16_t* AP = (const bf16_t*)(c.ws + WS_AP); bf16_t* Y = (bf16_t*)(c.ws + WS_Y);
    const float* sp = (const float*)(c.ws + WS_SSMP);
    const float* abr = sp, * abi = sp + SG * SP, * bbr = sp + 2 * SG * SP, * bbi = bbr + SG * SP * SC;
    for (int it = c.gwave; it < NB * SG; it += c.gwaves) {
        const int b = it / SG, g = it % SG, pp = c.lane;
        const float ar = abr[g * SP + pp], ai = abi[g * SP + pp];
        float br[16], bi[16], cr[16], ci[16];
#pragma unroll
        for (int ch = 0; ch < 16; ++ch) { br[ch] = bbr[(g * SP + pp) * SC + ch]; bi[ch] = bbi[(g * SP + pp) * SC + ch];
            cr[ch] = p.in[I_CRE][(g * SC + ch) * SP + pp]; ci[ch] = p.in[I_CIM][(g * SC + ch) * SP + pp]; }
        const float dsk = (pp < 16) ? p.in[I_SD][g * SC + pp] : 0.f;
        float sr = 0.f, si = 0.f;
        for (int l = 0; l < SEQ; ++l) {
            const bf16_t* up = AP + ((size_t)(g * (NB * NCHUNK) + b * NCHUNK + (l >> 4)) * APK + (l & 15) * 16);
            const u32x4 u0 = *(const u32x4*)up, u1 = *(const u32x4*)(up + 8);
            float u[16] = { __uint_as_float(u0.x << 16), __uint_as_float(u0.x & 0xffff0000u), __uint_as_float(u0.y << 16), __uint_as_float(u0.y & 0xffff0000u),
                            __uint_as_float(u0.z << 16), __uint_as_float(u0.z & 0xffff0000u), __uint_as_float(u0.w << 16), __uint_as_float(u0.w & 0xffff0000u),
                            __uint_as_float(u1.x << 16), __uint_as_float(u1.x & 0xffff0000u), __uint_as_float(u1.y << 16), __uint_as_float(u1.y & 0xffff0000u),
                            __uint_as_float(u1.z << 16), __uint_as_float(u1.z & 0xffff0000u), __uint_as_float(u1.w << 16), __uint_as_float(u1.w & 0xffff0000u) };
            float bur = 0.f, bui = 0.f;
#pragma unroll
            for (int ch = 0; ch < 16; ++ch) { bur += u[ch] * br[ch]; bui += u[ch] * bi[ch]; }
            const float nr = ar * sr - ai * si + bur, ni = ar * si + ai * sr + bui; sr = nr; si = ni;
            float mine = 0.f;
#pragma unroll
            for (int ch = 0; ch < 16; ++ch) { const float v = wave_sum(sr * cr[ch] - si * ci[ch]); if (pp == ch) mine = v + dsk * u[ch]; }
            if (pp < 16) Y[((size_t)b * SEQ + l) * 512 + g * 16 + pp] = f2bf(gelu_tanh(mine));
        }
    }
}

struct EpiGlu {
    const bf16_t* Y; bf16_t* MX; float* ss;
    __device__ __forceinline__ void operator()(int row, int col, const f32x4& a, const f32x4&, int) const {
        const u32x2 yv = *(const u32x2*)(Y + (size_t)row * 512 + col);
        const float y0 = __uint_as_float(yv.x << 16), y1 = __uint_as_float(yv.x & 0xffff0000u), y2 = __uint_as_float(yv.y << 16), y3 = __uint_as_float(yv.y & 0xffff0000u);
        const float v0 = y0 * sigmoidf(a[0]), v1 = y1 * sigmoidf(a[1]), v2 = y2 * sigmoidf(a[2]), v3 = y3 * sigmoidf(a[3]);
        u32x2 w; w.x = pk2(v0, v1); w.y = pk2(v2, v3); *(u32x2*)(MX + (size_t)row * 1024 + 512 + col) = w;
        float s = v0 * v0 + v1 * v1 + v2 * v2 + v3 * v3;
#pragma unroll
        for (int o = 1; o < 32; o <<= 1) s += __shfl_xor(s, o);
        if ((threadIdx.x & 31) == 0) atomicAdd(ss + row, s);
    }
};
__device__ __forceinline__ void ph_ssm_norm(const Ctx& c, const Params& p) {
    bf16_t* MX = (bf16_t*)(c.ws + WS_MIXIN); const float* ss = (const float*)(c.ws + WS_CTL + CTL_SS1);
    for (int t = c.gwave; t < T; t += c.gwaves) {
        const float rstd = rsqrtf(ss[t] * (1.f / 512.f) + EPS);
        bf16_t* r = MX + (size_t)t * 1024 + 512 + c.lane * 8; const float* g = p.in[I_SNG] + c.lane * 8;
        u32x4 w = *(u32x4*)r; unsigned* wp = (unsigned*)&w;
#pragma unroll
        for (int i = 0; i < 4; ++i) { const float a = __uint_as_float(wp[i] << 16) * rstd * g[2 * i], b = __uint_as_float(wp[i] & 0xffff0000u) * rstd * g[2 * i + 1]; wp[i] = pk2(a, b); }
        *(u32x4*)r = w;
    }
}
__device__ __forceinline__ void ph_ssm_norm2(const Ctx& c, const Params& p) {
    bf16_t* MX = (bf16_t*)(c.ws + WS_MIXIN); const float* ss = (const float*)(c.ws + WS_SS1P);
    constexpr int R = 8;
    float g[8];
#pragma unroll
    for (int i = 0; i < 8; ++i) g[i] = p.in[I_SNG][c.lane * 8 + i];
    for (int t0 = c.gwave * R; t0 < T; t0 += c.gwaves * R) {
        u32x4 w[R]; f32x4 s0[R], s1[R];
#pragma unroll
        for (int j = 0; j < R; ++j) { const size_t t = (size_t)(t0 + j); w[j] = *(const u32x4*)(MX + t * 1024 + 512 + c.lane * 8); s0[j] = *(const f32x4*)(ss + t * 8); s1[j] = *(const f32x4*)(ss + t * 8 + 4); }
#pragma unroll
        for (int j = 0; j < R; ++j) {
            const float tot = ((s0[j].x + s0[j].y) + (s0[j].z + s0[j].w)) + ((s1[j].x + s1[j].y) + (s1[j].z + s1[j].w));
            const float rstd = rsqrtf(tot * (1.f / 512.f) + EPS);
            unsigned* wp = (unsigned*)&w[j];
#pragma unroll
            for (int i = 0; i < 4; ++i) { const float a = __uint_as_float(wp[i] << 16) * rstd * g[2 * i], b = __uint_as_float(wp[i] & 0xffff0000u) * rstd * g[2 * i + 1]; wp[i] = pk2(a, b); }
            *(u32x4*)(MX + (size_t)(t0 + j) * 1024 + 512 + c.lane * 8) = w[j];
        }
    }
}
struct EpiWout {
    const float* x; const float* mod; float* out; float* ss;
    __device__ __forceinline__ void operator()(int row, int col, const f32x4& a, const f32x4&, int) const {
        const int b = row / SEQ; const f32x4 xv = *(const f32x4*)(x + (size_t)row * DM + col), g1 = *(const f32x4*)(mod + b * 6 * DM + 2 * DM + col);
        const f32x4 o = {xv.x + g1.x * a[0], xv.y + g1.y * a[1], xv.z + g1.z * a[2], xv.w + g1.w * a[3]};
        *(f32x4*)(out + (size_t)row * DM + col) = o;
        float s = o.x * o.x + o.y * o.y + o.z * o.z + o.w * o.w;
#pragma unroll
        for (int of = 1; of < 32; of <<= 1) s += __shfl_xor(s, of);
        if ((threadIdx.x & 31) == 0) atomicAdd(ss + row, s);
    }
};
__device__ __forceinline__ void ph_h2(const Ctx& c, const Params& p) {
    const float* mod = (const float*)(c.ws + WS_MOD); bf16_t* H = (bf16_t*)(c.ws + WS_H);
    const float* ss = (const float*)(c.ws + WS_CTL + CTL_SS2);
    for (int t = c.gwave; t < T; t += c.gwaves) {
        const int b = t / SEQ; const f32x4* xr = (const f32x4*)(p.out + (size_t)t * DM) + c.lane;
        const float rstd = rsqrtf(ss[t] * (1.f / DM) + EPS);
        const float* sh = mod + b * 6 * DM + 3 * DM, * sc = sh + DM;
#pragma unroll
        for (int j = 0; j < 4; ++j) { const int col = 4 * c.lane + 256 * j; const f32x4 v = xr[64 * j];
            const f32x4 g = *(const f32x4*)(p.in[I_N2G] + col), s1 = *(const f32x4*)(sc + col), h1 = *(const f32x4*)(sh + col);
            const f32x4 o = (v * rstd * g) * (1.f + s1) + h1;
            u32x2 w; w.x = pk2(o.x, o.y); w.y = pk2(o.z, o.w); *(u32x2*)(H + (size_t)t * DM + col) = w; }
    }
}
__device__ __forceinline__ void ph_h2_2(const Ctx& c, const Params& p) {
    const float* mod = (const float*)(c.ws + WS_MOD); bf16_t* H = (bf16_t*)(c.ws + WS_H);
    const float* ss = (const float*)(c.ws + WS_SS2P);
    constexpr int R = 4;
    for (int t0 = c.gwave * R; t0 < T; t0 += c.gwaves * R) {
        const int b = t0 / SEQ;
        f32x4 v[R][4], sv[R][4];
#pragma unroll
        for (int j = 0; j < R; ++j) { const f32x4* xr = (const f32x4*)(p.out + (size_t)(t0 + j) * DM) + c.lane;
#pragma unroll
            for (int q = 0; q < 4; ++q) { v[j][q] = xr[64 * q]; sv[j][q] = *(const f32x4*)(ss + (size_t)(t0 + j) * 16 + 4 * q); } }
        const float* sh = mod + b * 6 * DM + 3 * DM, * sc = sh + DM;
        f32x4 ca[4], cb[4];
#pragma unroll
        for (int q = 0; q < 4; ++q) { const int col = 4 * c.lane + 256 * q; ca[q] = *(const f32x4*)(p.in[I_N2G] + col) * (1.f + *(const f32x4*)(sc + col)); cb[q] = *(const f32x4*)(sh + col); }
#pragma unroll
        for (int j = 0; j < R; ++j) {
            float tot = 0.f;
#pragma unroll
            for (int q = 0; q < 4; ++q) tot += (sv[j][q].x + sv[j][q].y) + (sv[j][q].z + sv[j][q].w);
            const float rstd = rsqrtf(tot * (1.f / DM) + EPS);
#pragma unroll
            for (int q = 0; q < 4; ++q) { const int col = 4 * c.lane + 256 * q; const f32x4 o = (v[j][q] * rstd) * ca[q] + cb[q];
                u32x2 w; w.x = pk2(o.x, o.y); w.y = pk2(o.z, o.w); *(u32x2*)(H + (size_t)(t0 + j) * DM + col) = w; }
        }
    }
}
__device__ __forceinline__ void ph_h2_3(const Ctx& c, const Params& p) {
    const float* mod = (const float*)(c.ws + WS_MOD); unsigned char* H8 = c.ws + WS_H8;
    const float* ss = (const float*)(c.ws + WS_SS2P); const bf16_t* X1 = (const bf16_t*)(c.ws + WS_X1B);
    constexpr int R = 4;
    for (int t0 = c.gwave * R; t0 < T; t0 += c.gwaves * R) {
        const int b = t0 / SEQ;
        u32x4 v[R][2]; f32x4 sv[R][4];
#pragma unroll
        for (int j = 0; j < R; ++j) {
#pragma unroll
            for (int q = 0; q < 2; ++q) v[j][q] = *(const u32x4*)(X1 + (size_t)(t0 + j) * DM + 8 * c.lane + 512 * q);
#pragma unroll
            for (int q = 0; q < 4; ++q) sv[j][q] = *(const f32x4*)(ss + (size_t)(t0 + j) * 16 + 4 * q); }
        const float* sh = mod + b * 6 * DM + 3 * DM, * sc = sh + DM;
        f32x4 ca[4], cb[4];
#pragma unroll
        for (int q = 0; q < 4; ++q) { const int col = 8 * c.lane + 512 * (q >> 1) + 4 * (q & 1); ca[q] = *(const f32x4*)(p.in[I_N2G] + col) * (1.f + *(const f32x4*)(sc + col)); cb[q] = *(const f32x4*)(sh + col); }
#pragma unroll
        for (int j = 0; j < R; ++j) {
            float tot = 0.f;
#pragma unroll
            for (int q = 0; q < 4; ++q) tot += (sv[j][q].x + sv[j][q].y) + (sv[j][q].z + sv[j][q].w);
            const float rstd = rsqrtf(tot * (1.f / DM) + EPS);
#pragma unroll
            for (int q = 0; q < 2; ++q) { const int col = 8 * c.lane + 512 * q; const u32x4 xv = v[j][q];
                const f32x4 x0 = {__uint_as_float(xv.x << 16), __uint_as_float(xv.x & 0xffff0000u), __uint_as_float(xv.y << 16), __uint_as_float(xv.y & 0xffff0000u)};
                const f32x4 x1 = {__uint_as_float(xv.z << 16), __uint_as_float(xv.z & 0xffff0000u), __uint_as_float(xv.w << 16), __uint_as_float(xv.w & 0xffff0000u)};
                const f32x4 o0 = (x0 * rstd) * ca[2 * q] + cb[2 * q], o1 = (x1 * rstd) * ca[2 * q + 1] + cb[2 * q + 1];
                u32x2 w8; w8.x = pk4_fp8(o0.x, o0.y, o0.z, o0.w); w8.y = pk4_fp8(o1.x, o1.y, o1.z, o1.w); *(u32x2*)(H8 + (size_t)(t0 + j) * DM + col) = w8; }
        }
    }
}
struct EpiLogits { float* L; __device__ __forceinline__ void operator()(int row, int col, const f32x4& a, const f32x4&, int) const { *(f32x4*)(L + (size_t)row * 256 + col) = (f32x4){a[0], a[1], a[2], a[3]}; } };
struct EpiSwiglu { bf16_t* O; int ldo;
    __device__ __forceinline__ void operator()(int row, int col, const f32x4& a, const f32x4& b, int) const {
        u32x2 w; w.x = pk2(siluf(a[0]) * b[0], siluf(a[1]) * b[1]); w.y = pk2(siluf(a[2]) * b[2], siluf(a[3]) * b[3]); *(u32x2*)(O + (size_t)row * ldo + col) = w; } };

__device__ __forceinline__ void ph_route(const Ctx& c, const Params& p) {
    const float* L = (const float*)(c.ws + WS_LOGITS);
    int* eidx = (int*)(c.ws + WS_EIDX); float* gw = (float*)(c.ws + WS_GATEW); unsigned* counts = (unsigned*)(c.ws + WS_CTL) + CW_COUNTS;
    const int l = c.lane; const float NEG = -__builtin_inff();
    float rb[4];
#pragma unroll
    for (int r = 0; r < 4; ++r) rb[r] = p.in[I_RB][l + 64 * r];
    for (int t = c.gwave; t < T; t += c.gwaves) {
        float s[4], sb[4];
#pragma unroll
        for (int r = 0; r < 4; ++r) { s[r] = sigmoidf(L[(size_t)t * 256 + l + 64 * r]); sb[r] = s[r] + rb[r]; }
        float gs[4];
#pragma unroll
        for (int r = 0; r < 4; ++r) {
            float m1 = sb[r]; int i1 = l;
#pragma unroll
            for (int o = 1; o < 32; o <<= 1) { const float om = __shfl_xor(m1, o); const int oi = __shfl_xor(i1, o); if (om > m1 || (om == m1 && oi < i1)) { m1 = om; i1 = oi; } }
            float m2 = (l == i1) ? NEG : sb[r];
#pragma unroll
            for (int o = 1; o < 32; o <<= 1) m2 = fmaxf(m2, __shfl_xor(m2, o));
            gs[r] = m1 + m2;
        }
        float gsc[8];
#pragma unroll
        for (int r = 0; r < 4; ++r) { gsc[2 * r] = __shfl(gs[r], 0); gsc[2 * r + 1] = __shfl(gs[r], 32); }
        unsigned gmask = 0;
#pragma unroll
        for (int a = 0; a < 8; ++a) { int rank = 0;
#pragma unroll
            for (int b2 = 0; b2 < 8; ++b2) rank += (gsc[b2] > gsc[a] || (gsc[b2] == gsc[a] && b2 < a)) ? 1 : 0;
            if (rank < TOPG) gmask |= 1u << a; }
        float mv[4];
#pragma unroll
        for (int r = 0; r < 4; ++r) mv[r] = ((gmask >> (2 * r + (l >> 5))) & 1u) ? sb[r] : NEG;
        float wsel = 0.f; int esel = -1; float wsum = 0.f;
#pragma unroll
        for (int k = 0; k < TOPK; ++k) {
            float bm = mv[0]; int bi = l;
#pragma unroll
            for (int r = 1; r < 4; ++r) if (mv[r] > bm) { bm = mv[r]; bi = l + 64 * r; }
#pragma unroll
            for (int o = 1; o < 64; o <<= 1) { const float om = __shfl_xor(bm, o); const int oi = __shfl_xor(bi, o); if (om > bm || (om == bm && oi < bi)) { bm = om; bi = oi; } }
            float sv = 0.f;
#pragma unroll
            for (int r = 0; r < 4; ++r) if (bi == l + 64 * r) { sv = s[r]; mv[r] = NEG; }
            sv = __shfl(sv, bi & 63);
            wsum += sv;
            if (l == k) { wsel = sv; esel = bi; }
        }
        if (l < TOPK) { eidx[t * 8 + l] = esel; gw[t * 8 + l] = wsel / wsum * ROUTED_SCALE; atomicAdd(counts + esel, 1u); }
    }
}
__device__ __forceinline__ void ph_slot(const Ctx& c, const Params& p) {
    const unsigned* counts = (const unsigned*)(c.ws + WS_CTL) + CW_COUNTS; unsigned* cursor = (unsigned*)(c.ws + WS_CTL) + CW_CURSOR;
    int* ps = (int*)c.lds;
    if (c.tid == 0) { int acc = 0; for (int e = 0; e < NE; ++e) { ps[e] = acc; acc += ((int)counts[e] + 255) / 256 * 256; } ps[NE] = acc; }
    __syncthreads();
    const int* eidx = (const int*)(c.ws + WS_EIDX); const float* gw = (const float*)(c.ws + WS_GATEW);
    int* stok = (int*)(c.ws + WS_SLOT_TOK); int* sasg = (int*)(c.ws + WS_SLOT_ASG); float* sgate = (float*)(c.ws + WS_SLOT_GATE);
    for (int a = c.gtid; a < T * TOPK; a += c.gthreads) {
        const int e = eidx[a]; const unsigned pos = atomicAdd(cursor + e, 1u); const int slot = ps[e] + (int)pos;
        stok[slot] = a >> 3; sasg[slot] = a; sgate[slot] = gw[a];
    }
    if (c.bid == 0) {
        int* te = (int*)(c.ws + WS_TILE_E); int* padst = (int*)(c.ws + WS_PADST);
        for (int e = c.tid; e <= NE; e += 512) padst[e] = ps[e];
        for (int e = c.tid; e < NE; e += 512) for (int tl = ps[e] / 256; tl < ps[e + 1] / 256; ++tl) te[tl] = e;
        if (c.tid == 0) ((unsigned*)(c.ws + WS_CTL))[CW_NTILES] = (unsigned)(ps[NE] / 256);
    }
}
struct EpiE2 { const int* sasg; const float* sgate; bf16_t* YA;
    __device__ __forceinline__ void operator()(int row, int col, const f32x4& a, const f32x4&, int) const {
        const int asg = sasg[row]; if (asg < 0) return; const float g = sgate[row];
        u32x2 w; w.x = pk2(g * a[0], g * a[1]); w.y = pk2(g * a[2], g * a[3]); *(u32x2*)(YA + (size_t)asg * DM + col) = w; } };
struct EpiSD { const float* mod; float* out;
    __device__ __forceinline__ void operator()(int row, int col, const f32x4& a, const f32x4&, int) const {
        const int b = row / SEQ; const f32x4 g2 = *(const f32x4*)(mod + b * 6 * DM + 5 * DM + col); f32x4* o = (f32x4*)(out + (size_t)row * DM + col);
        f32x4 v = *o; v.x += g2.x * a[0]; v.y += g2.y * a[1]; v.z += g2.z * a[2]; v.w += g2.w * a[3]; *o = v; } };
__device__ __forceinline__ void ph_combine(const Ctx& c, const Params& p) {
    const float* mod = (const float*)(c.ws + WS_MOD); const bf16_t* YA = (const bf16_t*)(c.ws + WS_YA); float* out = p.out;
    for (int idx = c.gtid; idx < T * (DM / 8); idx += c.gthreads) {
        const int t = idx >> 7, col = (idx & 127) * 8, b = t / SEQ;
        float s[8] = {0.f, 0.f, 0.f, 0.f, 0.f, 0.f, 0.f, 0.f};
#pragma unroll
        for (int k = 0; k < 8; ++k) { const u32x4 w = *(const u32x4*)(YA + ((size_t)t * 8 + k) * DM + col); const unsigned* wp = (const unsigned*)&w;
#pragma unroll
            for (int i = 0; i < 4; ++i) { s[2 * i] += __uint_as_float(wp[i] << 16); s[2 * i + 1] += __uint_as_float(wp[i] & 0xffff0000u); } }
        const float* g2 = mod + b * 6 * DM + 5 * DM + col; float* o = out + (size_t)t * DM + col;
        f32x4 o0 = *(f32x4*)o, o1 = *(f32x4*)(o + 4);
        o0.x += g2[0] * s[0]; o0.y += g2[1] * s[1]; o0.z += g2[2] * s[2]; o0.w += g2[3] * s[3];
        o1.x += g2[4] * s[4]; o1.y += g2[5] * s[5]; o1.z += g2[6] * s[6]; o1.w += g2[7] * s[7];
        *(f32x4*)o = o0; *(f32x4*)(o + 4) = o1;
    }
}


#define GAS __attribute__((address_space(1)))
#define LAS __attribute__((address_space(3)))
#define XB_TMO      128
#define XB_XCNT(j)  (256  + 64 * (j))
#define XB_XSUB(j)  (1280 + 64 * (j))
#define XB_XGEN(j)  (2304 + 64 * (j))
#define XB_TOP      3328
#define XB_TOPGEN   3392
#define XCD_BAR_WORDS 3456
#define XB_SPIN_CAP (1u << 18)

__device__ __forceinline__ unsigned xb_ld(unsigned* p)              { return __hip_atomic_load(p, __ATOMIC_RELAXED, __HIP_MEMORY_SCOPE_AGENT); }
__device__ __forceinline__ unsigned xb_add(unsigned* p, unsigned v) { return __hip_atomic_fetch_add(p, v, __ATOMIC_RELAXED, __HIP_MEMORY_SCOPE_AGENT); }
__device__ __forceinline__ unsigned xb_xcc_id() { return (unsigned)__builtin_amdgcn_s_getreg((3 << 11) | 20) & 0xFu; }
#define XB_SPIN(cond, bar) do { unsigned _sp = 0; while (cond) { __builtin_amdgcn_s_sleep(1); \
    if ((++_sp & 255u) == 0u) { if (xb_ld(&(bar)[XB_TMO])) break; if (_sp > XB_SPIN_CAP) { atomicAdd(&(bar)[XB_TMO], 1u); break; } } } } while (0)

struct XcdBarrier {
    unsigned* bar; unsigned x;
    volatile LAS unsigned* st;
};

__device__ __forceinline__ XcdBarrier xcd_barrier_post(unsigned* bar, volatile LAS unsigned* st) {
    XcdBarrier b; b.bar = bar; b.x = xb_xcc_id(); b.st = st;
    if (threadIdx.x == 0) (void)xb_add(&bar[XB_XCNT(b.x)], 1u);
    return b;
}
__device__ __forceinline__ void xcd_barrier_complete(unsigned* bar, unsigned x, unsigned& nloc, unsigned& nx) {
    const unsigned G = gridDim.x * gridDim.y * gridDim.z;
    unsigned sum, cnt, mine, sp = 0u;
    for (;;) {
        sum = 0u; cnt = 0u; mine = 0u;
#pragma unroll
        for (unsigned j = 0; j < 16; ++j) { const unsigned c = xb_ld(&bar[XB_XCNT(j)]); sum += c; cnt += (c > 0u) ? 1u : 0u; mine = (j == x) ? c : mine; }
        if (sum == G) break;
        __builtin_amdgcn_s_sleep(1);
        if ((++sp & 255u) == 0u) { if (xb_ld(&bar[XB_TMO])) break; if (sp > XB_SPIN_CAP) { atomicAdd(&bar[XB_TMO], 1u); break; } }
    }
    nloc = mine > 0u ? mine : 1u; nx = cnt > 0u ? cnt : 1u;
}

__device__ __forceinline__ void xcd_barrier(const XcdBarrier& b) {
    asm volatile("s_waitcnt vmcnt(0)" ::: "memory");
    __syncthreads();
    if (threadIdx.x == 0) {
        unsigned* bar = b.bar;
        __builtin_amdgcn_s_waitcnt(0);
        unsigned nloc = b.st[0], nx = b.st[1];
        if (nloc == 0u) { xcd_barrier_complete(bar, b.x, nloc, nx); b.st[0] = nloc; b.st[1] = nx; }
        const unsigned old = xb_add(&bar[XB_XSUB(b.x)], 1u);
        const unsigned gen = old / nloc;
        if (old + 1u == (gen + 1u) * nloc) {
            __builtin_amdgcn_fence(__ATOMIC_RELEASE, "agent");
            asm volatile("s_waitcnt vmcnt(0)" ::: "memory");
            const unsigned og = xb_add(&bar[XB_TOP], 1u);
            const unsigned tg = og / nx;
            if (og + 1u == (tg + 1u) * nx) xb_add(&bar[XB_TOPGEN], 1u);
            else XB_SPIN(xb_ld(&bar[XB_TOPGEN]) == tg, bar);
            __builtin_amdgcn_fence(__ATOMIC_ACQUIRE, "agent");
            xb_add(&bar[XB_XGEN(b.x)], 1u);
            asm volatile("s_waitcnt vmcnt(0)" ::: "memory");
        } else {
            XB_SPIN(xb_ld(&bar[XB_XGEN(b.x)]) == gen, bar);
            __builtin_amdgcn_fence(__ATOMIC_ACQUIRE, "agent");
            asm volatile("s_waitcnt vmcnt(0)" ::: "memory");
        }
    }
    __syncthreads();
}

namespace pg8 {
#define PG8_LAS __attribute__((address_space(3)))
typedef short bf16x8 __attribute__((ext_vector_type(8)));
typedef int v4i __attribute__((ext_vector_type(4)));
typedef int v8i __attribute__((ext_vector_type(8)));
constexpr int BM = 256, BK = 64, HALF = 128, HTB = HALF * BK * 2  , STAGE_BYTES = 8 * HTB;

__host__ __device__ __forceinline__ int lds_byte(int r, int c) { const int st = (r >> 4) * 2 + (c >> 5), rr = r & 15, cc = c & 31, ob = rr * 64 + cc * 2; return st * 1024 + (ob ^ (((ob >> 9) & 1) << 5)); }
__host__ __device__ __forceinline__ void stage_rc(int b, int& R, int& C) { const int st = b / 1024, sb = b % 1024, swz = sb ^ (((sb >> 9) & 1) << 5); R = (st >> 1) * 16 + swz / 64; C = (st & 1) * 32 + (swz % 64) / 2; }
__host__ __device__ __forceinline__ int perm32(int rho) { const int n = rho >> 4, i = rho & 15; return 8 * (i >> 2) + 4 * n + (i & 3); }

struct Unit { int pm, pn, pb; int nv = 256; };
struct Gemm { const bf16_t* A; const bf16_t* Bt; int K, lda; const int* rowidx; unsigned scale_b = 0x7F7F7F7Fu, scale_a = 0x7F7F7F7Fu; const float* mid_ss = nullptr; unsigned scale_a2 = 0x7F7F7F7Fu; };

__device__ __forceinline__ unsigned cvt_pk_bf16(float lo, float hi) { unsigned r; asm volatile("v_cvt_pk_bf16_f32 %0, %1, %2" : "=v"(r) : "v"(lo), "v"(hi)); return r; }

template <class Epi, class Sched, bool GATHER, bool ALIGN_EPI, bool FP8 = false, int FIXED_NT = 0, bool MID = false, bool P16 = false>
__device__ __forceinline__ void gemm_phase(PG8_LAS unsigned char* lds, const Gemm g, const Sched& S, const Epi& E) {
    int tid_ = threadIdx.x; asm volatile("" : "+v"(tid_));
    const int tid = tid_, wid = __builtin_amdgcn_readfirstlane(tid >> 6), lane = tid & 63, wr = wid >> 2, wc = wid & 3, fr = lane & 15, fq = lane >> 4;
    int K_ = g.K; asm volatile("" : "+s"(K_));
    const int K = K_, nt = K / BK, lda = g.lda;
    unsigned voffB[2], oc[2][2], on[2][2];
#pragma unroll
    for (int i = 0; i < 2; ++i) { int R, C; stage_rc(tid * 16 + i * 8192, R, C); const int Rb = Epi::PERM ? ((R & ~31) + perm32(R & 31)) : R;
        voffB[i] = (unsigned)(Rb * K + C) * 2u;
        if constexpr (P16) { const int rho_ = R & 31, n_ = rho_ >> 4, i_ = rho_ & 15, base_ = 2 * (R & ~31) + 16 * (i_ >> 2) + 4 * n_ + (i_ & 3);
            voffB[i] = (unsigned)(base_ * K + C) * 2u; }
        oc[0][i] = (unsigned)(R * lda + C) * 2u; oc[1][i] = (unsigned)((R + HALF) * lda + C) * 2u; on[0][i] = oc[0][i]; on[1][i] = oc[1][i]; }
    const size_t kstep = (size_t)(BK * 2);
    const size_t hstep = (size_t)HALF * K * 2;
    const size_t tstepB = 2 * hstep, tstepA = (size_t)BM * lda * 2;
    const size_t hstep1 = P16 ? (size_t)8 * K * 2 : hstep;
    const unsigned ldsw = (unsigned)wid * 1024u;
    const int aoff = lds_byte(wr * 64 + fr, fq * 8), boff = lds_byte(wc * 32 + fr, fq * 8);
#define PG8_SA(b, h) (((b) * 2 + (h)) * HTB)
#define PG8_SB(b, h) ((4 + (b) * 2 + (h)) * HTB)
#define PG8_STAGE(bufoff, gbase, voff) do { _Pragma("unroll") for (int _i = 0; _i < 2; ++_i) \
        __builtin_amdgcn_global_load_lds((const unsigned*)((const char*)(gbase) + (voff)[_i]), (PG8_LAS unsigned*)(lds + (bufoff) + ldsw + _i * 8192), 16, 0, 0); } while (0)
#define PG8_LDA(dst, b, h) do { if constexpr (FP8) { _Pragma("unroll") for (int m = 0; m < 4; ++m) { const v4i lo_ = *(const PG8_LAS v4i*)(lds + PG8_SA(b, h) + aoff + m * 2048), hi_ = *(const PG8_LAS v4i*)(lds + PG8_SA(b, h) + aoff + m * 2048 + 1024); \
            dst##8[m] = __builtin_shufflevector(lo_, hi_, 0, 1, 2, 3, 4, 5, 6, 7); } } \
        else { _Pragma("unroll") for (int m = 0; m < 4; ++m) _Pragma("unroll") for (int k = 0; k < 2; ++k) dst[m][k] = *(const PG8_LAS bf16x8*)(lds + PG8_SA(b, h) + aoff + m * 2048 + k * 1024); } } while (0)
#define PG8_LDB(dst, b, h) do { if constexpr (FP8) { _Pragma("unroll") for (int n = 0; n < 2; ++n) { const v4i lo_ = *(const PG8_LAS v4i*)(lds + PG8_SB(b, h) + boff + n * 2048), hi_ = *(const PG8_LAS v4i*)(lds + PG8_SB(b, h) + boff + n * 2048 + 1024); \
            dst##8[n] = __builtin_shufflevector(lo_, hi_, 0, 1, 2, 3, 4, 5, 6, 7); } } \
        else { _Pragma("unroll") for (int n = 0; n < 2; ++n) _Pragma("unroll") for (int k = 0; k < 2; ++k) dst[n][k] = *(const PG8_LAS bf16x8*)(lds + PG8_SB(b, h) + boff + n * 2048 + k * 1024); } } while (0)
#define PG8_MMA(ai, bj, At, Bt) do { __builtin_amdgcn_s_setprio(1); \
        if constexpr (FP8) {   \
            _Pragma("unroll") for (int m = 0; m < 4; ++m) _Pragma("unroll") for (int n = 0; n < 2; ++n) { \
                acc[ai][bj][m][n] = __builtin_amdgcn_mfma_scale_f32_16x16x128_f8f6f4(Bt##8[n], At##8[m], acc[ai][bj][m][n], 0, 0, 0, (int)g.scale_b, 0, (int)sa_); } \
        } else { \
            _Pragma("unroll") for (int m = 0; m < 4; ++m) _Pragma("unroll") for (int n = 0; n < 2; ++n) _Pragma("unroll") for (int k = 0; k < 2; ++k) \
                acc[ai][bj][m][n] = __builtin_amdgcn_mfma_f32_16x16x32_bf16(Bt[n][k], At[m][k], acc[ai][bj][m][n], 0, 0, 0); } \
        __builtin_amdgcn_s_setprio(0); } while (0)
#define PG8_WAIT_V(n) asm volatile("s_waitcnt vmcnt(" #n ")" ::: "memory")
#define PG8_WAIT_V8S() do { if (FIXED_NT == 2 || (Epi::NSTORE > 0 && fresh)) asm volatile("s_waitcnt vmcnt(%0)" :: "i"(8 + Epi::NSTORE) : "memory"); else asm volatile("s_waitcnt vmcnt(8)" ::: "memory"); } while (0)
#define PG8_WAIT_L(n) asm volatile("s_waitcnt lgkmcnt(" #n ")" ::: "memory")
#define PG8_BAR __builtin_amdgcn_s_barrier()
#define PG8_SCHED __builtin_amdgcn_sched_barrier(0)
#define PG8_GIDX(dst, unit) do { _Pragma("unroll") for (int _i = 0; _i < 2; ++_i) { int R_, C_; stage_rc(tid * 16 + _i * 8192, R_, C_); \
        const int r0_ = g.rowidx ? g.rowidx[(unit).pm * BM + R_] : (unit).pm * BM + R_, r1_ = g.rowidx ? g.rowidx[(unit).pm * BM + HALF + R_] : (unit).pm * BM + HALF + R_; \
        dst[0][_i] = (unsigned)(r0_ * lda + C_) * 2u; dst[1][_i] = (unsigned)(r1_ * lda + C_) * 2u; } } while (0)
    Unit cur, nxt; int ui = 0;
    if (!S.next(0, cur)) return;
    f32x4 acc[2][2][4][2];
#pragma unroll
    for (int a = 0; a < 2; ++a)
#pragma unroll
        for (int b = 0; b < 2; ++b)
#pragma unroll
            for (int m = 0; m < 4; ++m)
#pragma unroll
                for (int n = 0; n < 2; ++n) acc[a][b][m][n] = (f32x4){0.f, 0.f, 0.f, 0.f};
    bf16x8 At[4][2], B0[2][2], B1[2][2]; v8i At8[4], B08[2], B18[2];
    PG8_LAS float* mtab = (PG8_LAS float*)(lds + 131072);
    if constexpr (MID) { Unit u_;
        for (int i_ = 0; i_ < 16 && S.next(i_, u_); ++i_) { if (tid < BM) { const size_t row_ = (size_t)u_.pm * BM + tid; const f32x4 s0_ = *(const f32x4*)(g.mid_ss + row_ * 8), s1_ = *(const f32x4*)(g.mid_ss + row_ * 8 + 4);
                mtab[i_ * BM + tid] = (((s0_.x + s0_.y) + (s0_.z + s0_.w)) + ((s1_.x + s1_.y) + (s1_.z + s1_.w))) * (1.f / 512.f) + EPS; } }
        __syncthreads(); }
#define PG8_MIDSCALE(FN) do { _Pragma("unroll") for (int a_ = 0; a_ < 2; ++a_) _Pragma("unroll") for (int m_ = 0; m_ < 4; ++m_) { const float f_ = FN(mtab[ui * BM + a_ * HALF + wr * 64 + m_ * 16 + fr]); \
        _Pragma("unroll") for (int b_ = 0; b_ < 2; ++b_) _Pragma("unroll") for (int n_ = 0; n_ < 2; ++n_) acc[a_][b_][m_][n_] *= f_; } } while (0)
    if constexpr (GATHER) { PG8_GIDX(oc, cur); }
    const char* cA = GATHER ? (const char*)g.A : (const char*)g.A + (size_t)cur.pm * tstepA; const char* cB = (const char*)g.Bt + (size_t)cur.pb * tstepB;
    PG8_STAGE(PG8_SB(0, 0), cB, voffB); PG8_STAGE(PG8_SB(0, 1), cB + hstep1, voffB); PG8_STAGE(PG8_SA(0, 0), cA, oc[0]); PG8_STAGE(PG8_SA(0, 1), cA, oc[1]);
    if (wr == 1) PG8_BAR;
    PG8_WAIT_V(2); PG8_BAR;
    PG8_STAGE(PG8_SB(1, 0), cB + kstep, voffB); PG8_STAGE(PG8_SA(1, 0), cA + kstep, oc[0]); PG8_STAGE(PG8_SB(1, 1), cB + hstep1 + kstep, voffB);
    PG8_WAIT_V(6); PG8_BAR;
    if constexpr (FIXED_NT == 2) { PG8_WAIT_V(0); PG8_BAR; }
    bool fresh = false;
    unsigned sa_ = g.scale_a;
    for (;;) {
        const bool has_next = S.next(ui + 1, nxt);
        if constexpr (GATHER) { if (has_next) { PG8_GIDX(on, nxt); } }
        const char* nA = has_next ? (GATHER ? (const char*)g.A : (const char*)g.A + (size_t)nxt.pm * tstepA) : cA; const char* nB = has_next ? (const char*)g.Bt + (size_t)nxt.pb * tstepB : cB;
#pragma unroll 1
        for (int t = 0; t < nt; t += 2) {
            if constexpr (MID) { if (t == (nt >> 1)) PG8_MIDSCALE(__builtin_amdgcn_sqrtf); sa_ = t >= (nt >> 1) ? g.scale_a2 : g.scale_a; }
            const bool last = (t == nt - 2);
            const char* a1 = cA + (size_t)(t + 1) * kstep;
            const char* a2 = last ? nA : cA + (size_t)(t + 2) * kstep; const char* b2 = last ? nB : cB + (size_t)(t + 2) * kstep;
            const char* a3 = a2 + kstep; const char* b3 = b2 + kstep;
            PG8_LDB(B0, 0, 0); PG8_LDB(B1, 0, 1); PG8_SCHED; PG8_LDA(At, 0, 0); PG8_STAGE(PG8_SA(1, 1), a1, oc[1]);
            if constexpr (GATHER) { if (last && has_next) { oc[0][0] = on[0][0]; oc[0][1] = on[0][1]; oc[1][0] = on[1][0]; oc[1][1] = on[1][1]; } }
            PG8_WAIT_V8S(); PG8_WAIT_L(0); PG8_BAR; PG8_MMA(0, 0, At, B0); PG8_MMA(0, 1, At, B1); PG8_BAR; PG8_SCHED;
            PG8_LDA(At, 0, 1); PG8_STAGE(PG8_SB(0, 0), b2, voffB); PG8_STAGE(PG8_SB(0, 1), b2 + hstep1, voffB); PG8_STAGE(PG8_SA(0, 0), a2, oc[0]);
            PG8_WAIT_V8S(); fresh = false; PG8_WAIT_L(0); PG8_BAR; PG8_MMA(1, 0, At, B0); PG8_MMA(1, 1, At, B1); PG8_BAR; PG8_SCHED;
            PG8_LDB(B0, 1, 0); PG8_LDB(B1, 1, 1); PG8_SCHED; PG8_LDA(At, 1, 0); PG8_STAGE(PG8_SA(0, 1), a2, oc[1]);
            PG8_WAIT_V(8); PG8_WAIT_L(0); PG8_BAR; PG8_MMA(0, 0, At, B0); PG8_MMA(0, 1, At, B1); PG8_BAR; PG8_SCHED;
            PG8_LDA(At, 1, 1); PG8_STAGE(PG8_SB(1, 0), b3, voffB); PG8_STAGE(PG8_SB(1, 1), b3 + hstep1, voffB); PG8_STAGE(PG8_SA(1, 0), a3, oc[0]);
            PG8_WAIT_V(8); PG8_WAIT_L(0); PG8_BAR; PG8_MMA(1, 0, At, B0); PG8_MMA(1, 1, At, B1); PG8_BAR; PG8_SCHED;
        }
        if constexpr (ALIGN_EPI) { if (wr == 0) PG8_BAR; }
        if constexpr (MID) PG8_MIDSCALE(__builtin_amdgcn_rsqf);
        E(acc, cur, wr, wc, fr, fq);
        if (!has_next) break;
#pragma unroll
        for (int a = 0; a < 2; ++a)
#pragma unroll
            for (int b = 0; b < 2; ++b)
#pragma unroll
                for (int m = 0; m < 4; ++m)
#pragma unroll
                    for (int n = 0; n < 2; ++n) acc[a][b][m][n] = (f32x4){0.f, 0.f, 0.f, 0.f};
        cur = nxt; cA = nA; cB = nB; ++ui; fresh = true;
        if constexpr (ALIGN_EPI) { if (wr == 1) PG8_BAR; }
    }
    PG8_WAIT_V(0);
    if constexpr (!ALIGN_EPI) { if (wr == 0) PG8_BAR; }
    PG8_BAR;
#undef PG8_SA
#undef PG8_SB
#undef PG8_STAGE
#undef PG8_LDA
#undef PG8_LDB
#undef PG8_MMA
#undef PG8_WAIT_V
#undef PG8_WAIT_V8S
#undef PG8_WAIT_L
#undef PG8_BAR
#undef PG8_SCHED
#undef PG8_GIDX
#undef PG8_MIDSCALE
}

struct DenseOrder {
    int nM, nN, nwg, G, c;
    __device__ __forceinline__ void init(int M, int N, int G_, int c_) { nM = M / BM; nN = N / BM; nwg = nM * nN; G = G_; c = c_; }
    __device__ __forceinline__ bool next(int i, Unit& u) const {
        const long L = (long)i * G + c; if (L >= nwg) return false;
        int wgid = (int)L; { const int q = nwg / 8, r = nwg % 8, xcd = wgid % 8, off = wgid / 8; wgid = (xcd < r ? xcd * (q + 1) : r * (q + 1) + (xcd - r) * q) + off; }
        const int nig = 8 * nN, gid = wgid / nig, fm = gid * 8, gsz = (nM - fm) < 8 ? (nM - fm) : 8;
        u.pm = fm + ((wgid % nig) % gsz); u.pn = (wgid % nig) / gsz; u.pb = u.pn; return true;
    }
};
struct GroupedOrder {
    const int* tile_e; int ntiles, NT, G, vcu;
    __device__ __forceinline__ bool next(int i, Unit& u) const {
        const int L = i * G + vcu; if (L >= ntiles * NT) return false;
        const int mt = L / NT, nn = L - mt * NT; u.pm = mt; u.pn = nn; u.pb = tile_e[mt] * NT + nn; return true;
    }
};

#define EPI_ROWS_BEGIN const int row0 = u.pm * BM + wr * 64 + fr; _Pragma("unroll") for (int ai = 0; ai < 2; ++ai) _Pragma("unroll") for (int m = 0; m < 4; ++m) { const int row = row0 + ai * HALF + m * 16;
#define EPI_ROWS_END }
struct EpiWinF {
    static constexpr bool PERM = true; static constexpr int NSTORE = 16;
    bf16_t* QK; bf16_t* V; bf16_t* AP;
    __device__ __forceinline__ void operator()(const f32x4 (&acc)[2][2][4][2], const Unit& u, int wr, int wc, int fr, int fq) const {
        const int colt = u.pn * BM + wc * 32 + 8 * fq;
        EPI_ROWS_BEGIN
#pragma unroll
            for (int bj = 0; bj < 2; ++bj) { const f32x4 v0 = acc[ai][bj][m][0], v1 = acc[ai][bj][m][1]; const int col = colt + bj * HALF;
                u32x4 w; w.x = cvt_pk_bf16(v0[0], v0[1]); w.y = cvt_pk_bf16(v0[2], v0[3]); w.z = cvt_pk_bf16(v1[0], v1[1]); w.w = cvt_pk_bf16(v1[2], v1[3]);
                bf16_t* dst;
                if (u.pn < 4) dst = QK + (size_t)row * 1024 + col;
                else if (u.pn < 6) dst = V + (size_t)row * 512 + (col - 1024);
                else { const int cc = col - 1536, gg = cc >> 4, ch = cc & 15, b = row / SEQ, l = row % SEQ;
                    dst = AP + ((size_t)(gg * (NB * NCHUNK) + b * NCHUNK + (l >> 4)) * APK + (l & 15) * 16 + ch); }
                *(u32x4*)dst = w; }
        EPI_ROWS_END
    }
};
struct EpiWinF8 : EpiWinF { static constexpr int NSTORE = 0; };
struct EpiGluF {
    static constexpr bool PERM = true; static constexpr int NSTORE = 0;
    const bf16_t* Y; bf16_t* MX; float* ss;
    __device__ __forceinline__ void operator()(const f32x4 (&acc)[2][2][4][2], const Unit& u, int wr, int wc, int fr, int fq) const {
        const int colt = u.pn * BM + wc * 32 + 8 * fq;
        EPI_ROWS_BEGIN
            float s = 0.f;
#pragma unroll
            for (int bj = 0; bj < 2; ++bj) { const int col = colt + bj * HALF; const u32x4 yv = *(const u32x4*)(Y + (size_t)row * 512 + col);
                const f32x4 a0 = acc[ai][bj][m][0], a1 = acc[ai][bj][m][1];
                float v[8];
                v[0] = __uint_as_float(yv.x << 16) * sigmoidf(a0[0]); v[1] = __uint_as_float(yv.x & 0xffff0000u) * sigmoidf(a0[1]);
                v[2] = __uint_as_float(yv.y << 16) * sigmoidf(a0[2]); v[3] = __uint_as_float(yv.y & 0xffff0000u) * sigmoidf(a0[3]);
                v[4] = __uint_as_float(yv.z << 16) * sigmoidf(a1[0]); v[5] = __uint_as_float(yv.z & 0xffff0000u) * sigmoidf(a1[1]);
                v[6] = __uint_as_float(yv.w << 16) * sigmoidf(a1[2]); v[7] = __uint_as_float(yv.w & 0xffff0000u) * sigmoidf(a1[3]);
#pragma unroll
                for (int i = 0; i < 8; ++i) s += v[i] * v[i];
                u32x2 w; w.x = pk4_fp8(MIXA8_SCALE * v[0], MIXA8_SCALE * v[1], MIXA8_SCALE * v[2], MIXA8_SCALE * v[3]); w.y = pk4_fp8(MIXA8_SCALE * v[4], MIXA8_SCALE * v[5], MIXA8_SCALE * v[6], MIXA8_SCALE * v[7]);
                *(u32x2*)((unsigned char*)MX + (size_t)row * 1024 + 512 + col) = w; }
            s += __shfl_xor(s, 16); s += __shfl_xor(s, 32);
            if (fq == 0) ss[(size_t)row * 8 + u.pn * 4 + wc] = s;
        EPI_ROWS_END
    }
};
struct EpiWoutF {
    static constexpr bool PERM = true; static constexpr int NSTORE = 0;
    const float* x; const float* mod; bf16_t* x1b; float* ss;
    __device__ __forceinline__ void operator()(const f32x4 (&acc)[2][2][4][2], const Unit& u, int wr, int wc, int fr, int fq) const {
        const int colt = u.pn * BM + wc * 32 + 8 * fq;
        EPI_ROWS_BEGIN
            const int b = row / SEQ; float s = 0.f;
#pragma unroll
            for (int bj = 0; bj < 2; ++bj) { const int col = colt + bj * HALF;
                const f32x4 xa = *(const f32x4*)(x + (size_t)row * DM + col), xb = *(const f32x4*)(x + (size_t)row * DM + col + 4);
                const f32x4 ga = *(const f32x4*)(mod + b * 6 * DM + 2 * DM + col), gb = *(const f32x4*)(mod + b * 6 * DM + 2 * DM + col + 4);
                const f32x4 oa = xa + ga * acc[ai][bj][m][0], ob = xb + gb * acc[ai][bj][m][1];
                u32x4 w; w.x = cvt_pk_bf16(oa[0], oa[1]); w.y = cvt_pk_bf16(oa[2], oa[3]); w.z = cvt_pk_bf16(ob[0], ob[1]); w.w = cvt_pk_bf16(ob[2], ob[3]);
                *(u32x4*)(x1b + (size_t)row * DM + col) = w;
                s += oa[0] * oa[0] + oa[1] * oa[1] + oa[2] * oa[2] + oa[3] * oa[3] + ob[0] * ob[0] + ob[1] * ob[1] + ob[2] * ob[2] + ob[3] * ob[3]; }
            s += __shfl_xor(s, 16); s += __shfl_xor(s, 32);
            if (fq == 0) ss[(size_t)row * 16 + u.pn * 4 + wc] = s;
        EPI_ROWS_END
    }
};
struct EpiRouterX {
    static constexpr bool PERM = true; static constexpr int NSTORE = 0;
    float* L; const float* bias; const float* ss2;
    __device__ __forceinline__ void operator()(const f32x4 (&acc)[2][2][4][2], const Unit& u, int wr, int wc, int fr, int fq) const {
        const int c8 = wc * 32 + 8 * fq; const int b = (u.pm * BM) / SEQ;
        f32x4 bz[2][2];
#pragma unroll
        for (int bj = 0; bj < 2; ++bj) { const float* bp = bias + (size_t)b * 1024 + bj * HALF + c8;
            bz[bj][0] = (*(const f32x4*)bp + *(const f32x4*)(bp + 256)) + (*(const f32x4*)(bp + 512) + *(const f32x4*)(bp + 768));
            bz[bj][1] = (*(const f32x4*)(bp + 4) + *(const f32x4*)(bp + 260)) + (*(const f32x4*)(bp + 516) + *(const f32x4*)(bp + 772)); }
        EPI_ROWS_BEGIN
            const f32x4 s0 = *(const f32x4*)(ss2 + (size_t)row * 16), s1 = *(const f32x4*)(ss2 + (size_t)row * 16 + 4), s2 = *(const f32x4*)(ss2 + (size_t)row * 16 + 8), s3 = *(const f32x4*)(ss2 + (size_t)row * 16 + 12);
            const float tot = (((s0.x + s0.y) + (s0.z + s0.w)) + ((s1.x + s1.y) + (s1.z + s1.w))) + (((s2.x + s2.y) + (s2.z + s2.w)) + ((s3.x + s3.y) + (s3.z + s3.w)));
            const float rs = rsqrtf(tot * (1.f / DM) + EPS);
#pragma unroll
            for (int bj = 0; bj < 2; ++bj) { float* d = L + (size_t)row * 256 + bj * HALF + c8; *(f32x4*)d = acc[ai][bj][m][0] * rs + bz[bj][0]; *(f32x4*)(d + 4) = acc[ai][bj][m][1] * rs + bz[bj][1]; }
        EPI_ROWS_END
    }
};
struct EpiRSF {
    static constexpr bool PERM = true; static constexpr int NSTORE = 0;
    float* L; bf16_t* AS;
    __device__ __forceinline__ void operator()(const f32x4 (&acc)[2][2][4][2], const Unit& u, int wr, int wc, int fr, int fq) const {
        const int c8 = wc * 32 + 8 * fq;
        EPI_ROWS_BEGIN
            if (u.pn == 0) {
#pragma unroll
                for (int bj = 0; bj < 2; ++bj) { float* d = L + (size_t)row * 256 + bj * HALF + c8; *(f32x4*)d = acc[ai][bj][m][0]; *(f32x4*)(d + 4) = acc[ai][bj][m][1]; }
            } else {
                const f32x4 g0 = acc[ai][0][m][0], g1 = acc[ai][0][m][1], u0 = acc[ai][1][m][0], u1 = acc[ai][1][m][1];
                u32x4 w; w.x = cvt_pk_bf16(siluf(g0[0]) * u0[0], siluf(g0[1]) * u0[1]); w.y = cvt_pk_bf16(siluf(g0[2]) * u0[2], siluf(g0[3]) * u0[3]);
                w.z = cvt_pk_bf16(siluf(g1[0]) * u1[0], siluf(g1[1]) * u1[1]); w.w = cvt_pk_bf16(siluf(g1[2]) * u1[2], siluf(g1[3]) * u1[3]);
                *(u32x4*)(AS + (size_t)row * 256 + (u.pn - 1) * 128 + c8) = w;
            }
        EPI_ROWS_END
    }
};
struct EpiSDF {
    static constexpr bool PERM = false; static constexpr int NSTORE = 0;
    const float* mod; float* out;
    __device__ __forceinline__ void operator()(const f32x4 (&acc)[2][2][4][2], const Unit& u, int wr, int wc, int fr, int fq) const {
        const int colt = u.pn * BM + wc * 32 + 4 * fq;
        EPI_ROWS_BEGIN
            const int b = row / SEQ;
#pragma unroll
            for (int bj = 0; bj < 2; ++bj)
#pragma unroll
                for (int n = 0; n < 2; ++n) { const int col = colt + bj * HALF + n * 16; const f32x4 g2 = *(const f32x4*)(mod + b * 6 * DM + 5 * DM + col);
                    f32x4* o = (f32x4*)(out + (size_t)row * DM + col); *o = *o + g2 * acc[ai][bj][m][n]; }
        EPI_ROWS_END
    }
};
struct EpiE1F {
    static constexpr bool PERM = true; static constexpr int NSTORE = 0;
    bf16_t* AE;
    __device__ __forceinline__ void operator()(const f32x4 (&acc)[2][2][4][2], const Unit& u, int wr, int wc, int fr, int fq) const {
        const int c8 = u.pn * 128 + wc * 32 + 8 * fq;
        EPI_ROWS_BEGIN
            const f32x4 g0 = acc[ai][0][m][0], g1 = acc[ai][0][m][1], u0 = acc[ai][1][m][0], u1 = acc[ai][1][m][1];
            u32x4 w; w.x = cvt_pk_bf16(siluf(g0[0]) * u0[0], siluf(g0[1]) * u0[1]); w.y = cvt_pk_bf16(siluf(g0[2]) * u0[2], siluf(g0[3]) * u0[3]);
            w.z = cvt_pk_bf16(siluf(g1[0]) * u1[0], siluf(g1[1]) * u1[1]); w.w = cvt_pk_bf16(siluf(g1[2]) * u1[2], siluf(g1[3]) * u1[3]);
            *(u32x4*)(AE + (size_t)row * 256 + c8) = w;
        EPI_ROWS_END
    }
};
struct EpiE2F {
    static constexpr bool PERM = true; static constexpr int NSTORE = 0;
    const int* sasg; const float* sgate; bf16_t* YA;
    __device__ __forceinline__ void operator()(const f32x4 (&acc)[2][2][4][2], const Unit& u, int wr, int wc, int fr, int fq) const {
        const int colt = u.pn * BM + wc * 32 + 8 * fq;
        EPI_ROWS_BEGIN
            const int asg = sasg[row]; const float gt = sgate[row];
            if (asg >= 0) {
#pragma unroll
                for (int bj = 0; bj < 2; ++bj) { const f32x4 v0 = acc[ai][bj][m][0] * gt, v1 = acc[ai][bj][m][1] * gt;
                    u32x4 w; w.x = cvt_pk_bf16(v0[0], v0[1]); w.y = cvt_pk_bf16(v0[2], v0[3]); w.z = cvt_pk_bf16(v1[0], v1[1]); w.w = cvt_pk_bf16(v1[2], v1[3]);
                    *(u32x4*)(YA + (size_t)asg * DM + colt + bj * HALF) = w; }
            }
        EPI_ROWS_END
    }
};
struct EpiSsmA {
    static constexpr bool PERM = false; static constexpr int NSTORE = 0;
    float* DS;
    __device__ __forceinline__ void operator()(const f32x4 (&acc)[2][2][4][2], const Unit& u, int wr, int wc, int fr, int fq) const {
        EPI_ROWS_BEGIN
#pragma unroll
            for (int n = 0; n < 2; ++n) *(f32x4*)(DS + (size_t)row * 128 + wc * 32 + n * 16 + 4 * fq) = acc[ai][0][m][n];
        EPI_ROWS_END
    }
};
struct EpiSsmC {
    static constexpr bool PERM = true; static constexpr int NSTORE = 0;
    bf16_t* Y;
    __device__ __forceinline__ void operator()(const f32x4 (&acc)[2][2][4][2], const Unit& u, int wr, int wc, int fr, int fq) const {
        EPI_ROWS_BEGIN
            const int gg = row >> 11, rem = row & 2047, b = rem >> 8, chunk = rem & 255; const size_t t0 = (size_t)b * SEQ + chunk * 16;
#pragma unroll
            for (int bj = 0; bj < 2; ++bj) { const int c0 = bj * HALF + wc * 32 + 8 * fq, jp = c0 >> 4, co0 = c0 & 15;
                const f32x4 v0 = acc[ai][bj][m][0], v1 = acc[ai][bj][m][1];
                u32x4 w; w.x = cvt_pk_bf16(gelu_tanh(v0[0]), gelu_tanh(v0[1])); w.y = cvt_pk_bf16(gelu_tanh(v0[2]), gelu_tanh(v0[3]));
                w.z = cvt_pk_bf16(gelu_tanh(v1[0]), gelu_tanh(v1[1])); w.w = cvt_pk_bf16(gelu_tanh(v1[2]), gelu_tanh(v1[3]));
                *(u32x4*)(Y + (t0 + jp) * 512 + gg * 16 + co0) = w; }
        EPI_ROWS_END
    }
};
struct EpiSDC {
    static constexpr bool PERM = true; static constexpr int NSTORE = 0;
    const float* mod; float* out; const bf16_t* YA;
    __device__ __forceinline__ void operator()(const f32x4 (&acc)[2][2][4][2], const Unit& u, int wr, int wc, int fr, int fq) const {
        const int colt = u.pn * BM + wc * 32 + 8 * fq;
        EPI_ROWS_BEGIN
            const int b = row / SEQ;
#pragma unroll
            for (int bj = 0; bj < 2; ++bj) { const int col = colt + bj * HALF;
                f32x4 s0 = acc[ai][bj][m][0], s1 = acc[ai][bj][m][1];
#pragma unroll
                for (int k = 0; k < 8; ++k) { const u32x4 w = *(const u32x4*)(YA + ((size_t)row * 8 + k) * DM + col);
                    s0[0] += __uint_as_float(w.x << 16); s0[1] += __uint_as_float(w.x & 0xffff0000u); s0[2] += __uint_as_float(w.y << 16); s0[3] += __uint_as_float(w.y & 0xffff0000u);
                    s1[0] += __uint_as_float(w.z << 16); s1[1] += __uint_as_float(w.z & 0xffff0000u); s1[2] += __uint_as_float(w.w << 16); s1[3] += __uint_as_float(w.w & 0xffff0000u); }
                const float* g2 = mod + b * 6 * DM + 5 * DM + col; float* o = out + (size_t)row * DM + col;
                *(f32x4*)o = *(const f32x4*)o + *(const f32x4*)g2 * s0; *(f32x4*)(o + 4) = *(const f32x4*)(o + 4) + *(const f32x4*)(g2 + 4) * s1; }
        EPI_ROWS_END
    }
};
struct EpiSDY {
    static constexpr bool PERM = true; static constexpr int NSTORE = 16;
    bf16_t* Y;
    __device__ __forceinline__ void operator()(const f32x4 (&acc)[2][2][4][2], const Unit& u, int wr, int wc, int fr, int fq) const {
        const int colt = u.pn * BM + wc * 32 + 8 * fq;
        EPI_ROWS_BEGIN
#pragma unroll
            for (int bj = 0; bj < 2; ++bj) { const f32x4 v0 = acc[ai][bj][m][0], v1 = acc[ai][bj][m][1];
                u32x4 w; w.x = cvt_pk_bf16(v0[0], v0[1]); w.y = cvt_pk_bf16(v0[2], v0[3]); w.z = cvt_pk_bf16(v1[0], v1[1]); w.w = cvt_pk_bf16(v1[2], v1[3]);
                *(u32x4*)(Y + (size_t)row * DM + colt + bj * HALF) = w; }
        EPI_ROWS_END
    }
};
struct EpiNone { static constexpr bool PERM = true; static constexpr int NSTORE = 0; float* sink;
    __device__ __forceinline__ void operator()(const f32x4 (&acc)[2][2][4][2], const Unit& u, int wr, int wc, int fr, int fq) const {
        float s = 0.f;
#pragma unroll
        for (int ai = 0; ai < 2; ++ai)
#pragma unroll
            for (int bj = 0; bj < 2; ++bj)
#pragma unroll
                for (int m = 0; m < 4; ++m)
#pragma unroll
                    for (int n = 0; n < 2; ++n) s += acc[ai][bj][m][n][0] + acc[ai][bj][m][n][1] + acc[ai][bj][m][n][2] + acc[ai][bj][m][n][3];
        if (s == 1234567.875f) sink[threadIdx.x] = s; } };
struct EpiDense { static constexpr bool PERM = true; static constexpr int NSTORE = 0; bf16_t* Y;
    __device__ __forceinline__ void operator()(const f32x4 (&acc)[2][2][4][2], const Unit& u, int wr, int wc, int fr, int fq) const {
        const int colt = u.pn * BM + wc * 32 + 8 * fq;
        EPI_ROWS_BEGIN
            if (row < T * 8) {
#pragma unroll
            for (int bj = 0; bj < 2; ++bj) { const f32x4 v0 = acc[ai][bj][m][0], v1 = acc[ai][bj][m][1];
                u32x4 w; w.x = cvt_pk_bf16(v0[0], v0[1]); w.y = cvt_pk_bf16(v0[2], v0[3]); w.z = cvt_pk_bf16(v1[0], v1[1]); w.w = cvt_pk_bf16(v1[2], v1[3]);
                *(u32x4*)(Y + (size_t)row * DM + colt + bj * HALF) = w; } }
        EPI_ROWS_END
    } };
struct ProbeOrder { int nunits, G, vcu;
    __device__ __forceinline__ bool next(int i, Unit& u) const { const int L = i * G + vcu; if (L >= nunits) return false; u.pm = vcu & 7; u.pn = 0; u.pb = vcu & 3; return true; } };
struct EpiE2S {
    static constexpr bool PERM = true; static constexpr int NSTORE = 16;
    const int* sasg; const float* sgate; bf16_t* YS;
    __device__ __forceinline__ void operator()(const f32x4 (&acc)[2][2][4][2], const Unit& u, int wr, int wc, int fr, int fq) const {
        const int colt = u.pn * BM + wc * 32 + 8 * fq; const int row0 = u.pm * BM + wr * 64 + fr;
        float gt[2][4];
#pragma unroll
        for (int ai = 0; ai < 2; ++ai)
#pragma unroll
            for (int m = 0; m < 4; ++m) gt[ai][m] = sgate[row0 + ai * HALF + m * 16];
        asm volatile("s_waitcnt vmcnt(0)" : "+v"(gt[0][0]), "+v"(gt[0][1]), "+v"(gt[0][2]), "+v"(gt[0][3]), "+v"(gt[1][0]), "+v"(gt[1][1]), "+v"(gt[1][2]), "+v"(gt[1][3]) :: "memory");
#pragma unroll
        for (int ai = 0; ai < 2; ++ai)
#pragma unroll
            for (int m = 0; m < 4; ++m) { const int row = row0 + ai * HALF + m * 16;
#pragma unroll
                for (int bj = 0; bj < 2; ++bj) { const f32x4 v0 = acc[ai][bj][m][0] * gt[ai][m], v1 = acc[ai][bj][m][1] * gt[ai][m];
                    u32x4 w; w.x = cvt_pk_bf16(v0[0], v0[1]); w.y = cvt_pk_bf16(v0[2], v0[3]); w.z = cvt_pk_bf16(v1[0], v1[1]); w.w = cvt_pk_bf16(v1[2], v1[3]);
                    *(u32x4*)(YS + (size_t)row * DM + colt + bj * HALF) = w; } }
    }
};
struct EpiE1F8 {
    static constexpr bool PERM = true; static constexpr int NSTORE = 0;
    unsigned char* AE;
    __device__ __forceinline__ void operator()(const f32x4 (&acc)[2][2][4][2], const Unit& u, int wr, int wc, int fr, int fq) const {
        const int c8 = u.pn * 128 + wc * 32 + 8 * fq;
        EPI_ROWS_BEGIN
            const f32x4 g0 = acc[ai][0][m][0], g1 = acc[ai][0][m][1], u0 = acc[ai][1][m][0], u1 = acc[ai][1][m][1];
            u32x2 w; w.x = pk4_fp8(ACT8_SCALE * siluf(g0[0]) * u0[0], ACT8_SCALE * siluf(g0[1]) * u0[1], ACT8_SCALE * siluf(g0[2]) * u0[2], ACT8_SCALE * siluf(g0[3]) * u0[3]);
            w.y = pk4_fp8(ACT8_SCALE * siluf(g1[0]) * u1[0], ACT8_SCALE * siluf(g1[1]) * u1[1], ACT8_SCALE * siluf(g1[2]) * u1[2], ACT8_SCALE * siluf(g1[3]) * u1[3]);
            *(u32x2*)(AE + (size_t)row * 256 + c8) = w;
        EPI_ROWS_END
    }
};
struct EpiE2S8 {
    static constexpr bool PERM = true; static constexpr int NSTORE = 16;
    const float* sgate; unsigned char* YS;
    __device__ __forceinline__ void operator()(const f32x4 (&acc)[2][2][4][2], const Unit& u, int wr, int wc, int fr, int fq) const {
        const int colt = u.pn * BM + wc * 32 + 8 * fq; const int row0 = u.pm * BM + wr * 64 + fr;
        float gt[2][4];
#pragma unroll
        for (int ai = 0; ai < 2; ++ai)
#pragma unroll
            for (int m = 0; m < 4; ++m) gt[ai][m] = sgate[row0 + ai * HALF + m * 16] * Y8_SCALE;
        asm volatile("s_waitcnt vmcnt(0)" : "+v"(gt[0][0]), "+v"(gt[0][1]), "+v"(gt[0][2]), "+v"(gt[0][3]), "+v"(gt[1][0]), "+v"(gt[1][1]), "+v"(gt[1][2]), "+v"(gt[1][3]) :: "memory");
#pragma unroll
        for (int ai = 0; ai < 2; ++ai)
#pragma unroll
            for (int m = 0; m < 4; ++m) { const int row = row0 + ai * HALF + m * 16;
#pragma unroll
                for (int bj = 0; bj < 2; ++bj) { const f32x4 v0 = acc[ai][bj][m][0] * gt[ai][m], v1 = acc[ai][bj][m][1] * gt[ai][m];
                    u32x2 w; w.x = pk4_fp8(v0[0], v0[1], v0[2], v0[3]); w.y = pk4_fp8(v1[0], v1[1], v1[2], v1[3]);
                    *(u32x2*)(YS + (size_t)row * DM + colt + bj * HALF) = w; } }
    }
};
struct EpiE2S8b {
    static constexpr bool PERM = true; static constexpr int NSTORE = 0;
    const float* sgate; unsigned char* YS;
    __device__ __forceinline__ void operator()(const f32x4 (&acc)[2][2][4][2], const Unit& u, int wr, int wc, int fr, int fq) const {
        const int colt = u.pn * BM + wc * 32 + 8 * fq;
        EPI_ROWS_BEGIN
            const float gt = sgate[row] * Y8_SCALE;
#pragma unroll
            for (int bj = 0; bj < 2; ++bj) { const f32x4 v0 = acc[ai][bj][m][0] * gt, v1 = acc[ai][bj][m][1] * gt;
                u32x2 w; w.x = pk4_fp8(v0[0], v0[1], v0[2], v0[3]); w.y = pk4_fp8(v1[0], v1[1], v1[2], v1[3]);
                *(u32x2*)(YS + (size_t)row * DM + colt + bj * HALF) = w; }
        EPI_ROWS_END
    }
};
struct EpiE1G8 {
    static constexpr bool PERM = true; static constexpr int NSTORE = 0;
    const float* sgate; unsigned char* AE;
    __device__ __forceinline__ void operator()(const f32x4 (&acc)[2][2][4][2], const Unit& u, int wr, int wc, int fr, int fq) const {
        const int c8 = u.pn * 128 + wc * 32 + 8 * fq;
        EPI_ROWS_BEGIN
            const float gs = sgate[row] * ACT8_SCALE;
            const f32x4 g0 = acc[ai][0][m][0], g1 = acc[ai][0][m][1], u0 = acc[ai][1][m][0], u1 = acc[ai][1][m][1];
            u32x2 w; w.x = pk4_fp8(gs * siluf(g0[0]) * u0[0], gs * siluf(g0[1]) * u0[1], gs * siluf(g0[2]) * u0[2], gs * siluf(g0[3]) * u0[3]);
            w.y = pk4_fp8(gs * siluf(g1[0]) * u1[0], gs * siluf(g1[1]) * u1[1], gs * siluf(g1[2]) * u1[2], gs * siluf(g1[3]) * u1[3]);
            *(u32x2*)(AE + (size_t)row * 256 + c8) = w;
        EPI_ROWS_END
    }
};
struct EpiE2P8 {
    static constexpr bool PERM = true; static constexpr int NSTORE = 16;
    unsigned char* YS; unsigned char* dump;
    __device__ __forceinline__ void operator()(const f32x4 (&acc)[2][2][4][2], const Unit& u, int wr, int wc, int fr, int fq) const {
        const int colt = u.pn * BM + wc * 32 + 8 * fq;
        unsigned char* ptr = YS + (size_t)(u.pm * BM + wr * 64 + fr) * DM + colt;
        int rin = wr * 64 + fr;
#pragma unroll
        for (int ai = 0; ai < 2; ++ai) {
#pragma unroll
            for (int m = 0; m < 4; ++m) {
#pragma unroll
                for (int bj = 0; bj < 2; ++bj) { const f32x4 v0 = acc[ai][bj][m][0], v1 = acc[ai][bj][m][1];
                    u32x2 w; w.x = pk4_fp8(v0[0], v0[1], v0[2], v0[3]); w.y = pk4_fp8(v1[0], v1[1], v1[2], v1[3]);
                    *(u32x2*)((rin < u.nv ? ptr : dump) + bj * HALF) = w; }
                ptr += 16 * DM; rin += 16; asm volatile("" : "+v"(ptr)); __builtin_amdgcn_sched_barrier(0); }
            ptr += (HALF - 64) * DM; rin += HALF - 64; }
    }
};
struct EpiSDY8 {
    static constexpr bool PERM = true; static constexpr int NSTORE = 8;
    unsigned char* Y;
    __device__ __forceinline__ void operator()(const f32x4 (&acc)[2][2][4][2], const Unit& u, int wr, int wc, int fr, int fq) const {
        const int colt = u.pn * BM + wc * 64 + 16 * fq;
        EPI_ROWS_BEGIN
            const f32x4 a0 = acc[ai][0][m][0], a1 = acc[ai][0][m][1], b0 = acc[ai][1][m][0], b1 = acc[ai][1][m][1];
            u32x4 w; w.x = pk4_fp8(a0[0], a0[1], a0[2], a0[3]); w.y = pk4_fp8(a1[0], a1[1], a1[2], a1[3]); w.z = pk4_fp8(b0[0], b0[1], b0[2], b0[3]); w.w = pk4_fp8(b1[0], b1[1], b1[2], b1[3]);
            *(u32x4*)(Y + (size_t)row * DM + colt) = w;
        EPI_ROWS_END
    }
};
struct EpiE2P16 {
    static constexpr bool PERM = true; static constexpr int NSTORE = 8;
    unsigned char* YS; unsigned char* dump;
    __device__ __forceinline__ void operator()(const f32x4 (&acc)[2][2][4][2], const Unit& u, int wr, int wc, int fr, int fq) const {
        const int colt = u.pn * BM + wc * 64 + 16 * fq;
        unsigned char* ptr = YS + (size_t)(u.pm * BM + wr * 64 + fr) * DM + colt;
        int rin = wr * 64 + fr;
#pragma unroll
        for (int ai = 0; ai < 2; ++ai) {
#pragma unroll
            for (int m = 0; m < 4; ++m) { const f32x4 a0 = acc[ai][0][m][0], a1 = acc[ai][0][m][1], b0 = acc[ai][1][m][0], b1 = acc[ai][1][m][1];
                u32x4 w; w.x = pk4_fp8(a0[0], a0[1], a0[2], a0[3]); w.y = pk4_fp8(a1[0], a1[1], a1[2], a1[3]); w.z = pk4_fp8(b0[0], b0[1], b0[2], b0[3]); w.w = pk4_fp8(b1[0], b1[1], b1[2], b1[3]);
                *(u32x4*)(rin < u.nv ? ptr : dump) = w;
                ptr += 16 * DM; rin += 16; asm volatile("" : "+v"(ptr)); __builtin_amdgcn_sched_barrier(0); }
            ptr += (HALF - 64) * DM; rin += HALF - 64; }
    }
};
struct GroupedOrderL {
    const PG8_LAS int* le; int ntiles, NT, G, vcu;
    __device__ __forceinline__ void fill(const int* tile_e, PG8_LAS int* dst) { le = dst; const int tot = ntiles * NT;
        for (int i = threadIdx.x; i * G + vcu < tot; i += blockDim.x) dst[i] = tile_e[(i * G + vcu) / NT];
        __syncthreads(); }
    __device__ __forceinline__ bool next(int i, Unit& u) const {
        const int L = i * G + vcu; if (L >= ntiles * NT) return false;
        const int mt = L / NT, nn = L - mt * NT; const int pk = le[i]; u.pm = mt; u.pn = nn; u.pb = (pk & 255) * NT + nn; u.nv = (pk >> 8) + 1; return true;
    }
};
struct DenseOrderOff {
    DenseOrder d; int pn_off;
    __device__ __forceinline__ bool next(int i, Unit& u) const { if (!d.next(i, u)) return false; u.pn += pn_off; return true; }
};
struct HalfOrder {
    int n_units, NT, G2, c2, pn0, pbsh = -1;
    __device__ __forceinline__ bool next(int i, Unit& u) const { const int L = i * G2 + c2; if (L >= n_units) return false;
        const int mt = NT == 2 ? (L >> 1) : L, nn = NT == 2 ? (L & 1) : 0; u.pm = mt; u.pn = pn0 + nn; u.pb = pbsh >= 0 ? (mt >> pbsh) : nn; return true; }
};
struct SsmOrder {
    int G, vcu;
    __device__ __forceinline__ bool next(int i, Unit& u) const { const int L = i * G + vcu; if (L >= 256) return false; u.pm = L; u.pn = 0; u.pb = L >> 3; return true; }
};
}

__device__ __forceinline__ void transpose_item(const float* W, int K, int N, bf16_t* WT, int kb, int nb, int rowbase, float* scr, int lane, const float* kscale = nullptr, int kscale0 = 0, const float* kscale2 = nullptr) {
    const int k0 = 64 * kb, n0 = 32 * nb;
#pragma unroll 8
    for (int i = 0; i < 32; ++i) { const int kk = 2 * i + (lane >> 5); scr[kk * 33 + (lane & 31)] = __builtin_nontemporal_load(W + (size_t)(k0 + kk) * N + n0 + (lane & 31)) * ((kscale && k0 + kk >= kscale0) ? kscale[k0 + kk - kscale0] * (kscale2 ? 1.f + kscale2[k0 + kk - kscale0] : 1.f) : 1.f); }
    asm volatile("s_waitcnt lgkmcnt(0)" ::: "memory");
    const int cch = lane & 7;
#pragma unroll
    for (int j = 0; j < 4; ++j) { const int n = (lane >> 3) + 8 * j; const float* s = scr + (8 * cch) * 33 + n;
        u32x4 o; o.x = pk2(s[0 * 33], s[1 * 33]); o.y = pk2(s[2 * 33], s[3 * 33]); o.z = pk2(s[4 * 33], s[5 * 33]); o.w = pk2(s[6 * 33], s[7 * 33]);
        *(u32x4*)(WT + (size_t)(rowbase + n) * K + k0 + 8 * cch) = o; }
    asm volatile("s_waitcnt lgkmcnt(0)" ::: "memory");
}
__device__ __forceinline__ int gu_row(int n0, int up) { return (n0 >> 7) * 256 + up * 128 + (n0 & 127); }
template <bool EXPERTS>
__device__ __forceinline__ void ph_convert(const Ctx& c, const Params& p) {
    float* scr = c.lds + c.wave * (64 * 33);
    unsigned char* ws = c.ws;
    constexpr int I0 = 16 * 64, I1 = 16 * 32, I2 = 8 * 16, I3 = 16 * 8, I6 = 4 * 32, IE = 128;
    constexpr int DENSE = I0 + I2 + I3, NITEMS = EXPERTS ? DENSE + 3 * IE * NE : DENSE;
    const int first_ = (!EXPERTS && c.gwaves >= 1536) ? 768 : 0;
    for (int it = c.gwave - first_; it < (EXPERTS ? NITEMS : 768); it += c.gwaves) {
        if (it < 0) continue;
        int r = EXPERTS ? it : (it < 512 ? (it >> 5) * 64 + (it & 31) : it + 512);
        if (r < I0) { if ((r % 64) < 32) transpose_item(p.in[I_WIN], DM, 2048, (bf16_t*)(ws + WS_WIN_T), r / 64, r % 64, (r % 64) * 32, scr, c.lane); continue; } r -= I0;
        if (r < I2) { transpose_item(p.in[I_WGLU], 512, 512, (bf16_t*)(ws + WS_WGLU_T), r / 16, r % 16, (r % 16) * 32, scr, c.lane); continue; } r -= I2;
        if (r < I3) { const int kb = r / 8, nb = r % 8, k0 = 64 * kb, n0 = 32 * nb;
#pragma unroll 8
            for (int i = 0; i < 32; ++i) { const int kk = 2 * i + (c.lane >> 5); scr[kk * 33 + (c.lane & 31)] = __builtin_nontemporal_load(p.in[I_WR] + (size_t)(k0 + kk) * 256 + n0 + (c.lane & 31)); }
            asm volatile("s_waitcnt lgkmcnt(0)" ::: "memory");
            { const int cch = c.lane & 7;
#pragma unroll
              for (int j = 0; j < 4; ++j) { const int n = (c.lane >> 3) + 8 * j; const float* s_ = scr + (8 * cch) * 33 + n; float* d = (float*)(ws + WS_WRT32) + (size_t)(n0 + n) * DM + k0 + 8 * cch;
                  *(f32x4*)d = (f32x4){s_[0 * 33], s_[1 * 33], s_[2 * 33], s_[3 * 33]}; *(f32x4*)(d + 4) = (f32x4){s_[4 * 33], s_[5 * 33], s_[6 * 33], s_[7 * 33]}; } }
            asm volatile("s_waitcnt lgkmcnt(0)" ::: "memory");
            continue; } r -= I3;
        const int e = r / (3 * IE), q = r % (3 * IE), which = q / IE, ii = q % IE;
        if (which == 0) transpose_item(p.in[I_WGE] + (size_t)e * DM * ED, DM, ED, (bf16_t*)(ws + WS_WGU) + (size_t)e * 512 * DM, ii / 8, ii % 8, gu_row((ii % 8) * 32, 0), scr, c.lane);
        else if (which == 1) transpose_item(p.in[I_WUE] + (size_t)e * DM * ED, DM, ED, (bf16_t*)(ws + WS_WGU) + (size_t)e * 512 * DM, ii / 8, ii % 8, gu_row((ii % 8) * 32, 1), scr, c.lane);
        else transpose_item(p.in[I_WDE] + (size_t)e * ED * DM, ED, DM, (bf16_t*)(ws + WS_WD) + (size_t)e * DM * ED, ii / 32, ii % 32, (ii % 32) * 32, scr, c.lane);
    }
}

__device__ __forceinline__ void transpose_tile64(const float* W, int K, int N, bf16_t* WT, int kb, int nb, int rowbase, float* scr, int lane) {
    const int k0 = 64 * kb, n0 = 64 * nb;
    f32x4 v[16];
#pragma unroll
    for (int i = 0; i < 16; ++i) v[i] = *(const f32x4*)(W + (size_t)(k0 + 4 * i + (lane >> 4)) * N + n0 + (lane & 15) * 4);
#pragma unroll
    for (int i = 0; i < 16; ++i) { float* d = scr + (4 * i + (lane >> 4)) * 65 + (lane & 15) * 4; d[0] = v[i].x; d[1] = v[i].y; d[2] = v[i].z; d[3] = v[i].w; }
    asm volatile("s_waitcnt lgkmcnt(0)" ::: "memory");
    const int cch = lane & 7;
#pragma unroll
    for (int jj = 0; jj < 8; ++jj) { const int n = (lane >> 3) + 8 * jj; const float* s_ = scr + (8 * cch) * 65 + n;
        u32x4 o; o.x = pk2(s_[0 * 65], s_[1 * 65]); o.y = pk2(s_[2 * 65], s_[3 * 65]); o.z = pk2(s_[4 * 65], s_[5 * 65]); o.w = pk2(s_[6 * 65], s_[7 * 65]);
        *(u32x4*)(WT + (size_t)(rowbase + n) * K + k0 + 8 * cch) = o; }
    asm volatile("s_waitcnt lgkmcnt(0)" ::: "memory");
}
struct ConvTile { const float* W; bf16_t* WT; int K, N, k0, n0, rowbase; bool f8; float scale; };
template <int GU8>
__device__ __forceinline__ ConvTile conv_tile_ref(const Ctx& c, const Params& p, int id) {
    const int e = id / 192, q = id % 192, which = q >> 6, ii = q & 63; ConvTile t; t.f8 = (GU8 >= 1 && which < 2) || (GU8 == 2); t.scale = which < 2 ? WGU8_SCALE : WD8_SCALE;
    if (which == 0) { t.W = p.in[I_WGE] + (size_t)e * DM * ED; t.WT = (bf16_t*)(c.ws + WS_WGU) + (size_t)e * 512 * (GU8 ? DM / 2 : DM); t.K = DM; t.N = ED; t.k0 = 64 * (ii >> 2); t.n0 = 64 * (ii & 3); t.rowbase = gu_row(t.n0, 0); }
    else if (which == 1) { t.W = p.in[I_WUE] + (size_t)e * DM * ED; t.WT = (bf16_t*)(c.ws + WS_WGU) + (size_t)e * 512 * (GU8 ? DM / 2 : DM); t.K = DM; t.N = ED; t.k0 = 64 * (ii >> 2); t.n0 = 64 * (ii & 3); t.rowbase = gu_row(t.n0, 1); }
    else { t.W = p.in[I_WDE] + (size_t)e * ED * DM; t.WT = (bf16_t*)(c.ws + WS_WD) + (size_t)e * DM * (GU8 == 2 ? ED / 2 : ED); t.K = ED; t.N = DM; t.k0 = 64 * (ii >> 4); t.n0 = 64 * (ii & 15); t.rowbase = t.n0; }
    return t;
}
#define CONV_LOAD(v, t) do { const float* p_ = (t).W + (size_t)((t).k0 + (c.lane >> 4)) * (t).N + (t).n0 + (c.lane & 15) * 4; const size_t st_ = (size_t)4 * (t).N; \
        _Pragma("unroll") for (int i_ = 0; i_ < 16; ++i_) { v[i_] = __builtin_nontemporal_load((const f32x4*)p_); p_ += st_; asm volatile("" : "+v"(p_)); } } while (0)
#define CONV_FINISH(v, t) do { _Pragma("unroll") for (int i_ = 0; i_ < 16; ++i_) { float* d_ = scr + (4 * i_ + (c.lane >> 4)) * 65 + (c.lane & 15) * 4; d_[0] = v[i_].x; d_[1] = v[i_].y; d_[2] = v[i_].z; d_[3] = v[i_].w; } \
        asm volatile("s_waitcnt lgkmcnt(0)" ::: "memory"); \
        { const int esz_ = (t).f8 ? 1 : 2; unsigned char* q_ = (unsigned char*)(t).WT + ((size_t)((t).rowbase + (c.lane >> 3)) * (t).K + (t).k0 + 8 * (c.lane & 7)) * esz_; const size_t qs_ = (size_t)8 * (t).K * esz_; \
        _Pragma("unroll") for (int jj_ = 0; jj_ < 8; ++jj_) { const float* s_ = scr + (8 * (c.lane & 7)) * 65 + (c.lane >> 3) + 8 * jj_; \
            if ((t).f8) { u32x2 o_; o_.x = pk4_fp8(s_[0 * 65] * (t).scale, s_[1 * 65] * (t).scale, s_[2 * 65] * (t).scale, s_[3 * 65] * (t).scale); \
                o_.y = pk4_fp8(s_[4 * 65] * (t).scale, s_[5 * 65] * (t).scale, s_[6 * 65] * (t).scale, s_[7 * 65] * (t).scale); \
                __builtin_nontemporal_store(o_, (u32x2*)q_); } \
            else { u32x4 o_; o_.x = pk2(s_[0 * 65], s_[1 * 65]); o_.y = pk2(s_[2 * 65], s_[3 * 65]); o_.z = pk2(s_[4 * 65], s_[5 * 65]); o_.w = pk2(s_[6 * 65], s_[7 * 65]); \
                *(u32x4*)q_ = o_; } \
            q_ += qs_; asm volatile("" : "+v"(q_)); } } \
        asm volatile("s_waitcnt lgkmcnt(0)" ::: "memory"); } while (0)
template <int GU8>
__device__ __forceinline__ void conv_range(const Ctx& c, const Params& p, int first, int end, int stride, float* scr) {
    if (first >= end) return;
    f32x4 va[16], vb[16];
    ConvTile ta = conv_tile_ref<GU8>(c, p, first), tb = ta;
    CONV_LOAD(va, ta);
    for (int id = first; id < end; id += 2 * stride) {
        const bool hb = id + stride < end;
        if (hb) { tb = conv_tile_ref<GU8>(c, p, id + stride); CONV_LOAD(vb, tb); }
        CONV_FINISH(va, ta);
        if (!hb) break;
        const bool ha = id + 2 * stride < end;
        if (ha) { ta = conv_tile_ref<GU8>(c, p, id + 2 * stride); CONV_LOAD(va, ta); }
        CONV_FINISH(vb, tb);
        if (!ha) break;
    }
}
__device__ __forceinline__ void ph_router_prep(const Ctx& c, const Params& p) {
    const float* mod = (const float*)(c.ws + WS_MOD);
    { const float* WT = (const float*)(c.ws + WS_WRT32); bf16_t* WB = (bf16_t*)(c.ws + WS_WRB);
      for (int idx = c.gthreads - 1 - c.gtid; idx < NB * 256 * (DM / 8); idx += c.gthreads) {
          const int k8 = idx & (DM / 8 - 1), n = (idx >> 7) & 255, b = idx >> 15, k = 8 * k8;
          const f32x4 w0 = *(const f32x4*)(WT + (size_t)n * DM + k), w1 = *(const f32x4*)(WT + (size_t)n * DM + k + 4);
          const f32x4 g0 = *(const f32x4*)(p.in[I_N2G] + k) * (1.f + *(const f32x4*)(mod + b * 6 * DM + 4 * DM + k)), g1 = *(const f32x4*)(p.in[I_N2G] + k + 4) * (1.f + *(const f32x4*)(mod + b * 6 * DM + 4 * DM + k + 4));
          const f32x4 o0 = w0 * g0, o1 = w1 * g1;
          u32x4 o; o.x = pk2(o0.x, o0.y); o.y = pk2(o0.z, o0.w); o.z = pk2(o1.x, o1.y); o.w = pk2(o1.z, o1.w);
          *(u32x4*)(WB + ((size_t)b * 256 + n) * DM + k) = o; } }
    __syncthreads();
    float* red = c.lds;
    for (int item = c.bid; item < NB * 16; item += c.nb) {
        const int b = item >> 4, kq = (item >> 2) & 3, n = (item & 3) * 64 + c.lane; const float* sh = mod + b * 6 * DM + 3 * DM;
        const int k0 = kq * 256 + c.wave * 32;
        float a = 0.f;
#pragma unroll
        for (int k = 0; k < 32; ++k) a += sh[k0 + k] * p.in[I_WR][(size_t)(k0 + k) * 256 + n];
        red[c.wave * 64 + c.lane] = a;
        __syncthreads();
        if (c.wave == 0) { float t = 0.f;
#pragma unroll
            for (int w = 0; w < 8; ++w) t += red[w * 64 + c.lane];
            ((float*)(c.ws + WS_RBIAS))[(b * 4 + kq) * 256 + n] = t; }
        __syncthreads();
    }
}
__device__ __forceinline__ void ph_convert_shared8(const Ctx& c, const Params& p) {
    float* scr = c.lds + c.wave * (64 * 65);
    for (int r = c.gwaves - 1 - c.gwave; r < 192 + 256 + 256; r += c.gwaves) {
        const int which = r >> 6, ii = r & 63;
        ConvTile t; t.f8 = true;
        if (r >= 448) { const int jj = r - 448;
            t.W = p.in[I_WIN]; t.WT = (bf16_t*)(c.ws + WS_WIN8); t.K = DM; t.N = 2048; t.k0 = 64 * (jj >> 4); t.n0 = 1024 + 64 * (jj & 15); t.rowbase = 64 * (jj & 15); t.scale = WGU8_SCALE;
            f32x4 v[16]; CONV_LOAD(v, t); CONV_FINISH(v, t); continue; }
        if (r >= 192) { const int jj = r - 192;
            t.W = p.in[I_WOUT]; t.WT = (bf16_t*)(c.ws + WS_WOUT_T); t.K = DM; t.N = DM; t.k0 = 64 * (jj >> 4); t.n0 = 64 * (jj & 15); t.rowbase = t.n0; t.scale = WOUT8_SCALE;
            f32x4 v[16]; CONV_LOAD(v, t);
            if (t.k0 >= 512) {
#pragma unroll
                for (int i = 0; i < 16; ++i) v[i] *= p.in[I_SNG][t.k0 - 512 + 4 * i + (c.lane >> 4)]; }
            CONV_FINISH(v, t); continue; }
        if (which < 2) { t.W = p.in[which ? I_WUS : I_WGS]; t.WT = (bf16_t*)(c.ws + WS_WS8); t.K = DM; t.N = 256; t.k0 = 64 * (ii >> 2); t.n0 = 64 * (ii & 3); t.rowbase = gu_row(t.n0, which); t.scale = WGU8_SCALE; }
        else { t.W = p.in[I_WDS]; t.WT = (bf16_t*)(c.ws + WS_WDS_T); t.K = ED; t.N = DM; t.k0 = 64 * (ii >> 4); t.n0 = 64 * (ii & 15); t.rowbase = t.n0; t.scale = WD8_SCALE; }
        f32x4 v[16];
        CONV_LOAD(v, t); CONV_FINISH(v, t);
    }
}
__device__ __forceinline__ void conv_tile_by_id(const Ctx& c, const Params& p, int id, float* scr) { conv_range<0>(c, p, id, id + 1, 1, scr); }
__device__ __forceinline__ void conv_queue(const Ctx& c, const Params& p, unsigned* qctr) {
    float* scr = c.lds + c.wave * (64 * 65);
    constexpr int NTILES = NE * 192, CHUNK = 16;
    for (;;) {
        int tk = 0; if (c.lane == 0) tk = (int)atomicAdd(qctr, 1u);
        tk = __builtin_amdgcn_readfirstlane(tk);
        if (tk * CHUNK >= NTILES) break;
        conv_range<0>(c, p, tk * CHUNK, tk * CHUNK + CHUNK, 1, scr);
    }
}
__device__ __forceinline__ void ph_prologue2(const Ctx& c, const Params& p) {
    float* mod = (float*)(c.ws + WS_MOD);
    const bool split = c.nb >= 2 * 96;
    const bool is_mod = c.bid < 96 || !split, is_helper = c.bid >= 96 || !split;
    const int hid = split ? (c.bid - 96) * NTHREADS_ + c.tid : c.gtid, hn = split ? (c.nb - 96) * NTHREADS_ : c.gthreads;
    float* sc = c.lds;
    if (is_mod) { for (int i = c.tid; i < NB * DM; i += NTHREADS_) sc[i] = siluf(p.in[I_C][i]); }
    __syncthreads();
    float* red = c.lds + NB * DM;
    if (is_mod) for (int cg = c.bid; cg < 96; cg += c.nb) {
        const int ks = c.wave, col = cg * 64 + c.lane;
        const float* w = p.in[I_WADA] + (size_t)(ks * 128) * (6 * DM) + col;
        float acc[8];
#pragma unroll
        for (int b = 0; b < 8; ++b) acc[b] = 0.f;
#pragma unroll
        for (int h = 0; h < 2; ++h) {
            float wv[64];
#pragma unroll
            for (int k = 0; k < 64; ++k) wv[k] = __builtin_nontemporal_load(w + (size_t)(h * 64 + k) * (6 * DM));
#pragma unroll
            for (int k = 0; k < 64; k += 4) {
#pragma unroll
                for (int b = 0; b < 8; ++b) { const f32x4 s4 = *(const f32x4*)(sc + b * DM + ks * 128 + h * 64 + k);
                    acc[b] += s4.x * wv[k]; acc[b] += s4.y * wv[k + 1]; acc[b] += s4.z * wv[k + 2]; acc[b] += s4.w * wv[k + 3]; } }
        }
#pragma unroll
        for (int b = 0; b < 8; ++b) red[(ks * 8 + b) * 64 + c.lane] = acc[b];
        __syncthreads();
        { const int b = c.wave; float sum = p.in[I_BADA][col];
#pragma unroll
          for (int k2 = 0; k2 < 8; ++k2) sum += red[(k2 * 8 + b) * 64 + c.lane];
          mod[b * 6 * DM + col] = sum; }
        __syncthreads();
    }
    float* ropec = (float*)(c.ws + WS_ROPE); float* ropes = ropec + SEQ * 32;
    if (is_helper) for (int idx = hid; idx < SEQ * 32; idx += hn) {
        const int l = idx >> 5, i = idx & 31;
        const double invf = exp(-log(10000.0) * (double)(2 * i) / 64.0);
        const double ang = (double)l * invf;
        ropec[idx] = (float)cos(ang); ropes[idx] = (float)sin(ang);
    }
    float* sp = (float*)(c.ws + WS_SSMP);
    float* abr = sp, * abi = sp + SG * SP, * bbr = sp + 2 * SG * SP, * bbi = bbr + SG * SP * SC;
    if (is_helper) for (int idx = hid; idx < SG * SP; idx += hn) {
        const int g = idx / SP;
        const double are = p.in[I_ARE][idx], aim = p.in[I_AIM][idx], dt = exp((double)p.in[I_LOGDT][g]);
        const double mag = exp(are * dt), ar = mag * cos(aim * dt), ai = mag * sin(aim * dt);
        abr[idx] = (float)ar; abi[idx] = (float)ai;
        const double den = are * are + aim * aim, nr = ar - 1.0;
        const double fre = (nr * are + ai * aim) / den, fim = (ai * are - nr * aim) / den;
        for (int ch = 0; ch < SC; ++ch) {
            const double br = p.in[I_BRE][idx * SC + ch], bi = p.in[I_BIM][idx * SC + ch];
            bbr[idx * SC + ch] = (float)(fre * br - fim * bi); bbi[idx * SC + ch] = (float)(fre * bi + fim * br);
        }
    }
    if (is_helper) for (int idx = hn - 1 - hid; idx < SG * SP * 17; idx += hn) {
        const int gp = idx / 17, d = idx % 17, g = gp / SP;
        const double are = p.in[I_ARE][gp], aim = p.in[I_AIM][gp], dt = exp((double)p.in[I_LOGDT][g]);
        const double m = exp(are * dt * d); float* pw = (float*)(c.ws + WS_SSMPW) + (size_t)gp * 34;
        pw[2 * d] = (float)(m * cos(aim * dt * d)); pw[2 * d + 1] = (float)(m * sin(aim * dt * d));
    }
    if (c.bid == c.nb - 1 && c.wave == 0) {
        static_assert(HD == 64, "one lane per head-dim element");
        float s1 = p.in[I_LQ1][c.lane] * p.in[I_LK1][c.lane], s2 = p.in[I_LQ2][c.lane] * p.in[I_LK2][c.lane];
        float gq = fabsf(p.in[I_QNG][c.lane]), gk = fabsf(p.in[I_KNG][c.lane]);
#pragma unroll
        for (int o = 1; o < 64; o <<= 1) { s1 += __shfl_xor(s1, o); s2 += __shfl_xor(s2, o); gq = fmaxf(gq, __shfl_xor(gq, o)); gk = fmaxf(gk, __shfl_xor(gk, o)); }
        if (c.lane == 0) { float* lam = (float*)(c.ws + WS_LAM);
            lam[0] = __expf(s1) - __expf(s2) + LAM_INIT;
            lam[1] = 0.125f * 64.f * gq * gk; }
    }
    int* stok = (int*)(c.ws + WS_SLOT_TOK); int* sasg = (int*)(c.ws + WS_SLOT_ASG); float* sgate = (float*)(c.ws + WS_SLOT_GATE);
    if (is_helper) for (int idx = hid; idx < NS_MAX; idx += hn) { stok[idx] = 0; sasg[idx] = -1; sgate[idx] = 0.f; }
    int* te = (int*)(c.ws + WS_TILE_E);
    if (is_helper) for (int idx = hid; idx < NS_MAX / 256; idx += hn) te[idx] = -1;
    __syncthreads();
}
__device__ __forceinline__ void ph_slot2(const Ctx& c, const Params& p) {
    const unsigned* counts = (const unsigned*)(c.ws + WS_CTL) + CW_COUNTS; unsigned* cursor = (unsigned*)(c.ws + WS_CTL) + CW_CURSOR;
    int* pc = (int*)c.lds; int* ps = pc + 256;
    if (c.tid < NE) pc[c.tid] = ((int)counts[c.tid] + 255) / 256 * 256;
    __syncthreads();
    if (c.tid <= NE) { int acc = 0; for (int e = 0; e < c.tid; ++e) acc += pc[e]; ps[c.tid] = acc; }
    __syncthreads();
    const int* eidx = (const int*)(c.ws + WS_EIDX); const float* gw = (const float*)(c.ws + WS_GATEW);
    int* stok = (int*)(c.ws + WS_SLOT_TOK); int* sasg = (int*)(c.ws + WS_SLOT_ASG); float* sgate = (float*)(c.ws + WS_SLOT_GATE);
    for (int a = c.gtid; a < T * TOPK; a += c.gthreads) {
        const int e = eidx[a]; const unsigned pos = atomicAdd(cursor + e, 1u); const int slot = ps[e] + (int)pos;
        stok[slot] = a >> 3; sasg[slot] = a; sgate[slot] = gw[a];
    }
    if (c.bid == 0) {
        int* te = (int*)(c.ws + WS_TILE_E);
        for (int e = c.tid; e < NE; e += NTHREADS_) for (int tl = ps[e] / 256; tl < ps[e + 1] / 256; ++tl) te[tl] = e;
        if (c.tid == 0) ((unsigned*)(c.ws + WS_CTL))[CW_NTILES] = (unsigned)(ps[NE] / 256);
    }
    __syncthreads();
}

template <int CTRL> __device__ __forceinline__ float dpp_f(float v) { return __builtin_bit_cast(float, __builtin_amdgcn_update_dpp(0, __builtin_bit_cast(int, v), CTRL, 0xF, 0xF, false)); }
template <int CTRL> __device__ __forceinline__ int dpp_i(int v) { return __builtin_amdgcn_update_dpp(0, v, CTRL, 0xF, 0xF, false); }
#define DPP_XOR1 0xB1
#define DPP_XOR2 0x4E
#define DPP_HMIR 0x141
#define DPP_MIR 0x140
__device__ __forceinline__ void ph_qkn2(const Ctx& c, const Params& p) {
    bf16_t* QK = (bf16_t*)(c.ws + WS_QK);
    const float* ropec = (const float*)(c.ws + WS_ROPE); const float* ropes = ropec + SEQ * 32;
    const int l = c.lane, qt = l & 3; const bool hi_half = qt >= 2;
    const float qsc = l < 32 ? 0.125f * 1.4426950408889634f : 1.f;
    float g[16];
#pragma unroll
    for (int j = 0; j < 16; ++j) g[j] = (l < 32 ? p.in[I_QNG] : p.in[I_KNG])[16 * qt + j];
    constexpr int R = 2;
    for (int t0 = c.gwave * R; t0 < T; t0 += c.gwaves * R) {
        u32x4 w[R][2]; f32x4 cs[R][4], sn[R][4];
#pragma unroll
        for (int r = 0; r < R; ++r) { const int t = t0 + r, pos = t % SEQ;
            w[r][0] = *(const u32x4*)(QK + (size_t)t * 1024 + l * 16); w[r][1] = *(const u32x4*)(QK + (size_t)t * 1024 + l * 16 + 8);
#pragma unroll
            for (int q = 0; q < 4; ++q) { cs[r][q] = *(const f32x4*)(ropec + pos * 32 + 16 * (qt & 1) + 4 * q); sn[r][q] = *(const f32x4*)(ropes + pos * 32 + 16 * (qt & 1) + 4 * q); } }
#pragma unroll
        for (int r = 0; r < R; ++r) {
            float v[16]; const unsigned* wp = (const unsigned*)&w[r][0];
#pragma unroll
            for (int i = 0; i < 8; ++i) { v[2 * i] = __uint_as_float(wp[i] << 16); v[2 * i + 1] = __uint_as_float(wp[i] & 0xffff0000u); }
            float ss = 0.f;
#pragma unroll
            for (int j = 0; j < 16; ++j) ss += v[j] * v[j];
            ss += dpp_f<DPP_XOR1>(ss); ss += dpp_f<DPP_XOR2>(ss);
            const float rstd = rsqrtf(ss * (1.f / 64.f) + EPS);
            unsigned o[8];
#pragma unroll
            for (int i = 0; i < 8; ++i) { float res[2];
#pragma unroll
                for (int e = 0; e < 2; ++e) { const int j = 2 * i + e; const float y = v[j] * rstd * g[j]; const float pr = dpp_f<DPP_XOR2>(y);
                    const float cc_ = cs[r][j >> 2][j & 3], s_ = sn[r][j >> 2][j & 3];
                    res[e] = (hi_half ? (pr * s_ + y * cc_) : (y * cc_ - pr * s_)) * qsc; }
                o[i] = pk2(res[0], res[1]); }
            *(u32x4*)(QK + (size_t)(t0 + r) * 1024 + l * 16) = (u32x4){o[0], o[1], o[2], o[3]}; *(u32x4*)(QK + (size_t)(t0 + r) * 1024 + l * 16 + 8) = (u32x4){o[4], o[5], o[6], o[7]};
        }
    }
}
template <bool ATOMIC_BASE>
__device__ __forceinline__ void ph_route2(const Ctx& c, const Params& p) {
    const float* L = (const float*)(c.ws + WS_LOGITS);
    int* eidx = (int*)(c.ws + WS_EIDX); float* gw = (float*)(c.ws + WS_GATEW); int* HIST = (int*)(c.ws + WS_HIST);
    int* hist = (int*)c.lds; float* sstrip = c.lds + 256;
    if (c.tid < NE) hist[c.tid] = 0;
    __syncthreads();
    const int j = c.lane & 15, r = c.lane >> 4, g = j >> 1; const float NEG = -__builtin_inff();
    float rb[16];
#pragma unroll
    for (int i = 0; i < 16; ++i) rb[i] = p.in[I_RB][16 * j + i];
    for (int blk = c.bid; blk < T / 128; blk += c.nb) {
        for (int it = 0; it < 4; ++it) {
            const int t = blk * 128 + it * 32 + c.wave * 4 + r;
            float s[16], mv[16];
            { const f32x4* lp = (const f32x4*)(L + (size_t)t * 256 + 16 * j);
#pragma unroll
              for (int q = 0; q < 4; ++q) { const f32x4 x = lp[q]; s[4 * q] = sigmoidf(x.x); s[4 * q + 1] = sigmoidf(x.y); s[4 * q + 2] = sigmoidf(x.z); s[4 * q + 3] = sigmoidf(x.w); } }
            float m1 = NEG, m2 = NEG;
#pragma unroll
            for (int i = 0; i < 16; ++i) { mv[i] = s[i] + rb[i]; m2 = fmaxf(m2, fminf(m1, mv[i])); m1 = fmaxf(m1, mv[i]); }
            const float pm1 = dpp_f<DPP_XOR1>(m1), pm2 = dpp_f<DPP_XOR1>(m2);
            const float gs = fmaxf(m1, pm1) + fmaxf(fminf(m1, pm1), fmaxf(m2, pm2));
            int rank = 0;
#define RANK_STEP(N) { const float os = dpp_f<0x120 + (N)>(gs); const int og = dpp_i<0x120 + (N)>(g); rank += (os > gs || (os == gs && og < g)) ? 1 : 0; }
            RANK_STEP(2) RANK_STEP(4) RANK_STEP(6) RANK_STEP(8) RANK_STEP(10) RANK_STEP(12) RANK_STEP(14)
#undef RANK_STEP
            unsigned key[16];
#pragma unroll
            for (int i = 0; i < 16; ++i) { unsigned u = __float_as_uint(mv[i]); u = (u >> 31) ? ~u : (u | 0x80000000u);
                key[i] = (rank >= TOPG) ? 0u : ((u & 0xFFFFFF00u) | (unsigned)(255 - (16 * j + i))); }
            float wsel = 0.f, wsum = 0.f; int esel = 0;
#pragma unroll
            for (int k = 0; k < TOPK; ++k) {
                unsigned bm = key[0];
#pragma unroll
                for (int i = 1; i < 16; ++i) bm = bm > key[i] ? bm : key[i];
#define KMAX_STEP(CT) { const unsigned om = (unsigned)dpp_i<CT>((int)bm); bm = om > bm ? om : bm; }
                KMAX_STEP(DPP_XOR1) KMAX_STEP(DPP_XOR2) KMAX_STEP(DPP_HMIR) KMAX_STEP(DPP_MIR)
#undef KMAX_STEP
#pragma unroll
                for (int i = 0; i < 16; ++i) key[i] = (key[i] == bm) ? 0u : key[i];
                if (j == k) esel = 255 - (int)(bm & 255u);
            }
            { float* strip = sstrip + (c.wave * 4 + r) * 256;
#pragma unroll
              for (int q = 0; q < 4; ++q) *(f32x4*)(strip + 16 * j + 4 * q) = (f32x4){s[4 * q], s[4 * q + 1], s[4 * q + 2], s[4 * q + 3]};
              asm volatile("s_waitcnt lgkmcnt(0)" ::: "memory");
              wsel = (j < TOPK) ? strip[esel] : 0.f;
              asm volatile("s_waitcnt lgkmcnt(0)" ::: "memory"); }
            wsum = wsel; wsum += dpp_f<DPP_XOR1>(wsum); wsum += dpp_f<DPP_XOR2>(wsum); wsum += dpp_f<DPP_HMIR>(wsum); wsum += dpp_f<DPP_MIR>(wsum);
            if (j < TOPK) { eidx[t * 8 + j] = esel; gw[t * 8 + j] = wsel / wsum * ROUTED_SCALE; atomicAdd(hist + esel, 1); }
        }
        __syncthreads();
        if (c.tid < NE) { const int h = hist[c.tid];
            if (ATOMIC_BASE) { unsigned* counts = (unsigned*)(c.ws + WS_CTL) + CW_COUNTS_S; HIST[blk * NE + c.tid] = h ? (int)atomicAdd(counts + c.tid * CW_COUNTS_STRIDE, (unsigned)h) : 0; }
            else HIST[blk * NE + c.tid] = h;
            hist[c.tid] = 0; }
        __syncthreads();
    }
}
template <bool INV>
__device__ __forceinline__ void ph_slot3(const Ctx& c, const Params& p) {
    const int* HIST = (const int*)(c.ws + WS_HIST);
    int* pc = (int*)c.lds; int* base = pc + 256; int* cnt = base + 257;
    const int* eidx = (const int*)(c.ws + WS_EIDX); const float* gw = (const float*)(c.ws + WS_GATEW);
    int* stok = (int*)(c.ws + WS_SLOT_TOK); int* sasg = (int*)(c.ws + WS_SLOT_ASG); float* sgate = (float*)(c.ws + WS_SLOT_GATE);
    for (int blk = c.bid; blk < T / 128; blk += c.nb) {
        int before = 0;
        if (c.tid < NE) { int tot = 0;
#pragma unroll 16
            for (int b2 = 0; b2 < T / 128; ++b2) { const int h = HIST[b2 * NE + c.tid]; tot += h; before += (b2 < blk) ? h : 0; }
            pc[c.tid] = (tot + 255) / 256 * 256; cnt[c.tid] = 0; }
        __syncthreads();
        if (c.tid <= NE) { int acc = 0; for (int e = 0; e < c.tid; ++e) acc += pc[e]; base[c.tid] = acc + (c.tid < NE ? before : 0); }
        __syncthreads();
        for (int i = c.tid; i < 128 * TOPK; i += NTHREADS_) {
            const int a = blk * 128 * TOPK + i, e = eidx[a]; const int pos = atomicAdd(cnt + e, 1); const int slot = base[e] + pos;
            stok[slot] = a >> 3; sasg[slot] = a; sgate[slot] = gw[a]; if (INV) ((int*)eidx)[a] = slot;
        }
        if (blk == 0) {
            int* te = (int*)(c.ws + WS_TILE_E);
            for (int e = c.tid; e < NE; e += NTHREADS_) for (int tl = base[e] / 256; tl < (base[e] + pc[e]) / 256; ++tl) te[tl] = e;
            if (c.tid == 0) ((unsigned*)(c.ws + WS_CTL))[CW_NTILES] = (unsigned)(base[NE] / 256);
        }
        __syncthreads();
    }
}
__device__ __forceinline__ void ph_slot5(const Ctx& c, const Params& p) {
    const int* HIST = (const int*)(c.ws + WS_HIST); const unsigned* counts = (const unsigned*)(c.ws + WS_CTL) + CW_COUNTS_S;
    int* pc = (int*)c.lds; int* base = pc + 256; int* cnt = base + 257; int* pst = cnt + 256;
    const int* eidx = (const int*)(c.ws + WS_EIDX); const float* gw = (const float*)(c.ws + WS_GATEW);
    int* stok = (int*)(c.ws + WS_SLOT_TOK); int* sasg = (int*)(c.ws + WS_SLOT_ASG); float* sgate = (float*)(c.ws + WS_SLOT_GATE);
    for (int blk = c.bid; blk < T / 128; blk += c.nb) {
        int before = 0;
        if (c.tid < NE) { pc[c.tid] = ((int)counts[c.tid * CW_COUNTS_STRIDE] + 255) / 256 * 256; before = HIST[blk * NE + c.tid]; cnt[c.tid] = 0; }
        __syncthreads();
        if (c.tid <= NE) { int acc = 0; for (int e = 0; e < c.tid; ++e) acc += pc[e]; pst[c.tid] = acc; base[c.tid] = acc + before; }
        __syncthreads();
        for (int i = c.tid; i < 128 * TOPK; i += NTHREADS_) {
            const int a = blk * 128 * TOPK + i, e = eidx[a]; const int pos = atomicAdd(cnt + e, 1); const int slot = base[e] + pos;
            stok[slot] = a >> 3; sasg[slot] = a; sgate[slot] = gw[a]; ((int*)eidx)[a] = slot;
        }
        if (blk == 0) {
            int* te = (int*)(c.ws + WS_TILE_E);
            for (int e = c.tid; e < NE; e += NTHREADS_) { const int real = (int)counts[e * CW_COUNTS_STRIDE], t0 = pst[e] / 256;
                for (int tl = t0; tl < (pst[e] + pc[e]) / 256; ++tl) { const int nv = real - 256 * (tl - t0); te[tl] = e | (((nv < 256 ? nv : 256) - 1) << 8); } }
            if (c.tid == 0) ((unsigned*)(c.ws + WS_CTL))[CW_NTILES] = (unsigned)(pst[NE] / 256);
        }
        __syncthreads();
    }
}
__device__ __forceinline__ void ph_combine2(const Ctx& c, const Params& p) {
    const float* mod = (const float*)(c.ws + WS_MOD); const bf16_t* YA = (const bf16_t*)(c.ws + WS_YA); const bf16_t* YS = (const bf16_t*)(c.ws + WS_YSH); float* out = p.out;
    for (int t = c.gwave; t < T; t += c.gwaves) {
        const int b = t / SEQ;
        u32x4 y[9][2]; f32x4 xv[2][2], gv[2][2];
#pragma unroll
        for (int q = 0; q < 2; ++q) { const int col = q * 512 + c.lane * 8;
#pragma unroll
            for (int k = 0; k < 8; ++k) y[k][q] = *(const u32x4*)(YA + ((size_t)t * 8 + k) * DM + col);
            y[8][q] = *(const u32x4*)(YS + (size_t)t * DM + col);
            xv[q][0] = *(const f32x4*)(out + (size_t)t * DM + col); xv[q][1] = *(const f32x4*)(out + (size_t)t * DM + col + 4);
            gv[q][0] = *(const f32x4*)(mod + b * 6 * DM + 5 * DM + col); gv[q][1] = *(const f32x4*)(mod + b * 6 * DM + 5 * DM + col + 4); }
#pragma unroll
        for (int q = 0; q < 2; ++q) { const int col = q * 512 + c.lane * 8;
            f32x4 s0 = {0.f, 0.f, 0.f, 0.f}, s1 = {0.f, 0.f, 0.f, 0.f};
#pragma unroll
            for (int k = 0; k < 9; ++k) { const u32x4 w = y[k][q];
                s0[0] += __uint_as_float(w.x << 16); s0[1] += __uint_as_float(w.x & 0xffff0000u); s0[2] += __uint_as_float(w.y << 16); s0[3] += __uint_as_float(w.y & 0xffff0000u);
                s1[0] += __uint_as_float(w.z << 16); s1[1] += __uint_as_float(w.z & 0xffff0000u); s1[2] += __uint_as_float(w.w << 16); s1[3] += __uint_as_float(w.w & 0xffff0000u); }
            *(f32x4*)(out + (size_t)t * DM + col) = xv[q][0] + gv[q][0] * s0; *(f32x4*)(out + (size_t)t * DM + col + 4) = xv[q][1] + gv[q][1] * s1; }
    }
}
__device__ __forceinline__ void ph_combine3(const Ctx& c, const Params& p) {
    const float* mod = (const float*)(c.ws + WS_MOD); const bf16_t* YS = (const bf16_t*)(c.ws + WS_YS); const bf16_t* YH = (const bf16_t*)(c.ws + WS_YSH); float* out = p.out;
    const int* inv = (const int*)(c.ws + WS_EIDX);
    for (int t = c.gwave; t < T; t += c.gwaves) {
        const int b = t / SEQ;
        int sl[8];
#pragma unroll
        for (int k = 0; k < 8; ++k) sl[k] = inv[t * 8 + k];
        u32x4 y[9][2]; f32x4 xv[2][2], gv[2][2];
#pragma unroll
        for (int q = 0; q < 2; ++q) { const int col = q * 512 + c.lane * 8;
#pragma unroll
            for (int k = 0; k < 8; ++k) y[k][q] = *(const u32x4*)(YS + (size_t)sl[k] * DM + col);
            y[8][q] = *(const u32x4*)(YH + (size_t)t * DM + col);
            xv[q][0] = *(const f32x4*)(out + (size_t)t * DM + col); xv[q][1] = *(const f32x4*)(out + (size_t)t * DM + col + 4);
            gv[q][0] = *(const f32x4*)(mod + b * 6 * DM + 5 * DM + col); gv[q][1] = *(const f32x4*)(mod + b * 6 * DM + 5 * DM + col + 4); }
#pragma unroll
        for (int q = 0; q < 2; ++q) { const int col = q * 512 + c.lane * 8;
            f32x4 s0 = {0.f, 0.f, 0.f, 0.f}, s1 = {0.f, 0.f, 0.f, 0.f};
#pragma unroll
            for (int k = 0; k < 9; ++k) { const u32x4 w = y[k][q];
                s0[0] += __uint_as_float(w.x << 16); s0[1] += __uint_as_float(w.x & 0xffff0000u); s0[2] += __uint_as_float(w.y << 16); s0[3] += __uint_as_float(w.y & 0xffff0000u);
                s1[0] += __uint_as_float(w.z << 16); s1[1] += __uint_as_float(w.z & 0xffff0000u); s1[2] += __uint_as_float(w.w << 16); s1[3] += __uint_as_float(w.w & 0xffff0000u); }
            *(f32x4*)(out + (size_t)t * DM + col) = xv[q][0] + gv[q][0] * s0; *(f32x4*)(out + (size_t)t * DM + col + 4) = xv[q][1] + gv[q][1] * s1; }
    }
}
__device__ __forceinline__ void ph_combine4(const Ctx& c, const Params& p) {
    const float* mod = (const float*)(c.ws + WS_MOD); const unsigned char* YS = c.ws + WS_YS; const bf16_t* YH = (const bf16_t*)(c.ws + WS_YSH); float* out = p.out;
    const int* inv = (const int*)(c.ws + WS_EIDX);
    typedef float f32x2 __attribute__((ext_vector_type(2)));
    for (int t = c.gwave; t < T; t += c.gwaves) {
        const int b = t / SEQ, col = c.lane * 16;
        int sl[8];
#pragma unroll
        for (int k = 0; k < 8; ++k) sl[k] = inv[t * 8 + k];
        u32x4 y[8], yh[2]; f32x4 xv[4], gv[4];
#pragma unroll
        for (int k = 0; k < 8; ++k) y[k] = *(const u32x4*)(YS + (size_t)sl[k] * DM + col);
#pragma unroll
        for (int q = 0; q < 2; ++q) yh[q] = *(const u32x4*)(YH + (size_t)t * DM + col + 8 * q);
#pragma unroll
        for (int q = 0; q < 4; ++q) { xv[q] = *(const f32x4*)(out + (size_t)t * DM + col + 4 * q); gv[q] = *(const f32x4*)(mod + b * 6 * DM + 5 * DM + col + 4 * q); }
        float sacc[16];
#pragma unroll
        for (int i = 0; i < 16; ++i) sacc[i] = 0.f;
#pragma unroll
        for (int k = 0; k < 8; ++k) { const unsigned* wp = (const unsigned*)&y[k];
#pragma unroll
            for (int i = 0; i < 4; ++i) { const f32x2 lo = __builtin_amdgcn_cvt_pk_f32_fp8((int)wp[i], false), hi2 = __builtin_amdgcn_cvt_pk_f32_fp8((int)wp[i], true);
                sacc[4 * i] += lo[0]; sacc[4 * i + 1] += lo[1]; sacc[4 * i + 2] += hi2[0]; sacc[4 * i + 3] += hi2[1]; } }
#pragma unroll
        for (int q = 0; q < 2; ++q) { const unsigned* wp = (const unsigned*)&yh[q];
#pragma unroll
            for (int i = 0; i < 4; ++i) { sacc[8 * q + 2 * i] = sacc[8 * q + 2 * i] * (1.f / Y8_SCALE) + __uint_as_float(wp[i] << 16); sacc[8 * q + 2 * i + 1] = sacc[8 * q + 2 * i + 1] * (1.f / Y8_SCALE) + __uint_as_float(wp[i] & 0xffff0000u); } }
#pragma unroll
        for (int q = 0; q < 4; ++q) { f32x4 o = xv[q]; o[0] += gv[q][0] * sacc[4 * q]; o[1] += gv[q][1] * sacc[4 * q + 1]; o[2] += gv[q][2] * sacc[4 * q + 2]; o[3] += gv[q][3] * sacc[4 * q + 3];
            *(f32x4*)(out + (size_t)t * DM + col + 4 * q) = o; }
    }
}
__device__ __forceinline__ void ph_combine5(const Ctx& c, const Params& p) {
    const float* mod = (const float*)(c.ws + WS_MOD); const unsigned char* YS = c.ws + WS_YS; const unsigned char* YH = c.ws + WS_YSH;        float* out = p.out; const bf16_t* X1 = (const bf16_t*)(c.ws + WS_X1B);
    const int* inv = (const int*)(c.ws + WS_EIDX); const float* gwp = (const float*)(c.ws + WS_GATEW);
    typedef float f32x2 __attribute__((ext_vector_type(2)));
    for (int t = c.gwave; t < T; t += c.gwaves) {
        const int b = t / SEQ, col = c.lane * 16;
        int sl[8]; float gk[8];
#pragma unroll
        for (int k = 0; k < 8; ++k) { sl[k] = inv[t * 8 + k]; gk[k] = gwp[t * 8 + k]; }
        u32x4 y[8], yh, xb[2]; f32x4 xv[4], gv[4];
#pragma unroll
        for (int k = 0; k < 8; ++k) y[k] = *(const u32x4*)(YS + (size_t)sl[k] * DM + col);
        yh = *(const u32x4*)(YH + (size_t)t * DM + col);
#pragma unroll
        for (int q = 0; q < 2; ++q) xb[q] = *(const u32x4*)(X1 + (size_t)t * DM + col + 8 * q);
#pragma unroll
        for (int q = 0; q < 4; ++q) gv[q] = *(const f32x4*)(mod + b * 6 * DM + 5 * DM + col + 4 * q);
#pragma unroll
        for (int q = 0; q < 2; ++q) { const u32x4 z = xb[q];
            xv[2 * q] = (f32x4){__uint_as_float(z.x << 16), __uint_as_float(z.x & 0xffff0000u), __uint_as_float(z.y << 16), __uint_as_float(z.y & 0xffff0000u)};
            xv[2 * q + 1] = (f32x4){__uint_as_float(z.z << 16), __uint_as_float(z.z & 0xffff0000u), __uint_as_float(z.w << 16), __uint_as_float(z.w & 0xffff0000u)}; }
        float sacc[16];
#pragma unroll
        for (int i = 0; i < 16; ++i) sacc[i] = 0.f;
#pragma unroll
        for (int k = 0; k < 8; ++k) { const unsigned* wp = (const unsigned*)&y[k];
#pragma unroll
            for (int i = 0; i < 4; ++i) { const f32x2 lo = __builtin_amdgcn_cvt_pk_f32_fp8((int)wp[i], false), hi2 = __builtin_amdgcn_cvt_pk_f32_fp8((int)wp[i], true);
                sacc[4 * i] += gk[k] * lo[0]; sacc[4 * i + 1] += gk[k] * lo[1]; sacc[4 * i + 2] += gk[k] * hi2[0]; sacc[4 * i + 3] += gk[k] * hi2[1]; } }
        { const unsigned* wp = (const unsigned*)&yh;
#pragma unroll
          for (int i = 0; i < 4; ++i) { const f32x2 lo = __builtin_amdgcn_cvt_pk_f32_fp8((int)wp[i], false), hi2 = __builtin_amdgcn_cvt_pk_f32_fp8((int)wp[i], true);
              sacc[4 * i] += lo[0]; sacc[4 * i + 1] += lo[1]; sacc[4 * i + 2] += hi2[0]; sacc[4 * i + 3] += hi2[1]; } }
#pragma unroll
        for (int i = 0; i < 16; ++i) sacc[i] *= (1.f / Y8_SCALE);
#pragma unroll
        for (int q = 0; q < 4; ++q) { f32x4 o = xv[q]; o[0] += gv[q][0] * sacc[4 * q]; o[1] += gv[q][1] * sacc[4 * q + 1]; o[2] += gv[q][2] * sacc[4 * q + 2]; o[3] += gv[q][3] * sacc[4 * q + 3];
            *(f32x4*)(out + (size_t)t * DM + col + 4 * q) = o; }
    }
}
__device__ __forceinline__ void cpowi(float ar, float ai, int n, float& pr, float& pi) { pr = 1.f; pi = 0.f; for (int i = 0; i < n; ++i) { const float t = pr * ar - pi * ai; pi = pr * ai + pi * ar; pr = t; } }
__device__ __forceinline__ void ph_ssm_gen(const Ctx& c, const Params& p) {
    const float* sp = (const float*)(c.ws + WS_SSMP);
    const float* bbr = sp + 2 * SG * SP, * bbi = bbr + SG * SP * SC; const float* PWg = (const float*)(c.ws + WS_SSMPW);
    bf16_t* BA = (bf16_t*)(c.ws + WS_SSM_BA); bf16_t* BC = (bf16_t*)(c.ws + WS_SSM_BC);
    float* Lpw = c.lds; float* Lbb = Lpw + SP * 34; float* Lcc = Lbb + SP * 32;
    for (int w = c.bid; w < SG * 8; w += c.nb) {
        const int g = w & 31, part = w >> 5;
        __syncthreads();
        for (int i = c.tid; i < SP * 34; i += NTHREADS_) Lpw[i] = PWg[(size_t)g * SP * 34 + i];
        for (int i = c.tid; i < SP * 16; i += NTHREADS_) { Lbb[2 * i] = bbr[g * SP * SC + i]; Lbb[2 * i + 1] = bbi[g * SP * SC + i]; }
        for (int i = c.tid; i < 16 * SP; i += NTHREADS_) { Lcc[2 * i] = p.in[I_CRE][g * SC * SP + i]; Lcc[2 * i + 1] = p.in[I_CIM][g * SC * SP + i]; }
        __syncthreads();
        bf16_t* baseC = BC + (size_t)g * 256 * APK; bf16_t* baseA = BA + (size_t)g * 256 * 256;
        { const int idx = part * 512 + c.tid, ci = idx & 15, co = (idx >> 4) & 15, d = idx >> 8;
          float kv = 0.f;
#pragma unroll 8
          for (int pp = 0; pp < SP; ++pp) { const float pr = Lpw[pp * 34 + 2 * d], pi = Lpw[pp * 34 + 2 * d + 1], br = Lbb[(pp * 16 + ci) * 2], bi = Lbb[(pp * 16 + ci) * 2 + 1];
              const float tr = pr * br - pi * bi, ti = pr * bi + pi * br;
              kv += Lcc[(co * SP + pp) * 2] * tr - Lcc[(co * SP + pp) * 2 + 1] * ti; }
          if (d == 0 && co == ci) kv += p.in[I_SD][g * SC + co];
          const bf16_t kb = f2bf(kv);
          for (int j = 0; j + d < 16; ++j) { baseC[((j + d) * 16 + co) * APK + j * 16 + ci] = kb; if (d > 0) baseC[(j * 16 + co) * APK + (j + d) * 16 + ci] = 0; } }
        for (int q = c.tid; q < 2048; q += NTHREADS_) { const int idx = part * 2048 + q;
            { const int pp = idx & 63, co = (idx >> 6) & 15, jp = idx >> 10;
              const float pr = Lpw[pp * 34 + 2 * (jp + 1)], pi = Lpw[pp * 34 + 2 * (jp + 1) + 1], cr = Lcc[(co * SP + pp) * 2], ci2 = Lcc[(co * SP + pp) * 2 + 1];
              bf16_t* row = baseC + (size_t)(jp * 16 + co) * APK + 256;
              row[pp] = f2bf(cr * pr - ci2 * pi); row[64 + pp] = f2bf(-(cr * pi + ci2 * pr)); }
            { const int ci = idx & 15, j = (idx >> 4) & 15, pp = idx >> 8;
              const float pr = Lpw[pp * 34 + 2 * (15 - j)], pi = Lpw[pp * 34 + 2 * (15 - j) + 1], br = Lbb[(pp * 16 + ci) * 2], bi = Lbb[(pp * 16 + ci) * 2 + 1];
              baseA[pp * 256 + j * 16 + ci] = f2bf(pr * br - pi * bi); baseA[(64 + pp) * 256 + j * 16 + ci] = f2bf(pr * bi + pi * br); } }
        for (int q = c.tid; q < 512; q += NTHREADS_) *(u32x4*)(baseA + 128 * 256 + (part * 512 + q) * 8) = (u32x4){0u, 0u, 0u, 0u};
    }
    __syncthreads();
}
__device__ __forceinline__ void ph_ssm_scan(const Ctx& c, const Params& p, int vcu) {
    const float* sp = (const float*)(c.ws + WS_SSMP); const float* abr = sp, * abi = sp + SG * SP;
    const float* DS = (const float*)(c.ws + WS_DS); bf16_t* AP = (bf16_t*)(c.ws + WS_AP);
    float* fw = c.lds;
    for (int it = vcu; it < NB * SG; it += c.nb) {
        const int g = it >> 3, b = it & 7, pp = c.lane, w = c.wave;
        const size_t r0 = (size_t)g * (NB * NCHUNK) + b * NCHUNK + 32 * w;
        float ar = abr[g * SP + pp], ai = abi[g * SP + pp];
#pragma unroll
        for (int i = 0; i < 4; ++i) { const float t = ar * ar - ai * ai; ai = 2.f * ar * ai; ar = t; }
        float lr[32], li[32];
#pragma unroll
        for (int i = 0; i < 32; ++i) { lr[i] = DS[(r0 + i) * 128 + pp]; li[i] = DS[(r0 + i) * 128 + 64 + pp]; }
#pragma unroll
        for (int i = 1; i < 32; ++i) { const float nr = ar * lr[i - 1] - ai * li[i - 1] + lr[i], ni = ar * li[i - 1] + ai * lr[i - 1] + li[i]; lr[i] = nr; li[i] = ni; }
        __syncthreads();
        fw[(w * 64 + pp) * 2] = lr[31]; fw[(w * 64 + pp) * 2 + 1] = li[31];
        __syncthreads();
        float a32r = ar, a32i = ai;
#pragma unroll
        for (int i = 0; i < 5; ++i) { const float t = a32r * a32r - a32i * a32i; a32i = 2.f * a32r * a32i; a32r = t; }
        float cr = 0.f, ci = 0.f;
        for (int w2 = 0; w2 < w; ++w2) { const float fr_ = fw[(w2 * 64 + pp) * 2], fi_ = fw[(w2 * 64 + pp) * 2 + 1];
            const float nr = a32r * cr - a32i * ci + fr_, ni = a32r * ci + a32i * cr + fi_; cr = nr; ci = ni; }
        bf16_t* row = AP + r0 * APK + 256 + pp;
#pragma unroll
        for (int i = 0; i < 32; ++i) {
            const float sr = cr + (i ? lr[i - 1] : 0.f), si = ci + (i ? li[i - 1] : 0.f);
            row[0] = f2bf(sr); row[64] = f2bf(si);
            row += APK; asm volatile("" : "+v"(row));
            const float nr = ar * cr - ai * ci, ni = ar * ci + ai * cr; cr = nr; ci = ni;
        }
    }
}

namespace att {
typedef short bf16x8 __attribute__((ext_vector_type(8)));
typedef short s16x4 __attribute__((ext_vector_type(4)));
typedef float f32x16 __attribute__((ext_vector_type(16)));
typedef float f32x2 __attribute__((ext_vector_type(2)));
constexpr int NW = 8, QBLK = 32, KVBLK = 64, QB = 128, NQB = SEQ / QB;
constexpr int KP = 1024, VP = 512;
constexpr int SHM_V = KVBLK * 128 * 2, SHM_K = KVBLK * 128 * 2;
constexpr int LDS_WS = 2 * SHM_V + 2 * SHM_K, LDS_EX = LDS_WS + NW * 64 * 4, LDS_END = LDS_EX + 4 * 16384;
#define KSWZ(row, colB) ((row) * 256 + ((colB) ^ (((row) & 7) << 4)))
#define SBAR() __builtin_amdgcn_sched_barrier(0)
__device__ __forceinline__ int v_st(int k, int c) { const int kk = (k & ~0xC) | ((k & 4) << 1) | ((k & 8) >> 1); return ((kk >> 3) * 4 + (c >> 5)) * 512 + ((kk & 7) * 32 + (c & 31)) * 2; }
__device__ __forceinline__ int v_rd_base(int lane) { return ((lane & 3) << 3) | (((lane >> 2) & 3) << 6) | (((lane >> 4) & 1) << 5) | (((lane >> 5) & 1) << 8); }
constexpr int v_rd_off(int d0, int ks, int half) { return d0 * 512 + ks * 4096 + half * 2048; }
__device__ __forceinline__ int crow(int r, int hi) { return (r & 3) + 8 * (r >> 2) + 4 * hi; }
__device__ __forceinline__ unsigned cvtpk(float lo, float hi) { unsigned r; asm volatile("v_cvt_pk_bf16_f32 %0, %1, %2" : "=v"(r) : "v"(lo), "v"(hi)); return r; }
__device__ __forceinline__ void mask_tile(f32x16& p0, f32x16& p1, int dq) {
    const float NEG = -__builtin_inff();
#pragma unroll
    for (int r = 0; r < 16; ++r) { const int c = (r & 3) + 8 * (r >> 2); if (dq - c < 0) p0[r] = NEG; if (dq - c - 32 < 0) p1[r] = NEG; }
}
template <bool ZC>
__device__ __forceinline__ void offsetSM(f32x16& p0, f32x16& p1, float negM) {
    if constexpr (!ZC) {
#pragma unroll
        for (int r = 0; r < 16; ++r) { p0[r] += negM; p1[r] += negM; } }
}
template <bool ZC>
__device__ __forceinline__ void partialSM(f32x16& p0, f32x16& p1, float C2, float negM) {
    if constexpr (!ZC) {
#pragma unroll
        for (int r = 0; r < 16; ++r) { p0[r] += negM; p1[r] += negM; } }
#pragma unroll
    for (int r = 0; r < 16; ++r) p0[r] = __builtin_amdgcn_exp2f(p0[r]);
}
__device__ __forceinline__ void finishSM(f32x16& p0, f32x16& p1, float& l_reg, bf16x8& pa0, bf16x8& pa1, bf16x8& pa2, bf16x8& pa3) {
#pragma unroll
    for (int r = 0; r < 16; ++r) p1[r] = __builtin_amdgcn_exp2f(p1[r]);
    float ps = 0;
#pragma unroll
    for (int r = 0; r < 16; ++r) ps += p0[r];
#pragma unroll
    for (int r = 0; r < 16; ++r) ps += p1[r];
    { auto rr = __builtin_amdgcn_permlane32_swap(__float_as_uint(ps), __float_as_uint(ps), false, false); ps = __uint_as_float(rr[0]) + __uint_as_float(rr[1]); }
    l_reg += ps;
#define PK4(P, B_, OUT) do { unsigned a0 = cvtpk(P[B_+0], P[B_+1]), a1 = cvtpk(P[B_+2], P[B_+3]);                          \
        unsigned b0 = cvtpk(P[B_+4], P[B_+5]), b1 = cvtpk(P[B_+6], P[B_+7]);                                             \
        auto r0 = __builtin_amdgcn_permlane32_swap(a0, b0, false, false); auto r1 = __builtin_amdgcn_permlane32_swap(a1, b1, false, false); \
        u32x4 w = {r0[0], r1[0], r0[1], r1[1]}; OUT = *reinterpret_cast<bf16x8*>(&w); } while (0)
    PK4(p0, 0, pa0); PK4(p0, 8, pa1); PK4(p1, 0, pa2); PK4(p1, 8, pa3);
#undef PK4
}
template <int KB>
__device__ __forceinline__ void qkt(f32x16& p0, f32x16& p1, const char* K_lds, int r32, int hi, const bf16x8* qr, int cc) {
    p0 = f32x16{}; p1 = f32x16{};
    const char* kb[4];
#pragma unroll
    for (int dd = 0; dd < 4; ++dd) kb[dd] = K_lds + KB * SHM_K + KSWZ(r32, (dd * 16 + hi * 8) * 2) + cc * 128;
#pragma unroll
    for (int d0 = 0; d0 < 4; ++d0) { const char* a = kb[d0];
        bf16x8 b0 = *reinterpret_cast<const bf16x8*>(a);
        bf16x8 b1 = *reinterpret_cast<const bf16x8*>(a + 32 * 256);
        p0 = __builtin_amdgcn_mfma_f32_32x32x16_bf16(b0, qr[d0], p0, 0, 0, 0);
        p1 = __builtin_amdgcn_mfma_f32_32x32x16_bf16(b1, qr[d0], p1, 0, 0, 0); }
}
template <int VB>
__device__ __forceinline__ void pv_tile(f32x16* o, int vb0, bf16x8 pa0, bf16x8 pa1, bf16x8 pa2, bf16x8 pa3) {
#define TRRD(dst, off) asm volatile("ds_read_b64_tr_b16 %0, %1 offset:%2" : "=&v"(dst) : "v"(vb0), "i"(off) : "memory")
#define PV_D0(d0) do { s16x4 l0, l1, l2, l3, h0, h1, h2, h3; constexpr int b_ = VB * SHM_V + v_rd_off(d0, 0, 0); \
        TRRD(l0, b_); TRRD(h0, b_ + 2048); TRRD(l1, b_ + 4096); TRRD(h1, b_ + 6144); TRRD(l2, b_ + 8192); TRRD(h2, b_ + 10240); TRRD(l3, b_ + 12288); TRRD(h3, b_ + 14336); \
        asm volatile("s_waitcnt lgkmcnt(0)" ::: "memory"); SBAR();   \
        o[d0] = __builtin_amdgcn_mfma_f32_32x32x16_bf16(pa0, (bf16x8){l0[0], l0[1], l0[2], l0[3], h0[0], h0[1], h0[2], h0[3]}, o[d0], 0, 0, 0);   \
        o[d0] = __builtin_amdgcn_mfma_f32_32x32x16_bf16(pa1, (bf16x8){l1[0], l1[1], l1[2], l1[3], h1[0], h1[1], h1[2], h1[3]}, o[d0], 0, 0, 0);   \
        o[d0] = __builtin_amdgcn_mfma_f32_32x32x16_bf16(pa2, (bf16x8){l2[0], l2[1], l2[2], l2[3], h2[0], h2[1], h2[2], h2[3]}, o[d0], 0, 0, 0);   \
        o[d0] = __builtin_amdgcn_mfma_f32_32x32x16_bf16(pa3, (bf16x8){l3[0], l3[1], l3[2], l3[3], h3[0], h3[1], h3[2], h3[3]}, o[d0], 0, 0, 0); } while (0)
    PV_D0(0); PV_D0(1); PV_D0(2); PV_D0(3);
#undef PV_D0
#undef TRRD
}
template <int VB>
__device__ __forceinline__ void pv_tile_x(f32x16* o, int vb0, bf16x8 pa0, bf16x8 pa1, bf16x8 pa2, bf16x8 pa3, f32x16& px) {
#define TRRD(dst, off) asm volatile("ds_read_b64_tr_b16 %0, %1 offset:%2" : "=&v"(dst) : "v"(vb0), "i"(off) : "memory")
#define PV_D0(d0) do { s16x4 l0, l1, l2, l3, h0, h1, h2, h3; constexpr int b_ = VB * SHM_V + v_rd_off(d0, 0, 0); \
        TRRD(l0, b_); TRRD(h0, b_ + 2048); TRRD(l1, b_ + 4096); TRRD(h1, b_ + 6144); TRRD(l2, b_ + 8192); TRRD(h2, b_ + 10240); TRRD(l3, b_ + 12288); TRRD(h3, b_ + 14336); \
        asm volatile("s_waitcnt lgkmcnt(0)" ::: "memory"); SBAR();   \
        o[d0] = __builtin_amdgcn_mfma_f32_32x32x16_bf16(pa0, (bf16x8){l0[0], l0[1], l0[2], l0[3], h0[0], h0[1], h0[2], h0[3]}, o[d0], 0, 0, 0);   \
        o[d0] = __builtin_amdgcn_mfma_f32_32x32x16_bf16(pa1, (bf16x8){l1[0], l1[1], l1[2], l1[3], h1[0], h1[1], h1[2], h1[3]}, o[d0], 0, 0, 0);   \
        o[d0] = __builtin_amdgcn_mfma_f32_32x32x16_bf16(pa2, (bf16x8){l2[0], l2[1], l2[2], l2[3], h2[0], h2[1], h2[2], h2[3]}, o[d0], 0, 0, 0);   \
        o[d0] = __builtin_amdgcn_mfma_f32_32x32x16_bf16(pa3, (bf16x8){l3[0], l3[1], l3[2], l3[3], h3[0], h3[1], h3[2], h3[3]}, o[d0], 0, 0, 0);   \
        _Pragma("unroll") for (int e_ = 0; e_ < 4; ++e_) px[4 * (d0) + e_] = __builtin_amdgcn_exp2f(px[4 * (d0) + e_]); } while (0)
    PV_D0(0); PV_D0(1); PV_D0(2); PV_D0(3);
#undef PV_D0
#undef TRRD
}
struct BlockRef { const bf16_t* Q; const bf16_t* K; const bf16_t* V; bf16_t* O; int P0; };
struct Seam { bf16x8 qr[4]; bf16x8 st_v0, st_v1, st_k0, st_k1; };
#define ROWK(p, k0, rr) ((p) + (size_t)((k0) + (rr)) * KP + sc)
#define ROWV(p, k0, rr) ((p) + (size_t)((k0) + (rr)) * VP + sc)
#define LD8(ptr) (*reinterpret_cast<const bf16x8*>(ptr))
#define VMW() asm volatile("s_waitcnt vmcnt(0)" ::: "memory")
#define VMWN(n) asm volatile("s_waitcnt vmcnt(%0)" :: "i"(n) : "memory")
#define SLOAD_H(Kp, Vp, k0) do { S.st_v0 = LD8(ROWV(Vp, k0, sr)); S.st_v1 = LD8(ROWV(Vp, k0, 32 + sr)); S.st_k0 = LD8(ROWK(Kp, k0, sr)); S.st_k1 = LD8(ROWK(Kp, k0, 32 + sr)); } while (0)
#define SWRITE_HK(bf) do { *(bf16x8*)(K_lds + (bf) * SHM_K + kws) = S.st_k0; *(bf16x8*)(K_lds + (bf) * SHM_K + kws + 32 * 256) = S.st_k1; } while (0)
#define SWRITE_HV(bf) do { *(bf16x8*)(V_lds + (bf) * SHM_V + vst0) = S.st_v0; *(bf16x8*)(V_lds + (bf) * SHM_V + vst1) = S.st_v1; } while (0)
#define SWRITE_H(bf) do { SWRITE_HV(bf); SWRITE_HK(bf); } while (0)
#define QLOAD(ref) do { _Pragma("unroll") for (int d0 = 0; d0 < 4; ++d0) S.qr[d0] = LD8((ref).Q + (size_t)(qi * QBLK + r32) * KP + cc * 64 + d0 * 16 + hi * 8); } while (0)
__device__ __forceinline__ void prime(const BlockRef& cur, char* lds, Seam& S, int tid) {
    const int  wid = __builtin_amdgcn_readfirstlane(tid >> 6), lane = tid & 63, r32 = lane & 31, hi = lane >> 5, qi = wid >> 1, cc = wid & 1;
    const int sr = tid >> 4, sc = (tid & 15) * 8, kws = KSWZ(sr, sc * 2); char* K_lds = lds + 2 * SHM_V;
    QLOAD(cur);
    SLOAD_H(cur.K, cur.V, 0); VMW(); SWRITE_HK(0);
    __syncthreads();
}
template <bool ZC>
__device__ __forceinline__ void block(const BlockRef& cur, const BlockRef& nxt, char* lds, Seam& S, float lam, float smax, const float* subg, bool lastblk, int tid) {
    const int  wid = __builtin_amdgcn_readfirstlane(tid >> 6), lane = tid & 63, r32 = lane & 31, hi = lane >> 5, qi = wid >> 1, cc = wid & 1;
    const int NT = cur.P0 / KVBLK + 2;
    const int qlo = cur.P0 + qi * QBLK, qm = qlo + r32 - 4 * hi;
    char* V_lds = lds; char* K_lds = lds + 2 * SHM_V;
    float* wsf = (float*)(lds + LDS_WS) + wid * 64; float* li_l = wsf;
    float* exch = (float*)(lds + LDS_EX) + qi * 4096;
    float l_reg = 0; f32x16 o[4] = {};
    const int sr = tid >> 4, sc = (tid & 15) * 8, vst0 = v_st(sr, sc), vst1 = v_st(32 + sr, sc), kws = KSWZ(sr, sc * 2);
    const int vb0 = (int)(uintptr_t)V_lds + v_rd_base(lane);
    const bf16_t* Kh = cur.K; const bf16_t* Vh = cur.V;
    constexpr float C2 = 1.4426950408889634f * 0.125f; const float negM = -smax * 1.4426950408889634f;
#define KBASE(t) ((t) * KVBLK)
#define MASKT(P0_, P1_, t) do { const int kb_ = KBASE(t); if (kb_ + KVBLK - 1 > qlo) mask_tile(P0_, P1_, qm - kb_); } while (0)
    f32x16 pA0, pA1, pB0, pB1; bf16x8 pa0, pa1, pa2, pa3;
    SWRITE_HV(0); SBAR();
    SLOAD_H(Kh, Vh, KBASE(1));
    SBAR(); qkt<0>(pA0, pA1, K_lds, r32, hi, S.qr, cc);
    MASKT(pA0, pA1, 0); partialSM<ZC>(pA0, pA1, C2, negM);
    VMW(); SWRITE_H(1);
    __syncthreads();
#define HALF_STEP(PX0, PX1, PY0, PY1, t, KB, VB, SB) do {                                                      \
        SBAR(); qkt<KB>(PX0, PX1, K_lds, r32, hi, S.qr, cc);                                                  \
        finishSM(PY0, PY1, l_reg, pa0, pa1, pa2, pa3); SBAR();                                                \
        if ((t) + 1 < NT) { SLOAD_H(Kh, Vh, KBASE((t) + 1)); SBAR(); }                                        \
        MASKT(PX0, PX1, (t)); offsetSM<ZC>(PX0, PX1, negM); SBAR(); pv_tile_x<VB>(o, vb0, pa0, pa1, pa2, pa3, PX0);               \
        __syncthreads();                                                                                       \
        if ((t) + 1 < NT) { VMW(); SWRITE_H(SB); }                                                             \
        __syncthreads(); } while (0)
    for (int t = 1; t + 1 < NT; t += 2) {
        HALF_STEP(pB0, pB1, pA0, pA1, t, 1, 0, 0);
        HALF_STEP(pA0, pA1, pB0, pB1, t + 1, 0, 1, 1);
    }
    SBAR(); qkt<1>(pB0, pB1, K_lds, r32, hi, S.qr, cc); SBAR();
    SLOAD_H(nxt.K, nxt.V, 0); SBAR();
    QLOAD(nxt);
    SBAR();
    finishSM(pA0, pA1, l_reg, pa0, pa1, pa2, pa3); SBAR();
    pv_tile<0>(o, vb0, pa0, pa1, pa2, pa3);
    MASKT(pB0, pB1, NT - 1); partialSM<ZC>(pB0, pB1, C2, negM); __syncthreads();
    finishSM(pB0, pB1, l_reg, pa0, pa1, pa2, pa3); SBAR(); pv_tile<1>(o, vb0, pa0, pa1, pa2, pa3);
    SBAR(); VMWN(4); SWRITE_HK(0); SBAR();
    if (hi == 0) li_l[r32] = l_reg; asm volatile("s_waitcnt lgkmcnt(0)" ::: "memory");
    float rli[16];
#pragma unroll
    for (int r = 0; r < 16; ++r) rli[r] = __builtin_amdgcn_rcpf(li_l[crow(r, hi)]) * (cc ? lam : 1.f);
#pragma unroll
    for (int d0 = 0; d0 < 4; ++d0)
#pragma unroll
        for (int r = 0; r < 16; ++r) o[d0][r] *= rli[r];
    if (cc == 1) {
#pragma unroll
        for (int d0 = 0; d0 < 4; ++d0)
#pragma unroll
            for (int r = 0; r < 16; ++r) exch[(d0 * 16 + r) * 64 + lane] = o[d0][r];
    }
    __syncthreads();
    if (cc == 0) {
        float gsub[4];
#pragma unroll
        for (int d0 = 0; d0 < 4; ++d0) gsub[d0] = subg[d0 * 32 + r32] * (1.f - LAM_INIT);
        unsigned char* Ow8 = (unsigned char*)cur.O + (size_t)(qi * QBLK) * KP;
#pragma unroll
        for (int r = 0; r < 16; ++r) {
            float ss = 0.f;
#pragma unroll
            for (int d0 = 0; d0 < 4; ++d0) { o[d0][r] -= exch[(d0 * 16 + r) * 64 + lane]; ss += o[d0][r] * o[d0][r]; }
#pragma unroll
            for (int of = 1; of < 32; of <<= 1) ss += __shfl_xor(ss, of);
            const float rstd = rsqrtf(ss * (1.f / 128.f) + EPS); const int orow = crow(r, hi);
#pragma unroll
            for (int d0 = 0; d0 < 4; ++d0) { const float v = o[d0][r] * rstd * gsub[d0]; const float vn = __shfl_xor(v, 1);
                (void)vn; const float v0 = dpp_f<0x00>(v), v1 = dpp_f<0x55>(v), v2 = dpp_f<0xAA>(v), v3 = dpp_f<0xFF>(v);
                if ((r32 & 3) == 0) *(unsigned*)(Ow8 + (size_t)orow * KP + d0 * 32 + r32) = pk4_fp8(MIXA8_SCALE * v0, MIXA8_SCALE * v1, MIXA8_SCALE * v2, MIXA8_SCALE * v3); }
        }
    }
    if (lastblk) __syncthreads();
#undef KBASE
#undef MASKT
#undef HALF_STEP
}
template <bool ZC = false>
__device__ __forceinline__ void phase(char* lds, const bf16_t* QKb, const bf16_t* Vb, bf16_t* MX, float lam, float smax, const float* subg, int G, int vcu, int L0 = -1, int Lend = 1 << 30) {
    constexpr int NX = NQB / 2; const int TOTAL = (NB * NH * NX) < Lend ? (NB * NH * NX) : Lend;
    int L = L0 < 0 ? vcu : L0; if (L >= TOTAL) return;
    int pass = 0;
#define MKREF(ref, LL, ps) do { const int bh_ = (LL) / NX, x_ = (LL) % NX, qb_ = (ps) ? (NQB - 1 - x_) : x_, b_ = bh_ / NH, h_ = bh_ % NH; \
        const size_t row0_ = (size_t)b_ * SEQ; (ref).P0 = qb_ * QB; \
        (ref).Q = QKb + (row0_ + qb_ * QB) * KP + h_ * 128; (ref).K = QKb + row0_ * KP + 512 + h_ * 128; (ref).V = Vb + row0_ * VP + h_ * 128; \
        (ref).O = (bf16_t*)((unsigned char*)MX + ((row0_ + qb_ * QB) * KP + h_ * 128)); } while (0)
    BlockRef cur, nxt; MKREF(cur, L, 0);
    Seam S;
    int tid_ = threadIdx.x; asm volatile("" : "+v"(tid_));
    prime(cur, lds, S, tid_);
    for (;;) {
        const bool more_pass = pass == 0, more_item = L + G < TOTAL, last = !more_pass && !more_item;
        int passn = pass + 1, Ln = L;
        if (!more_pass) { passn = 0; Ln = more_item ? L + G : L; }
        if (last) nxt = cur; else MKREF(nxt, Ln, passn);
        block<ZC>(cur, nxt, lds, S, lam, smax, subg, last, tid_);
        if (last) break;
        cur = nxt; pass = passn; L = Ln;
    }
#undef MKREF
}
__device__ __forceinline__ void phase_queue(char* lds, const bf16_t* QKb, const bf16_t* Vb, bf16_t* MX, float lam, float smax, const float* subg, unsigned* qctr, int xg) {
    constexpr int TOTAL = NB * NH * NQB / 8;
    volatile int* tk = (volatile int*)(lds + LDS_END);
#define MKREFQ(ref, kk) do { const int hf_ = (kk) >> 6, k6_ = (kk) & 63, bh_ = 4 * xg + 2 * hf_ + (k6_ & 1), qb_ = NQB - 1 - (k6_ >> 1), b_ = bh_ / NH, h_ = bh_ % NH; \
        const size_t row0_ = (size_t)b_ * SEQ; (ref).P0 = qb_ * QB; \
        (ref).Q = QKb + (row0_ + qb_ * QB) * KP + h_ * 128; (ref).K = QKb + row0_ * KP + 512 + h_ * 128; (ref).V = Vb + row0_ * VP + h_ * 128; \
        (ref).O = (bf16_t*)((unsigned char*)MX + ((row0_ + qb_ * QB) * KP + h_ * 128)); } while (0)
    if (threadIdx.x == 0) { tk[0] = (int)atomicAdd(qctr, 1u); tk[1] = (int)atomicAdd(qctr, 1u); }
    __syncthreads();
    int tc = tk[0];
    if (tc >= TOTAL) { __syncthreads(); return; }
    BlockRef cur, nxt; MKREFQ(cur, tc);
    Seam S;
    int tid_ = threadIdx.x; asm volatile("" : "+v"(tid_));
    prime(cur, lds, S, tid_);
    for (int i = 0;; ++i) {
        const int tn = tk[(i + 1) & 1];
        if (threadIdx.x == 0) tk[i & 1] = (int)atomicAdd(qctr, 1u);
        const bool last = tn >= TOTAL;
        if (last) nxt = cur; else MKREFQ(nxt, tn);
        block<false>(cur, nxt, lds, S, lam, smax, subg, last, tid_);
        if (last) break;
        cur = nxt;
    }
    __syncthreads();
#undef MKREFQ
}
#undef ROWK
#undef ROWV
#undef LD8
#undef VMW
#undef VMWN
#undef SLOAD_H
#undef SWRITE_HK
#undef SWRITE_HV
#undef SWRITE_H
#undef QLOAD
#undef KSWZ
#undef SBAR
}


enum { PH_PRO = 0, PH_H1, PH_WIN, PH_WIN_F, PH_QKN, PH_ATT, PH_ATTC, PH_SSM, PH_GLU, PH_NORM, PH_WOUT, PH_WOUT_F, PH_H2, PH_RS, PH_RS2, PH_RS_F, PH_SD, PH_ROUTE, PH_SLOT, PH_E1, PH_E1_F, PH_E2, PH_COMB, PH_M_B, PH_M_D, PH_NORM2, PH_H2_2, PH_M_J2, PH_X1, PH_X2, PH_M_A2, PH_M_E3, PH_SLOT4, PH_E2S_F, PH_COMB3, PH_M_E4, PH_H2_3, PH_E1_8, PH_M_E5, PH_E1_88, PH_E2_8, PH_COMB4, PH_E2_B8, PH_E1_G8, PH_E2_P8, PH_M_J3, PH_SLOT5, PH_COMB5, PH_M_E6, PH_COUNT };
constexpr int NTHREADS = 512;
constexpr int LDS_BYTES = 147456;
constexpr int LDS_MISC_OFF = 147456 - 256;
typedef unsigned long long mask_t;
#define PHBIT(k) (1ull << (k))

template <mask_t MASK>
__global__ void __launch_bounds__(NTHREADS, 2) mega(Params p) {
    extern __shared__ __attribute__((aligned(16))) unsigned char lds_raw[];
    __builtin_amdgcn_s_setreg(1 | (23 << 6) | (0 << 11), 1);
#define MAKE_CTX() Ctx c; { int t_ = threadIdx.x; asm volatile("" : "+v"(t_)); c.tid = t_; c.lane = c.tid & 63; c.wave = __builtin_amdgcn_readfirstlane(c.tid >> 6); c.bid = blockIdx.x; c.nb = gridDim.x; \
    c.gtid = c.bid * NTHREADS + c.tid; c.gthreads = c.nb * NTHREADS; c.gwave = c.bid * (NTHREADS / 64) + c.wave; c.gwaves = c.nb * (NTHREADS / 64); c.ws = p.ws; c.lds = (float*)lds_raw; }
    unsigned char* ws = p.ws;
    PG8_LAS unsigned char* lds3 = (PG8_LAS unsigned char*)lds_raw;
    const int G = gridDim.x, bid = blockIdx.x, vcu = (G % 8 == 0) ? (bid % 8) * (G / 8) + bid / 8 : bid;
    constexpr bool MULTI = (MASK & (MASK - 1)) != 0;
    XcdBarrier bar; bar.bar = (unsigned*)(ws + WS_CTL) + CW_BAR; bar.x = 0; bar.st = nullptr;
    if constexpr (MULTI) {
        volatile LAS unsigned* misc = (volatile LAS unsigned*)(lds3 + LDS_MISC_OFF);
        if (threadIdx.x < 32) misc[threadIdx.x] = 0u;
        __syncthreads();
        bar = xcd_barrier_post((unsigned*)(ws + WS_CTL) + CW_BAR, misc + 8);
    }
    bool first = true;
#ifndef TIME_A
#define TIME_A -1
#endif
#ifndef TIME_B
#define TIME_B -1
#endif
#ifndef TIME_Q
#define TIME_Q 800
#endif
    constexpr bool TIMING = (TIME_A >= 0) || (TIME_B >= 0);
    unsigned long long tstart = 0, t_a = 0, t_b = 0; int pidx = 0;
#define STAMP() ({ if constexpr (TIMING) { const unsigned long long now_ = __builtin_amdgcn_s_memrealtime(); \
        if (pidx > 0 && pidx - 1 == TIME_A) t_a = now_ - tstart; if (pidx > 0 && pidx - 1 == TIME_B) t_b = now_ - tstart; tstart = now_; ++pidx; } true; })
#define PHASE(k) if constexpr ((MASK >> (k)) & 1ull) if ((MULTI ? (first ? (first = false, true) : (xcd_barrier(bar), true)) : true)) if (STAMP())
    PHASE(PH_PRO) { MAKE_CTX(); ph_prologue(c, p); }
    PHASE(PH_M_A2) { MAKE_CTX(); ph_prologue2(c, p); ph_convert<false>(c, p); __syncthreads(); ph_convert_shared8(c, p); }
    PHASE(PH_H1) { MAKE_CTX(); ph_h1(c, p); }
    PHASE(PH_M_B) { MAKE_CTX(); if (vcu & 1) { ph_ssm_gen(c, p); ph_router_prep(c, p); ph_h1(c, p); } else { ph_h1(c, p); ph_ssm_gen(c, p); ph_router_prep(c, p); } }
    PHASE(PH_WIN) { MAKE_CTX(); SG_Args g{(const bf16_t*)(ws + WS_H), DM, nullptr, p.in[I_WIN], nullptr, 2048, 0, nullptr, T, 2048, DM};
        EpiWin E{(bf16_t*)(ws + WS_QK), (bf16_t*)(ws + WS_V), (bf16_t*)(ws + WS_AP)}; sgemm_phase<false>(c, g, E); }
    PHASE(PH_WIN_F) { MAKE_CTX();
        { pg8::Gemm g{(const bf16_t*)(ws + WS_H), (const bf16_t*)(ws + WS_WIN_T), DM, DM, nullptr}; pg8::DenseOrder S; S.init(T, 1024, G, bid);
          pg8::EpiWinF E{(bf16_t*)(ws + WS_QK), (bf16_t*)(ws + WS_V), (bf16_t*)(ws + WS_AP)}; pg8::gemm_phase<pg8::EpiWinF, pg8::DenseOrder, false, true>(lds3, g, S, E); }
        { pg8::Gemm g{(const bf16_t*)(ws + WS_H18), (const bf16_t*)(ws + WS_WIN8), DM / 2, DM / 2, nullptr, 0x79797979u, 0x7C7C7C7Cu}; pg8::DenseOrderOff S; S.d.init(T, 1024, G, bid); S.pn_off = 4;
          pg8::EpiWinF8 E; E.QK = (bf16_t*)(ws + WS_QK); E.V = (bf16_t*)(ws + WS_V); E.AP = (bf16_t*)(ws + WS_AP); pg8::gemm_phase<pg8::EpiWinF8, pg8::DenseOrderOff, true, true, true>(lds3, g, S, E); } }
    PHASE(PH_QKN) { MAKE_CTX(); ph_qkn(c, p); }
    PHASE(PH_M_D) { { MAKE_CTX(); ph_qkn2(c, p); }
        { pg8::Gemm g{(const bf16_t*)(ws + WS_AP), (const bf16_t*)(ws + WS_SSM_BA), 256, APK, nullptr}; pg8::SsmOrder S{G, vcu};
          pg8::EpiSsmA E{(float*)(ws + WS_DS)}; pg8::gemm_phase<pg8::EpiSsmA, pg8::SsmOrder, false, false>(lds3, g, S, E); }
        __builtin_amdgcn_fence(__ATOMIC_ACQUIRE, "agent"); asm volatile("s_waitcnt vmcnt(0)" ::: "memory"); __syncthreads();
        { MAKE_CTX(); ph_ssm_scan(c, p, vcu); }
        asm volatile("s_waitcnt vmcnt(0)" ::: "memory"); __syncthreads(); __builtin_amdgcn_fence(__ATOMIC_ACQUIRE, "agent"); asm volatile("s_waitcnt vmcnt(0)" ::: "memory"); __syncthreads();
        { pg8::Gemm g{(const bf16_t*)(ws + WS_AP), (const bf16_t*)(ws + WS_SSM_BC), APK, APK, nullptr}; pg8::SsmOrder S{G, vcu};
          pg8::EpiSsmC E{(bf16_t*)(ws + WS_Y)}; pg8::gemm_phase<pg8::EpiSsmC, pg8::SsmOrder, false, false>(lds3, g, S, E); } }
    PHASE(PH_ATT) { MAKE_CTX(); ph_att_base(c, p); }
    PHASE(PH_ATTC) { MAKE_CTX(); ph_att_comb(c, p); }
    PHASE(PH_SSM) { MAKE_CTX(); ph_ssm_base(c, p); }
    PHASE(PH_M_E3) { { constexpr int GU8E = 0; MAKE_CTX(); const float* lamp = (const float*)(ws + WS_LAM); const float lam_ = lamp[0], smax_ = lamp[1];
          float* scr = c.lds + c.wave * (64 * 65);
          const int grp = vcu & 3;
          const unsigned prog = grp == 0 ? 0x0213u : grp == 1 ? 0x0231u : grp == 2 ? 0x0321u : 0x2514u;
          for (int step = 0; step < 4; ++step) {
              const int code = (int)((prog >> (4 * step)) & 15u);
              if (code == 1 || code == 2) { const int i_ = code - 1;
                  att::phase((char*)lds_raw, (const bf16_t*)(ws + WS_QK), (const bf16_t*)(ws + WS_V), (bf16_t*)(ws + WS_MIXIN), lam_, smax_, p.in[I_SUBG], G, vcu, vcu + i_ * G, vcu + i_ * G + 1); }
              else if (code >= 3) { const int lo = code == 5 ? 96 : 0, hi = code == 4 ? 96 : 192;
                  conv_range<GU8E>(c, p, vcu * 192 + lo + c.wave, vcu * 192 + hi, 8, scr); }
              __syncthreads();
          }
        }
        { pg8::Gemm g{(const bf16_t*)(ws + WS_Y), (const bf16_t*)(ws + WS_WGLU_T), 512, 512, nullptr}; pg8::DenseOrder S; S.init(T, 512, G, bid);
          pg8::EpiGluF E{(const bf16_t*)(ws + WS_Y), (bf16_t*)(ws + WS_MIXIN), (float*)(ws + WS_SS1P)}; pg8::gemm_phase<pg8::EpiGluF, pg8::DenseOrder, false, true>(lds3, g, S, E); } }
    PHASE(PH_M_E4) { { constexpr int GU8E = 1; MAKE_CTX(); const float* lamp = (const float*)(ws + WS_LAM); const float lam_ = lamp[0], smax_ = lamp[1];
          float* scr = c.lds + c.wave * (64 * 65);
          const int grp = vcu & 3;
          const unsigned prog = grp == 0 ? 0x0213u : grp == 1 ? 0x0231u : grp == 2 ? 0x0321u : 0x2514u;
          for (int step = 0; step < 4; ++step) {
              const int code = (int)((prog >> (4 * step)) & 15u);
              if (code == 1 || code == 2) { const int i_ = code - 1;
                  att::phase((char*)lds_raw, (const bf16_t*)(ws + WS_QK), (const bf16_t*)(ws + WS_V), (bf16_t*)(ws + WS_MIXIN), lam_, smax_, p.in[I_SUBG], G, vcu, vcu + i_ * G, vcu + i_ * G + 1); }
              else if (code >= 3) { const int lo = code == 5 ? 96 : 0, hi = code == 4 ? 96 : 192;
                  conv_range<GU8E>(c, p, vcu * 192 + lo + c.wave, vcu * 192 + hi, 8, scr); }
              __syncthreads();
          }
        }
        { pg8::Gemm g{(const bf16_t*)(ws + WS_Y), (const bf16_t*)(ws + WS_WGLU_T), 512, 512, nullptr}; pg8::DenseOrder S; S.init(T, 512, G, bid);
          pg8::EpiGluF E{(const bf16_t*)(ws + WS_Y), (bf16_t*)(ws + WS_MIXIN), (float*)(ws + WS_SS1P)}; pg8::gemm_phase<pg8::EpiGluF, pg8::DenseOrder, false, true>(lds3, g, S, E); } }
    PHASE(PH_M_E5) { { constexpr int GU8E = 2; MAKE_CTX(); const float* lamp = (const float*)(ws + WS_LAM); const float lam_ = lamp[0], smax_ = lamp[1];
          float* scr = c.lds + c.wave * (64 * 65);
          const int grp = vcu & 3;
          const unsigned prog = grp == 0 ? 0x0213u : grp == 1 ? 0x0231u : grp == 2 ? 0x0321u : 0x2514u;
#define E5_STEPS(ZC_) \
          for (int step = 0; step < 4; ++step) { \
              const int code = (int)((prog >> (4 * step)) & 15u); \
              if (code == 1 || code == 2) { const int i_ = code - 1; \
                  att::phase<ZC_>((char*)lds_raw, (const bf16_t*)(ws + WS_QK), (const bf16_t*)(ws + WS_V), (bf16_t*)(ws + WS_MIXIN), lam_, smax_, p.in[I_SUBG], G, vcu, vcu + i_ * G, vcu + i_ * G + 1); } \
              else if (code >= 3) { const int lo = code == 5 ? 96 : 0, hi = code == 4 ? 96 : 192; \
                  conv_range<GU8E>(c, p, vcu * 192 + lo + c.wave, vcu * 192 + hi, 8, scr); } \
              __syncthreads(); \
          }
          if (smax_ * 1.4426950408889634f <= 64.f) { E5_STEPS(true); }
          else { E5_STEPS(false); }
#undef E5_STEPS
        }
        { pg8::Gemm g{(const bf16_t*)(ws + WS_Y), (const bf16_t*)(ws + WS_WGLU_T), 512, 512, nullptr}; pg8::DenseOrder S; S.init(T, 512, G, bid);
          pg8::EpiGluF E{(const bf16_t*)(ws + WS_Y), (bf16_t*)(ws + WS_MIXIN), (float*)(ws + WS_SS1P)}; pg8::gemm_phase<pg8::EpiGluF, pg8::DenseOrder, false, true>(lds3, g, S, E); } }
    PHASE(PH_GLU) { MAKE_CTX(); SG_Args g{(const bf16_t*)(ws + WS_Y), 512, nullptr, p.in[I_WGLU], nullptr, 512, 0, nullptr, T, 512, 512};
        EpiGlu E{(const bf16_t*)(ws + WS_Y), (bf16_t*)(ws + WS_MIXIN), (float*)(ws + WS_CTL + CTL_SS1)}; sgemm_phase<false>(c, g, E); }
    PHASE(PH_NORM) { MAKE_CTX(); ph_ssm_norm(c, p); }
    PHASE(PH_NORM2) { MAKE_CTX(); ph_ssm_norm2(c, p); }
    PHASE(PH_WOUT) { MAKE_CTX(); SG_Args g{(const bf16_t*)(ws + WS_MIXIN), DM, nullptr, p.in[I_WOUT], nullptr, DM, 0, nullptr, T, DM, DM};
        EpiWout E{p.in[I_X], (const float*)(ws + WS_MOD), p.out, (float*)(ws + WS_CTL + CTL_SS2)}; sgemm_phase<false>(c, g, E); }
    PHASE(PH_WOUT_F) { MAKE_CTX(); pg8::Gemm g{(const bf16_t*)(ws + WS_MIXIN), (const bf16_t*)(ws + WS_WOUT_T), DM / 2, DM / 2, nullptr, 0x79797979u, 0x7C7C7C7Cu}; g.scale_a2 = 0x7C7C7C7Cu;
        g.mid_ss = (const float*)(ws + WS_SS1P); pg8::DenseOrder S; S.init(T, DM, G, bid);
        pg8::EpiWoutF E{p.in[I_X], (const float*)(ws + WS_MOD), (bf16_t*)(ws + WS_X1B), (float*)(ws + WS_SS2P)}; pg8::gemm_phase<pg8::EpiWoutF, pg8::DenseOrder, true, true, true, 0, true>(lds3, g, S, E); }
    PHASE(PH_H2) { MAKE_CTX(); ph_h2(c, p); }
    PHASE(PH_H2_2) { MAKE_CTX(); ph_h2_2(c, p); }
    PHASE(PH_H2_3) { MAKE_CTX(); ph_h2_3(c, p); }
    PHASE(PH_RS) { MAKE_CTX(); SG_Args g{(const bf16_t*)(ws + WS_H), DM, nullptr, p.in[I_WR], nullptr, 256, 0, nullptr, T, 256, DM};
        EpiLogits E{(float*)(ws + WS_LOGITS)}; sgemm_phase<false>(c, g, E); }
    PHASE(PH_RS2) { MAKE_CTX(); SG_Args g2{(const bf16_t*)(ws + WS_H), DM, nullptr, p.in[I_WGS], p.in[I_WUS], 256, 0, nullptr, T, 256, DM};
        EpiSwiglu E2{(bf16_t*)(ws + WS_ACTS), 256}; sgemm_phase<true>(c, g2, E2); }
    PHASE(PH_RS_F) { MAKE_CTX(); const int G2 = G >> 1;
        pg8::EpiRSF E{(float*)(ws + WS_LOGITS), (bf16_t*)(ws + WS_ACTS)};
        if (vcu < G2) { pg8::Gemm g{(const bf16_t*)(ws + WS_X1B), (const bf16_t*)(ws + WS_WRB), DM, DM, nullptr}; pg8::HalfOrder S{T / 256, 1, G2, vcu, 0, 4};
            pg8::EpiRouterX ER{(float*)(ws + WS_LOGITS), (const float*)(ws + WS_RBIAS), (const float*)(ws + WS_SS2P)}; pg8::gemm_phase<pg8::EpiRouterX, pg8::HalfOrder, false, true>(lds3, g, S, ER); }
        else { pg8::Gemm g{(const bf16_t*)(ws + WS_H8), (const bf16_t*)(ws + WS_WS8), DM / 2, DM / 2, nullptr, 0x79797979u, 0x7F7F7F7Fu}; pg8::HalfOrder S{T / 256 * 2, 2, G - G2, vcu - G2, 0};
            pg8::EpiE1F8 E8{ws + WS_ACTS}; pg8::gemm_phase<pg8::EpiE1F8, pg8::HalfOrder, true, true, true>(lds3, g, S, E8); } }
    PHASE(PH_SD) { MAKE_CTX(); SG_Args g{(const bf16_t*)(ws + WS_ACTS), 256, nullptr, p.in[I_WDS], nullptr, DM, 0, nullptr, T, DM, ED};
        EpiSD E{(const float*)(ws + WS_MOD), p.out}; sgemm_phase<false>(c, g, E); }
    PHASE(PH_ROUTE) { MAKE_CTX(); ph_route(c, p); }
    PHASE(PH_M_J2) { { MAKE_CTX(); ph_route2<false>(c, p); }
        { pg8::Gemm g{(const bf16_t*)(ws + WS_ACTS), (const bf16_t*)(ws + WS_WDS_T), ED / 2, ED / 2, nullptr, 0x7A7A7A7Au, 0x7C7C7C7Cu}; pg8::DenseOrder S; S.init(T, DM, G, bid);
          pg8::EpiSDY E{(bf16_t*)(ws + WS_YSH)}; pg8::gemm_phase<pg8::EpiSDY, pg8::DenseOrder, true, true, true, 2>(lds3, g, S, E); } }
    PHASE(PH_M_J3) { { MAKE_CTX(); ph_route2<true>(c, p); }
        { pg8::Gemm g{(const bf16_t*)(ws + WS_ACTS), (const bf16_t*)(ws + WS_WDS_T), ED / 2, ED / 2, nullptr, 0x7A7A7A7Au, 0x80808080u}; pg8::DenseOrder S; S.init(T, DM, G, bid);
          pg8::EpiSDY8 E{ws + WS_YSH}; pg8::gemm_phase<pg8::EpiSDY8, pg8::DenseOrder, true, true, true, 2, false, true>(lds3, g, S, E); } }
    PHASE(PH_SLOT5) { MAKE_CTX(); ph_slot5(c, p); }
    PHASE(PH_SLOT) { MAKE_CTX(); ph_slot(c, p); }
    PHASE(PH_SLOT4) { MAKE_CTX(); ph_slot3<true>(c, p); }
    PHASE(PH_E1) { MAKE_CTX(); SG_Args g{(const bf16_t*)(ws + WS_H), DM, (const int*)(ws + WS_SLOT_TOK), p.in[I_WGE], p.in[I_WUE], 256, (size_t)DM * ED, (const int*)(ws + WS_TILE_E), NS_MAX, ED, DM};
        EpiSwiglu E{(bf16_t*)(ws + WS_ACTE), 256}; sgemm_phase<true>(c, g, E); }
    PHASE(PH_E1_F) { MAKE_CTX(); pg8::Gemm g{(const bf16_t*)(ws + WS_H), (const bf16_t*)(ws + WS_WGU), DM, DM, (const int*)(ws + WS_SLOT_TOK)};
        pg8::GroupedOrder S{(const int*)(ws + WS_TILE_E), (int)((const unsigned*)(ws + WS_CTL))[CW_NTILES], 2, G, vcu};
        pg8::EpiE1F E{(bf16_t*)(ws + WS_ACTE)}; pg8::gemm_phase<pg8::EpiE1F, pg8::GroupedOrder, true, true>(lds3, g, S, E); }
    PHASE(PH_X1) { pg8::Gemm g{(const bf16_t*)(ws + WS_ACTE), (const bf16_t*)(ws + WS_WD), ED / 2, ED / 2, nullptr, 0x7A7A7A7Au, 0x7C7C7C7Cu};
        pg8::GroupedOrder S{(const int*)(ws + WS_TILE_E), (int)((const unsigned*)(ws + WS_CTL))[CW_NTILES], 4, G, vcu};
        pg8::EpiNone E{(float*)(ws + WS_DS)}; pg8::gemm_phase<pg8::EpiNone, pg8::GroupedOrder, true, true, true>(lds3, g, S, E); }
    PHASE(PH_X2) { pg8::Gemm g{(const bf16_t*)(ws + WS_ACTE), (const bf16_t*)(ws + WS_WD), ED, ED, nullptr};
        pg8::GroupedOrder S{(const int*)(ws + WS_TILE_E), (int)((const unsigned*)(ws + WS_CTL))[CW_NTILES], 4, G, vcu};
        pg8::EpiDense E{(bf16_t*)(ws + WS_YA)}; pg8::gemm_phase<pg8::EpiDense, pg8::GroupedOrder, false, true>(lds3, g, S, E); }
    PHASE(PH_E1_8) { pg8::Gemm g{(const bf16_t*)(ws + WS_H8), (const bf16_t*)(ws + WS_WGU), DM / 2, DM / 2, (const int*)(ws + WS_SLOT_TOK), 0x79797979u};
        pg8::GroupedOrder S{(const int*)(ws + WS_TILE_E), (int)((const unsigned*)(ws + WS_CTL))[CW_NTILES], 2, G, vcu};
        pg8::EpiE1F E{(bf16_t*)(ws + WS_ACTE)}; pg8::gemm_phase<pg8::EpiE1F, pg8::GroupedOrder, true, true, true>(lds3, g, S, E); }
    PHASE(PH_E1_88) { pg8::Gemm g{(const bf16_t*)(ws + WS_H8), (const bf16_t*)(ws + WS_WGU), DM / 2, DM / 2, (const int*)(ws + WS_SLOT_TOK), 0x79797979u};
        pg8::GroupedOrderL S{nullptr, (int)((const unsigned*)(ws + WS_CTL))[CW_NTILES], 2, G, vcu}; S.fill((const int*)(ws + WS_TILE_E), (PG8_LAS int*)(lds3 + 131072));
        pg8::EpiE1F8 E{ws + WS_ACTE}; pg8::gemm_phase<pg8::EpiE1F8, pg8::GroupedOrderL, true, true, true>(lds3, g, S, E); }
    PHASE(PH_E2_8) { pg8::Gemm g{(const bf16_t*)(ws + WS_ACTE), (const bf16_t*)(ws + WS_WD), ED / 2, ED / 2, nullptr, 0x7A7A7A7Au, 0x7C7C7C7Cu};
        pg8::GroupedOrder S{(const int*)(ws + WS_TILE_E), (int)((const unsigned*)(ws + WS_CTL))[CW_NTILES], 4, G, vcu};
        pg8::EpiE2S8b E{(const float*)(ws + WS_SLOT_GATE), ws + WS_YS}; pg8::gemm_phase<pg8::EpiE2S8b, pg8::GroupedOrder, true, true, true>(lds3, g, S, E); }
    PHASE(PH_E2_B8) { pg8::Gemm g{(const bf16_t*)(ws + WS_ACTE), (const bf16_t*)(ws + WS_WD), ED, ED, nullptr};
        pg8::GroupedOrder S{(const int*)(ws + WS_TILE_E), (int)((const unsigned*)(ws + WS_CTL))[CW_NTILES], 4, G, vcu};
        pg8::EpiE2S8 E{(const float*)(ws + WS_SLOT_GATE), ws + WS_YS}; pg8::gemm_phase<pg8::EpiE2S8, pg8::GroupedOrder, false, true>(lds3, g, S, E); }
    PHASE(PH_E1_G8) { pg8::Gemm g{(const bf16_t*)(ws + WS_H8), (const bf16_t*)(ws + WS_WGU), DM / 2, DM / 2, (const int*)(ws + WS_SLOT_TOK), 0x79797979u};
        pg8::GroupedOrder S{(const int*)(ws + WS_TILE_E), (int)((const unsigned*)(ws + WS_CTL))[CW_NTILES], 2, G, vcu};
        pg8::EpiE1G8 E{(const float*)(ws + WS_SLOT_GATE), ws + WS_ACTE}; pg8::gemm_phase<pg8::EpiE1G8, pg8::GroupedOrder, true, true, true>(lds3, g, S, E); }
    static_assert(Y8_SCALE == 16.f && ACT8_SCALE == 8.f && WD8_SCALE == 32.f, "E8M0 scales below");
    PHASE(PH_E2_P8) { pg8::Gemm g{(const bf16_t*)(ws + WS_ACTE), (const bf16_t*)(ws + WS_WD), ED / 2, ED / 2, nullptr, 0x7A7A7A7Au, 0x80808080u};
        pg8::GroupedOrderL S{nullptr, (int)((const unsigned*)(ws + WS_CTL))[CW_NTILES], 4, G, vcu}; S.fill((const int*)(ws + WS_TILE_E), (PG8_LAS int*)(lds3 + 131072));
        pg8::EpiE2P16 E{ws + WS_YS, ws + WS_DUMP + (threadIdx.x & 63) * 16}; pg8::gemm_phase<pg8::EpiE2P16, pg8::GroupedOrderL, true, true, true, 2, false, true>(lds3, g, S, E); }
    PHASE(PH_COMB5) { MAKE_CTX(); ph_combine5(c, p); }
    PHASE(PH_COMB4) { MAKE_CTX(); ph_combine4(c, p); }
    PHASE(PH_E2) { MAKE_CTX(); SG_Args g{(const bf16_t*)(ws + WS_ACTE), 256, nullptr, p.in[I_WDE], nullptr, DM, (size_t)ED * DM, (const int*)(ws + WS_TILE_E), NS_MAX, DM, ED};
        EpiE2 E{(const int*)(ws + WS_SLOT_ASG), (const float*)(ws + WS_SLOT_GATE), (bf16_t*)(ws + WS_YA)}; sgemm_phase<false>(c, g, E); }
    PHASE(PH_E2S_F) { pg8::Gemm g{(const bf16_t*)(ws + WS_ACTE), (const bf16_t*)(ws + WS_WD), ED, ED, nullptr};
        pg8::GroupedOrder S{(const int*)(ws + WS_TILE_E), (int)((const unsigned*)(ws + WS_CTL))[CW_NTILES], 4, G, vcu};
        pg8::EpiE2S E{(const int*)(ws + WS_SLOT_ASG), (const float*)(ws + WS_SLOT_GATE), (bf16_t*)(ws + WS_YS)}; pg8::gemm_phase<pg8::EpiE2S, pg8::GroupedOrder, false, true>(lds3, g, S, E); }
    PHASE(PH_COMB3) { MAKE_CTX(); ph_combine3(c, p); }
    PHASE(PH_COMB) { MAKE_CTX(); ph_combine(c, p); }
    if constexpr (TIMING) {
        xcd_barrier(bar); (void)STAMP();
        if (blockIdx.x == 0 && threadIdx.x == 0) {
            const unsigned long long qb = (t_b + TIME_Q / 2) / TIME_Q;
            const unsigned long long wait = t_a + qb * 102400ull, t0 = __builtin_amdgcn_s_memrealtime();
            while (__builtin_amdgcn_s_memrealtime() - t0 < wait) __builtin_amdgcn_s_sleep(8);
        }
    }
#undef PHASE
}

#ifndef PLAN
#define PLAN 18
#endif
#if PLAN == 0
#define LAUNCH_LIST X(PHBIT(PH_PRO)) X(PHBIT(PH_H1)) X(PHBIT(PH_WIN)) X(PHBIT(PH_QKN)) X(PHBIT(PH_ATT)) X(PHBIT(PH_ATTC)) X(PHBIT(PH_SSM)) X(PHBIT(PH_GLU)) X(PHBIT(PH_NORM)) \
    X(PHBIT(PH_WOUT)) X(PHBIT(PH_H2)) X(PHBIT(PH_RS)) X(PHBIT(PH_RS2)) X(PHBIT(PH_SD)) X(PHBIT(PH_ROUTE)) X(PHBIT(PH_SLOT)) X(PHBIT(PH_E1)) X(PHBIT(PH_E2)) X(PHBIT(PH_COMB))
#elif PLAN == 99
#define LAUNCH_LIST X(PHBIT(PH_M_E5)) X(PHBIT(PH_E1_88)) X(PHBIT(PH_E2_8)) X(PHBIT(PH_COMB4)) X(PHBIT(PH_H2_3)) X(PHBIT(PH_M_D)) X(PHBIT(PH_WIN_F)) X(PHBIT(PH_WOUT_F)) X(PHBIT(PH_RS_F)) X(PHBIT(PH_M_J2))
#elif PLAN == 18
#define LAUNCH_LIST X(PHBIT(PH_M_A2) | PHBIT(PH_M_B) | PHBIT(PH_WIN_F) | PHBIT(PH_M_D) | PHBIT(PH_M_E5) | PHBIT(PH_WOUT_F) | PHBIT(PH_H2_3) | PHBIT(PH_RS_F) | PHBIT(PH_M_J3) | PHBIT(PH_SLOT5) | PHBIT(PH_E1_88) | PHBIT(PH_E2_P8) | PHBIT(PH_COMB5))
#endif

extern "C" void kernel_launch(void* const* d_in, const int* in_sizes, int n_in, void* d_out, int out_size, void* d_ws, size_t ws_size, hipStream_t stream) {
    static int grid = 0;
    if (grid == 0) {
        if (n_in != 33 || out_size != T * DM || ws_size < WS_NEED) { fprintf(stderr, "kernel_launch: unexpected shapes (n_in %d out %d ws %zu)\n", n_in, out_size, ws_size); grid = -1; return; }
        int dev = 0, cus = 0;
        if (hipGetDevice(&dev) != hipSuccess || hipDeviceGetAttribute(&cus, hipDeviceAttributeMultiprocessorCount, dev) != hipSuccess) { grid = -1; return; }
        bool ok = true;
#define X(m) ok = ok && (hipFuncSetAttribute((const void*)mega<(m)>, hipFuncAttributeMaxDynamicSharedMemorySize, LDS_BYTES) == hipSuccess);
        LAUNCH_LIST
#undef X
        if (!ok) { grid = -1; return; }
        grid = cus;
    }
    if (grid < 0) return;
    (void)hipMemsetAsync((char*)d_ws + WS_CTL, 0, CTL_BYTES, stream);
    Params a{};
    for (int i = 0; i < 33; ++i) a.in[i] = (const float*)d_in[i];
    a.out = (float*)d_out; a.ws = (unsigned char*)d_ws;
#define X(m) hipLaunchKernelGGL((mega<(m)>), dim3(grid), dim3(NTHREADS), LDS_BYTES, stream, a);
    LAUNCH_LIST
#undef X
}
```
